# Optimizing an MI355X kernel written in HIP

```python
import math
import jax, jax.numpy as jnp
from jax import lax
import numpy as np


D_MODEL = 1024
BATCH = 2
SEQ = 16384
DEPTH = 1
DEC_BATCH = 8
DEC_SEQ = 8192
PAST_LEN = 128

N_MEM = 256
RMS_EPS = 1e-6
ROPE_THETA = 10000.0

GLA_HEADS = 4
GLA_DK = 128
GLA_DV = 256
GLA_LOWRANK = 16
GLA_GATE_NORM = 16.0
GLA_CHUNK = 64
GLA_QK = GLA_HEADS * GLA_DK
GLA_V = GLA_HEADS * GLA_DV

DIFF_HEADS = 8
DIFF_DH = 64
DIFF_DV = 2 * DIFF_DH
DIFF_QK = DIFF_HEADS * 2 * DIFF_DH
DIFF_V = DIFF_HEADS * DIFF_DV
QUERY_BLOCK = 128

MEM_HEADS = 4
MEM_DH = 256
MEM_Q = MEM_HEADS * MEM_DH

N_BRANCH = 3
SPLIT_SIZES = (GLA_QK, GLA_QK, GLA_V, GLA_V, GLA_LOWRANK, GLA_LOWRANK,
               DIFF_QK, DIFF_QK, DIFF_V, MEM_Q, N_BRANCH * D_MODEL)
IN_COLS = sum(SPLIT_SIZES)

PEER_HEADS = 8
PEER_NKEYS = 128
PEER_EXPERTS = PEER_NKEYS * PEER_NKEYS
PEER_DQ = 256
PEER_DQH = PEER_DQ // 2
PEER_TOPK = 16
PEER_TOKEN_BLOCK = 128

kernel_name = 'hybrid_gla_diffattn_peer_encoder'


def rmsnorm(x, g):
    xf = x.astype(jnp.float32)
    return xf * lax.rsqrt(jnp.mean(xf * xf, axis=-1, keepdims=True) + RMS_EPS) * g.astype(jnp.float32)


def rope(x):
    T, d = x.shape[1], x.shape[-1]
    inv_freq = ROPE_THETA ** (-jnp.arange(0, d, 2, dtype=jnp.float32) / d)
    ang = jnp.arange(T, dtype=jnp.float32)[:, None] * inv_freq[None, :]
    bshape = (1, T) + (1,) * (x.ndim - 3) + (d // 2,)
    cos, sin = jnp.cos(ang).reshape(bshape), jnp.sin(ang).reshape(bshape)
    x1, x2 = x[..., : d // 2], x[..., d // 2:]
    return jnp.concatenate([x1 * cos - x2 * sin, x2 * cos + x1 * sin], axis=-1)


def split_cols(proj):
    points = np.cumsum(np.array(SPLIT_SIZES))[:-1].tolist()
    return jnp.split(proj, points, axis=-1)


def gla_chunked(q, k, v, log_a):
    B, H, T, dk = q.shape
    dv = v.shape[-1]
    C = GLA_CHUNK
    N = T // C
    q = q.reshape(B, H, N, C, dk)
    k = k.reshape(B, H, N, C, dk)
    log_a = log_a.reshape(B, H, N, C, dk)
    v = v.reshape(B, H, N, C, dv)
    b = jnp.cumsum(log_a, axis=3)
    b_last = b[:, :, :, -1:, :]
    q_e = q * jnp.exp(b)
    k_e = k * jnp.exp(-b)
    k_s = k * jnp.exp(b_last - b)
    mask = jnp.tril(jnp.ones((C, C), dtype=bool))
    att = jnp.where(mask, jnp.einsum('bhncd,bhnsd->bhncs', q_e, k_e), 0.0)
    o_intra = jnp.einsum('bhncs,bhnse->bhnce', att, v)
    u = jnp.einsum('bhncd,bhnce->bhnde', k_s, v)
    g = jnp.exp(b_last[:, :, :, 0, :])

    def step(S, inp):
        g_n, u_n = inp
        return g_n[..., None] * S + u_n, S

    S0 = jnp.zeros((B, H, dk, dv), jnp.float32)
    _, S_prev = lax.scan(step, S0, (jnp.moveaxis(g, 2, 0), jnp.moveaxis(u, 2, 0)))
    S_prev = jnp.moveaxis(S_prev, 0, 2)
    o_inter = jnp.einsum('bhncd,bhnde->bhnce', q_e, S_prev)
    return (o_intra + o_inter).reshape(B, H, T, dv)


def gla_branch(q, k, v, gate, lr_f, lr_b, w_dec_f, b_dec_f, w_dec_b, b_dec_b, g_out, w_o):
    B, T, _ = q.shape
    dt = q.dtype

    def heads(t, d):
        return t.astype(jnp.float32).reshape(B, T, GLA_HEADS, d).transpose(0, 2, 1, 3)

    qh = heads(q, GLA_DK) * (GLA_DK ** -0.5)
    kh = heads(k, GLA_DK)
    vh = heads(v, GLA_DV)
    la_f = heads(jax.nn.log_sigmoid((lr_f @ w_dec_f + b_dec_f).astype(jnp.float32)) / GLA_GATE_NORM, GLA_DK)
    la_b = heads(jax.nn.log_sigmoid((lr_b @ w_dec_b + b_dec_b).astype(jnp.float32)) / GLA_GATE_NORM, GLA_DK)
    fwd = gla_chunked(qh, kh, vh, la_f)
    fl = lambda t: jnp.flip(t, axis=2)
    bwd = fl(gla_chunked(fl(qh), fl(kh), fl(vh), fl(la_b)))
    diag = jnp.sum(qh * kh, axis=-1, keepdims=True) * vh
    o = (fwd + bwd - diag).transpose(0, 2, 1, 3)
    o = rmsnorm(o, g_out) * jax.nn.silu(gate.astype(jnp.float32).reshape(B, T, GLA_HEADS, GLA_DV))
    return o.reshape(B, T, GLA_V).astype(dt) @ w_o


def diff_branch(q, k, v, g_q, g_k, lq1, lk1, lq2, lk2, g_sub, w_o, lam_init):
    B, T, _ = q.shape
    dt = q.dtype
    qh = rope(rmsnorm(q.reshape(B, T, DIFF_HEADS, 2, DIFF_DH), g_q))
    kh = rope(rmsnorm(k.reshape(B, T, DIFF_HEADS, 2, DIFF_DH), g_k))
    vh = v.astype(jnp.float32).reshape(B, T, DIFF_HEADS, DIFF_DV)
    f32 = lambda t: t.astype(jnp.float32)
    lam = jnp.exp(jnp.sum(f32(lq1) * f32(lk1))) - jnp.exp(jnp.sum(f32(lq2) * f32(lk2))) + lam_init
    scale = DIFF_DH ** -0.5
    nb = T // QUERY_BLOCK
    qb = qh.reshape(B, nb, QUERY_BLOCK, DIFF_HEADS, 2, DIFF_DH).swapaxes(0, 1)

    def block(qi):
        s = jnp.einsum('bqhcd,bkhcd->bhcqk', qi, kh) * scale
        p = jax.nn.softmax(s, axis=-1)
        a = p[:, :, 0] - lam * p[:, :, 1]
        return jnp.einsum('bhqk,bkhe->bqhe', a, vh)

    o = lax.map(block, qb).swapaxes(0, 1).reshape(B, T, DIFF_HEADS, DIFF_DV)
    o = rmsnorm(o, g_sub) * (1.0 - lam_init)
    return o.reshape(B, T, DIFF_V).astype(dt) @ w_o


def mem_branch(q, mem, g_mem, w_kv, g_q, g_k, w_o):
    B, T, _ = q.shape
    M = mem.shape[1]
    dt = q.dtype
    kv = rmsnorm(mem, g_mem).astype(dt) @ w_kv
    k, v = jnp.split(kv, 2, axis=-1)
    kh = rmsnorm(k.reshape(B, M, MEM_HEADS, MEM_DH), g_k)
    vh = v.astype(jnp.float32).reshape(B, M, MEM_HEADS, MEM_DH)
    qh = rmsnorm(q.reshape(B, T, MEM_HEADS, MEM_DH), g_q)
    s = jnp.einsum('bthd,bmhd->bhtm', qh, kh) * (MEM_DH ** -0.5)
    p = jax.nn.softmax(s, axis=-1)
    o = jnp.einsum('bhtm,bmhd->bthd', p, vh)
    return o.reshape(B, T, MEM_Q).astype(dt) @ w_o


def peer(h, w_q, sub_k1, sub_k2, u_tab, v_tab):
    B, T, D = h.shape
    tokens = h.reshape(-1, PEER_TOKEN_BLOCK, D)
    k1 = sub_k1.astype(jnp.float32)
    k2 = sub_k2.astype(jnp.float32)

    def block(hb):
        n = hb.shape[0]
        q = (hb @ w_q).astype(jnp.float32).reshape(n, PEER_HEADS, 2, PEER_DQH)
        s1 = jnp.einsum('nhd,kd->nhk', q[:, :, 0], k1)
        s2 = jnp.einsum('nhd,kd->nhk', q[:, :, 1], k2)
        v1, i1 = lax.top_k(s1, PEER_TOPK)
        v2, i2 = lax.top_k(s2, PEER_TOPK)
        cand = (v1[..., :, None] + v2[..., None, :]).reshape(n, PEER_HEADS, PEER_TOPK * PEER_TOPK)
        cidx = (i1[..., :, None] * PEER_NKEYS + i2[..., None, :]).reshape(n, PEER_HEADS, PEER_TOPK * PEER_TOPK)
        top_s, pos = lax.top_k(cand, PEER_TOPK)
        eidx = jnp.take_along_axis(cidx, pos, axis=-1)
        gates = jax.nn.softmax(top_s, axis=-1)
        a = jnp.einsum('nhkd,nd->nhk', u_tab[eidx].astype(jnp.float32), hb.astype(jnp.float32))
        w = gates * jax.nn.gelu(a, approximate=False)
        return jnp.einsum('nhk,nhkd->nd', w, v_tab[eidx].astype(jnp.float32)).astype(h.dtype)

    return lax.map(block, tokens).reshape(B, T, D)


def trunk(x, mem, g_mix, w_in, gla_w_dec_f, gla_b_dec_f, gla_w_dec_b, gla_b_dec_b, gla_g_out, gla_w_o,
          diff_g_q, diff_g_k, diff_lq1, diff_lk1, diff_lq2, diff_lk2, diff_g_sub, diff_w_o,
          mem_g_norm, mem_w_kv, mem_g_q, mem_g_k, mem_w_o, w_out,
          g_ffn, peer_w_q, peer_sub_k1, peer_sub_k2, peer_u, peer_v):
    dt = x.dtype
    B, T, D = x.shape
    for l in range(DEPTH):
        lam_init = 0.8 - 0.6 * math.exp(-0.3 * l)
        h = rmsnorm(x, g_mix[l]).astype(dt)
        (g_q, g_k, g_v, g_gate, lr_f, lr_b, d_q, d_k, d_v, m_q, br_gate) = split_cols(h @ w_in[l])
        y_gla = gla_branch(g_q, g_k, g_v, g_gate, lr_f, lr_b, gla_w_dec_f[l], gla_b_dec_f[l],
                           gla_w_dec_b[l], gla_b_dec_b[l], gla_g_out[l], gla_w_o[l])
        y_diff = diff_branch(d_q, d_k, d_v, diff_g_q[l], diff_g_k[l], diff_lq1[l], diff_lk1[l],
                             diff_lq2[l], diff_lk2[l], diff_g_sub[l], diff_w_o[l], lam_init)
        y_mem = mem_branch(m_q, mem, mem_g_norm[l], mem_w_kv[l], mem_g_q[l], mem_g_k[l], mem_w_o[l])
        gates = jax.nn.sigmoid(br_gate.astype(jnp.float32)).reshape(B, T, N_BRANCH, D)
        merged = (gates[:, :, 0] * y_gla.astype(jnp.float32) + gates[:, :, 1] * y_diff.astype(jnp.float32)
                  + gates[:, :, 2] * y_mem.astype(jnp.float32))
        x = x + merged.astype(dt) @ w_out[l]
        x = x + peer(rmsnorm(x, g_ffn[l]).astype(dt), peer_w_q[l], peer_sub_k1[l], peer_sub_k2[l],
                     peer_u[l], peer_v[l])
    return x


def setup_inputs(seed: int = 0) -> dict:
    key = jax.random.key(seed)
    ks = iter(jax.random.split(key, 40))

    def nrm(shape, scale):
        return jax.random.normal(next(ks), shape, jnp.float32) * scale

    def gain(d):
        return 1.0 + nrm((DEPTH, d), 0.05)

    L, D = DEPTH, D_MODEL
    return {
        'x_prompt': nrm((BATCH, SEQ, D), 1.0),
        'x_sample': nrm((DEC_BATCH, DEC_SEQ, D), 1.0),
        'mem_prompt': nrm((BATCH, N_MEM, D), 1.0),
        'mem_sample': nrm((DEC_BATCH, N_MEM, D), 1.0),
        'g_mix': gain(D),
        'w_in': nrm((L, D, IN_COLS), D ** -0.5),
        'gla_w_dec_f': nrm((L, GLA_LOWRANK, GLA_QK), GLA_LOWRANK ** -0.5),
        'gla_b_dec_f': nrm((L, GLA_QK), 0.1),
        'gla_w_dec_b': nrm((L, GLA_LOWRANK, GLA_QK), GLA_LOWRANK ** -0.5),
        'gla_b_dec_b': nrm((L, GLA_QK), 0.1),
        'gla_g_out': gain(GLA_DV),
        'gla_w_o': nrm((L, GLA_V, D), GLA_V ** -0.5),
        'diff_g_q': gain(DIFF_DH),
        'diff_g_k': gain(DIFF_DH),
        'diff_lq1': nrm((L, DIFF_DH), 0.1),
        'diff_lk1': nrm((L, DIFF_DH), 0.1),
        'diff_lq2': nrm((L, DIFF_DH), 0.1),
        'diff_lk2': nrm((L, DIFF_DH), 0.1),
        'diff_g_sub': gain(DIFF_DV),
        'diff_w_o': nrm((L, DIFF_V, D), DIFF_V ** -0.5),
        'mem_g_norm': gain(D),
        'mem_w_kv': nrm((L, D, 2 * MEM_Q), D ** -0.5),
        'mem_g_q': gain(MEM_DH),
        'mem_g_k': gain(MEM_DH),
        'mem_w_o': nrm((L, MEM_Q, D), MEM_Q ** -0.5),
        'w_out': nrm((L, D, D), D ** -0.5),
        'g_ffn': gain(D),
        'peer_w_q': nrm((L, D, PEER_HEADS * PEER_DQ), D ** -0.5),
        'peer_sub_k1': nrm((L, PEER_NKEYS, PEER_DQH), PEER_DQH ** -0.5),
        'peer_sub_k2': nrm((L, PEER_NKEYS, PEER_DQH), PEER_DQH ** -0.5),
        'peer_u': nrm((L, PEER_EXPERTS, D), D ** -0.5),
        'peer_v': nrm((L, PEER_EXPERTS, D), (PEER_HEADS * PEER_TOPK) ** -0.5),
    }


def reference(x_prompt, x_sample, mem_prompt, mem_sample, g_mix, w_in, gla_w_dec_f, gla_b_dec_f,
              gla_w_dec_b, gla_b_dec_b, gla_g_out, gla_w_o, diff_g_q, diff_g_k, diff_lq1, diff_lk1,
              diff_lq2, diff_lk2, diff_g_sub, diff_w_o, mem_g_norm, mem_w_kv, mem_g_q, mem_g_k, mem_w_o,
              w_out, g_ffn, peer_w_q, peer_sub_k1, peer_sub_k2, peer_u, peer_v):
    weights = (g_mix, w_in, gla_w_dec_f, gla_b_dec_f, gla_w_dec_b, gla_b_dec_b, gla_g_out, gla_w_o,
               diff_g_q, diff_g_k, diff_lq1, diff_lk1, diff_lq2, diff_lk2, diff_g_sub, diff_w_o,
               mem_g_norm, mem_w_kv, mem_g_q, mem_g_k, mem_w_o, w_out,
               g_ffn, peer_w_q, peer_sub_k1, peer_sub_k2, peer_u, peer_v)
    y_prompt = trunk(x_prompt, mem_prompt, *weights)
    y_sample = trunk(x_sample, mem_sample, *weights)
    return (y_prompt, y_sample)
```

```cpp
#include <hip/hip_runtime.h>
#include <hip/hip_cooperative_groups.h>
#include <cstdio>
#include <cstdint>
namespace cg = cooperative_groups;

typedef unsigned short bf16_t;
typedef short bf16x8 __attribute__((ext_vector_type(8)));
typedef float f32x4 __attribute__((ext_vector_type(4)));
typedef unsigned u32x4 __attribute__((ext_vector_type(4)));
typedef unsigned u32x2 __attribute__((ext_vector_type(2)));

constexpr int D = 1024;
constexpr int NP = 10496;
constexpr int IN_COLS = 10272;
constexpr int C_GQ = 0, C_GK = 512, C_GV = 1024, C_GG = 2048, C_DQ = 3072, C_DK = 4096, C_DV = 5120, C_MQ = 6144, C_BG = 7168, C_LR = 10240;
constexpr int G_TOK = 32768;
constexpr int NGROUP = 3;
constexpr int NTHR = 512;
constexpr float RMS_EPS = 1e-6f;
constexpr float LOG2E = 1.4426950408889634f;
constexpr int LDS_BYTES = 126976;

enum { I_XP = 0, I_XS, I_MP, I_MS, I_GMIX, I_WIN, I_WDF, I_BDF, I_WDB, I_BDB, I_GOUT, I_GWO, I_DGQ, I_DGK, I_LQ1, I_LK1, I_LQ2, I_LK2,
       I_DGSUB, I_DWO, I_MGN, I_MWKV, I_MGQ, I_MGK, I_MWO, I_WOUT, I_GFFN, I_PWQ, I_PK1, I_PK2, I_PU, I_PV };

constexpr size_t al256(size_t x) { return (x + 255) & ~(size_t)255; }
constexpr size_t WS_CTRL = 0;
constexpr size_t WS_PROJ = 4096;
constexpr size_t WS_HB   = WS_PROJ + (size_t)G_TOK * NP * 2;
constexpr size_t WS_VT   = WS_HB + (size_t)G_TOK * D * 2;
constexpr size_t WS_WINT = WS_VT + (size_t)G_TOK * D * 2;
constexpr size_t WS_WOT  = WS_WINT + (size_t)NP * D * 2;
constexpr size_t WS_WKVT = WS_WOT + (size_t)4 * D * D * 2;
constexpr size_t WS_WQT  = WS_WKVT + (size_t)2048 * D * 2;
constexpr size_t WS_PU   = WS_WQT + (size_t)2048 * D * 2;
constexpr size_t WS_PV   = WS_PU + (size_t)16384 * D * 2;
constexpr size_t WS_K12  = WS_PV + (size_t)16384 * D * 2;
constexpr size_t WS_ROPE = WS_K12 + (size_t)2 * 128 * 128 * 2;
constexpr size_t WS_HM   = WS_ROPE + (size_t)16384 * 64 * 4;
constexpr size_t WS_KVR  = WS_HM + (size_t)2560 * D * 2;
constexpr size_t WS_MEMK = WS_KVR + (size_t)2560 * 2048 * 4;
constexpr size_t WS_MEMV = WS_MEMK + (size_t)10 * 4 * 256 * 256 * 2;
constexpr size_t WS_END  = WS_MEMV + (size_t)10 * 4 * 256 * 256 * 2;

struct Params {
    const float* in[32];
    float* out;
    unsigned char* ws;
    int ph_lo, ph_hi;
};

typedef float f32x2 __attribute__((ext_vector_type(2)));
typedef __bf16 bf16x2v __attribute__((ext_vector_type(2)));
__device__ __forceinline__ unsigned pk2(float lo, float hi) { const f32x2 v = {lo, hi}; const bf16x2v b = __builtin_convertvector(v, bf16x2v); return __builtin_bit_cast(unsigned, b); }
__device__ __forceinline__ float bflo(unsigned u) { return __uint_as_float(u << 16); }
__device__ __forceinline__ float bfhi(unsigned u) { return __uint_as_float(u & 0xffff0000u); }
__device__ __forceinline__ float bf2f(bf16_t b) { return __uint_as_float(((unsigned)b) << 16); }
__device__ __forceinline__ bf16_t f2bf(float f) { return (bf16_t)(pk2(f, 0.f) & 0xffffu); }
__device__ __forceinline__ float wave_sum(float v) {
#pragma unroll
    for (int o = 1; o < 64; o <<= 1) v += __shfl_xor(v, o);
    return v;
}
__device__ __forceinline__ f32x4 mfma16(bf16x8 a, bf16x8 b, f32x4 c) { return __builtin_amdgcn_mfma_f32_16x16x32_bf16(a, b, c, 0, 0, 0); }
__device__ __forceinline__ float fexp2(float x) { return __builtin_amdgcn_exp2f(x); }
__device__ __forceinline__ int otid() { int t = threadIdx.x; asm volatile("" : "+v"(t)); return t; }

struct Grp { const float* x; const float* mem; float* out; int B, T, mb0; };
__device__ __forceinline__ Grp get_group(const Params& p, int g) {
    Grp r;
    if (g == 0) { r.x = p.in[I_XP]; r.out = p.out; r.B = 2; r.T = 16384; r.mb0 = 0; }
    else { r.x = p.in[I_XS] + (size_t)(g - 1) * G_TOK * D; r.out = p.out + (size_t)g * G_TOK * D; r.B = 4; r.T = 8192; r.mb0 = 2 + (g - 1) * 4; }
    r.mem = nullptr;
    return r;
}

constexpr int G_ROW = 144;
constexpr int G_A_BYTES = 128 * G_ROW;
constexpr int G_B_BYTES = 256 * G_ROW;
constexpr int G_STAGE = G_A_BYTES + G_B_BYTES;

template <bool SWAP>
__device__ __forceinline__ void gemm_kloop(f32x4 (&acc)[4][4], const bf16_t* __restrict__ A, int lda, const bf16_t* __restrict__ Bt, int ldb, int K, char* lds) {
    const int tid = otid(), lane = tid & 63, wid = tid >> 6, wm = wid >> 2, wn = wid & 3, fr = lane & 15, fq = lane >> 4;
    const int lr = tid >> 3, lc = tid & 7;
    u32x4 ra[2], rb[4];
    const bf16_t* Ap = A + (size_t)lr * lda + lc * 8;
    const bf16_t* Bp = Bt + (size_t)lr * ldb + lc * 8;
#define GLOAD(k0) do { _Pragma("unroll") for (int i = 0; i < 2; ++i) ra[i] = *(const u32x4*)(Ap + (size_t)(i * 64) * lda + (k0)); \
                       _Pragma("unroll") for (int i = 0; i < 4; ++i) rb[i] = *(const u32x4*)(Bp + (size_t)(i * 64) * ldb + (k0)); } while (0)
#define SWRITE(buf) do { char* b_ = lds + (buf) * G_STAGE + lr * G_ROW + lc * 16; \
                       _Pragma("unroll") for (int i = 0; i < 2; ++i) *(u32x4*)(b_ + i * 64 * G_ROW) = ra[i]; \
                       _Pragma("unroll") for (int i = 0; i < 4; ++i) *(u32x4*)(b_ + G_A_BYTES + i * 64 * G_ROW) = rb[i]; } while (0)
    const int nk = K / 64;
    GLOAD(0); SWRITE(0); __syncthreads();
    for (int kt = 0; kt < nk; ++kt) {
        if (kt + 1 < nk) GLOAD((kt + 1) * 64);
        const char* base = lds + (kt & 1) * G_STAGE;
#pragma unroll
        for (int ks = 0; ks < 2; ++ks) {
            bf16x8 af[4], bfr[4];
#pragma unroll
            for (int mt = 0; mt < 4; ++mt) af[mt] = *(const bf16x8*)(base + (wm * 64 + mt * 16 + fr) * G_ROW + ks * 64 + fq * 16);
#pragma unroll
            for (int nt = 0; nt < 4; ++nt) bfr[nt] = *(const bf16x8*)(base + G_A_BYTES + (wn * 64 + nt * 16 + fr) * G_ROW + ks * 64 + fq * 16);
#pragma unroll
            for (int mt = 0; mt < 4; ++mt)
#pragma unroll
                for (int nt = 0; nt < 4; ++nt)
                    acc[mt][nt] = SWAP ? mfma16(bfr[nt], af[mt], acc[mt][nt]) : mfma16(af[mt], bfr[nt], acc[mt][nt]);
        }
        if (kt + 1 < nk) SWRITE((kt + 1) & 1);
        __syncthreads();
    }
#undef GLOAD
#undef SWRITE
}

__device__ __forceinline__ void tile_order(int t, int nM, int nN, int& pm, int& pn) {
    const int per = 8 * nN, grp = t / per, r = t % per;
    pm = grp * 8 + (r & 7); pn = r >> 3;
}

__device__ __forceinline__ void phase_p0a(const Params& p, char* lds) {
    const int tid = otid(), lane = tid & 63, wid = tid >> 6;
    unsigned char* ws = p.ws;
    if (blockIdx.x == 0 && tid < 256) atomicExch((unsigned*)(ws + WS_CTRL) + tid, 0u);
    float* scr = (float*)(lds + wid * 8448);
    constexpr int IT_WIN = 16 * (NP / 32), IT_SQ = 16 * 32, IT_W2 = 16 * 64;
    constexpr int NIT = IT_WIN + 4 * IT_SQ + 2 * IT_W2;
    for (int it0 = blockIdx.x * 8; it0 < NIT; it0 += gridDim.x * 8) {
        int it = it0 + wid;
        const float* W = nullptr; bf16_t* WT = nullptr; int N = 0, nb = 0, kb = 0, srccol = -1;
        if (it < NIT) {
            int r = it;
            if (r < IT_WIN) { W = p.in[I_WIN]; N = IN_COLS; WT = (bf16_t*)(ws + WS_WINT); kb = r / (NP / 32); nb = r % (NP / 32);
                const int n0 = nb * 32; srccol = n0 < 3072 ? n0 : (n0 < 10240 ? n0 + 32 : (n0 == 10240 ? 3072 : -1)); }
            else { r -= IT_WIN;
                if (r < 4 * IT_SQ) { const int w = r / IT_SQ; r %= IT_SQ; const int idx[4] = {I_GWO, I_DWO, I_MWO, I_WOUT};
                    W = p.in[w == 0 ? I_GWO : (w == 1 ? I_DWO : (w == 2 ? I_MWO : I_WOUT))]; (void)idx; N = 1024; WT = (bf16_t*)(ws + WS_WOT) + (size_t)w * D * D; kb = r / 32; nb = r % 32; srccol = nb * 32; }
                else { r -= 4 * IT_SQ; const int w = r / IT_W2; r %= IT_W2; W = p.in[w == 0 ? I_MWKV : I_PWQ]; N = 2048; WT = (bf16_t*)(ws + (w == 0 ? WS_WKVT : WS_WQT)); kb = r / 64; nb = r % 64; srccol = nb * 32; }
            }
            const int k0 = kb * 64;
#pragma unroll 8
            for (int i = 0; i < 32; ++i) { const int kk = 2 * i + (lane >> 5); scr[kk * 33 + (lane & 31)] = srccol >= 0 ? W[(size_t)(k0 + kk) * N + srccol + (lane & 31)] : 0.f; }
        }
        __syncthreads();
        if (it < NIT) {
            const int k0 = kb * 64, c = lane & 7;
#pragma unroll
            for (int j = 0; j < 4; ++j) { const int n = (lane >> 3) + 8 * j; const float* s = scr + (8 * c) * 33 + n;
                u32x4 o; o.x = pk2(s[0], s[33]); o.y = pk2(s[66], s[99]); o.z = pk2(s[132], s[165]); o.w = pk2(s[198], s[231]);
                *(u32x4*)(WT + (size_t)(nb * 32 + n) * D + k0 + 8 * c) = o; }
        }
        __syncthreads();
    }
    const size_t gtid = (size_t)blockIdx.x * NTHR + tid, gsz = (size_t)gridDim.x * NTHR;
    {
        const size_t n8 = (size_t)16384 * D / 8;
        for (size_t i = gtid; i < 2 * n8; i += gsz) {
            const int w = i >= n8; const size_t j = w ? i - n8 : i;
            const float* src = p.in[w ? I_PV : I_PU] + j * 8; bf16_t* dst = (bf16_t*)(ws + (w ? WS_PV : WS_PU)) + j * 8;
            const f32x4 a = *(const f32x4*)src, b = *(const f32x4*)(src + 4);
            u32x4 o; o.x = pk2(a.x, a.y); o.y = pk2(a.z, a.w); o.z = pk2(b.x, b.y); o.w = pk2(b.z, b.w);
            *(u32x4*)dst = o;
        }
        for (size_t i = gtid; i < 2 * 16384; i += gsz) {
            const int w = i >= 16384; const size_t j = w ? i - 16384 : i;
            ((bf16_t*)(ws + WS_K12))[i] = f2bf(p.in[w ? I_PK2 : I_PK1][j]);
        }
    }
    for (size_t i = gtid; i < (size_t)16384 * 32; i += gsz) {
        const int t = (int)(i >> 5), k = (int)(i & 31);
        const float inv = powf(10000.0f, -(float)(2 * k) / 64.0f);
        const float ang = (float)t * inv;
        double sn, cs; sincos((double)ang, &sn, &cs);
        float* R = (float*)(ws + WS_ROPE) + (size_t)t * 64;
        R[k] = (float)cs; R[32 + k] = (float)sn;
    }
    for (int row = blockIdx.x * 8 + wid; row < 2560; row += gridDim.x * 8) {
        const float* src = row < 512 ? p.in[I_MP] + (size_t)row * D : p.in[I_MS] + (size_t)(row - 512) * D;
        const f32x4* xr = (const f32x4*)src + lane; const f32x4* gr = (const f32x4*)p.in[I_MGN] + lane;
        f32x4 v[4]; float s = 0.f;
#pragma unroll
        for (int j = 0; j < 4; ++j) { v[j] = xr[64 * j]; s += v[j].x * v[j].x + v[j].y * v[j].y + v[j].z * v[j].z + v[j].w * v[j].w; }
        const float r = rsqrtf(wave_sum(s) * (1.f / D) + RMS_EPS);
        u32x2* o = (u32x2*)((bf16_t*)(ws + WS_HM) + (size_t)row * D) + lane;
#pragma unroll
        for (int j = 0; j < 4; ++j) { const f32x4 g = gr[64 * j]; u32x2 w; w.x = pk2(v[j].x * r * g.x, v[j].y * r * g.y); w.y = pk2(v[j].z * r * g.z, v[j].w * r * g.w); o[64 * j] = w; }
    }
}

__device__ __forceinline__ void phase_p0b(const Params& p, char* lds) {
    const int tid_ = otid(), lane = tid_ & 63, wid = tid_ >> 6, wm = wid >> 2, wn = wid & 3, fr = lane & 15, fq = lane >> 4;
    const bf16_t* A = (const bf16_t*)(p.ws + WS_HM); const bf16_t* Bt = (const bf16_t*)(p.ws + WS_WKVT);
    float* C = (float*)(p.ws + WS_KVR);
    const int nM = 20, nN = 8;
    for (int t = blockIdx.x; t < nM * nN; t += gridDim.x) {
        const int pm = t % nM, pn = t / nM, m0 = pm * 128, n0 = pn * 256;
        f32x4 acc[4][4];
#pragma unroll
        for (int i = 0; i < 4; ++i)
#pragma unroll
            for (int j = 0; j < 4; ++j) acc[i][j] = (f32x4){0.f, 0.f, 0.f, 0.f};
        gemm_kloop<true>(acc, A + (size_t)m0 * D, D, Bt + (size_t)n0 * D, D, D, lds);
#pragma unroll
        for (int mt = 0; mt < 4; ++mt)
#pragma unroll
            for (int nt = 0; nt < 4; ++nt) {
                const int row = m0 + wm * 64 + mt * 16 + fr, col = n0 + wn * 64 + nt * 16 + fq * 4;
                *(f32x4*)(C + (size_t)row * 2048 + col) = acc[mt][nt];
            }
    }
}

__device__ __forceinline__ void phase_p0c(const Params& p) {
    const int tid_ = otid(), lane = tid_ & 63, wid = tid_ >> 6;
    const float* KV = (const float*)(p.ws + WS_KVR);
    bf16_t* MK = (bf16_t*)(p.ws + WS_MEMK); bf16_t* MV = (bf16_t*)(p.ws + WS_MEMV);
    for (int it = blockIdx.x * 8 + wid; it < 2560 * 4; it += gridDim.x * 8) {
        const int row = it >> 2, h = it & 3, b = row >> 8, m = row & 255;
        const f32x4 kv = *(const f32x4*)(KV + (size_t)row * 2048 + h * 256 + lane * 4);
        const float ss = wave_sum(kv.x * kv.x + kv.y * kv.y + kv.z * kv.z + kv.w * kv.w);
        const float r = rsqrtf(ss * (1.f / 256.f) + RMS_EPS);
        const f32x4 g = *(const f32x4*)(p.in[I_MGK] + lane * 4);
        u32x2 w; w.x = pk2(kv.x * r * g.x, kv.y * r * g.y); w.y = pk2(kv.z * r * g.z, kv.w * r * g.w);
        *(u32x2*)(MK + ((size_t)(b * 4 + h) * 256 + m) * 256 + lane * 4) = w;
        const f32x4 vv = *(const f32x4*)(KV + (size_t)row * 2048 + 1024 + h * 256 + lane * 4);
        const int pos = (m & ~31) + ((m >> 2) & 3) * 8 + ((m >> 4) & 1) * 4 + (m & 3);
        bf16_t* dst = MV + ((size_t)(b * 4 + h) * 256 + lane * 4) * 256 + pos;
        dst[0] = f2bf(vv.x); dst[256] = f2bf(vv.y); dst[512] = f2bf(vv.z); dst[768] = f2bf(vv.w);
    }
}

__device__ __forceinline__ void phase_rmsnorm(const float* X, const float* gain, bf16_t* O, int rows) {
    const int tid_ = otid(), lane = tid_ & 63, wid = tid_ >> 6;
    const f32x4* gr = (const f32x4*)gain + lane;
    f32x4 g[4];
#pragma unroll
    for (int j = 0; j < 4; ++j) g[j] = gr[64 * j];
    for (int row = blockIdx.x * 8 + wid; row < rows; row += gridDim.x * 8) {
        const f32x4* xr = (const f32x4*)(X + (size_t)row * D) + lane;
        f32x4 v[4]; float s = 0.f;
#pragma unroll
        for (int j = 0; j < 4; ++j) { v[j] = xr[64 * j]; s += v[j].x * v[j].x + v[j].y * v[j].y + v[j].z * v[j].z + v[j].w * v[j].w; }
        const float r = rsqrtf(wave_sum(s) * (1.f / D) + RMS_EPS);
        u32x2* o = (u32x2*)(O + (size_t)row * D) + lane;
#pragma unroll
        for (int j = 0; j < 4; ++j) { u32x2 w; w.x = pk2(v[j].x * r * g[j].x, v[j].y * r * g[j].y); w.y = pk2(v[j].z * r * g[j].z, v[j].w * r * g[j].w); o[64 * j] = w; }
    }
}

__device__ __forceinline__ void phase_inproj(const Params& p, int g, char* lds) {
    const Grp G = get_group(p, g);
    const int tid_ = otid(), lane = tid_ & 63, wid = tid_ >> 6, wm = wid >> 2, wn = wid & 3, fr = lane & 15, fq = lane >> 4;
    const bf16_t* A = (const bf16_t*)(p.ws + WS_HB); const bf16_t* Bt = (const bf16_t*)(p.ws + WS_WINT);
    bf16_t* P = (bf16_t*)(p.ws + WS_PROJ); bf16_t* VT = (bf16_t*)(p.ws + WS_VT);
    const int nM = G_TOK / 128, nN = NP / 256;
    for (int t = blockIdx.x; t < nM * nN; t += gridDim.x) {
        int pm, pn; tile_order(t, nM, nN, pm, pn);
        const int m0 = pm * 128, n0 = pn * 256;
        f32x4 acc[4][4];
#pragma unroll
        for (int i = 0; i < 4; ++i)
#pragma unroll
            for (int j = 0; j < 4; ++j) acc[i][j] = (f32x4){0.f, 0.f, 0.f, 0.f};
        if (n0 >= C_DV && n0 < C_DV + 1024) {
            gemm_kloop<false>(acc, A + (size_t)m0 * D, D, Bt + (size_t)n0 * D, D, D, lds);
            const int b = m0 / G.T, t0 = m0 % G.T + wm * 64;
#pragma unroll
            for (int mt = 0; mt < 4; ++mt)
#pragma unroll
                for (int nt = 0; nt < 4; ++nt) {
                    const int n = n0 - C_DV + wn * 64 + nt * 16 + fr, h = n >> 7, dv = n & 127;
                    const int pos = t0 + (mt >> 1) * 32 + fq * 8 + (mt & 1) * 4;
                    u32x2 w; w.x = pk2(acc[mt][nt].x, acc[mt][nt].y); w.y = pk2(acc[mt][nt].z, acc[mt][nt].w);
                    *(u32x2*)(VT + ((size_t)((b * 8 + h) * 128 + dv)) * G.T + pos) = w;
                }
        } else {
            gemm_kloop<true>(acc, A + (size_t)m0 * D, D, Bt + (size_t)n0 * D, D, D, lds);
            const float sc = n0 < 512 ? 0.08838834764831845f : 1.0f;
#pragma unroll
            for (int mt = 0; mt < 4; ++mt)
#pragma unroll
                for (int nt = 0; nt < 4; ++nt) {
                    const int row = m0 + wm * 64 + mt * 16 + fr, col = n0 + wn * 64 + nt * 16 + fq * 4;
                    u32x2 w; w.x = pk2(acc[mt][nt].x * sc, acc[mt][nt].y * sc); w.y = pk2(acc[mt][nt].z * sc, acc[mt][nt].w * sc);
                    *(u32x2*)(P + (size_t)row * NP + col) = w;
                }
        }
    }
}

__device__ __forceinline__ void phase_qkrope(const Params& p, int g) {
    const Grp G = get_group(p, g);
    const int tid_ = otid(), lane = tid_ & 63, wid = tid_ >> 6, grp = lane >> 2, sub = lane & 3;
    bf16_t* P = (bf16_t*)(p.ws + WS_PROJ); const float* ROPE = (const float*)(p.ws + WS_ROPE);
    for (int it = blockIdx.x * 8 + wid; it < G_TOK * 2; it += gridDim.x * 8) {
        const int tok = it >> 1, isk = it & 1, t = tok % G.T;
        bf16_t* base = P + (size_t)tok * NP + (isk ? C_DK : C_DQ) + grp * 64 + sub * 8;
        const u32x4 a = *(const u32x4*)base, b = *(const u32x4*)(base + 32);
        float x1[8], x2[8];
        x1[0] = bflo(a.x); x1[1] = bfhi(a.x); x1[2] = bflo(a.y); x1[3] = bfhi(a.y); x1[4] = bflo(a.z); x1[5] = bfhi(a.z); x1[6] = bflo(a.w); x1[7] = bfhi(a.w);
        x2[0] = bflo(b.x); x2[1] = bfhi(b.x); x2[2] = bflo(b.y); x2[3] = bfhi(b.y); x2[4] = bflo(b.z); x2[5] = bfhi(b.z); x2[6] = bflo(b.w); x2[7] = bfhi(b.w);
        float ss = 0.f;
#pragma unroll
        for (int e = 0; e < 8; ++e) ss += x1[e] * x1[e] + x2[e] * x2[e];
        ss += __shfl_xor(ss, 1); ss += __shfl_xor(ss, 2);
        const float r = rsqrtf(ss * (1.f / 64.f) + RMS_EPS) * (isk ? 1.0f : 0.125f * LOG2E);
        const float* gn = p.in[isk ? I_DGK : I_DGQ] + sub * 8;
        const float* rp = ROPE + (size_t)t * 64 + sub * 8;
        float o1[8], o2[8];
#pragma unroll
        for (int e = 0; e < 8; ++e) {
            const float y1 = x1[e] * r * gn[e], y2 = x2[e] * r * gn[32 + e], c = rp[e], s = rp[32 + e];
            o1[e] = y1 * c - y2 * s; o2[e] = y2 * c + y1 * s;
        }
        u32x4 w1, w2;
        w1.x = pk2(o1[0], o1[1]); w1.y = pk2(o1[2], o1[3]); w1.z = pk2(o1[4], o1[5]); w1.w = pk2(o1[6], o1[7]);
        w2.x = pk2(o2[0], o2[1]); w2.y = pk2(o2[2], o2[3]); w2.z = pk2(o2[4], o2[5]); w2.w = pk2(o2[6], o2[7]);
        *(u32x4*)base = w1; *(u32x4*)(base + 32) = w2;
    }
}

__device__ __forceinline__ void diff_attn_item(const Params& p, const Grp& G, int item, char* lds, float lam, float shift) {
    const int tid = otid(), lane = tid & 63, wid = tid >> 6, fr = lane & 15, fq = lane >> 4;
    const int c = wid & 1, sub = wid >> 1;
    const int T = G.T, nqb = T / 128;
    const int qb = item % nqb, bh = item / nqb, h = bh & 7, b = bh >> 3;
    bf16_t* P = (bf16_t*)(p.ws + WS_PROJ) + (size_t)b * T * NP;
    const bf16_t* Kg = P + C_DK + h * 128;
    const bf16_t* VTg = (const bf16_t*)(p.ws + WS_VT) + (size_t)bh * 128 * T;
    const int q0 = qb * 128 + sub * 32;
    bf16x8 qf[2][2];
#pragma unroll
    for (int nt = 0; nt < 2; ++nt)
#pragma unroll
        for (int ks = 0; ks < 2; ++ks) qf[nt][ks] = *(const bf16x8*)(P + (size_t)(q0 + nt * 16 + fr) * NP + C_DQ + h * 128 + c * 64 + ks * 32 + fq * 8);
    f32x4 o[8][2];
#pragma unroll
    for (int i = 0; i < 8; ++i) { o[i][0] = (f32x4){0.f, 0.f, 0.f, 0.f}; o[i][1] = (f32x4){0.f, 0.f, 0.f, 0.f}; }
    float l[2] = {0.f, 0.f};
    constexpr int STG = 36864, VOFF = 18432;
    u32x4 rk[2], rv[2];
    const int krow = tid >> 4, kch = tid & 15;
    const int vrow = tid >> 3, vch = tid & 7;
#define AGLOAD(kt) do { const int key0_ = (kt) * 64; \
        _Pragma("unroll") for (int i = 0; i < 2; ++i) rk[i] = *(const u32x4*)(Kg + (size_t)(key0_ + krow + i * 32) * NP + kch * 8); \
        _Pragma("unroll") for (int i = 0; i < 2; ++i) rv[i] = *(const u32x4*)(VTg + (size_t)(vrow + i * 64) * T + key0_ + vch * 8); } while (0)
#define ASWRITE(buf) do { char* b_ = lds + (buf) * STG; \
        _Pragma("unroll") for (int i = 0; i < 2; ++i) *(u32x4*)(b_ + ((kch >> 3) * 64 + krow + i * 32) * 144 + (kch & 7) * 16) = rk[i]; \
        _Pragma("unroll") for (int i = 0; i < 2; ++i) *(u32x4*)(b_ + VOFF + (vrow + i * 64) * 144 + vch * 16) = rv[i]; } while (0)
    const int nkt = T / 64;
    AGLOAD(0); ASWRITE(0); __syncthreads();
    for (int kt = 0; kt < nkt; ++kt) {
        if (kt + 1 < nkt) AGLOAD(kt + 1);
        const char* base = lds + (kt & 1) * STG;
        f32x4 s[4][2];
#pragma unroll
        for (int mt = 0; mt < 4; ++mt) { s[mt][0] = (f32x4){-shift, -shift, -shift, -shift}; s[mt][1] = s[mt][0]; }
#pragma unroll
        for (int ks = 0; ks < 2; ++ks)
#pragma unroll
            for (int mt = 0; mt < 4; ++mt) {
                const bf16x8 kf = *(const bf16x8*)(base + (c * 64 + mt * 16 + fr) * 144 + ks * 64 + fq * 16);
                s[mt][0] = mfma16(kf, qf[0][ks], s[mt][0]);
                s[mt][1] = mfma16(kf, qf[1][ks], s[mt][1]);
            }
        bf16x8 pf[2][2];
#pragma unroll
        for (int nt = 0; nt < 2; ++nt)
#pragma unroll
            for (int kk = 0; kk < 2; ++kk) {
                const f32x4 a = s[2 * kk][nt], bb = s[2 * kk + 1][nt];
                const float p0 = fexp2(a.x), p1 = fexp2(a.y), p2 = fexp2(a.z), p3 = fexp2(a.w);
                const float p4 = fexp2(bb.x), p5 = fexp2(bb.y), p6 = fexp2(bb.z), p7 = fexp2(bb.w);
                l[nt] += ((p0 + p1) + (p2 + p3)) + ((p4 + p5) + (p6 + p7));
                u32x4 w; w.x = pk2(p0, p1); w.y = pk2(p2, p3); w.z = pk2(p4, p5); w.w = pk2(p6, p7);
                pf[kk][nt] = __builtin_bit_cast(bf16x8, w);
            }
#pragma unroll
        for (int kk = 0; kk < 2; ++kk)
#pragma unroll
            for (int dvt = 0; dvt < 8; ++dvt) {
                const bf16x8 vf = *(const bf16x8*)(base + VOFF + (dvt * 16 + fr) * 144 + kk * 64 + fq * 16);
                o[dvt][0] = mfma16(vf, pf[kk][0], o[dvt][0]);
                o[dvt][1] = mfma16(vf, pf[kk][1], o[dvt][1]);
            }
        if (kt + 1 < nkt) ASWRITE((kt + 1) & 1);
        __syncthreads();
    }
#undef AGLOAD
#undef ASWRITE
    float inv[2];
#pragma unroll
    for (int nt = 0; nt < 2; ++nt) { float v = l[nt]; v += __shfl_xor(v, 16); v += __shfl_xor(v, 32); inv[nt] = 1.0f / v; }
    float* xch = (float*)lds + sub * 4096;
    if (c == 1) {
#pragma unroll
        for (int dvt = 0; dvt < 8; ++dvt)
#pragma unroll
            for (int nt = 0; nt < 2; ++nt) {
                xch[(dvt * 16 + fq * 4 + 0) * 32 + nt * 16 + fr] = o[dvt][nt].x * inv[nt];
                xch[(dvt * 16 + fq * 4 + 1) * 32 + nt * 16 + fr] = o[dvt][nt].y * inv[nt];
                xch[(dvt * 16 + fq * 4 + 2) * 32 + nt * 16 + fr] = o[dvt][nt].z * inv[nt];
                xch[(dvt * 16 + fq * 4 + 3) * 32 + nt * 16 + fr] = o[dvt][nt].w * inv[nt];
            }
    }
    __syncthreads();
    if (c == 0) {
        float ss[2] = {0.f, 0.f};
#pragma unroll
        for (int dvt = 0; dvt < 8; ++dvt)
#pragma unroll
            for (int nt = 0; nt < 2; ++nt) {
                f32x4 v = o[dvt][nt] * inv[nt];
                v.x -= lam * xch[(dvt * 16 + fq * 4 + 0) * 32 + nt * 16 + fr];
                v.y -= lam * xch[(dvt * 16 + fq * 4 + 1) * 32 + nt * 16 + fr];
                v.z -= lam * xch[(dvt * 16 + fq * 4 + 2) * 32 + nt * 16 + fr];
                v.w -= lam * xch[(dvt * 16 + fq * 4 + 3) * 32 + nt * 16 + fr];
                o[dvt][nt] = v; ss[nt] += v.x * v.x + v.y * v.y + v.z * v.z + v.w * v.w;
            }
#pragma unroll
        for (int nt = 0; nt < 2; ++nt) {
            float v = ss[nt]; v += __shfl_xor(v, 16); v += __shfl_xor(v, 32);
            const float r = rsqrtf(v * (1.f / 128.f) + RMS_EPS) * 0.8f;
#pragma unroll
            for (int dvt = 0; dvt < 8; ++dvt) {
                const f32x4 gs = *(const f32x4*)(p.in[I_DGSUB] + dvt * 16 + fq * 4);
                const f32x4 v4 = o[dvt][nt];
                u32x2 w; w.x = pk2(v4.x * r * gs.x, v4.y * r * gs.y); w.y = pk2(v4.z * r * gs.z, v4.w * r * gs.w);
                *(u32x2*)(P + (size_t)(q0 + nt * 16 + fr) * NP + C_DQ + h * 128 + dvt * 16 + fq * 4) = w;
            }
        }
    }
    __syncthreads();
}

__device__ __forceinline__ void mem_attn_item(const Params& p, const Grp& G, int item, char* lds, float shift) {
    const int tid = otid(), lane = tid & 63, wid = tid >> 6, fr = lane & 15, fq = lane >> 4;
    const int T = G.T, nqb = T / 128;
    const int qb = item % nqb, bh = item / nqb, h = bh & 3, b = bh >> 2;
    bf16_t* P = (bf16_t*)(p.ws + WS_PROJ) + (size_t)b * T * NP;
    const bf16_t* MK = (const bf16_t*)(p.ws + WS_MEMK) + (size_t)((G.mb0 + b) * 4 + h) * 256 * 256;
    const bf16_t* MV = (const bf16_t*)(p.ws + WS_MEMV) + (size_t)((G.mb0 + b) * 4 + h) * 256 * 256;
    const int row = qb * 128 + wid * 16 + fr;
    bf16_t* qp = P + (size_t)row * NP + C_MQ + h * 256;
    bf16x8 qf[8];
    {
        float ss = 0.f; u32x4 raw[8];
#pragma unroll
        for (int ks = 0; ks < 8; ++ks) { raw[ks] = *(const u32x4*)(qp + ks * 32 + fq * 8);
            const float a0 = bflo(raw[ks].x), a1 = bfhi(raw[ks].x), a2 = bflo(raw[ks].y), a3 = bfhi(raw[ks].y), a4 = bflo(raw[ks].z), a5 = bfhi(raw[ks].z), a6 = bflo(raw[ks].w), a7 = bfhi(raw[ks].w);
            ss += a0 * a0 + a1 * a1 + a2 * a2 + a3 * a3 + a4 * a4 + a5 * a5 + a6 * a6 + a7 * a7; }
        ss += __shfl_xor(ss, 16); ss += __shfl_xor(ss, 32);
        const float r = rsqrtf(ss * (1.f / 256.f) + RMS_EPS) * (0.0625f * LOG2E);
#pragma unroll
        for (int ks = 0; ks < 8; ++ks) {
            const f32x4 g0 = *(const f32x4*)(p.in[I_MGQ] + ks * 32 + fq * 8), g1 = *(const f32x4*)(p.in[I_MGQ] + ks * 32 + fq * 8 + 4);
            u32x4 w;
            w.x = pk2(bflo(raw[ks].x) * r * g0.x, bfhi(raw[ks].x) * r * g0.y); w.y = pk2(bflo(raw[ks].y) * r * g0.z, bfhi(raw[ks].y) * r * g0.w);
            w.z = pk2(bflo(raw[ks].z) * r * g1.x, bfhi(raw[ks].z) * r * g1.y); w.w = pk2(bflo(raw[ks].w) * r * g1.z, bfhi(raw[ks].w) * r * g1.w);
            qf[ks] = __builtin_bit_cast(bf16x8, w);
        }
    }
    f32x4 o[16];
#pragma unroll
    for (int i = 0; i < 16; ++i) o[i] = (f32x4){0.f, 0.f, 0.f, 0.f};
    float l = 0.f;
    constexpr int KROW = 528, VOFF = 64 * 528;
    for (int kt = 0; kt < 4; ++kt) {
#pragma unroll
        for (int i = 0; i < 4; ++i) {
            const int idx = tid + i * 512, r = idx >> 5, ch = idx & 31;
            *(u32x4*)(lds + r * KROW + ch * 16) = *(const u32x4*)(MK + (size_t)(kt * 64 + r) * 256 + ch * 8);
            const int vr = idx >> 3, vc = idx & 7;
            *(u32x4*)(lds + VOFF + vr * 144 + vc * 16) = *(const u32x4*)(MV + (size_t)vr * 256 + kt * 64 + vc * 8);
        }
        __syncthreads();
        f32x4 s[4];
#pragma unroll
        for (int mt = 0; mt < 4; ++mt) s[mt] = (f32x4){-shift, -shift, -shift, -shift};
#pragma unroll
        for (int ks = 0; ks < 8; ++ks)
#pragma unroll
            for (int mt = 0; mt < 4; ++mt) {
                const bf16x8 kf = *(const bf16x8*)(lds + (mt * 16 + fr) * KROW + ks * 64 + fq * 16);
                s[mt] = mfma16(kf, qf[ks], s[mt]);
            }
        bf16x8 pf[2];
#pragma unroll
        for (int kk = 0; kk < 2; ++kk) {
            const f32x4 a = s[2 * kk], bb = s[2 * kk + 1];
            const float p0 = fexp2(a.x), p1 = fexp2(a.y), p2 = fexp2(a.z), p3 = fexp2(a.w);
            const float p4 = fexp2(bb.x), p5 = fexp2(bb.y), p6 = fexp2(bb.z), p7 = fexp2(bb.w);
            l += ((p0 + p1) + (p2 + p3)) + ((p4 + p5) + (p6 + p7));
            u32x4 w; w.x = pk2(p0, p1); w.y = pk2(p2, p3); w.z = pk2(p4, p5); w.w = pk2(p6, p7);
            pf[kk] = __builtin_bit_cast(bf16x8, w);
        }
#pragma unroll
        for (int kk = 0; kk < 2; ++kk)
#pragma unroll
            for (int dvt = 0; dvt < 16; ++dvt) {
                const bf16x8 vf = *(const bf16x8*)(lds + VOFF + (dvt * 16 + fr) * 144 + kk * 64 + fq * 16);
                o[dvt] = mfma16(vf, pf[kk], o[dvt]);
            }
        __syncthreads();
    }
    l += __shfl_xor(l, 16); l += __shfl_xor(l, 32);
    const float inv = 1.0f / l;
#pragma unroll
    for (int dvt = 0; dvt < 16; ++dvt) {
        u32x2 w; w.x = pk2(o[dvt].x * inv, o[dvt].y * inv); w.y = pk2(o[dvt].z * inv, o[dvt].w * inv);
        *(u32x2*)(qp + dvt * 16 + fq * 4) = w;
    }
}

constexpr int L_QE = 0, L_KE = 17408, L_KST = 34816, L_VTL = 53248, L_ATT = 71680, L_SB = 80896, L_LRF = 115712, L_TOT = 119808, L_GDEC = 121856;
__device__ __forceinline__ void gla_item(const Params& p, const Grp& G, int item, char* lds) {
    const int tid = otid(), lane = tid & 63, wid = tid >> 6, fr = lane & 15, fq = lane >> 4;
    const int slice = item & 1, dir = (item >> 1) & 1, h = (item >> 2) & 3, b = item >> 4;
    const int T = G.T, N = T / 64;
    const bf16_t* P = (const bf16_t*)(p.ws + WS_PROJ) + (size_t)b * T * NP;
    bf16_t* OUT = dir ? (bf16_t*)(p.ws + WS_PROJ) + (size_t)b * T * NP + C_DV + h * 256 + slice * 128
                      : (bf16_t*)(p.ws + WS_HB) + (size_t)b * T * D + h * 256 + slice * 128;
    const int ldo = dir ? NP : D;
    const int d = tid & 127, rg = tid >> 7;
    float wdec[16];
    {
        const float* wd = p.in[dir ? I_WDB : I_WDF];
#pragma unroll
        for (int r = 0; r < 16; ++r) wdec[r] = wd[r * 512 + h * 128 + d];
    }
    const float bdec = p.in[dir ? I_BDB : I_BDF][h * 128 + d];
    for (int i = tid; i < 34816 / 16; i += NTHR) *(u32x4*)(lds + L_SB + i * 16) = (u32x4){0u, 0u, 0u, 0u};
    f32x4 S[8];
#pragma unroll
    for (int i = 0; i < 8; ++i) S[i] = (f32x4){0.f, 0.f, 0.f, 0.f};
    u32x4 rq[2], rk[2], rv[2], rl;
    const int lrow = tid >> 4, lch = tid & 15;
#define GGLOAD(n) do { const int cb_ = (dir ? (N - 1 - (n)) : (n)) * 64; \
        _Pragma("unroll") for (int i = 0; i < 2; ++i) { const int li_ = lrow + i * 32, tk_ = cb_ + (dir ? 63 - li_ : li_); const bf16_t* rp_ = P + (size_t)tk_ * NP; \
            rq[i] = *(const u32x4*)(rp_ + C_GQ + h * 128 + lch * 8); rk[i] = *(const u32x4*)(rp_ + C_GK + h * 128 + lch * 8); rv[i] = *(const u32x4*)(rp_ + C_GV + h * 256 + slice * 128 + lch * 8); } \
        if (tid < 128) { const int li_ = tid >> 1, tk_ = cb_ + (dir ? 63 - li_ : li_); rl = *(const u32x4*)(P + (size_t)tk_ * NP + C_LR + dir * 16 + (tid & 1) * 8); } } while (0)
    GGLOAD(0);
    for (int n = 0; n < N; ++n) {
#pragma unroll
        for (int i = 0; i < 2; ++i) {
            const int li = lrow + i * 32;
            *(u32x4*)(lds + L_QE + li * 272 + lch * 16) = rq[i];
            *(u32x4*)(lds + L_KE + li * 272 + lch * 16) = rk[i];
            bf16_t* vt = (bf16_t*)(lds + L_VTL) + (lch * 8) * 72 + li;
            vt[0 * 72] = (bf16_t)(rv[i].x & 0xffff); vt[1 * 72] = (bf16_t)(rv[i].x >> 16); vt[2 * 72] = (bf16_t)(rv[i].y & 0xffff); vt[3 * 72] = (bf16_t)(rv[i].y >> 16);
            vt[4 * 72] = (bf16_t)(rv[i].z & 0xffff); vt[5 * 72] = (bf16_t)(rv[i].z >> 16); vt[6 * 72] = (bf16_t)(rv[i].w & 0xffff); vt[7 * 72] = (bf16_t)(rv[i].w >> 16);
        }
        if (tid < 128) {
            float* lf = (float*)(lds + L_LRF) + (tid >> 1) * 16 + (tid & 1) * 8;
            *(f32x4*)lf = (f32x4){bflo(rl.x), bfhi(rl.x), bflo(rl.y), bfhi(rl.y)};
            *(f32x4*)(lf + 4) = (f32x4){bflo(rl.z), bfhi(rl.z), bflo(rl.w), bfhi(rl.w)};
        }
        if (n + 1 < N) GGLOAD(n + 1);
        __syncthreads();
        float cs[16]; float run = 0.f;
#pragma unroll
        for (int ii = 0; ii < 16; ++ii) {
            const float* lf = (const float*)(lds + L_LRF) + (rg * 16 + ii) * 16;
            const f32x4 a0 = *(const f32x4*)lf, a1 = *(const f32x4*)(lf + 4), a2 = *(const f32x4*)(lf + 8), a3 = *(const f32x4*)(lf + 12);
            float x = bdec;
            x += a0.x * wdec[0] + a0.y * wdec[1] + a0.z * wdec[2] + a0.w * wdec[3];
            x += a1.x * wdec[4] + a1.y * wdec[5] + a1.z * wdec[6] + a1.w * wdec[7];
            x += a2.x * wdec[8] + a2.y * wdec[9] + a2.z * wdec[10] + a2.w * wdec[11];
            x += a3.x * wdec[12] + a3.y * wdec[13] + a3.z * wdec[14] + a3.w * wdec[15];
            const float ls = fminf(x, 0.f) - __logf(1.0f + __expf(-fabsf(x)));
            run += ls * 0.0625f; cs[ii] = run;
        }
        ((float*)(lds + L_TOT))[rg * 128 + d] = run;
        __syncthreads();
        float off = 0.f, blast = 0.f;
#pragma unroll
        for (int r = 0; r < 4; ++r) { const float tv = ((const float*)(lds + L_TOT))[r * 128 + d]; blast += tv; if (r < rg) off += tv; }
        {
            bf16_t* qe = (bf16_t*)(lds + L_QE) + d; bf16_t* ke = (bf16_t*)(lds + L_KE) + d;
            unsigned ksp[8];
#pragma unroll
            for (int ii = 0; ii < 16; ii += 2) {
                const int i0 = rg * 16 + ii;
                const float b0 = off + cs[ii], b1 = off + cs[ii + 1];
                const float q0v = bf2f(qe[i0 * 136]), q1v = bf2f(qe[(i0 + 1) * 136]), k0v = bf2f(ke[i0 * 136]), k1v = bf2f(ke[(i0 + 1) * 136]);
                qe[i0 * 136] = f2bf(q0v * __expf(b0)); qe[(i0 + 1) * 136] = f2bf(q1v * __expf(b1));
                ke[i0 * 136] = f2bf(k0v * __expf(-b0)); ke[(i0 + 1) * 136] = f2bf(k1v * __expf(-b1));
                ksp[ii >> 1] = pk2(k0v * __expf(blast - b0), k1v * __expf(blast - b1));
            }
            char* kst = lds + L_KST + d * 144 + rg * 32;
            *(u32x4*)kst = (u32x4){ksp[0], ksp[1], ksp[2], ksp[3]};
            *(u32x4*)(kst + 16) = (u32x4){ksp[4], ksp[5], ksp[6], ksp[7]};
            if (rg == 0) ((float*)(lds + L_GDEC))[d] = __expf(blast);
        }
        __syncthreads();
        {
            const int ct = wid & 3;
            f32x4 a[2] = {(f32x4){0.f, 0.f, 0.f, 0.f}, (f32x4){0.f, 0.f, 0.f, 0.f}};
#pragma unroll
            for (int ks = 0; ks < 4; ++ks) {
                const bf16x8 qv = *(const bf16x8*)(lds + L_QE + (ct * 16 + fr) * 272 + ks * 64 + fq * 16);
#pragma unroll
                for (int j = 0; j < 2; ++j) {
                    const int st = (wid >> 2) * 2 + j;
                    const bf16x8 kv = *(const bf16x8*)(lds + L_KE + (st * 16 + fr) * 272 + ks * 64 + fq * 16);
                    a[j] = mfma16(kv, qv, a[j]);
                }
            }
#pragma unroll
            for (int j = 0; j < 2; ++j) {
                const int st = (wid >> 2) * 2 + j, cc = ct * 16 + fr, s0 = st * 16 + fq * 4;
                const float v0 = (s0 + 0 <= cc) ? a[j].x : 0.f, v1 = (s0 + 1 <= cc) ? a[j].y : 0.f, v2 = (s0 + 2 <= cc) ? a[j].z : 0.f, v3 = (s0 + 3 <= cc) ? a[j].w : 0.f;
                *(u32x2*)(lds + L_ATT + cc * 144 + s0 * 2) = (u32x2){pk2(v0, v1), pk2(v2, v3)};
            }
        }
        __syncthreads();
        {
            f32x4 oc[4] = {(f32x4){0.f, 0.f, 0.f, 0.f}, (f32x4){0.f, 0.f, 0.f, 0.f}, (f32x4){0.f, 0.f, 0.f, 0.f}, (f32x4){0.f, 0.f, 0.f, 0.f}};
#pragma unroll
            for (int ks = 0; ks < 2; ++ks) {
                const bf16x8 af = *(const bf16x8*)(lds + L_VTL + (wid * 16 + fr) * 144 + ks * 64 + fq * 16);
#pragma unroll
                for (int ct = 0; ct < 4; ++ct) { const bf16x8 bfv = *(const bf16x8*)(lds + L_ATT + (ct * 16 + fr) * 144 + ks * 64 + fq * 16); oc[ct] = mfma16(af, bfv, oc[ct]); }
            }
#pragma unroll
            for (int ks = 0; ks < 4; ++ks) {
                const bf16x8 af = *(const bf16x8*)(lds + L_SB + (wid * 16 + fr) * 272 + ks * 64 + fq * 16);
#pragma unroll
                for (int ct = 0; ct < 4; ++ct) { const bf16x8 bfv = *(const bf16x8*)(lds + L_QE + (ct * 16 + fr) * 272 + ks * 64 + fq * 16); oc[ct] = mfma16(af, bfv, oc[ct]); }
            }
            const int cb = (dir ? (N - 1 - n) : n) * 64;
#pragma unroll
            for (int ct = 0; ct < 4; ++ct) {
                const int cl = ct * 16 + fr, tk = cb + (dir ? 63 - cl : cl);
                *(u32x2*)(OUT + (size_t)tk * ldo + wid * 16 + fq * 4) = (u32x2){pk2(oc[ct].x, oc[ct].y), pk2(oc[ct].z, oc[ct].w)};
            }
        }
        __syncthreads();
        {
            const f32x4 gd = *(const f32x4*)((const float*)(lds + L_GDEC) + wid * 16 + fq * 4);
#pragma unroll
            for (int et = 0; et < 8; ++et) S[et] = S[et] * gd;
#pragma unroll
            for (int ks = 0; ks < 2; ++ks) {
                const bf16x8 af = *(const bf16x8*)(lds + L_KST + (wid * 16 + fr) * 144 + ks * 64 + fq * 16);
#pragma unroll
                for (int et = 0; et < 8; ++et) { const bf16x8 bfv = *(const bf16x8*)(lds + L_VTL + (et * 16 + fr) * 144 + ks * 64 + fq * 16); S[et] = mfma16(af, bfv, S[et]); }
            }
#pragma unroll
            for (int et = 0; et < 8; ++et)
                *(u32x2*)(lds + L_SB + (et * 16 + fr) * 272 + (wid * 16 + fq * 4) * 2) = (u32x2){pk2(S[et].x, S[et].y), pk2(S[et].z, S[et].w)};
        }
        __syncthreads();
    }
#undef GGLOAD
}

__device__ __forceinline__ void phase_mixer(const Params& p, int g, char* lds, int* s_item) {
    const Grp G = get_group(p, g);
    const int nGLA = G.B * 16, nATT = G.B * 8 * (G.T / 128), nMEM = G.B * 4 * (G.T / 128), nTot = nGLA + nATT + nMEM;
    unsigned* ctr = (unsigned*)(p.ws + WS_CTRL) + g;
    float d1 = 0.f, d2 = 0.f, mq = 0.f, mk = 0.f, mmq = 0.f, mmk = 0.f;
    for (int i = 0; i < 64; ++i) { d1 += p.in[I_LQ1][i] * p.in[I_LK1][i]; d2 += p.in[I_LQ2][i] * p.in[I_LK2][i]; mq = fmaxf(mq, fabsf(p.in[I_DGQ][i])); mk = fmaxf(mk, fabsf(p.in[I_DGK][i])); }
    for (int i = 0; i < 256; ++i) { mmq = fmaxf(mmq, fabsf(p.in[I_MGQ][i])); mmk = fmaxf(mmk, fabsf(p.in[I_MGK][i])); }
    const float lam = expf(d1) - expf(d2) + 0.2f;
    const float shiftD = fmaxf(0.f, 8.f * mq * mk * LOG2E - 64.f), shiftM = fmaxf(0.f, 16.f * mmq * mmk * LOG2E - 64.f);
#ifndef STATIC_SCHED
#define STATIC_SCHED 1
#endif
    for (int sit = blockIdx.x;; sit += gridDim.x) {
#if STATIC_SCHED
        (void)ctr; (void)s_item;
        const int it = sit;
#else
        if (threadIdx.x == 0) *s_item = (int)atomicAdd(ctr, 1u);
        __syncthreads();
        const int it = *s_item;
        __syncthreads();
#endif
        if (it >= nTot) break;
        if (it < nGLA) gla_item(p, G, it, lds);
        else if (it < nGLA + nATT) diff_attn_item(p, G, it - nGLA, lds, lam, shiftD);
        else mem_attn_item(p, G, it - nGLA - nATT, lds, shiftM);
    }
}

__device__ __forceinline__ void phase_glafin(const Params& p, int g) {
    const int tid_ = otid(), lane = tid_ & 63, wid = tid_ >> 6;
    bf16_t* P = (bf16_t*)(p.ws + WS_PROJ); const bf16_t* F = (const bf16_t*)(p.ws + WS_HB);
    for (int it = blockIdx.x * 8 + wid; it < G_TOK * 4; it += gridDim.x * 8) {
        const int tok = it >> 2, h = it & 3;
        bf16_t* row = P + (size_t)tok * NP;
        const unsigned qq = *(const unsigned*)(row + C_GQ + h * 128 + lane * 2), kk = *(const unsigned*)(row + C_GK + h * 128 + lane * 2);
        const float qk = wave_sum(bflo(qq) * bflo(kk) + bfhi(qq) * bfhi(kk));
        const u32x2 f = *(const u32x2*)(F + (size_t)tok * D + h * 256 + lane * 4), bk = *(const u32x2*)(row + C_DV + h * 256 + lane * 4);
        const u32x2 v = *(const u32x2*)(row + C_GV + h * 256 + lane * 4), gt = *(const u32x2*)(row + C_GG + h * 256 + lane * 4);
        float o0 = bflo(f.x) + bflo(bk.x) - qk * bflo(v.x), o1 = bfhi(f.x) + bfhi(bk.x) - qk * bfhi(v.x);
        float o2 = bflo(f.y) + bflo(bk.y) - qk * bflo(v.y), o3 = bfhi(f.y) + bfhi(bk.y) - qk * bfhi(v.y);
        const float r = rsqrtf(wave_sum(o0 * o0 + o1 * o1 + o2 * o2 + o3 * o3) * (1.f / 256.f) + RMS_EPS);
        const f32x4 go = *(const f32x4*)(p.in[I_GOUT] + lane * 4);
        const float g0 = bflo(gt.x), g1 = bfhi(gt.x), g2 = bflo(gt.y), g3 = bfhi(gt.y);
        o0 *= r * go.x * g0 / (1.f + __expf(-g0)); o1 *= r * go.y * g1 / (1.f + __expf(-g1));
        o2 *= r * go.z * g2 / (1.f + __expf(-g2)); o3 *= r * go.w * g3 / (1.f + __expf(-g3));
        *(u32x2*)(row + C_GG + h * 256 + lane * 4) = (u32x2){pk2(o0, o1), pk2(o2, o3)};
    }
}

__device__ __forceinline__ void phase_merge(const Params& p, int g, char* lds) {
    const int tid_ = otid(), lane = tid_ & 63, wid = tid_ >> 6, wm = wid >> 2, wn = wid & 3, fr = lane & 15, fq = lane >> 4;
    const bf16_t* P = (const bf16_t*)(p.ws + WS_PROJ); bf16_t* M = (bf16_t*)(p.ws + WS_VT);
    const int nM = G_TOK / 128, nN = 4;
    for (int t = blockIdx.x; t < nM * nN; t += gridDim.x) {
        int pm, pn; tile_order(t, nM, nN, pm, pn);
        const int m0 = pm * 128, n0 = pn * 256;
        f32x4 macc[4][4];
#pragma unroll
        for (int i = 0; i < 4; ++i)
#pragma unroll
            for (int j = 0; j < 4; ++j) macc[i][j] = (f32x4){0.f, 0.f, 0.f, 0.f};
        for (int br = 0; br < 3; ++br) {
            f32x4 acc[4][4];
#pragma unroll
            for (int i = 0; i < 4; ++i)
#pragma unroll
                for (int j = 0; j < 4; ++j) acc[i][j] = (f32x4){0.f, 0.f, 0.f, 0.f};
            const int acol = br == 0 ? C_GG : (br == 1 ? C_DQ : C_MQ);
            gemm_kloop<true>(acc, P + (size_t)m0 * NP + acol, NP, (const bf16_t*)(p.ws + WS_WOT) + (size_t)br * D * D + (size_t)n0 * D, D, D, lds);
#pragma unroll
            for (int mt = 0; mt < 4; ++mt)
#pragma unroll
                for (int nt = 0; nt < 4; ++nt) {
                    const int row = m0 + wm * 64 + mt * 16 + fr, col = n0 + wn * 64 + nt * 16 + fq * 4;
                    const u32x2 gt = *(const u32x2*)(P + (size_t)row * NP + C_BG + br * 1024 + col);
                    f32x4 sg; sg.x = 1.f / (1.f + __expf(-bflo(gt.x))); sg.y = 1.f / (1.f + __expf(-bfhi(gt.x))); sg.z = 1.f / (1.f + __expf(-bflo(gt.y))); sg.w = 1.f / (1.f + __expf(-bfhi(gt.y)));
                    macc[mt][nt] += sg * acc[mt][nt];
                }
        }
#pragma unroll
        for (int mt = 0; mt < 4; ++mt)
#pragma unroll
            for (int nt = 0; nt < 4; ++nt) {
                const int row = m0 + wm * 64 + mt * 16 + fr, col = n0 + wn * 64 + nt * 16 + fq * 4;
                *(u32x2*)(M + (size_t)row * D + col) = (u32x2){pk2(macc[mt][nt].x, macc[mt][nt].y), pk2(macc[mt][nt].z, macc[mt][nt].w)};
            }
    }
}

__device__ __forceinline__ void phase_outproj(const Params& p, int g, char* lds) {
    const Grp G = get_group(p, g);
    const int tid_ = otid(), lane = tid_ & 63, wid = tid_ >> 6, wm = wid >> 2, wn = wid & 3, fr = lane & 15, fq = lane >> 4;
    const bf16_t* M = (const bf16_t*)(p.ws + WS_VT); const bf16_t* W = (const bf16_t*)(p.ws + WS_WOT) + (size_t)3 * D * D;
    const int nM = G_TOK / 128, nN = 4;
    for (int t = blockIdx.x; t < nM * nN; t += gridDim.x) {
        int pm, pn; tile_order(t, nM, nN, pm, pn);
        const int m0 = pm * 128, n0 = pn * 256;
        f32x4 acc[4][4];
#pragma unroll
        for (int i = 0; i < 4; ++i)
#pragma unroll
            for (int j = 0; j < 4; ++j) acc[i][j] = (f32x4){0.f, 0.f, 0.f, 0.f};
        gemm_kloop<true>(acc, M + (size_t)m0 * D, D, W + (size_t)n0 * D, D, D, lds);
#pragma unroll
        for (int mt = 0; mt < 4; ++mt)
#pragma unroll
            for (int nt = 0; nt < 4; ++nt) {
                const int row = m0 + wm * 64 + mt * 16 + fr, col = n0 + wn * 64 + nt * 16 + fq * 4;
                const f32x4 xv = *(const f32x4*)(G.x + (size_t)row * D + col);
                *(f32x4*)(G.out + (size_t)row * D + col) = xv + acc[mt][nt];
            }
    }
}

__device__ __forceinline__ void phase_peerq(const Params& p, int g, char* lds) {
    const int tid_ = otid(), lane = tid_ & 63, wid = tid_ >> 6, wm = wid >> 2, wn = wid & 3, fr = lane & 15, fq = lane >> 4;
    const bf16_t* A = (const bf16_t*)(p.ws + WS_HB); const bf16_t* W = (const bf16_t*)(p.ws + WS_WQT); bf16_t* P = (bf16_t*)(p.ws + WS_PROJ);
    const int nM = G_TOK / 128, nN = 8;
    for (int t = blockIdx.x; t < nM * nN; t += gridDim.x) {
        int pm, pn; tile_order(t, nM, nN, pm, pn);
        const int m0 = pm * 128, n0 = pn * 256;
        f32x4 acc[4][4];
#pragma unroll
        for (int i = 0; i < 4; ++i)
#pragma unroll
            for (int j = 0; j < 4; ++j) acc[i][j] = (f32x4){0.f, 0.f, 0.f, 0.f};
        gemm_kloop<true>(acc, A + (size_t)m0 * D, D, W + (size_t)n0 * D, D, D, lds);
#pragma unroll
        for (int mt = 0; mt < 4; ++mt)
#pragma unroll
            for (int nt = 0; nt < 4; ++nt) {
                const int row = m0 + wm * 64 + mt * 16 + fr, col = n0 + wn * 64 + nt * 16 + fq * 4;
                *(u32x2*)(P + (size_t)row * NP + col) = (u32x2){pk2(acc[mt][nt].x, acc[mt][nt].y), pk2(acc[mt][nt].z, acc[mt][nt].w)};
            }
    }
}

__device__ __forceinline__ unsigned f2ord(float f) { const unsigned u = __float_as_uint(f); return (u & 0x80000000u) ? ~u : (u | 0x80000000u); }
__device__ __forceinline__ float ord2f(unsigned k) { const unsigned u = (k & 0x80000000u) ? (k & 0x7fffffffu) : ~k; return __uint_as_float(u); }
__device__ __forceinline__ unsigned gmax16(unsigned v) {
#pragma unroll
    for (int o = 1; o < 16; o <<= 1) { const unsigned t = (unsigned)__shfl_xor((int)v, o); v = v > t ? v : t; }
    return v;
}
__device__ __forceinline__ float gsum16(float v) {
#pragma unroll
    for (int o = 1; o < 16; o <<= 1) v += __shfl_xor(v, o);
    return v;
}
__device__ __forceinline__ float gelu_exact(float a) { return 0.5f * a * (1.0f + erff(a * 0.70710678118654752f)); }

__device__ __forceinline__ void phase_peer(const Params& p, int g, char* lds) {
    const Grp G = get_group(p, g);
    const int tid = otid(), lane = tid & 63, wid = tid >> 6, fr = lane & 15, fq = lane >> 4;
    const bf16_t* P = (const bf16_t*)(p.ws + WS_PROJ); const bf16_t* HB = (const bf16_t*)(p.ws + WS_HB);
    const bf16_t* K12 = (const bf16_t*)(p.ws + WS_K12);
    const bf16_t* PU = (const bf16_t*)(p.ws + WS_PU); const bf16_t* PV = (const bf16_t*)(p.ws + WS_PV);
    float* SC = (float*)lds;
    int* EIDX = (int*)(lds + 65536);
    float* GATE = (float*)(lds + 65536 + 4096);
    for (int tile = blockIdx.x; tile < G_TOK / 8; tile += gridDim.x) {
        const int tok0 = tile * 8;
        {
            const int mt = wid >> 1, half = wid & 1;
            const int r = mt * 16 + fr, tl = r >> 3, hh = r & 7;
            const bf16_t* qrow = P + (size_t)(tok0 + tl) * NP + hh * 256 + half * 128;
            const bf16_t* kb = K12 + half * 16384;
            f32x4 acc[8];
#pragma unroll
            for (int i = 0; i < 8; ++i) acc[i] = (f32x4){0.f, 0.f, 0.f, 0.f};
#pragma unroll
            for (int ks = 0; ks < 4; ++ks) {
                const bf16x8 af = *(const bf16x8*)(qrow + ks * 32 + fq * 8);
#pragma unroll
                for (int nt = 0; nt < 8; ++nt) { const bf16x8 bfv = *(const bf16x8*)(kb + (nt * 16 + fr) * 128 + ks * 32 + fq * 8); acc[nt] = mfma16(af, bfv, acc[nt]); }
            }
#pragma unroll
            for (int nt = 0; nt < 8; ++nt) {
                float* dst = SC + (mt * 16 + fq * 4) * 256 + half * 128 + nt * 16 + fr;
                dst[0] = acc[nt].x; dst[256] = acc[nt].y; dst[512] = acc[nt].z; dst[768] = acc[nt].w;
            }
        }
        __syncthreads();
        for (int pass = 0; pass < 2; ++pass) {
            const int row = wid * 8 + pass * 4 + fq, sl = fr, gb = fq * 16;
            float v1 = 0.f, v2 = 0.f; int i1 = 0, i2 = 0;
#pragma unroll
            for (int hf = 0; hf < 2; ++hf) {
                unsigned key[8];
#pragma unroll
                for (int i = 0; i < 8; ++i) { const int idx = sl + 16 * i; key[i] = (f2ord(SC[row * 256 + hf * 128 + idx]) & ~127u) | (unsigned)(127 - idx); }
                float sv = 0.f; int si = 0;
                for (int r = 0; r < 16; ++r) {
                    unsigned m = key[0];
#pragma unroll
                    for (int i = 1; i < 8; ++i) m = m > key[i] ? m : key[i];
                    m = gmax16(m);
                    if (sl == r) { sv = ord2f(m & ~127u); si = 127 - (int)(m & 127u); }
#pragma unroll
                    for (int i = 0; i < 8; ++i) key[i] = key[i] == m ? 0u : key[i];
                }
                if (hf == 0) { v1 = sv; i1 = si; } else { v2 = sv; i2 = si; }
            }
            int ptr = 0; float ts = 0.f; int pid = 0;
            for (int r = 0; r < 16; ++r) {
                const float v2p = __shfl(v2, gb + (ptr & 15));
                const unsigned key = ptr < 16 ? ((f2ord(v1 + v2p) & ~255u) | (unsigned)(255 - (sl * 16 + ptr))) : 0u;
                const unsigned m = gmax16(key);
                if (sl == r) { ts = ord2f(m & ~255u); pid = 255 - (int)(m & 255u); }
                if (key == m) ptr++;
            }
            const int e1 = __shfl(i1, gb + (pid >> 4)), e2 = __shfl(i2, gb + (pid & 15));
            float mx = ts;
#pragma unroll
            for (int o = 1; o < 16; o <<= 1) mx = fmaxf(mx, __shfl_xor(mx, o));
            const float ex = __expf(ts - mx), sm = gsum16(ex);
            EIDX[row * 16 + sl] = e1 * 128 + e2; GATE[row * 16 + sl] = ex / sm;
        }
        __syncthreads();
        {
            const int tok = tok0 + wid;
            const bf16_t* hrow = HB + (size_t)tok * D;
            const u32x4 h0 = *(const u32x4*)(hrow + lane * 8), h1 = *(const u32x4*)(hrow + 512 + lane * 8);
            float hv[16];
            hv[0] = bflo(h0.x); hv[1] = bfhi(h0.x); hv[2] = bflo(h0.y); hv[3] = bfhi(h0.y); hv[4] = bflo(h0.z); hv[5] = bfhi(h0.z); hv[6] = bflo(h0.w); hv[7] = bfhi(h0.w);
            hv[8] = bflo(h1.x); hv[9] = bfhi(h1.x); hv[10] = bflo(h1.y); hv[11] = bfhi(h1.y); hv[12] = bflo(h1.z); hv[13] = bfhi(h1.z); hv[14] = bflo(h1.w); hv[15] = bfhi(h1.w);
            float acc[16];
#pragma unroll
            for (int i = 0; i < 16; ++i) acc[i] = 0.f;
#pragma unroll 4
            for (int k = 0; k < 128; ++k) {
                const int e = EIDX[wid * 128 + k]; const float gt = GATE[wid * 128 + k];
                const bf16_t* ur = PU + (size_t)e * D; const bf16_t* vr = PV + (size_t)e * D;
                const u32x4 u0 = *(const u32x4*)(ur + lane * 8), u1 = *(const u32x4*)(ur + 512 + lane * 8);
                const u32x4 w0 = *(const u32x4*)(vr + lane * 8), w1 = *(const u32x4*)(vr + 512 + lane * 8);
                float a = bflo(u0.x) * hv[0] + bfhi(u0.x) * hv[1] + bflo(u0.y) * hv[2] + bfhi(u0.y) * hv[3] + bflo(u0.z) * hv[4] + bfhi(u0.z) * hv[5] + bflo(u0.w) * hv[6] + bfhi(u0.w) * hv[7]
                        + bflo(u1.x) * hv[8] + bfhi(u1.x) * hv[9] + bflo(u1.y) * hv[10] + bfhi(u1.y) * hv[11] + bflo(u1.z) * hv[12] + bfhi(u1.z) * hv[13] + bflo(u1.w) * hv[14] + bfhi(u1.w) * hv[15];
                a = wave_sum(a);
                const float w = gt * gelu_exact(a);
                acc[0] += w * bflo(w0.x); acc[1] += w * bfhi(w0.x); acc[2] += w * bflo(w0.y); acc[3] += w * bfhi(w0.y);
                acc[4] += w * bflo(w0.z); acc[5] += w * bfhi(w0.z); acc[6] += w * bflo(w0.w); acc[7] += w * bfhi(w0.w);
                acc[8] += w * bflo(w1.x); acc[9] += w * bfhi(w1.x); acc[10] += w * bflo(w1.y); acc[11] += w * bfhi(w1.y);
                acc[12] += w * bflo(w1.z); acc[13] += w * bfhi(w1.z); acc[14] += w * bflo(w1.w); acc[15] += w * bfhi(w1.w);
            }
            float* orow = G.out + (size_t)tok * D;
            f32x4* o0 = (f32x4*)(orow + lane * 8); f32x4* o1 = (f32x4*)(orow + 512 + lane * 8);
            f32x4 t;
#define SAN(v) (v)
            t = o0[0]; t.x += acc[0]; t.y += acc[1]; t.z += acc[2]; t.w += acc[3]; t.x = SAN(t.x); t.y = SAN(t.y); t.z = SAN(t.z); t.w = SAN(t.w); o0[0] = t;
            t = o0[1]; t.x += acc[4]; t.y += acc[5]; t.z += acc[6]; t.w += acc[7]; t.x = SAN(t.x); t.y = SAN(t.y); t.z = SAN(t.z); t.w = SAN(t.w); o0[1] = t;
            t = o1[0]; t.x += acc[8]; t.y += acc[9]; t.z += acc[10]; t.w += acc[11]; t.x = SAN(t.x); t.y = SAN(t.y); t.z = SAN(t.z); t.w = SAN(t.w); o1[0] = t;
            t = o1[1]; t.x += acc[12]; t.y += acc[13]; t.z += acc[14]; t.w += acc[15]; t.x = SAN(t.x); t.y = SAN(t.y); t.z = SAN(t.z); t.w = SAN(t.w); o1[1] = t;
        }
        __syncthreads();
    }
}


#ifndef DEBUG_NAN
#define DEBUG_NAN 0
#endif
#if DEBUG_NAN
__device__ __noinline__ void scan_bf16(const bf16_t* base, size_t rows, size_t pitch, int col0, int ncols, unsigned* flag) {
    const size_t gtid = (size_t)blockIdx.x * NTHR + threadIdx.x, gsz = (size_t)gridDim.x * NTHR, cpr = ncols / 8, total = rows * cpr;
    bool bad = false;
    for (size_t i = gtid; i < total; i += gsz) {
        const size_t r = i / cpr, c = i % cpr;
        const u32x4 v = *(const u32x4*)(base + r * pitch + col0 + c * 8);
        bad = bad || ((v.x & 0x7F80u) == 0x7F80u) || ((v.x & 0x7F800000u) == 0x7F800000u) || ((v.y & 0x7F80u) == 0x7F80u) || ((v.y & 0x7F800000u) == 0x7F800000u)
                  || ((v.z & 0x7F80u) == 0x7F80u) || ((v.z & 0x7F800000u) == 0x7F800000u) || ((v.w & 0x7F80u) == 0x7F80u) || ((v.w & 0x7F800000u) == 0x7F800000u);
    }
    if (bad) atomicOr(flag, 1u);
}
__device__ __noinline__ void scan_f32(const float* base, size_t n, unsigned* flag) {
    const size_t gtid = (size_t)blockIdx.x * NTHR + threadIdx.x, gsz = (size_t)gridDim.x * NTHR;
    bool bad = false;
    for (size_t i = gtid; i < n; i += gsz) { if ((__float_as_uint(base[i]) & 0x7F800000u) == 0x7F800000u) bad = true; }
    if (bad) atomicOr(flag, 1u);
}
__device__ __forceinline__ void debug_scan(const Params& p, int ph) {
    unsigned* F = (unsigned*)(p.ws + WS_CTRL) + 128;
    const bf16_t* P = (const bf16_t*)(p.ws + WS_PROJ); const bf16_t* HB = (const bf16_t*)(p.ws + WS_HB); const bf16_t* VT = (const bf16_t*)(p.ws + WS_VT);
    if (ph == 0) {
        scan_bf16((const bf16_t*)(p.ws + WS_WINT), NP, D, 0, D, F + 0);
        scan_bf16((const bf16_t*)(p.ws + WS_WOT), 4 * D + 4096, D, 0, D, F + 1);
        scan_bf16((const bf16_t*)(p.ws + WS_PU), 32768, D, 0, D, F + 2);
        scan_f32((const float*)(p.ws + WS_ROPE), 16384 * 64, F + 3);
        scan_bf16((const bf16_t*)(p.ws + WS_HM), 2560, D, 0, D, F + 3);
    } else if (ph == 2) {
        scan_bf16((const bf16_t*)(p.ws + WS_MEMK), 2 * 10 * 4 * 256, 256, 0, 256, F + 4);
    } else if (ph == 3) scan_bf16(HB, G_TOK, D, 0, D, F + 5);
    else if (ph == 4) { scan_bf16(P, G_TOK, NP, 0, 3072, F + 6); scan_bf16(P, G_TOK, NP, 3072, 2048, F + 7); scan_bf16(VT, G_TOK, D, 0, D, F + 8); scan_bf16(P, G_TOK, NP, 6144, NP - 6144, F + 9); }
    else if (ph == 5) scan_bf16(P, G_TOK, NP, 3072, 2048, F + 10);
    else if (ph == 6) { scan_bf16(HB, G_TOK, D, 0, D, F + 11); scan_bf16(P, G_TOK, NP, C_DV, 1024, F + 12); scan_bf16(P, G_TOK, NP, C_DQ, 1024, F + 13); scan_bf16(P, G_TOK, NP, C_MQ, 1024, F + 14); }
    else if (ph == 7) scan_bf16(P, G_TOK, NP, C_GG, 1024, F + 15);
    else if (ph == 8) scan_bf16(VT, G_TOK, D, 0, D, F + 16);
    else if (ph == 9) scan_f32(p.out, (size_t)G_TOK * D, F + 17);
    else if (ph == 10) scan_bf16(HB, G_TOK, D, 0, D, F + 18);
    else if (ph == 11) scan_bf16(P, G_TOK, NP, 0, 2048, F + 19);
    else if (ph == 12) scan_f32(p.out, (size_t)G_TOK * D, F + 20);
}
#endif

constexpr int NPH = 3 + NGROUP * 10;
__device__ __forceinline__ void run_phase(const Params& p, int ph, char* lds, int* s_item) {
    if (ph == 0) { phase_p0a(p, lds); return; }
    if (ph == 1) { phase_p0b(p, lds); return; }
    if (ph == 2) { phase_p0c(p); return; }
    const int g = (ph - 3) / 10, s = (ph - 3) % 10;
    const Grp G = get_group(p, g);
    switch (s) {
        case 0: phase_rmsnorm(G.x, p.in[I_GMIX], (bf16_t*)(p.ws + WS_HB), G_TOK); break;
        case 1: phase_inproj(p, g, lds); break;
        case 2: phase_qkrope(p, g); break;
        case 3: phase_mixer(p, g, lds, s_item); break;
        case 4: phase_glafin(p, g); break;
        case 5: phase_merge(p, g, lds); break;
        case 6: phase_outproj(p, g, lds); break;
        case 7: phase_rmsnorm(G.out, p.in[I_GFFN], (bf16_t*)(p.ws + WS_HB), G_TOK); break;
        case 8: phase_peerq(p, g, lds); break;
        case 9: phase_peer(p, g, lds); break;
    }
}

__global__ void __launch_bounds__(NTHR) mega_kernel(Params p) {
    extern __shared__ __attribute__((aligned(16))) char lds[];
    __shared__ int s_item;
    cg::grid_group grid = cg::this_grid();
    for (int ph = p.ph_lo; ph < p.ph_hi; ++ph) {
        run_phase(p, ph, lds, &s_item);
#if DEBUG_NAN
        __threadfence(); grid.sync(); __threadfence();
        debug_scan(p, ph);
        __threadfence(); grid.sync(); __threadfence();
#else
        if (ph + 1 < p.ph_hi) { __threadfence(); grid.sync(); __threadfence(); }
#endif
    }
#if DEBUG_NAN
    if (blockIdx.x == 0 && threadIdx.x == 0) {
        const unsigned* F = (const unsigned*)(p.ws + WS_CTRL) + 128; int first = -1;
        for (int k = 0; k <= 20; ++k) if (first < 0 && atomicOr((unsigned*)F + k, 0u)) first = k;
        float mark = 1000.f; for (int k = 0; k < first; ++k) mark *= 10.f;
        p.out[0] = first < 0 ? 777.f : mark;
    }
#endif
}

extern "C" void kernel_launch(void* const* d_in, const int* in_sizes, int n_in, void* d_out, int out_size, void* d_ws, size_t ws_size, hipStream_t stream) {
    static int grid_blocks = 0;
    if (grid_blocks == 0) {
        if (n_in != 32 || ws_size < WS_END) { fprintf(stderr, "kernel_launch: unexpected n_in %d or ws_size %zu (< %zu)\n", n_in, ws_size, (size_t)WS_END); grid_blocks = -1; return; }
        int dev = 0, cus = 0, per_cu = 0;
        hipGetDevice(&dev);
        hipDeviceGetAttribute(&cus, hipDeviceAttributeMultiprocessorCount, dev);
        hipFuncSetAttribute((const void*)mega_kernel, hipFuncAttributeMaxDynamicSharedMemorySize, LDS_BYTES);
        hipOccupancyMaxActiveBlocksPerMultiprocessor(&per_cu, (const void*)mega_kernel, NTHR, LDS_BYTES);
        if (per_cu < 1) per_cu = 1;
        grid_blocks = cus * per_cu;
        (void)hipGetLastError();
    }
    if (grid_blocks < 0) return;
    Params p{};
    for (int i = 0; i < 32; ++i) p.in[i] = (const float*)d_in[i];
    p.out = (float*)d_out; p.ws = (unsigned char*)d_ws; p.ph_lo = 0; p.ph_hi = NPH;
    void* args[] = {&p};
    hipError_t e = hipLaunchCooperativeKernel((const void*)mega_kernel, dim3(grid_blocks), dim3(NTHR), args, LDS_BYTES, stream);
    if (e != hipSuccess) fprintf(stderr, "cooperative launch failed: %s (grid %d)\n", hipGetErrorString(e), grid_blocks);
}
```

```cpp
#include <hip/hip_runtime.h>
#include <hip/hip_cooperative_groups.h>
#include <cstdio>
#include <cstdint>
namespace cg = cooperative_groups;

typedef unsigned short bf16_t;
typedef short bf16x8 __attribute__((ext_vector_type(8)));
typedef float f32x4 __attribute__((ext_vector_type(4)));
typedef unsigned u32x4 __attribute__((ext_vector_type(4)));
typedef unsigned u32x2 __attribute__((ext_vector_type(2)));

constexpr int D = 1024;
constexpr int NP = 10496;
constexpr int IN_COLS = 10272;
constexpr int C_GQ = 0, C_GK = 512, C_GV = 1024, C_GG = 2048, C_DQ = 3072, C_DK = 4096, C_DV = 5120, C_MQ = 6144, C_BG = 7168, C_LR = 10240;
constexpr int G_TOK = 32768;
constexpr int NGROUP = 3;
constexpr int NTHR = 512;
constexpr float RMS_EPS = 1e-6f;
constexpr float LOG2E = 1.4426950408889634f;
constexpr int LDS_BYTES = 126976;

enum { I_XP = 0, I_XS, I_MP, I_MS, I_GMIX, I_WIN, I_WDF, I_BDF, I_WDB, I_BDB, I_GOUT, I_GWO, I_DGQ, I_DGK, I_LQ1, I_LK1, I_LQ2, I_LK2,
       I_DGSUB, I_DWO, I_MGN, I_MWKV, I_MGQ, I_MGK, I_MWO, I_WOUT, I_GFFN, I_PWQ, I_PK1, I_PK2, I_PU, I_PV };

constexpr size_t al256(size_t x) { return (x + 255) & ~(size_t)255; }
constexpr size_t WS_CTRL = 0;
constexpr size_t WS_PROJ = 4096;
constexpr size_t WS_HB   = WS_PROJ + (size_t)G_TOK * NP * 2;
constexpr size_t WS_VT   = WS_HB + (size_t)G_TOK * D * 2;
constexpr size_t WS_WINT = WS_VT + (size_t)G_TOK * D * 2;
constexpr size_t WS_WOT  = WS_WINT + (size_t)NP * D * 2;
constexpr size_t WS_WKVT = WS_WOT + (size_t)4 * D * D * 2;
constexpr size_t WS_WQT  = WS_WKVT + (size_t)2048 * D * 2;
constexpr size_t WS_PU   = WS_WQT + (size_t)2048 * D * 2;
constexpr size_t WS_PV   = WS_PU + (size_t)16384 * D * 2;
constexpr size_t WS_K12  = WS_PV + (size_t)16384 * D * 2;
constexpr size_t WS_ROPE = WS_K12 + (size_t)2 * 128 * 128 * 2;
constexpr size_t WS_HM   = WS_ROPE + (size_t)16384 * 64 * 4;
constexpr size_t WS_KVR  = WS_HM + (size_t)2560 * D * 2;
constexpr size_t WS_MEMK = WS_KVR + (size_t)2560 * 2048 * 4;
constexpr size_t WS_MEMV = WS_MEMK + (size_t)10 * 4 * 256 * 256 * 2;
constexpr size_t WS_END  = WS_MEMV + (size_t)10 * 4 * 256 * 256 * 2;

struct Params {
    const float* in[32];
    float* out;
    unsigned char* ws;
    int ph_lo, ph_hi;
};

typedef float f32x2 __attribute__((ext_vector_type(2)));
typedef __bf16 bf16x2v __attribute__((ext_vector_type(2)));
__device__ __forceinline__ unsigned pk2(float lo, float hi) { const f32x2 v = {lo, hi}; const bf16x2v b = __builtin_convertvector(v, bf16x2v); return __builtin_bit_cast(unsigned, b); }
__device__ __forceinline__ float bflo(unsigned u) { return __uint_as_float(u << 16); }
__device__ __forceinline__ float bfhi(unsigned u) { return __uint_as_float(u & 0xffff0000u); }
__device__ __forceinline__ float bf2f(bf16_t b) { return __uint_as_float(((unsigned)b) << 16); }
__device__ __forceinline__ bf16_t f2bf(float f) { return (bf16_t)(pk2(f, 0.f) & 0xffffu); }
__device__ __forceinline__ f32x4 mfma16(bf16x8 a, bf16x8 b, f32x4 c) { return __builtin_amdgcn_mfma_f32_16x16x32_bf16(a, b, c, 0, 0, 0); }
__device__ __forceinline__ float fexp2(float x) { return __builtin_amdgcn_exp2f(x); }
__device__ __forceinline__ int otid() { int t = threadIdx.x; asm volatile("" : "+v"(t)); return t; }
template <int M> __device__ __forceinline__ float sxor(float v) {
    if (M < 32) return __int_as_float(__builtin_amdgcn_ds_swizzle(__float_as_int(v), (M << 10) | 0x1F));
    const int l = otid() & 63; return __int_as_float(__builtin_amdgcn_ds_bpermute((l ^ 32) << 2, __float_as_int(v)));
}
template <int M> __device__ __forceinline__ unsigned sxoru(unsigned v) { return (unsigned)__builtin_amdgcn_ds_swizzle((int)v, (M << 10) | 0x1F); }
__device__ __forceinline__ float wave_sum(float v) {
    v += sxor<1>(v); v += sxor<2>(v); v += sxor<4>(v); v += sxor<8>(v); v += sxor<16>(v); v += sxor<32>(v);
    return v;
}

struct Grp { const float* x; const float* mem; float* out; int B, T, mb0; };
__device__ __forceinline__ Grp get_group(const Params& p, int g) {
    Grp r;
    if (g == 0) { r.x = p.in[I_XP]; r.out = p.out; r.B = 2; r.T = 16384; r.mb0 = 0; }
    else { r.x = p.in[I_XS] + (size_t)(g - 1) * G_TOK * D; r.out = p.out + (size_t)g * G_TOK * D; r.B = 4; r.T = 8192; r.mb0 = 2 + (g - 1) * 4; }
    r.mem = nullptr;
    return r;
}

constexpr int G_ROW = 144;
constexpr int G_A_BYTES = 128 * G_ROW;
constexpr int G_B_BYTES = 256 * G_ROW;
constexpr int G_STAGE = G_A_BYTES + G_B_BYTES;

template <bool SWAP>
__device__ __forceinline__ void gemm_kloop(f32x4 (&acc)[4][4], const bf16_t* __restrict__ A, int lda, const bf16_t* __restrict__ Bt, int ldb, int K, char* lds) {
    const int tid = otid(), lane = tid & 63, wid = tid >> 6, wm = wid >> 2, wn = wid & 3, fr = lane & 15, fq = lane >> 4;
    const int lr = tid >> 3, lc = tid & 7;
    u32x4 ra[2], rb[4];
    const bf16_t* Ap = A + (size_t)lr * lda + lc * 8;
    const bf16_t* Bp = Bt + (size_t)lr * ldb + lc * 8;
#define GLOAD(k0) do { _Pragma("unroll") for (int i = 0; i < 2; ++i) ra[i] = *(const u32x4*)(Ap + (size_t)(i * 64) * lda + (k0)); \
                       _Pragma("unroll") for (int i = 0; i < 4; ++i) rb[i] = *(const u32x4*)(Bp + (size_t)(i * 64) * ldb + (k0)); } while (0)
#define SWRITE(buf) do { char* b_ = lds + (buf) * G_STAGE + lr * G_ROW + lc * 16; \
                       _Pragma("unroll") for (int i = 0; i < 2; ++i) *(u32x4*)(b_ + i * 64 * G_ROW) = ra[i]; \
                       _Pragma("unroll") for (int i = 0; i < 4; ++i) *(u32x4*)(b_ + G_A_BYTES + i * 64 * G_ROW) = rb[i]; } while (0)
    const int nk = K / 64;
    GLOAD(0); SWRITE(0); __syncthreads();
    for (int kt = 0; kt < nk; ++kt) {
        if (kt + 1 < nk) GLOAD((kt + 1) * 64);
        const char* base = lds + (kt & 1) * G_STAGE;
#pragma unroll
        for (int ks = 0; ks < 2; ++ks) {
            bf16x8 af[4], bfr[4];
#pragma unroll
            for (int mt = 0; mt < 4; ++mt) af[mt] = *(const bf16x8*)(base + (wm * 64 + mt * 16 + fr) * G_ROW + ks * 64 + fq * 16);
#pragma unroll
            for (int nt = 0; nt < 4; ++nt) bfr[nt] = *(const bf16x8*)(base + G_A_BYTES + (wn * 64 + nt * 16 + fr) * G_ROW + ks * 64 + fq * 16);
#pragma unroll
            for (int mt = 0; mt < 4; ++mt)
#pragma unroll
                for (int nt = 0; nt < 4; ++nt)
                    acc[mt][nt] = SWAP ? mfma16(bfr[nt], af[mt], acc[mt][nt]) : mfma16(af[mt], bfr[nt], acc[mt][nt]);
        }
        if (kt + 1 < nk) SWRITE((kt + 1) & 1);
        __syncthreads();
    }
#undef GLOAD
#undef SWRITE
}

__device__ __forceinline__ void tile_order(int t, int nM, int nN, int& pm, int& pn) {
    const int per = 8 * nN, grp = t / per, r = t % per;
    pm = grp * 8 + (r & 7); pn = r >> 3;
}

__device__ __forceinline__ void phase_p0a(const Params& p, char* lds) {
    const int tid = otid(), lane = tid & 63, wid = tid >> 6;
    unsigned char* ws = p.ws;
    if (blockIdx.x == 0 && tid < 256) atomicExch((unsigned*)(ws + WS_CTRL) + tid, 0u);
    float* scr = (float*)(lds + wid * 8448);
    constexpr int IT_WIN = 16 * (NP / 32), IT_SQ = 16 * 32, IT_W2 = 16 * 64;
    constexpr int NIT = IT_WIN + 4 * IT_SQ + 2 * IT_W2;
    for (int it0 = blockIdx.x * 8; it0 < NIT; it0 += gridDim.x * 8) {
        int it = it0 + wid;
        const float* W = nullptr; bf16_t* WT = nullptr; int N = 0, nb = 0, kb = 0, srccol = -1;
        if (it < NIT) {
            int r = it;
            if (r < IT_WIN) { W = p.in[I_WIN]; N = IN_COLS; WT = (bf16_t*)(ws + WS_WINT); kb = r / (NP / 32); nb = r % (NP / 32);
                const int n0 = nb * 32; srccol = n0 < 3072 ? n0 : (n0 < 10240 ? n0 + 32 : (n0 == 10240 ? 3072 : -1)); }
            else { r -= IT_WIN;
                if (r < 4 * IT_SQ) { const int w = r / IT_SQ; r %= IT_SQ; const int idx[4] = {I_GWO, I_DWO, I_MWO, I_WOUT};
                    W = p.in[w == 0 ? I_GWO : (w == 1 ? I_DWO : (w == 2 ? I_MWO : I_WOUT))]; (void)idx; N = 1024; WT = (bf16_t*)(ws + WS_WOT) + (size_t)w * D * D; kb = r / 32; nb = r % 32; srccol = nb * 32; }
                else { r -= 4 * IT_SQ; const int w = r / IT_W2; r %= IT_W2; W = p.in[w == 0 ? I_MWKV : I_PWQ]; N = 2048; WT = (bf16_t*)(ws + (w == 0 ? WS_WKVT : WS_WQT)); kb = r / 64; nb = r % 64; srccol = nb * 32; }
            }
            const int k0 = kb * 64;
#pragma unroll 8
            for (int i = 0; i < 32; ++i) { const int kk = 2 * i + (lane >> 5); scr[kk * 33 + (lane & 31)] = srccol >= 0 ? W[(size_t)(k0 + kk) * N + srccol + (lane & 31)] : 0.f; }
        }
        __syncthreads();
        if (it < NIT) {
            const int k0 = kb * 64, c = lane & 7;
#pragma unroll
            for (int j = 0; j < 4; ++j) { const int n = (lane >> 3) + 8 * j; const float* s = scr + (8 * c) * 33 + n;
                u32x4 o; o.x = pk2(s[0], s[33]); o.y = pk2(s[66], s[99]); o.z = pk2(s[132], s[165]); o.w = pk2(s[198], s[231]);
                *(u32x4*)(WT + (size_t)(nb * 32 + n) * D + k0 + 8 * c) = o; }
        }
        __syncthreads();
    }
    const size_t gtid = (size_t)blockIdx.x * NTHR + tid, gsz = (size_t)gridDim.x * NTHR;
    {
        const size_t n8 = (size_t)16384 * D / 8;
        for (size_t i = gtid; i < 2 * n8; i += gsz) {
            const int w = i >= n8; const size_t j = w ? i - n8 : i;
            const float* src = p.in[w ? I_PV : I_PU] + j * 8; bf16_t* dst = (bf16_t*)(ws + (w ? WS_PV : WS_PU)) + j * 8;
            const f32x4 a = *(const f32x4*)src, b = *(const f32x4*)(src + 4);
            u32x4 o; o.x = pk2(a.x, a.y); o.y = pk2(a.z, a.w); o.z = pk2(b.x, b.y); o.w = pk2(b.z, b.w);
            *(u32x4*)dst = o;
        }
        for (size_t i = gtid; i < 2 * 16384; i += gsz) {
            const int w = i >= 16384; const size_t j = w ? i - 16384 : i;
            ((bf16_t*)(ws + WS_K12))[i] = f2bf(p.in[w ? I_PK2 : I_PK1][j]);
        }
    }
    for (size_t i = gtid; i < (size_t)16384 * 32; i += gsz) {
        const int t = (int)(i >> 5), k = (int)(i & 31);
        const float inv = powf(10000.0f, -(float)(2 * k) / 64.0f);
        const float ang = (float)t * inv;
        double sn, cs; sincos((double)ang, &sn, &cs);
        float* R = (float*)(ws + WS_ROPE) + (size_t)t * 64;
        R[k] = (float)cs; R[32 + k] = (float)sn;
    }
    for (int row = blockIdx.x * 8 + wid; row < 2560; row += gridDim.x * 8) {
        const float* src = row < 512 ? p.in[I_MP] + (size_t)row * D : p.in[I_MS] + (size_t)(row - 512) * D;
        const f32x4* xr = (const f32x4*)src + lane; const f32x4* gr = (const f32x4*)p.in[I_MGN] + lane;
        f32x4 v[4]; float s = 0.f;
#pragma unroll
        for (int j = 0; j < 4; ++j) { v[j] = xr[64 * j]; s += v[j].x * v[j].x + v[j].y * v[j].y + v[j].z * v[j].z + v[j].w * v[j].w; }
        const float r = rsqrtf(wave_sum(s) * (1.f / D) + RMS_EPS);
        u32x2* o = (u32x2*)((bf16_t*)(ws + WS_HM) + (size_t)row * D) + lane;
#pragma unroll
        for (int j = 0; j < 4; ++j) { const f32x4 g = gr[64 * j]; u32x2 w; w.x = pk2(v[j].x * r * g.x, v[j].y * r * g.y); w.y = pk2(v[j].z * r * g.z, v[j].w * r * g.w); o[64 * j] = w; }
    }
}

__device__ __forceinline__ void phase_p0b(const Params& p, char* lds) {
    const int tid_ = otid(), lane = tid_ & 63, wid = tid_ >> 6, wm = wid >> 2, wn = wid & 3, fr = lane & 15, fq = lane >> 4;
    const bf16_t* A = (const bf16_t*)(p.ws + WS_HM); const bf16_t* Bt = (const bf16_t*)(p.ws + WS_WKVT);
    float* C = (float*)(p.ws + WS_KVR);
    const int nM = 20, nN = 8;
    for (int t = blockIdx.x; t < nM * nN; t += gridDim.x) {
        const int pm = t % nM, pn = t / nM, m0 = pm * 128, n0 = pn * 256;
        f32x4 acc[4][4];
#pragma unroll
        for (int i = 0; i < 4; ++i)
#pragma unroll
            for (int j = 0; j < 4; ++j) acc[i][j] = (f32x4){0.f, 0.f, 0.f, 0.f};
        gemm_kloop<true>(acc, A + (size_t)m0 * D, D, Bt + (size_t)n0 * D, D, D, lds);
#pragma unroll
        for (int mt = 0; mt < 4; ++mt)
#pragma unroll
            for (int nt = 0; nt < 4; ++nt) {
                const int row = m0 + wm * 64 + mt * 16 + fr, col = n0 + wn * 64 + nt * 16 + fq * 4;
                *(f32x4*)(C + (size_t)row * 2048 + col) = acc[mt][nt];
            }
    }
}

__device__ __forceinline__ void phase_p0c(const Params& p) {
    const int tid_ = otid(), lane = tid_ & 63, wid = tid_ >> 6;
    const float* KV = (const float*)(p.ws + WS_KVR);
    bf16_t* MK = (bf16_t*)(p.ws + WS_MEMK); bf16_t* MV = (bf16_t*)(p.ws + WS_MEMV);
    for (int it = blockIdx.x * 8 + wid; it < 2560 * 4; it += gridDim.x * 8) {
        const int row = it >> 2, h = it & 3, b = row >> 8, m = row & 255;
        const f32x4 kv = *(const f32x4*)(KV + (size_t)row * 2048 + h * 256 + lane * 4);
        const float ss = wave_sum(kv.x * kv.x + kv.y * kv.y + kv.z * kv.z + kv.w * kv.w);
        const float r = rsqrtf(ss * (1.f / 256.f) + RMS_EPS);
        const f32x4 g = *(const f32x4*)(p.in[I_MGK] + lane * 4);
        u32x2 w; w.x = pk2(kv.x * r * g.x, kv.y * r * g.y); w.y = pk2(kv.z * r * g.z, kv.w * r * g.w);
        *(u32x2*)(MK + ((size_t)(b * 4 + h) * 256 + m) * 256 + lane * 4) = w;
        const f32x4 vv = *(const f32x4*)(KV + (size_t)row * 2048 + 1024 + h * 256 + lane * 4);
        const int pos = (m & ~31) + ((m >> 2) & 3) * 8 + ((m >> 4) & 1) * 4 + (m & 3);
        bf16_t* dst = MV + ((size_t)(b * 4 + h) * 256 + lane * 4) * 256 + pos;
        dst[0] = f2bf(vv.x); dst[256] = f2bf(vv.y); dst[512] = f2bf(vv.z); dst[768] = f2bf(vv.w);
    }
}

__device__ __forceinline__ void phase_rmsnorm(const float* X, const float* gain, bf16_t* O, int rows) {
    const int tid_ = otid(), lane = tid_ & 63, wid = tid_ >> 6;
    const f32x4* gr = (const f32x4*)gain + lane;
    f32x4 g[4];
#pragma unroll
    for (int j = 0; j < 4; ++j) g[j] = gr[64 * j];
    for (int row = blockIdx.x * 8 + wid; row < rows; row += gridDim.x * 8) {
        const f32x4* xr = (const f32x4*)(X + (size_t)row * D) + lane;
        f32x4 v[4]; float s = 0.f;
#pragma unroll
        for (int j = 0; j < 4; ++j) { v[j] = xr[64 * j]; s += v[j].x * v[j].x + v[j].y * v[j].y + v[j].z * v[j].z + v[j].w * v[j].w; }
        const float r = rsqrtf(wave_sum(s) * (1.f / D) + RMS_EPS);
        u32x2* o = (u32x2*)(O + (size_t)row * D) + lane;
#pragma unroll
        for (int j = 0; j < 4; ++j) { u32x2 w; w.x = pk2(v[j].x * r * g[j].x, v[j].y * r * g[j].y); w.y = pk2(v[j].z * r * g[j].z, v[j].w * r * g[j].w); o[64 * j] = w; }
    }
}

__device__ __forceinline__ void phase_inproj(const Params& p, int g, char* lds) {
    const Grp G = get_group(p, g);
    const int tid_ = otid(), lane = tid_ & 63, wid = tid_ >> 6, wm = wid >> 2, wn = wid & 3, fr = lane & 15, fq = lane >> 4;
    const bf16_t* A = (const bf16_t*)(p.ws + WS_HB); const bf16_t* Bt = (const bf16_t*)(p.ws + WS_WINT);
    bf16_t* P = (bf16_t*)(p.ws + WS_PROJ); bf16_t* VT = (bf16_t*)(p.ws + WS_VT);
    const int nM = G_TOK / 128, nN = NP / 256;
    for (int t = blockIdx.x; t < nM * nN; t += gridDim.x) {
        int pm, pn; tile_order(t, nM, nN, pm, pn);
        const int m0 = pm * 128, n0 = pn * 256;
        f32x4 acc[4][4];
#pragma unroll
        for (int i = 0; i < 4; ++i)
#pragma unroll
            for (int j = 0; j < 4; ++j) acc[i][j] = (f32x4){0.f, 0.f, 0.f, 0.f};
        if (n0 >= C_DV && n0 < C_DV + 1024) {
            gemm_kloop<false>(acc, A + (size_t)m0 * D, D, Bt + (size_t)n0 * D, D, D, lds);
            const int b = m0 / G.T, t0 = m0 % G.T + wm * 64;
#pragma unroll
            for (int mt = 0; mt < 4; ++mt)
#pragma unroll
                for (int nt = 0; nt < 4; ++nt) {
                    const int n = n0 - C_DV + wn * 64 + nt * 16 + fr, h = n >> 7, dv = n & 127;
                    const int pos = t0 + (mt >> 1) * 32 + fq * 8 + (mt & 1) * 4;
                    u32x2 w; w.x = pk2(acc[mt][nt].x, acc[mt][nt].y); w.y = pk2(acc[mt][nt].z, acc[mt][nt].w);
                    *(u32x2*)(VT + ((size_t)((b * 8 + h) * 128 + dv)) * G.T + pos) = w;
                }
        } else {
            gemm_kloop<true>(acc, A + (size_t)m0 * D, D, Bt + (size_t)n0 * D, D, D, lds);
            const float sc = n0 < 512 ? 0.08838834764831845f : 1.0f;
#pragma unroll
            for (int mt = 0; mt < 4; ++mt)
#pragma unroll
                for (int nt = 0; nt < 4; ++nt) {
                    const int row = m0 + wm * 64 + mt * 16 + fr, col = n0 + wn * 64 + nt * 16 + fq * 4;
                    u32x2 w; w.x = pk2(acc[mt][nt].x * sc, acc[mt][nt].y * sc); w.y = pk2(acc[mt][nt].z * sc, acc[mt][nt].w * sc);
                    *(u32x2*)(P + (size_t)row * NP + col) = w;
                }
        }
    }
}

__device__ __forceinline__ void phase_qkrope(const Params& p, int g) {
    const Grp G = get_group(p, g);
    const int tid_ = otid(), lane = tid_ & 63, wid = tid_ >> 6, grp = lane >> 2, sub = lane & 3;
    bf16_t* P = (bf16_t*)(p.ws + WS_PROJ); const float* ROPE = (const float*)(p.ws + WS_ROPE);
    for (int it = blockIdx.x * 8 + wid; it < G_TOK * 2; it += gridDim.x * 8) {
        const int tok = it >> 1, isk = it & 1, t = tok % G.T;
        bf16_t* base = P + (size_t)tok * NP + (isk ? C_DK : C_DQ) + grp * 64 + sub * 8;
        const u32x4 a = *(const u32x4*)base, b = *(const u32x4*)(base + 32);
        float x1[8], x2[8];
        x1[0] = bflo(a.x); x1[1] = bfhi(a.x); x1[2] = bflo(a.y); x1[3] = bfhi(a.y); x1[4] = bflo(a.z); x1[5] = bfhi(a.z); x1[6] = bflo(a.w); x1[7] = bfhi(a.w);
        x2[0] = bflo(b.x); x2[1] = bfhi(b.x); x2[2] = bflo(b.y); x2[3] = bfhi(b.y); x2[4] = bflo(b.z); x2[5] = bfhi(b.z); x2[6] = bflo(b.w); x2[7] = bfhi(b.w);
        float ss = 0.f;
#pragma unroll
        for (int e = 0; e < 8; ++e) ss += x1[e] * x1[e] + x2[e] * x2[e];
        ss += sxor<1>(ss); ss += sxor<2>(ss);
        const float r = rsqrtf(ss * (1.f / 64.f) + RMS_EPS) * (isk ? 1.0f : 0.125f * LOG2E);
        const float* gn = p.in[isk ? I_DGK : I_DGQ] + sub * 8;
        const float* rp = ROPE + (size_t)t * 64 + sub * 8;
        float o1[8], o2[8];
#pragma unroll
        for (int e = 0; e < 8; ++e) {
            const float y1 = x1[e] * r * gn[e], y2 = x2[e] * r * gn[32 + e], c = rp[e], s = rp[32 + e];
            o1[e] = y1 * c - y2 * s; o2[e] = y2 * c + y1 * s;
        }
        u32x4 w1, w2;
        w1.x = pk2(o1[0], o1[1]); w1.y = pk2(o1[2], o1[3]); w1.z = pk2(o1[4], o1[5]); w1.w = pk2(o1[6], o1[7]);
        w2.x = pk2(o2[0], o2[1]); w2.y = pk2(o2[2], o2[3]); w2.z = pk2(o2[4], o2[5]); w2.w = pk2(o2[6], o2[7]);
        *(u32x4*)base = w1; *(u32x4*)(base + 32) = w2;
    }
}

__device__ __forceinline__ void diff_attn_item(const Params& p, const Grp& G, int item, char* lds, float lam, float shift) {
    const int tid = otid(), lane = tid & 63, wid = tid >> 6, fr = lane & 15, fq = lane >> 4;
    const int c = wid & 1, sub = wid >> 1;
    const int T = G.T, nqb = T / 128;
    const int qb = item % nqb, bh = item / nqb, h = bh & 7, b = bh >> 3;
    bf16_t* P = (bf16_t*)(p.ws + WS_PROJ) + (size_t)b * T * NP;
    const bf16_t* Kg = P + C_DK + h * 128;
    const bf16_t* VTg = (const bf16_t*)(p.ws + WS_VT) + (size_t)bh * 128 * T;
    const int q0 = qb * 128 + sub * 32;
    bf16x8 qf[2][2];
#pragma unroll
    for (int nt = 0; nt < 2; ++nt)
#pragma unroll
        for (int ks = 0; ks < 2; ++ks) qf[nt][ks] = *(const bf16x8*)(P + (size_t)(q0 + nt * 16 + fr) * NP + C_DQ + h * 128 + c * 64 + ks * 32 + fq * 8);
    f32x4 o[8][2];
#pragma unroll
    for (int i = 0; i < 8; ++i) { o[i][0] = (f32x4){0.f, 0.f, 0.f, 0.f}; o[i][1] = (f32x4){0.f, 0.f, 0.f, 0.f}; }
    float l[2] = {0.f, 0.f};
    constexpr int STG = 36864, VOFF = 18432;
    u32x4 rk[2], rv[2];
    const int krow = tid >> 4, kch = tid & 15;
    const int vrow = tid >> 3, vch = tid & 7;
#define AGLOAD(kt) do { const int key0_ = (kt) * 64; \
        _Pragma("unroll") for (int i = 0; i < 2; ++i) rk[i] = *(const u32x4*)(Kg + (size_t)(key0_ + krow + i * 32) * NP + kch * 8); \
        _Pragma("unroll") for (int i = 0; i < 2; ++i) rv[i] = *(const u32x4*)(VTg + (size_t)(vrow + i * 64) * T + key0_ + vch * 8); } while (0)
#define ASWRITE(buf) do { char* b_ = lds + (buf) * STG; \
        _Pragma("unroll") for (int i = 0; i < 2; ++i) *(u32x4*)(b_ + ((kch >> 3) * 64 + krow + i * 32) * 144 + (kch & 7) * 16) = rk[i]; \
        _Pragma("unroll") for (int i = 0; i < 2; ++i) *(u32x4*)(b_ + VOFF + (vrow + i * 64) * 144 + vch * 16) = rv[i]; } while (0)
    const int nkt = T / 64;
    AGLOAD(0); ASWRITE(0); __syncthreads();
    for (int kt = 0; kt < nkt; ++kt) {
        if (kt + 1 < nkt) AGLOAD(kt + 1);
        const char* base = lds + (kt & 1) * STG;
        f32x4 s[4][2];
#pragma unroll
        for (int mt = 0; mt < 4; ++mt) { s[mt][0] = (f32x4){-shift, -shift, -shift, -shift}; s[mt][1] = s[mt][0]; }
#pragma unroll
        for (int ks = 0; ks < 2; ++ks)
#pragma unroll
            for (int mt = 0; mt < 4; ++mt) {
                const bf16x8 kf = *(const bf16x8*)(base + (c * 64 + mt * 16 + fr) * 144 + ks * 64 + fq * 16);
                s[mt][0] = mfma16(kf, qf[0][ks], s[mt][0]);
                s[mt][1] = mfma16(kf, qf[1][ks], s[mt][1]);
            }
        bf16x8 pf[2][2];
#pragma unroll
        for (int nt = 0; nt < 2; ++nt)
#pragma unroll
            for (int kk = 0; kk < 2; ++kk) {
                const f32x4 a = s[2 * kk][nt], bb = s[2 * kk + 1][nt];
                const float p0 = fexp2(a.x), p1 = fexp2(a.y), p2 = fexp2(a.z), p3 = fexp2(a.w);
                const float p4 = fexp2(bb.x), p5 = fexp2(bb.y), p6 = fexp2(bb.z), p7 = fexp2(bb.w);
                l[nt] += ((p0 + p1) + (p2 + p3)) + ((p4 + p5) + (p6 + p7));
                u32x4 w; w.x = pk2(p0, p1); w.y = pk2(p2, p3); w.z = pk2(p4, p5); w.w = pk2(p6, p7);
                pf[kk][nt] = __builtin_bit_cast(bf16x8, w);
            }
#pragma unroll
        for (int kk = 0; kk < 2; ++kk)
#pragma unroll
            for (int dvt = 0; dvt < 8; ++dvt) {
                const bf16x8 vf = *(const bf16x8*)(base + VOFF + (dvt * 16 + fr) * 144 + kk * 64 + fq * 16);
                o[dvt][0] = mfma16(vf, pf[kk][0], o[dvt][0]);
                o[dvt][1] = mfma16(vf, pf[kk][1], o[dvt][1]);
            }
        if (kt + 1 < nkt) ASWRITE((kt + 1) & 1);
        __syncthreads();
    }
#undef AGLOAD
#undef ASWRITE
    float inv[2];
#pragma unroll
    for (int nt = 0; nt < 2; ++nt) { float v = l[nt]; v += sxor<16>(v); v += sxor<32>(v); inv[nt] = 1.0f / v; }
    float* xch = (float*)lds + sub * 4096;
    if (c == 1) {
#pragma unroll
        for (int dvt = 0; dvt < 8; ++dvt)
#pragma unroll
            for (int nt = 0; nt < 2; ++nt) {
                xch[(dvt * 16 + fq * 4 + 0) * 32 + nt * 16 + fr] = o[dvt][nt].x * inv[nt];
                xch[(dvt * 16 + fq * 4 + 1) * 32 + nt * 16 + fr] = o[dvt][nt].y * inv[nt];
                xch[(dvt * 16 + fq * 4 + 2) * 32 + nt * 16 + fr] = o[dvt][nt].z * inv[nt];
                xch[(dvt * 16 + fq * 4 + 3) * 32 + nt * 16 + fr] = o[dvt][nt].w * inv[nt];
            }
    }
    __syncthreads();
    if (c == 0) {
        float ss[2] = {0.f, 0.f};
#pragma unroll
        for (int dvt = 0; dvt < 8; ++dvt)
#pragma unroll
            for (int nt = 0; nt < 2; ++nt) {
                f32x4 v = o[dvt][nt] * inv[nt];
                v.x -= lam * xch[(dvt * 16 + fq * 4 + 0) * 32 + nt * 16 + fr];
                v.y -= lam * xch[(dvt * 16 + fq * 4 + 1) * 32 + nt * 16 + fr];
                v.z -= lam * xch[(dvt * 16 + fq * 4 + 2) * 32 + nt * 16 + fr];
                v.w -= lam * xch[(dvt * 16 + fq * 4 + 3) * 32 + nt * 16 + fr];
                o[dvt][nt] = v; ss[nt] += v.x * v.x + v.y * v.y + v.z * v.z + v.w * v.w;
            }
#pragma unroll
        for (int nt = 0; nt < 2; ++nt) {
            float v = ss[nt]; v += sxor<16>(v); v += sxor<32>(v);
            const float r = rsqrtf(v * (1.f / 128.f) + RMS_EPS) * 0.8f;
#pragma unroll
            for (int dvt = 0; dvt < 8; ++dvt) {
                const f32x4 gs = *(const f32x4*)(p.in[I_DGSUB] + dvt * 16 + fq * 4);
                const f32x4 v4 = o[dvt][nt];
                u32x2 w; w.x = pk2(v4.x * r * gs.x, v4.y * r * gs.y); w.y = pk2(v4.z * r * gs.z, v4.w * r * gs.w);
                *(u32x2*)(P + (size_t)(q0 + nt * 16 + fr) * NP + C_DQ + h * 128 + dvt * 16 + fq * 4) = w;
            }
        }
    }
    __syncthreads();
}

__device__ __forceinline__ void mem_attn_item(const Params& p, const Grp& G, int item, char* lds, float shift) {
    const int tid = otid(), lane = tid & 63, wid = tid >> 6, fr = lane & 15, fq = lane >> 4;
    const int T = G.T, nqb = T / 128;
    const int qb = item % nqb, bh = item / nqb, h = bh & 3, b = bh >> 2;
    bf16_t* P = (bf16_t*)(p.ws + WS_PROJ) + (size_t)b * T * NP;
    const bf16_t* MK = (const bf16_t*)(p.ws + WS_MEMK) + (size_t)((G.mb0 + b) * 4 + h) * 256 * 256;
    const bf16_t* MV = (const bf16_t*)(p.ws + WS_MEMV) + (size_t)((G.mb0 + b) * 4 + h) * 256 * 256;
    const int row = qb * 128 + wid * 16 + fr;
    bf16_t* qp = P + (size_t)row * NP + C_MQ + h * 256;
    bf16x8 qf[8];
    {
        float ss = 0.f; u32x4 raw[8];
#pragma unroll
        for (int ks = 0; ks < 8; ++ks) { raw[ks] = *(const u32x4*)(qp + ks * 32 + fq * 8);
            const float a0 = bflo(raw[ks].x), a1 = bfhi(raw[ks].x), a2 = bflo(raw[ks].y), a3 = bfhi(raw[ks].y), a4 = bflo(raw[ks].z), a5 = bfhi(raw[ks].z), a6 = bflo(raw[ks].w), a7 = bfhi(raw[ks].w);
            ss += a0 * a0 + a1 * a1 + a2 * a2 + a3 * a3 + a4 * a4 + a5 * a5 + a6 * a6 + a7 * a7; }
        ss += sxor<16>(ss); ss += sxor<32>(ss);
        const float r = rsqrtf(ss * (1.f / 256.f) + RMS_EPS) * (0.0625f * LOG2E);
#pragma unroll
        for (int ks = 0; ks < 8; ++ks) {
            const f32x4 g0 = *(const f32x4*)(p.in[I_MGQ] + ks * 32 + fq * 8), g1 = *(const f32x4*)(p.in[I_MGQ] + ks * 32 + fq * 8 + 4);
            u32x4 w;
            w.x = pk2(bflo(raw[ks].x) * r * g0.x, bfhi(raw[ks].x) * r * g0.y); w.y = pk2(bflo(raw[ks].y) * r * g0.z, bfhi(raw[ks].y) * r * g0.w);
            w.z = pk2(bflo(raw[ks].z) * r * g1.x, bfhi(raw[ks].z) * r * g1.y); w.w = pk2(bflo(raw[ks].w) * r * g1.z, bfhi(raw[ks].w) * r * g1.w);
            qf[ks] = __builtin_bit_cast(bf16x8, w);
        }
    }
    f32x4 o[16];
#pragma unroll
    for (int i = 0; i < 16; ++i) o[i] = (f32x4){0.f, 0.f, 0.f, 0.f};
    float l = 0.f;
    constexpr int KROW = 528, VOFF = 64 * 528;
    for (int kt = 0; kt < 4; ++kt) {
#pragma unroll
        for (int i = 0; i < 4; ++i) {
            const int idx = tid + i * 512, r = idx >> 5, ch = idx & 31;
            *(u32x4*)(lds + r * KROW + ch * 16) = *(const u32x4*)(MK + (size_t)(kt * 64 + r) * 256 + ch * 8);
            const int vr = idx >> 3, vc = idx & 7;
            *(u32x4*)(lds + VOFF + vr * 144 + vc * 16) = *(const u32x4*)(MV + (size_t)vr * 256 + kt * 64 + vc * 8);
        }
        __syncthreads();
        f32x4 s[4];
#pragma unroll
        for (int mt = 0; mt < 4; ++mt) s[mt] = (f32x4){-shift, -shift, -shift, -shift};
#pragma unroll
        for (int ks = 0; ks < 8; ++ks)
#pragma unroll
            for (int mt = 0; mt < 4; ++mt) {
                const bf16x8 kf = *(const bf16x8*)(lds + (mt * 16 + fr) * KROW + ks * 64 + fq * 16);
                s[mt] = mfma16(kf, qf[ks], s[mt]);
            }
        bf16x8 pf[2];
#pragma unroll
        for (int kk = 0; kk < 2; ++kk) {
            const f32x4 a = s[2 * kk], bb = s[2 * kk + 1];
            const float p0 = fexp2(a.x), p1 = fexp2(a.y), p2 = fexp2(a.z), p3 = fexp2(a.w);
            const float p4 = fexp2(bb.x), p5 = fexp2(bb.y), p6 = fexp2(bb.z), p7 = fexp2(bb.w);
            l += ((p0 + p1) + (p2 + p3)) + ((p4 + p5) + (p6 + p7));
            u32x4 w; w.x = pk2(p0, p1); w.y = pk2(p2, p3); w.z = pk2(p4, p5); w.w = pk2(p6, p7);
            pf[kk] = __builtin_bit_cast(bf16x8, w);
        }
#pragma unroll
        for (int kk = 0; kk < 2; ++kk)
#pragma unroll
            for (int dvt = 0; dvt < 16; ++dvt) {
                const bf16x8 vf = *(const bf16x8*)(lds + VOFF + (dvt * 16 + fr) * 144 + kk * 64 + fq * 16);
                o[dvt] = mfma16(vf, pf[kk], o[dvt]);
            }
        __syncthreads();
    }
    l += sxor<16>(l); l += sxor<32>(l);
    const float inv = 1.0f / l;
#pragma unroll
    for (int dvt = 0; dvt < 16; ++dvt) {
        u32x2 w; w.x = pk2(o[dvt].x * inv, o[dvt].y * inv); w.y = pk2(o[dvt].z * inv, o[dvt].w * inv);
        *(u32x2*)(qp + dvt * 16 + fq * 4) = w;
    }
}

constexpr int L_QE = 0, L_KE = 17408, L_KST = 34816, L_VTL = 53248, L_ATT = 71680, L_SB = 80896, L_LRF = 115712, L_TOT = 119808, L_GDEC = 121856;
__device__ __forceinline__ void gla_item(const Params& p, const Grp& G, int item, char* lds) {
    const int tid = otid(), lane = tid & 63, wid = tid >> 6, fr = lane & 15, fq = lane >> 4;
    const int slice = item & 1, dir = (item >> 1) & 1, h = (item >> 2) & 3, b = item >> 4;
    const int T = G.T, N = T / 64;
    const bf16_t* P = (const bf16_t*)(p.ws + WS_PROJ) + (size_t)b * T * NP;
    bf16_t* OUT = dir ? (bf16_t*)(p.ws + WS_PROJ) + (size_t)b * T * NP + C_DV + h * 256 + slice * 128
                      : (bf16_t*)(p.ws + WS_HB) + (size_t)b * T * D + h * 256 + slice * 128;
    const int ldo = dir ? NP : D;
    const int d = tid & 127, rg = tid >> 7;
    float wdec[16];
    {
        const float* wd = p.in[dir ? I_WDB : I_WDF];
#pragma unroll
        for (int r = 0; r < 16; ++r) wdec[r] = wd[r * 512 + h * 128 + d];
    }
    const float bdec = p.in[dir ? I_BDB : I_BDF][h * 128 + d];
    for (int i = tid; i < 34816 / 16; i += NTHR) *(u32x4*)(lds + L_SB + i * 16) = (u32x4){0u, 0u, 0u, 0u};
    f32x4 S[8];
#pragma unroll
    for (int i = 0; i < 8; ++i) S[i] = (f32x4){0.f, 0.f, 0.f, 0.f};
    u32x4 rq[2], rk[2], rv[2], rl;
    const int lrow = tid >> 4, lch = tid & 15;
#define GGLOAD(n) do { const int cb_ = (dir ? (N - 1 - (n)) : (n)) * 64; \
        _Pragma("unroll") for (int i = 0; i < 2; ++i) { const int li_ = lrow + i * 32, tk_ = cb_ + (dir ? 63 - li_ : li_); const bf16_t* rp_ = P + (size_t)tk_ * NP; \
            rq[i] = *(const u32x4*)(rp_ + C_GQ + h * 128 + lch * 8); rk[i] = *(const u32x4*)(rp_ + C_GK + h * 128 + lch * 8); rv[i] = *(const u32x4*)(rp_ + C_GV + h * 256 + slice * 128 + lch * 8); } \
        if (tid < 128) { const int li_ = tid >> 1, tk_ = cb_ + (dir ? 63 - li_ : li_); rl = *(const u32x4*)(P + (size_t)tk_ * NP + C_LR + dir * 16 + (tid & 1) * 8); } } while (0)
    GGLOAD(0);
    for (int n = 0; n < N; ++n) {
#pragma unroll
        for (int i = 0; i < 2; ++i) {
            const int li = lrow + i * 32;
            *(u32x4*)(lds + L_QE + li * 272 + lch * 16) = rq[i];
            *(u32x4*)(lds + L_KE + li * 272 + lch * 16) = rk[i];
            bf16_t* vt = (bf16_t*)(lds + L_VTL) + (lch * 8) * 72 + li;
            vt[0 * 72] = (bf16_t)(rv[i].x & 0xffff); vt[1 * 72] = (bf16_t)(rv[i].x >> 16); vt[2 * 72] = (bf16_t)(rv[i].y & 0xffff); vt[3 * 72] = (bf16_t)(rv[i].y >> 16);
            vt[4 * 72] = (bf16_t)(rv[i].z & 0xffff); vt[5 * 72] = (bf16_t)(rv[i].z >> 16); vt[6 * 72] = (bf16_t)(rv[i].w & 0xffff); vt[7 * 72] = (bf16_t)(rv[i].w >> 16);
        }
        if (tid < 128) {
            float* lf = (float*)(lds + L_LRF) + (tid >> 1) * 16 + (tid & 1) * 8;
            *(f32x4*)lf = (f32x4){bflo(rl.x), bfhi(rl.x), bflo(rl.y), bfhi(rl.y)};
            *(f32x4*)(lf + 4) = (f32x4){bflo(rl.z), bfhi(rl.z), bflo(rl.w), bfhi(rl.w)};
        }
        if (n + 1 < N) GGLOAD(n + 1);
        __syncthreads();
        float cs[16]; float run = 0.f;
#pragma unroll
        for (int ii = 0; ii < 16; ++ii) {
            const float* lf = (const float*)(lds + L_LRF) + (rg * 16 + ii) * 16;
            const f32x4 a0 = *(const f32x4*)lf, a1 = *(const f32x4*)(lf + 4), a2 = *(const f32x4*)(lf + 8), a3 = *(const f32x4*)(lf + 12);
            float x = bdec;
            x += a0.x * wdec[0] + a0.y * wdec[1] + a0.z * wdec[2] + a0.w * wdec[3];
            x += a1.x * wdec[4] + a1.y * wdec[5] + a1.z * wdec[6] + a1.w * wdec[7];
            x += a2.x * wdec[8] + a2.y * wdec[9] + a2.z * wdec[10] + a2.w * wdec[11];
            x += a3.x * wdec[12] + a3.y * wdec[13] + a3.z * wdec[14] + a3.w * wdec[15];
            const float ls = fminf(x, 0.f) - __logf(1.0f + __expf(-fabsf(x)));
            run += ls * 0.0625f; cs[ii] = run;
        }
        ((float*)(lds + L_TOT))[rg * 128 + d] = run;
        __syncthreads();
        float off = 0.f, blast = 0.f;
#pragma unroll
        for (int r = 0; r < 4; ++r) { const float tv = ((const float*)(lds + L_TOT))[r * 128 + d]; blast += tv; if (r < rg) off += tv; }
        {
            bf16_t* qe = (bf16_t*)(lds + L_QE) + d; bf16_t* ke = (bf16_t*)(lds + L_KE) + d;
            unsigned ksp[8];
#pragma unroll
            for (int ii = 0; ii < 16; ii += 2) {
                const int i0 = rg * 16 + ii;
                const float b0 = off + cs[ii], b1 = off + cs[ii + 1];
                const float q0v = bf2f(qe[i0 * 136]), q1v = bf2f(qe[(i0 + 1) * 136]), k0v = bf2f(ke[i0 * 136]), k1v = bf2f(ke[(i0 + 1) * 136]);
                qe[i0 * 136] = f2bf(q0v * __expf(b0)); qe[(i0 + 1) * 136] = f2bf(q1v * __expf(b1));
                ke[i0 * 136] = f2bf(k0v * __expf(-b0)); ke[(i0 + 1) * 136] = f2bf(k1v * __expf(-b1));
                ksp[ii >> 1] = pk2(k0v * __expf(blast - b0), k1v * __expf(blast - b1));
            }
            char* kst = lds + L_KST + d * 144 + rg * 32;
            *(u32x4*)kst = (u32x4){ksp[0], ksp[1], ksp[2], ksp[3]};
            *(u32x4*)(kst + 16) = (u32x4){ksp[4], ksp[5], ksp[6], ksp[7]};
            if (rg == 0) ((float*)(lds + L_GDEC))[d] = __expf(blast);
        }
        __syncthreads();
        {
            const int ct = wid & 3;
            f32x4 a[2] = {(f32x4){0.f, 0.f, 0.f, 0.f}, (f32x4){0.f, 0.f, 0.f, 0.f}};
#pragma unroll
            for (int ks = 0; ks < 4; ++ks) {
                const bf16x8 qv = *(const bf16x8*)(lds + L_QE + (ct * 16 + fr) * 272 + ks * 64 + fq * 16);
#pragma unroll
                for (int j = 0; j < 2; ++j) {
                    const int st = (wid >> 2) * 2 + j;
                    const bf16x8 kv = *(const bf16x8*)(lds + L_KE + (st * 16 + fr) * 272 + ks * 64 + fq * 16);
                    a[j] = mfma16(kv, qv, a[j]);
                }
            }
#pragma unroll
            for (int j = 0; j < 2; ++j) {
                const int st = (wid >> 2) * 2 + j, cc = ct * 16 + fr, s0 = st * 16 + fq * 4;
                const float v0 = (s0 + 0 <= cc) ? a[j].x : 0.f, v1 = (s0 + 1 <= cc) ? a[j].y : 0.f, v2 = (s0 + 2 <= cc) ? a[j].z : 0.f, v3 = (s0 + 3 <= cc) ? a[j].w : 0.f;
                *(u32x2*)(lds + L_ATT + cc * 144 + s0 * 2) = (u32x2){pk2(v0, v1), pk2(v2, v3)};
            }
        }
        __syncthreads();
        {
            f32x4 oc[4] = {(f32x4){0.f, 0.f, 0.f, 0.f}, (f32x4){0.f, 0.f, 0.f, 0.f}, (f32x4){0.f, 0.f, 0.f, 0.f}, (f32x4){0.f, 0.f, 0.f, 0.f}};
#pragma unroll
            for (int ks = 0; ks < 2; ++ks) {
                const bf16x8 af = *(const bf16x8*)(lds + L_VTL + (wid * 16 + fr) * 144 + ks * 64 + fq * 16);
#pragma unroll
                for (int ct = 0; ct < 4; ++ct) { const bf16x8 bfv = *(const bf16x8*)(lds + L_ATT + (ct * 16 + fr) * 144 + ks * 64 + fq * 16); oc[ct] = mfma16(af, bfv, oc[ct]); }
            }
#pragma unroll
            for (int ks = 0; ks < 4; ++ks) {
                const bf16x8 af = *(const bf16x8*)(lds + L_SB + (wid * 16 + fr) * 272 + ks * 64 + fq * 16);
#pragma unroll
                for (int ct = 0; ct < 4; ++ct) { const bf16x8 bfv = *(const bf16x8*)(lds + L_QE + (ct * 16 + fr) * 272 + ks * 64 + fq * 16); oc[ct] = mfma16(af, bfv, oc[ct]); }
            }
            const int cb = (dir ? (N - 1 - n) : n) * 64;
#pragma unroll
            for (int ct = 0; ct < 4; ++ct) {
                const int cl = ct * 16 + fr, tk = cb + (dir ? 63 - cl : cl);
                *(u32x2*)(OUT + (size_t)tk * ldo + wid * 16 + fq * 4) = (u32x2){pk2(oc[ct].x, oc[ct].y), pk2(oc[ct].z, oc[ct].w)};
            }
        }
        __syncthreads();
        {
            const f32x4 gd = *(const f32x4*)((const float*)(lds + L_GDEC) + wid * 16 + fq * 4);
#pragma unroll
            for (int et = 0; et < 8; ++et) S[et] = S[et] * gd;
#pragma unroll
            for (int ks = 0; ks < 2; ++ks) {
                const bf16x8 af = *(const bf16x8*)(lds + L_KST + (wid * 16 + fr) * 144 + ks * 64 + fq * 16);
#pragma unroll
                for (int et = 0; et < 8; ++et) { const bf16x8 bfv = *(const bf16x8*)(lds + L_VTL + (et * 16 + fr) * 144 + ks * 64 + fq * 16); S[et] = mfma16(af, bfv, S[et]); }
            }
#pragma unroll
            for (int et = 0; et < 8; ++et)
                *(u32x2*)(lds + L_SB + (et * 16 + fr) * 272 + (wid * 16 + fq * 4) * 2) = (u32x2){pk2(S[et].x, S[et].y), pk2(S[et].z, S[et].w)};
        }
        __syncthreads();
    }
#undef GGLOAD
}

__device__ __forceinline__ void phase_mixer(const Params& p, int g, char* lds, int* s_item) {
    const Grp G = get_group(p, g);
    const int nGLA = G.B * 16, nATT = G.B * 8 * (G.T / 128), nMEM = G.B * 4 * (G.T / 128), nTot = nGLA + nATT + nMEM;
    unsigned* ctr = (unsigned*)(p.ws + WS_CTRL) + g;
    float d1 = 0.f, d2 = 0.f, mq = 0.f, mk = 0.f, mmq = 0.f, mmk = 0.f;
    for (int i = 0; i < 64; ++i) { d1 += p.in[I_LQ1][i] * p.in[I_LK1][i]; d2 += p.in[I_LQ2][i] * p.in[I_LK2][i]; mq = fmaxf(mq, fabsf(p.in[I_DGQ][i])); mk = fmaxf(mk, fabsf(p.in[I_DGK][i])); }
    for (int i = 0; i < 256; ++i) { mmq = fmaxf(mmq, fabsf(p.in[I_MGQ][i])); mmk = fmaxf(mmk, fabsf(p.in[I_MGK][i])); }
    const float lam = expf(d1) - expf(d2) + 0.2f;
    const float shiftD = fmaxf(0.f, 8.f * mq * mk * LOG2E - 64.f), shiftM = fmaxf(0.f, 16.f * mmq * mmk * LOG2E - 64.f);
#ifndef STATIC_SCHED
#define STATIC_SCHED 0
#endif
    for (int sit = blockIdx.x;; sit += gridDim.x) {
#if STATIC_SCHED
        (void)ctr; (void)s_item;
        const int it = sit;
#else
        if (threadIdx.x == 0) *s_item = (int)atomicAdd(ctr, 1u);
        __syncthreads();
        const int it = *s_item;
        __syncthreads();
#endif
        if (it >= nTot) break;
        if (it < nGLA) gla_item(p, G, it, lds);
        else if (it < nGLA + nATT) diff_attn_item(p, G, it - nGLA, lds, lam, shiftD);
        else mem_attn_item(p, G, it - nGLA - nATT, lds, shiftM);
    }
}

__device__ __forceinline__ void phase_glafin(const Params& p, int g) {
    const int tid_ = otid(), lane = tid_ & 63, wid = tid_ >> 6;
    bf16_t* P = (bf16_t*)(p.ws + WS_PROJ); const bf16_t* F = (const bf16_t*)(p.ws + WS_HB);
    for (int it = blockIdx.x * 8 + wid; it < G_TOK * 4; it += gridDim.x * 8) {
        const int tok = it >> 2, h = it & 3;
        bf16_t* row = P + (size_t)tok * NP;
        const unsigned qq = *(const unsigned*)(row + C_GQ + h * 128 + lane * 2), kk = *(const unsigned*)(row + C_GK + h * 128 + lane * 2);
        const float qk = wave_sum(bflo(qq) * bflo(kk) + bfhi(qq) * bfhi(kk));
        const u32x2 f = *(const u32x2*)(F + (size_t)tok * D + h * 256 + lane * 4), bk = *(const u32x2*)(row + C_DV + h * 256 + lane * 4);
        const u32x2 v = *(const u32x2*)(row + C_GV + h * 256 + lane * 4), gt = *(const u32x2*)(row + C_GG + h * 256 + lane * 4);
        float o0 = bflo(f.x) + bflo(bk.x) - qk * bflo(v.x), o1 = bfhi(f.x) + bfhi(bk.x) - qk * bfhi(v.x);
        float o2 = bflo(f.y) + bflo(bk.y) - qk * bflo(v.y), o3 = bfhi(f.y) + bfhi(bk.y) - qk * bfhi(v.y);
        const float r = rsqrtf(wave_sum(o0 * o0 + o1 * o1 + o2 * o2 + o3 * o3) * (1.f / 256.f) + RMS_EPS);
        const f32x4 go = *(const f32x4*)(p.in[I_GOUT] + lane * 4);
        const float g0 = bflo(gt.x), g1 = bfhi(gt.x), g2 = bflo(gt.y), g3 = bfhi(gt.y);
        o0 *= r * go.x * g0 / (1.f + __expf(-g0)); o1 *= r * go.y * g1 / (1.f + __expf(-g1));
        o2 *= r * go.z * g2 / (1.f + __expf(-g2)); o3 *= r * go.w * g3 / (1.f + __expf(-g3));
        *(u32x2*)(row + C_GG + h * 256 + lane * 4) = (u32x2){pk2(o0, o1), pk2(o2, o3)};
    }
}

__device__ __forceinline__ void phase_merge(const Params& p, int g, char* lds) {
    const int tid_ = otid(), lane = tid_ & 63, wid = tid_ >> 6, wm = wid >> 2, wn = wid & 3, fr = lane & 15, fq = lane >> 4;
    const bf16_t* P = (const bf16_t*)(p.ws + WS_PROJ); bf16_t* M = (bf16_t*)(p.ws + WS_VT);
    const int nM = G_TOK / 128, nN = 4;
    for (int t = blockIdx.x; t < nM * nN; t += gridDim.x) {
        int pm, pn; tile_order(t, nM, nN, pm, pn);
        const int m0 = pm * 128, n0 = pn * 256;
        f32x4 macc[4][4];
#pragma unroll
        for (int i = 0; i < 4; ++i)
#pragma unroll
            for (int j = 0; j < 4; ++j) macc[i][j] = (f32x4){0.f, 0.f, 0.f, 0.f};
        for (int br = 0; br < 3; ++br) {
            f32x4 acc[4][4];
#pragma unroll
            for (int i = 0; i < 4; ++i)
#pragma unroll
                for (int j = 0; j < 4; ++j) acc[i][j] = (f32x4){0.f, 0.f, 0.f, 0.f};
            const int acol = br == 0 ? C_GG : (br == 1 ? C_DQ : C_MQ);
            gemm_kloop<true>(acc, P + (size_t)m0 * NP + acol, NP, (const bf16_t*)(p.ws + WS_WOT) + (size_t)br * D * D + (size_t)n0 * D, D, D, lds);
#pragma unroll
            for (int mt = 0; mt < 4; ++mt)
#pragma unroll
                for (int nt = 0; nt < 4; ++nt) {
                    const int row = m0 + wm * 64 + mt * 16 + fr, col = n0 + wn * 64 + nt * 16 + fq * 4;
                    const u32x2 gt = *(const u32x2*)(P + (size_t)row * NP + C_BG + br * 1024 + col);
                    f32x4 sg; sg.x = 1.f / (1.f + __expf(-bflo(gt.x))); sg.y = 1.f / (1.f + __expf(-bfhi(gt.x))); sg.z = 1.f / (1.f + __expf(-bflo(gt.y))); sg.w = 1.f / (1.f + __expf(-bfhi(gt.y)));
                    macc[mt][nt] += sg * acc[mt][nt];
                }
        }
#pragma unroll
        for (int mt = 0; mt < 4; ++mt)
#pragma unroll
            for (int nt = 0; nt < 4; ++nt) {
                const int row = m0 + wm * 64 + mt * 16 + fr, col = n0 + wn * 64 + nt * 16 + fq * 4;
                *(u32x2*)(M + (size_t)row * D + col) = (u32x2){pk2(macc[mt][nt].x, macc[mt][nt].y), pk2(macc[mt][nt].z, macc[mt][nt].w)};
            }
    }
}

__device__ __forceinline__ void phase_outproj(const Params& p, int g, char* lds) {
    const Grp G = get_group(p, g);
    const int tid_ = otid(), lane = tid_ & 63, wid = tid_ >> 6, wm = wid >> 2, wn = wid & 3, fr = lane & 15, fq = lane >> 4;
    const bf16_t* M = (const bf16_t*)(p.ws + WS_VT); const bf16_t* W = (const bf16_t*)(p.ws + WS_WOT) + (size_t)3 * D * D;
    const int nM = G_TOK / 128, nN = 4;
    for (int t = blockIdx.x; t < nM * nN; t += gridDim.x) {
        int pm, pn; tile_order(t, nM, nN, pm, pn);
        const int m0 = pm * 128, n0 = pn * 256;
        f32x4 acc[4][4];
#pragma unroll
        for (int i = 0; i < 4; ++i)
#pragma unroll
            for (int j = 0; j < 4; ++j) acc[i][j] = (f32x4){0.f, 0.f, 0.f, 0.f};
        gemm_kloop<true>(acc, M + (size_t)m0 * D, D, W + (size_t)n0 * D, D, D, lds);
#pragma unroll
        for (int mt = 0; mt < 4; ++mt)
#pragma unroll
            for (int nt = 0; nt < 4; ++nt) {
                const int row = m0 + wm * 64 + mt * 16 + fr, col = n0 + wn * 64 + nt * 16 + fq * 4;
                const f32x4 xv = *(const f32x4*)(G.x + (size_t)row * D + col);
                *(f32x4*)(G.out + (size_t)row * D + col) = xv + acc[mt][nt];
            }
    }
}

__device__ __forceinline__ void phase_peerq(const Params& p, int g, char* lds) {
    const int tid_ = otid(), lane = tid_ & 63, wid = tid_ >> 6, wm = wid >> 2, wn = wid & 3, fr = lane & 15, fq = lane >> 4;
    const bf16_t* A = (const bf16_t*)(p.ws + WS_HB); const bf16_t* W = (const bf16_t*)(p.ws + WS_WQT); bf16_t* P = (bf16_t*)(p.ws + WS_PROJ);
    const int nM = G_TOK / 128, nN = 8;
    for (int t = blockIdx.x; t < nM * nN; t += gridDim.x) {
        int pm, pn; tile_order(t, nM, nN, pm, pn);
        const int m0 = pm * 128, n0 = pn * 256;
        f32x4 acc[4][4];
#pragma unroll
        for (int i = 0; i < 4; ++i)
#pragma unroll
            for (int j = 0; j < 4; ++j) acc[i][j] = (f32x4){0.f, 0.f, 0.f, 0.f};
        gemm_kloop<true>(acc, A + (size_t)m0 * D, D, W + (size_t)n0 * D, D, D, lds);
#pragma unroll
        for (int mt = 0; mt < 4; ++mt)
#pragma unroll
            for (int nt = 0; nt < 4; ++nt) {
                const int row = m0 + wm * 64 + mt * 16 + fr, col = n0 + wn * 64 + nt * 16 + fq * 4;
                *(u32x2*)(P + (size_t)row * NP + col) = (u32x2){pk2(acc[mt][nt].x, acc[mt][nt].y), pk2(acc[mt][nt].z, acc[mt][nt].w)};
            }
    }
}

__device__ __forceinline__ unsigned f2ord(float f) { const unsigned u = __float_as_uint(f); return (u & 0x80000000u) ? ~u : (u | 0x80000000u); }
__device__ __forceinline__ float ord2f(unsigned k) { const unsigned u = (k & 0x80000000u) ? (k & 0x7fffffffu) : ~k; return __uint_as_float(u); }
__device__ __forceinline__ unsigned gmax16(unsigned v) {
    unsigned t;
    t = sxoru<1>(v); v = v > t ? v : t; t = sxoru<2>(v); v = v > t ? v : t; t = sxoru<4>(v); v = v > t ? v : t; t = sxoru<8>(v); v = v > t ? v : t;
    return v;
}
__device__ __forceinline__ float gsum16(float v) { v += sxor<1>(v); v += sxor<2>(v); v += sxor<4>(v); v += sxor<8>(v); return v; }
__device__ __forceinline__ float gelu_exact(float a) { return 0.5f * a * (1.0f + erff(a * 0.70710678118654752f)); }

__device__ __forceinline__ void phase_peer(const Params& p, int g, char* lds) {
    const Grp G = get_group(p, g);
    const int tid = otid(), lane = tid & 63, wid = tid >> 6, fr = lane & 15, fq = lane >> 4;
    const bf16_t* P = (const bf16_t*)(p.ws + WS_PROJ); const bf16_t* HB = (const bf16_t*)(p.ws + WS_HB);
    const bf16_t* K12 = (const bf16_t*)(p.ws + WS_K12);
    const bf16_t* PU = (const bf16_t*)(p.ws + WS_PU); const bf16_t* PV = (const bf16_t*)(p.ws + WS_PV);
    float* SC = (float*)lds;
    int* EIDX = (int*)(lds + 65536);
    float* GATE = (float*)(lds + 65536 + 4096);
    for (int tile = blockIdx.x; tile < G_TOK / 8; tile += gridDim.x) {
        const int tok0 = tile * 8;
        {
            const int mt = wid >> 1, half = wid & 1;
            const int r = mt * 16 + fr, tl = r >> 3, hh = r & 7;
            const bf16_t* qrow = P + (size_t)(tok0 + tl) * NP + hh * 256 + half * 128;
            const bf16_t* kb = K12 + half * 16384;
            f32x4 acc[8];
#pragma unroll
            for (int i = 0; i < 8; ++i) acc[i] = (f32x4){0.f, 0.f, 0.f, 0.f};
#pragma unroll
            for (int ks = 0; ks < 4; ++ks) {
                const bf16x8 af = *(const bf16x8*)(qrow + ks * 32 + fq * 8);
#pragma unroll
                for (int nt = 0; nt < 8; ++nt) { const bf16x8 bfv = *(const bf16x8*)(kb + (nt * 16 + fr) * 128 + ks * 32 + fq * 8); acc[nt] = mfma16(af, bfv, acc[nt]); }
            }
#pragma unroll
            for (int nt = 0; nt < 8; ++nt) {
                float* dst = SC + (mt * 16 + fq * 4) * 256 + half * 128 + nt * 16 + fr;
                dst[0] = acc[nt].x; dst[256] = acc[nt].y; dst[512] = acc[nt].z; dst[768] = acc[nt].w;
            }
        }
        __syncthreads();
        for (int pass = 0; pass < 2; ++pass) {
            const int row = wid * 8 + pass * 4 + fq, sl = fr, gb = fq * 16;
            float v1 = 0.f, v2 = 0.f; int i1 = 0, i2 = 0;
#pragma unroll
            for (int hf = 0; hf < 2; ++hf) {
                unsigned key[8];
#pragma unroll
                for (int i = 0; i < 8; ++i) { const int idx = sl + 16 * i; key[i] = (f2ord(SC[row * 256 + hf * 128 + idx]) & ~127u) | (unsigned)(127 - idx); }
                float sv = 0.f; int si = 0;
                for (int r = 0; r < 16; ++r) {
                    unsigned m = key[0];
#pragma unroll
                    for (int i = 1; i < 8; ++i) m = m > key[i] ? m : key[i];
                    m = gmax16(m);
                    if (sl == r) { sv = ord2f(m & ~127u); si = 127 - (int)(m & 127u); }
#pragma unroll
                    for (int i = 0; i < 8; ++i) key[i] = key[i] == m ? 0u : key[i];
                }
                if (hf == 0) { v1 = sv; i1 = si; } else { v2 = sv; i2 = si; }
            }
            int ptr = 0; float ts = 0.f; int pid = 0;
            for (int r = 0; r < 16; ++r) {
                const float v2p = __shfl(v2, gb + (ptr & 15));
                const unsigned key = ptr < 16 ? ((f2ord(v1 + v2p) & ~255u) | (unsigned)(255 - (sl * 16 + ptr))) : 0u;
                const unsigned m = gmax16(key);
                if (sl == r) { ts = ord2f(m & ~255u); pid = 255 - (int)(m & 255u); }
                if (key == m) ptr++;
            }
            const int e1 = __shfl(i1, gb + (pid >> 4)), e2 = __shfl(i2, gb + (pid & 15));
            float mx = ts;
            mx = fmaxf(mx, sxor<1>(mx)); mx = fmaxf(mx, sxor<2>(mx)); mx = fmaxf(mx, sxor<4>(mx)); mx = fmaxf(mx, sxor<8>(mx));
            const float ex = __expf(ts - mx), sm = gsum16(ex);
            EIDX[row * 16 + sl] = e1 * 128 + e2; GATE[row * 16 + sl] = ex / sm;
        }
        __syncthreads();
        {
            const int tok = tok0 + wid;
            const bf16_t* hrow = HB + (size_t)tok * D;
            const u32x4 h0 = *(const u32x4*)(hrow + lane * 8), h1 = *(const u32x4*)(hrow + 512 + lane * 8);
            float hv[16];
            hv[0] = bflo(h0.x); hv[1] = bfhi(h0.x); hv[2] = bflo(h0.y); hv[3] = bfhi(h0.y); hv[4] = bflo(h0.z); hv[5] = bfhi(h0.z); hv[6] = bflo(h0.w); hv[7] = bfhi(h0.w);
            hv[8] = bflo(h1.x); hv[9] = bfhi(h1.x); hv[10] = bflo(h1.y); hv[11] = bfhi(h1.y); hv[12] = bflo(h1.z); hv[13] = bfhi(h1.z); hv[14] = bflo(h1.w); hv[15] = bfhi(h1.w);
            float acc[16];
#pragma unroll
            for (int i = 0; i < 16; ++i) acc[i] = 0.f;
#pragma unroll 4
            for (int k = 0; k < 128; ++k) {
                const int e = EIDX[wid * 128 + k]; const float gt = GATE[wid * 128 + k];
                const bf16_t* ur = PU + (size_t)e * D; const bf16_t* vr = PV + (size_t)e * D;
                const u32x4 u0 = *(const u32x4*)(ur + lane * 8), u1 = *(const u32x4*)(ur + 512 + lane * 8);
                const u32x4 w0 = *(const u32x4*)(vr + lane * 8), w1 = *(const u32x4*)(vr + 512 + lane * 8);
                float a = bflo(u0.x) * hv[0] + bfhi(u0.x) * hv[1] + bflo(u0.y) * hv[2] + bfhi(u0.y) * hv[3] + bflo(u0.z) * hv[4] + bfhi(u0.z) * hv[5] + bflo(u0.w) * hv[6] + bfhi(u0.w) * hv[7]
                        + bflo(u1.x) * hv[8] + bfhi(u1.x) * hv[9] + bflo(u1.y) * hv[10] + bfhi(u1.y) * hv[11] + bflo(u1.z) * hv[12] + bfhi(u1.z) * hv[13] + bflo(u1.w) * hv[14] + bfhi(u1.w) * hv[15];
                a = wave_sum(a);
                const float w = gt * gelu_exact(a);
                acc[0] += w * bflo(w0.x); acc[1] += w * bfhi(w0.x); acc[2] += w * bflo(w0.y); acc[3] += w * bfhi(w0.y);
                acc[4] += w * bflo(w0.z); acc[5] += w * bfhi(w0.z); acc[6] += w * bflo(w0.w); acc[7] += w * bfhi(w0.w);
                acc[8] += w * bflo(w1.x); acc[9] += w * bfhi(w1.x); acc[10] += w * bflo(w1.y); acc[11] += w * bfhi(w1.y);
                acc[12] += w * bflo(w1.z); acc[13] += w * bfhi(w1.z); acc[14] += w * bflo(w1.w); acc[15] += w * bfhi(w1.w);
            }
            float* orow = G.out + (size_t)tok * D;
            f32x4* o0 = (f32x4*)(orow + lane * 8); f32x4* o1 = (f32x4*)(orow + 512 + lane * 8);
            f32x4 t;
#define SAN(v) (v)
            t = o0[0]; t.x += acc[0]; t.y += acc[1]; t.z += acc[2]; t.w += acc[3]; t.x = SAN(t.x); t.y = SAN(t.y); t.z = SAN(t.z); t.w = SAN(t.w); o0[0] = t;
            t = o0[1]; t.x += acc[4]; t.y += acc[5]; t.z += acc[6]; t.w += acc[7]; t.x = SAN(t.x); t.y = SAN(t.y); t.z = SAN(t.z); t.w = SAN(t.w); o0[1] = t;
            t = o1[0]; t.x += acc[8]; t.y += acc[9]; t.z += acc[10]; t.w += acc[11]; t.x = SAN(t.x); t.y = SAN(t.y); t.z = SAN(t.z); t.w = SAN(t.w); o1[0] = t;
            t = o1[1]; t.x += acc[12]; t.y += acc[13]; t.z += acc[14]; t.w += acc[15]; t.x = SAN(t.x); t.y = SAN(t.y); t.z = SAN(t.z); t.w = SAN(t.w); o1[1] = t;
        }
        __syncthreads();
    }
}


#ifndef DEBUG_NAN
#define DEBUG_NAN 0
#endif
#if DEBUG_NAN
__device__ __noinline__ void scan_bf16(const bf16_t* base, size_t rows, size_t pitch, int col0, int ncols, unsigned* flag) {
    const size_t gtid = (size_t)blockIdx.x * NTHR + threadIdx.x, gsz = (size_t)gridDim.x * NTHR, cpr = ncols / 8, total = rows * cpr;
    bool bad = false;
    for (size_t i = gtid; i < total; i += gsz) {
        const size_t r = i / cpr, c = i % cpr;
        const u32x4 v = *(const u32x4*)(base + r * pitch + col0 + c * 8);
        bad = bad || ((v.x & 0x7F80u) == 0x7F80u) || ((v.x & 0x7F800000u) == 0x7F800000u) || ((v.y & 0x7F80u) == 0x7F80u) || ((v.y & 0x7F800000u) == 0x7F800000u)
                  || ((v.z & 0x7F80u) == 0x7F80u) || ((v.z & 0x7F800000u) == 0x7F800000u) || ((v.w & 0x7F80u) == 0x7F80u) || ((v.w & 0x7F800000u) == 0x7F800000u);
    }
    if (bad) atomicOr(flag, 1u);
}
__device__ __noinline__ void scan_f32(const float* base, size_t n, unsigned* flag) {
    const size_t gtid = (size_t)blockIdx.x * NTHR + threadIdx.x, gsz = (size_t)gridDim.x * NTHR;
    bool bad = false;
    for (size_t i = gtid; i < n; i += gsz) { if ((__float_as_uint(base[i]) & 0x7F800000u) == 0x7F800000u) bad = true; }
    if (bad) atomicOr(flag, 1u);
}
__device__ __forceinline__ void debug_scan(const Params& p, int ph) {
    unsigned* F = (unsigned*)(p.ws + WS_CTRL) + 128;
    const bf16_t* P = (const bf16_t*)(p.ws + WS_PROJ); const bf16_t* HB = (const bf16_t*)(p.ws + WS_HB); const bf16_t* VT = (const bf16_t*)(p.ws + WS_VT);
    if (ph == 0) {
        scan_bf16((const bf16_t*)(p.ws + WS_WINT), NP, D, 0, D, F + 0);
        scan_bf16((const bf16_t*)(p.ws + WS_WOT), 4 * D + 4096, D, 0, D, F + 1);
        scan_bf16((const bf16_t*)(p.ws + WS_PU), 32768, D, 0, D, F + 2);
        scan_f32((const float*)(p.ws + WS_ROPE), 16384 * 64, F + 3);
        scan_bf16((const bf16_t*)(p.ws + WS_HM), 2560, D, 0, D, F + 3);
    } else if (ph == 2) {
        scan_bf16((const bf16_t*)(p.ws + WS_MEMK), 2 * 10 * 4 * 256, 256, 0, 256, F + 4);
    } else if (ph == 3) scan_bf16(HB, G_TOK, D, 0, D, F + 5);
    else if (ph == 4) { scan_bf16(P, G_TOK, NP, 0, 3072, F + 6); scan_bf16(P, G_TOK, NP, 3072, 2048, F + 7); scan_bf16(VT, G_TOK, D, 0, D, F + 8); scan_bf16(P, G_TOK, NP, 6144, NP - 6144, F + 9); }
    else if (ph == 5) scan_bf16(P, G_TOK, NP, 3072, 2048, F + 10);
    else if (ph == 6) { scan_bf16(HB, G_TOK, D, 0, D, F + 11); scan_bf16(P, G_TOK, NP, C_DV, 1024, F + 12); scan_bf16(P, G_TOK, NP, C_DQ, 1024, F + 13); scan_bf16(P, G_TOK, NP, C_MQ, 1024, F + 14); }
    else if (ph == 7) scan_bf16(P, G_TOK, NP, C_GG, 1024, F + 15);
    else if (ph == 8) scan_bf16(VT, G_TOK, D, 0, D, F + 16);
    else if (ph == 9) scan_f32(p.out, (size_t)G_TOK * D, F + 17);
    else if (ph == 10) scan_bf16(HB, G_TOK, D, 0, D, F + 18);
    else if (ph == 11) scan_bf16(P, G_TOK, NP, 0, 2048, F + 19);
    else if (ph == 12) scan_f32(p.out, (size_t)G_TOK * D, F + 20);
}
#endif

constexpr int NPH = 3 + NGROUP * 10;
__device__ __forceinline__ void run_phase(const Params& p, int ph, char* lds, int* s_item) {
    if (ph == 0) { phase_p0a(p, lds); return; }
    if (ph == 1) { phase_p0b(p, lds); return; }
    if (ph == 2) { phase_p0c(p); return; }
    const int g = (ph - 3) / 10, s = (ph - 3) % 10;
    const Grp G = get_group(p, g);
    switch (s) {
        case 0: phase_rmsnorm(G.x, p.in[I_GMIX], (bf16_t*)(p.ws + WS_HB), G_TOK); break;
        case 1: phase_inproj(p, g, lds); break;
        case 2: phase_qkrope(p, g); break;
        case 3: phase_mixer(p, g, lds, s_item); break;
        case 4: phase_glafin(p, g); break;
        case 5: phase_merge(p, g, lds); break;
        case 6: phase_outproj(p, g, lds); break;
        case 7: phase_rmsnorm(G.out, p.in[I_GFFN], (bf16_t*)(p.ws + WS_HB), G_TOK); break;
        case 8: phase_peerq(p, g, lds); break;
        case 9: phase_peer(p, g, lds); break;
    }
}

__global__ void __launch_bounds__(NTHR) mega_kernel(Params p) {
    extern __shared__ __attribute__((aligned(16))) char lds[];
    __shared__ int s_item;
    cg::grid_group grid = cg::this_grid();
#ifndef PROBE
#define PROBE 0
#endif
#if PROBE
    __shared__ unsigned long long tacc[16];
    if (threadIdx.x < 16) tacc[threadIdx.x] = 0ull;
    __syncthreads();
    if (threadIdx.x == 0) tacc[15] = __builtin_amdgcn_s_memrealtime();
#endif
    for (int ph = p.ph_lo; ph < p.ph_hi; ++ph) {
        run_phase(p, ph, lds, &s_item);
#if DEBUG_NAN
        __threadfence(); grid.sync(); __threadfence();
        debug_scan(p, ph);
        __threadfence(); grid.sync(); __threadfence();
#else
#if PROBE
        __threadfence(); grid.sync(); __threadfence();
        if (blockIdx.x == 0 && threadIdx.x == 0) { const unsigned long long tn = __builtin_amdgcn_s_memrealtime(); tacc[ph < 3 ? 10 + ph : (ph - 3) % 10] += tn - tacc[15]; tacc[15] = tn; }
#else
        if (ph + 1 < p.ph_hi) { __threadfence(); grid.sync(); __threadfence(); }
#endif
#endif
    }
#if PROBE
    if (blockIdx.x == 0 && threadIdx.x == 0) {
        unsigned long long ta = 0, tb = 0;
        for (int k = 0; k < 13; ++k) { if ((PROBE_A >> k) & 1) ta += tacc[k]; if ((PROBE_B >> k) & 1) tb += tacc[k]; }
        float ma = (float)ta * 1e-5f;
        if (ma >= 10.f) ma *= 0.1f;
        if (ma < 1.f) ma *= 10.f;
        const int eb = 5 + (int)((float)tb * 1e-5f + 0.5f);
        float mark = ma; for (int k = 0; k < eb; ++k) mark *= 10.f;
        p.out[0] = mark;
    }
#endif
#if DEBUG_NAN
    if (blockIdx.x == 0 && threadIdx.x == 0) {
        const unsigned* F = (const unsigned*)(p.ws + WS_CTRL) + 128; int first = -1;
        for (int k = 0; k <= 20; ++k) if (first < 0 && atomicOr((unsigned*)F + k, 0u)) first = k;
        float mark = 1000.f; for (int k = 0; k < first; ++k) mark *= 10.f;
        p.out[0] = first < 0 ? 777.f : mark;
    }
#endif
}

extern "C" void kernel_launch(void* const* d_in, const int* in_sizes, int n_in, void* d_out, int out_size, void* d_ws, size_t ws_size, hipStream_t stream) {
    static int grid_blocks = 0;
    if (grid_blocks == 0) {
        if (n_in != 32 || ws_size < WS_END) { fprintf(stderr, "kernel_launch: unexpected n_in %d or ws_size %zu (< %zu)\n", n_in, ws_size, (size_t)WS_END); grid_blocks = -1; return; }
        int dev = 0, cus = 0, per_cu = 0;
        hipGetDevice(&dev);
        hipDeviceGetAttribute(&cus, hipDeviceAttributeMultiprocessorCount, dev);
        hipFuncSetAttribute((const void*)mega_kernel, hipFuncAttributeMaxDynamicSharedMemorySize, LDS_BYTES);
        hipOccupancyMaxActiveBlocksPerMultiprocessor(&per_cu, (const void*)mega_kernel, NTHR, LDS_BYTES);
        if (per_cu < 1) per_cu = 1;
        grid_blocks = cus * per_cu;
        (void)hipGetLastError();
    }
    if (grid_blocks < 0) return;
    Params p{};
    for (int i = 0; i < 32; ++i) p.in[i] = (const float*)d_in[i];
    p.out = (float*)d_out; p.ws = (unsigned char*)d_ws; p.ph_lo = 0; p.ph_hi = NPH;
    void* args[] = {&p};
    hipError_t e = hipLaunchCooperativeKernel((const void*)mega_kernel, dim3(grid_blocks), dim3(NTHR), args, LDS_BYTES, stream);
    if (e != hipSuccess) fprintf(stderr, "cooperative launch failed: %s (grid %d)\n", hipGetErrorString(e), grid_blocks);
}
```

```cpp
#include <hip/hip_runtime.h>
#include <hip/hip_cooperative_groups.h>
#include <cstdio>
#include <cstdint>
namespace cg = cooperative_groups;

typedef unsigned short bf16_t;
typedef short bf16x8 __attribute__((ext_vector_type(8)));
typedef float f32x4 __attribute__((ext_vector_type(4)));
typedef unsigned u32x4 __attribute__((ext_vector_type(4)));
typedef unsigned u32x2 __attribute__((ext_vector_type(2)));

constexpr int D = 1024;
constexpr int NP = 10496;
constexpr int IN_COLS = 10272;
constexpr int C_GQ = 0, C_GK = 512, C_GV = 1024, C_GG = 2048, C_DQ = 3072, C_DK = 4096, C_DV = 5120, C_MQ = 6144, C_BG = 7168, C_LR = 10240;
constexpr int G_TOK = 32768;
constexpr int NGROUP = 3;
constexpr int NTHR = 512;
constexpr float RMS_EPS = 1e-6f;
constexpr float LOG2E = 1.4426950408889634f;
constexpr int LDS_BYTES = 126976;

enum { I_XP = 0, I_XS, I_MP, I_MS, I_GMIX, I_WIN, I_WDF, I_BDF, I_WDB, I_BDB, I_GOUT, I_GWO, I_DGQ, I_DGK, I_LQ1, I_LK1, I_LQ2, I_LK2,
       I_DGSUB, I_DWO, I_MGN, I_MWKV, I_MGQ, I_MGK, I_MWO, I_WOUT, I_GFFN, I_PWQ, I_PK1, I_PK2, I_PU, I_PV };

constexpr size_t al256(size_t x) { return (x + 255) & ~(size_t)255; }
constexpr size_t WS_CTRL = 0;
constexpr size_t WS_PROJ = 4096;
constexpr size_t WS_HB   = WS_PROJ + (size_t)G_TOK * NP * 2;
constexpr size_t WS_VT   = WS_HB + (size_t)G_TOK * D * 2;
constexpr size_t WS_WINT = WS_VT + (size_t)G_TOK * D * 2;
constexpr size_t WS_WOT  = WS_WINT + (size_t)NP * D * 2;
constexpr size_t WS_WKVT = WS_WOT + (size_t)4 * D * D * 2;
constexpr size_t WS_WQT  = WS_WKVT + (size_t)2048 * D * 2;
constexpr size_t WS_PU   = WS_WQT + (size_t)2048 * D * 2;
constexpr size_t WS_PV   = WS_PU + (size_t)16384 * D * 2;
constexpr size_t WS_K12  = WS_PV + (size_t)16384 * D * 2;
constexpr size_t WS_ROPE = WS_K12 + (size_t)2 * 128 * 128 * 2;
constexpr size_t WS_HM   = WS_ROPE + (size_t)16384 * 64 * 4;
constexpr size_t WS_KVR  = WS_HM + (size_t)2560 * D * 2;
constexpr size_t WS_MEMK = WS_KVR + (size_t)2560 * 2048 * 4;
constexpr size_t WS_MEMV = WS_MEMK + (size_t)10 * 4 * 256 * 256 * 2;
constexpr size_t WS_END  = WS_MEMV + (size_t)10 * 4 * 256 * 256 * 2;

struct Params {
    const float* in[32];
    float* out;
    unsigned char* ws;
    int ph_lo, ph_hi;
};

typedef float f32x2 __attribute__((ext_vector_type(2)));
typedef __bf16 bf16x2v __attribute__((ext_vector_type(2)));
__device__ __forceinline__ unsigned pk2(float lo, float hi) { const f32x2 v = {lo, hi}; const bf16x2v b = __builtin_convertvector(v, bf16x2v); return __builtin_bit_cast(unsigned, b); }
__device__ __forceinline__ float bflo(unsigned u) { return __uint_as_float(u << 16); }
__device__ __forceinline__ float bfhi(unsigned u) { return __uint_as_float(u & 0xffff0000u); }
__device__ __forceinline__ float bf2f(bf16_t b) { return __uint_as_float(((unsigned)b) << 16); }
__device__ __forceinline__ bf16_t f2bf(float f) { return (bf16_t)(pk2(f, 0.f) & 0xffffu); }
__device__ __forceinline__ f32x4 mfma16(bf16x8 a, bf16x8 b, f32x4 c) { return __builtin_amdgcn_mfma_f32_16x16x32_bf16(a, b, c, 0, 0, 0); }
__device__ __forceinline__ float fexp2(float x) { return __builtin_amdgcn_exp2f(x); }
__device__ __forceinline__ int otid() { int t = threadIdx.x; asm volatile("" : "+v"(t)); return t; }
template <int M> __device__ __forceinline__ float sxor(float v) {
    if (M < 32) return __int_as_float(__builtin_amdgcn_ds_swizzle(__float_as_int(v), (M << 10) | 0x1F));
    const int l = otid() & 63; return __int_as_float(__builtin_amdgcn_ds_bpermute((l ^ 32) << 2, __float_as_int(v)));
}
template <int M> __device__ __forceinline__ unsigned sxoru(unsigned v) { return (unsigned)__builtin_amdgcn_ds_swizzle((int)v, (M << 10) | 0x1F); }
__device__ __forceinline__ float wave_sum(float v) {
    v += sxor<1>(v); v += sxor<2>(v); v += sxor<4>(v); v += sxor<8>(v); v += sxor<16>(v); v += sxor<32>(v);
    return v;
}

struct Grp { const float* x; const float* mem; float* out; int B, T, mb0; };
__device__ __forceinline__ Grp get_group(const Params& p, int g) {
    Grp r;
    if (g == 0) { r.x = p.in[I_XP]; r.out = p.out; r.B = 2; r.T = 16384; r.mb0 = 0; }
    else { r.x = p.in[I_XS] + (size_t)(g - 1) * G_TOK * D; r.out = p.out + (size_t)g * G_TOK * D; r.B = 4; r.T = 8192; r.mb0 = 2 + (g - 1) * 4; }
    r.mem = nullptr;
    return r;
}

constexpr int G_ROW = 144;
constexpr int G_A_BYTES = 128 * G_ROW;
constexpr int G_B_BYTES = 256 * G_ROW;
constexpr int G_STAGE = G_A_BYTES + G_B_BYTES;

template <bool SWAP>
__device__ __forceinline__ void gemm_kloop(f32x4 (&acc)[4][4], const bf16_t* __restrict__ A, int lda, const bf16_t* __restrict__ Bt, int ldb, int K, char* lds) {
    const int tid = otid(), lane = tid & 63, wid = tid >> 6, wm = wid >> 2, wn = wid & 3, fr = lane & 15, fq = lane >> 4;
    const int lr = tid >> 3, lc = tid & 7;
    u32x4 ra[2], rb[4];
    const bf16_t* Ap = A + (size_t)lr * lda + lc * 8;
    const bf16_t* Bp = Bt + (size_t)lr * ldb + lc * 8;
#define GLOAD(k0) do { _Pragma("unroll") for (int i = 0; i < 2; ++i) ra[i] = *(const u32x4*)(Ap + (size_t)(i * 64) * lda + (k0)); \
                       _Pragma("unroll") for (int i = 0; i < 4; ++i) rb[i] = *(const u32x4*)(Bp + (size_t)(i * 64) * ldb + (k0)); } while (0)
#define SWRITE(buf) do { char* b_ = lds + (buf) * G_STAGE + lr * G_ROW + lc * 16; \
                       _Pragma("unroll") for (int i = 0; i < 2; ++i) *(u32x4*)(b_ + i * 64 * G_ROW) = ra[i]; \
                       _Pragma("unroll") for (int i = 0; i < 4; ++i) *(u32x4*)(b_ + G_A_BYTES + i * 64 * G_ROW) = rb[i]; } while (0)
    const int nk = K / 64;
    GLOAD(0); SWRITE(0); __syncthreads();
    for (int kt = 0; kt < nk; ++kt) {
        if (kt + 1 < nk) GLOAD((kt + 1) * 64);
        const char* base = lds + (kt & 1) * G_STAGE;
#pragma unroll
        for (int ks = 0; ks < 2; ++ks) {
            bf16x8 af[4], bfr[4];
#pragma unroll
            for (int mt = 0; mt < 4; ++mt) af[mt] = *(const bf16x8*)(base + (wm * 64 + mt * 16 + fr) * G_ROW + ks * 64 + fq * 16);
#pragma unroll
            for (int nt = 0; nt < 4; ++nt) bfr[nt] = *(const bf16x8*)(base + G_A_BYTES + (wn * 64 + nt * 16 + fr) * G_ROW + ks * 64 + fq * 16);
#pragma unroll
            for (int mt = 0; mt < 4; ++mt)
#pragma unroll
                for (int nt = 0; nt < 4; ++nt)
                    acc[mt][nt] = SWAP ? mfma16(bfr[nt], af[mt], acc[mt][nt]) : mfma16(af[mt], bfr[nt], acc[mt][nt]);
        }
        if (kt + 1 < nk) SWRITE((kt + 1) & 1);
        __syncthreads();
    }
#undef GLOAD
#undef SWRITE
}

__device__ __forceinline__ void tile_order(int t, int nM, int nN, int& pm, int& pn) {
    const int per = 8 * nN, grp = t / per, r = t % per;
    pm = grp * 8 + (r & 7); pn = r >> 3;
}

__device__ __forceinline__ void phase_p0a(const Params& p, char* lds) {
    const int tid = otid(), lane = tid & 63, wid = tid >> 6;
    unsigned char* ws = p.ws;
    if (blockIdx.x == 0 && tid < 256) atomicExch((unsigned*)(ws + WS_CTRL) + tid, 0u);
    float* scr = (float*)(lds + wid * 8448);
    constexpr int IT_WIN = 16 * (NP / 32), IT_SQ = 16 * 32, IT_W2 = 16 * 64;
    constexpr int NIT = IT_WIN + 4 * IT_SQ + 2 * IT_W2;
    for (int it0 = blockIdx.x * 8; it0 < NIT; it0 += gridDim.x * 8) {
        int it = it0 + wid;
        const float* W = nullptr; bf16_t* WT = nullptr; int N = 0, nb = 0, kb = 0, srccol = -1;
        if (it < NIT) {
            int r = it;
            if (r < IT_WIN) { W = p.in[I_WIN]; N = IN_COLS; WT = (bf16_t*)(ws + WS_WINT); kb = r / (NP / 32); nb = r % (NP / 32);
                const int n0 = nb * 32; srccol = n0 < 3072 ? n0 : (n0 < 10240 ? n0 + 32 : (n0 == 10240 ? 3072 : -1)); }
            else { r -= IT_WIN;
                if (r < 4 * IT_SQ) { const int w = r / IT_SQ; r %= IT_SQ; const int idx[4] = {I_GWO, I_DWO, I_MWO, I_WOUT};
                    W = p.in[w == 0 ? I_GWO : (w == 1 ? I_DWO : (w == 2 ? I_MWO : I_WOUT))]; (void)idx; N = 1024; WT = (bf16_t*)(ws + WS_WOT) + (size_t)w * D * D; kb = r / 32; nb = r % 32; srccol = nb * 32; }
                else { r -= 4 * IT_SQ; const int w = r / IT_W2; r %= IT_W2; W = p.in[w == 0 ? I_MWKV : I_PWQ]; N = 2048; WT = (bf16_t*)(ws + (w == 0 ? WS_WKVT : WS_WQT)); kb = r / 64; nb = r % 64; srccol = nb * 32; }
            }
            const int k0 = kb * 64;
#pragma unroll 8
            for (int i = 0; i < 32; ++i) { const int kk = 2 * i + (lane >> 5); scr[kk * 33 + (lane & 31)] = srccol >= 0 ? W[(size_t)(k0 + kk) * N + srccol + (lane & 31)] : 0.f; }
        }
        __syncthreads();
        if (it < NIT) {
            const int k0 = kb * 64, c = lane & 7;
#pragma unroll
            for (int j = 0; j < 4; ++j) { const int n = (lane >> 3) + 8 * j; const float* s = scr + (8 * c) * 33 + n;
                u32x4 o; o.x = pk2(s[0], s[33]); o.y = pk2(s[66], s[99]); o.z = pk2(s[132], s[165]); o.w = pk2(s[198], s[231]);
                *(u32x4*)(WT + (size_t)(nb * 32 + n) * D + k0 + 8 * c) = o; }
        }
        __syncthreads();
    }
    const size_t gtid = (size_t)blockIdx.x * NTHR + tid, gsz = (size_t)gridDim.x * NTHR;
    {
        const size_t n8 = (size_t)16384 * D / 8;
        for (size_t i = gtid; i < 2 * n8; i += gsz) {
            const int w = i >= n8; const size_t j = w ? i - n8 : i;
            const float* src = p.in[w ? I_PV : I_PU] + j * 8; bf16_t* dst = (bf16_t*)(ws + (w ? WS_PV : WS_PU)) + j * 8;
            const f32x4 a = *(const f32x4*)src, b = *(const f32x4*)(src + 4);
            u32x4 o; o.x = pk2(a.x, a.y); o.y = pk2(a.z, a.w); o.z = pk2(b.x, b.y); o.w = pk2(b.z, b.w);
            *(u32x4*)dst = o;
        }
        for (size_t i = gtid; i < 2 * 16384; i += gsz) {
            const int w = i >= 16384; const size_t j = w ? i - 16384 : i;
            ((bf16_t*)(ws + WS_K12))[i] = f2bf(p.in[w ? I_PK2 : I_PK1][j]);
        }
    }
    for (size_t i = gtid; i < (size_t)16384 * 32; i += gsz) {
        const int t = (int)(i >> 5), k = (int)(i & 31);
        const float inv = powf(10000.0f, -(float)(2 * k) / 64.0f);
        const float ang = (float)t * inv;
        double sn, cs; sincos((double)ang, &sn, &cs);
        float* R = (float*)(ws + WS_ROPE) + (size_t)t * 64;
        R[k] = (float)cs; R[32 + k] = (float)sn;
    }
    for (int row = blockIdx.x * 8 + wid; row < 2560; row += gridDim.x * 8) {
        const float* src = row < 512 ? p.in[I_MP] + (size_t)row * D : p.in[I_MS] + (size_t)(row - 512) * D;
        const f32x4* xr = (const f32x4*)src + lane; const f32x4* gr = (const f32x4*)p.in[I_MGN] + lane;
        f32x4 v[4]; float s = 0.f;
#pragma unroll
        for (int j = 0; j < 4; ++j) { v[j] = xr[64 * j]; s += v[j].x * v[j].x + v[j].y * v[j].y + v[j].z * v[j].z + v[j].w * v[j].w; }
        const float r = rsqrtf(wave_sum(s) * (1.f / D) + RMS_EPS);
        u32x2* o = (u32x2*)((bf16_t*)(ws + WS_HM) + (size_t)row * D) + lane;
#pragma unroll
        for (int j = 0; j < 4; ++j) { const f32x4 g = gr[64 * j]; u32x2 w; w.x = pk2(v[j].x * r * g.x, v[j].y * r * g.y); w.y = pk2(v[j].z * r * g.z, v[j].w * r * g.w); o[64 * j] = w; }
    }
}

__device__ __forceinline__ void phase_p0b(const Params& p, char* lds) {
    const int tid_ = otid(), lane = tid_ & 63, wid = tid_ >> 6, wm = wid >> 2, wn = wid & 3, fr = lane & 15, fq = lane >> 4;
    const bf16_t* A = (const bf16_t*)(p.ws + WS_HM); const bf16_t* Bt = (const bf16_t*)(p.ws + WS_WKVT);
    float* C = (float*)(p.ws + WS_KVR);
    const int nM = 20, nN = 8;
    for (int t = blockIdx.x; t < nM * nN; t += gridDim.x) {
        const int pm = t % nM, pn = t / nM, m0 = pm * 128, n0 = pn * 256;
        f32x4 acc[4][4];
#pragma unroll
        for (int i = 0; i < 4; ++i)
#pragma unroll
            for (int j = 0; j < 4; ++j) acc[i][j] = (f32x4){0.f, 0.f, 0.f, 0.f};
        gemm_kloop<true>(acc, A + (size_t)m0 * D, D, Bt + (size_t)n0 * D, D, D, lds);
#pragma unroll
        for (int mt = 0; mt < 4; ++mt)
#pragma unroll
            for (int nt = 0; nt < 4; ++nt) {
                const int row = m0 + wm * 64 + mt * 16 + fr, col = n0 + wn * 64 + nt * 16 + fq * 4;
                *(f32x4*)(C + (size_t)row * 2048 + col) = acc[mt][nt];
            }
    }
}

__device__ __forceinline__ void phase_p0c(const Params& p) {
    const int tid_ = otid(), lane = tid_ & 63, wid = tid_ >> 6;
    const float* KV = (const float*)(p.ws + WS_KVR);
    bf16_t* MK = (bf16_t*)(p.ws + WS_MEMK); bf16_t* MV = (bf16_t*)(p.ws + WS_MEMV);
    for (int it = blockIdx.x * 8 + wid; it < 2560 * 4; it += gridDim.x * 8) {
        const int row = it >> 2, h = it & 3, b = row >> 8, m = row & 255;
        const f32x4 kv = *(const f32x4*)(KV + (size_t)row * 2048 + h * 256 + lane * 4);
        const float ss = wave_sum(kv.x * kv.x + kv.y * kv.y + kv.z * kv.z + kv.w * kv.w);
        const float r = rsqrtf(ss * (1.f / 256.f) + RMS_EPS);
        const f32x4 g = *(const f32x4*)(p.in[I_MGK] + lane * 4);
        u32x2 w; w.x = pk2(kv.x * r * g.x, kv.y * r * g.y); w.y = pk2(kv.z * r * g.z, kv.w * r * g.w);
        *(u32x2*)(MK + ((size_t)(b * 4 + h) * 256 + m) * 256 + lane * 4) = w;
        const f32x4 vv = *(const f32x4*)(KV + (size_t)row * 2048 + 1024 + h * 256 + lane * 4);
        const int pos = (m & ~31) + ((m >> 2) & 3) * 8 + ((m >> 4) & 1) * 4 + (m & 3);
        bf16_t* dst = MV + ((size_t)(b * 4 + h) * 256 + lane * 4) * 256 + pos;
        dst[0] = f2bf(vv.x); dst[256] = f2bf(vv.y); dst[512] = f2bf(vv.z); dst[768] = f2bf(vv.w);
    }
}

__device__ __forceinline__ void phase_rmsnorm(const float* X, const float* gain, bf16_t* O, int rows) {
    const int tid_ = otid(), lane = tid_ & 63, wid = tid_ >> 6;
    const f32x4* gr = (const f32x4*)gain + lane;
    f32x4 g[4];
#pragma unroll
    for (int j = 0; j < 4; ++j) g[j] = gr[64 * j];
    for (int row = blockIdx.x * 8 + wid; row < rows; row += gridDim.x * 8) {
        const f32x4* xr = (const f32x4*)(X + (size_t)row * D) + lane;
        f32x4 v[4]; float s = 0.f;
#pragma unroll
        for (int j = 0; j < 4; ++j) { v[j] = xr[64 * j]; s += v[j].x * v[j].x + v[j].y * v[j].y + v[j].z * v[j].z + v[j].w * v[j].w; }
        const float r = rsqrtf(wave_sum(s) * (1.f / D) + RMS_EPS);
        u32x2* o = (u32x2*)(O + (size_t)row * D) + lane;
#pragma unroll
        for (int j = 0; j < 4; ++j) { u32x2 w; w.x = pk2(v[j].x * r * g[j].x, v[j].y * r * g[j].y); w.y = pk2(v[j].z * r * g[j].z, v[j].w * r * g[j].w); o[64 * j] = w; }
    }
}

__device__ __forceinline__ void phase_inproj(const Params& p, int g, char* lds) {
    const Grp G = get_group(p, g);
    const int tid_ = otid(), lane = tid_ & 63, wid = tid_ >> 6, wm = wid >> 2, wn = wid & 3, fr = lane & 15, fq = lane >> 4;
    const bf16_t* A = (const bf16_t*)(p.ws + WS_HB); const bf16_t* Bt = (const bf16_t*)(p.ws + WS_WINT);
    bf16_t* P = (bf16_t*)(p.ws + WS_PROJ); bf16_t* VT = (bf16_t*)(p.ws + WS_VT);
    const int nM = G_TOK / 128, nN = NP / 256;
    for (int t = blockIdx.x; t < nM * nN; t += gridDim.x) {
        int pm, pn; tile_order(t, nM, nN, pm, pn);
        const int m0 = pm * 128, n0 = pn * 256;
        f32x4 acc[4][4];
#pragma unroll
        for (int i = 0; i < 4; ++i)
#pragma unroll
            for (int j = 0; j < 4; ++j) acc[i][j] = (f32x4){0.f, 0.f, 0.f, 0.f};
        if (n0 >= C_DV && n0 < C_DV + 1024) {
            gemm_kloop<false>(acc, A + (size_t)m0 * D, D, Bt + (size_t)n0 * D, D, D, lds);
            const int b = m0 / G.T, t0 = m0 % G.T + wm * 64;
#pragma unroll
            for (int mt = 0; mt < 4; ++mt)
#pragma unroll
                for (int nt = 0; nt < 4; ++nt) {
                    const int n = n0 - C_DV + wn * 64 + nt * 16 + fr, h = n >> 7, dv = n & 127;
                    const int pos = t0 + (mt >> 1) * 32 + fq * 8 + (mt & 1) * 4;
                    u32x2 w; w.x = pk2(acc[mt][nt].x, acc[mt][nt].y); w.y = pk2(acc[mt][nt].z, acc[mt][nt].w);
                    *(u32x2*)(VT + ((size_t)((b * 8 + h) * 128 + dv)) * G.T + pos) = w;
                }
        } else {
            gemm_kloop<true>(acc, A + (size_t)m0 * D, D, Bt + (size_t)n0 * D, D, D, lds);
            const float sc = n0 < 512 ? 0.08838834764831845f : 1.0f;
#pragma unroll
            for (int mt = 0; mt < 4; ++mt)
#pragma unroll
                for (int nt = 0; nt < 4; ++nt) {
                    const int row = m0 + wm * 64 + mt * 16 + fr, col = n0 + wn * 64 + nt * 16 + fq * 4;
                    u32x2 w; w.x = pk2(acc[mt][nt].x * sc, acc[mt][nt].y * sc); w.y = pk2(acc[mt][nt].z * sc, acc[mt][nt].w * sc);
                    *(u32x2*)(P + (size_t)row * NP + col) = w;
                }
        }
    }
}

__device__ __forceinline__ void phase_qkrope(const Params& p, int g) {
    const Grp G = get_group(p, g);
    const int tid_ = otid(), lane = tid_ & 63, wid = tid_ >> 6, grp = lane >> 2, sub = lane & 3;
    bf16_t* P = (bf16_t*)(p.ws + WS_PROJ); const float* ROPE = (const float*)(p.ws + WS_ROPE);
    for (int it = blockIdx.x * 8 + wid; it < G_TOK * 2; it += gridDim.x * 8) {
        const int tok = it >> 1, isk = it & 1, t = tok % G.T;
        bf16_t* base = P + (size_t)tok * NP + (isk ? C_DK : C_DQ) + grp * 64 + sub * 8;
        const u32x4 a = *(const u32x4*)base, b = *(const u32x4*)(base + 32);
        float x1[8], x2[8];
        x1[0] = bflo(a.x); x1[1] = bfhi(a.x); x1[2] = bflo(a.y); x1[3] = bfhi(a.y); x1[4] = bflo(a.z); x1[5] = bfhi(a.z); x1[6] = bflo(a.w); x1[7] = bfhi(a.w);
        x2[0] = bflo(b.x); x2[1] = bfhi(b.x); x2[2] = bflo(b.y); x2[3] = bfhi(b.y); x2[4] = bflo(b.z); x2[5] = bfhi(b.z); x2[6] = bflo(b.w); x2[7] = bfhi(b.w);
        float ss = 0.f;
#pragma unroll
        for (int e = 0; e < 8; ++e) ss += x1[e] * x1[e] + x2[e] * x2[e];
        ss += sxor<1>(ss); ss += sxor<2>(ss);
        const float r = rsqrtf(ss * (1.f / 64.f) + RMS_EPS) * (isk ? 1.0f : 0.125f * LOG2E);
        const float* gn = p.in[isk ? I_DGK : I_DGQ] + sub * 8;
        const float* rp = ROPE + (size_t)t * 64 + sub * 8;
        float o1[8], o2[8];
#pragma unroll
        for (int e = 0; e < 8; ++e) {
            const float y1 = x1[e] * r * gn[e], y2 = x2[e] * r * gn[32 + e], c = rp[e], s = rp[32 + e];
            o1[e] = y1 * c - y2 * s; o2[e] = y2 * c + y1 * s;
        }
        u32x4 w1, w2;
        w1.x = pk2(o1[0], o1[1]); w1.y = pk2(o1[2], o1[3]); w1.z = pk2(o1[4], o1[5]); w1.w = pk2(o1[6], o1[7]);
        w2.x = pk2(o2[0], o2[1]); w2.y = pk2(o2[2], o2[3]); w2.z = pk2(o2[4], o2[5]); w2.w = pk2(o2[6], o2[7]);
        *(u32x4*)base = w1; *(u32x4*)(base + 32) = w2;
    }
}

__device__ __forceinline__ void diff_attn_item(const Params& p, const Grp& G, int item, char* lds, float lam, float shift) {
    const int tid = otid(), lane = tid & 63, wid = tid >> 6, fr = lane & 15, fq = lane >> 4;
    const int c = wid & 1, sub = wid >> 1;
    const int T = G.T, nqb = T / 128;
    const int qb = item % nqb, bh = item / nqb, h = bh & 7, b = bh >> 3;
    bf16_t* P = (bf16_t*)(p.ws + WS_PROJ) + (size_t)b * T * NP;
    const bf16_t* Kg = P + C_DK + h * 128;
    const bf16_t* VTg = (const bf16_t*)(p.ws + WS_VT) + (size_t)bh * 128 * T;
    const int q0 = qb * 128 + sub * 32;
    bf16x8 qf[2][2];
#pragma unroll
    for (int nt = 0; nt < 2; ++nt)
#pragma unroll
        for (int ks = 0; ks < 2; ++ks) qf[nt][ks] = *(const bf16x8*)(P + (size_t)(q0 + nt * 16 + fr) * NP + C_DQ + h * 128 + c * 64 + ks * 32 + fq * 8);
    f32x4 o[8][2];
#pragma unroll
    for (int i = 0; i < 8; ++i) { o[i][0] = (f32x4){0.f, 0.f, 0.f, 0.f}; o[i][1] = (f32x4){0.f, 0.f, 0.f, 0.f}; }
    float l[2] = {0.f, 0.f};
    constexpr int STG = 36864, VOFF = 18432;
    u32x4 rk[2], rv[2];
    const int krow = tid >> 4, kch = tid & 15;
    const int vrow = tid >> 3, vch = tid & 7;
#define AGLOAD(kt) do { const int key0_ = (kt) * 64; \
        _Pragma("unroll") for (int i = 0; i < 2; ++i) rk[i] = *(const u32x4*)(Kg + (size_t)(key0_ + krow + i * 32) * NP + kch * 8); \
        _Pragma("unroll") for (int i = 0; i < 2; ++i) rv[i] = *(const u32x4*)(VTg + (size_t)(vrow + i * 64) * T + key0_ + vch * 8); } while (0)
#define ASWRITE(buf) do { char* b_ = lds + (buf) * STG; \
        _Pragma("unroll") for (int i = 0; i < 2; ++i) *(u32x4*)(b_ + ((kch >> 3) * 64 + krow + i * 32) * 144 + (kch & 7) * 16) = rk[i]; \
        _Pragma("unroll") for (int i = 0; i < 2; ++i) *(u32x4*)(b_ + VOFF + (vrow + i * 64) * 144 + vch * 16) = rv[i]; } while (0)
    const int nkt = T / 64;
    AGLOAD(0); ASWRITE(0); __syncthreads();
    for (int kt = 0; kt < nkt; ++kt) {
        if (kt + 1 < nkt) AGLOAD(kt + 1);
        const char* base = lds + (kt & 1) * STG;
        f32x4 s[4][2];
#pragma unroll
        for (int mt = 0; mt < 4; ++mt) { s[mt][0] = (f32x4){-shift, -shift, -shift, -shift}; s[mt][1] = s[mt][0]; }
#pragma unroll
        for (int ks = 0; ks < 2; ++ks)
#pragma unroll
            for (int mt = 0; mt < 4; ++mt) {
                const bf16x8 kf = *(const bf16x8*)(base + (c * 64 + mt * 16 + fr) * 144 + ks * 64 + fq * 16);
                s[mt][0] = mfma16(kf, qf[0][ks], s[mt][0]);
                s[mt][1] = mfma16(kf, qf[1][ks], s[mt][1]);
            }
        bf16x8 pf[2][2];
#pragma unroll
        for (int nt = 0; nt < 2; ++nt)
#pragma unroll
            for (int kk = 0; kk < 2; ++kk) {
                const f32x4 a = s[2 * kk][nt], bb = s[2 * kk + 1][nt];
                const float p0 = fexp2(a.x), p1 = fexp2(a.y), p2 = fexp2(a.z), p3 = fexp2(a.w);
                const float p4 = fexp2(bb.x), p5 = fexp2(bb.y), p6 = fexp2(bb.z), p7 = fexp2(bb.w);
                l[nt] += ((p0 + p1) + (p2 + p3)) + ((p4 + p5) + (p6 + p7));
                u32x4 w; w.x = pk2(p0, p1); w.y = pk2(p2, p3); w.z = pk2(p4, p5); w.w = pk2(p6, p7);
                pf[kk][nt] = __builtin_bit_cast(bf16x8, w);
            }
#pragma unroll
        for (int kk = 0; kk < 2; ++kk)
#pragma unroll
            for (int dvt = 0; dvt < 8; ++dvt) {
                const bf16x8 vf = *(const bf16x8*)(base + VOFF + (dvt * 16 + fr) * 144 + kk * 64 + fq * 16);
                o[dvt][0] = mfma16(vf, pf[kk][0], o[dvt][0]);
                o[dvt][1] = mfma16(vf, pf[kk][1], o[dvt][1]);
            }
        if (kt + 1 < nkt) ASWRITE((kt + 1) & 1);
        __syncthreads();
    }
#undef AGLOAD
#undef ASWRITE
    float inv[2];
#pragma unroll
    for (int nt = 0; nt < 2; ++nt) { float v = l[nt]; v += sxor<16>(v); v += sxor<32>(v); inv[nt] = 1.0f / v; }
    float* xch = (float*)lds + sub * 4096;
    if (c == 1) {
#pragma unroll
        for (int dvt = 0; dvt < 8; ++dvt)
#pragma unroll
            for (int nt = 0; nt < 2; ++nt) {
                xch[(dvt * 16 + fq * 4 + 0) * 32 + nt * 16 + fr] = o[dvt][nt].x * inv[nt];
                xch[(dvt * 16 + fq * 4 + 1) * 32 + nt * 16 + fr] = o[dvt][nt].y * inv[nt];
                xch[(dvt * 16 + fq * 4 + 2) * 32 + nt * 16 + fr] = o[dvt][nt].z * inv[nt];
                xch[(dvt * 16 + fq * 4 + 3) * 32 + nt * 16 + fr] = o[dvt][nt].w * inv[nt];
            }
    }
    __syncthreads();
    if (c == 0) {
        float ss[2] = {0.f, 0.f};
#pragma unroll
        for (int dvt = 0; dvt < 8; ++dvt)
#pragma unroll
            for (int nt = 0; nt < 2; ++nt) {
                f32x4 v = o[dvt][nt] * inv[nt];
                v.x -= lam * xch[(dvt * 16 + fq * 4 + 0) * 32 + nt * 16 + fr];
                v.y -= lam * xch[(dvt * 16 + fq * 4 + 1) * 32 + nt * 16 + fr];
                v.z -= lam * xch[(dvt * 16 + fq * 4 + 2) * 32 + nt * 16 + fr];
                v.w -= lam * xch[(dvt * 16 + fq * 4 + 3) * 32 + nt * 16 + fr];
                o[dvt][nt] = v; ss[nt] += v.x * v.x + v.y * v.y + v.z * v.z + v.w * v.w;
            }
#pragma unroll
        for (int nt = 0; nt < 2; ++nt) {
            float v = ss[nt]; v += sxor<16>(v); v += sxor<32>(v);
            const float r = rsqrtf(v * (1.f / 128.f) + RMS_EPS) * 0.8f;
#pragma unroll
            for (int dvt = 0; dvt < 8; ++dvt) {
                const f32x4 gs = *(const f32x4*)(p.in[I_DGSUB] + dvt * 16 + fq * 4);
                const f32x4 v4 = o[dvt][nt];
                u32x2 w; w.x = pk2(v4.x * r * gs.x, v4.y * r * gs.y); w.y = pk2(v4.z * r * gs.z, v4.w * r * gs.w);
                *(u32x2*)(P + (size_t)(q0 + nt * 16 + fr) * NP + C_DQ + h * 128 + dvt * 16 + fq * 4) = w;
            }
        }
    }
    __syncthreads();
}

__device__ __forceinline__ void mem_attn_item(const Params& p, const Grp& G, int item, char* lds, float shift) {
    const int tid = otid(), lane = tid & 63, wid = tid >> 6, fr = lane & 15, fq = lane >> 4;
    const int T = G.T, nqb = T / 128;
    const int qb = item % nqb, bh = item / nqb, h = bh & 3, b = bh >> 2;
    bf16_t* P = (bf16_t*)(p.ws + WS_PROJ) + (size_t)b * T * NP;
    const bf16_t* MK = (const bf16_t*)(p.ws + WS_MEMK) + (size_t)((G.mb0 + b) * 4 + h) * 256 * 256;
    const bf16_t* MV = (const bf16_t*)(p.ws + WS_MEMV) + (size_t)((G.mb0 + b) * 4 + h) * 256 * 256;
    const int row = qb * 128 + wid * 16 + fr;
    bf16_t* qp = P + (size_t)row * NP + C_MQ + h * 256;
    bf16x8 qf[8];
    {
        float ss = 0.f; u32x4 raw[8];
#pragma unroll
        for (int ks = 0; ks < 8; ++ks) { raw[ks] = *(const u32x4*)(qp + ks * 32 + fq * 8);
            const float a0 = bflo(raw[ks].x), a1 = bfhi(raw[ks].x), a2 = bflo(raw[ks].y), a3 = bfhi(raw[ks].y), a4 = bflo(raw[ks].z), a5 = bfhi(raw[ks].z), a6 = bflo(raw[ks].w), a7 = bfhi(raw[ks].w);
            ss += a0 * a0 + a1 * a1 + a2 * a2 + a3 * a3 + a4 * a4 + a5 * a5 + a6 * a6 + a7 * a7; }
        ss += sxor<16>(ss); ss += sxor<32>(ss);
        const float r = rsqrtf(ss * (1.f / 256.f) + RMS_EPS) * (0.0625f * LOG2E);
#pragma unroll
        for (int ks = 0; ks < 8; ++ks) {
            const f32x4 g0 = *(const f32x4*)(p.in[I_MGQ] + ks * 32 + fq * 8), g1 = *(const f32x4*)(p.in[I_MGQ] + ks * 32 + fq * 8 + 4);
            u32x4 w;
            w.x = pk2(bflo(raw[ks].x) * r * g0.x, bfhi(raw[ks].x) * r * g0.y); w.y = pk2(bflo(raw[ks].y) * r * g0.z, bfhi(raw[ks].y) * r * g0.w);
            w.z = pk2(bflo(raw[ks].z) * r * g1.x, bfhi(raw[ks].z) * r * g1.y); w.w = pk2(bflo(raw[ks].w) * r * g1.z, bfhi(raw[ks].w) * r * g1.w);
            qf[ks] = __builtin_bit_cast(bf16x8, w);
        }
    }
    f32x4 o[16];
#pragma unroll
    for (int i = 0; i < 16; ++i) o[i] = (f32x4){0.f, 0.f, 0.f, 0.f};
    float l = 0.f;
    constexpr int KROW = 528, VOFF = 64 * 528;
    for (int kt = 0; kt < 4; ++kt) {
#pragma unroll
        for (int i = 0; i < 4; ++i) {
            const int idx = tid + i * 512, r = idx >> 5, ch = idx & 31;
            *(u32x4*)(lds + r * KROW + ch * 16) = *(const u32x4*)(MK + (size_t)(kt * 64 + r) * 256 + ch * 8);
            const int vr = idx >> 3, vc = idx & 7;
            *(u32x4*)(lds + VOFF + vr * 144 + vc * 16) = *(const u32x4*)(MV + (size_t)vr * 256 + kt * 64 + vc * 8);
        }
        __syncthreads();
        f32x4 s[4];
#pragma unroll
        for (int mt = 0; mt < 4; ++mt) s[mt] = (f32x4){-shift, -shift, -shift, -shift};
#pragma unroll
        for (int ks = 0; ks < 8; ++ks)
#pragma unroll
            for (int mt = 0; mt < 4; ++mt) {
                const bf16x8 kf = *(const bf16x8*)(lds + (mt * 16 + fr) * KROW + ks * 64 + fq * 16);
                s[mt] = mfma16(kf, qf[ks], s[mt]);
            }
        bf16x8 pf[2];
#pragma unroll
        for (int kk = 0; kk < 2; ++kk) {
            const f32x4 a = s[2 * kk], bb = s[2 * kk + 1];
            const float p0 = fexp2(a.x), p1 = fexp2(a.y), p2 = fexp2(a.z), p3 = fexp2(a.w);
            const float p4 = fexp2(bb.x), p5 = fexp2(bb.y), p6 = fexp2(bb.z), p7 = fexp2(bb.w);
            l += ((p0 + p1) + (p2 + p3)) + ((p4 + p5) + (p6 + p7));
            u32x4 w; w.x = pk2(p0, p1); w.y = pk2(p2, p3); w.z = pk2(p4, p5); w.w = pk2(p6, p7);
            pf[kk] = __builtin_bit_cast(bf16x8, w);
        }
#pragma unroll
        for (int kk = 0; kk < 2; ++kk)
#pragma unroll
            for (int dvt = 0; dvt < 16; ++dvt) {
                const bf16x8 vf = *(const bf16x8*)(lds + VOFF + (dvt * 16 + fr) * 144 + kk * 64 + fq * 16);
                o[dvt] = mfma16(vf, pf[kk], o[dvt]);
            }
        __syncthreads();
    }
    l += sxor<16>(l); l += sxor<32>(l);
    const float inv = 1.0f / l;
#pragma unroll
    for (int dvt = 0; dvt < 16; ++dvt) {
        u32x2 w; w.x = pk2(o[dvt].x * inv, o[dvt].y * inv); w.y = pk2(o[dvt].z * inv, o[dvt].w * inv);
        *(u32x2*)(qp + dvt * 16 + fq * 4) = w;
    }
}

constexpr int L_QE = 0, L_KE = 17408, L_KST = 34816, L_VTL = 53248, L_ATT = 71680, L_SB = 80896, L_LRF = 115712, L_TOT = 119808, L_GDEC = 121856;
__device__ __forceinline__ void gla_item(const Params& p, const Grp& G, int item, char* lds) {
    const int tid = otid(), lane = tid & 63, wid = tid >> 6, fr = lane & 15, fq = lane >> 4;
    const int slice = item & 1, dir = (item >> 1) & 1, h = (item >> 2) & 3, b = item >> 4;
    const int T = G.T, N = T / 64;
    const bf16_t* P = (const bf16_t*)(p.ws + WS_PROJ) + (size_t)b * T * NP;
    bf16_t* OUT = dir ? (bf16_t*)(p.ws + WS_PROJ) + (size_t)b * T * NP + C_DV + h * 256 + slice * 128
                      : (bf16_t*)(p.ws + WS_HB) + (size_t)b * T * D + h * 256 + slice * 128;
    const int ldo = dir ? NP : D;
    const int d = tid & 127, rg = tid >> 7;
    float wdec[16];
    {
        const float* wd = p.in[dir ? I_WDB : I_WDF];
#pragma unroll
        for (int r = 0; r < 16; ++r) wdec[r] = wd[r * 512 + h * 128 + d];
    }
    const float bdec = p.in[dir ? I_BDB : I_BDF][h * 128 + d];
    for (int i = tid; i < 34816 / 16; i += NTHR) *(u32x4*)(lds + L_SB + i * 16) = (u32x4){0u, 0u, 0u, 0u};
    f32x4 S[8];
#pragma unroll
    for (int i = 0; i < 8; ++i) S[i] = (f32x4){0.f, 0.f, 0.f, 0.f};
    u32x4 rq[2], rk[2], rv[2], rl;
    const int lrow = tid >> 4, lch = tid & 15;
#define GGLOAD(n) do { const int cb_ = (dir ? (N - 1 - (n)) : (n)) * 64; \
        _Pragma("unroll") for (int i = 0; i < 2; ++i) { const int li_ = lrow + i * 32, tk_ = cb_ + (dir ? 63 - li_ : li_); const bf16_t* rp_ = P + (size_t)tk_ * NP; \
            rq[i] = *(const u32x4*)(rp_ + C_GQ + h * 128 + lch * 8); rk[i] = *(const u32x4*)(rp_ + C_GK + h * 128 + lch * 8); rv[i] = *(const u32x4*)(rp_ + C_GV + h * 256 + slice * 128 + lch * 8); } \
        if (tid < 128) { const int li_ = tid >> 1, tk_ = cb_ + (dir ? 63 - li_ : li_); rl = *(const u32x4*)(P + (size_t)tk_ * NP + C_LR + dir * 16 + (tid & 1) * 8); } } while (0)
    GGLOAD(0);
    for (int n = 0; n < N; ++n) {
#pragma unroll
        for (int i = 0; i < 2; ++i) {
            const int li = lrow + i * 32;
            *(u32x4*)(lds + L_QE + li * 272 + lch * 16) = rq[i];
            *(u32x4*)(lds + L_KE + li * 272 + lch * 16) = rk[i];
            bf16_t* vt = (bf16_t*)(lds + L_VTL) + (lch * 8) * 72 + li;
            vt[0 * 72] = (bf16_t)(rv[i].x & 0xffff); vt[1 * 72] = (bf16_t)(rv[i].x >> 16); vt[2 * 72] = (bf16_t)(rv[i].y & 0xffff); vt[3 * 72] = (bf16_t)(rv[i].y >> 16);
            vt[4 * 72] = (bf16_t)(rv[i].z & 0xffff); vt[5 * 72] = (bf16_t)(rv[i].z >> 16); vt[6 * 72] = (bf16_t)(rv[i].w & 0xffff); vt[7 * 72] = (bf16_t)(rv[i].w >> 16);
        }
        if (tid < 128) {
            float* lf = (float*)(lds + L_LRF) + (tid >> 1) * 16 + (tid & 1) * 8;
            *(f32x4*)lf = (f32x4){bflo(rl.x), bfhi(rl.x), bflo(rl.y), bfhi(rl.y)};
            *(f32x4*)(lf + 4) = (f32x4){bflo(rl.z), bfhi(rl.z), bflo(rl.w), bfhi(rl.w)};
        }
        if (n + 1 < N) GGLOAD(n + 1);
        __syncthreads();
        float cs[16]; float run = 0.f;
#pragma unroll
        for (int ii = 0; ii < 16; ++ii) {
            const float* lf = (const float*)(lds + L_LRF) + (rg * 16 + ii) * 16;
            const f32x4 a0 = *(const f32x4*)lf, a1 = *(const f32x4*)(lf + 4), a2 = *(const f32x4*)(lf + 8), a3 = *(const f32x4*)(lf + 12);
            float x = bdec;
            x += a0.x * wdec[0] + a0.y * wdec[1] + a0.z * wdec[2] + a0.w * wdec[3];
            x += a1.x * wdec[4] + a1.y * wdec[5] + a1.z * wdec[6] + a1.w * wdec[7];
            x += a2.x * wdec[8] + a2.y * wdec[9] + a2.z * wdec[10] + a2.w * wdec[11];
            x += a3.x * wdec[12] + a3.y * wdec[13] + a3.z * wdec[14] + a3.w * wdec[15];
            const float ls = fminf(x, 0.f) - __logf(1.0f + __expf(-fabsf(x)));
            run += ls * 0.0625f; cs[ii] = run;
        }
        ((float*)(lds + L_TOT))[rg * 128 + d] = run;
        __syncthreads();
        float off = 0.f, blast = 0.f;
#pragma unroll
        for (int r = 0; r < 4; ++r) { const float tv = ((const float*)(lds + L_TOT))[r * 128 + d]; blast += tv; if (r < rg) off += tv; }
        {
            bf16_t* qe = (bf16_t*)(lds + L_QE) + d; bf16_t* ke = (bf16_t*)(lds + L_KE) + d;
            unsigned ksp[8];
#pragma unroll
            for (int ii = 0; ii < 16; ii += 2) {
                const int i0 = rg * 16 + ii;
                const float b0 = off + cs[ii], b1 = off + cs[ii + 1];
                const float q0v = bf2f(qe[i0 * 136]), q1v = bf2f(qe[(i0 + 1) * 136]), k0v = bf2f(ke[i0 * 136]), k1v = bf2f(ke[(i0 + 1) * 136]);
                qe[i0 * 136] = f2bf(q0v * __expf(b0)); qe[(i0 + 1) * 136] = f2bf(q1v * __expf(b1));
                ke[i0 * 136] = f2bf(k0v * __expf(-b0)); ke[(i0 + 1) * 136] = f2bf(k1v * __expf(-b1));
                ksp[ii >> 1] = pk2(k0v * __expf(blast - b0), k1v * __expf(blast - b1));
            }
            char* kst = lds + L_KST + d * 144 + rg * 32;
            *(u32x4*)kst = (u32x4){ksp[0], ksp[1], ksp[2], ksp[3]};
            *(u32x4*)(kst + 16) = (u32x4){ksp[4], ksp[5], ksp[6], ksp[7]};
            if (rg == 0) ((float*)(lds + L_GDEC))[d] = __expf(blast);
        }
        __syncthreads();
        {
            const int ct = wid & 3;
            f32x4 a[2] = {(f32x4){0.f, 0.f, 0.f, 0.f}, (f32x4){0.f, 0.f, 0.f, 0.f}};
#pragma unroll
            for (int ks = 0; ks < 4; ++ks) {
                const bf16x8 qv = *(const bf16x8*)(lds + L_QE + (ct * 16 + fr) * 272 + ks * 64 + fq * 16);
#pragma unroll
                for (int j = 0; j < 2; ++j) {
                    const int st = (wid >> 2) * 2 + j;
                    const bf16x8 kv = *(const bf16x8*)(lds + L_KE + (st * 16 + fr) * 272 + ks * 64 + fq * 16);
                    a[j] = mfma16(kv, qv, a[j]);
                }
            }
#pragma unroll
            for (int j = 0; j < 2; ++j) {
                const int st = (wid >> 2) * 2 + j, cc = ct * 16 + fr, s0 = st * 16 + fq * 4;
                const float v0 = (s0 + 0 <= cc) ? a[j].x : 0.f, v1 = (s0 + 1 <= cc) ? a[j].y : 0.f, v2 = (s0 + 2 <= cc) ? a[j].z : 0.f, v3 = (s0 + 3 <= cc) ? a[j].w : 0.f;
                *(u32x2*)(lds + L_ATT + cc * 144 + s0 * 2) = (u32x2){pk2(v0, v1), pk2(v2, v3)};
            }
        }
        __syncthreads();
        {
            f32x4 oc[4] = {(f32x4){0.f, 0.f, 0.f, 0.f}, (f32x4){0.f, 0.f, 0.f, 0.f}, (f32x4){0.f, 0.f, 0.f, 0.f}, (f32x4){0.f, 0.f, 0.f, 0.f}};
#pragma unroll
            for (int ks = 0; ks < 2; ++ks) {
                const bf16x8 af = *(const bf16x8*)(lds + L_VTL + (wid * 16 + fr) * 144 + ks * 64 + fq * 16);
#pragma unroll
                for (int ct = 0; ct < 4; ++ct) { const bf16x8 bfv = *(const bf16x8*)(lds + L_ATT + (ct * 16 + fr) * 144 + ks * 64 + fq * 16); oc[ct] = mfma16(af, bfv, oc[ct]); }
            }
#pragma unroll
            for (int ks = 0; ks < 4; ++ks) {
                const bf16x8 af = *(const bf16x8*)(lds + L_SB + (wid * 16 + fr) * 272 + ks * 64 + fq * 16);
#pragma unroll
                for (int ct = 0; ct < 4; ++ct) { const bf16x8 bfv = *(const bf16x8*)(lds + L_QE + (ct * 16 + fr) * 272 + ks * 64 + fq * 16); oc[ct] = mfma16(af, bfv, oc[ct]); }
            }
            const int cb = (dir ? (N - 1 - n) : n) * 64;
#pragma unroll
            for (int ct = 0; ct < 4; ++ct) {
                const int cl = ct * 16 + fr, tk = cb + (dir ? 63 - cl : cl);
                *(u32x2*)(OUT + (size_t)tk * ldo + wid * 16 + fq * 4) = (u32x2){pk2(oc[ct].x, oc[ct].y), pk2(oc[ct].z, oc[ct].w)};
            }
        }
        __syncthreads();
        {
            const f32x4 gd = *(const f32x4*)((const float*)(lds + L_GDEC) + wid * 16 + fq * 4);
#pragma unroll
            for (int et = 0; et < 8; ++et) S[et] = S[et] * gd;
#pragma unroll
            for (int ks = 0; ks < 2; ++ks) {
                const bf16x8 af = *(const bf16x8*)(lds + L_KST + (wid * 16 + fr) * 144 + ks * 64 + fq * 16);
#pragma unroll
                for (int et = 0; et < 8; ++et) { const bf16x8 bfv = *(const bf16x8*)(lds + L_VTL + (et * 16 + fr) * 144 + ks * 64 + fq * 16); S[et] = mfma16(af, bfv, S[et]); }
            }
#pragma unroll
            for (int et = 0; et < 8; ++et)
                *(u32x2*)(lds + L_SB + (et * 16 + fr) * 272 + (wid * 16 + fq * 4) * 2) = (u32x2){pk2(S[et].x, S[et].y), pk2(S[et].z, S[et].w)};
        }
        __syncthreads();
    }
#undef GGLOAD
}

__device__ __forceinline__ void phase_mixer(const Params& p, int g, char* lds, int* s_item) {
    const Grp G = get_group(p, g);
    const int nGLA = G.B * 16, nATT = G.B * 8 * (G.T / 128), nMEM = G.B * 4 * (G.T / 128), nTot = nGLA + nATT + nMEM;
    unsigned* ctr = (unsigned*)(p.ws + WS_CTRL) + g;
    float d1 = 0.f, d2 = 0.f, mq = 0.f, mk = 0.f, mmq = 0.f, mmk = 0.f;
    for (int i = 0; i < 64; ++i) { d1 += p.in[I_LQ1][i] * p.in[I_LK1][i]; d2 += p.in[I_LQ2][i] * p.in[I_LK2][i]; mq = fmaxf(mq, fabsf(p.in[I_DGQ][i])); mk = fmaxf(mk, fabsf(p.in[I_DGK][i])); }
    for (int i = 0; i < 256; ++i) { mmq = fmaxf(mmq, fabsf(p.in[I_MGQ][i])); mmk = fmaxf(mmk, fabsf(p.in[I_MGK][i])); }
    const float lam = expf(d1) - expf(d2) + 0.2f;
    const float shiftD = fmaxf(0.f, 8.f * mq * mk * LOG2E - 64.f), shiftM = fmaxf(0.f, 16.f * mmq * mmk * LOG2E - 64.f);
#ifndef STATIC_SCHED
#define STATIC_SCHED 0
#endif
    for (int sit = blockIdx.x;; sit += gridDim.x) {
#if STATIC_SCHED
        (void)ctr; (void)s_item;
        const int it = sit;
#else
        if (threadIdx.x == 0) *s_item = (int)atomicAdd(ctr, 1u);
        __syncthreads();
        const int it = *s_item;
        __syncthreads();
#endif
        if (it >= nTot) break;
        if (it < nGLA) gla_item(p, G, it, lds);
        else if (it < nGLA + nATT) diff_attn_item(p, G, it - nGLA, lds, lam, shiftD);
        else mem_attn_item(p, G, it - nGLA - nATT, lds, shiftM);
    }
}

__device__ __forceinline__ void phase_glafin(const Params& p, int g) {
    const int tid_ = otid(), lane = tid_ & 63, wid = tid_ >> 6;
    bf16_t* P = (bf16_t*)(p.ws + WS_PROJ); const bf16_t* F = (const bf16_t*)(p.ws + WS_HB);
    for (int it = blockIdx.x * 8 + wid; it < G_TOK * 4; it += gridDim.x * 8) {
        const int tok = it >> 2, h = it & 3;
        bf16_t* row = P + (size_t)tok * NP;
        const unsigned qq = *(const unsigned*)(row + C_GQ + h * 128 + lane * 2), kk = *(const unsigned*)(row + C_GK + h * 128 + lane * 2);
        const float qk = wave_sum(bflo(qq) * bflo(kk) + bfhi(qq) * bfhi(kk));
        const u32x2 f = *(const u32x2*)(F + (size_t)tok * D + h * 256 + lane * 4), bk = *(const u32x2*)(row + C_DV + h * 256 + lane * 4);
        const u32x2 v = *(const u32x2*)(row + C_GV + h * 256 + lane * 4), gt = *(const u32x2*)(row + C_GG + h * 256 + lane * 4);
        float o0 = bflo(f.x) + bflo(bk.x) - qk * bflo(v.x), o1 = bfhi(f.x) + bfhi(bk.x) - qk * bfhi(v.x);
        float o2 = bflo(f.y) + bflo(bk.y) - qk * bflo(v.y), o3 = bfhi(f.y) + bfhi(bk.y) - qk * bfhi(v.y);
        const float r = rsqrtf(wave_sum(o0 * o0 + o1 * o1 + o2 * o2 + o3 * o3) * (1.f / 256.f) + RMS_EPS);
        const f32x4 go = *(const f32x4*)(p.in[I_GOUT] + lane * 4);
        const float g0 = bflo(gt.x), g1 = bfhi(gt.x), g2 = bflo(gt.y), g3 = bfhi(gt.y);
        o0 *= r * go.x * g0 / (1.f + __expf(-g0)); o1 *= r * go.y * g1 / (1.f + __expf(-g1));
        o2 *= r * go.z * g2 / (1.f + __expf(-g2)); o3 *= r * go.w * g3 / (1.f + __expf(-g3));
        *(u32x2*)(row + C_GG + h * 256 + lane * 4) = (u32x2){pk2(o0, o1), pk2(o2, o3)};
    }
}

__device__ __forceinline__ void phase_merge(const Params& p, int g, char* lds) {
    const int tid_ = otid(), lane = tid_ & 63, wid = tid_ >> 6, wm = wid >> 2, wn = wid & 3, fr = lane & 15, fq = lane >> 4;
    const bf16_t* P = (const bf16_t*)(p.ws + WS_PROJ); bf16_t* M = (bf16_t*)(p.ws + WS_VT);
    const int nM = G_TOK / 128, nN = 4;
    for (int t = blockIdx.x; t < nM * nN; t += gridDim.x) {
        int pm, pn; tile_order(t, nM, nN, pm, pn);
        const int m0 = pm * 128, n0 = pn * 256;
        f32x4 macc[4][4];
#pragma unroll
        for (int i = 0; i < 4; ++i)
#pragma unroll
            for (int j = 0; j < 4; ++j) macc[i][j] = (f32x4){0.f, 0.f, 0.f, 0.f};
        for (int br = 0; br < 3; ++br) {
            f32x4 acc[4][4];
#pragma unroll
            for (int i = 0; i < 4; ++i)
#pragma unroll
                for (int j = 0; j < 4; ++j) acc[i][j] = (f32x4){0.f, 0.f, 0.f, 0.f};
            const int acol = br == 0 ? C_GG : (br == 1 ? C_DQ : C_MQ);
            gemm_kloop<true>(acc, P + (size_t)m0 * NP + acol, NP, (const bf16_t*)(p.ws + WS_WOT) + (size_t)br * D * D + (size_t)n0 * D, D, D, lds);
#pragma unroll
            for (int mt = 0; mt < 4; ++mt)
#pragma unroll
                for (int nt = 0; nt < 4; ++nt) {
                    const int row = m0 + wm * 64 + mt * 16 + fr, col = n0 + wn * 64 + nt * 16 + fq * 4;
                    const u32x2 gt = *(const u32x2*)(P + (size_t)row * NP + C_BG + br * 1024 + col);
                    f32x4 sg; sg.x = 1.f / (1.f + __expf(-bflo(gt.x))); sg.y = 1.f / (1.f + __expf(-bfhi(gt.x))); sg.z = 1.f / (1.f + __expf(-bflo(gt.y))); sg.w = 1.f / (1.f + __expf(-bfhi(gt.y)));
                    macc[mt][nt] += sg * acc[mt][nt];
                }
        }
#pragma unroll
        for (int mt = 0; mt < 4; ++mt)
#pragma unroll
            for (int nt = 0; nt < 4; ++nt) {
                const int row = m0 + wm * 64 + mt * 16 + fr, col = n0 + wn * 64 + nt * 16 + fq * 4;
                *(u32x2*)(M + (size_t)row * D + col) = (u32x2){pk2(macc[mt][nt].x, macc[mt][nt].y), pk2(macc[mt][nt].z, macc[mt][nt].w)};
            }
    }
}

__device__ __forceinline__ void phase_outproj(const Params& p, int g, char* lds) {
    const Grp G = get_group(p, g);
    const int tid_ = otid(), lane = tid_ & 63, wid = tid_ >> 6, wm = wid >> 2, wn = wid & 3, fr = lane & 15, fq = lane >> 4;
    const bf16_t* M = (const bf16_t*)(p.ws + WS_VT); const bf16_t* W = (const bf16_t*)(p.ws + WS_WOT) + (size_t)3 * D * D;
    const int nM = G_TOK / 128, nN = 4;
    for (int t = blockIdx.x; t < nM * nN; t += gridDim.x) {
        int pm, pn; tile_order(t, nM, nN, pm, pn);
        const int m0 = pm * 128, n0 = pn * 256;
        f32x4 acc[4][4];
#pragma unroll
        for (int i = 0; i < 4; ++i)
#pragma unroll
            for (int j = 0; j < 4; ++j) acc[i][j] = (f32x4){0.f, 0.f, 0.f, 0.f};
        gemm_kloop<true>(acc, M + (size_t)m0 * D, D, W + (size_t)n0 * D, D, D, lds);
#pragma unroll
        for (int mt = 0; mt < 4; ++mt)
#pragma unroll
            for (int nt = 0; nt < 4; ++nt) {
                const int row = m0 + wm * 64 + mt * 16 + fr, col = n0 + wn * 64 + nt * 16 + fq * 4;
                const f32x4 xv = *(const f32x4*)(G.x + (size_t)row * D + col);
                *(f32x4*)(G.out + (size_t)row * D + col) = xv + acc[mt][nt];
            }
    }
}

__device__ __forceinline__ void phase_peerq(const Params& p, int g, char* lds) {
    const int tid_ = otid(), lane = tid_ & 63, wid = tid_ >> 6, wm = wid >> 2, wn = wid & 3, fr = lane & 15, fq = lane >> 4;
    const bf16_t* A = (const bf16_t*)(p.ws + WS_HB); const bf16_t* W = (const bf16_t*)(p.ws + WS_WQT); bf16_t* P = (bf16_t*)(p.ws + WS_PROJ);
    const int nM = G_TOK / 128, nN = 8;
    for (int t = blockIdx.x; t < nM * nN; t += gridDim.x) {
        int pm, pn; tile_order(t, nM, nN, pm, pn);
        const int m0 = pm * 128, n0 = pn * 256;
        f32x4 acc[4][4];
#pragma unroll
        for (int i = 0; i < 4; ++i)
#pragma unroll
            for (int j = 0; j < 4; ++j) acc[i][j] = (f32x4){0.f, 0.f, 0.f, 0.f};
        gemm_kloop<true>(acc, A + (size_t)m0 * D, D, W + (size_t)n0 * D, D, D, lds);
#pragma unroll
        for (int mt = 0; mt < 4; ++mt)
#pragma unroll
            for (int nt = 0; nt < 4; ++nt) {
                const int row = m0 + wm * 64 + mt * 16 + fr, col = n0 + wn * 64 + nt * 16 + fq * 4;
                *(u32x2*)(P + (size_t)row * NP + col) = (u32x2){pk2(acc[mt][nt].x, acc[mt][nt].y), pk2(acc[mt][nt].z, acc[mt][nt].w)};
            }
    }
}

__device__ __forceinline__ unsigned f2ord(float f) { const unsigned u = __float_as_uint(f); return (u & 0x80000000u) ? ~u : (u | 0x80000000u); }
__device__ __forceinline__ float ord2f(unsigned k) { const unsigned u = (k & 0x80000000u) ? (k & 0x7fffffffu) : ~k; return __uint_as_float(u); }
__device__ __forceinline__ unsigned gmax16(unsigned v) {
    unsigned t;
    t = sxoru<1>(v); v = v > t ? v : t; t = sxoru<2>(v); v = v > t ? v : t; t = sxoru<4>(v); v = v > t ? v : t; t = sxoru<8>(v); v = v > t ? v : t;
    return v;
}
__device__ __forceinline__ float gsum16(float v) { v += sxor<1>(v); v += sxor<2>(v); v += sxor<4>(v); v += sxor<8>(v); return v; }
__device__ __forceinline__ float gelu_exact(float a) { return 0.5f * a * (1.0f + erff(a * 0.70710678118654752f)); }

__device__ __forceinline__ void phase_peer(const Params& p, int g, char* lds) {
    const Grp G = get_group(p, g);
    const int tid = otid(), lane = tid & 63, wid = tid >> 6, fr = lane & 15, fq = lane >> 4;
    const bf16_t* P = (const bf16_t*)(p.ws + WS_PROJ); const bf16_t* HB = (const bf16_t*)(p.ws + WS_HB);
    const bf16_t* K12 = (const bf16_t*)(p.ws + WS_K12);
    const bf16_t* PU = (const bf16_t*)(p.ws + WS_PU); const bf16_t* PV = (const bf16_t*)(p.ws + WS_PV);
    float* SC = (float*)lds;
    int* EIDX = (int*)(lds + 65536);
    float* GATE = (float*)(lds + 65536 + 4096);
    for (int tile = blockIdx.x; tile < G_TOK / 8; tile += gridDim.x) {
        const int tok0 = tile * 8;
        {
            const int mt = wid >> 1, half = wid & 1;
            const int r = mt * 16 + fr, tl = r >> 3, hh = r & 7;
            const bf16_t* qrow = P + (size_t)(tok0 + tl) * NP + hh * 256 + half * 128;
            const bf16_t* kb = K12 + half * 16384;
            f32x4 acc[8];
#pragma unroll
            for (int i = 0; i < 8; ++i) acc[i] = (f32x4){0.f, 0.f, 0.f, 0.f};
#pragma unroll
            for (int ks = 0; ks < 4; ++ks) {
                const bf16x8 af = *(const bf16x8*)(qrow + ks * 32 + fq * 8);
#pragma unroll
                for (int nt = 0; nt < 8; ++nt) { const bf16x8 bfv = *(const bf16x8*)(kb + (nt * 16 + fr) * 128 + ks * 32 + fq * 8); acc[nt] = mfma16(af, bfv, acc[nt]); }
            }
#pragma unroll
            for (int nt = 0; nt < 8; ++nt) {
                float* dst = SC + (mt * 16 + fq * 4) * 256 + half * 128 + nt * 16 + fr;
                dst[0] = acc[nt].x; dst[256] = acc[nt].y; dst[512] = acc[nt].z; dst[768] = acc[nt].w;
            }
        }
        __syncthreads();
        for (int pass = 0; pass < 2; ++pass) {
            const int row = wid * 8 + pass * 4 + fq, sl = fr, gb = fq * 16;
            float v1 = 0.f, v2 = 0.f; int i1 = 0, i2 = 0;
#pragma unroll
            for (int hf = 0; hf < 2; ++hf) {
                unsigned key[8];
#pragma unroll
                for (int i = 0; i < 8; ++i) { const int idx = sl + 16 * i; key[i] = (f2ord(SC[row * 256 + hf * 128 + idx]) & ~127u) | (unsigned)(127 - idx); }
                float sv = 0.f; int si = 0;
                for (int r = 0; r < 16; ++r) {
                    unsigned m = key[0];
#pragma unroll
                    for (int i = 1; i < 8; ++i) m = m > key[i] ? m : key[i];
                    m = gmax16(m);
                    if (sl == r) { sv = ord2f(m & ~127u); si = 127 - (int)(m & 127u); }
#pragma unroll
                    for (int i = 0; i < 8; ++i) key[i] = key[i] == m ? 0u : key[i];
                }
                if (hf == 0) { v1 = sv; i1 = si; } else { v2 = sv; i2 = si; }
            }
            int ptr = 0; float ts = 0.f; int pid = 0;
            for (int r = 0; r < 16; ++r) {
                const float v2p = __shfl(v2, gb + (ptr & 15));
                const unsigned key = ptr < 16 ? ((f2ord(v1 + v2p) & ~255u) | (unsigned)(255 - (sl * 16 + ptr))) : 0u;
                const unsigned m = gmax16(key);
                if (sl == r) { ts = ord2f(m & ~255u); pid = 255 - (int)(m & 255u); }
                if (key == m) ptr++;
            }
            const int e1 = __shfl(i1, gb + (pid >> 4)), e2 = __shfl(i2, gb + (pid & 15));
            float mx = ts;
            mx = fmaxf(mx, sxor<1>(mx)); mx = fmaxf(mx, sxor<2>(mx)); mx = fmaxf(mx, sxor<4>(mx)); mx = fmaxf(mx, sxor<8>(mx));
            const float ex = __expf(ts - mx), sm = gsum16(ex);
            EIDX[row * 16 + sl] = e1 * 128 + e2; GATE[row * 16 + sl] = ex / sm;
        }
        __syncthreads();
        {
            const int tok = tok0 + wid;
            const bf16_t* hrow = HB + (size_t)tok * D;
            const u32x4 h0 = *(const u32x4*)(hrow + lane * 8), h1 = *(const u32x4*)(hrow + 512 + lane * 8);
            float hv[16];
            hv[0] = bflo(h0.x); hv[1] = bfhi(h0.x); hv[2] = bflo(h0.y); hv[3] = bfhi(h0.y); hv[4] = bflo(h0.z); hv[5] = bfhi(h0.z); hv[6] = bflo(h0.w); hv[7] = bfhi(h0.w);
            hv[8] = bflo(h1.x); hv[9] = bfhi(h1.x); hv[10] = bflo(h1.y); hv[11] = bfhi(h1.y); hv[12] = bflo(h1.z); hv[13] = bfhi(h1.z); hv[14] = bflo(h1.w); hv[15] = bfhi(h1.w);
            float acc[16];
#pragma unroll
            for (int i = 0; i < 16; ++i) acc[i] = 0.f;
#pragma unroll 4
            for (int k = 0; k < 128; ++k) {
                const int e = EIDX[wid * 128 + k]; const float gt = GATE[wid * 128 + k];
                const bf16_t* ur = PU + (size_t)e * D; const bf16_t* vr = PV + (size_t)e * D;
                const u32x4 u0 = *(const u32x4*)(ur + lane * 8), u1 = *(const u32x4*)(ur + 512 + lane * 8);
                const u32x4 w0 = *(const u32x4*)(vr + lane * 8), w1 = *(const u32x4*)(vr + 512 + lane * 8);
                float a = bflo(u0.x) * hv[0] + bfhi(u0.x) * hv[1] + bflo(u0.y) * hv[2] + bfhi(u0.y) * hv[3] + bflo(u0.z) * hv[4] + bfhi(u0.z) * hv[5] + bflo(u0.w) * hv[6] + bfhi(u0.w) * hv[7]
                        + bflo(u1.x) * hv[8] + bfhi(u1.x) * hv[9] + bflo(u1.y) * hv[10] + bfhi(u1.y) * hv[11] + bflo(u1.z) * hv[12] + bfhi(u1.z) * hv[13] + bflo(u1.w) * hv[14] + bfhi(u1.w) * hv[15];
                a = wave_sum(a);
                const float w = gt * gelu_exact(a);
                acc[0] += w * bflo(w0.x); acc[1] += w * bfhi(w0.x); acc[2] += w * bflo(w0.y); acc[3] += w * bfhi(w0.y);
                acc[4] += w * bflo(w0.z); acc[5] += w * bfhi(w0.z); acc[6] += w * bflo(w0.w); acc[7] += w * bfhi(w0.w);
                acc[8] += w * bflo(w1.x); acc[9] += w * bfhi(w1.x); acc[10] += w * bflo(w1.y); acc[11] += w * bfhi(w1.y);
                acc[12] += w * bflo(w1.z); acc[13] += w * bfhi(w1.z); acc[14] += w * bflo(w1.w); acc[15] += w * bfhi(w1.w);
            }
            float* orow = G.out + (size_t)tok * D;
            f32x4* o0 = (f32x4*)(orow + lane * 8); f32x4* o1 = (f32x4*)(orow + 512 + lane * 8);
            f32x4 t;
#define SAN(v) (v)
            t = o0[0]; t.x += acc[0]; t.y += acc[1]; t.z += acc[2]; t.w += acc[3]; t.x = SAN(t.x); t.y = SAN(t.y); t.z = SAN(t.z); t.w = SAN(t.w); o0[0] = t;
            t = o0[1]; t.x += acc[4]; t.y += acc[5]; t.z += acc[6]; t.w += acc[7]; t.x = SAN(t.x); t.y = SAN(t.y); t.z = SAN(t.z); t.w = SAN(t.w); o0[1] = t;
            t = o1[0]; t.x += acc[8]; t.y += acc[9]; t.z += acc[10]; t.w += acc[11]; t.x = SAN(t.x); t.y = SAN(t.y); t.z = SAN(t.z); t.w = SAN(t.w); o1[0] = t;
            t = o1[1]; t.x += acc[12]; t.y += acc[13]; t.z += acc[14]; t.w += acc[15]; t.x = SAN(t.x); t.y = SAN(t.y); t.z = SAN(t.z); t.w = SAN(t.w); o1[1] = t;
        }
        __syncthreads();
    }
}


#ifndef DEBUG_NAN
#define DEBUG_NAN 0
#endif
#if DEBUG_NAN
__device__ __noinline__ void scan_bf16(const bf16_t* base, size_t rows, size_t pitch, int col0, int ncols, unsigned* flag) {
    const size_t gtid = (size_t)blockIdx.x * NTHR + threadIdx.x, gsz = (size_t)gridDim.x * NTHR, cpr = ncols / 8, total = rows * cpr;
    bool bad = false;
    for (size_t i = gtid; i < total; i += gsz) {
        const size_t r = i / cpr, c = i % cpr;
        const u32x4 v = *(const u32x4*)(base + r * pitch + col0 + c * 8);
        bad = bad || ((v.x & 0x7F80u) == 0x7F80u) || ((v.x & 0x7F800000u) == 0x7F800000u) || ((v.y & 0x7F80u) == 0x7F80u) || ((v.y & 0x7F800000u) == 0x7F800000u)
                  || ((v.z & 0x7F80u) == 0x7F80u) || ((v.z & 0x7F800000u) == 0x7F800000u) || ((v.w & 0x7F80u) == 0x7F80u) || ((v.w & 0x7F800000u) == 0x7F800000u);
    }
    if (bad) atomicOr(flag, 1u);
}
__device__ __noinline__ void scan_f32(const float* base, size_t n, unsigned* flag) {
    const size_t gtid = (size_t)blockIdx.x * NTHR + threadIdx.x, gsz = (size_t)gridDim.x * NTHR;
    bool bad = false;
    for (size_t i = gtid; i < n; i += gsz) { if ((__float_as_uint(base[i]) & 0x7F800000u) == 0x7F800000u) bad = true; }
    if (bad) atomicOr(flag, 1u);
}
__device__ __forceinline__ void debug_scan(const Params& p, int ph) {
    unsigned* F = (unsigned*)(p.ws + WS_CTRL) + 128;
    const bf16_t* P = (const bf16_t*)(p.ws + WS_PROJ); const bf16_t* HB = (const bf16_t*)(p.ws + WS_HB); const bf16_t* VT = (const bf16_t*)(p.ws + WS_VT);
    if (ph == 0) {
        scan_bf16((const bf16_t*)(p.ws + WS_WINT), NP, D, 0, D, F + 0);
        scan_bf16((const bf16_t*)(p.ws + WS_WOT), 4 * D + 4096, D, 0, D, F + 1);
        scan_bf16((const bf16_t*)(p.ws + WS_PU), 32768, D, 0, D, F + 2);
        scan_f32((const float*)(p.ws + WS_ROPE), 16384 * 64, F + 3);
        scan_bf16((const bf16_t*)(p.ws + WS_HM), 2560, D, 0, D, F + 3);
    } else if (ph == 2) {
        scan_bf16((const bf16_t*)(p.ws + WS_MEMK), 2 * 10 * 4 * 256, 256, 0, 256, F + 4);
    } else if (ph == 3) scan_bf16(HB, G_TOK, D, 0, D, F + 5);
    else if (ph == 4) { scan_bf16(P, G_TOK, NP, 0, 3072, F + 6); scan_bf16(P, G_TOK, NP, 3072, 2048, F + 7); scan_bf16(VT, G_TOK, D, 0, D, F + 8); scan_bf16(P, G_TOK, NP, 6144, NP - 6144, F + 9); }
    else if (ph == 5) scan_bf16(P, G_TOK, NP, 3072, 2048, F + 10);
    else if (ph == 6) { scan_bf16(HB, G_TOK, D, 0, D, F + 11); scan_bf16(P, G_TOK, NP, C_DV, 1024, F + 12); scan_bf16(P, G_TOK, NP, C_DQ, 1024, F + 13); scan_bf16(P, G_TOK, NP, C_MQ, 1024, F + 14); }
    else if (ph == 7) scan_bf16(P, G_TOK, NP, C_GG, 1024, F + 15);
    else if (ph == 8) scan_bf16(VT, G_TOK, D, 0, D, F + 16);
    else if (ph == 9) scan_f32(p.out, (size_t)G_TOK * D, F + 17);
    else if (ph == 10) scan_bf16(HB, G_TOK, D, 0, D, F + 18);
    else if (ph == 11) scan_bf16(P, G_TOK, NP, 0, 2048, F + 19);
    else if (ph == 12) scan_f32(p.out, (size_t)G_TOK * D, F + 20);
}
#endif

constexpr int NPH = 3 + NGROUP * 10;
__device__ __forceinline__ void run_phase(const Params& p, int ph, char* lds, int* s_item) {
    if (ph == 0) { phase_p0a(p, lds); return; }
    if (ph == 1) { phase_p0b(p, lds); return; }
    if (ph == 2) { phase_p0c(p); return; }
    const int g = (ph - 3) / 10, s = (ph - 3) % 10;
    const Grp G = get_group(p, g);
    switch (s) {
        case 0: phase_rmsnorm(G.x, p.in[I_GMIX], (bf16_t*)(p.ws + WS_HB), G_TOK); break;
        case 1: phase_inproj(p, g, lds); break;
        case 2: phase_qkrope(p, g); break;
        case 3: phase_mixer(p, g, lds, s_item); break;
        case 4: phase_glafin(p, g); break;
        case 5: phase_merge(p, g, lds); break;
        case 6: phase_outproj(p, g, lds); break;
        case 7: phase_rmsnorm(G.out, p.in[I_GFFN], (bf16_t*)(p.ws + WS_HB), G_TOK); break;
        case 8: phase_peerq(p, g, lds); break;
        case 9: phase_peer(p, g, lds); break;
    }
}

__global__ void __launch_bounds__(NTHR) mega_kernel(Params p) {
    extern __shared__ __attribute__((aligned(16))) char lds[];
    __shared__ int s_item;
    cg::grid_group grid = cg::this_grid();
#ifndef PROBE
#define PROBE 0
#endif
#if PROBE
    __shared__ unsigned long long tacc[16];
    if (threadIdx.x < 16) tacc[threadIdx.x] = 0ull;
    __syncthreads();
    if (threadIdx.x == 0) tacc[15] = __builtin_amdgcn_s_memrealtime();
#endif
    for (int ph = p.ph_lo; ph < p.ph_hi; ++ph) {
        run_phase(p, ph, lds, &s_item);
#if DEBUG_NAN
        __threadfence(); grid.sync(); __threadfence();
        debug_scan(p, ph);
        __threadfence(); grid.sync(); __threadfence();
#else
#if PROBE
        __threadfence(); grid.sync(); __threadfence();
        if (blockIdx.x == 0 && threadIdx.x == 0) { const unsigned long long tn = __builtin_amdgcn_s_memrealtime(); tacc[ph < 3 ? 10 + ph : (ph - 3) % 10] += tn - tacc[15]; tacc[15] = tn; }
#else
        if (ph + 1 < p.ph_hi) grid.sync();
#endif
#endif
    }
#if PROBE
    if (blockIdx.x == 0 && threadIdx.x == 0) {
        unsigned long long ta = 0, tb = 0;
        for (int k = 0; k < 13; ++k) { if ((PROBE_A >> k) & 1) ta += tacc[k]; if ((PROBE_B >> k) & 1) tb += tacc[k]; }
        float ma = (float)ta * 1e-5f;
        if (ma >= 10.f) ma *= 0.1f;
        if (ma < 1.f) ma *= 10.f;
        const int eb = 5 + (int)((float)tb * 1e-5f + 0.5f);
        float mark = ma; for (int k = 0; k < eb; ++k) mark *= 10.f;
        p.out[0] = mark;
    }
#endif
#if DEBUG_NAN
    if (blockIdx.x == 0 && threadIdx.x == 0) {
        const unsigned* F = (const unsigned*)(p.ws + WS_CTRL) + 128; int first = -1;
        for (int k = 0; k <= 20; ++k) if (first < 0 && atomicOr((unsigned*)F + k, 0u)) first = k;
        float mark = 1000.f; for (int k = 0; k < first; ++k) mark *= 10.f;
        p.out[0] = first < 0 ? 777.f : mark;
    }
#endif
}

extern "C" void kernel_launch(void* const* d_in, const int* in_sizes, int n_in, void* d_out, int out_size, void* d_ws, size_t ws_size, hipStream_t stream) {
    static int grid_blocks = 0;
    if (grid_blocks == 0) {
        if (n_in != 32 || ws_size < WS_END) { fprintf(stderr, "kernel_launch: unexpected n_in %d or ws_size %zu (< %zu)\n", n_in, ws_size, (size_t)WS_END); grid_blocks = -1; return; }
        int dev = 0, cus = 0, per_cu = 0;
        hipGetDevice(&dev);
        hipDeviceGetAttribute(&cus, hipDeviceAttributeMultiprocessorCount, dev);
        hipFuncSetAttribute((const void*)mega_kernel, hipFuncAttributeMaxDynamicSharedMemorySize, LDS_BYTES);
        hipOccupancyMaxActiveBlocksPerMultiprocessor(&per_cu, (const void*)mega_kernel, NTHR, LDS_BYTES);
        if (per_cu < 1) per_cu = 1;
        grid_blocks = cus * per_cu;
        (void)hipGetLastError();
    }
    if (grid_blocks < 0) return;
    Params p{};
    for (int i = 0; i < 32; ++i) p.in[i] = (const float*)d_in[i];
    p.out = (float*)d_out; p.ws = (unsigned char*)d_ws; p.ph_lo = 0; p.ph_hi = NPH;
    void* args[] = {&p};
    hipError_t e = hipLaunchCooperativeKernel((const void*)mega_kernel, dim3(grid_blocks), dim3(NTHR), args, LDS_BYTES, stream);
    if (e != hipSuccess) fprintf(stderr, "cooperative launch failed: %s (grid %d)\n", hipGetErrorString(e), grid_blocks);
}
```

```cpp
#include <hip/hip_runtime.h>
#include <hip/hip_cooperative_groups.h>
#include <cstdio>
#include <cstdint>
namespace cg = cooperative_groups;

typedef unsigned short bf16_t;
typedef short bf16x8 __attribute__((ext_vector_type(8)));
typedef float f32x4 __attribute__((ext_vector_type(4)));
typedef unsigned u32x4 __attribute__((ext_vector_type(4)));
typedef unsigned u32x2 __attribute__((ext_vector_type(2)));

constexpr int D = 1024;
constexpr int NP = 10496;
constexpr int IN_COLS = 10272;
constexpr int C_GQ = 0, C_GK = 512, C_GV = 1024, C_GG = 2048, C_DQ = 3072, C_DK = 4096, C_DV = 5120, C_MQ = 6144, C_BG = 7168, C_LR = 10240;
constexpr int G_TOK = 32768;
constexpr int NGROUP = 3;
constexpr int NTHR = 512;
constexpr float RMS_EPS = 1e-6f;
constexpr float LOG2E = 1.4426950408889634f;
constexpr int LDS_BYTES = 126976;
constexpr float PEER_SU = 32.0f, PEER_SV = 8.0f;

enum { I_XP = 0, I_XS, I_MP, I_MS, I_GMIX, I_WIN, I_WDF, I_BDF, I_WDB, I_BDB, I_GOUT, I_GWO, I_DGQ, I_DGK, I_LQ1, I_LK1, I_LQ2, I_LK2,
       I_DGSUB, I_DWO, I_MGN, I_MWKV, I_MGQ, I_MGK, I_MWO, I_WOUT, I_GFFN, I_PWQ, I_PK1, I_PK2, I_PU, I_PV };

constexpr size_t al256(size_t x) { return (x + 255) & ~(size_t)255; }
constexpr size_t WS_CTRL = 0;
constexpr size_t WS_PROJ = 4096;
constexpr size_t WS_HB   = WS_PROJ + (size_t)G_TOK * NP * 2;
constexpr size_t WS_VT   = WS_HB + (size_t)G_TOK * D * 2;
constexpr size_t WS_WINT = WS_VT + (size_t)G_TOK * D * 2;
constexpr size_t WS_WOT  = WS_WINT + (size_t)NP * D * 2;
constexpr size_t WS_WKVT = WS_WOT + (size_t)4 * D * D * 2;
constexpr size_t WS_WQT  = WS_WKVT + (size_t)2048 * D * 2;
constexpr size_t WS_PU   = WS_WQT + (size_t)2048 * D * 2;
constexpr size_t WS_PV   = WS_PU + (size_t)16384 * D * 2;
constexpr size_t WS_K12  = WS_PV + (size_t)16384 * D * 2;
constexpr size_t WS_ROPE = WS_K12 + (size_t)2 * 128 * 128 * 2;
constexpr size_t WS_HM   = WS_ROPE + (size_t)16384 * 64 * 4;
constexpr size_t WS_KVR  = WS_HM + (size_t)2560 * D * 2;
constexpr size_t WS_MEMK = WS_KVR + (size_t)2560 * 2048 * 4;
constexpr size_t WS_MEMV = WS_MEMK + (size_t)10 * 4 * 256 * 256 * 2;
constexpr size_t WS_END  = WS_MEMV + (size_t)10 * 4 * 256 * 256 * 2;

struct Params {
    const float* in[32];
    float* out;
    unsigned char* ws;
    int ph_lo, ph_hi;
};

typedef float f32x2 __attribute__((ext_vector_type(2)));
typedef __bf16 bf16x2v __attribute__((ext_vector_type(2)));
__device__ __forceinline__ unsigned pk2(float lo, float hi) { const f32x2 v = {lo, hi}; const bf16x2v b = __builtin_convertvector(v, bf16x2v); return __builtin_bit_cast(unsigned, b); }
__device__ __forceinline__ float bflo(unsigned u) { return __uint_as_float(u << 16); }
__device__ __forceinline__ float bfhi(unsigned u) { return __uint_as_float(u & 0xffff0000u); }
__device__ __forceinline__ float bf2f(bf16_t b) { return __uint_as_float(((unsigned)b) << 16); }
__device__ __forceinline__ bf16_t f2bf(float f) { return (bf16_t)(pk2(f, 0.f) & 0xffffu); }
__device__ __forceinline__ f32x4 mfma16(bf16x8 a, bf16x8 b, f32x4 c) { return __builtin_amdgcn_mfma_f32_16x16x32_bf16(a, b, c, 0, 0, 0); }
__device__ __forceinline__ float fexp2(float x) { return __builtin_amdgcn_exp2f(x); }
__device__ __forceinline__ int otid() { int t = threadIdx.x; asm volatile("" : "+v"(t)); return t; }
template <int M> __device__ __forceinline__ float sxor(float v) {
    if (M < 32) return __int_as_float(__builtin_amdgcn_ds_swizzle(__float_as_int(v), (M << 10) | 0x1F));
    const int l = otid() & 63; return __int_as_float(__builtin_amdgcn_ds_bpermute((l ^ 32) << 2, __float_as_int(v)));
}
template <int M> __device__ __forceinline__ unsigned sxoru(unsigned v) { return (unsigned)__builtin_amdgcn_ds_swizzle((int)v, (M << 10) | 0x1F); }
__device__ __forceinline__ float wave_sum(float v) {
    v += sxor<1>(v); v += sxor<2>(v); v += sxor<4>(v); v += sxor<8>(v); v += sxor<16>(v); v += sxor<32>(v);
    return v;
}

struct Grp { const float* x; const float* mem; float* out; int B, T, mb0; };
__device__ __forceinline__ Grp get_group(const Params& p, int g) {
    Grp r;
    if (g == 0) { r.x = p.in[I_XP]; r.out = p.out; r.B = 2; r.T = 16384; r.mb0 = 0; }
    else { r.x = p.in[I_XS] + (size_t)(g - 1) * G_TOK * D; r.out = p.out + (size_t)g * G_TOK * D; r.B = 4; r.T = 8192; r.mb0 = 2 + (g - 1) * 4; }
    r.mem = nullptr;
    return r;
}

constexpr int G_ROW = 144;
constexpr int G_A_BYTES = 128 * G_ROW;
constexpr int G_B_BYTES = 256 * G_ROW;
constexpr int G_STAGE = G_A_BYTES + G_B_BYTES;

template <bool SWAP>
__device__ __forceinline__ void gemm_kloop(f32x4 (&acc)[4][4], const bf16_t* __restrict__ A, int lda, const bf16_t* __restrict__ Bt, int ldb, int K, char* lds) {
    const int tid = otid(), lane = tid & 63, wid = tid >> 6, wm = wid >> 2, wn = wid & 3, fr = lane & 15, fq = lane >> 4;
    const int lr = tid >> 3, lc = tid & 7;
    u32x4 ra[2], rb[4];
    const bf16_t* Ap = A + (size_t)lr * lda + lc * 8;
    const bf16_t* Bp = Bt + (size_t)lr * ldb + lc * 8;
#define GLOAD(k0) do { _Pragma("unroll") for (int i = 0; i < 2; ++i) ra[i] = *(const u32x4*)(Ap + (size_t)(i * 64) * lda + (k0)); \
                       _Pragma("unroll") for (int i = 0; i < 4; ++i) rb[i] = *(const u32x4*)(Bp + (size_t)(i * 64) * ldb + (k0)); } while (0)
#define SWRITE(buf) do { char* b_ = lds + (buf) * G_STAGE + lr * G_ROW + lc * 16; \
                       _Pragma("unroll") for (int i = 0; i < 2; ++i) *(u32x4*)(b_ + i * 64 * G_ROW) = ra[i]; \
                       _Pragma("unroll") for (int i = 0; i < 4; ++i) *(u32x4*)(b_ + G_A_BYTES + i * 64 * G_ROW) = rb[i]; } while (0)
    const int nk = K / 64;
    GLOAD(0); SWRITE(0); __syncthreads();
    for (int kt = 0; kt < nk; ++kt) {
        if (kt + 1 < nk) GLOAD((kt + 1) * 64);
        const char* base = lds + (kt & 1) * G_STAGE;
#pragma unroll
        for (int ks = 0; ks < 2; ++ks) {
            bf16x8 af[4], bfr[4];
#pragma unroll
            for (int mt = 0; mt < 4; ++mt) af[mt] = *(const bf16x8*)(base + (wm * 64 + mt * 16 + fr) * G_ROW + ks * 64 + fq * 16);
#pragma unroll
            for (int nt = 0; nt < 4; ++nt) bfr[nt] = *(const bf16x8*)(base + G_A_BYTES + (wn * 64 + nt * 16 + fr) * G_ROW + ks * 64 + fq * 16);
#pragma unroll
            for (int mt = 0; mt < 4; ++mt)
#pragma unroll
                for (int nt = 0; nt < 4; ++nt)
                    acc[mt][nt] = SWAP ? mfma16(bfr[nt], af[mt], acc[mt][nt]) : mfma16(af[mt], bfr[nt], acc[mt][nt]);
        }
        if (kt + 1 < nk) SWRITE((kt + 1) & 1);
        __syncthreads();
    }
#undef GLOAD
#undef SWRITE
}

__device__ __forceinline__ void tile_order(int t, int nM, int nN, int& pm, int& pn) {
    const int per = 8 * nN, grp = t / per, r = t % per;
    pm = grp * 8 + (r & 7); pn = r >> 3;
}

__device__ __forceinline__ void phase_p0a(const Params& p, char* lds) {
    const int tid = otid(), lane = tid & 63, wid = tid >> 6;
    unsigned char* ws = p.ws;
    if (blockIdx.x == 0 && tid < 256) atomicExch((unsigned*)(ws + WS_CTRL) + tid, 0u);
    float* scr = (float*)(lds + wid * 8448);
    constexpr int IT_WIN = 16 * (NP / 32), IT_SQ = 16 * 32, IT_W2 = 16 * 64;
    constexpr int NIT = IT_WIN + 4 * IT_SQ + 2 * IT_W2;
    for (int it0 = blockIdx.x * 8; it0 < NIT; it0 += gridDim.x * 8) {
        int it = it0 + wid;
        const float* W = nullptr; bf16_t* WT = nullptr; int N = 0, nb = 0, kb = 0, srccol = -1;
        if (it < NIT) {
            int r = it;
            if (r < IT_WIN) { W = p.in[I_WIN]; N = IN_COLS; WT = (bf16_t*)(ws + WS_WINT); kb = r / (NP / 32); nb = r % (NP / 32);
                const int n0 = nb * 32; srccol = n0 < 3072 ? n0 : (n0 < 10240 ? n0 + 32 : (n0 == 10240 ? 3072 : -1)); }
            else { r -= IT_WIN;
                if (r < 4 * IT_SQ) { const int w = r / IT_SQ; r %= IT_SQ; const int idx[4] = {I_GWO, I_DWO, I_MWO, I_WOUT};
                    W = p.in[w == 0 ? I_GWO : (w == 1 ? I_DWO : (w == 2 ? I_MWO : I_WOUT))]; (void)idx; N = 1024; WT = (bf16_t*)(ws + WS_WOT) + (size_t)w * D * D; kb = r / 32; nb = r % 32; srccol = nb * 32; }
                else { r -= 4 * IT_SQ; const int w = r / IT_W2; r %= IT_W2; W = p.in[w == 0 ? I_MWKV : I_PWQ]; N = 2048; WT = (bf16_t*)(ws + (w == 0 ? WS_WKVT : WS_WQT)); kb = r / 64; nb = r % 64; srccol = nb * 32; }
            }
            const int k0 = kb * 64;
#pragma unroll 8
            for (int i = 0; i < 32; ++i) { const int kk = 2 * i + (lane >> 5); scr[kk * 33 + (lane & 31)] = srccol >= 0 ? W[(size_t)(k0 + kk) * N + srccol + (lane & 31)] : 0.f; }
        }
        __syncthreads();
        if (it < NIT) {
            const int k0 = kb * 64, c = lane & 7;
#pragma unroll
            for (int j = 0; j < 4; ++j) { const int n = (lane >> 3) + 8 * j; const float* s = scr + (8 * c) * 33 + n;
                u32x4 o; o.x = pk2(s[0], s[33]); o.y = pk2(s[66], s[99]); o.z = pk2(s[132], s[165]); o.w = pk2(s[198], s[231]);
                *(u32x4*)(WT + (size_t)(nb * 32 + n) * D + k0 + 8 * c) = o; }
        }
        __syncthreads();
    }
    const size_t gtid = (size_t)blockIdx.x * NTHR + tid, gsz = (size_t)gridDim.x * NTHR;
    {
        const size_t n8 = (size_t)16384 * D / 8;
        for (size_t i = gtid; i < 2 * n8; i += gsz) {
            const int w = i >= n8; const size_t j = w ? i - n8 : i;
            const float* src = p.in[w ? I_PV : I_PU] + j * 8; unsigned char* dst = ws + (w ? WS_PV : WS_PU) + j * 8;
            const float sc = w ? PEER_SV : PEER_SU;
            const f32x4 a = *(const f32x4*)src * sc, b = *(const f32x4*)(src + 4) * sc;
            int lo = __builtin_amdgcn_cvt_pk_fp8_f32(a.x, a.y, 0, false); lo = __builtin_amdgcn_cvt_pk_fp8_f32(a.z, a.w, lo, true);
            int hi = __builtin_amdgcn_cvt_pk_fp8_f32(b.x, b.y, 0, false); hi = __builtin_amdgcn_cvt_pk_fp8_f32(b.z, b.w, hi, true);
            *(u32x2*)dst = (u32x2){(unsigned)lo, (unsigned)hi};
        }
        for (size_t i = gtid; i < 2 * 16384; i += gsz) {
            const int w = i >= 16384; const size_t j = w ? i - 16384 : i;
            ((bf16_t*)(ws + WS_K12))[i] = f2bf(p.in[w ? I_PK2 : I_PK1][j]);
        }
    }
    for (size_t i = gtid; i < (size_t)16384 * 32; i += gsz) {
        const int t = (int)(i >> 5), k = (int)(i & 31);
        const float inv = powf(10000.0f, -(float)(2 * k) / 64.0f);
        const float ang = (float)t * inv;
        double sn, cs; sincos((double)ang, &sn, &cs);
        float* R = (float*)(ws + WS_ROPE) + (size_t)t * 64;
        R[k] = (float)cs; R[32 + k] = (float)sn;
    }
    for (int row = blockIdx.x * 8 + wid; row < 2560; row += gridDim.x * 8) {
        const float* src = row < 512 ? p.in[I_MP] + (size_t)row * D : p.in[I_MS] + (size_t)(row - 512) * D;
        const f32x4* xr = (const f32x4*)src + lane; const f32x4* gr = (const f32x4*)p.in[I_MGN] + lane;
        f32x4 v[4]; float s = 0.f;
#pragma unroll
        for (int j = 0; j < 4; ++j) { v[j] = xr[64 * j]; s += v[j].x * v[j].x + v[j].y * v[j].y + v[j].z * v[j].z + v[j].w * v[j].w; }
        const float r = rsqrtf(wave_sum(s) * (1.f / D) + RMS_EPS);
        u32x2* o = (u32x2*)((bf16_t*)(ws + WS_HM) + (size_t)row * D) + lane;
#pragma unroll
        for (int j = 0; j < 4; ++j) { const f32x4 g = gr[64 * j]; u32x2 w; w.x = pk2(v[j].x * r * g.x, v[j].y * r * g.y); w.y = pk2(v[j].z * r * g.z, v[j].w * r * g.w); o[64 * j] = w; }
    }
}

__device__ __forceinline__ void phase_p0b(const Params& p, char* lds) {
    const int tid_ = otid(), lane = tid_ & 63, wid = tid_ >> 6, wm = wid >> 2, wn = wid & 3, fr = lane & 15, fq = lane >> 4;
    const bf16_t* A = (const bf16_t*)(p.ws + WS_HM); const bf16_t* Bt = (const bf16_t*)(p.ws + WS_WKVT);
    float* C = (float*)(p.ws + WS_KVR);
    const int nM = 20, nN = 8;
    for (int t = blockIdx.x; t < nM * nN; t += gridDim.x) {
        const int pm = t % nM, pn = t / nM, m0 = pm * 128, n0 = pn * 256;
        f32x4 acc[4][4];
#pragma unroll
        for (int i = 0; i < 4; ++i)
#pragma unroll
            for (int j = 0; j < 4; ++j) acc[i][j] = (f32x4){0.f, 0.f, 0.f, 0.f};
        gemm_kloop<true>(acc, A + (size_t)m0 * D, D, Bt + (size_t)n0 * D, D, D, lds);
#pragma unroll
        for (int mt = 0; mt < 4; ++mt)
#pragma unroll
            for (int nt = 0; nt < 4; ++nt) {
                const int row = m0 + wm * 64 + mt * 16 + fr, col = n0 + wn * 64 + nt * 16 + fq * 4;
                *(f32x4*)(C + (size_t)row * 2048 + col) = acc[mt][nt];
            }
    }
}

__device__ __forceinline__ void phase_p0c(const Params& p) {
    const int tid_ = otid(), lane = tid_ & 63, wid = tid_ >> 6;
    const float* KV = (const float*)(p.ws + WS_KVR);
    bf16_t* MK = (bf16_t*)(p.ws + WS_MEMK); bf16_t* MV = (bf16_t*)(p.ws + WS_MEMV);
    for (int it = blockIdx.x * 8 + wid; it < 2560 * 4; it += gridDim.x * 8) {
        const int row = it >> 2, h = it & 3, b = row >> 8, m = row & 255;
        const f32x4 kv = *(const f32x4*)(KV + (size_t)row * 2048 + h * 256 + lane * 4);
        const float ss = wave_sum(kv.x * kv.x + kv.y * kv.y + kv.z * kv.z + kv.w * kv.w);
        const float r = rsqrtf(ss * (1.f / 256.f) + RMS_EPS);
        const f32x4 g = *(const f32x4*)(p.in[I_MGK] + lane * 4);
        u32x2 w; w.x = pk2(kv.x * r * g.x, kv.y * r * g.y); w.y = pk2(kv.z * r * g.z, kv.w * r * g.w);
        *(u32x2*)(MK + ((size_t)(b * 4 + h) * 256 + m) * 256 + lane * 4) = w;
        const f32x4 vv = *(const f32x4*)(KV + (size_t)row * 2048 + 1024 + h * 256 + lane * 4);
        const int pos = (m & ~31) + ((m >> 2) & 3) * 8 + ((m >> 4) & 1) * 4 + (m & 3);
        bf16_t* dst = MV + ((size_t)(b * 4 + h) * 256 + lane * 4) * 256 + pos;
        dst[0] = f2bf(vv.x); dst[256] = f2bf(vv.y); dst[512] = f2bf(vv.z); dst[768] = f2bf(vv.w);
    }
}

__device__ __forceinline__ void phase_rmsnorm(const float* X, const float* gain, bf16_t* O, int rows) {
    const int tid_ = otid(), lane = tid_ & 63, wid = tid_ >> 6;
    const f32x4* gr = (const f32x4*)gain + lane;
    f32x4 g[4];
#pragma unroll
    for (int j = 0; j < 4; ++j) g[j] = gr[64 * j];
    for (int row = blockIdx.x * 8 + wid; row < rows; row += gridDim.x * 8) {
        const f32x4* xr = (const f32x4*)(X + (size_t)row * D) + lane;
        f32x4 v[4]; float s = 0.f;
#pragma unroll
        for (int j = 0; j < 4; ++j) { v[j] = xr[64 * j]; s += v[j].x * v[j].x + v[j].y * v[j].y + v[j].z * v[j].z + v[j].w * v[j].w; }
        const float r = rsqrtf(wave_sum(s) * (1.f / D) + RMS_EPS);
        u32x2* o = (u32x2*)(O + (size_t)row * D) + lane;
#pragma unroll
        for (int j = 0; j < 4; ++j) { u32x2 w; w.x = pk2(v[j].x * r * g[j].x, v[j].y * r * g[j].y); w.y = pk2(v[j].z * r * g[j].z, v[j].w * r * g[j].w); o[64 * j] = w; }
    }
}

__device__ __forceinline__ void phase_inproj(const Params& p, int g, char* lds) {
    const Grp G = get_group(p, g);
    const int tid_ = otid(), lane = tid_ & 63, wid = tid_ >> 6, wm = wid >> 2, wn = wid & 3, fr = lane & 15, fq = lane >> 4;
    const bf16_t* A = (const bf16_t*)(p.ws + WS_HB); const bf16_t* Bt = (const bf16_t*)(p.ws + WS_WINT);
    bf16_t* P = (bf16_t*)(p.ws + WS_PROJ); bf16_t* VT = (bf16_t*)(p.ws + WS_VT);
    const int nM = G_TOK / 128, nN = NP / 256;
    for (int t = blockIdx.x; t < nM * nN; t += gridDim.x) {
        int pm, pn; tile_order(t, nM, nN, pm, pn);
        const int m0 = pm * 128, n0 = pn * 256;
        f32x4 acc[4][4];
#pragma unroll
        for (int i = 0; i < 4; ++i)
#pragma unroll
            for (int j = 0; j < 4; ++j) acc[i][j] = (f32x4){0.f, 0.f, 0.f, 0.f};
        if (n0 >= C_DV && n0 < C_DV + 1024) {
            gemm_kloop<false>(acc, A + (size_t)m0 * D, D, Bt + (size_t)n0 * D, D, D, lds);
            const int b = m0 / G.T, t0 = m0 % G.T + wm * 64;
#pragma unroll
            for (int mt = 0; mt < 4; ++mt)
#pragma unroll
                for (int nt = 0; nt < 4; ++nt) {
                    const int n = n0 - C_DV + wn * 64 + nt * 16 + fr, h = n >> 7, dv = n & 127;
                    const int pos = t0 + (mt >> 1) * 32 + fq * 8 + (mt & 1) * 4;
                    u32x2 w; w.x = pk2(acc[mt][nt].x, acc[mt][nt].y); w.y = pk2(acc[mt][nt].z, acc[mt][nt].w);
                    *(u32x2*)(VT + ((size_t)((b * 8 + h) * 128 + dv)) * G.T + pos) = w;
                }
        } else {
            gemm_kloop<true>(acc, A + (size_t)m0 * D, D, Bt + (size_t)n0 * D, D, D, lds);
            const float sc = n0 < 512 ? 0.08838834764831845f : 1.0f;
#pragma unroll
            for (int mt = 0; mt < 4; ++mt)
#pragma unroll
                for (int nt = 0; nt < 4; ++nt) {
                    const int row = m0 + wm * 64 + mt * 16 + fr, col = n0 + wn * 64 + nt * 16 + fq * 4;
                    u32x2 w; w.x = pk2(acc[mt][nt].x * sc, acc[mt][nt].y * sc); w.y = pk2(acc[mt][nt].z * sc, acc[mt][nt].w * sc);
                    *(u32x2*)(P + (size_t)row * NP + col) = w;
                }
        }
    }
}

__device__ __forceinline__ void phase_qkrope(const Params& p, int g) {
    const Grp G = get_group(p, g);
    const int tid_ = otid(), lane = tid_ & 63, wid = tid_ >> 6, grp = lane >> 2, sub = lane & 3;
    bf16_t* P = (bf16_t*)(p.ws + WS_PROJ); const float* ROPE = (const float*)(p.ws + WS_ROPE);
    for (int it = blockIdx.x * 8 + wid; it < G_TOK * 2; it += gridDim.x * 8) {
        const int tok = it >> 1, isk = it & 1, t = tok % G.T;
        bf16_t* base = P + (size_t)tok * NP + (isk ? C_DK : C_DQ) + grp * 64 + sub * 8;
        const u32x4 a = *(const u32x4*)base, b = *(const u32x4*)(base + 32);
        float x1[8], x2[8];
        x1[0] = bflo(a.x); x1[1] = bfhi(a.x); x1[2] = bflo(a.y); x1[3] = bfhi(a.y); x1[4] = bflo(a.z); x1[5] = bfhi(a.z); x1[6] = bflo(a.w); x1[7] = bfhi(a.w);
        x2[0] = bflo(b.x); x2[1] = bfhi(b.x); x2[2] = bflo(b.y); x2[3] = bfhi(b.y); x2[4] = bflo(b.z); x2[5] = bfhi(b.z); x2[6] = bflo(b.w); x2[7] = bfhi(b.w);
        float ss = 0.f;
#pragma unroll
        for (int e = 0; e < 8; ++e) ss += x1[e] * x1[e] + x2[e] * x2[e];
        ss += sxor<1>(ss); ss += sxor<2>(ss);
        const float r = rsqrtf(ss * (1.f / 64.f) + RMS_EPS) * (isk ? 1.0f : 0.125f * LOG2E);
        const float* gn = p.in[isk ? I_DGK : I_DGQ] + sub * 8;
        const float* rp = ROPE + (size_t)t * 64 + sub * 8;
        float o1[8], o2[8];
#pragma unroll
        for (int e = 0; e < 8; ++e) {
            const float y1 = x1[e] * r * gn[e], y2 = x2[e] * r * gn[32 + e], c = rp[e], s = rp[32 + e];
            o1[e] = y1 * c - y2 * s; o2[e] = y2 * c + y1 * s;
        }
        u32x4 w1, w2;
        w1.x = pk2(o1[0], o1[1]); w1.y = pk2(o1[2], o1[3]); w1.z = pk2(o1[4], o1[5]); w1.w = pk2(o1[6], o1[7]);
        w2.x = pk2(o2[0], o2[1]); w2.y = pk2(o2[2], o2[3]); w2.z = pk2(o2[4], o2[5]); w2.w = pk2(o2[6], o2[7]);
        *(u32x4*)base = w1; *(u32x4*)(base + 32) = w2;
    }
}

__device__ __forceinline__ void diff_attn_item(const Params& p, const Grp& G, int item, char* lds, float lam, float shift) {
    const int tid = otid(), lane = tid & 63, wid = tid >> 6, fr = lane & 15, fq = lane >> 4;
    const int c = wid & 1, sub = wid >> 1;
    const int T = G.T, nqb = T / 128;
    const int qb = item % nqb, bh = item / nqb, h = bh & 7, b = bh >> 3;
    bf16_t* P = (bf16_t*)(p.ws + WS_PROJ) + (size_t)b * T * NP;
    const bf16_t* Kg = P + C_DK + h * 128;
    const bf16_t* VTg = (const bf16_t*)(p.ws + WS_VT) + (size_t)bh * 128 * T;
    const int q0 = qb * 128 + sub * 32;
    bf16x8 qf[2][2];
#pragma unroll
    for (int nt = 0; nt < 2; ++nt)
#pragma unroll
        for (int ks = 0; ks < 2; ++ks) qf[nt][ks] = *(const bf16x8*)(P + (size_t)(q0 + nt * 16 + fr) * NP + C_DQ + h * 128 + c * 64 + ks * 32 + fq * 8);
    f32x4 o[8][2];
#pragma unroll
    for (int i = 0; i < 8; ++i) { o[i][0] = (f32x4){0.f, 0.f, 0.f, 0.f}; o[i][1] = (f32x4){0.f, 0.f, 0.f, 0.f}; }
    float l[2] = {0.f, 0.f};
    constexpr int STG = 36864, VOFF = 18432;
    u32x4 rk[2], rv[2];
    const int krow = tid >> 4, kch = tid & 15;
    const int vrow = tid >> 3, vch = tid & 7;
#define AGLOAD(kt) do { const int key0_ = (kt) * 64; \
        _Pragma("unroll") for (int i = 0; i < 2; ++i) rk[i] = *(const u32x4*)(Kg + (size_t)(key0_ + krow + i * 32) * NP + kch * 8); \
        _Pragma("unroll") for (int i = 0; i < 2; ++i) rv[i] = *(const u32x4*)(VTg + (size_t)(vrow + i * 64) * T + key0_ + vch * 8); } while (0)
#define ASWRITE(buf) do { char* b_ = lds + (buf) * STG; \
        _Pragma("unroll") for (int i = 0; i < 2; ++i) *(u32x4*)(b_ + ((kch >> 3) * 64 + krow + i * 32) * 144 + (kch & 7) * 16) = rk[i]; \
        _Pragma("unroll") for (int i = 0; i < 2; ++i) *(u32x4*)(b_ + VOFF + (vrow + i * 64) * 144 + vch * 16) = rv[i]; } while (0)
    const int nkt = T / 64;
    AGLOAD(0); ASWRITE(0); __syncthreads();
    for (int kt = 0; kt < nkt; ++kt) {
        if (kt + 1 < nkt) AGLOAD(kt + 1);
        const char* base = lds + (kt & 1) * STG;
        f32x4 s[4][2];
#pragma unroll
        for (int mt = 0; mt < 4; ++mt) { s[mt][0] = (f32x4){-shift, -shift, -shift, -shift}; s[mt][1] = s[mt][0]; }
#pragma unroll
        for (int ks = 0; ks < 2; ++ks)
#pragma unroll
            for (int mt = 0; mt < 4; ++mt) {
                const bf16x8 kf = *(const bf16x8*)(base + (c * 64 + mt * 16 + fr) * 144 + ks * 64 + fq * 16);
                s[mt][0] = mfma16(kf, qf[0][ks], s[mt][0]);
                s[mt][1] = mfma16(kf, qf[1][ks], s[mt][1]);
            }
        bf16x8 pf[2][2];
#pragma unroll
        for (int nt = 0; nt < 2; ++nt)
#pragma unroll
            for (int kk = 0; kk < 2; ++kk) {
                const f32x4 a = s[2 * kk][nt], bb = s[2 * kk + 1][nt];
                const float p0 = fexp2(a.x), p1 = fexp2(a.y), p2 = fexp2(a.z), p3 = fexp2(a.w);
                const float p4 = fexp2(bb.x), p5 = fexp2(bb.y), p6 = fexp2(bb.z), p7 = fexp2(bb.w);
                l[nt] += ((p0 + p1) + (p2 + p3)) + ((p4 + p5) + (p6 + p7));
                u32x4 w; w.x = pk2(p0, p1); w.y = pk2(p2, p3); w.z = pk2(p4, p5); w.w = pk2(p6, p7);
                pf[kk][nt] = __builtin_bit_cast(bf16x8, w);
            }
#pragma unroll
        for (int kk = 0; kk < 2; ++kk)
#pragma unroll
            for (int dvt = 0; dvt < 8; ++dvt) {
                const bf16x8 vf = *(const bf16x8*)(base + VOFF + (dvt * 16 + fr) * 144 + kk * 64 + fq * 16);
                o[dvt][0] = mfma16(vf, pf[kk][0], o[dvt][0]);
                o[dvt][1] = mfma16(vf, pf[kk][1], o[dvt][1]);
            }
        if (kt + 1 < nkt) ASWRITE((kt + 1) & 1);
        __syncthreads();
    }
#undef AGLOAD
#undef ASWRITE
    float inv[2];
#pragma unroll
    for (int nt = 0; nt < 2; ++nt) { float v = l[nt]; v += sxor<16>(v); v += sxor<32>(v); inv[nt] = 1.0f / v; }
    float* xch = (float*)lds + sub * 4096;
    if (c == 1) {
#pragma unroll
        for (int dvt = 0; dvt < 8; ++dvt)
#pragma unroll
            for (int nt = 0; nt < 2; ++nt) {
                xch[(dvt * 16 + fq * 4 + 0) * 32 + nt * 16 + fr] = o[dvt][nt].x * inv[nt];
                xch[(dvt * 16 + fq * 4 + 1) * 32 + nt * 16 + fr] = o[dvt][nt].y * inv[nt];
                xch[(dvt * 16 + fq * 4 + 2) * 32 + nt * 16 + fr] = o[dvt][nt].z * inv[nt];
                xch[(dvt * 16 + fq * 4 + 3) * 32 + nt * 16 + fr] = o[dvt][nt].w * inv[nt];
            }
    }
    __syncthreads();
    if (c == 0) {
        float ss[2] = {0.f, 0.f};
#pragma unroll
        for (int dvt = 0; dvt < 8; ++dvt)
#pragma unroll
            for (int nt = 0; nt < 2; ++nt) {
                f32x4 v = o[dvt][nt] * inv[nt];
                v.x -= lam * xch[(dvt * 16 + fq * 4 + 0) * 32 + nt * 16 + fr];
                v.y -= lam * xch[(dvt * 16 + fq * 4 + 1) * 32 + nt * 16 + fr];
                v.z -= lam * xch[(dvt * 16 + fq * 4 + 2) * 32 + nt * 16 + fr];
                v.w -= lam * xch[(dvt * 16 + fq * 4 + 3) * 32 + nt * 16 + fr];
                o[dvt][nt] = v; ss[nt] += v.x * v.x + v.y * v.y + v.z * v.z + v.w * v.w;
            }
#pragma unroll
        for (int nt = 0; nt < 2; ++nt) {
            float v = ss[nt]; v += sxor<16>(v); v += sxor<32>(v);
            const float r = rsqrtf(v * (1.f / 128.f) + RMS_EPS) * 0.8f;
#pragma unroll
            for (int dvt = 0; dvt < 8; ++dvt) {
                const f32x4 gs = *(const f32x4*)(p.in[I_DGSUB] + dvt * 16 + fq * 4);
                const f32x4 v4 = o[dvt][nt];
                u32x2 w; w.x = pk2(v4.x * r * gs.x, v4.y * r * gs.y); w.y = pk2(v4.z * r * gs.z, v4.w * r * gs.w);
                *(u32x2*)(P + (size_t)(q0 + nt * 16 + fr) * NP + C_DQ + h * 128 + dvt * 16 + fq * 4) = w;
            }
        }
    }
    __syncthreads();
}

__device__ __forceinline__ void mem_attn_item(const Params& p, const Grp& G, int item, char* lds, float shift) {
    const int tid = otid(), lane = tid & 63, wid = tid >> 6, fr = lane & 15, fq = lane >> 4;
    const int T = G.T, nqb = T / 128;
    const int qb = item % nqb, bh = item / nqb, h = bh & 3, b = bh >> 2;
    bf16_t* P = (bf16_t*)(p.ws + WS_PROJ) + (size_t)b * T * NP;
    const bf16_t* MK = (const bf16_t*)(p.ws + WS_MEMK) + (size_t)((G.mb0 + b) * 4 + h) * 256 * 256;
    const bf16_t* MV = (const bf16_t*)(p.ws + WS_MEMV) + (size_t)((G.mb0 + b) * 4 + h) * 256 * 256;
    const int row = qb * 128 + wid * 16 + fr;
    bf16_t* qp = P + (size_t)row * NP + C_MQ + h * 256;
    bf16x8 qf[8];
    {
        float ss = 0.f; u32x4 raw[8];
#pragma unroll
        for (int ks = 0; ks < 8; ++ks) { raw[ks] = *(const u32x4*)(qp + ks * 32 + fq * 8);
            const float a0 = bflo(raw[ks].x), a1 = bfhi(raw[ks].x), a2 = bflo(raw[ks].y), a3 = bfhi(raw[ks].y), a4 = bflo(raw[ks].z), a5 = bfhi(raw[ks].z), a6 = bflo(raw[ks].w), a7 = bfhi(raw[ks].w);
            ss += a0 * a0 + a1 * a1 + a2 * a2 + a3 * a3 + a4 * a4 + a5 * a5 + a6 * a6 + a7 * a7; }
        ss += sxor<16>(ss); ss += sxor<32>(ss);
        const float r = rsqrtf(ss * (1.f / 256.f) + RMS_EPS) * (0.0625f * LOG2E);
#pragma unroll
        for (int ks = 0; ks < 8; ++ks) {
            const f32x4 g0 = *(const f32x4*)(p.in[I_MGQ] + ks * 32 + fq * 8), g1 = *(const f32x4*)(p.in[I_MGQ] + ks * 32 + fq * 8 + 4);
            u32x4 w;
            w.x = pk2(bflo(raw[ks].x) * r * g0.x, bfhi(raw[ks].x) * r * g0.y); w.y = pk2(bflo(raw[ks].y) * r * g0.z, bfhi(raw[ks].y) * r * g0.w);
            w.z = pk2(bflo(raw[ks].z) * r * g1.x, bfhi(raw[ks].z) * r * g1.y); w.w = pk2(bflo(raw[ks].w) * r * g1.z, bfhi(raw[ks].w) * r * g1.w);
            qf[ks] = __builtin_bit_cast(bf16x8, w);
        }
    }
    f32x4 o[16];
#pragma unroll
    for (int i = 0; i < 16; ++i) o[i] = (f32x4){0.f, 0.f, 0.f, 0.f};
    float l = 0.f;
    constexpr int KROW = 528, VOFF = 64 * 528;
    for (int kt = 0; kt < 4; ++kt) {
#pragma unroll
        for (int i = 0; i < 4; ++i) {
            const int idx = tid + i * 512, r = idx >> 5, ch = idx & 31;
            *(u32x4*)(lds + r * KROW + ch * 16) = *(const u32x4*)(MK + (size_t)(kt * 64 + r) * 256 + ch * 8);
            const int vr = idx >> 3, vc = idx & 7;
            *(u32x4*)(lds + VOFF + vr * 144 + vc * 16) = *(const u32x4*)(MV + (size_t)vr * 256 + kt * 64 + vc * 8);
        }
        __syncthreads();
        f32x4 s[4];
#pragma unroll
        for (int mt = 0; mt < 4; ++mt) s[mt] = (f32x4){-shift, -shift, -shift, -shift};
#pragma unroll
        for (int ks = 0; ks < 8; ++ks)
#pragma unroll
            for (int mt = 0; mt < 4; ++mt) {
                const bf16x8 kf = *(const bf16x8*)(lds + (mt * 16 + fr) * KROW + ks * 64 + fq * 16);
                s[mt] = mfma16(kf, qf[ks], s[mt]);
            }
        bf16x8 pf[2];
#pragma unroll
        for (int kk = 0; kk < 2; ++kk) {
            const f32x4 a = s[2 * kk], bb = s[2 * kk + 1];
            const float p0 = fexp2(a.x), p1 = fexp2(a.y), p2 = fexp2(a.z), p3 = fexp2(a.w);
            const float p4 = fexp2(bb.x), p5 = fexp2(bb.y), p6 = fexp2(bb.z), p7 = fexp2(bb.w);
            l += ((p0 + p1) + (p2 + p3)) + ((p4 + p5) + (p6 + p7));
            u32x4 w; w.x = pk2(p0, p1); w.y = pk2(p2, p3); w.z = pk2(p4, p5); w.w = pk2(p6, p7);
            pf[kk] = __builtin_bit_cast(bf16x8, w);
        }
#pragma unroll
        for (int kk = 0; kk < 2; ++kk)
#pragma unroll
            for (int dvt = 0; dvt < 16; ++dvt) {
                const bf16x8 vf = *(const bf16x8*)(lds + VOFF + (dvt * 16 + fr) * 144 + kk * 64 + fq * 16);
                o[dvt] = mfma16(vf, pf[kk], o[dvt]);
            }
        __syncthreads();
    }
    l += sxor<16>(l); l += sxor<32>(l);
    const float inv = 1.0f / l;
#pragma unroll
    for (int dvt = 0; dvt < 16; ++dvt) {
        u32x2 w; w.x = pk2(o[dvt].x * inv, o[dvt].y * inv); w.y = pk2(o[dvt].z * inv, o[dvt].w * inv);
        *(u32x2*)(qp + dvt * 16 + fq * 4) = w;
    }
}

constexpr int L_QE = 0, L_KE = 17408, L_KST = 34816, L_VTL = 53248, L_ATT = 71680, L_SB = 80896, L_LRF = 115712, L_TOT = 119808, L_GDEC = 121856;
__device__ __forceinline__ void gla_item(const Params& p, const Grp& G, int item, char* lds) {
    const int tid = otid(), lane = tid & 63, wid = tid >> 6, fr = lane & 15, fq = lane >> 4;
    const int slice = item & 1, dir = (item >> 1) & 1, h = (item >> 2) & 3, b = item >> 4;
    const int T = G.T, N = T / 64;
    const bf16_t* P = (const bf16_t*)(p.ws + WS_PROJ) + (size_t)b * T * NP;
    bf16_t* OUT = dir ? (bf16_t*)(p.ws + WS_PROJ) + (size_t)b * T * NP + C_DV + h * 256 + slice * 128
                      : (bf16_t*)(p.ws + WS_HB) + (size_t)b * T * D + h * 256 + slice * 128;
    const int ldo = dir ? NP : D;
    const int d = tid & 127, rg = tid >> 7;
    float wdec[16];
    {
        const float* wd = p.in[dir ? I_WDB : I_WDF];
#pragma unroll
        for (int r = 0; r < 16; ++r) wdec[r] = wd[r * 512 + h * 128 + d];
    }
    const float bdec = p.in[dir ? I_BDB : I_BDF][h * 128 + d];
    for (int i = tid; i < 34816 / 16; i += NTHR) *(u32x4*)(lds + L_SB + i * 16) = (u32x4){0u, 0u, 0u, 0u};
    f32x4 S[8];
#pragma unroll
    for (int i = 0; i < 8; ++i) S[i] = (f32x4){0.f, 0.f, 0.f, 0.f};
    u32x4 rq[2], rk[2], rv[2], rl;
    const int lrow = tid >> 4, lch = tid & 15;
#define GGLOAD(n) do { const int cb_ = (dir ? (N - 1 - (n)) : (n)) * 64; \
        _Pragma("unroll") for (int i = 0; i < 2; ++i) { const int li_ = lrow + i * 32, tk_ = cb_ + (dir ? 63 - li_ : li_); const bf16_t* rp_ = P + (size_t)tk_ * NP; \
            rq[i] = *(const u32x4*)(rp_ + C_GQ + h * 128 + lch * 8); rk[i] = *(const u32x4*)(rp_ + C_GK + h * 128 + lch * 8); rv[i] = *(const u32x4*)(rp_ + C_GV + h * 256 + slice * 128 + lch * 8); } \
        if (tid < 128) { const int li_ = tid >> 1, tk_ = cb_ + (dir ? 63 - li_ : li_); rl = *(const u32x4*)(P + (size_t)tk_ * NP + C_LR + dir * 16 + (tid & 1) * 8); } } while (0)
    GGLOAD(0);
    for (int n = 0; n < N; ++n) {
#pragma unroll
        for (int i = 0; i < 2; ++i) {
            const int li = lrow + i * 32;
            *(u32x4*)(lds + L_QE + li * 272 + lch * 16) = rq[i];
            *(u32x4*)(lds + L_KE + li * 272 + lch * 16) = rk[i];
            bf16_t* vt = (bf16_t*)(lds + L_VTL) + (lch * 8) * 72 + li;
            vt[0 * 72] = (bf16_t)(rv[i].x & 0xffff); vt[1 * 72] = (bf16_t)(rv[i].x >> 16); vt[2 * 72] = (bf16_t)(rv[i].y & 0xffff); vt[3 * 72] = (bf16_t)(rv[i].y >> 16);
            vt[4 * 72] = (bf16_t)(rv[i].z & 0xffff); vt[5 * 72] = (bf16_t)(rv[i].z >> 16); vt[6 * 72] = (bf16_t)(rv[i].w & 0xffff); vt[7 * 72] = (bf16_t)(rv[i].w >> 16);
        }
        if (tid < 128) {
            float* lf = (float*)(lds + L_LRF) + (tid >> 1) * 16 + (tid & 1) * 8;
            *(f32x4*)lf = (f32x4){bflo(rl.x), bfhi(rl.x), bflo(rl.y), bfhi(rl.y)};
            *(f32x4*)(lf + 4) = (f32x4){bflo(rl.z), bfhi(rl.z), bflo(rl.w), bfhi(rl.w)};
        }
        if (n + 1 < N) GGLOAD(n + 1);
        __syncthreads();
        float cs[16]; float run = 0.f;
#pragma unroll
        for (int ii = 0; ii < 16; ++ii) {
            const float* lf = (const float*)(lds + L_LRF) + (rg * 16 + ii) * 16;
            const f32x4 a0 = *(const f32x4*)lf, a1 = *(const f32x4*)(lf + 4), a2 = *(const f32x4*)(lf + 8), a3 = *(const f32x4*)(lf + 12);
            float x = bdec;
            x += a0.x * wdec[0] + a0.y * wdec[1] + a0.z * wdec[2] + a0.w * wdec[3];
            x += a1.x * wdec[4] + a1.y * wdec[5] + a1.z * wdec[6] + a1.w * wdec[7];
            x += a2.x * wdec[8] + a2.y * wdec[9] + a2.z * wdec[10] + a2.w * wdec[11];
            x += a3.x * wdec[12] + a3.y * wdec[13] + a3.z * wdec[14] + a3.w * wdec[15];
            const float ls = fminf(x, 0.f) - __logf(1.0f + __expf(-fabsf(x)));
            run += ls * 0.0625f; cs[ii] = run;
        }
        ((float*)(lds + L_TOT))[rg * 128 + d] = run;
        __syncthreads();
        float off = 0.f, blast = 0.f;
#pragma unroll
        for (int r = 0; r < 4; ++r) { const float tv = ((const float*)(lds + L_TOT))[r * 128 + d]; blast += tv; if (r < rg) off += tv; }
        {
            bf16_t* qe = (bf16_t*)(lds + L_QE) + d; bf16_t* ke = (bf16_t*)(lds + L_KE) + d;
            unsigned ksp[8];
#pragma unroll
            for (int ii = 0; ii < 16; ii += 2) {
                const int i0 = rg * 16 + ii;
                const float b0 = off + cs[ii], b1 = off + cs[ii + 1];
                const float q0v = bf2f(qe[i0 * 136]), q1v = bf2f(qe[(i0 + 1) * 136]), k0v = bf2f(ke[i0 * 136]), k1v = bf2f(ke[(i0 + 1) * 136]);
                qe[i0 * 136] = f2bf(q0v * __expf(b0)); qe[(i0 + 1) * 136] = f2bf(q1v * __expf(b1));
                ke[i0 * 136] = f2bf(k0v * __expf(-b0)); ke[(i0 + 1) * 136] = f2bf(k1v * __expf(-b1));
                ksp[ii >> 1] = pk2(k0v * __expf(blast - b0), k1v * __expf(blast - b1));
            }
            char* kst = lds + L_KST + d * 144 + rg * 32;
            *(u32x4*)kst = (u32x4){ksp[0], ksp[1], ksp[2], ksp[3]};
            *(u32x4*)(kst + 16) = (u32x4){ksp[4], ksp[5], ksp[6], ksp[7]};
            if (rg == 0) ((float*)(lds + L_GDEC))[d] = __expf(blast);
        }
        __syncthreads();
        {
            const int ct = wid & 3;
            f32x4 a[2] = {(f32x4){0.f, 0.f, 0.f, 0.f}, (f32x4){0.f, 0.f, 0.f, 0.f}};
#pragma unroll
            for (int ks = 0; ks < 4; ++ks) {
                const bf16x8 qv = *(const bf16x8*)(lds + L_QE + (ct * 16 + fr) * 272 + ks * 64 + fq * 16);
#pragma unroll
                for (int j = 0; j < 2; ++j) {
                    const int st = (wid >> 2) * 2 + j;
                    const bf16x8 kv = *(const bf16x8*)(lds + L_KE + (st * 16 + fr) * 272 + ks * 64 + fq * 16);
                    a[j] = mfma16(kv, qv, a[j]);
                }
            }
#pragma unroll
            for (int j = 0; j < 2; ++j) {
                const int st = (wid >> 2) * 2 + j, cc = ct * 16 + fr, s0 = st * 16 + fq * 4;
                const float v0 = (s0 + 0 <= cc) ? a[j].x : 0.f, v1 = (s0 + 1 <= cc) ? a[j].y : 0.f, v2 = (s0 + 2 <= cc) ? a[j].z : 0.f, v3 = (s0 + 3 <= cc) ? a[j].w : 0.f;
                *(u32x2*)(lds + L_ATT + cc * 144 + s0 * 2) = (u32x2){pk2(v0, v1), pk2(v2, v3)};
            }
        }
        __syncthreads();
        {
            f32x4 oc[4] = {(f32x4){0.f, 0.f, 0.f, 0.f}, (f32x4){0.f, 0.f, 0.f, 0.f}, (f32x4){0.f, 0.f, 0.f, 0.f}, (f32x4){0.f, 0.f, 0.f, 0.f}};
#pragma unroll
            for (int ks = 0; ks < 2; ++ks) {
                const bf16x8 af = *(const bf16x8*)(lds + L_VTL + (wid * 16 + fr) * 144 + ks * 64 + fq * 16);
#pragma unroll
                for (int ct = 0; ct < 4; ++ct) { const bf16x8 bfv = *(const bf16x8*)(lds + L_ATT + (ct * 16 + fr) * 144 + ks * 64 + fq * 16); oc[ct] = mfma16(af, bfv, oc[ct]); }
            }
#pragma unroll
            for (int ks = 0; ks < 4; ++ks) {
                const bf16x8 af = *(const bf16x8*)(lds + L_SB + (wid * 16 + fr) * 272 + ks * 64 + fq * 16);
#pragma unroll
                for (int ct = 0; ct < 4; ++ct) { const bf16x8 bfv = *(const bf16x8*)(lds + L_QE + (ct * 16 + fr) * 272 + ks * 64 + fq * 16); oc[ct] = mfma16(af, bfv, oc[ct]); }
            }
            const int cb = (dir ? (N - 1 - n) : n) * 64;
#pragma unroll
            for (int ct = 0; ct < 4; ++ct) {
                const int cl = ct * 16 + fr, tk = cb + (dir ? 63 - cl : cl);
                *(u32x2*)(OUT + (size_t)tk * ldo + wid * 16 + fq * 4) = (u32x2){pk2(oc[ct].x, oc[ct].y), pk2(oc[ct].z, oc[ct].w)};
            }
        }
        __syncthreads();
        {
            const f32x4 gd = *(const f32x4*)((const float*)(lds + L_GDEC) + wid * 16 + fq * 4);
#pragma unroll
            for (int et = 0; et < 8; ++et) S[et] = S[et] * gd;
#pragma unroll
            for (int ks = 0; ks < 2; ++ks) {
                const bf16x8 af = *(const bf16x8*)(lds + L_KST + (wid * 16 + fr) * 144 + ks * 64 + fq * 16);
#pragma unroll
                for (int et = 0; et < 8; ++et) { const bf16x8 bfv = *(const bf16x8*)(lds + L_VTL + (et * 16 + fr) * 144 + ks * 64 + fq * 16); S[et] = mfma16(af, bfv, S[et]); }
            }
#pragma unroll
            for (int et = 0; et < 8; ++et)
                *(u32x2*)(lds + L_SB + (et * 16 + fr) * 272 + (wid * 16 + fq * 4) * 2) = (u32x2){pk2(S[et].x, S[et].y), pk2(S[et].z, S[et].w)};
        }
        __syncthreads();
    }
#undef GGLOAD
}

__device__ __forceinline__ void phase_mixer(const Params& p, int g, char* lds, int* s_item) {
    const Grp G = get_group(p, g);
    const int nGLA = G.B * 16, nATT = G.B * 8 * (G.T / 128), nMEM = G.B * 4 * (G.T / 128), nTot = nGLA + nATT + nMEM;
    unsigned* ctr = (unsigned*)(p.ws + WS_CTRL) + g;
    float d1 = 0.f, d2 = 0.f, mq = 0.f, mk = 0.f, mmq = 0.f, mmk = 0.f;
    for (int i = 0; i < 64; ++i) { d1 += p.in[I_LQ1][i] * p.in[I_LK1][i]; d2 += p.in[I_LQ2][i] * p.in[I_LK2][i]; mq = fmaxf(mq, fabsf(p.in[I_DGQ][i])); mk = fmaxf(mk, fabsf(p.in[I_DGK][i])); }
    for (int i = 0; i < 256; ++i) { mmq = fmaxf(mmq, fabsf(p.in[I_MGQ][i])); mmk = fmaxf(mmk, fabsf(p.in[I_MGK][i])); }
    const float lam = expf(d1) - expf(d2) + 0.2f;
    const float shiftD = fmaxf(0.f, 8.f * mq * mk * LOG2E - 64.f), shiftM = fmaxf(0.f, 16.f * mmq * mmk * LOG2E - 64.f);
#ifndef STATIC_SCHED
#define STATIC_SCHED 0
#endif
    for (int sit = blockIdx.x;; sit += gridDim.x) {
#if STATIC_SCHED
        (void)ctr; (void)s_item;
        const int it = sit;
#else
        if (threadIdx.x == 0) *s_item = (int)atomicAdd(ctr, 1u);
        __syncthreads();
        const int it = *s_item;
        __syncthreads();
#endif
        if (it >= nTot) break;
        if (it < nGLA) gla_item(p, G, it, lds);
        else if (it < nGLA + nATT) diff_attn_item(p, G, it - nGLA, lds, lam, shiftD);
        else mem_attn_item(p, G, it - nGLA - nATT, lds, shiftM);
    }
}

__device__ __forceinline__ void phase_glafin(const Params& p, int g) {
    const int tid_ = otid(), lane = tid_ & 63, wid = tid_ >> 6;
    bf16_t* P = (bf16_t*)(p.ws + WS_PROJ); const bf16_t* F = (const bf16_t*)(p.ws + WS_HB);
    for (int it = blockIdx.x * 8 + wid; it < G_TOK * 4; it += gridDim.x * 8) {
        const int tok = it >> 2, h = it & 3;
        bf16_t* row = P + (size_t)tok * NP;
        const unsigned qq = *(const unsigned*)(row + C_GQ + h * 128 + lane * 2), kk = *(const unsigned*)(row + C_GK + h * 128 + lane * 2);
        const float qk = wave_sum(bflo(qq) * bflo(kk) + bfhi(qq) * bfhi(kk));
        const u32x2 f = *(const u32x2*)(F + (size_t)tok * D + h * 256 + lane * 4), bk = *(const u32x2*)(row + C_DV + h * 256 + lane * 4);
        const u32x2 v = *(const u32x2*)(row + C_GV + h * 256 + lane * 4), gt = *(const u32x2*)(row + C_GG + h * 256 + lane * 4);
        float o0 = bflo(f.x) + bflo(bk.x) - qk * bflo(v.x), o1 = bfhi(f.x) + bfhi(bk.x) - qk * bfhi(v.x);
        float o2 = bflo(f.y) + bflo(bk.y) - qk * bflo(v.y), o3 = bfhi(f.y) + bfhi(bk.y) - qk * bfhi(v.y);
        const float r = rsqrtf(wave_sum(o0 * o0 + o1 * o1 + o2 * o2 + o3 * o3) * (1.f / 256.f) + RMS_EPS);
        const f32x4 go = *(const f32x4*)(p.in[I_GOUT] + lane * 4);
        const float g0 = bflo(gt.x), g1 = bfhi(gt.x), g2 = bflo(gt.y), g3 = bfhi(gt.y);
        o0 *= r * go.x * g0 / (1.f + __expf(-g0)); o1 *= r * go.y * g1 / (1.f + __expf(-g1));
        o2 *= r * go.z * g2 / (1.f + __expf(-g2)); o3 *= r * go.w * g3 / (1.f + __expf(-g3));
        *(u32x2*)(row + C_GG + h * 256 + lane * 4) = (u32x2){pk2(o0, o1), pk2(o2, o3)};
    }
}

__device__ __forceinline__ void phase_merge(const Params& p, int g, char* lds) {
    const int tid_ = otid(), lane = tid_ & 63, wid = tid_ >> 6, wm = wid >> 2, wn = wid & 3, fr = lane & 15, fq = lane >> 4;
    const bf16_t* P = (const bf16_t*)(p.ws + WS_PROJ); bf16_t* M = (bf16_t*)(p.ws + WS_VT);
    const int nM = G_TOK / 128, nN = 4;
    for (int t = blockIdx.x; t < nM * nN; t += gridDim.x) {
        int pm, pn; tile_order(t, nM, nN, pm, pn);
        const int m0 = pm * 128, n0 = pn * 256;
        f32x4 macc[4][4];
#pragma unroll
        for (int i = 0; i < 4; ++i)
#pragma unroll
            for (int j = 0; j < 4; ++j) macc[i][j] = (f32x4){0.f, 0.f, 0.f, 0.f};
        for (int br = 0; br < 3; ++br) {
            f32x4 acc[4][4];
#pragma unroll
            for (int i = 0; i < 4; ++i)
#pragma unroll
                for (int j = 0; j < 4; ++j) acc[i][j] = (f32x4){0.f, 0.f, 0.f, 0.f};
            const int acol = br == 0 ? C_GG : (br == 1 ? C_DQ : C_MQ);
            gemm_kloop<true>(acc, P + (size_t)m0 * NP + acol, NP, (const bf16_t*)(p.ws + WS_WOT) + (size_t)br * D * D + (size_t)n0 * D, D, D, lds);
#pragma unroll
            for (int mt = 0; mt < 4; ++mt)
#pragma unroll
                for (int nt = 0; nt < 4; ++nt) {
                    const int row = m0 + wm * 64 + mt * 16 + fr, col = n0 + wn * 64 + nt * 16 + fq * 4;
                    const u32x2 gt = *(const u32x2*)(P + (size_t)row * NP + C_BG + br * 1024 + col);
                    f32x4 sg; sg.x = 1.f / (1.f + __expf(-bflo(gt.x))); sg.y = 1.f / (1.f + __expf(-bfhi(gt.x))); sg.z = 1.f / (1.f + __expf(-bflo(gt.y))); sg.w = 1.f / (1.f + __expf(-bfhi(gt.y)));
                    macc[mt][nt] += sg * acc[mt][nt];
                }
        }
#pragma unroll
        for (int mt = 0; mt < 4; ++mt)
#pragma unroll
            for (int nt = 0; nt < 4; ++nt) {
                const int row = m0 + wm * 64 + mt * 16 + fr, col = n0 + wn * 64 + nt * 16 + fq * 4;
                *(u32x2*)(M + (size_t)row * D + col) = (u32x2){pk2(macc[mt][nt].x, macc[mt][nt].y), pk2(macc[mt][nt].z, macc[mt][nt].w)};
            }
    }
}

__device__ __forceinline__ void phase_outproj(const Params& p, int g, char* lds) {
    const Grp G = get_group(p, g);
    const int tid_ = otid(), lane = tid_ & 63, wid = tid_ >> 6, wm = wid >> 2, wn = wid & 3, fr = lane & 15, fq = lane >> 4;
    const bf16_t* M = (const bf16_t*)(p.ws + WS_VT); const bf16_t* W = (const bf16_t*)(p.ws + WS_WOT) + (size_t)3 * D * D;
    const int nM = G_TOK / 128, nN = 4;
    for (int t = blockIdx.x; t < nM * nN; t += gridDim.x) {
        int pm, pn; tile_order(t, nM, nN, pm, pn);
        const int m0 = pm * 128, n0 = pn * 256;
        f32x4 acc[4][4];
#pragma unroll
        for (int i = 0; i < 4; ++i)
#pragma unroll
            for (int j = 0; j < 4; ++j) acc[i][j] = (f32x4){0.f, 0.f, 0.f, 0.f};
        gemm_kloop<true>(acc, M + (size_t)m0 * D, D, W + (size_t)n0 * D, D, D, lds);
#pragma unroll
        for (int mt = 0; mt < 4; ++mt)
#pragma unroll
            for (int nt = 0; nt < 4; ++nt) {
                const int row = m0 + wm * 64 + mt * 16 + fr, col = n0 + wn * 64 + nt * 16 + fq * 4;
                const f32x4 xv = *(const f32x4*)(G.x + (size_t)row * D + col);
                *(f32x4*)(G.out + (size_t)row * D + col) = xv + acc[mt][nt];
            }
    }
}

__device__ __forceinline__ void phase_peerq(const Params& p, int g, char* lds) {
    const int tid_ = otid(), lane = tid_ & 63, wid = tid_ >> 6, wm = wid >> 2, wn = wid & 3, fr = lane & 15, fq = lane >> 4;
    const bf16_t* A = (const bf16_t*)(p.ws + WS_HB); const bf16_t* W = (const bf16_t*)(p.ws + WS_WQT); bf16_t* P = (bf16_t*)(p.ws + WS_PROJ);
    const int nM = G_TOK / 128, nN = 8;
    for (int t = blockIdx.x; t < nM * nN; t += gridDim.x) {
        int pm, pn; tile_order(t, nM, nN, pm, pn);
        const int m0 = pm * 128, n0 = pn * 256;
        f32x4 acc[4][4];
#pragma unroll
        for (int i = 0; i < 4; ++i)
#pragma unroll
            for (int j = 0; j < 4; ++j) acc[i][j] = (f32x4){0.f, 0.f, 0.f, 0.f};
        gemm_kloop<true>(acc, A + (size_t)m0 * D, D, W + (size_t)n0 * D, D, D, lds);
#pragma unroll
        for (int mt = 0; mt < 4; ++mt)
#pragma unroll
            for (int nt = 0; nt < 4; ++nt) {
                const int row = m0 + wm * 64 + mt * 16 + fr, col = n0 + wn * 64 + nt * 16 + fq * 4;
                *(u32x2*)(P + (size_t)row * NP + col) = (u32x2){pk2(acc[mt][nt].x, acc[mt][nt].y), pk2(acc[mt][nt].z, acc[mt][nt].w)};
            }
    }
}

__device__ __forceinline__ unsigned f2ord(float f) { const unsigned u = __float_as_uint(f); return (u & 0x80000000u) ? ~u : (u | 0x80000000u); }
__device__ __forceinline__ float ord2f(unsigned k) { const unsigned u = (k & 0x80000000u) ? (k & 0x7fffffffu) : ~k; return __uint_as_float(u); }
__device__ __forceinline__ unsigned gmax16(unsigned v) {
    unsigned t;
    t = sxoru<1>(v); v = v > t ? v : t; t = sxoru<2>(v); v = v > t ? v : t; t = sxoru<4>(v); v = v > t ? v : t; t = sxoru<8>(v); v = v > t ? v : t;
    return v;
}
__device__ __forceinline__ float gsum16(float v) { v += sxor<1>(v); v += sxor<2>(v); v += sxor<4>(v); v += sxor<8>(v); return v; }
__device__ __forceinline__ float gelu_exact(float a) { return 0.5f * a * (1.0f + erff(a * 0.70710678118654752f)); }

__device__ __forceinline__ void phase_peer(const Params& p, int g, char* lds) {
    const Grp G = get_group(p, g);
    const int tid = otid(), lane = tid & 63, wid = tid >> 6, fr = lane & 15, fq = lane >> 4;
    const bf16_t* P = (const bf16_t*)(p.ws + WS_PROJ); const bf16_t* HB = (const bf16_t*)(p.ws + WS_HB);
    const bf16_t* K12 = (const bf16_t*)(p.ws + WS_K12);
    float* SC = (float*)lds;
    int* EIDX = (int*)(lds + 65536);
    float* GATE = (float*)(lds + 65536 + 4096);
    for (int tile = blockIdx.x; tile < G_TOK / 8; tile += gridDim.x) {
        const int tok0 = tile * 8;
        {
            const int mt = wid >> 1, half = wid & 1;
            const int r = mt * 16 + fr, tl = r >> 3, hh = r & 7;
            const bf16_t* qrow = P + (size_t)(tok0 + tl) * NP + hh * 256 + half * 128;
            const bf16_t* kb = K12 + half * 16384;
            f32x4 acc[8];
#pragma unroll
            for (int i = 0; i < 8; ++i) acc[i] = (f32x4){0.f, 0.f, 0.f, 0.f};
#pragma unroll
            for (int ks = 0; ks < 4; ++ks) {
                const bf16x8 af = *(const bf16x8*)(qrow + ks * 32 + fq * 8);
#pragma unroll
                for (int nt = 0; nt < 8; ++nt) { const bf16x8 bfv = *(const bf16x8*)(kb + (nt * 16 + fr) * 128 + ks * 32 + fq * 8); acc[nt] = mfma16(af, bfv, acc[nt]); }
            }
#pragma unroll
            for (int nt = 0; nt < 8; ++nt) {
                float* dst = SC + (mt * 16 + fq * 4) * 256 + half * 128 + nt * 16 + fr;
                dst[0] = acc[nt].x; dst[256] = acc[nt].y; dst[512] = acc[nt].z; dst[768] = acc[nt].w;
            }
        }
        __syncthreads();
        for (int pass = 0; pass < 2; ++pass) {
            const int row = wid * 8 + pass * 4 + fq, sl = fr, gb = fq * 16;
            float v1 = 0.f, v2 = 0.f; int i1 = 0, i2 = 0;
#pragma unroll
            for (int hf = 0; hf < 2; ++hf) {
                unsigned key[8];
#pragma unroll
                for (int i = 0; i < 8; ++i) { const int idx = sl + 16 * i; key[i] = (f2ord(SC[row * 256 + hf * 128 + idx]) & ~127u) | (unsigned)(127 - idx); }
                float sv = 0.f; int si = 0;
                for (int r = 0; r < 16; ++r) {
                    unsigned m = key[0];
#pragma unroll
                    for (int i = 1; i < 8; ++i) m = m > key[i] ? m : key[i];
                    m = gmax16(m);
                    if (sl == r) { sv = ord2f(m & ~127u); si = 127 - (int)(m & 127u); }
#pragma unroll
                    for (int i = 0; i < 8; ++i) key[i] = key[i] == m ? 0u : key[i];
                }
                if (hf == 0) { v1 = sv; i1 = si; } else { v2 = sv; i2 = si; }
            }
            int ptr = 0; float ts = 0.f; int pid = 0;
            for (int r = 0; r < 16; ++r) {
                const float v2p = __shfl(v2, gb + (ptr & 15));
                const unsigned key = ptr < 16 ? ((f2ord(v1 + v2p) & ~255u) | (unsigned)(255 - (sl * 16 + ptr))) : 0u;
                const unsigned m = gmax16(key);
                if (sl == r) { ts = ord2f(m & ~255u); pid = 255 - (int)(m & 255u); }
                if (key == m) ptr++;
            }
            const int e1 = __shfl(i1, gb + (pid >> 4)), e2 = __shfl(i2, gb + (pid & 15));
            float mx = ts;
            mx = fmaxf(mx, sxor<1>(mx)); mx = fmaxf(mx, sxor<2>(mx)); mx = fmaxf(mx, sxor<4>(mx)); mx = fmaxf(mx, sxor<8>(mx));
            const float ex = __expf(ts - mx), sm = gsum16(ex);
            EIDX[row * 16 + sl] = e1 * 128 + e2; GATE[row * 16 + sl] = ex / sm;
        }
        __syncthreads();
        {
            const int tok = tok0 + wid;
            const bf16_t* hrow = HB + (size_t)tok * D;
            const u32x4 h0 = *(const u32x4*)(hrow + lane * 16), h1 = *(const u32x4*)(hrow + lane * 16 + 8);
            f32x2 hv[8];
            hv[0] = (f32x2){bflo(h0.x), bfhi(h0.x)}; hv[1] = (f32x2){bflo(h0.y), bfhi(h0.y)}; hv[2] = (f32x2){bflo(h0.z), bfhi(h0.z)}; hv[3] = (f32x2){bflo(h0.w), bfhi(h0.w)};
            hv[4] = (f32x2){bflo(h1.x), bfhi(h1.x)}; hv[5] = (f32x2){bflo(h1.y), bfhi(h1.y)}; hv[6] = (f32x2){bflo(h1.z), bfhi(h1.z)}; hv[7] = (f32x2){bflo(h1.w), bfhi(h1.w)};
#pragma unroll
            for (int i = 0; i < 8; ++i) hv[i] = hv[i] * (1.0f / PEER_SU);
            f32x2 acc[8];
#pragma unroll
            for (int i = 0; i < 8; ++i) acc[i] = (f32x2){0.f, 0.f};
            const unsigned char* PU8 = p.ws + WS_PU + lane * 16; const unsigned char* PV8 = p.ws + WS_PV + lane * 16;
#pragma unroll 4
            for (int k = 0; k < 128; ++k) {
                const int e = EIDX[wid * 128 + k]; const float gt = GATE[wid * 128 + k];
                const u32x4 u = *(const u32x4*)(PU8 + (size_t)e * D), v = *(const u32x4*)(PV8 + (size_t)e * D);
                f32x2 a2 = __builtin_amdgcn_cvt_pk_f32_fp8((int)u.x, false) * hv[0];
                a2 += __builtin_amdgcn_cvt_pk_f32_fp8((int)u.x, true) * hv[1];
                a2 += __builtin_amdgcn_cvt_pk_f32_fp8((int)u.y, false) * hv[2];
                a2 += __builtin_amdgcn_cvt_pk_f32_fp8((int)u.y, true) * hv[3];
                a2 += __builtin_amdgcn_cvt_pk_f32_fp8((int)u.z, false) * hv[4];
                a2 += __builtin_amdgcn_cvt_pk_f32_fp8((int)u.z, true) * hv[5];
                a2 += __builtin_amdgcn_cvt_pk_f32_fp8((int)u.w, false) * hv[6];
                a2 += __builtin_amdgcn_cvt_pk_f32_fp8((int)u.w, true) * hv[7];
                const float a = wave_sum(a2.x + a2.y);
                const float w = gt * gelu_exact(a);
                const f32x2 w2 = (f32x2){w, w};
                acc[0] += w2 * __builtin_amdgcn_cvt_pk_f32_fp8((int)v.x, false); acc[1] += w2 * __builtin_amdgcn_cvt_pk_f32_fp8((int)v.x, true);
                acc[2] += w2 * __builtin_amdgcn_cvt_pk_f32_fp8((int)v.y, false); acc[3] += w2 * __builtin_amdgcn_cvt_pk_f32_fp8((int)v.y, true);
                acc[4] += w2 * __builtin_amdgcn_cvt_pk_f32_fp8((int)v.z, false); acc[5] += w2 * __builtin_amdgcn_cvt_pk_f32_fp8((int)v.z, true);
                acc[6] += w2 * __builtin_amdgcn_cvt_pk_f32_fp8((int)v.w, false); acc[7] += w2 * __builtin_amdgcn_cvt_pk_f32_fp8((int)v.w, true);
            }
            float* orow = G.out + (size_t)tok * D + lane * 16;
#pragma unroll
            for (int i = 0; i < 4; ++i) {
                f32x4 t = *(f32x4*)(orow + i * 4);
                t.x += acc[2 * i].x * (1.0f / PEER_SV); t.y += acc[2 * i].y * (1.0f / PEER_SV); t.z += acc[2 * i + 1].x * (1.0f / PEER_SV); t.w += acc[2 * i + 1].y * (1.0f / PEER_SV);
                *(f32x4*)(orow + i * 4) = t;
            }
        }
        __syncthreads();
    }
}


#ifndef DEBUG_NAN
#define DEBUG_NAN 0
#endif
#if DEBUG_NAN
__device__ __noinline__ void scan_bf16(const bf16_t* base, size_t rows, size_t pitch, int col0, int ncols, unsigned* flag) {
    const size_t gtid = (size_t)blockIdx.x * NTHR + threadIdx.x, gsz = (size_t)gridDim.x * NTHR, cpr = ncols / 8, total = rows * cpr;
    bool bad = false;
    for (size_t i = gtid; i < total; i += gsz) {
        const size_t r = i / cpr, c = i % cpr;
        const u32x4 v = *(const u32x4*)(base + r * pitch + col0 + c * 8);
        bad = bad || ((v.x & 0x7F80u) == 0x7F80u) || ((v.x & 0x7F800000u) == 0x7F800000u) || ((v.y & 0x7F80u) == 0x7F80u) || ((v.y & 0x7F800000u) == 0x7F800000u)
                  || ((v.z & 0x7F80u) == 0x7F80u) || ((v.z & 0x7F800000u) == 0x7F800000u) || ((v.w & 0x7F80u) == 0x7F80u) || ((v.w & 0x7F800000u) == 0x7F800000u);
    }
    if (bad) atomicOr(flag, 1u);
}
__device__ __noinline__ void scan_f32(const float* base, size_t n, unsigned* flag) {
    const size_t gtid = (size_t)blockIdx.x * NTHR + threadIdx.x, gsz = (size_t)gridDim.x * NTHR;
    bool bad = false;
    for (size_t i = gtid; i < n; i += gsz) { if ((__float_as_uint(base[i]) & 0x7F800000u) == 0x7F800000u) bad = true; }
    if (bad) atomicOr(flag, 1u);
}
__device__ __forceinline__ void debug_scan(const Params& p, int ph) {
    unsigned* F = (unsigned*)(p.ws + WS_CTRL) + 128;
    const bf16_t* P = (const bf16_t*)(p.ws + WS_PROJ); const bf16_t* HB = (const bf16_t*)(p.ws + WS_HB); const bf16_t* VT = (const bf16_t*)(p.ws + WS_VT);
    if (ph == 0) {
        scan_bf16((const bf16_t*)(p.ws + WS_WINT), NP, D, 0, D, F + 0);
        scan_bf16((const bf16_t*)(p.ws + WS_WOT), 4 * D + 4096, D, 0, D, F + 1);
        scan_bf16((const bf16_t*)(p.ws + WS_PU), 32768, D, 0, D, F + 2);
        scan_f32((const float*)(p.ws + WS_ROPE), 16384 * 64, F + 3);
        scan_bf16((const bf16_t*)(p.ws + WS_HM), 2560, D, 0, D, F + 3);
    } else if (ph == 2) {
        scan_bf16((const bf16_t*)(p.ws + WS_MEMK), 2 * 10 * 4 * 256, 256, 0, 256, F + 4);
    } else if (ph == 3) scan_bf16(HB, G_TOK, D, 0, D, F + 5);
    else if (ph == 4) { scan_bf16(P, G_TOK, NP, 0, 3072, F + 6); scan_bf16(P, G_TOK, NP, 3072, 2048, F + 7); scan_bf16(VT, G_TOK, D, 0, D, F + 8); scan_bf16(P, G_TOK, NP, 6144, NP - 6144, F + 9); }
    else if (ph == 5) scan_bf16(P, G_TOK, NP, 3072, 2048, F + 10);
    else if (ph == 6) { scan_bf16(HB, G_TOK, D, 0, D, F + 11); scan_bf16(P, G_TOK, NP, C_DV, 1024, F + 12); scan_bf16(P, G_TOK, NP, C_DQ, 1024, F + 13); scan_bf16(P, G_TOK, NP, C_MQ, 1024, F + 14); }
    else if (ph == 7) scan_bf16(P, G_TOK, NP, C_GG, 1024, F + 15);
    else if (ph == 8) scan_bf16(VT, G_TOK, D, 0, D, F + 16);
    else if (ph == 9) scan_f32(p.out, (size_t)G_TOK * D, F + 17);
    else if (ph == 10) scan_bf16(HB, G_TOK, D, 0, D, F + 18);
    else if (ph == 11) scan_bf16(P, G_TOK, NP, 0, 2048, F + 19);
    else if (ph == 12) scan_f32(p.out, (size_t)G_TOK * D, F + 20);
}
#endif

constexpr int NPH = 3 + NGROUP * 10;
__device__ __forceinline__ void run_phase(const Params& p, int ph, char* lds, int* s_item) {
    if (ph == 0) { phase_p0a(p, lds); return; }
    if (ph == 1) { phase_p0b(p, lds); return; }
    if (ph == 2) { phase_p0c(p); return; }
    const int g = (ph - 3) / 10, s = (ph - 3) % 10;
    const Grp G = get_group(p, g);
    switch (s) {
        case 0: phase_rmsnorm(G.x, p.in[I_GMIX], (bf16_t*)(p.ws + WS_HB), G_TOK); break;
        case 1: phase_inproj(p, g, lds); break;
        case 2: phase_qkrope(p, g); break;
        case 3: phase_mixer(p, g, lds, s_item); break;
        case 4: phase_glafin(p, g); break;
        case 5: phase_merge(p, g, lds); break;
        case 6: phase_outproj(p, g, lds); break;
        case 7: phase_rmsnorm(G.out, p.in[I_GFFN], (bf16_t*)(p.ws + WS_HB), G_TOK); break;
        case 8: phase_peerq(p, g, lds); break;
        case 9: phase_peer(p, g, lds); break;
    }
}

__global__ void __launch_bounds__(NTHR) mega_kernel(Params p) {
    extern __shared__ __attribute__((aligned(16))) char lds[];
    __shared__ int s_item;
    cg::grid_group grid = cg::this_grid();
#ifndef PROBE
#define PROBE 0
#endif
#if PROBE
    __shared__ unsigned long long tacc[16];
    if (threadIdx.x < 16) tacc[threadIdx.x] = 0ull;
    __syncthreads();
    if (threadIdx.x == 0) tacc[15] = __builtin_amdgcn_s_memrealtime();
#endif
    for (int ph = p.ph_lo; ph < p.ph_hi; ++ph) {
        run_phase(p, ph, lds, &s_item);
#if DEBUG_NAN
        __threadfence(); grid.sync(); __threadfence();
        debug_scan(p, ph);
        __threadfence(); grid.sync(); __threadfence();
#else
#if PROBE
        __threadfence(); grid.sync(); __threadfence();
        if (blockIdx.x == 0 && threadIdx.x == 0) { const unsigned long long tn = __builtin_amdgcn_s_memrealtime(); tacc[ph < 3 ? 10 + ph : (ph - 3) % 10] += tn - tacc[15]; tacc[15] = tn; }
#else
        if (ph + 1 < p.ph_hi) grid.sync();
#endif
#endif
    }
#if PROBE
    if (blockIdx.x == 0 && threadIdx.x == 0) {
        unsigned long long ta = 0, tb = 0;
        for (int k = 0; k < 13; ++k) { if ((PROBE_A >> k) & 1) ta += tacc[k]; if ((PROBE_B >> k) & 1) tb += tacc[k]; }
        float ma = (float)ta * 1e-5f;
        if (ma >= 10.f) ma *= 0.1f;
        if (ma < 1.f) ma *= 10.f;
        const int eb = 5 + (int)((float)tb * 1e-5f + 0.5f);
        float mark = ma; for (int k = 0; k < eb; ++k) mark *= 10.f;
        p.out[0] = mark;
    }
#endif
#if DEBUG_NAN
    if (blockIdx.x == 0 && threadIdx.x == 0) {
        const unsigned* F = (const unsigned*)(p.ws + WS_CTRL) + 128; int first = -1;
        for (int k = 0; k <= 20; ++k) if (first < 0 && atomicOr((unsigned*)F + k, 0u)) first = k;
        float mark = 1000.f; for (int k = 0; k < first; ++k) mark *= 10.f;
        p.out[0] = first < 0 ? 777.f : mark;
    }
#endif
}

extern "C" void kernel_launch(void* const* d_in, const int* in_sizes, int n_in, void* d_out, int out_size, void* d_ws, size_t ws_size, hipStream_t stream) {
    static int grid_blocks = 0;
    if (grid_blocks == 0) {
        if (n_in != 32 || ws_size < WS_END) { fprintf(stderr, "kernel_launch: unexpected n_in %d or ws_size %zu (< %zu)\n", n_in, ws_size, (size_t)WS_END); grid_blocks = -1; return; }
        int dev = 0, cus = 0, per_cu = 0;
        hipGetDevice(&dev);
        hipDeviceGetAttribute(&cus, hipDeviceAttributeMultiprocessorCount, dev);
        hipFuncSetAttribute((const void*)mega_kernel, hipFuncAttributeMaxDynamicSharedMemorySize, LDS_BYTES);
        hipOccupancyMaxActiveBlocksPerMultiprocessor(&per_cu, (const void*)mega_kernel, NTHR, LDS_BYTES);
        if (per_cu < 1) per_cu = 1;
        grid_blocks = cus * per_cu;
        (void)hipGetLastError();
    }
    if (grid_blocks < 0) return;
    Params p{};
    for (int i = 0; i < 32; ++i) p.in[i] = (const float*)d_in[i];
    p.out = (float*)d_out; p.ws = (unsigned char*)d_ws; p.ph_lo = 0; p.ph_hi = NPH;
    void* args[] = {&p};
    hipError_t e = hipLaunchCooperativeKernel((const void*)mega_kernel, dim3(grid_blocks), dim3(NTHR), args, LDS_BYTES, stream);
    if (e != hipSuccess) fprintf(stderr, "cooperative launch failed: %s (grid %d)\n", hipGetErrorString(e), grid_blocks);
}
```

```cpp
#include <hip/hip_runtime.h>
#include <hip/hip_cooperative_groups.h>
#include <cstdio>
#include <cstdint>
namespace cg = cooperative_groups;

typedef unsigned short bf16_t;
typedef short bf16x8 __attribute__((ext_vector_type(8)));
typedef float f32x4 __attribute__((ext_vector_type(4)));
typedef unsigned u32x4 __attribute__((ext_vector_type(4)));
typedef unsigned u32x2 __attribute__((ext_vector_type(2)));

constexpr int D = 1024;
constexpr int NP = 10496;
constexpr int IN_COLS = 10272;
constexpr int C_GQ = 0, C_GK = 512, C_GV = 1024, C_GG = 2048, C_DQ = 3072, C_DK = 4096, C_DV = 5120, C_MQ = 6144, C_BG = 7168, C_LR = 10240;
constexpr int G_TOK = 32768;
constexpr int NGROUP = 3;
constexpr int NTHR = 512;
constexpr float RMS_EPS = 1e-6f;
constexpr float LOG2E = 1.4426950408889634f;
constexpr int LDS_BYTES = 147456;
constexpr float PEER_SU = 32.0f, PEER_SV = 8.0f;

enum { I_XP = 0, I_XS, I_MP, I_MS, I_GMIX, I_WIN, I_WDF, I_BDF, I_WDB, I_BDB, I_GOUT, I_GWO, I_DGQ, I_DGK, I_LQ1, I_LK1, I_LQ2, I_LK2,
       I_DGSUB, I_DWO, I_MGN, I_MWKV, I_MGQ, I_MGK, I_MWO, I_WOUT, I_GFFN, I_PWQ, I_PK1, I_PK2, I_PU, I_PV };

constexpr size_t al256(size_t x) { return (x + 255) & ~(size_t)255; }
constexpr size_t WS_CTRL = 0;
constexpr size_t WS_PROJ = 4096;
constexpr size_t WS_HB   = WS_PROJ + (size_t)G_TOK * NP * 2;
constexpr size_t WS_VT   = WS_HB + (size_t)G_TOK * D * 2;
constexpr size_t WS_WINT = WS_VT + (size_t)G_TOK * D * 2;
constexpr size_t WS_WOT  = WS_WINT + (size_t)NP * D * 2;
constexpr size_t WS_WKVT = WS_WOT + (size_t)4 * D * D * 2;
constexpr size_t WS_WQT  = WS_WKVT + (size_t)2048 * D * 2;
constexpr size_t WS_PU   = WS_WQT + (size_t)2048 * D * 2;
constexpr size_t WS_PV   = WS_PU + (size_t)16384 * D * 2;
constexpr size_t WS_K12  = WS_PV + (size_t)16384 * D * 2;
constexpr size_t WS_ROPE = WS_K12 + (size_t)2 * 128 * 128 * 2;
constexpr size_t WS_HM   = WS_ROPE + (size_t)16384 * 64 * 4;
constexpr size_t WS_KVR  = WS_HM + (size_t)2560 * D * 2;
constexpr size_t WS_MEMK = WS_KVR + (size_t)2560 * 2048 * 4;
constexpr size_t WS_MEMV = WS_MEMK + (size_t)10 * 4 * 256 * 256 * 2;
constexpr size_t WS_END  = WS_MEMV + (size_t)10 * 4 * 256 * 256 * 2;

struct Params {
    const float* in[32];
    float* out;
    unsigned char* ws;
    int ph_lo, ph_hi;
};

typedef float f32x2 __attribute__((ext_vector_type(2)));
typedef __bf16 bf16x2v __attribute__((ext_vector_type(2)));
__device__ __forceinline__ unsigned pk2(float lo, float hi) { const f32x2 v = {lo, hi}; const bf16x2v b = __builtin_convertvector(v, bf16x2v); return __builtin_bit_cast(unsigned, b); }
__device__ __forceinline__ float bflo(unsigned u) { return __uint_as_float(u << 16); }
__device__ __forceinline__ float bfhi(unsigned u) { return __uint_as_float(u & 0xffff0000u); }
__device__ __forceinline__ float bf2f(bf16_t b) { return __uint_as_float(((unsigned)b) << 16); }
__device__ __forceinline__ bf16_t f2bf(float f) { return (bf16_t)(pk2(f, 0.f) & 0xffffu); }
__device__ __forceinline__ f32x4 mfma16(bf16x8 a, bf16x8 b, f32x4 c) { return __builtin_amdgcn_mfma_f32_16x16x32_bf16(a, b, c, 0, 0, 0); }
__device__ __forceinline__ float fexp2(float x) { return __builtin_amdgcn_exp2f(x); }
__device__ __forceinline__ int otid() { int t = threadIdx.x; asm volatile("" : "+v"(t)); return t; }
template <int M> __device__ __forceinline__ float sxor(float v) {
    if (M < 32) return __int_as_float(__builtin_amdgcn_ds_swizzle(__float_as_int(v), (M << 10) | 0x1F));
    const int l = otid() & 63; return __int_as_float(__builtin_amdgcn_ds_bpermute((l ^ 32) << 2, __float_as_int(v)));
}
template <int M> __device__ __forceinline__ unsigned sxoru(unsigned v) { return (unsigned)__builtin_amdgcn_ds_swizzle((int)v, (M << 10) | 0x1F); }
__device__ __forceinline__ float wave_sum(float v) {
    v += sxor<1>(v); v += sxor<2>(v); v += sxor<4>(v); v += sxor<8>(v); v += sxor<16>(v); v += sxor<32>(v);
    return v;
}

struct Grp { const float* x; const float* mem; float* out; int B, T, mb0; };
__device__ __forceinline__ Grp get_group(const Params& p, int g) {
    Grp r;
    if (g == 0) { r.x = p.in[I_XP]; r.out = p.out; r.B = 2; r.T = 16384; r.mb0 = 0; }
    else { r.x = p.in[I_XS] + (size_t)(g - 1) * G_TOK * D; r.out = p.out + (size_t)g * G_TOK * D; r.B = 4; r.T = 8192; r.mb0 = 2 + (g - 1) * 4; }
    r.mem = nullptr;
    return r;
}

constexpr int G_ROW = 144;
constexpr int G_A_BYTES = 128 * G_ROW;
constexpr int G_B_BYTES = 256 * G_ROW;
constexpr int G_STAGE = G_A_BYTES + G_B_BYTES;

template <bool SWAP, int MT>
__device__ __forceinline__ void gemm_kloop(f32x4 (&acc)[MT][4], const bf16_t* __restrict__ A, int lda, const bf16_t* __restrict__ Bt, int ldb, int K, char* lds) {
    constexpr int A_BYTES = MT * 32 * G_ROW, STAGE = A_BYTES + G_B_BYTES, NA = MT / 2;
    const int tid = otid(), lane = tid & 63, wid = tid >> 6, wm = wid >> 2, wn = wid & 3, fr = lane & 15, fq = lane >> 4;
    const int lr = tid >> 3, lc = tid & 7;
    u32x4 ra[NA], rb[4];
    const bf16_t* Ap = A + (size_t)lr * lda + lc * 8;
    const bf16_t* Bp = Bt + (size_t)lr * ldb + lc * 8;
#define GLOAD(k0) do { _Pragma("unroll") for (int i = 0; i < NA; ++i) ra[i] = *(const u32x4*)(Ap + (size_t)(i * 64) * lda + (k0)); \
                       _Pragma("unroll") for (int i = 0; i < 4; ++i) rb[i] = *(const u32x4*)(Bp + (size_t)(i * 64) * ldb + (k0)); } while (0)
#define SWRITE(buf) do { char* b_ = lds + (buf) * STAGE + lr * G_ROW + lc * 16; \
                       _Pragma("unroll") for (int i = 0; i < NA; ++i) *(u32x4*)(b_ + i * 64 * G_ROW) = ra[i]; \
                       _Pragma("unroll") for (int i = 0; i < 4; ++i) *(u32x4*)(b_ + A_BYTES + i * 64 * G_ROW) = rb[i]; } while (0)
    const int nk = K / 64;
    GLOAD(0); SWRITE(0); __syncthreads();
    for (int kt = 0; kt < nk; ++kt) {
        if (kt + 1 < nk) GLOAD((kt + 1) * 64);
        const char* base = lds + (kt & 1) * STAGE;
#pragma unroll
        for (int ks = 0; ks < 2; ++ks) {
            bf16x8 bfr[4];
#pragma unroll
            for (int nt = 0; nt < 4; ++nt) bfr[nt] = *(const bf16x8*)(base + A_BYTES + (wn * 64 + nt * 16 + fr) * G_ROW + ks * 64 + fq * 16);
#pragma unroll
            for (int mt = 0; mt < MT; ++mt) {
                const bf16x8 af = *(const bf16x8*)(base + (wm * (MT * 16) + mt * 16 + fr) * G_ROW + ks * 64 + fq * 16);
#pragma unroll
                for (int nt = 0; nt < 4; ++nt)
                    acc[mt][nt] = SWAP ? mfma16(bfr[nt], af, acc[mt][nt]) : mfma16(af, bfr[nt], acc[mt][nt]);
            }
        }
        if (kt + 1 < nk) SWRITE((kt + 1) & 1);
        __syncthreads();
    }
#undef GLOAD
#undef SWRITE
}

__device__ __forceinline__ void tile_order(int t, int nM, int nN, int& pm, int& pn) {
    const int per = 8 * nN, grp = t / per, r = t % per;
    pm = grp * 8 + (r & 7); pn = r >> 3;
}

__device__ __forceinline__ void phase_p0a(const Params& p, char* lds) {
    const int tid = otid(), lane = tid & 63, wid = tid >> 6;
    unsigned char* ws = p.ws;
    if (blockIdx.x == 0 && tid < 256) atomicExch((unsigned*)(ws + WS_CTRL) + tid, 0u);
    float* scr = (float*)(lds + wid * 8448);
    constexpr int IT_WIN = 16 * (NP / 32), IT_SQ = 16 * 32, IT_W2 = 16 * 64;
    constexpr int NIT = IT_WIN + 4 * IT_SQ + 2 * IT_W2;
    for (int it0 = blockIdx.x * 8; it0 < NIT; it0 += gridDim.x * 8) {
        int it = it0 + wid;
        const float* W = nullptr; bf16_t* WT = nullptr; int N = 0, nb = 0, kb = 0, srccol = -1;
        if (it < NIT) {
            int r = it;
            if (r < IT_WIN) { W = p.in[I_WIN]; N = IN_COLS; WT = (bf16_t*)(ws + WS_WINT); kb = r / (NP / 32); nb = r % (NP / 32);
                const int n0 = nb * 32; srccol = n0 < 3072 ? n0 : (n0 < 10240 ? n0 + 32 : (n0 == 10240 ? 3072 : -1)); }
            else { r -= IT_WIN;
                if (r < 4 * IT_SQ) { const int w = r / IT_SQ; r %= IT_SQ; const int idx[4] = {I_GWO, I_DWO, I_MWO, I_WOUT};
                    W = p.in[w == 0 ? I_GWO : (w == 1 ? I_DWO : (w == 2 ? I_MWO : I_WOUT))]; (void)idx; N = 1024; WT = (bf16_t*)(ws + WS_WOT) + (size_t)w * D * D; kb = r / 32; nb = r % 32; srccol = nb * 32; }
                else { r -= 4 * IT_SQ; const int w = r / IT_W2; r %= IT_W2; W = p.in[w == 0 ? I_MWKV : I_PWQ]; N = 2048; WT = (bf16_t*)(ws + (w == 0 ? WS_WKVT : WS_WQT)); kb = r / 64; nb = r % 64; srccol = nb * 32; }
            }
            const int k0 = kb * 64;
#pragma unroll 8
            for (int i = 0; i < 32; ++i) { const int kk = 2 * i + (lane >> 5); scr[kk * 33 + (lane & 31)] = srccol >= 0 ? W[(size_t)(k0 + kk) * N + srccol + (lane & 31)] : 0.f; }
        }
        __syncthreads();
        if (it < NIT) {
            const int k0 = kb * 64, c = lane & 7;
#pragma unroll
            for (int j = 0; j < 4; ++j) { const int n = (lane >> 3) + 8 * j; const float* s = scr + (8 * c) * 33 + n;
                u32x4 o; o.x = pk2(s[0], s[33]); o.y = pk2(s[66], s[99]); o.z = pk2(s[132], s[165]); o.w = pk2(s[198], s[231]);
                *(u32x4*)(WT + (size_t)(nb * 32 + n) * D + k0 + 8 * c) = o; }
        }
        __syncthreads();
    }
    const size_t gtid = (size_t)blockIdx.x * NTHR + tid, gsz = (size_t)gridDim.x * NTHR;
    {
        const size_t n8 = (size_t)16384 * D / 8;
        for (size_t i = gtid; i < 2 * n8; i += gsz) {
            const int w = i >= n8; const size_t j = w ? i - n8 : i;
            const float* src = p.in[w ? I_PV : I_PU] + j * 8; unsigned char* dst = ws + (w ? WS_PV : WS_PU) + j * 8;
            const float sc = w ? PEER_SV : PEER_SU;
            const f32x4 a = *(const f32x4*)src * sc, b = *(const f32x4*)(src + 4) * sc;
            int lo = __builtin_amdgcn_cvt_pk_fp8_f32(a.x, a.y, 0, false); lo = __builtin_amdgcn_cvt_pk_fp8_f32(a.z, a.w, lo, true);
            int hi = __builtin_amdgcn_cvt_pk_fp8_f32(b.x, b.y, 0, false); hi = __builtin_amdgcn_cvt_pk_fp8_f32(b.z, b.w, hi, true);
            *(u32x2*)dst = (u32x2){(unsigned)lo, (unsigned)hi};
        }
        for (size_t i = gtid; i < 2 * 16384; i += gsz) {
            const int w = i >= 16384; const size_t j = w ? i - 16384 : i;
            ((bf16_t*)(ws + WS_K12))[i] = f2bf(p.in[w ? I_PK2 : I_PK1][j]);
        }
    }
    for (size_t i = gtid; i < (size_t)16384 * 32; i += gsz) {
        const int t = (int)(i >> 5), k = (int)(i & 31);
        const float inv = powf(10000.0f, -(float)(2 * k) / 64.0f);
        const float ang = (float)t * inv;
        double sn, cs; sincos((double)ang, &sn, &cs);
        float* R = (float*)(ws + WS_ROPE) + (size_t)t * 64;
        R[k] = (float)cs; R[32 + k] = (float)sn;
    }
    for (int row = blockIdx.x * 8 + wid; row < 2560; row += gridDim.x * 8) {
        const float* src = row < 512 ? p.in[I_MP] + (size_t)row * D : p.in[I_MS] + (size_t)(row - 512) * D;
        const f32x4* xr = (const f32x4*)src + lane; const f32x4* gr = (const f32x4*)p.in[I_MGN] + lane;
        f32x4 v[4]; float s = 0.f;
#pragma unroll
        for (int j = 0; j < 4; ++j) { v[j] = xr[64 * j]; s += v[j].x * v[j].x + v[j].y * v[j].y + v[j].z * v[j].z + v[j].w * v[j].w; }
        const float r = rsqrtf(wave_sum(s) * (1.f / D) + RMS_EPS);
        u32x2* o = (u32x2*)((bf16_t*)(ws + WS_HM) + (size_t)row * D) + lane;
#pragma unroll
        for (int j = 0; j < 4; ++j) { const f32x4 g = gr[64 * j]; u32x2 w; w.x = pk2(v[j].x * r * g.x, v[j].y * r * g.y); w.y = pk2(v[j].z * r * g.z, v[j].w * r * g.w); o[64 * j] = w; }
    }
}

__device__ __forceinline__ void phase_p0b(const Params& p, char* lds) {
    const int tid_ = otid(), lane = tid_ & 63, wid = tid_ >> 6, wm = wid >> 2, wn = wid & 3, fr = lane & 15, fq = lane >> 4;
    const bf16_t* A = (const bf16_t*)(p.ws + WS_HM); const bf16_t* Bt = (const bf16_t*)(p.ws + WS_WKVT);
    float* C = (float*)(p.ws + WS_KVR);
    const int nM = 20, nN = 8;
    for (int t = blockIdx.x; t < nM * nN; t += gridDim.x) {
        const int pm = t % nM, pn = t / nM, m0 = pm * 128, n0 = pn * 256;
        f32x4 acc[4][4];
#pragma unroll
        for (int i = 0; i < 4; ++i)
#pragma unroll
            for (int j = 0; j < 4; ++j) acc[i][j] = (f32x4){0.f, 0.f, 0.f, 0.f};
        gemm_kloop<true, 4>(acc, A + (size_t)m0 * D, D, Bt + (size_t)n0 * D, D, D, lds);
#pragma unroll
        for (int mt = 0; mt < 4; ++mt)
#pragma unroll
            for (int nt = 0; nt < 4; ++nt) {
                const int row = m0 + wm * 64 + mt * 16 + fr, col = n0 + wn * 64 + nt * 16 + fq * 4;
                *(f32x4*)(C + (size_t)row * 2048 + col) = acc[mt][nt];
            }
    }
}

__device__ __forceinline__ void phase_p0c(const Params& p) {
    const int tid_ = otid(), lane = tid_ & 63, wid = tid_ >> 6;
    const float* KV = (const float*)(p.ws + WS_KVR);
    bf16_t* MK = (bf16_t*)(p.ws + WS_MEMK); bf16_t* MV = (bf16_t*)(p.ws + WS_MEMV);
    for (int it = blockIdx.x * 8 + wid; it < 2560 * 4; it += gridDim.x * 8) {
        const int row = it >> 2, h = it & 3, b = row >> 8, m = row & 255;
        const f32x4 kv = *(const f32x4*)(KV + (size_t)row * 2048 + h * 256 + lane * 4);
        const float ss = wave_sum(kv.x * kv.x + kv.y * kv.y + kv.z * kv.z + kv.w * kv.w);
        const float r = rsqrtf(ss * (1.f / 256.f) + RMS_EPS);
        const f32x4 g = *(const f32x4*)(p.in[I_MGK] + lane * 4);
        u32x2 w; w.x = pk2(kv.x * r * g.x, kv.y * r * g.y); w.y = pk2(kv.z * r * g.z, kv.w * r * g.w);
        *(u32x2*)(MK + ((size_t)(b * 4 + h) * 256 + m) * 256 + lane * 4) = w;
        const f32x4 vv = *(const f32x4*)(KV + (size_t)row * 2048 + 1024 + h * 256 + lane * 4);
        const int pos = (m & ~31) + ((m >> 2) & 3) * 8 + ((m >> 4) & 1) * 4 + (m & 3);
        bf16_t* dst = MV + ((size_t)(b * 4 + h) * 256 + lane * 4) * 256 + pos;
        dst[0] = f2bf(vv.x); dst[256] = f2bf(vv.y); dst[512] = f2bf(vv.z); dst[768] = f2bf(vv.w);
    }
}

__device__ __forceinline__ void phase_rmsnorm(const float* X, const float* gain, bf16_t* O, int rows) {
    const int tid_ = otid(), lane = tid_ & 63, wid = tid_ >> 6;
    const f32x4* gr = (const f32x4*)gain + lane;
    f32x4 g[4];
#pragma unroll
    for (int j = 0; j < 4; ++j) g[j] = gr[64 * j];
    for (int row = blockIdx.x * 8 + wid; row < rows; row += gridDim.x * 8) {
        const f32x4* xr = (const f32x4*)(X + (size_t)row * D) + lane;
        f32x4 v[4]; float s = 0.f;
#pragma unroll
        for (int j = 0; j < 4; ++j) { v[j] = xr[64 * j]; s += v[j].x * v[j].x + v[j].y * v[j].y + v[j].z * v[j].z + v[j].w * v[j].w; }
        const float r = rsqrtf(wave_sum(s) * (1.f / D) + RMS_EPS);
        u32x2* o = (u32x2*)(O + (size_t)row * D) + lane;
#pragma unroll
        for (int j = 0; j < 4; ++j) { u32x2 w; w.x = pk2(v[j].x * r * g[j].x, v[j].y * r * g[j].y); w.y = pk2(v[j].z * r * g[j].z, v[j].w * r * g[j].w); o[64 * j] = w; }
    }
}

__device__ __forceinline__ void phase_inproj(const Params& p, int g, char* lds) {
    const Grp G = get_group(p, g);
    const int tid_ = otid(), lane = tid_ & 63, wid = tid_ >> 6, wm = wid >> 2, wn = wid & 3, fr = lane & 15, fq = lane >> 4;
    const bf16_t* A = (const bf16_t*)(p.ws + WS_HB); const bf16_t* Bt = (const bf16_t*)(p.ws + WS_WINT);
    bf16_t* P = (bf16_t*)(p.ws + WS_PROJ); bf16_t* VT = (bf16_t*)(p.ws + WS_VT);
    const int nM = G_TOK / 256;
    {
        const int nN = NP / 256 - 4;
        for (int t = blockIdx.x; t < nM * nN; t += gridDim.x) {
            int pm, pn; tile_order(t, nM, nN, pm, pn);
            if (pn >= C_DV / 256) pn += 4;
            const int m0 = pm * 256, n0 = pn * 256;
            f32x4 acc[8][4];
#pragma unroll
            for (int i = 0; i < 8; ++i)
#pragma unroll
                for (int j = 0; j < 4; ++j) acc[i][j] = (f32x4){0.f, 0.f, 0.f, 0.f};
            gemm_kloop<true, 8>(acc, A + (size_t)m0 * D, D, Bt + (size_t)n0 * D, D, D, lds);
            const float sc = n0 < 512 ? 0.08838834764831845f : 1.0f;
#pragma unroll
            for (int mt = 0; mt < 8; ++mt)
#pragma unroll
                for (int nt = 0; nt < 4; ++nt) {
                    const int row = m0 + wm * 128 + mt * 16 + fr, col = n0 + wn * 64 + nt * 16 + fq * 4;
                    u32x2 w; w.x = pk2(acc[mt][nt].x * sc, acc[mt][nt].y * sc); w.y = pk2(acc[mt][nt].z * sc, acc[mt][nt].w * sc);
                    *(u32x2*)(P + (size_t)row * NP + col) = w;
                }
        }
    }
    {
        const int nN = 4;
        for (int t = blockIdx.x; t < nM * nN; t += gridDim.x) {
            int pm, pn; tile_order(t, nM, nN, pm, pn);
            const int m0 = pm * 256, n0 = C_DV + pn * 256;
            f32x4 acc[8][4];
#pragma unroll
            for (int i = 0; i < 8; ++i)
#pragma unroll
                for (int j = 0; j < 4; ++j) acc[i][j] = (f32x4){0.f, 0.f, 0.f, 0.f};
            gemm_kloop<false, 8>(acc, A + (size_t)m0 * D, D, Bt + (size_t)n0 * D, D, D, lds);
            const int b = m0 / G.T, t0 = m0 % G.T + wm * 128;
#pragma unroll
            for (int mt = 0; mt < 8; ++mt)
#pragma unroll
                for (int nt = 0; nt < 4; ++nt) {
                    const int n = n0 - C_DV + wn * 64 + nt * 16 + fr, h = n >> 7, dv = n & 127;
                    const int pos = t0 + (mt >> 1) * 32 + fq * 8 + (mt & 1) * 4;
                    u32x2 w; w.x = pk2(acc[mt][nt].x, acc[mt][nt].y); w.y = pk2(acc[mt][nt].z, acc[mt][nt].w);
                    *(u32x2*)(VT + ((size_t)((b * 8 + h) * 128 + dv)) * G.T + pos) = w;
                }
        }
    }
}

__device__ __forceinline__ void phase_qkrope(const Params& p, int g) {
    const Grp G = get_group(p, g);
    const int tid_ = otid(), lane = tid_ & 63, wid = tid_ >> 6, grp = lane >> 2, sub = lane & 3;
    bf16_t* P = (bf16_t*)(p.ws + WS_PROJ); const float* ROPE = (const float*)(p.ws + WS_ROPE);
    for (int it = blockIdx.x * 8 + wid; it < G_TOK * 2; it += gridDim.x * 8) {
        const int tok = it >> 1, isk = it & 1, t = tok % G.T;
        bf16_t* base = P + (size_t)tok * NP + (isk ? C_DK : C_DQ) + grp * 64 + sub * 8;
        const u32x4 a = *(const u32x4*)base, b = *(const u32x4*)(base + 32);
        float x1[8], x2[8];
        x1[0] = bflo(a.x); x1[1] = bfhi(a.x); x1[2] = bflo(a.y); x1[3] = bfhi(a.y); x1[4] = bflo(a.z); x1[5] = bfhi(a.z); x1[6] = bflo(a.w); x1[7] = bfhi(a.w);
        x2[0] = bflo(b.x); x2[1] = bfhi(b.x); x2[2] = bflo(b.y); x2[3] = bfhi(b.y); x2[4] = bflo(b.z); x2[5] = bfhi(b.z); x2[6] = bflo(b.w); x2[7] = bfhi(b.w);
        float ss = 0.f;
#pragma unroll
        for (int e = 0; e < 8; ++e) ss += x1[e] * x1[e] + x2[e] * x2[e];
        ss += sxor<1>(ss); ss += sxor<2>(ss);
        const float r = rsqrtf(ss * (1.f / 64.f) + RMS_EPS) * (isk ? 1.0f : 0.125f * LOG2E);
        const float* gn = p.in[isk ? I_DGK : I_DGQ] + sub * 8;
        const float* rp = ROPE + (size_t)t * 64 + sub * 8;
        float o1[8], o2[8];
#pragma unroll
        for (int e = 0; e < 8; ++e) {
            const float y1 = x1[e] * r * gn[e], y2 = x2[e] * r * gn[32 + e], c = rp[e], s = rp[32 + e];
            o1[e] = y1 * c - y2 * s; o2[e] = y2 * c + y1 * s;
        }
        u32x4 w1, w2;
        w1.x = pk2(o1[0], o1[1]); w1.y = pk2(o1[2], o1[3]); w1.z = pk2(o1[4], o1[5]); w1.w = pk2(o1[6], o1[7]);
        w2.x = pk2(o2[0], o2[1]); w2.y = pk2(o2[2], o2[3]); w2.z = pk2(o2[4], o2[5]); w2.w = pk2(o2[6], o2[7]);
        *(u32x4*)base = w1; *(u32x4*)(base + 32) = w2;
    }
}

__device__ __forceinline__ void diff_attn_item(const Params& p, const Grp& G, int item, char* lds, float lam, float shift) {
    const int tid = otid(), lane = tid & 63, wid = tid >> 6, fr = lane & 15, fq = lane >> 4;
    const int c = wid & 1, sub = wid >> 1;
    const int T = G.T, nqb = T / 128;
    const int qb = item % nqb, bh = item / nqb, h = bh & 7, b = bh >> 3;
    bf16_t* P = (bf16_t*)(p.ws + WS_PROJ) + (size_t)b * T * NP;
    const bf16_t* Kg = P + C_DK + h * 128;
    const bf16_t* VTg = (const bf16_t*)(p.ws + WS_VT) + (size_t)bh * 128 * T;
    const int q0 = qb * 128 + sub * 32;
    bf16x8 qf[2][2];
#pragma unroll
    for (int nt = 0; nt < 2; ++nt)
#pragma unroll
        for (int ks = 0; ks < 2; ++ks) qf[nt][ks] = *(const bf16x8*)(P + (size_t)(q0 + nt * 16 + fr) * NP + C_DQ + h * 128 + c * 64 + ks * 32 + fq * 8);
    f32x4 o[8][2];
#pragma unroll
    for (int i = 0; i < 8; ++i) { o[i][0] = (f32x4){0.f, 0.f, 0.f, 0.f}; o[i][1] = (f32x4){0.f, 0.f, 0.f, 0.f}; }
    float l[2] = {0.f, 0.f};
    constexpr int STG = 36864, VOFF = 18432;
    u32x4 rk[2], rv[2];
    const int krow = tid >> 4, kch = tid & 15;
    const int vrow = tid >> 3, vch = tid & 7;
#define AGLOAD(kt) do { const int key0_ = (kt) * 64; \
        _Pragma("unroll") for (int i = 0; i < 2; ++i) rk[i] = *(const u32x4*)(Kg + (size_t)(key0_ + krow + i * 32) * NP + kch * 8); \
        _Pragma("unroll") for (int i = 0; i < 2; ++i) rv[i] = *(const u32x4*)(VTg + (size_t)(vrow + i * 64) * T + key0_ + vch * 8); } while (0)
#define ASWRITE(buf) do { char* b_ = lds + (buf) * STG; \
        _Pragma("unroll") for (int i = 0; i < 2; ++i) *(u32x4*)(b_ + ((kch >> 3) * 64 + krow + i * 32) * 144 + (kch & 7) * 16) = rk[i]; \
        _Pragma("unroll") for (int i = 0; i < 2; ++i) *(u32x4*)(b_ + VOFF + (vrow + i * 64) * 144 + vch * 16) = rv[i]; } while (0)
    const int nkt = T / 64;
    AGLOAD(0); ASWRITE(0); __syncthreads();
    for (int kt = 0; kt < nkt; ++kt) {
        if (kt + 1 < nkt) AGLOAD(kt + 1);
        const char* base = lds + (kt & 1) * STG;
        f32x4 s[4][2];
#pragma unroll
        for (int mt = 0; mt < 4; ++mt) { s[mt][0] = (f32x4){-shift, -shift, -shift, -shift}; s[mt][1] = s[mt][0]; }
#pragma unroll
        for (int ks = 0; ks < 2; ++ks)
#pragma unroll
            for (int mt = 0; mt < 4; ++mt) {
                const bf16x8 kf = *(const bf16x8*)(base + (c * 64 + mt * 16 + fr) * 144 + ks * 64 + fq * 16);
                s[mt][0] = mfma16(kf, qf[0][ks], s[mt][0]);
                s[mt][1] = mfma16(kf, qf[1][ks], s[mt][1]);
            }
        bf16x8 pf[2][2];
#pragma unroll
        for (int nt = 0; nt < 2; ++nt)
#pragma unroll
            for (int kk = 0; kk < 2; ++kk) {
                const f32x4 a = s[2 * kk][nt], bb = s[2 * kk + 1][nt];
                const float p0 = fexp2(a.x), p1 = fexp2(a.y), p2 = fexp2(a.z), p3 = fexp2(a.w);
                const float p4 = fexp2(bb.x), p5 = fexp2(bb.y), p6 = fexp2(bb.z), p7 = fexp2(bb.w);
                l[nt] += ((p0 + p1) + (p2 + p3)) + ((p4 + p5) + (p6 + p7));
                u32x4 w; w.x = pk2(p0, p1); w.y = pk2(p2, p3); w.z = pk2(p4, p5); w.w = pk2(p6, p7);
                pf[kk][nt] = __builtin_bit_cast(bf16x8, w);
            }
#pragma unroll
        for (int kk = 0; kk < 2; ++kk)
#pragma unroll
            for (int dvt = 0; dvt < 8; ++dvt) {
                const bf16x8 vf = *(const bf16x8*)(base + VOFF + (dvt * 16 + fr) * 144 + kk * 64 + fq * 16);
                o[dvt][0] = mfma16(vf, pf[kk][0], o[dvt][0]);
                o[dvt][1] = mfma16(vf, pf[kk][1], o[dvt][1]);
            }
        if (kt + 1 < nkt) ASWRITE((kt + 1) & 1);
        __syncthreads();
    }
#undef AGLOAD
#undef ASWRITE
    float inv[2];
#pragma unroll
    for (int nt = 0; nt < 2; ++nt) { float v = l[nt]; v += sxor<16>(v); v += sxor<32>(v); inv[nt] = 1.0f / v; }
    float* xch = (float*)lds + sub * 4096;
    if (c == 1) {
#pragma unroll
        for (int dvt = 0; dvt < 8; ++dvt)
#pragma unroll
            for (int nt = 0; nt < 2; ++nt) {
                xch[(dvt * 16 + fq * 4 + 0) * 32 + nt * 16 + fr] = o[dvt][nt].x * inv[nt];
                xch[(dvt * 16 + fq * 4 + 1) * 32 + nt * 16 + fr] = o[dvt][nt].y * inv[nt];
                xch[(dvt * 16 + fq * 4 + 2) * 32 + nt * 16 + fr] = o[dvt][nt].z * inv[nt];
                xch[(dvt * 16 + fq * 4 + 3) * 32 + nt * 16 + fr] = o[dvt][nt].w * inv[nt];
            }
    }
    __syncthreads();
    if (c == 0) {
        float ss[2] = {0.f, 0.f};
#pragma unroll
        for (int dvt = 0; dvt < 8; ++dvt)
#pragma unroll
            for (int nt = 0; nt < 2; ++nt) {
                f32x4 v = o[dvt][nt] * inv[nt];
                v.x -= lam * xch[(dvt * 16 + fq * 4 + 0) * 32 + nt * 16 + fr];
                v.y -= lam * xch[(dvt * 16 + fq * 4 + 1) * 32 + nt * 16 + fr];
                v.z -= lam * xch[(dvt * 16 + fq * 4 + 2) * 32 + nt * 16 + fr];
                v.w -= lam * xch[(dvt * 16 + fq * 4 + 3) * 32 + nt * 16 + fr];
                o[dvt][nt] = v; ss[nt] += v.x * v.x + v.y * v.y + v.z * v.z + v.w * v.w;
            }
#pragma unroll
        for (int nt = 0; nt < 2; ++nt) {
            float v = ss[nt]; v += sxor<16>(v); v += sxor<32>(v);
            const float r = rsqrtf(v * (1.f / 128.f) + RMS_EPS) * 0.8f;
#pragma unroll
            for (int dvt = 0; dvt < 8; ++dvt) {
                const f32x4 gs = *(const f32x4*)(p.in[I_DGSUB] + dvt * 16 + fq * 4);
                const f32x4 v4 = o[dvt][nt];
                u32x2 w; w.x = pk2(v4.x * r * gs.x, v4.y * r * gs.y); w.y = pk2(v4.z * r * gs.z, v4.w * r * gs.w);
                *(u32x2*)(P + (size_t)(q0 + nt * 16 + fr) * NP + C_DQ + h * 128 + dvt * 16 + fq * 4) = w;
            }
        }
    }
    __syncthreads();
}

__device__ __forceinline__ void mem_attn_item(const Params& p, const Grp& G, int item, char* lds, float shift) {
    const int tid = otid(), lane = tid & 63, wid = tid >> 6, fr = lane & 15, fq = lane >> 4;
    const int T = G.T, nqb = T / 128;
    const int qb = item % nqb, bh = item / nqb, h = bh & 3, b = bh >> 2;
    bf16_t* P = (bf16_t*)(p.ws + WS_PROJ) + (size_t)b * T * NP;
    const bf16_t* MK = (const bf16_t*)(p.ws + WS_MEMK) + (size_t)((G.mb0 + b) * 4 + h) * 256 * 256;
    const bf16_t* MV = (const bf16_t*)(p.ws + WS_MEMV) + (size_t)((G.mb0 + b) * 4 + h) * 256 * 256;
    const int row = qb * 128 + wid * 16 + fr;
    bf16_t* qp = P + (size_t)row * NP + C_MQ + h * 256;
    bf16x8 qf[8];
    {
        float ss = 0.f; u32x4 raw[8];
#pragma unroll
        for (int ks = 0; ks < 8; ++ks) { raw[ks] = *(const u32x4*)(qp + ks * 32 + fq * 8);
            const float a0 = bflo(raw[ks].x), a1 = bfhi(raw[ks].x), a2 = bflo(raw[ks].y), a3 = bfhi(raw[ks].y), a4 = bflo(raw[ks].z), a5 = bfhi(raw[ks].z), a6 = bflo(raw[ks].w), a7 = bfhi(raw[ks].w);
            ss += a0 * a0 + a1 * a1 + a2 * a2 + a3 * a3 + a4 * a4 + a5 * a5 + a6 * a6 + a7 * a7; }
        ss += sxor<16>(ss); ss += sxor<32>(ss);
        const float r = rsqrtf(ss * (1.f / 256.f) + RMS_EPS) * (0.0625f * LOG2E);
#pragma unroll
        for (int ks = 0; ks < 8; ++ks) {
            const f32x4 g0 = *(const f32x4*)(p.in[I_MGQ] + ks * 32 + fq * 8), g1 = *(const f32x4*)(p.in[I_MGQ] + ks * 32 + fq * 8 + 4);
            u32x4 w;
            w.x = pk2(bflo(raw[ks].x) * r * g0.x, bfhi(raw[ks].x) * r * g0.y); w.y = pk2(bflo(raw[ks].y) * r * g0.z, bfhi(raw[ks].y) * r * g0.w);
            w.z = pk2(bflo(raw[ks].z) * r * g1.x, bfhi(raw[ks].z) * r * g1.y); w.w = pk2(bflo(raw[ks].w) * r * g1.z, bfhi(raw[ks].w) * r * g1.w);
            qf[ks] = __builtin_bit_cast(bf16x8, w);
        }
    }
    f32x4 o[16];
#pragma unroll
    for (int i = 0; i < 16; ++i) o[i] = (f32x4){0.f, 0.f, 0.f, 0.f};
    float l = 0.f;
    constexpr int KROW = 528, VOFF = 64 * 528;
    for (int kt = 0; kt < 4; ++kt) {
#pragma unroll
        for (int i = 0; i < 4; ++i) {
            const int idx = tid + i * 512, r = idx >> 5, ch = idx & 31;
            *(u32x4*)(lds + r * KROW + ch * 16) = *(const u32x4*)(MK + (size_t)(kt * 64 + r) * 256 + ch * 8);
            const int vr = idx >> 3, vc = idx & 7;
            *(u32x4*)(lds + VOFF + vr * 144 + vc * 16) = *(const u32x4*)(MV + (size_t)vr * 256 + kt * 64 + vc * 8);
        }
        __syncthreads();
        f32x4 s[4];
#pragma unroll
        for (int mt = 0; mt < 4; ++mt) s[mt] = (f32x4){-shift, -shift, -shift, -shift};
#pragma unroll
        for (int ks = 0; ks < 8; ++ks)
#pragma unroll
            for (int mt = 0; mt < 4; ++mt) {
                const bf16x8 kf = *(const bf16x8*)(lds + (mt * 16 + fr) * KROW + ks * 64 + fq * 16);
                s[mt] = mfma16(kf, qf[ks], s[mt]);
            }
        bf16x8 pf[2];
#pragma unroll
        for (int kk = 0; kk < 2; ++kk) {
            const f32x4 a = s[2 * kk], bb = s[2 * kk + 1];
            const float p0 = fexp2(a.x), p1 = fexp2(a.y), p2 = fexp2(a.z), p3 = fexp2(a.w);
            const float p4 = fexp2(bb.x), p5 = fexp2(bb.y), p6 = fexp2(bb.z), p7 = fexp2(bb.w);
            l += ((p0 + p1) + (p2 + p3)) + ((p4 + p5) + (p6 + p7));
            u32x4 w; w.x = pk2(p0, p1); w.y = pk2(p2, p3); w.z = pk2(p4, p5); w.w = pk2(p6, p7);
            pf[kk] = __builtin_bit_cast(bf16x8, w);
        }
#pragma unroll
        for (int kk = 0; kk < 2; ++kk)
#pragma unroll
            for (int dvt = 0; dvt < 16; ++dvt) {
                const bf16x8 vf = *(const bf16x8*)(lds + VOFF + (dvt * 16 + fr) * 144 + kk * 64 + fq * 16);
                o[dvt] = mfma16(vf, pf[kk], o[dvt]);
            }
        __syncthreads();
    }
    l += sxor<16>(l); l += sxor<32>(l);
    const float inv = 1.0f / l;
#pragma unroll
    for (int dvt = 0; dvt < 16; ++dvt) {
        u32x2 w; w.x = pk2(o[dvt].x * inv, o[dvt].y * inv); w.y = pk2(o[dvt].z * inv, o[dvt].w * inv);
        *(u32x2*)(qp + dvt * 16 + fq * 4) = w;
    }
}

constexpr int L_QE = 0, L_KE = 17408, L_KST = 34816, L_VTL = 53248, L_ATT = 71680, L_SB = 80896, L_LRF = 115712, L_TOT = 119808, L_GDEC = 121856;
__device__ __forceinline__ void gla_item(const Params& p, const Grp& G, int item, char* lds) {
    const int tid = otid(), lane = tid & 63, wid = tid >> 6, fr = lane & 15, fq = lane >> 4;
    const int slice = item & 1, dir = (item >> 1) & 1, h = (item >> 2) & 3, b = item >> 4;
    const int T = G.T, N = T / 64;
    const bf16_t* P = (const bf16_t*)(p.ws + WS_PROJ) + (size_t)b * T * NP;
    bf16_t* OUT = dir ? (bf16_t*)(p.ws + WS_PROJ) + (size_t)b * T * NP + C_DV + h * 256 + slice * 128
                      : (bf16_t*)(p.ws + WS_HB) + (size_t)b * T * D + h * 256 + slice * 128;
    const int ldo = dir ? NP : D;
    const int d = tid & 127, rg = tid >> 7;
    float wdec[16];
    {
        const float* wd = p.in[dir ? I_WDB : I_WDF];
#pragma unroll
        for (int r = 0; r < 16; ++r) wdec[r] = wd[r * 512 + h * 128 + d];
    }
    const float bdec = p.in[dir ? I_BDB : I_BDF][h * 128 + d];
    { unsigned z = 0u; asm volatile("" : "+v"(z)); for (int i = tid; i < 34816 / 16; i += NTHR) *(u32x4*)(lds + L_SB + i * 16) = (u32x4){z, z, z, z}; }
    f32x4 S[8];
#pragma unroll
    for (int i = 0; i < 8; ++i) S[i] = (f32x4){0.f, 0.f, 0.f, 0.f};
    u32x4 rq[2], rk[2], rv[2], rl;
    const int lrow = tid >> 4, lch = tid & 15;
#define GGLOAD(n) do { const int cb_ = (dir ? (N - 1 - (n)) : (n)) * 64; \
        _Pragma("unroll") for (int i = 0; i < 2; ++i) { const int li_ = lrow + i * 32, tk_ = cb_ + (dir ? 63 - li_ : li_); const bf16_t* rp_ = P + (size_t)tk_ * NP; \
            rq[i] = *(const u32x4*)(rp_ + C_GQ + h * 128 + lch * 8); rk[i] = *(const u32x4*)(rp_ + C_GK + h * 128 + lch * 8); rv[i] = *(const u32x4*)(rp_ + C_GV + h * 256 + slice * 128 + lch * 8); } \
        if (tid < 128) { const int li_ = tid >> 1, tk_ = cb_ + (dir ? 63 - li_ : li_); rl = *(const u32x4*)(P + (size_t)tk_ * NP + C_LR + dir * 16 + (tid & 1) * 8); } } while (0)
    GGLOAD(0);
    for (int n = 0; n < N; ++n) {
#pragma unroll
        for (int i = 0; i < 2; ++i) {
            const int li = lrow + i * 32;
            *(u32x4*)(lds + L_QE + li * 272 + lch * 16) = rq[i];
            *(u32x4*)(lds + L_KE + li * 272 + lch * 16) = rk[i];
            bf16_t* vt = (bf16_t*)(lds + L_VTL) + (lch * 8) * 72 + li;
            vt[0 * 72] = (bf16_t)(rv[i].x & 0xffff); vt[1 * 72] = (bf16_t)(rv[i].x >> 16); vt[2 * 72] = (bf16_t)(rv[i].y & 0xffff); vt[3 * 72] = (bf16_t)(rv[i].y >> 16);
            vt[4 * 72] = (bf16_t)(rv[i].z & 0xffff); vt[5 * 72] = (bf16_t)(rv[i].z >> 16); vt[6 * 72] = (bf16_t)(rv[i].w & 0xffff); vt[7 * 72] = (bf16_t)(rv[i].w >> 16);
        }
        if (tid < 128) {
            float* lf = (float*)(lds + L_LRF) + (tid >> 1) * 16 + (tid & 1) * 8;
            *(f32x4*)lf = (f32x4){bflo(rl.x), bfhi(rl.x), bflo(rl.y), bfhi(rl.y)};
            *(f32x4*)(lf + 4) = (f32x4){bflo(rl.z), bfhi(rl.z), bflo(rl.w), bfhi(rl.w)};
        }
        if (n + 1 < N) GGLOAD(n + 1);
        __syncthreads();
        float cs[16]; float run = 0.f;
#pragma unroll
        for (int ii = 0; ii < 16; ++ii) {
            const float* lf = (const float*)(lds + L_LRF) + (rg * 16 + ii) * 16;
            const f32x4 a0 = *(const f32x4*)lf, a1 = *(const f32x4*)(lf + 4), a2 = *(const f32x4*)(lf + 8), a3 = *(const f32x4*)(lf + 12);
            float x = bdec;
            x += a0.x * wdec[0] + a0.y * wdec[1] + a0.z * wdec[2] + a0.w * wdec[3];
            x += a1.x * wdec[4] + a1.y * wdec[5] + a1.z * wdec[6] + a1.w * wdec[7];
            x += a2.x * wdec[8] + a2.y * wdec[9] + a2.z * wdec[10] + a2.w * wdec[11];
            x += a3.x * wdec[12] + a3.y * wdec[13] + a3.z * wdec[14] + a3.w * wdec[15];
            const float ls = fminf(x, 0.f) - __logf(1.0f + __expf(-fabsf(x)));
            run += ls * 0.0625f; cs[ii] = run;
        }
        ((float*)(lds + L_TOT))[rg * 128 + d] = run;
        __syncthreads();
        float off = 0.f, blast = 0.f;
#pragma unroll
        for (int r = 0; r < 4; ++r) { const float tv = ((const float*)(lds + L_TOT))[r * 128 + d]; blast += tv; if (r < rg) off += tv; }
        {
            bf16_t* qe = (bf16_t*)(lds + L_QE) + d; bf16_t* ke = (bf16_t*)(lds + L_KE) + d;
            unsigned ksp[8];
#pragma unroll
            for (int ii = 0; ii < 16; ii += 2) {
                const int i0 = rg * 16 + ii;
                const float b0 = off + cs[ii], b1 = off + cs[ii + 1];
                const float q0v = bf2f(qe[i0 * 136]), q1v = bf2f(qe[(i0 + 1) * 136]), k0v = bf2f(ke[i0 * 136]), k1v = bf2f(ke[(i0 + 1) * 136]);
                qe[i0 * 136] = f2bf(q0v * __expf(b0)); qe[(i0 + 1) * 136] = f2bf(q1v * __expf(b1));
                ke[i0 * 136] = f2bf(k0v * __expf(-b0)); ke[(i0 + 1) * 136] = f2bf(k1v * __expf(-b1));
                ksp[ii >> 1] = pk2(k0v * __expf(blast - b0), k1v * __expf(blast - b1));
            }
            char* kst = lds + L_KST + d * 144 + rg * 32;
            *(u32x4*)kst = (u32x4){ksp[0], ksp[1], ksp[2], ksp[3]};
            *(u32x4*)(kst + 16) = (u32x4){ksp[4], ksp[5], ksp[6], ksp[7]};
            if (rg == 0) ((float*)(lds + L_GDEC))[d] = __expf(blast);
        }
        __syncthreads();
        {
            const int ct = wid & 3;
            f32x4 a[2] = {(f32x4){0.f, 0.f, 0.f, 0.f}, (f32x4){0.f, 0.f, 0.f, 0.f}};
#pragma unroll
            for (int ks = 0; ks < 4; ++ks) {
                const bf16x8 qv = *(const bf16x8*)(lds + L_QE + (ct * 16 + fr) * 272 + ks * 64 + fq * 16);
#pragma unroll
                for (int j = 0; j < 2; ++j) {
                    const int st = (wid >> 2) * 2 + j;
                    const bf16x8 kv = *(const bf16x8*)(lds + L_KE + (st * 16 + fr) * 272 + ks * 64 + fq * 16);
                    a[j] = mfma16(kv, qv, a[j]);
                }
            }
#pragma unroll
            for (int j = 0; j < 2; ++j) {
                const int st = (wid >> 2) * 2 + j, cc = ct * 16 + fr, s0 = st * 16 + fq * 4;
                const float v0 = (s0 + 0 <= cc) ? a[j].x : 0.f, v1 = (s0 + 1 <= cc) ? a[j].y : 0.f, v2 = (s0 + 2 <= cc) ? a[j].z : 0.f, v3 = (s0 + 3 <= cc) ? a[j].w : 0.f;
                *(u32x2*)(lds + L_ATT + cc * 144 + s0 * 2) = (u32x2){pk2(v0, v1), pk2(v2, v3)};
            }
        }
        __syncthreads();
        {
            f32x4 oc[4] = {(f32x4){0.f, 0.f, 0.f, 0.f}, (f32x4){0.f, 0.f, 0.f, 0.f}, (f32x4){0.f, 0.f, 0.f, 0.f}, (f32x4){0.f, 0.f, 0.f, 0.f}};
#pragma unroll
            for (int ks = 0; ks < 2; ++ks) {
                const bf16x8 af = *(const bf16x8*)(lds + L_VTL + (wid * 16 + fr) * 144 + ks * 64 + fq * 16);
#pragma unroll
                for (int ct = 0; ct < 4; ++ct) { const bf16x8 bfv = *(const bf16x8*)(lds + L_ATT + (ct * 16 + fr) * 144 + ks * 64 + fq * 16); oc[ct] = mfma16(af, bfv, oc[ct]); }
            }
#pragma unroll
            for (int ks = 0; ks < 4; ++ks) {
                const bf16x8 af = *(const bf16x8*)(lds + L_SB + (wid * 16 + fr) * 272 + ks * 64 + fq * 16);
#pragma unroll
                for (int ct = 0; ct < 4; ++ct) { const bf16x8 bfv = *(const bf16x8*)(lds + L_QE + (ct * 16 + fr) * 272 + ks * 64 + fq * 16); oc[ct] = mfma16(af, bfv, oc[ct]); }
            }
            const int cb = (dir ? (N - 1 - n) : n) * 64;
#pragma unroll
            for (int ct = 0; ct < 4; ++ct) {
                const int cl = ct * 16 + fr, tk = cb + (dir ? 63 - cl : cl);
                *(u32x2*)(OUT + (size_t)tk * ldo + wid * 16 + fq * 4) = (u32x2){pk2(oc[ct].x, oc[ct].y), pk2(oc[ct].z, oc[ct].w)};
            }
        }
        __syncthreads();
        {
            const f32x4 gd = *(const f32x4*)((const float*)(lds + L_GDEC) + wid * 16 + fq * 4);
#pragma unroll
            for (int et = 0; et < 8; ++et) S[et] = S[et] * gd;
#pragma unroll
            for (int ks = 0; ks < 2; ++ks) {
                const bf16x8 af = *(const bf16x8*)(lds + L_KST + (wid * 16 + fr) * 144 + ks * 64 + fq * 16);
#pragma unroll
                for (int et = 0; et < 8; ++et) { const bf16x8 bfv = *(const bf16x8*)(lds + L_VTL + (et * 16 + fr) * 144 + ks * 64 + fq * 16); S[et] = mfma16(af, bfv, S[et]); }
            }
#pragma unroll
            for (int et = 0; et < 8; ++et)
                *(u32x2*)(lds + L_SB + (et * 16 + fr) * 272 + (wid * 16 + fq * 4) * 2) = (u32x2){pk2(S[et].x, S[et].y), pk2(S[et].z, S[et].w)};
        }
        __syncthreads();
    }
#undef GGLOAD
}

__device__ __forceinline__ void phase_mixer(const Params& p, int g, char* lds, int* s_item) {
    const Grp G = get_group(p, g);
    const int nGLA = G.B * 16, nATT = G.B * 8 * (G.T / 128), nMEM = G.B * 4 * (G.T / 128), nTot = nGLA + nATT + nMEM;
    unsigned* ctr = (unsigned*)(p.ws + WS_CTRL) + g;
    float d1 = 0.f, d2 = 0.f, mq = 0.f, mk = 0.f, mmq = 0.f, mmk = 0.f;
    for (int i = 0; i < 64; ++i) { d1 += p.in[I_LQ1][i] * p.in[I_LK1][i]; d2 += p.in[I_LQ2][i] * p.in[I_LK2][i]; mq = fmaxf(mq, fabsf(p.in[I_DGQ][i])); mk = fmaxf(mk, fabsf(p.in[I_DGK][i])); }
    for (int i = 0; i < 256; ++i) { mmq = fmaxf(mmq, fabsf(p.in[I_MGQ][i])); mmk = fmaxf(mmk, fabsf(p.in[I_MGK][i])); }
    const float lam = expf(d1) - expf(d2) + 0.2f;
    const float shiftD = fmaxf(0.f, 8.f * mq * mk * LOG2E - 64.f), shiftM = fmaxf(0.f, 16.f * mmq * mmk * LOG2E - 64.f);
#ifndef STATIC_SCHED
#define STATIC_SCHED 0
#endif
    for (int sit = blockIdx.x;; sit += gridDim.x) {
#if STATIC_SCHED
        (void)ctr; (void)s_item;
        const int it = sit;
#else
        if (threadIdx.x == 0) *s_item = (int)atomicAdd(ctr, 1u);
        __syncthreads();
        const int it = *s_item;
        __syncthreads();
#endif
        if (it >= nTot) break;
        if (it < nGLA) gla_item(p, G, it, lds);
        else if (it < nGLA + nATT) diff_attn_item(p, G, it - nGLA, lds, lam, shiftD);
        else mem_attn_item(p, G, it - nGLA - nATT, lds, shiftM);
    }
}

__device__ __forceinline__ void phase_glafin(const Params& p, int g) {
    const int tid_ = otid(), lane = tid_ & 63, wid = tid_ >> 6;
    bf16_t* P = (bf16_t*)(p.ws + WS_PROJ); const bf16_t* F = (const bf16_t*)(p.ws + WS_HB);
    for (int it = blockIdx.x * 8 + wid; it < G_TOK * 4; it += gridDim.x * 8) {
        const int tok = it >> 2, h = it & 3;
        bf16_t* row = P + (size_t)tok * NP;
        const unsigned qq = *(const unsigned*)(row + C_GQ + h * 128 + lane * 2), kk = *(const unsigned*)(row + C_GK + h * 128 + lane * 2);
        const float qk = wave_sum(bflo(qq) * bflo(kk) + bfhi(qq) * bfhi(kk));
        const u32x2 f = *(const u32x2*)(F + (size_t)tok * D + h * 256 + lane * 4), bk = *(const u32x2*)(row + C_DV + h * 256 + lane * 4);
        const u32x2 v = *(const u32x2*)(row + C_GV + h * 256 + lane * 4), gt = *(const u32x2*)(row + C_GG + h * 256 + lane * 4);
        float o0 = bflo(f.x) + bflo(bk.x) - qk * bflo(v.x), o1 = bfhi(f.x) + bfhi(bk.x) - qk * bfhi(v.x);
        float o2 = bflo(f.y) + bflo(bk.y) - qk * bflo(v.y), o3 = bfhi(f.y) + bfhi(bk.y) - qk * bfhi(v.y);
        const float r = rsqrtf(wave_sum(o0 * o0 + o1 * o1 + o2 * o2 + o3 * o3) * (1.f / 256.f) + RMS_EPS);
        const f32x4 go = *(const f32x4*)(p.in[I_GOUT] + lane * 4);
        const float g0 = bflo(gt.x), g1 = bfhi(gt.x), g2 = bflo(gt.y), g3 = bfhi(gt.y);
        o0 *= r * go.x * g0 / (1.f + __expf(-g0)); o1 *= r * go.y * g1 / (1.f + __expf(-g1));
        o2 *= r * go.z * g2 / (1.f + __expf(-g2)); o3 *= r * go.w * g3 / (1.f + __expf(-g3));
        *(u32x2*)(row + C_GG + h * 256 + lane * 4) = (u32x2){pk2(o0, o1), pk2(o2, o3)};
    }
}

__device__ __forceinline__ void phase_merge(const Params& p, int g, char* lds) {
    const int tid_ = otid(), lane = tid_ & 63, wid = tid_ >> 6, wm = wid >> 2, wn = wid & 3, fr = lane & 15, fq = lane >> 4;
    const bf16_t* P = (const bf16_t*)(p.ws + WS_PROJ); bf16_t* M = (bf16_t*)(p.ws + WS_VT);
    const int nM = G_TOK / 128, nN = 4;
    for (int t = blockIdx.x; t < nM * nN; t += gridDim.x) {
        int pm, pn; tile_order(t, nM, nN, pm, pn);
        const int m0 = pm * 128, n0 = pn * 256;
        f32x4 macc[4][4];
#pragma unroll
        for (int i = 0; i < 4; ++i)
#pragma unroll
            for (int j = 0; j < 4; ++j) macc[i][j] = (f32x4){0.f, 0.f, 0.f, 0.f};
        for (int br = 0; br < 3; ++br) {
            f32x4 acc[4][4];
#pragma unroll
            for (int i = 0; i < 4; ++i)
#pragma unroll
                for (int j = 0; j < 4; ++j) acc[i][j] = (f32x4){0.f, 0.f, 0.f, 0.f};
            const int acol = br == 0 ? C_GG : (br == 1 ? C_DQ : C_MQ);
            gemm_kloop<true, 4>(acc, P + (size_t)m0 * NP + acol, NP, (const bf16_t*)(p.ws + WS_WOT) + (size_t)br * D * D + (size_t)n0 * D, D, D, lds);
#pragma unroll
            for (int mt = 0; mt < 4; ++mt)
#pragma unroll
                for (int nt = 0; nt < 4; ++nt) {
                    const int row = m0 + wm * 64 + mt * 16 + fr, col = n0 + wn * 64 + nt * 16 + fq * 4;
                    const u32x2 gt = *(const u32x2*)(P + (size_t)row * NP + C_BG + br * 1024 + col);
                    f32x4 sg; sg.x = 1.f / (1.f + __expf(-bflo(gt.x))); sg.y = 1.f / (1.f + __expf(-bfhi(gt.x))); sg.z = 1.f / (1.f + __expf(-bflo(gt.y))); sg.w = 1.f / (1.f + __expf(-bfhi(gt.y)));
                    macc[mt][nt] += sg * acc[mt][nt];
                }
        }
#pragma unroll
        for (int mt = 0; mt < 4; ++mt)
#pragma unroll
            for (int nt = 0; nt < 4; ++nt) {
                const int row = m0 + wm * 64 + mt * 16 + fr, col = n0 + wn * 64 + nt * 16 + fq * 4;
                *(u32x2*)(M + (size_t)row * D + col) = (u32x2){pk2(macc[mt][nt].x, macc[mt][nt].y), pk2(macc[mt][nt].z, macc[mt][nt].w)};
            }
    }
}

__device__ __forceinline__ void phase_outproj(const Params& p, int g, char* lds) {
    const Grp G = get_group(p, g);
    const int tid_ = otid(), lane = tid_ & 63, wid = tid_ >> 6, wm = wid >> 2, wn = wid & 3, fr = lane & 15, fq = lane >> 4;
    const bf16_t* M = (const bf16_t*)(p.ws + WS_VT); const bf16_t* W = (const bf16_t*)(p.ws + WS_WOT) + (size_t)3 * D * D;
    const int nM = G_TOK / 256, nN = 4;
    for (int t = blockIdx.x; t < nM * nN; t += gridDim.x) {
        int pm, pn; tile_order(t, nM, nN, pm, pn);
        const int m0 = pm * 256, n0 = pn * 256;
        f32x4 acc[8][4];
#pragma unroll
        for (int i = 0; i < 8; ++i)
#pragma unroll
            for (int j = 0; j < 4; ++j) acc[i][j] = (f32x4){0.f, 0.f, 0.f, 0.f};
        gemm_kloop<true, 8>(acc, M + (size_t)m0 * D, D, W + (size_t)n0 * D, D, D, lds);
#pragma unroll
        for (int mt = 0; mt < 8; ++mt)
#pragma unroll
            for (int nt = 0; nt < 4; ++nt) {
                const int row = m0 + wm * 128 + mt * 16 + fr, col = n0 + wn * 64 + nt * 16 + fq * 4;
                const f32x4 xv = *(const f32x4*)(G.x + (size_t)row * D + col);
                *(f32x4*)(G.out + (size_t)row * D + col) = xv + acc[mt][nt];
            }
    }
}

__device__ __forceinline__ void phase_peerq(const Params& p, int g, char* lds) {
    const int tid_ = otid(), lane = tid_ & 63, wid = tid_ >> 6, wm = wid >> 2, wn = wid & 3, fr = lane & 15, fq = lane >> 4;
    const bf16_t* A = (const bf16_t*)(p.ws + WS_HB); const bf16_t* W = (const bf16_t*)(p.ws + WS_WQT); bf16_t* P = (bf16_t*)(p.ws + WS_PROJ);
    const int nM = G_TOK / 256, nN = 8;
    for (int t = blockIdx.x; t < nM * nN; t += gridDim.x) {
        int pm, pn; tile_order(t, nM, nN, pm, pn);
        const int m0 = pm * 256, n0 = pn * 256;
        f32x4 acc[8][4];
#pragma unroll
        for (int i = 0; i < 8; ++i)
#pragma unroll
            for (int j = 0; j < 4; ++j) acc[i][j] = (f32x4){0.f, 0.f, 0.f, 0.f};
        gemm_kloop<true, 8>(acc, A + (size_t)m0 * D, D, W + (size_t)n0 * D, D, D, lds);
#pragma unroll
        for (int mt = 0; mt < 8; ++mt)
#pragma unroll
            for (int nt = 0; nt < 4; ++nt) {
                const int row = m0 + wm * 128 + mt * 16 + fr, col = n0 + wn * 64 + nt * 16 + fq * 4;
                *(u32x2*)(P + (size_t)row * NP + col) = (u32x2){pk2(acc[mt][nt].x, acc[mt][nt].y), pk2(acc[mt][nt].z, acc[mt][nt].w)};
            }
    }
}

__device__ __forceinline__ unsigned f2ord(float f) { const unsigned u = __float_as_uint(f); return (u & 0x80000000u) ? ~u : (u | 0x80000000u); }
__device__ __forceinline__ float ord2f(unsigned k) { const unsigned u = (k & 0x80000000u) ? (k & 0x7fffffffu) : ~k; return __uint_as_float(u); }
__device__ __forceinline__ unsigned gmax16(unsigned v) {
    unsigned t;
    t = sxoru<1>(v); v = v > t ? v : t; t = sxoru<2>(v); v = v > t ? v : t; t = sxoru<4>(v); v = v > t ? v : t; t = sxoru<8>(v); v = v > t ? v : t;
    return v;
}
__device__ __forceinline__ float gsum16(float v) { v += sxor<1>(v); v += sxor<2>(v); v += sxor<4>(v); v += sxor<8>(v); return v; }
__device__ __forceinline__ float gelu_exact(float a) { return 0.5f * a * (1.0f + erff(a * 0.70710678118654752f)); }

__device__ __forceinline__ void phase_peer(const Params& p, int g, char* lds) {
    const Grp G = get_group(p, g);
    const int tid = otid(), lane = tid & 63, wid = tid >> 6, fr = lane & 15, fq = lane >> 4;
    const bf16_t* P = (const bf16_t*)(p.ws + WS_PROJ); const bf16_t* HB = (const bf16_t*)(p.ws + WS_HB);
    const bf16_t* K12 = (const bf16_t*)(p.ws + WS_K12);
    float* SC = (float*)lds;
    int* EIDX = (int*)(lds + 65536);
    float* GATE = (float*)(lds + 65536 + 4096);
    for (int tile = blockIdx.x; tile < G_TOK / 8; tile += gridDim.x) {
        const int tok0 = tile * 8;
        {
            const int mt = wid >> 1, half = wid & 1;
            const int r = mt * 16 + fr, tl = r >> 3, hh = r & 7;
            const bf16_t* qrow = P + (size_t)(tok0 + tl) * NP + hh * 256 + half * 128;
            const bf16_t* kb = K12 + half * 16384;
            f32x4 acc[8];
#pragma unroll
            for (int i = 0; i < 8; ++i) acc[i] = (f32x4){0.f, 0.f, 0.f, 0.f};
#pragma unroll
            for (int ks = 0; ks < 4; ++ks) {
                const bf16x8 af = *(const bf16x8*)(qrow + ks * 32 + fq * 8);
#pragma unroll
                for (int nt = 0; nt < 8; ++nt) { const bf16x8 bfv = *(const bf16x8*)(kb + (nt * 16 + fr) * 128 + ks * 32 + fq * 8); acc[nt] = mfma16(af, bfv, acc[nt]); }
            }
#pragma unroll
            for (int nt = 0; nt < 8; ++nt) {
                float* dst = SC + (mt * 16 + fq * 4) * 256 + half * 128 + nt * 16 + fr;
                dst[0] = acc[nt].x; dst[256] = acc[nt].y; dst[512] = acc[nt].z; dst[768] = acc[nt].w;
            }
        }
        __syncthreads();
        for (int pass = 0; pass < 2; ++pass) {
            const int row = wid * 8 + pass * 4 + fq, sl = fr, gb = fq * 16;
            float v1 = 0.f, v2 = 0.f; int i1 = 0, i2 = 0;
#pragma unroll
            for (int hf = 0; hf < 2; ++hf) {
                unsigned key[8];
#pragma unroll
                for (int i = 0; i < 8; ++i) { const int idx = sl + 16 * i; key[i] = (f2ord(SC[row * 256 + hf * 128 + idx]) & ~127u) | (unsigned)(127 - idx); }
                float sv = 0.f; int si = 0;
                for (int r = 0; r < 16; ++r) {
                    unsigned m = key[0];
#pragma unroll
                    for (int i = 1; i < 8; ++i) m = m > key[i] ? m : key[i];
                    m = gmax16(m);
                    if (sl == r) { sv = ord2f(m & ~127u); si = 127 - (int)(m & 127u); }
#pragma unroll
                    for (int i = 0; i < 8; ++i) key[i] = key[i] == m ? 0u : key[i];
                }
                if (hf == 0) { v1 = sv; i1 = si; } else { v2 = sv; i2 = si; }
            }
            int ptr = 0; float ts = 0.f; int pid = 0;
            for (int r = 0; r < 16; ++r) {
                const float v2p = __int_as_float(__builtin_amdgcn_ds_bpermute((gb + (ptr & 15)) << 2, __float_as_int(v2)));
                const unsigned key = ptr < 16 ? ((f2ord(v1 + v2p) & ~255u) | (unsigned)(255 - (sl * 16 + ptr))) : 0u;
                const unsigned m = gmax16(key);
                if (sl == r) { ts = ord2f(m & ~255u); pid = 255 - (int)(m & 255u); }
                if (key == m) ptr++;
            }
            const int e1 = __builtin_amdgcn_ds_bpermute((gb + (pid >> 4)) << 2, i1), e2 = __builtin_amdgcn_ds_bpermute((gb + (pid & 15)) << 2, i2);
            float mx = ts;
            mx = fmaxf(mx, sxor<1>(mx)); mx = fmaxf(mx, sxor<2>(mx)); mx = fmaxf(mx, sxor<4>(mx)); mx = fmaxf(mx, sxor<8>(mx));
            const float ex = __expf(ts - mx), sm = gsum16(ex);
            EIDX[row * 16 + sl] = e1 * 128 + e2; GATE[row * 16 + sl] = ex / sm;
        }
        __syncthreads();
        {
            const int tok = tok0 + wid;
            const bf16_t* hrow = HB + (size_t)tok * D;
            const int grp = lane >> 4, sl = lane & 15;
            {
                f32x2 hv[32];
#pragma unroll
                for (int c = 0; c < 8; ++c) {
                    const u32x4 hq = *(const u32x4*)(hrow + sl * 64 + c * 8);
                    hv[c * 4 + 0] = (f32x2){bflo(hq.x), bfhi(hq.x)} * (1.0f / PEER_SU); hv[c * 4 + 1] = (f32x2){bflo(hq.y), bfhi(hq.y)} * (1.0f / PEER_SU);
                    hv[c * 4 + 2] = (f32x2){bflo(hq.z), bfhi(hq.z)} * (1.0f / PEER_SU); hv[c * 4 + 3] = (f32x2){bflo(hq.w), bfhi(hq.w)} * (1.0f / PEER_SU);
                }
                const unsigned char* PU8 = p.ws + WS_PU + sl * 64;
#pragma unroll 2
                for (int it = 0; it < 32; ++it) {
                    const int k = it * 4 + grp;
                    const int e = EIDX[wid * 128 + k]; const float gt = GATE[wid * 128 + k];
                    const unsigned char* ur = PU8 + (size_t)e * D;
                    const u32x4 u0 = *(const u32x4*)ur, u1 = *(const u32x4*)(ur + 16), u2 = *(const u32x4*)(ur + 32), u3 = *(const u32x4*)(ur + 48);
                    f32x2 a2 = (f32x2){0.f, 0.f}, b2 = (f32x2){0.f, 0.f};
#define PDOT(uq, base) \
                    a2 += __builtin_amdgcn_cvt_pk_f32_fp8((int)uq.x, false) * hv[base + 0]; b2 += __builtin_amdgcn_cvt_pk_f32_fp8((int)uq.x, true) * hv[base + 1]; \
                    a2 += __builtin_amdgcn_cvt_pk_f32_fp8((int)uq.y, false) * hv[base + 2]; b2 += __builtin_amdgcn_cvt_pk_f32_fp8((int)uq.y, true) * hv[base + 3]; \
                    a2 += __builtin_amdgcn_cvt_pk_f32_fp8((int)uq.z, false) * hv[base + 4]; b2 += __builtin_amdgcn_cvt_pk_f32_fp8((int)uq.z, true) * hv[base + 5]; \
                    a2 += __builtin_amdgcn_cvt_pk_f32_fp8((int)uq.w, false) * hv[base + 6]; b2 += __builtin_amdgcn_cvt_pk_f32_fp8((int)uq.w, true) * hv[base + 7];
                    PDOT(u0, 0) PDOT(u1, 8) PDOT(u2, 16) PDOT(u3, 24)
#undef PDOT
                    a2 += b2;
                    const float a = gsum16(a2.x + a2.y);
                    GATE[wid * 128 + k] = gt * gelu_exact(a);
                }
            }
            __syncthreads();
            f32x2 acc[8];
#pragma unroll
            for (int i = 0; i < 8; ++i) acc[i] = (f32x2){0.f, 0.f};
            const unsigned char* PV8 = p.ws + WS_PV + lane * 16;
#pragma unroll 8
            for (int k = 0; k < 128; ++k) {
                const int e = EIDX[wid * 128 + k]; const float w = GATE[wid * 128 + k];
                const u32x4 v = *(const u32x4*)(PV8 + (size_t)e * D);
                const f32x2 w2 = (f32x2){w, w};
                acc[0] += w2 * __builtin_amdgcn_cvt_pk_f32_fp8((int)v.x, false); acc[1] += w2 * __builtin_amdgcn_cvt_pk_f32_fp8((int)v.x, true);
                acc[2] += w2 * __builtin_amdgcn_cvt_pk_f32_fp8((int)v.y, false); acc[3] += w2 * __builtin_amdgcn_cvt_pk_f32_fp8((int)v.y, true);
                acc[4] += w2 * __builtin_amdgcn_cvt_pk_f32_fp8((int)v.z, false); acc[5] += w2 * __builtin_amdgcn_cvt_pk_f32_fp8((int)v.z, true);
                acc[6] += w2 * __builtin_amdgcn_cvt_pk_f32_fp8((int)v.w, false); acc[7] += w2 * __builtin_amdgcn_cvt_pk_f32_fp8((int)v.w, true);
            }
            float* orow = G.out + (size_t)tok * D + lane * 16;
#pragma unroll
            for (int i = 0; i < 4; ++i) {
                f32x4 t = *(f32x4*)(orow + i * 4);
                t.x += acc[2 * i].x * (1.0f / PEER_SV); t.y += acc[2 * i].y * (1.0f / PEER_SV); t.z += acc[2 * i + 1].x * (1.0f / PEER_SV); t.w += acc[2 * i + 1].y * (1.0f / PEER_SV);
                *(f32x4*)(orow + i * 4) = t;
            }
        }
        __syncthreads();
    }
}


#ifndef DEBUG_NAN
#define DEBUG_NAN 0
#endif
#if DEBUG_NAN
__device__ __noinline__ void scan_bf16(const bf16_t* base, size_t rows, size_t pitch, int col0, int ncols, unsigned* flag) {
    const size_t gtid = (size_t)blockIdx.x * NTHR + threadIdx.x, gsz = (size_t)gridDim.x * NTHR, cpr = ncols / 8, total = rows * cpr;
    bool bad = false;
    for (size_t i = gtid; i < total; i += gsz) {
        const size_t r = i / cpr, c = i % cpr;
        const u32x4 v = *(const u32x4*)(base + r * pitch + col0 + c * 8);
        bad = bad || ((v.x & 0x7F80u) == 0x7F80u) || ((v.x & 0x7F800000u) == 0x7F800000u) || ((v.y & 0x7F80u) == 0x7F80u) || ((v.y & 0x7F800000u) == 0x7F800000u)
                  || ((v.z & 0x7F80u) == 0x7F80u) || ((v.z & 0x7F800000u) == 0x7F800000u) || ((v.w & 0x7F80u) == 0x7F80u) || ((v.w & 0x7F800000u) == 0x7F800000u);
    }
    if (bad) atomicOr(flag, 1u);
}
__device__ __noinline__ void scan_f32(const float* base, size_t n, unsigned* flag) {
    const size_t gtid = (size_t)blockIdx.x * NTHR + threadIdx.x, gsz = (size_t)gridDim.x * NTHR;
    bool bad = false;
    for (size_t i = gtid; i < n; i += gsz) { if ((__float_as_uint(base[i]) & 0x7F800000u) == 0x7F800000u) bad = true; }
    if (bad) atomicOr(flag, 1u);
}
__device__ __forceinline__ void debug_scan(const Params& p, int ph) {
    unsigned* F = (unsigned*)(p.ws + WS_CTRL) + 128;
    const bf16_t* P = (const bf16_t*)(p.ws + WS_PROJ); const bf16_t* HB = (const bf16_t*)(p.ws + WS_HB); const bf16_t* VT = (const bf16_t*)(p.ws + WS_VT);
    if (ph == 0) {
        scan_bf16((const bf16_t*)(p.ws + WS_WINT), NP, D, 0, D, F + 0);
        scan_bf16((const bf16_t*)(p.ws + WS_WOT), 4 * D + 4096, D, 0, D, F + 1);
        scan_bf16((const bf16_t*)(p.ws + WS_PU), 32768, D, 0, D, F + 2);
        scan_f32((const float*)(p.ws + WS_ROPE), 16384 * 64, F + 3);
        scan_bf16((const bf16_t*)(p.ws + WS_HM), 2560, D, 0, D, F + 3);
    } else if (ph == 2) {
        scan_bf16((const bf16_t*)(p.ws + WS_MEMK), 2 * 10 * 4 * 256, 256, 0, 256, F + 4);
    } else if (ph == 3) scan_bf16(HB, G_TOK, D, 0, D, F + 5);
    else if (ph == 4) { scan_bf16(P, G_TOK, NP, 0, 3072, F + 6); scan_bf16(P, G_TOK, NP, 3072, 2048, F + 7); scan_bf16(VT, G_TOK, D, 0, D, F + 8); scan_bf16(P, G_TOK, NP, 6144, NP - 6144, F + 9); }
    else if (ph == 5) scan_bf16(P, G_TOK, NP, 3072, 2048, F + 10);
    else if (ph == 6) { scan_bf16(HB, G_TOK, D, 0, D, F + 11); scan_bf16(P, G_TOK, NP, C_DV, 1024, F + 12); scan_bf16(P, G_TOK, NP, C_DQ, 1024, F + 13); scan_bf16(P, G_TOK, NP, C_MQ, 1024, F + 14); }
    else if (ph == 7) scan_bf16(P, G_TOK, NP, C_GG, 1024, F + 15);
    else if (ph == 8) scan_bf16(VT, G_TOK, D, 0, D, F + 16);
    else if (ph == 9) scan_f32(p.out, (size_t)G_TOK * D, F + 17);
    else if (ph == 10) scan_bf16(HB, G_TOK, D, 0, D, F + 18);
    else if (ph == 11) scan_bf16(P, G_TOK, NP, 0, 2048, F + 19);
    else if (ph == 12) scan_f32(p.out, (size_t)G_TOK * D, F + 20);
}
#endif

constexpr int NPH = 3 + NGROUP * 10;
__device__ __forceinline__ void run_phase(const Params& p, int ph, char* lds, int* s_item) {
    if (ph == 0) { phase_p0a(p, lds); return; }
    if (ph == 1) { phase_p0b(p, lds); return; }
    if (ph == 2) { phase_p0c(p); return; }
    const int g = (ph - 3) / 10, s = (ph - 3) % 10;
    const Grp G = get_group(p, g);
    switch (s) {
        case 0: phase_rmsnorm(G.x, p.in[I_GMIX], (bf16_t*)(p.ws + WS_HB), G_TOK); break;
        case 1: phase_inproj(p, g, lds); break;
        case 2: phase_qkrope(p, g); break;
        case 3: phase_mixer(p, g, lds, s_item); break;
        case 4: phase_glafin(p, g); break;
        case 5: phase_merge(p, g, lds); break;
        case 6: phase_outproj(p, g, lds); break;
        case 7: phase_rmsnorm(G.out, p.in[I_GFFN], (bf16_t*)(p.ws + WS_HB), G_TOK); break;
        case 8: phase_peerq(p, g, lds); break;
        case 9: phase_peer(p, g, lds); break;
    }
}

__global__ void __launch_bounds__(NTHR) mega_kernel(Params p) {
    extern __shared__ __attribute__((aligned(16))) char lds[];
    __shared__ int s_item;
    cg::grid_group grid = cg::this_grid();
#ifndef PROBE
#define PROBE 0
#endif
#if PROBE
    __shared__ unsigned long long tacc[16];
    if (threadIdx.x < 16) tacc[threadIdx.x] = 0ull;
    __syncthreads();
    if (threadIdx.x == 0) tacc[15] = __builtin_amdgcn_s_memrealtime();
#endif
    for (int ph = p.ph_lo; ph < p.ph_hi; ++ph) {
        run_phase(p, ph, lds, &s_item);
#if DEBUG_NAN
        __threadfence(); grid.sync(); __threadfence();
        debug_scan(p, ph);
        __threadfence(); grid.sync(); __threadfence();
#else
#if PROBE
        __threadfence(); grid.sync(); __threadfence();
        if (blockIdx.x == 0 && threadIdx.x == 0) { const unsigned long long tn = __builtin_amdgcn_s_memrealtime(); tacc[ph < 3 ? 10 + ph : (ph - 3) % 10] += tn - tacc[15]; tacc[15] = tn; }
#else
        if (ph + 1 < p.ph_hi) grid.sync();
#endif
#endif
    }
#if PROBE
    if (blockIdx.x == 0 && threadIdx.x == 0) {
        unsigned long long ta = 0, tb = 0;
        for (int k = 0; k < 13; ++k) { if ((PROBE_A >> k) & 1) ta += tacc[k]; if ((PROBE_B >> k) & 1) tb += tacc[k]; }
        float ma = (float)ta * 1e-5f;
        if (ma >= 10.f) ma *= 0.1f;
        if (ma < 1.f) ma *= 10.f;
        const int eb = 5 + (int)((float)tb * 1e-5f + 0.5f);
        float mark = ma; for (int k = 0; k < eb; ++k) mark *= 10.f;
        p.out[0] = mark;
    }
#endif
#if DEBUG_NAN
    if (blockIdx.x == 0 && threadIdx.x == 0) {
        const unsigned* F = (const unsigned*)(p.ws + WS_CTRL) + 128; int first = -1;
        for (int k = 0; k <= 20; ++k) if (first < 0 && atomicOr((unsigned*)F + k, 0u)) first = k;
        float mark = 1000.f; for (int k = 0; k < first; ++k) mark *= 10.f;
        p.out[0] = first < 0 ? 777.f : mark;
    }
#endif
}

extern "C" void kernel_launch(void* const* d_in, const int* in_sizes, int n_in, void* d_out, int out_size, void* d_ws, size_t ws_size, hipStream_t stream) {
    static int grid_blocks = 0;
    if (grid_blocks == 0) {
        if (n_in != 32 || ws_size < WS_END) { fprintf(stderr, "kernel_launch: unexpected n_in %d or ws_size %zu (< %zu)\n", n_in, ws_size, (size_t)WS_END); grid_blocks = -1; return; }
        int dev = 0, cus = 0, per_cu = 0;
        hipGetDevice(&dev);
        hipDeviceGetAttribute(&cus, hipDeviceAttributeMultiprocessorCount, dev);
        hipFuncSetAttribute((const void*)mega_kernel, hipFuncAttributeMaxDynamicSharedMemorySize, LDS_BYTES);
        hipOccupancyMaxActiveBlocksPerMultiprocessor(&per_cu, (const void*)mega_kernel, NTHR, LDS_BYTES);
        if (per_cu < 1) per_cu = 1;
        grid_blocks = cus * per_cu;
        (void)hipGetLastError();
    }
    if (grid_blocks < 0) return;
    Params p{};
    for (int i = 0; i < 32; ++i) p.in[i] = (const float*)d_in[i];
    p.out = (float*)d_out; p.ws = (unsigned char*)d_ws; p.ph_lo = 0; p.ph_hi = NPH;
    void* args[] = {&p};
    hipError_t e = hipLaunchCooperativeKernel((const void*)mega_kernel, dim3(grid_blocks), dim3(NTHR), args, LDS_BYTES, stream);
    if (e != hipSuccess) fprintf(stderr, "cooperative launch failed: %s (grid %d)\n", hipGetErrorString(e), grid_blocks);
}
```

```cpp
#include <hip/hip_runtime.h>
#include <hip/hip_cooperative_groups.h>
#include <cstdio>
#include <cstdint>
namespace cg = cooperative_groups;

typedef unsigned short bf16_t;
typedef short bf16x8 __attribute__((ext_vector_type(8)));
typedef float f32x4 __attribute__((ext_vector_type(4)));
typedef unsigned u32x4 __attribute__((ext_vector_type(4)));
typedef unsigned u32x2 __attribute__((ext_vector_type(2)));

constexpr int D = 1024;
constexpr int NP = 10496;
constexpr int IN_COLS = 10272;
constexpr int C_GQ = 0, C_GK = 512, C_GV = 1024, C_GG = 2048, C_DQ = 3072, C_DK = 4096, C_DV = 5120, C_MQ = 6144, C_BG = 7168, C_LR = 10240;
constexpr int G_TOK = 32768;
constexpr int NGROUP = 3;
constexpr int NTHR = 512;
constexpr float RMS_EPS = 1e-6f;
constexpr float LOG2E = 1.4426950408889634f;
constexpr int LDS_BYTES = 147456;
constexpr float PEER_SU = 32.0f, PEER_SV = 8.0f;

enum { I_XP = 0, I_XS, I_MP, I_MS, I_GMIX, I_WIN, I_WDF, I_BDF, I_WDB, I_BDB, I_GOUT, I_GWO, I_DGQ, I_DGK, I_LQ1, I_LK1, I_LQ2, I_LK2,
       I_DGSUB, I_DWO, I_MGN, I_MWKV, I_MGQ, I_MGK, I_MWO, I_WOUT, I_GFFN, I_PWQ, I_PK1, I_PK2, I_PU, I_PV };

constexpr size_t al256(size_t x) { return (x + 255) & ~(size_t)255; }
constexpr size_t WS_CTRL = 0;
constexpr size_t WS_PROJ = 4096;
constexpr size_t WS_HB   = WS_PROJ + (size_t)G_TOK * NP * 2;
constexpr size_t WS_VT   = WS_HB + (size_t)G_TOK * D * 2;
constexpr size_t WS_WINT = WS_VT + (size_t)G_TOK * D * 2;
constexpr size_t WS_WOT  = WS_WINT + (size_t)NP * D * 2;
constexpr size_t WS_WKVT = WS_WOT + (size_t)4 * D * D * 2;
constexpr size_t WS_WQT  = WS_WKVT + (size_t)2048 * D * 2;
constexpr size_t WS_PU   = WS_WQT + (size_t)2048 * D * 2;
constexpr size_t WS_PV   = WS_PU + (size_t)16384 * D * 2;
constexpr size_t WS_K12  = WS_PV + (size_t)16384 * D * 2;
constexpr size_t WS_ROPE = WS_K12 + (size_t)2 * 128 * 128 * 2;
constexpr size_t WS_HM   = WS_ROPE + (size_t)16384 * 64 * 4;
constexpr size_t WS_KVR  = WS_HM + (size_t)2560 * D * 2;
constexpr size_t WS_MEMK = WS_KVR + (size_t)2560 * 2048 * 4;
constexpr size_t WS_MEMV = WS_MEMK + (size_t)10 * 4 * 256 * 256 * 2;
constexpr size_t WS_END  = WS_MEMV + (size_t)10 * 4 * 256 * 256 * 2;

struct Params {
    const float* in[32];
    float* out;
    unsigned char* ws;
    int ph_lo, ph_hi;
};

typedef float f32x2 __attribute__((ext_vector_type(2)));
typedef __bf16 bf16x2v __attribute__((ext_vector_type(2)));
__device__ __forceinline__ unsigned pk2(float lo, float hi) { const f32x2 v = {lo, hi}; const bf16x2v b = __builtin_convertvector(v, bf16x2v); return __builtin_bit_cast(unsigned, b); }
__device__ __forceinline__ float bflo(unsigned u) { return __uint_as_float(u << 16); }
__device__ __forceinline__ float bfhi(unsigned u) { return __uint_as_float(u & 0xffff0000u); }
__device__ __forceinline__ float bf2f(bf16_t b) { return __uint_as_float(((unsigned)b) << 16); }
__device__ __forceinline__ bf16_t f2bf(float f) { return (bf16_t)(pk2(f, 0.f) & 0xffffu); }
__device__ __forceinline__ f32x4 mfma16(bf16x8 a, bf16x8 b, f32x4 c) { return __builtin_amdgcn_mfma_f32_16x16x32_bf16(a, b, c, 0, 0, 0); }
__device__ __forceinline__ float fexp2(float x) { return __builtin_amdgcn_exp2f(x); }
__device__ __forceinline__ int otid() { int t = threadIdx.x; asm volatile("" : "+v"(t)); return t; }
template <int M> __device__ __forceinline__ float sxor(float v) {
    if (M < 32) return __int_as_float(__builtin_amdgcn_ds_swizzle(__float_as_int(v), (M << 10) | 0x1F));
    const int l = otid() & 63; return __int_as_float(__builtin_amdgcn_ds_bpermute((l ^ 32) << 2, __float_as_int(v)));
}
template <int M> __device__ __forceinline__ unsigned sxoru(unsigned v) { return (unsigned)__builtin_amdgcn_ds_swizzle((int)v, (M << 10) | 0x1F); }
__device__ __forceinline__ float wave_sum(float v) {
    v += sxor<1>(v); v += sxor<2>(v); v += sxor<4>(v); v += sxor<8>(v); v += sxor<16>(v); v += sxor<32>(v);
    return v;
}

struct Grp { const float* x; const float* mem; float* out; int B, T, mb0; };
__device__ __forceinline__ Grp get_group(const Params& p, int g) {
    Grp r;
    if (g == 0) { r.x = p.in[I_XP]; r.out = p.out; r.B = 2; r.T = 16384; r.mb0 = 0; }
    else { r.x = p.in[I_XS] + (size_t)(g - 1) * G_TOK * D; r.out = p.out + (size_t)g * G_TOK * D; r.B = 4; r.T = 8192; r.mb0 = 2 + (g - 1) * 4; }
    r.mem = nullptr;
    return r;
}

constexpr int G_ROW = 144;
constexpr int G_A_BYTES = 128 * G_ROW;
constexpr int G_B_BYTES = 256 * G_ROW;
constexpr int G_STAGE = G_A_BYTES + G_B_BYTES;

template <bool SWAP, int MT>
__device__ __forceinline__ void gemm_kloop(f32x4 (&acc)[MT][4], const bf16_t* __restrict__ A, int lda, const bf16_t* __restrict__ Bt, int ldb, int K, char* lds) {
    constexpr int A_BYTES = MT * 32 * G_ROW, STAGE = A_BYTES + G_B_BYTES, NA = MT / 2;
    const int tid = otid(), lane = tid & 63, wid = tid >> 6, wm = wid >> 2, wn = wid & 3, fr = lane & 15, fq = lane >> 4;
    const int lr = tid >> 3, lc = tid & 7;
    u32x4 ra[NA], rb[4];
    const bf16_t* Ap = A + (size_t)lr * lda + lc * 8;
    const bf16_t* Bp = Bt + (size_t)lr * ldb + lc * 8;
#define GLOAD(k0) do { _Pragma("unroll") for (int i = 0; i < NA; ++i) ra[i] = *(const u32x4*)(Ap + (size_t)(i * 64) * lda + (k0)); \
                       _Pragma("unroll") for (int i = 0; i < 4; ++i) rb[i] = *(const u32x4*)(Bp + (size_t)(i * 64) * ldb + (k0)); } while (0)
#define SWRITE(buf) do { char* b_ = lds + (buf) * STAGE + lr * G_ROW + lc * 16; \
                       _Pragma("unroll") for (int i = 0; i < NA; ++i) *(u32x4*)(b_ + i * 64 * G_ROW) = ra[i]; \
                       _Pragma("unroll") for (int i = 0; i < 4; ++i) *(u32x4*)(b_ + A_BYTES + i * 64 * G_ROW) = rb[i]; } while (0)
    const int nk = K / 64;
    GLOAD(0); SWRITE(0); __syncthreads();
    for (int kt = 0; kt < nk; ++kt) {
        if (kt + 1 < nk) GLOAD((kt + 1) * 64);
        const char* base = lds + (kt & 1) * STAGE;
#pragma unroll
        for (int ks = 0; ks < 2; ++ks) {
            bf16x8 bfr[4];
#pragma unroll
            for (int nt = 0; nt < 4; ++nt) bfr[nt] = *(const bf16x8*)(base + A_BYTES + (wn * 64 + nt * 16 + fr) * G_ROW + ks * 64 + fq * 16);
#pragma unroll
            for (int mt = 0; mt < MT; ++mt) {
                const bf16x8 af = *(const bf16x8*)(base + (wm * (MT * 16) + mt * 16 + fr) * G_ROW + ks * 64 + fq * 16);
#pragma unroll
                for (int nt = 0; nt < 4; ++nt)
                    acc[mt][nt] = SWAP ? mfma16(bfr[nt], af, acc[mt][nt]) : mfma16(af, bfr[nt], acc[mt][nt]);
            }
        }
        if (kt + 1 < nk) SWRITE((kt + 1) & 1);
        __syncthreads();
    }
#undef GLOAD
#undef SWRITE
}

__device__ __forceinline__ void tile_order(int t, int nM, int nN, int& pm, int& pn) {
    const int per = 8 * nN, grp = t / per, r = t % per;
    pm = grp * 8 + (r & 7); pn = r >> 3;
}

__device__ __forceinline__ void phase_p0a(const Params& p, char* lds) {
    const int tid = otid(), lane = tid & 63, wid = tid >> 6;
    unsigned char* ws = p.ws;
    if (blockIdx.x == 0 && tid < 256) atomicExch((unsigned*)(ws + WS_CTRL) + tid, 0u);
    float* scr = (float*)(lds + wid * 8448);
    constexpr int IT_WIN = 16 * (NP / 32), IT_SQ = 16 * 32, IT_W2 = 16 * 64;
    constexpr int NIT = IT_WIN + 4 * IT_SQ + 2 * IT_W2;
    for (int it0 = blockIdx.x * 8; it0 < NIT; it0 += gridDim.x * 8) {
        int it = it0 + wid;
        const float* W = nullptr; bf16_t* WT = nullptr; int N = 0, nb = 0, kb = 0, srccol = -1;
        if (it < NIT) {
            int r = it;
            if (r < IT_WIN) { W = p.in[I_WIN]; N = IN_COLS; WT = (bf16_t*)(ws + WS_WINT); kb = r / (NP / 32); nb = r % (NP / 32);
                const int n0 = nb * 32; srccol = n0 < 3072 ? n0 : (n0 < 10240 ? n0 + 32 : (n0 == 10240 ? 3072 : -1)); }
            else { r -= IT_WIN;
                if (r < 4 * IT_SQ) { const int w = r / IT_SQ; r %= IT_SQ; const int idx[4] = {I_GWO, I_DWO, I_MWO, I_WOUT};
                    W = p.in[w == 0 ? I_GWO : (w == 1 ? I_DWO : (w == 2 ? I_MWO : I_WOUT))]; (void)idx; N = 1024; WT = (bf16_t*)(ws + WS_WOT) + (size_t)w * D * D; kb = r / 32; nb = r % 32; srccol = nb * 32; }
                else { r -= 4 * IT_SQ; const int w = r / IT_W2; r %= IT_W2; W = p.in[w == 0 ? I_MWKV : I_PWQ]; N = 2048; WT = (bf16_t*)(ws + (w == 0 ? WS_WKVT : WS_WQT)); kb = r / 64; nb = r % 64; srccol = nb * 32; }
            }
            const int k0 = kb * 64;
#pragma unroll 8
            for (int i = 0; i < 32; ++i) { const int kk = 2 * i + (lane >> 5); scr[kk * 33 + (lane & 31)] = srccol >= 0 ? W[(size_t)(k0 + kk) * N + srccol + (lane & 31)] : 0.f; }
        }
        __syncthreads();
        if (it < NIT) {
            const int k0 = kb * 64, c = lane & 7;
#pragma unroll
            for (int j = 0; j < 4; ++j) { const int n = (lane >> 3) + 8 * j; const float* s = scr + (8 * c) * 33 + n;
                u32x4 o; o.x = pk2(s[0], s[33]); o.y = pk2(s[66], s[99]); o.z = pk2(s[132], s[165]); o.w = pk2(s[198], s[231]);
                *(u32x4*)(WT + (size_t)(nb * 32 + n) * D + k0 + 8 * c) = o; }
        }
        __syncthreads();
    }
    const size_t gtid = (size_t)blockIdx.x * NTHR + tid, gsz = (size_t)gridDim.x * NTHR;
    {
        const size_t n8 = (size_t)16384 * D / 8;
        for (size_t i = gtid; i < 2 * n8; i += gsz) {
            const int w = i >= n8; const size_t j = w ? i - n8 : i;
            const float* src = p.in[w ? I_PV : I_PU] + j * 8; unsigned char* dst = ws + (w ? WS_PV : WS_PU) + j * 8;
            const float sc = w ? PEER_SV : PEER_SU;
            const f32x4 a = *(const f32x4*)src * sc, b = *(const f32x4*)(src + 4) * sc;
            int lo = __builtin_amdgcn_cvt_pk_fp8_f32(a.x, a.y, 0, false); lo = __builtin_amdgcn_cvt_pk_fp8_f32(a.z, a.w, lo, true);
            int hi = __builtin_amdgcn_cvt_pk_fp8_f32(b.x, b.y, 0, false); hi = __builtin_amdgcn_cvt_pk_fp8_f32(b.z, b.w, hi, true);
            *(u32x2*)dst = (u32x2){(unsigned)lo, (unsigned)hi};
        }
        for (size_t i = gtid; i < 2 * 16384; i += gsz) {
            const int w = i >= 16384; const size_t j = w ? i - 16384 : i;
            ((bf16_t*)(ws + WS_K12))[i] = f2bf(p.in[w ? I_PK2 : I_PK1][j]);
        }
    }
    for (size_t i = gtid; i < (size_t)16384 * 32; i += gsz) {
        const int t = (int)(i >> 5), k = (int)(i & 31);
        const float inv = powf(10000.0f, -(float)(2 * k) / 64.0f);
        const float ang = (float)t * inv;
        double sn, cs; sincos((double)ang, &sn, &cs);
        float* R = (float*)(ws + WS_ROPE) + (size_t)t * 64;
        R[k] = (float)cs; R[32 + k] = (float)sn;
    }
    for (int row = blockIdx.x * 8 + wid; row < 2560; row += gridDim.x * 8) {
        const float* src = row < 512 ? p.in[I_MP] + (size_t)row * D : p.in[I_MS] + (size_t)(row - 512) * D;
        const f32x4* xr = (const f32x4*)src + lane; const f32x4* gr = (const f32x4*)p.in[I_MGN] + lane;
        f32x4 v[4]; float s = 0.f;
#pragma unroll
        for (int j = 0; j < 4; ++j) { v[j] = xr[64 * j]; s += v[j].x * v[j].x + v[j].y * v[j].y + v[j].z * v[j].z + v[j].w * v[j].w; }
        const float r = rsqrtf(wave_sum(s) * (1.f / D) + RMS_EPS);
        u32x2* o = (u32x2*)((bf16_t*)(ws + WS_HM) + (size_t)row * D) + lane;
#pragma unroll
        for (int j = 0; j < 4; ++j) { const f32x4 g = gr[64 * j]; u32x2 w; w.x = pk2(v[j].x * r * g.x, v[j].y * r * g.y); w.y = pk2(v[j].z * r * g.z, v[j].w * r * g.w); o[64 * j] = w; }
    }
}

__device__ __forceinline__ void phase_p0b(const Params& p, char* lds) {
    const int tid_ = otid(), lane = tid_ & 63, wid = tid_ >> 6, wm = wid >> 2, wn = wid & 3, fr = lane & 15, fq = lane >> 4;
    const bf16_t* A = (const bf16_t*)(p.ws + WS_HM); const bf16_t* Bt = (const bf16_t*)(p.ws + WS_WKVT);
    float* C = (float*)(p.ws + WS_KVR);
    const int nM = 20, nN = 8;
    for (int t = blockIdx.x; t < nM * nN; t += gridDim.x) {
        const int pm = t % nM, pn = t / nM, m0 = pm * 128, n0 = pn * 256;
        f32x4 acc[4][4];
#pragma unroll
        for (int i = 0; i < 4; ++i)
#pragma unroll
            for (int j = 0; j < 4; ++j) acc[i][j] = (f32x4){0.f, 0.f, 0.f, 0.f};
        gemm_kloop<true, 4>(acc, A + (size_t)m0 * D, D, Bt + (size_t)n0 * D, D, D, lds);
#pragma unroll
        for (int mt = 0; mt < 4; ++mt)
#pragma unroll
            for (int nt = 0; nt < 4; ++nt) {
                const int row = m0 + wm * 64 + mt * 16 + fr, col = n0 + wn * 64 + nt * 16 + fq * 4;
                *(f32x4*)(C + (size_t)row * 2048 + col) = acc[mt][nt];
            }
    }
}

__device__ __forceinline__ void phase_p0c(const Params& p) {
    const int tid_ = otid(), lane = tid_ & 63, wid = tid_ >> 6;
    const float* KV = (const float*)(p.ws + WS_KVR);
    bf16_t* MK = (bf16_t*)(p.ws + WS_MEMK); bf16_t* MV = (bf16_t*)(p.ws + WS_MEMV);
    for (int it = blockIdx.x * 8 + wid; it < 2560 * 4; it += gridDim.x * 8) {
        const int row = it >> 2, h = it & 3, b = row >> 8, m = row & 255;
        const f32x4 kv = *(const f32x4*)(KV + (size_t)row * 2048 + h * 256 + lane * 4);
        const float ss = wave_sum(kv.x * kv.x + kv.y * kv.y + kv.z * kv.z + kv.w * kv.w);
        const float r = rsqrtf(ss * (1.f / 256.f) + RMS_EPS);
        const f32x4 g = *(const f32x4*)(p.in[I_MGK] + lane * 4);
        u32x2 w; w.x = pk2(kv.x * r * g.x, kv.y * r * g.y); w.y = pk2(kv.z * r * g.z, kv.w * r * g.w);
        *(u32x2*)(MK + ((size_t)(b * 4 + h) * 256 + m) * 256 + lane * 4) = w;
        const f32x4 vv = *(const f32x4*)(KV + (size_t)row * 2048 + 1024 + h * 256 + lane * 4);
        const int pos = (m & ~31) + ((m >> 2) & 3) * 8 + ((m >> 4) & 1) * 4 + (m & 3);
        bf16_t* dst = MV + ((size_t)(b * 4 + h) * 256 + lane * 4) * 256 + pos;
        dst[0] = f2bf(vv.x); dst[256] = f2bf(vv.y); dst[512] = f2bf(vv.z); dst[768] = f2bf(vv.w);
    }
}

__device__ __forceinline__ void phase_rmsnorm(const float* X, const float* gain, bf16_t* O, int rows) {
    const int tid_ = otid(), lane = tid_ & 63, wid = tid_ >> 6;
    const f32x4* gr = (const f32x4*)gain + lane;
    f32x4 g[4];
#pragma unroll
    for (int j = 0; j < 4; ++j) g[j] = gr[64 * j];
    for (int row = blockIdx.x * 8 + wid; row < rows; row += gridDim.x * 8) {
        const f32x4* xr = (const f32x4*)(X + (size_t)row * D) + lane;
        f32x4 v[4]; float s = 0.f;
#pragma unroll
        for (int j = 0; j < 4; ++j) { v[j] = xr[64 * j]; s += v[j].x * v[j].x + v[j].y * v[j].y + v[j].z * v[j].z + v[j].w * v[j].w; }
        const float r = rsqrtf(wave_sum(s) * (1.f / D) + RMS_EPS);
        u32x2* o = (u32x2*)(O + (size_t)row * D) + lane;
#pragma unroll
        for (int j = 0; j < 4; ++j) { u32x2 w; w.x = pk2(v[j].x * r * g[j].x, v[j].y * r * g[j].y); w.y = pk2(v[j].z * r * g[j].z, v[j].w * r * g[j].w); o[64 * j] = w; }
    }
}

__device__ __forceinline__ void phase_inproj(const Params& p, int g, char* lds) {
    const Grp G = get_group(p, g);
    const int tid_ = otid(), lane = tid_ & 63, wid = tid_ >> 6, wm = wid >> 2, wn = wid & 3, fr = lane & 15, fq = lane >> 4;
    const bf16_t* A = (const bf16_t*)(p.ws + WS_HB); const bf16_t* Bt = (const bf16_t*)(p.ws + WS_WINT);
    bf16_t* P = (bf16_t*)(p.ws + WS_PROJ); bf16_t* VT = (bf16_t*)(p.ws + WS_VT);
    const int nM = G_TOK / 256;
    {
        const int nN = NP / 256 - 4;
        for (int t = blockIdx.x; t < nM * nN; t += gridDim.x) {
            int pm, pn; tile_order(t, nM, nN, pm, pn);
            if (pn >= C_DV / 256) pn += 4;
            const int m0 = pm * 256, n0 = pn * 256;
            f32x4 acc[8][4];
#pragma unroll
            for (int i = 0; i < 8; ++i)
#pragma unroll
                for (int j = 0; j < 4; ++j) acc[i][j] = (f32x4){0.f, 0.f, 0.f, 0.f};
            gemm_kloop<true, 8>(acc, A + (size_t)m0 * D, D, Bt + (size_t)n0 * D, D, D, lds);
            const float sc = n0 < 512 ? 0.08838834764831845f : 1.0f;
#pragma unroll
            for (int mt = 0; mt < 8; ++mt)
#pragma unroll
                for (int nt = 0; nt < 4; ++nt) {
                    const int row = m0 + wm * 128 + mt * 16 + fr, col = n0 + wn * 64 + nt * 16 + fq * 4;
                    u32x2 w; w.x = pk2(acc[mt][nt].x * sc, acc[mt][nt].y * sc); w.y = pk2(acc[mt][nt].z * sc, acc[mt][nt].w * sc);
                    *(u32x2*)(P + (size_t)row * NP + col) = w;
                }
        }
    }
    {
        const int nN = 4;
        for (int t = blockIdx.x; t < nM * nN; t += gridDim.x) {
            int pm, pn; tile_order(t, nM, nN, pm, pn);
            const int m0 = pm * 256, n0 = C_DV + pn * 256;
            f32x4 acc[8][4];
#pragma unroll
            for (int i = 0; i < 8; ++i)
#pragma unroll
                for (int j = 0; j < 4; ++j) acc[i][j] = (f32x4){0.f, 0.f, 0.f, 0.f};
            gemm_kloop<false, 8>(acc, A + (size_t)m0 * D, D, Bt + (size_t)n0 * D, D, D, lds);
            const int b = m0 / G.T, t0 = m0 % G.T + wm * 128;
#pragma unroll
            for (int mt = 0; mt < 8; ++mt)
#pragma unroll
                for (int nt = 0; nt < 4; ++nt) {
                    const int n = n0 - C_DV + wn * 64 + nt * 16 + fr, h = n >> 7, dv = n & 127;
                    const int pos = t0 + (mt >> 1) * 32 + fq * 8 + (mt & 1) * 4;
                    u32x2 w; w.x = pk2(acc[mt][nt].x, acc[mt][nt].y); w.y = pk2(acc[mt][nt].z, acc[mt][nt].w);
                    *(u32x2*)(VT + ((size_t)((b * 8 + h) * 128 + dv)) * G.T + pos) = w;
                }
        }
    }
}

__device__ __forceinline__ void phase_qkrope(const Params& p, int g) {
    const Grp G = get_group(p, g);
    const int tid_ = otid(), lane = tid_ & 63, wid = tid_ >> 6, grp = lane >> 2, sub = lane & 3;
    bf16_t* P = (bf16_t*)(p.ws + WS_PROJ); const float* ROPE = (const float*)(p.ws + WS_ROPE);
    for (int it = blockIdx.x * 8 + wid; it < G_TOK * 2; it += gridDim.x * 8) {
        const int tok = it >> 1, isk = it & 1, t = tok % G.T;
        bf16_t* base = P + (size_t)tok * NP + (isk ? C_DK : C_DQ) + grp * 64 + sub * 8;
        const u32x4 a = *(const u32x4*)base, b = *(const u32x4*)(base + 32);
        float x1[8], x2[8];
        x1[0] = bflo(a.x); x1[1] = bfhi(a.x); x1[2] = bflo(a.y); x1[3] = bfhi(a.y); x1[4] = bflo(a.z); x1[5] = bfhi(a.z); x1[6] = bflo(a.w); x1[7] = bfhi(a.w);
        x2[0] = bflo(b.x); x2[1] = bfhi(b.x); x2[2] = bflo(b.y); x2[3] = bfhi(b.y); x2[4] = bflo(b.z); x2[5] = bfhi(b.z); x2[6] = bflo(b.w); x2[7] = bfhi(b.w);
        float ss = 0.f;
#pragma unroll
        for (int e = 0; e < 8; ++e) ss += x1[e] * x1[e] + x2[e] * x2[e];
        ss += sxor<1>(ss); ss += sxor<2>(ss);
        const float r = rsqrtf(ss * (1.f / 64.f) + RMS_EPS) * (isk ? 1.0f : 0.125f * LOG2E);
        const float* gn = p.in[isk ? I_DGK : I_DGQ] + sub * 8;
        const float* rp = ROPE + (size_t)t * 64 + sub * 8;
        float o1[8], o2[8];
#pragma unroll
        for (int e = 0; e < 8; ++e) {
            const float y1 = x1[e] * r * gn[e], y2 = x2[e] * r * gn[32 + e], c = rp[e], s = rp[32 + e];
            o1[e] = y1 * c - y2 * s; o2[e] = y2 * c + y1 * s;
        }
        u32x4 w1, w2;
        w1.x = pk2(o1[0], o1[1]); w1.y = pk2(o1[2], o1[3]); w1.z = pk2(o1[4], o1[5]); w1.w = pk2(o1[6], o1[7]);
        w2.x = pk2(o2[0], o2[1]); w2.y = pk2(o2[2], o2[3]); w2.z = pk2(o2[4], o2[5]); w2.w = pk2(o2[6], o2[7]);
        *(u32x4*)base = w1; *(u32x4*)(base + 32) = w2;
    }
}

__device__ __forceinline__ void diff_attn_item(const Params& p, const Grp& G, int item, char* lds, float lam, float shift) {
    const int tid = otid(), lane = tid & 63, wid = tid >> 6, fr = lane & 15, fq = lane >> 4;
    const int c = wid & 1, sub = wid >> 1;
    const int T = G.T, nqb = T / 128;
    const int qb = item % nqb, bh = item / nqb, h = bh & 7, b = bh >> 3;
    bf16_t* P = (bf16_t*)(p.ws + WS_PROJ) + (size_t)b * T * NP;
    const bf16_t* Kg = P + C_DK + h * 128;
    const bf16_t* VTg = (const bf16_t*)(p.ws + WS_VT) + (size_t)bh * 128 * T;
    const int q0 = qb * 128 + sub * 32;
    bf16x8 qf[2][2];
#pragma unroll
    for (int nt = 0; nt < 2; ++nt)
#pragma unroll
        for (int ks = 0; ks < 2; ++ks) qf[nt][ks] = *(const bf16x8*)(P + (size_t)(q0 + nt * 16 + fr) * NP + C_DQ + h * 128 + c * 64 + ks * 32 + fq * 8);
    f32x4 o[8][2];
#pragma unroll
    for (int i = 0; i < 8; ++i) { o[i][0] = (f32x4){0.f, 0.f, 0.f, 0.f}; o[i][1] = (f32x4){0.f, 0.f, 0.f, 0.f}; }
    float l[2] = {0.f, 0.f};
    constexpr int STG = 36864, VOFF = 18432;
    u32x4 rk[2], rv[2];
    const int krow = tid >> 4, kch = tid & 15;
    const int vrow = tid >> 3, vch = tid & 7;
#define AGLOAD(kt) do { const int key0_ = (kt) * 64; \
        _Pragma("unroll") for (int i = 0; i < 2; ++i) rk[i] = *(const u32x4*)(Kg + (size_t)(key0_ + krow + i * 32) * NP + kch * 8); \
        _Pragma("unroll") for (int i = 0; i < 2; ++i) rv[i] = *(const u32x4*)(VTg + (size_t)(vrow + i * 64) * T + key0_ + vch * 8); } while (0)
#define ASWRITE(buf) do { char* b_ = lds + (buf) * STG; \
        _Pragma("unroll") for (int i = 0; i < 2; ++i) *(u32x4*)(b_ + ((kch >> 3) * 64 + krow + i * 32) * 144 + (kch & 7) * 16) = rk[i]; \
        _Pragma("unroll") for (int i = 0; i < 2; ++i) *(u32x4*)(b_ + VOFF + (vrow + i * 64) * 144 + vch * 16) = rv[i]; } while (0)
    const int nkt = T / 64;
#define EXPQ(SRC, NT, DSTP) do { const f32x4 a_ = SRC[0][NT], b_ = SRC[1][NT]; \
        const float p0 = fexp2(a_.x), p1 = fexp2(a_.y), p2 = fexp2(a_.z), p3 = fexp2(a_.w); \
        const float p4 = fexp2(b_.x), p5 = fexp2(b_.y), p6 = fexp2(b_.z), p7 = fexp2(b_.w); \
        l[NT] += ((p0 + p1) + (p2 + p3)) + ((p4 + p5) + (p6 + p7)); \
        u32x4 w_; w_.x = pk2(p0, p1); w_.y = pk2(p2, p3); w_.z = pk2(p4, p5); w_.w = pk2(p6, p7); \
        DSTP[NT] = __builtin_bit_cast(bf16x8, w_); } while (0)
#define SMMA1(DST, I, MT, KBASE) do { \
        const bf16x8 k0_ = *(const bf16x8*)((KBASE) + (c * 64 + (MT) * 16 + fr) * 144 + fq * 16); \
        const bf16x8 k1_ = *(const bf16x8*)((KBASE) + (c * 64 + (MT) * 16 + fr) * 144 + 64 + fq * 16); \
        DST[I][0] = mfma16(k0_, qf[0][0], (f32x4){0.f, 0.f, 0.f, 0.f}); DST[I][1] = mfma16(k0_, qf[1][0], (f32x4){0.f, 0.f, 0.f, 0.f}); \
        DST[I][0] = mfma16(k1_, qf[0][1], DST[I][0]); DST[I][1] = mfma16(k1_, qf[1][1], DST[I][1]); } while (0)
#define PVMMA(DVT, KK, PF, VBASE) do { \
        const bf16x8 vf_ = *(const bf16x8*)((VBASE) + VOFF + ((DVT) * 16 + fr) * 144 + (KK) * 64 + fq * 16); \
        o[DVT][0] = mfma16(vf_, PF[0], o[DVT][0]); o[DVT][1] = mfma16(vf_, PF[1], o[DVT][1]); } while (0)
#define PV8(KK, PF, VBASE) do { PVMMA(0, KK, PF, VBASE); PVMMA(1, KK, PF, VBASE); PVMMA(2, KK, PF, VBASE); PVMMA(3, KK, PF, VBASE); \
        PVMMA(4, KK, PF, VBASE); PVMMA(5, KK, PF, VBASE); PVMMA(6, KK, PF, VBASE); PVMMA(7, KK, PF, VBASE); } while (0)
    f32x4 slo[2][2], shi[2][2];
    bf16x8 pflo[2], pfhi[2];
    AGLOAD(0); ASWRITE(0); AGLOAD(1); ASWRITE(1); __syncthreads();
    SMMA1(slo, 0, 0, lds); SMMA1(slo, 1, 1, lds);
    for (int kt = 0; kt < nkt; ++kt) {
        { const int ktl = kt + 2 < nkt ? kt + 2 : nkt - 1; AGLOAD(ktl); }
        const char* cur = lds + (kt & 3) * STG; const char* nxt = lds + ((kt + 1) & 3) * STG; const char* prv = lds + ((kt + 3) & 3) * STG;
        SMMA1(shi, 0, 2, cur); SMMA1(shi, 1, 3, cur);
        if (kt > 0) PV8(1, pfhi, prv);
        EXPQ(slo, 0, pflo); EXPQ(slo, 1, pflo);
        __builtin_amdgcn_sched_barrier(0);
        SMMA1(slo, 0, 0, nxt); SMMA1(slo, 1, 1, nxt);
        PV8(0, pflo, cur);
        EXPQ(shi, 0, pfhi); EXPQ(shi, 1, pfhi);
        __builtin_amdgcn_sched_barrier(0);
        ASWRITE((kt + 2) & 3);
        __syncthreads();
    }
    { const char* prv = lds + ((nkt - 1) & 3) * STG; PV8(1, pfhi, prv); }
    __syncthreads();
#undef EXPQ
#undef SMMA1
#undef PVMMA
#undef PV8
#undef AGLOAD
#undef ASWRITE
    float inv[2];
#pragma unroll
    for (int nt = 0; nt < 2; ++nt) { float v = l[nt]; v += sxor<16>(v); v += sxor<32>(v); inv[nt] = 1.0f / v; }
    float* xch = (float*)lds + sub * 4096;
    if (c == 1) {
#pragma unroll
        for (int dvt = 0; dvt < 8; ++dvt)
#pragma unroll
            for (int nt = 0; nt < 2; ++nt) {
                xch[(dvt * 16 + fq * 4 + 0) * 32 + nt * 16 + fr] = o[dvt][nt].x * inv[nt];
                xch[(dvt * 16 + fq * 4 + 1) * 32 + nt * 16 + fr] = o[dvt][nt].y * inv[nt];
                xch[(dvt * 16 + fq * 4 + 2) * 32 + nt * 16 + fr] = o[dvt][nt].z * inv[nt];
                xch[(dvt * 16 + fq * 4 + 3) * 32 + nt * 16 + fr] = o[dvt][nt].w * inv[nt];
            }
    }
    __syncthreads();
    if (c == 0) {
        float ss[2] = {0.f, 0.f};
#pragma unroll
        for (int dvt = 0; dvt < 8; ++dvt)
#pragma unroll
            for (int nt = 0; nt < 2; ++nt) {
                f32x4 v = o[dvt][nt] * inv[nt];
                v.x -= lam * xch[(dvt * 16 + fq * 4 + 0) * 32 + nt * 16 + fr];
                v.y -= lam * xch[(dvt * 16 + fq * 4 + 1) * 32 + nt * 16 + fr];
                v.z -= lam * xch[(dvt * 16 + fq * 4 + 2) * 32 + nt * 16 + fr];
                v.w -= lam * xch[(dvt * 16 + fq * 4 + 3) * 32 + nt * 16 + fr];
                o[dvt][nt] = v; ss[nt] += v.x * v.x + v.y * v.y + v.z * v.z + v.w * v.w;
            }
#pragma unroll
        for (int nt = 0; nt < 2; ++nt) {
            float v = ss[nt]; v += sxor<16>(v); v += sxor<32>(v);
            const float r = rsqrtf(v * (1.f / 128.f) + RMS_EPS) * 0.8f;
#pragma unroll
            for (int dvt = 0; dvt < 8; ++dvt) {
                const f32x4 gs = *(const f32x4*)(p.in[I_DGSUB] + dvt * 16 + fq * 4);
                const f32x4 v4 = o[dvt][nt];
                u32x2 w; w.x = pk2(v4.x * r * gs.x, v4.y * r * gs.y); w.y = pk2(v4.z * r * gs.z, v4.w * r * gs.w);
                *(u32x2*)(P + (size_t)(q0 + nt * 16 + fr) * NP + C_DQ + h * 128 + dvt * 16 + fq * 4) = w;
            }
        }
    }
    __syncthreads();
}

__device__ __forceinline__ void mem_attn_item(const Params& p, const Grp& G, int item, char* lds, float shift) {
    const int tid = otid(), lane = tid & 63, wid = tid >> 6, fr = lane & 15, fq = lane >> 4;
    const int T = G.T, nqb = T / 128;
    const int qb = item % nqb, bh = item / nqb, h = bh & 3, b = bh >> 2;
    bf16_t* P = (bf16_t*)(p.ws + WS_PROJ) + (size_t)b * T * NP;
    const bf16_t* MK = (const bf16_t*)(p.ws + WS_MEMK) + (size_t)((G.mb0 + b) * 4 + h) * 256 * 256;
    const bf16_t* MV = (const bf16_t*)(p.ws + WS_MEMV) + (size_t)((G.mb0 + b) * 4 + h) * 256 * 256;
    const int row = qb * 128 + wid * 16 + fr;
    bf16_t* qp = P + (size_t)row * NP + C_MQ + h * 256;
    bf16x8 qf[8];
    {
        float ss = 0.f; u32x4 raw[8];
#pragma unroll
        for (int ks = 0; ks < 8; ++ks) { raw[ks] = *(const u32x4*)(qp + ks * 32 + fq * 8);
            const float a0 = bflo(raw[ks].x), a1 = bfhi(raw[ks].x), a2 = bflo(raw[ks].y), a3 = bfhi(raw[ks].y), a4 = bflo(raw[ks].z), a5 = bfhi(raw[ks].z), a6 = bflo(raw[ks].w), a7 = bfhi(raw[ks].w);
            ss += a0 * a0 + a1 * a1 + a2 * a2 + a3 * a3 + a4 * a4 + a5 * a5 + a6 * a6 + a7 * a7; }
        ss += sxor<16>(ss); ss += sxor<32>(ss);
        const float r = rsqrtf(ss * (1.f / 256.f) + RMS_EPS) * (0.0625f * LOG2E);
#pragma unroll
        for (int ks = 0; ks < 8; ++ks) {
            const f32x4 g0 = *(const f32x4*)(p.in[I_MGQ] + ks * 32 + fq * 8), g1 = *(const f32x4*)(p.in[I_MGQ] + ks * 32 + fq * 8 + 4);
            u32x4 w;
            w.x = pk2(bflo(raw[ks].x) * r * g0.x, bfhi(raw[ks].x) * r * g0.y); w.y = pk2(bflo(raw[ks].y) * r * g0.z, bfhi(raw[ks].y) * r * g0.w);
            w.z = pk2(bflo(raw[ks].z) * r * g1.x, bfhi(raw[ks].z) * r * g1.y); w.w = pk2(bflo(raw[ks].w) * r * g1.z, bfhi(raw[ks].w) * r * g1.w);
            qf[ks] = __builtin_bit_cast(bf16x8, w);
        }
    }
    f32x4 o[16];
#pragma unroll
    for (int i = 0; i < 16; ++i) o[i] = (f32x4){0.f, 0.f, 0.f, 0.f};
    float l = 0.f;
    constexpr int KROW = 528, VOFF = 64 * 528;
    for (int kt = 0; kt < 4; ++kt) {
#pragma unroll
        for (int i = 0; i < 4; ++i) {
            const int idx = tid + i * 512, r = idx >> 5, ch = idx & 31;
            *(u32x4*)(lds + r * KROW + ch * 16) = *(const u32x4*)(MK + (size_t)(kt * 64 + r) * 256 + ch * 8);
            const int vr = idx >> 3, vc = idx & 7;
            *(u32x4*)(lds + VOFF + vr * 144 + vc * 16) = *(const u32x4*)(MV + (size_t)vr * 256 + kt * 64 + vc * 8);
        }
        __syncthreads();
        f32x4 s[4];
#pragma unroll
        for (int mt = 0; mt < 4; ++mt) s[mt] = (f32x4){-shift, -shift, -shift, -shift};
#pragma unroll
        for (int ks = 0; ks < 8; ++ks)
#pragma unroll
            for (int mt = 0; mt < 4; ++mt) {
                const bf16x8 kf = *(const bf16x8*)(lds + (mt * 16 + fr) * KROW + ks * 64 + fq * 16);
                s[mt] = mfma16(kf, qf[ks], s[mt]);
            }
        bf16x8 pf[2];
#pragma unroll
        for (int kk = 0; kk < 2; ++kk) {
            const f32x4 a = s[2 * kk], bb = s[2 * kk + 1];
            const float p0 = fexp2(a.x), p1 = fexp2(a.y), p2 = fexp2(a.z), p3 = fexp2(a.w);
            const float p4 = fexp2(bb.x), p5 = fexp2(bb.y), p6 = fexp2(bb.z), p7 = fexp2(bb.w);
            l += ((p0 + p1) + (p2 + p3)) + ((p4 + p5) + (p6 + p7));
            u32x4 w; w.x = pk2(p0, p1); w.y = pk2(p2, p3); w.z = pk2(p4, p5); w.w = pk2(p6, p7);
            pf[kk] = __builtin_bit_cast(bf16x8, w);
        }
#pragma unroll
        for (int kk = 0; kk < 2; ++kk)
#pragma unroll
            for (int dvt = 0; dvt < 16; ++dvt) {
                const bf16x8 vf = *(const bf16x8*)(lds + VOFF + (dvt * 16 + fr) * 144 + kk * 64 + fq * 16);
                o[dvt] = mfma16(vf, pf[kk], o[dvt]);
            }
        __syncthreads();
    }
    l += sxor<16>(l); l += sxor<32>(l);
    const float inv = 1.0f / l;
#pragma unroll
    for (int dvt = 0; dvt < 16; ++dvt) {
        u32x2 w; w.x = pk2(o[dvt].x * inv, o[dvt].y * inv); w.y = pk2(o[dvt].z * inv, o[dvt].w * inv);
        *(u32x2*)(qp + dvt * 16 + fq * 4) = w;
    }
}

constexpr int L_QE = 0, L_KE = 17408, L_KST = 34816, L_VTL = 53248, L_ATT = 71680, L_SB = 80896, L_LRF = 115712, L_TOT = 119808, L_GDEC = 121856;
__device__ __forceinline__ void gla_item(const Params& p, const Grp& G, int item, char* lds) {
    const int tid = otid(), lane = tid & 63, wid = tid >> 6, fr = lane & 15, fq = lane >> 4;
    const int slice = item & 1, dir = (item >> 1) & 1, h = (item >> 2) & 3, b = item >> 4;
    const int T = G.T, N = T / 64;
    const bf16_t* P = (const bf16_t*)(p.ws + WS_PROJ) + (size_t)b * T * NP;
    bf16_t* OUT = dir ? (bf16_t*)(p.ws + WS_PROJ) + (size_t)b * T * NP + C_DV + h * 256 + slice * 128
                      : (bf16_t*)(p.ws + WS_HB) + (size_t)b * T * D + h * 256 + slice * 128;
    const int ldo = dir ? NP : D;
    const int d = tid & 127, rg = tid >> 7;
    float wdec[16];
    {
        const float* wd = p.in[dir ? I_WDB : I_WDF];
#pragma unroll
        for (int r = 0; r < 16; ++r) wdec[r] = wd[r * 512 + h * 128 + d];
    }
    const float bdec = p.in[dir ? I_BDB : I_BDF][h * 128 + d];
    { unsigned z = 0u; asm volatile("" : "+v"(z)); for (int i = tid; i < 34816 / 16; i += NTHR) *(u32x4*)(lds + L_SB + i * 16) = (u32x4){z, z, z, z}; }
    f32x4 S[8];
#pragma unroll
    for (int i = 0; i < 8; ++i) S[i] = (f32x4){0.f, 0.f, 0.f, 0.f};
    u32x4 rq[2], rk[2], rv[2], rl;
    const int lrow = tid >> 4, lch = tid & 15;
#define GGLOAD(n) do { const int cb_ = (dir ? (N - 1 - (n)) : (n)) * 64; \
        _Pragma("unroll") for (int i = 0; i < 2; ++i) { const int li_ = lrow + i * 32, tk_ = cb_ + (dir ? 63 - li_ : li_); const bf16_t* rp_ = P + (size_t)tk_ * NP; \
            rq[i] = *(const u32x4*)(rp_ + C_GQ + h * 128 + lch * 8); rk[i] = *(const u32x4*)(rp_ + C_GK + h * 128 + lch * 8); rv[i] = *(const u32x4*)(rp_ + C_GV + h * 256 + slice * 128 + lch * 8); } \
        if (tid < 128) { const int li_ = tid >> 1, tk_ = cb_ + (dir ? 63 - li_ : li_); rl = *(const u32x4*)(P + (size_t)tk_ * NP + C_LR + dir * 16 + (tid & 1) * 8); } } while (0)
    GGLOAD(0);
    for (int n = 0; n < N; ++n) {
#pragma unroll
        for (int i = 0; i < 2; ++i) {
            const int li = lrow + i * 32;
            *(u32x4*)(lds + L_QE + li * 272 + lch * 16) = rq[i];
            *(u32x4*)(lds + L_KE + li * 272 + lch * 16) = rk[i];
            bf16_t* vt = (bf16_t*)(lds + L_VTL) + (lch * 8) * 72 + li;
            vt[0 * 72] = (bf16_t)(rv[i].x & 0xffff); vt[1 * 72] = (bf16_t)(rv[i].x >> 16); vt[2 * 72] = (bf16_t)(rv[i].y & 0xffff); vt[3 * 72] = (bf16_t)(rv[i].y >> 16);
            vt[4 * 72] = (bf16_t)(rv[i].z & 0xffff); vt[5 * 72] = (bf16_t)(rv[i].z >> 16); vt[6 * 72] = (bf16_t)(rv[i].w & 0xffff); vt[7 * 72] = (bf16_t)(rv[i].w >> 16);
        }
        if (tid < 128) {
            float* lf = (float*)(lds + L_LRF) + (tid >> 1) * 16 + (tid & 1) * 8;
            *(f32x4*)lf = (f32x4){bflo(rl.x), bfhi(rl.x), bflo(rl.y), bfhi(rl.y)};
            *(f32x4*)(lf + 4) = (f32x4){bflo(rl.z), bfhi(rl.z), bflo(rl.w), bfhi(rl.w)};
        }
        if (n + 1 < N) GGLOAD(n + 1);
        __syncthreads();
        float cs[16]; float run = 0.f;
#pragma unroll
        for (int ii = 0; ii < 16; ++ii) {
            const float* lf = (const float*)(lds + L_LRF) + (rg * 16 + ii) * 16;
            const f32x4 a0 = *(const f32x4*)lf, a1 = *(const f32x4*)(lf + 4), a2 = *(const f32x4*)(lf + 8), a3 = *(const f32x4*)(lf + 12);
            float x = bdec;
            x += a0.x * wdec[0] + a0.y * wdec[1] + a0.z * wdec[2] + a0.w * wdec[3];
            x += a1.x * wdec[4] + a1.y * wdec[5] + a1.z * wdec[6] + a1.w * wdec[7];
            x += a2.x * wdec[8] + a2.y * wdec[9] + a2.z * wdec[10] + a2.w * wdec[11];
            x += a3.x * wdec[12] + a3.y * wdec[13] + a3.z * wdec[14] + a3.w * wdec[15];
            const float ls = fminf(x, 0.f) - __logf(1.0f + __expf(-fabsf(x)));
            run += ls * 0.0625f; cs[ii] = run;
        }
        ((float*)(lds + L_TOT))[rg * 128 + d] = run;
        __syncthreads();
        float off = 0.f, blast = 0.f;
#pragma unroll
        for (int r = 0; r < 4; ++r) { const float tv = ((const float*)(lds + L_TOT))[r * 128 + d]; blast += tv; if (r < rg) off += tv; }
        {
            bf16_t* qe = (bf16_t*)(lds + L_QE) + d; bf16_t* ke = (bf16_t*)(lds + L_KE) + d;
            unsigned ksp[8];
#pragma unroll
            for (int ii = 0; ii < 16; ii += 2) {
                const int i0 = rg * 16 + ii;
                const float b0 = off + cs[ii], b1 = off + cs[ii + 1];
                const float q0v = bf2f(qe[i0 * 136]), q1v = bf2f(qe[(i0 + 1) * 136]), k0v = bf2f(ke[i0 * 136]), k1v = bf2f(ke[(i0 + 1) * 136]);
                qe[i0 * 136] = f2bf(q0v * __expf(b0)); qe[(i0 + 1) * 136] = f2bf(q1v * __expf(b1));
                ke[i0 * 136] = f2bf(k0v * __expf(-b0)); ke[(i0 + 1) * 136] = f2bf(k1v * __expf(-b1));
                ksp[ii >> 1] = pk2(k0v * __expf(blast - b0), k1v * __expf(blast - b1));
            }
            char* kst = lds + L_KST + d * 144 + rg * 32;
            *(u32x4*)kst = (u32x4){ksp[0], ksp[1], ksp[2], ksp[3]};
            *(u32x4*)(kst + 16) = (u32x4){ksp[4], ksp[5], ksp[6], ksp[7]};
            if (rg == 0) ((float*)(lds + L_GDEC))[d] = __expf(blast);
        }
        __syncthreads();
        {
            const int ct = wid & 3;
            f32x4 a[2] = {(f32x4){0.f, 0.f, 0.f, 0.f}, (f32x4){0.f, 0.f, 0.f, 0.f}};
#pragma unroll
            for (int ks = 0; ks < 4; ++ks) {
                const bf16x8 qv = *(const bf16x8*)(lds + L_QE + (ct * 16 + fr) * 272 + ks * 64 + fq * 16);
#pragma unroll
                for (int j = 0; j < 2; ++j) {
                    const int st = (wid >> 2) * 2 + j;
                    const bf16x8 kv = *(const bf16x8*)(lds + L_KE + (st * 16 + fr) * 272 + ks * 64 + fq * 16);
                    a[j] = mfma16(kv, qv, a[j]);
                }
            }
#pragma unroll
            for (int j = 0; j < 2; ++j) {
                const int st = (wid >> 2) * 2 + j, cc = ct * 16 + fr, s0 = st * 16 + fq * 4;
                const float v0 = (s0 + 0 <= cc) ? a[j].x : 0.f, v1 = (s0 + 1 <= cc) ? a[j].y : 0.f, v2 = (s0 + 2 <= cc) ? a[j].z : 0.f, v3 = (s0 + 3 <= cc) ? a[j].w : 0.f;
                *(u32x2*)(lds + L_ATT + cc * 144 + s0 * 2) = (u32x2){pk2(v0, v1), pk2(v2, v3)};
            }
        }
        __syncthreads();
        {
            f32x4 oc[4] = {(f32x4){0.f, 0.f, 0.f, 0.f}, (f32x4){0.f, 0.f, 0.f, 0.f}, (f32x4){0.f, 0.f, 0.f, 0.f}, (f32x4){0.f, 0.f, 0.f, 0.f}};
#pragma unroll
            for (int ks = 0; ks < 2; ++ks) {
                const bf16x8 af = *(const bf16x8*)(lds + L_VTL + (wid * 16 + fr) * 144 + ks * 64 + fq * 16);
#pragma unroll
                for (int ct = 0; ct < 4; ++ct) { const bf16x8 bfv = *(const bf16x8*)(lds + L_ATT + (ct * 16 + fr) * 144 + ks * 64 + fq * 16); oc[ct] = mfma16(af, bfv, oc[ct]); }
            }
#pragma unroll
            for (int ks = 0; ks < 4; ++ks) {
                const bf16x8 af = *(const bf16x8*)(lds + L_SB + (wid * 16 + fr) * 272 + ks * 64 + fq * 16);
#pragma unroll
                for (int ct = 0; ct < 4; ++ct) { const bf16x8 bfv = *(const bf16x8*)(lds + L_QE + (ct * 16 + fr) * 272 + ks * 64 + fq * 16); oc[ct] = mfma16(af, bfv, oc[ct]); }
            }
            const int cb = (dir ? (N - 1 - n) : n) * 64;
#pragma unroll
            for (int ct = 0; ct < 4; ++ct) {
                const int cl = ct * 16 + fr, tk = cb + (dir ? 63 - cl : cl);
                *(u32x2*)(OUT + (size_t)tk * ldo + wid * 16 + fq * 4) = (u32x2){pk2(oc[ct].x, oc[ct].y), pk2(oc[ct].z, oc[ct].w)};
            }
        }
        __syncthreads();
        {
            const f32x4 gd = *(const f32x4*)((const float*)(lds + L_GDEC) + wid * 16 + fq * 4);
#pragma unroll
            for (int et = 0; et < 8; ++et) S[et] = S[et] * gd;
#pragma unroll
            for (int ks = 0; ks < 2; ++ks) {
                const bf16x8 af = *(const bf16x8*)(lds + L_KST + (wid * 16 + fr) * 144 + ks * 64 + fq * 16);
#pragma unroll
                for (int et = 0; et < 8; ++et) { const bf16x8 bfv = *(const bf16x8*)(lds + L_VTL + (et * 16 + fr) * 144 + ks * 64 + fq * 16); S[et] = mfma16(af, bfv, S[et]); }
            }
#pragma unroll
            for (int et = 0; et < 8; ++et)
                *(u32x2*)(lds + L_SB + (et * 16 + fr) * 272 + (wid * 16 + fq * 4) * 2) = (u32x2){pk2(S[et].x, S[et].y), pk2(S[et].z, S[et].w)};
        }
        __syncthreads();
    }
#undef GGLOAD
}

__device__ __forceinline__ void phase_mixer(const Params& p, int g, char* lds, int* s_item) {
    const Grp G = get_group(p, g);
    const int nGLA = G.B * 16, nATT = G.B * 8 * (G.T / 128), nMEM = G.B * 4 * (G.T / 128), nTot = nGLA + nATT + nMEM;
    unsigned* ctr = (unsigned*)(p.ws + WS_CTRL) + g;
    float d1 = 0.f, d2 = 0.f, mq = 0.f, mk = 0.f, mmq = 0.f, mmk = 0.f;
    for (int i = 0; i < 64; ++i) { d1 += p.in[I_LQ1][i] * p.in[I_LK1][i]; d2 += p.in[I_LQ2][i] * p.in[I_LK2][i]; mq = fmaxf(mq, fabsf(p.in[I_DGQ][i])); mk = fmaxf(mk, fabsf(p.in[I_DGK][i])); }
    for (int i = 0; i < 256; ++i) { mmq = fmaxf(mmq, fabsf(p.in[I_MGQ][i])); mmk = fmaxf(mmk, fabsf(p.in[I_MGK][i])); }
    const float lam = expf(d1) - expf(d2) + 0.2f;
    const float shiftD = fmaxf(0.f, 8.f * mq * mk * LOG2E - 64.f), shiftM = fmaxf(0.f, 16.f * mmq * mmk * LOG2E - 64.f);
#ifndef STATIC_SCHED
#define STATIC_SCHED 0
#endif
    for (int sit = blockIdx.x;; sit += gridDim.x) {
#if STATIC_SCHED
        (void)ctr; (void)s_item;
        const int it = sit;
#else
        if (threadIdx.x == 0) *s_item = (int)atomicAdd(ctr, 1u);
        __syncthreads();
        const int it = *s_item;
        __syncthreads();
#endif
        if (it >= nTot) break;
        if (it < nGLA) gla_item(p, G, it, lds);
        else if (it < nGLA + nATT) diff_attn_item(p, G, it - nGLA, lds, lam, shiftD);
        else mem_attn_item(p, G, it - nGLA - nATT, lds, shiftM);
    }
}

__device__ __forceinline__ void phase_glafin(const Params& p, int g) {
    const int tid_ = otid(), lane = tid_ & 63, wid = tid_ >> 6;
    bf16_t* P = (bf16_t*)(p.ws + WS_PROJ); const bf16_t* F = (const bf16_t*)(p.ws + WS_HB);
    for (int it = blockIdx.x * 8 + wid; it < G_TOK * 4; it += gridDim.x * 8) {
        const int tok = it >> 2, h = it & 3;
        bf16_t* row = P + (size_t)tok * NP;
        const unsigned qq = *(const unsigned*)(row + C_GQ + h * 128 + lane * 2), kk = *(const unsigned*)(row + C_GK + h * 128 + lane * 2);
        const float qk = wave_sum(bflo(qq) * bflo(kk) + bfhi(qq) * bfhi(kk));
        const u32x2 f = *(const u32x2*)(F + (size_t)tok * D + h * 256 + lane * 4), bk = *(const u32x2*)(row + C_DV + h * 256 + lane * 4);
        const u32x2 v = *(const u32x2*)(row + C_GV + h * 256 + lane * 4), gt = *(const u32x2*)(row + C_GG + h * 256 + lane * 4);
        float o0 = bflo(f.x) + bflo(bk.x) - qk * bflo(v.x), o1 = bfhi(f.x) + bfhi(bk.x) - qk * bfhi(v.x);
        float o2 = bflo(f.y) + bflo(bk.y) - qk * bflo(v.y), o3 = bfhi(f.y) + bfhi(bk.y) - qk * bfhi(v.y);
        const float r = rsqrtf(wave_sum(o0 * o0 + o1 * o1 + o2 * o2 + o3 * o3) * (1.f / 256.f) + RMS_EPS);
        const f32x4 go = *(const f32x4*)(p.in[I_GOUT] + lane * 4);
        const float g0 = bflo(gt.x), g1 = bfhi(gt.x), g2 = bflo(gt.y), g3 = bfhi(gt.y);
        o0 *= r * go.x * g0 / (1.f + __expf(-g0)); o1 *= r * go.y * g1 / (1.f + __expf(-g1));
        o2 *= r * go.z * g2 / (1.f + __expf(-g2)); o3 *= r * go.w * g3 / (1.f + __expf(-g3));
        *(u32x2*)(row + C_GG + h * 256 + lane * 4) = (u32x2){pk2(o0, o1), pk2(o2, o3)};
    }
}

__device__ __forceinline__ void phase_merge(const Params& p, int g, char* lds) {
    const int tid_ = otid(), lane = tid_ & 63, wid = tid_ >> 6, wm = wid >> 2, wn = wid & 3, fr = lane & 15, fq = lane >> 4;
    const bf16_t* P = (const bf16_t*)(p.ws + WS_PROJ); bf16_t* M = (bf16_t*)(p.ws + WS_VT);
    const int nM = G_TOK / 128, nN = 4;
    for (int t = blockIdx.x; t < nM * nN; t += gridDim.x) {
        int pm, pn; tile_order(t, nM, nN, pm, pn);
        const int m0 = pm * 128, n0 = pn * 256;
        f32x4 macc[4][4];
#pragma unroll
        for (int i = 0; i < 4; ++i)
#pragma unroll
            for (int j = 0; j < 4; ++j) macc[i][j] = (f32x4){0.f, 0.f, 0.f, 0.f};
        for (int br = 0; br < 3; ++br) {
            f32x4 acc[4][4];
#pragma unroll
            for (int i = 0; i < 4; ++i)
#pragma unroll
                for (int j = 0; j < 4; ++j) acc[i][j] = (f32x4){0.f, 0.f, 0.f, 0.f};
            const int acol = br == 0 ? C_GG : (br == 1 ? C_DQ : C_MQ);
            gemm_kloop<true, 4>(acc, P + (size_t)m0 * NP + acol, NP, (const bf16_t*)(p.ws + WS_WOT) + (size_t)br * D * D + (size_t)n0 * D, D, D, lds);
#pragma unroll
            for (int mt = 0; mt < 4; ++mt)
#pragma unroll
                for (int nt = 0; nt < 4; ++nt) {
                    const int row = m0 + wm * 64 + mt * 16 + fr, col = n0 + wn * 64 + nt * 16 + fq * 4;
                    const u32x2 gt = *(const u32x2*)(P + (size_t)row * NP + C_BG + br * 1024 + col);
                    f32x4 sg; sg.x = 1.f / (1.f + __expf(-bflo(gt.x))); sg.y = 1.f / (1.f + __expf(-bfhi(gt.x))); sg.z = 1.f / (1.f + __expf(-bflo(gt.y))); sg.w = 1.f / (1.f + __expf(-bfhi(gt.y)));
                    macc[mt][nt] += sg * acc[mt][nt];
                }
        }
#pragma unroll
        for (int mt = 0; mt < 4; ++mt)
#pragma unroll
            for (int nt = 0; nt < 4; ++nt) {
                const int row = m0 + wm * 64 + mt * 16 + fr, col = n0 + wn * 64 + nt * 16 + fq * 4;
                *(u32x2*)(M + (size_t)row * D + col) = (u32x2){pk2(macc[mt][nt].x, macc[mt][nt].y), pk2(macc[mt][nt].z, macc[mt][nt].w)};
            }
    }
}

__device__ __forceinline__ void phase_outproj(const Params& p, int g, char* lds) {
    const Grp G = get_group(p, g);
    const int tid_ = otid(), lane = tid_ & 63, wid = tid_ >> 6, wm = wid >> 2, wn = wid & 3, fr = lane & 15, fq = lane >> 4;
    const bf16_t* M = (const bf16_t*)(p.ws + WS_VT); const bf16_t* W = (const bf16_t*)(p.ws + WS_WOT) + (size_t)3 * D * D;
    const int nM = G_TOK / 256, nN = 4;
    for (int t = blockIdx.x; t < nM * nN; t += gridDim.x) {
        int pm, pn; tile_order(t, nM, nN, pm, pn);
        const int m0 = pm * 256, n0 = pn * 256;
        f32x4 acc[8][4];
#pragma unroll
        for (int i = 0; i < 8; ++i)
#pragma unroll
            for (int j = 0; j < 4; ++j) acc[i][j] = (f32x4){0.f, 0.f, 0.f, 0.f};
        gemm_kloop<true, 8>(acc, M + (size_t)m0 * D, D, W + (size_t)n0 * D, D, D, lds);
#pragma unroll
        for (int mt = 0; mt < 8; ++mt)
#pragma unroll
            for (int nt = 0; nt < 4; ++nt) {
                const int row = m0 + wm * 128 + mt * 16 + fr, col = n0 + wn * 64 + nt * 16 + fq * 4;
                const f32x4 xv = *(const f32x4*)(G.x + (size_t)row * D + col);
                *(f32x4*)(G.out + (size_t)row * D + col) = xv + acc[mt][nt];
            }
    }
}

__device__ __forceinline__ void phase_peerq(const Params& p, int g, char* lds) {
    const int tid_ = otid(), lane = tid_ & 63, wid = tid_ >> 6, wm = wid >> 2, wn = wid & 3, fr = lane & 15, fq = lane >> 4;
    const bf16_t* A = (const bf16_t*)(p.ws + WS_HB); const bf16_t* W = (const bf16_t*)(p.ws + WS_WQT); bf16_t* P = (bf16_t*)(p.ws + WS_PROJ);
    const int nM = G_TOK / 256, nN = 8;
    for (int t = blockIdx.x; t < nM * nN; t += gridDim.x) {
        int pm, pn; tile_order(t, nM, nN, pm, pn);
        const int m0 = pm * 256, n0 = pn * 256;
        f32x4 acc[8][4];
#pragma unroll
        for (int i = 0; i < 8; ++i)
#pragma unroll
            for (int j = 0; j < 4; ++j) acc[i][j] = (f32x4){0.f, 0.f, 0.f, 0.f};
        gemm_kloop<true, 8>(acc, A + (size_t)m0 * D, D, W + (size_t)n0 * D, D, D, lds);
#pragma unroll
        for (int mt = 0; mt < 8; ++mt)
#pragma unroll
            for (int nt = 0; nt < 4; ++nt) {
                const int row = m0 + wm * 128 + mt * 16 + fr, col = n0 + wn * 64 + nt * 16 + fq * 4;
                *(u32x2*)(P + (size_t)row * NP + col) = (u32x2){pk2(acc[mt][nt].x, acc[mt][nt].y), pk2(acc[mt][nt].z, acc[mt][nt].w)};
            }
    }
}

__device__ __forceinline__ unsigned f2ord(float f) { const unsigned u = __float_as_uint(f); return (u & 0x80000000u) ? ~u : (u | 0x80000000u); }
__device__ __forceinline__ float ord2f(unsigned k) { const unsigned u = (k & 0x80000000u) ? (k & 0x7fffffffu) : ~k; return __uint_as_float(u); }
__device__ __forceinline__ unsigned gmax16(unsigned v) {
    unsigned t;
    t = sxoru<1>(v); v = v > t ? v : t; t = sxoru<2>(v); v = v > t ? v : t; t = sxoru<4>(v); v = v > t ? v : t; t = sxoru<8>(v); v = v > t ? v : t;
    return v;
}
__device__ __forceinline__ float gsum16(float v) { v += sxor<1>(v); v += sxor<2>(v); v += sxor<4>(v); v += sxor<8>(v); return v; }
__device__ __forceinline__ float gelu_exact(float a) { return 0.5f * a * (1.0f + erff(a * 0.70710678118654752f)); }

__device__ __forceinline__ void phase_peer(const Params& p, int g, char* lds) {
    const Grp G = get_group(p, g);
    const int tid = otid(), lane = tid & 63, wid = tid >> 6, fr = lane & 15, fq = lane >> 4;
    const bf16_t* P = (const bf16_t*)(p.ws + WS_PROJ); const bf16_t* HB = (const bf16_t*)(p.ws + WS_HB);
    const bf16_t* K12 = (const bf16_t*)(p.ws + WS_K12);
    float* SC = (float*)lds;
    int* EIDX = (int*)(lds + 65536);
    float* GATE = (float*)(lds + 65536 + 4096);
    for (int tile = blockIdx.x; tile < G_TOK / 8; tile += gridDim.x) {
        const int tok0 = tile * 8;
        {
            const int mt = wid >> 1, half = wid & 1;
            const int r = mt * 16 + fr, tl = r >> 3, hh = r & 7;
            const bf16_t* qrow = P + (size_t)(tok0 + tl) * NP + hh * 256 + half * 128;
            const bf16_t* kb = K12 + half * 16384;
            f32x4 acc[8];
#pragma unroll
            for (int i = 0; i < 8; ++i) acc[i] = (f32x4){0.f, 0.f, 0.f, 0.f};
#pragma unroll
            for (int ks = 0; ks < 4; ++ks) {
                const bf16x8 af = *(const bf16x8*)(qrow + ks * 32 + fq * 8);
#pragma unroll
                for (int nt = 0; nt < 8; ++nt) { const bf16x8 bfv = *(const bf16x8*)(kb + (nt * 16 + fr) * 128 + ks * 32 + fq * 8); acc[nt] = mfma16(af, bfv, acc[nt]); }
            }
#pragma unroll
            for (int nt = 0; nt < 8; ++nt) {
                float* dst = SC + (mt * 16 + fq * 4) * 256 + half * 128 + nt * 16 + fr;
                dst[0] = acc[nt].x; dst[256] = acc[nt].y; dst[512] = acc[nt].z; dst[768] = acc[nt].w;
            }
        }
        __syncthreads();
        for (int pass = 0; pass < 2; ++pass) {
            const int row = wid * 8 + pass * 4 + fq, sl = fr, gb = fq * 16;
            float v1 = 0.f, v2 = 0.f; int i1 = 0, i2 = 0;
#pragma unroll
            for (int hf = 0; hf < 2; ++hf) {
                unsigned key[8];
#pragma unroll
                for (int i = 0; i < 8; ++i) { const int idx = sl + 16 * i; key[i] = (f2ord(SC[row * 256 + hf * 128 + idx]) & ~127u) | (unsigned)(127 - idx); }
                float sv = 0.f; int si = 0;
                for (int r = 0; r < 16; ++r) {
                    unsigned m = key[0];
#pragma unroll
                    for (int i = 1; i < 8; ++i) m = m > key[i] ? m : key[i];
                    m = gmax16(m);
                    if (sl == r) { sv = ord2f(m & ~127u); si = 127 - (int)(m & 127u); }
#pragma unroll
                    for (int i = 0; i < 8; ++i) key[i] = key[i] == m ? 0u : key[i];
                }
                if (hf == 0) { v1 = sv; i1 = si; } else { v2 = sv; i2 = si; }
            }
            int ptr = 0; float ts = 0.f; int pid = 0;
            for (int r = 0; r < 16; ++r) {
                const float v2p = __int_as_float(__builtin_amdgcn_ds_bpermute((gb + (ptr & 15)) << 2, __float_as_int(v2)));
                const unsigned key = ptr < 16 ? ((f2ord(v1 + v2p) & ~255u) | (unsigned)(255 - (sl * 16 + ptr))) : 0u;
                const unsigned m = gmax16(key);
                if (sl == r) { ts = ord2f(m & ~255u); pid = 255 - (int)(m & 255u); }
                if (key == m) ptr++;
            }
            const int e1 = __builtin_amdgcn_ds_bpermute((gb + (pid >> 4)) << 2, i1), e2 = __builtin_amdgcn_ds_bpermute((gb + (pid & 15)) << 2, i2);
            float mx = ts;
            mx = fmaxf(mx, sxor<1>(mx)); mx = fmaxf(mx, sxor<2>(mx)); mx = fmaxf(mx, sxor<4>(mx)); mx = fmaxf(mx, sxor<8>(mx));
            const float ex = __expf(ts - mx), sm = gsum16(ex);
            EIDX[row * 16 + sl] = e1 * 128 + e2; GATE[row * 16 + sl] = ex / sm;
        }
        __syncthreads();
        {
            const int tok = tok0 + wid;
            const bf16_t* hrow = HB + (size_t)tok * D;
            const int grp = lane >> 4, sl = lane & 15;
            {
                f32x2 hv[32];
#pragma unroll
                for (int c = 0; c < 8; ++c) {
                    const u32x4 hq = *(const u32x4*)(hrow + sl * 64 + c * 8);
                    hv[c * 4 + 0] = (f32x2){bflo(hq.x), bfhi(hq.x)} * (1.0f / PEER_SU); hv[c * 4 + 1] = (f32x2){bflo(hq.y), bfhi(hq.y)} * (1.0f / PEER_SU);
                    hv[c * 4 + 2] = (f32x2){bflo(hq.z), bfhi(hq.z)} * (1.0f / PEER_SU); hv[c * 4 + 3] = (f32x2){bflo(hq.w), bfhi(hq.w)} * (1.0f / PEER_SU);
                }
                const unsigned char* PU8 = p.ws + WS_PU + sl * 64;
#pragma unroll 2
                for (int it = 0; it < 32; ++it) {
                    const int k = it * 4 + grp;
                    const int e = EIDX[wid * 128 + k]; const float gt = GATE[wid * 128 + k];
                    const unsigned char* ur = PU8 + (size_t)e * D;
                    const u32x4 u0 = *(const u32x4*)ur, u1 = *(const u32x4*)(ur + 16), u2 = *(const u32x4*)(ur + 32), u3 = *(const u32x4*)(ur + 48);
                    f32x2 a2 = (f32x2){0.f, 0.f}, b2 = (f32x2){0.f, 0.f};
#define PDOT(uq, base) \
                    a2 += __builtin_amdgcn_cvt_pk_f32_fp8((int)uq.x, false) * hv[base + 0]; b2 += __builtin_amdgcn_cvt_pk_f32_fp8((int)uq.x, true) * hv[base + 1]; \
                    a2 += __builtin_amdgcn_cvt_pk_f32_fp8((int)uq.y, false) * hv[base + 2]; b2 += __builtin_amdgcn_cvt_pk_f32_fp8((int)uq.y, true) * hv[base + 3]; \
                    a2 += __builtin_amdgcn_cvt_pk_f32_fp8((int)uq.z, false) * hv[base + 4]; b2 += __builtin_amdgcn_cvt_pk_f32_fp8((int)uq.z, true) * hv[base + 5]; \
                    a2 += __builtin_amdgcn_cvt_pk_f32_fp8((int)uq.w, false) * hv[base + 6]; b2 += __builtin_amdgcn_cvt_pk_f32_fp8((int)uq.w, true) * hv[base + 7];
                    PDOT(u0, 0) PDOT(u1, 8) PDOT(u2, 16) PDOT(u3, 24)
#undef PDOT
                    a2 += b2;
                    const float a = gsum16(a2.x + a2.y);
                    GATE[wid * 128 + k] = gt * gelu_exact(a);
                }
            }
            __syncthreads();
            f32x2 acc[8];
#pragma unroll
            for (int i = 0; i < 8; ++i) acc[i] = (f32x2){0.f, 0.f};
            const unsigned char* PV8 = p.ws + WS_PV + lane * 16;
#pragma unroll 8
            for (int k = 0; k < 128; ++k) {
                const int e = EIDX[wid * 128 + k]; const float w = GATE[wid * 128 + k];
                const u32x4 v = *(const u32x4*)(PV8 + (size_t)e * D);
                const f32x2 w2 = (f32x2){w, w};
                acc[0] += w2 * __builtin_amdgcn_cvt_pk_f32_fp8((int)v.x, false); acc[1] += w2 * __builtin_amdgcn_cvt_pk_f32_fp8((int)v.x, true);
                acc[2] += w2 * __builtin_amdgcn_cvt_pk_f32_fp8((int)v.y, false); acc[3] += w2 * __builtin_amdgcn_cvt_pk_f32_fp8((int)v.y, true);
                acc[4] += w2 * __builtin_amdgcn_cvt_pk_f32_fp8((int)v.z, false); acc[5] += w2 * __builtin_amdgcn_cvt_pk_f32_fp8((int)v.z, true);
                acc[6] += w2 * __builtin_amdgcn_cvt_pk_f32_fp8((int)v.w, false); acc[7] += w2 * __builtin_amdgcn_cvt_pk_f32_fp8((int)v.w, true);
            }
            float* orow = G.out + (size_t)tok * D + lane * 16;
#pragma unroll
            for (int i = 0; i < 4; ++i) {
                f32x4 t = *(f32x4*)(orow + i * 4);
                t.x += acc[2 * i].x * (1.0f / PEER_SV); t.y += acc[2 * i].y * (1.0f / PEER_SV); t.z += acc[2 * i + 1].x * (1.0f / PEER_SV); t.w += acc[2 * i + 1].y * (1.0f / PEER_SV);
                *(f32x4*)(orow + i * 4) = t;
            }
        }
        __syncthreads();
    }
}


#ifndef DEBUG_NAN
#define DEBUG_NAN 0
#endif
#if DEBUG_NAN
__device__ __noinline__ void scan_bf16(const bf16_t* base, size_t rows, size_t pitch, int col0, int ncols, unsigned* flag) {
    const size_t gtid = (size_t)blockIdx.x * NTHR + threadIdx.x, gsz = (size_t)gridDim.x * NTHR, cpr = ncols / 8, total = rows * cpr;
    bool bad = false;
    for (size_t i = gtid; i < total; i += gsz) {
        const size_t r = i / cpr, c = i % cpr;
        const u32x4 v = *(const u32x4*)(base + r * pitch + col0 + c * 8);
        bad = bad || ((v.x & 0x7F80u) == 0x7F80u) || ((v.x & 0x7F800000u) == 0x7F800000u) || ((v.y & 0x7F80u) == 0x7F80u) || ((v.y & 0x7F800000u) == 0x7F800000u)
                  || ((v.z & 0x7F80u) == 0x7F80u) || ((v.z & 0x7F800000u) == 0x7F800000u) || ((v.w & 0x7F80u) == 0x7F80u) || ((v.w & 0x7F800000u) == 0x7F800000u);
    }
    if (bad) atomicOr(flag, 1u);
}
__device__ __noinline__ void scan_f32(const float* base, size_t n, unsigned* flag) {
    const size_t gtid = (size_t)blockIdx.x * NTHR + threadIdx.x, gsz = (size_t)gridDim.x * NTHR;
    bool bad = false;
    for (size_t i = gtid; i < n; i += gsz) { if ((__float_as_uint(base[i]) & 0x7F800000u) == 0x7F800000u) bad = true; }
    if (bad) atomicOr(flag, 1u);
}
__device__ __forceinline__ void debug_scan(const Params& p, int ph) {
    unsigned* F = (unsigned*)(p.ws + WS_CTRL) + 128;
    const bf16_t* P = (const bf16_t*)(p.ws + WS_PROJ); const bf16_t* HB = (const bf16_t*)(p.ws + WS_HB); const bf16_t* VT = (const bf16_t*)(p.ws + WS_VT);
    if (ph == 0) {
        scan_bf16((const bf16_t*)(p.ws + WS_WINT), NP, D, 0, D, F + 0);
        scan_bf16((const bf16_t*)(p.ws + WS_WOT), 4 * D + 4096, D, 0, D, F + 1);
        scan_bf16((const bf16_t*)(p.ws + WS_PU), 32768, D, 0, D, F + 2);
        scan_f32((const float*)(p.ws + WS_ROPE), 16384 * 64, F + 3);
        scan_bf16((const bf16_t*)(p.ws + WS_HM), 2560, D, 0, D, F + 3);
    } else if (ph == 2) {
        scan_bf16((const bf16_t*)(p.ws + WS_MEMK), 2 * 10 * 4 * 256, 256, 0, 256, F + 4);
    } else if (ph == 3) scan_bf16(HB, G_TOK, D, 0, D, F + 5);
    else if (ph == 4) { scan_bf16(P, G_TOK, NP, 0, 3072, F + 6); scan_bf16(P, G_TOK, NP, 3072, 2048, F + 7); scan_bf16(VT, G_TOK, D, 0, D, F + 8); scan_bf16(P, G_TOK, NP, 6144, NP - 6144, F + 9); }
    else if (ph == 5) scan_bf16(P, G_TOK, NP, 3072, 2048, F + 10);
    else if (ph == 6) { scan_bf16(HB, G_TOK, D, 0, D, F + 11); scan_bf16(P, G_TOK, NP, C_DV, 1024, F + 12); scan_bf16(P, G_TOK, NP, C_DQ, 1024, F + 13); scan_bf16(P, G_TOK, NP, C_MQ, 1024, F + 14); }
    else if (ph == 7) scan_bf16(P, G_TOK, NP, C_GG, 1024, F + 15);
    else if (ph == 8) scan_bf16(VT, G_TOK, D, 0, D, F + 16);
    else if (ph == 9) scan_f32(p.out, (size_t)G_TOK * D, F + 17);
    else if (ph == 10) scan_bf16(HB, G_TOK, D, 0, D, F + 18);
    else if (ph == 11) scan_bf16(P, G_TOK, NP, 0, 2048, F + 19);
    else if (ph == 12) scan_f32(p.out, (size_t)G_TOK * D, F + 20);
}
#endif

constexpr int NPH = 3 + NGROUP * 10;
__device__ __forceinline__ void run_phase(const Params& p, int ph, char* lds, int* s_item) {
    if (ph == 0) { phase_p0a(p, lds); return; }
    if (ph == 1) { phase_p0b(p, lds); return; }
    if (ph == 2) { phase_p0c(p); return; }
    const int g = (ph - 3) / 10, s = (ph - 3) % 10;
    const Grp G = get_group(p, g);
    switch (s) {
        case 0: phase_rmsnorm(G.x, p.in[I_GMIX], (bf16_t*)(p.ws + WS_HB), G_TOK); break;
        case 1: phase_inproj(p, g, lds); break;
        case 2: phase_qkrope(p, g); break;
        case 3: phase_mixer(p, g, lds, s_item); break;
        case 4: phase_glafin(p, g); break;
        case 5: phase_merge(p, g, lds); break;
        case 6: phase_outproj(p, g, lds); break;
        case 7: phase_rmsnorm(G.out, p.in[I_GFFN], (bf16_t*)(p.ws + WS_HB), G_TOK); break;
        case 8: phase_peerq(p, g, lds); break;
        case 9: phase_peer(p, g, lds); break;
    }
}

__global__ void __launch_bounds__(NTHR) mega_kernel(Params p) {
    extern __shared__ __attribute__((aligned(16))) char lds[];
    __shared__ int s_item;
    cg::grid_group grid = cg::this_grid();
#ifndef PROBE
#define PROBE 0
#endif
#if PROBE
    __shared__ unsigned long long tacc[16];
    if (threadIdx.x < 16) tacc[threadIdx.x] = 0ull;
    __syncthreads();
    if (threadIdx.x == 0) tacc[15] = __builtin_amdgcn_s_memrealtime();
#endif
    for (int ph = p.ph_lo; ph < p.ph_hi; ++ph) {
        run_phase(p, ph, lds, &s_item);
#if DEBUG_NAN
        __threadfence(); grid.sync(); __threadfence();
        debug_scan(p, ph);
        __threadfence(); grid.sync(); __threadfence();
#else
#if PROBE
        __threadfence(); grid.sync(); __threadfence();
        if (blockIdx.x == 0 && threadIdx.x == 0) { const unsigned long long tn = __builtin_amdgcn_s_memrealtime(); tacc[ph < 3 ? 10 + ph : (ph - 3) % 10] += tn - tacc[15]; tacc[15] = tn; }
#else
        if (ph + 1 < p.ph_hi) grid.sync();
#endif
#endif
    }
#if PROBE
    if (blockIdx.x == 0 && threadIdx.x == 0) {
        unsigned long long ta = 0, tb = 0;
        for (int k = 0; k < 13; ++k) { if ((PROBE_A >> k) & 1) ta += tacc[k]; if ((PROBE_B >> k) & 1) tb += tacc[k]; }
        float ma = (float)ta * 1e-5f;
        if (ma >= 10.f) ma *= 0.1f;
        if (ma < 1.f) ma *= 10.f;
        const int eb = 5 + (int)((float)tb * 1e-5f + 0.5f);
        float mark = ma; for (int k = 0; k < eb; ++k) mark *= 10.f;
        p.out[0] = mark;
    }
#endif
#if DEBUG_NAN
    if (blockIdx.x == 0 && threadIdx.x == 0) {
        const unsigned* F = (const unsigned*)(p.ws + WS_CTRL) + 128; int first = -1;
        for (int k = 0; k <= 20; ++k) if (first < 0 && atomicOr((unsigned*)F + k, 0u)) first = k;
        float mark = 1000.f; for (int k = 0; k < first; ++k) mark *= 10.f;
        p.out[0] = first < 0 ? 777.f : mark;
    }
#endif
}

extern "C" void kernel_launch(void* const* d_in, const int* in_sizes, int n_in, void* d_out, int out_size, void* d_ws, size_t ws_size, hipStream_t stream) {
    static int grid_blocks = 0;
    if (grid_blocks == 0) {
        if (n_in != 32 || ws_size < WS_END) { fprintf(stderr, "kernel_launch: unexpected n_in %d or ws_size %zu (< %zu)\n", n_in, ws_size, (size_t)WS_END); grid_blocks = -1; return; }
        int dev = 0, cus = 0, per_cu = 0;
        hipGetDevice(&dev);
        hipDeviceGetAttribute(&cus, hipDeviceAttributeMultiprocessorCount, dev);
        hipFuncSetAttribute((const void*)mega_kernel, hipFuncAttributeMaxDynamicSharedMemorySize, LDS_BYTES);
        hipOccupancyMaxActiveBlocksPerMultiprocessor(&per_cu, (const void*)mega_kernel, NTHR, LDS_BYTES);
        if (per_cu < 1) per_cu = 1;
        grid_blocks = cus * per_cu;
        (void)hipGetLastError();
    }
    if (grid_blocks < 0) return;
    Params p{};
    for (int i = 0; i < 32; ++i) p.in[i] = (const float*)d_in[i];
    p.out = (float*)d_out; p.ws = (unsigned char*)d_ws; p.ph_lo = 0; p.ph_hi = NPH;
    void* args[] = {&p};
    hipError_t e = hipLaunchCooperativeKernel((const void*)mega_kernel, dim3(grid_blocks), dim3(NTHR), args, LDS_BYTES, stream);
    if (e != hipSuccess) fprintf(stderr, "cooperative launch failed: %s (grid %d)\n", hipGetErrorString(e), grid_blocks);
}
```

```cpp
#include <hip/hip_runtime.h>
#include <hip/hip_cooperative_groups.h>
#include <cstdio>
#include <cstdint>
namespace cg = cooperative_groups;

typedef unsigned short bf16_t;
typedef short bf16x8 __attribute__((ext_vector_type(8)));
typedef float f32x4 __attribute__((ext_vector_type(4)));
typedef unsigned u32x4 __attribute__((ext_vector_type(4)));
typedef unsigned u32x2 __attribute__((ext_vector_type(2)));

constexpr int D = 1024;
constexpr int NP = 10496;
constexpr int IN_COLS = 10272;
constexpr int C_GQ = 0, C_GK = 512, C_GV = 1024, C_GG = 2048, C_DQ = 3072, C_DK = 4096, C_DV = 5120, C_MQ = 6144, C_BG = 7168, C_LR = 10240;
constexpr int G_TOK = 32768;
constexpr int NGROUP = 3;
constexpr int NTHR = 512;
constexpr float RMS_EPS = 1e-6f;
constexpr float LOG2E = 1.4426950408889634f;
constexpr int LDS_BYTES = 147456;
constexpr float PEER_SU = 32.0f, PEER_SV = 8.0f;

enum { I_XP = 0, I_XS, I_MP, I_MS, I_GMIX, I_WIN, I_WDF, I_BDF, I_WDB, I_BDB, I_GOUT, I_GWO, I_DGQ, I_DGK, I_LQ1, I_LK1, I_LQ2, I_LK2,
       I_DGSUB, I_DWO, I_MGN, I_MWKV, I_MGQ, I_MGK, I_MWO, I_WOUT, I_GFFN, I_PWQ, I_PK1, I_PK2, I_PU, I_PV };

constexpr size_t al256(size_t x) { return (x + 255) & ~(size_t)255; }
constexpr size_t WS_CTRL = 0;
constexpr size_t WS_PROJ = 4096;
constexpr size_t WS_HB   = WS_PROJ + (size_t)G_TOK * NP * 2;
constexpr size_t WS_VT   = WS_HB + (size_t)G_TOK * D * 2;
constexpr size_t WS_WINT = WS_VT + (size_t)G_TOK * D * 2;
constexpr size_t WS_WOT  = WS_WINT + (size_t)NP * D * 2;
constexpr size_t WS_WKVT = WS_WOT + (size_t)4 * D * D * 2;
constexpr size_t WS_WQT  = WS_WKVT + (size_t)2048 * D * 2;
constexpr size_t WS_PU   = WS_WQT + (size_t)2048 * D * 2;
constexpr size_t WS_PV   = WS_PU + (size_t)16384 * D * 2;
constexpr size_t WS_K12  = WS_PV + (size_t)16384 * D * 2;
constexpr size_t WS_ROPE = WS_K12 + (size_t)2 * 128 * 128 * 2;
constexpr size_t WS_HM   = WS_ROPE + (size_t)16384 * 64 * 4;
constexpr size_t WS_KVR  = WS_HM + (size_t)2560 * D * 2;
constexpr size_t WS_MEMK = WS_KVR + (size_t)2560 * 2048 * 4;
constexpr size_t WS_MEMV = WS_MEMK + (size_t)10 * 4 * 256 * 256 * 2;
constexpr size_t WS_END  = WS_MEMV + (size_t)10 * 4 * 256 * 256 * 2;

struct Params {
    const float* in[32];
    float* out;
    unsigned char* ws;
    int ph_lo, ph_hi;
};

typedef float f32x2 __attribute__((ext_vector_type(2)));
typedef __bf16 bf16x2v __attribute__((ext_vector_type(2)));
__device__ __forceinline__ unsigned pk2(float lo, float hi) { const f32x2 v = {lo, hi}; const bf16x2v b = __builtin_convertvector(v, bf16x2v); return __builtin_bit_cast(unsigned, b); }
__device__ __forceinline__ float bflo(unsigned u) { return __uint_as_float(u << 16); }
__device__ __forceinline__ float bfhi(unsigned u) { return __uint_as_float(u & 0xffff0000u); }
__device__ __forceinline__ float bf2f(bf16_t b) { return __uint_as_float(((unsigned)b) << 16); }
__device__ __forceinline__ bf16_t f2bf(float f) { return (bf16_t)(pk2(f, 0.f) & 0xffffu); }
__device__ __forceinline__ f32x4 mfma16(bf16x8 a, bf16x8 b, f32x4 c) { return __builtin_amdgcn_mfma_f32_16x16x32_bf16(a, b, c, 0, 0, 0); }
__device__ __forceinline__ float fexp2(float x) { return __builtin_amdgcn_exp2f(x); }
template <class T> __device__ __forceinline__ T* launder(T* q) { asm volatile("" : "+s"(q)); return q; }
__device__ __forceinline__ int otid() { int t = threadIdx.x; asm volatile("" : "+v"(t)); return t; }
template <int M> __device__ __forceinline__ float sxor(float v) {
    if (M < 32) return __int_as_float(__builtin_amdgcn_ds_swizzle(__float_as_int(v), (M << 10) | 0x1F));
    const int l = otid() & 63; return __int_as_float(__builtin_amdgcn_ds_bpermute((l ^ 32) << 2, __float_as_int(v)));
}
template <int M> __device__ __forceinline__ unsigned sxoru(unsigned v) { return (unsigned)__builtin_amdgcn_ds_swizzle((int)v, (M << 10) | 0x1F); }
__device__ __forceinline__ float wave_sum(float v) {
    v += sxor<1>(v); v += sxor<2>(v); v += sxor<4>(v); v += sxor<8>(v); v += sxor<16>(v); v += sxor<32>(v);
    return v;
}

struct Grp { const float* x; const float* mem; float* out; int B, T, mb0; };
__device__ __forceinline__ Grp get_group(const Params& p, int g) {
    Grp r;
    if (g == 0) { r.x = p.in[I_XP]; r.out = p.out; r.B = 2; r.T = 16384; r.mb0 = 0; }
    else { r.x = p.in[I_XS] + (size_t)(g - 1) * G_TOK * D; r.out = p.out + (size_t)g * G_TOK * D; r.B = 4; r.T = 8192; r.mb0 = 2 + (g - 1) * 4; }
    r.mem = nullptr;
    return r;
}

constexpr int G_ROW = 144;
constexpr int G_A_BYTES = 128 * G_ROW;
constexpr int G_B_BYTES = 256 * G_ROW;
constexpr int G_STAGE = G_A_BYTES + G_B_BYTES;

template <bool SWAP, int MT>
__device__ __forceinline__ void gemm_kloop(f32x4 (&acc)[MT][4], const bf16_t* __restrict__ A, int lda, const bf16_t* __restrict__ Bt, int ldb, int K, char* lds) {
    constexpr int A_BYTES = MT * 32 * G_ROW, STAGE = A_BYTES + G_B_BYTES, NA = MT / 2;
    const int tid = otid(), lane = tid & 63, wid = tid >> 6, wm = wid >> 2, wn = wid & 3, fr = lane & 15, fq = lane >> 4;
    const int lr = tid >> 3, lc = tid & 7;
    u32x4 ra[NA], rb[4];
    const bf16_t* Ap = A + (size_t)lr * lda + lc * 8;
    const bf16_t* Bp = Bt + (size_t)lr * ldb + lc * 8;
#define GLOAD(k0) do { _Pragma("unroll") for (int i = 0; i < NA; ++i) ra[i] = *(const u32x4*)(Ap + (size_t)(i * 64) * lda + (k0)); \
                       _Pragma("unroll") for (int i = 0; i < 4; ++i) rb[i] = *(const u32x4*)(Bp + (size_t)(i * 64) * ldb + (k0)); } while (0)
#define SWRITE(buf) do { char* b_ = lds + (buf) * STAGE + lr * G_ROW + lc * 16; \
                       _Pragma("unroll") for (int i = 0; i < NA; ++i) *(u32x4*)(b_ + i * 64 * G_ROW) = ra[i]; \
                       _Pragma("unroll") for (int i = 0; i < 4; ++i) *(u32x4*)(b_ + A_BYTES + i * 64 * G_ROW) = rb[i]; } while (0)
    const int nk = K / 64;
    GLOAD(0); SWRITE(0); __syncthreads();
    for (int kt = 0; kt < nk; ++kt) {
        if (kt + 1 < nk) GLOAD((kt + 1) * 64);
        const char* base = lds + (kt & 1) * STAGE;
#pragma unroll
        for (int ks = 0; ks < 2; ++ks) {
            bf16x8 bfr[4];
#pragma unroll
            for (int nt = 0; nt < 4; ++nt) bfr[nt] = *(const bf16x8*)(base + A_BYTES + (wn * 64 + nt * 16 + fr) * G_ROW + ks * 64 + fq * 16);
#pragma unroll
            for (int mt = 0; mt < MT; ++mt) {
                const bf16x8 af = *(const bf16x8*)(base + (wm * (MT * 16) + mt * 16 + fr) * G_ROW + ks * 64 + fq * 16);
#pragma unroll
                for (int nt = 0; nt < 4; ++nt)
                    acc[mt][nt] = SWAP ? mfma16(bfr[nt], af, acc[mt][nt]) : mfma16(af, bfr[nt], acc[mt][nt]);
            }
        }
        if (kt + 1 < nk) SWRITE((kt + 1) & 1);
        __syncthreads();
    }
#undef GLOAD
#undef SWRITE
}

__device__ __forceinline__ void tile_order(int t, int nM, int nN, int& pm, int& pn) {
    const int per = 8 * nN, grp = t / per, r = t % per;
    pm = grp * 8 + (r & 7); pn = r >> 3;
}

__device__ __forceinline__ void phase_p0a(const Params& p, char* lds) {
    const int tid = otid(), lane = tid & 63, wid = tid >> 6;
    unsigned char* ws = p.ws;
    if (blockIdx.x == 0 && tid < 256) atomicExch((unsigned*)(ws + WS_CTRL) + tid, 0u);
    float* scr = (float*)(lds + wid * 8448);
    constexpr int IT_WIN = 16 * (NP / 32), IT_SQ = 16 * 32, IT_W2 = 16 * 64;
    constexpr int NIT = IT_WIN + 4 * IT_SQ + 2 * IT_W2;
    for (int it0 = blockIdx.x * 8; it0 < NIT; it0 += gridDim.x * 8) {
        int it = it0 + wid;
        const float* W = nullptr; bf16_t* WT = nullptr; int N = 0, nb = 0, kb = 0, srccol = -1;
        if (it < NIT) {
            int r = it;
            if (r < IT_WIN) { W = p.in[I_WIN]; N = IN_COLS; WT = (bf16_t*)(ws + WS_WINT); kb = r / (NP / 32); nb = r % (NP / 32);
                const int n0 = nb * 32; srccol = n0 < 3072 ? n0 : (n0 < 10240 ? n0 + 32 : (n0 == 10240 ? 3072 : -1)); }
            else { r -= IT_WIN;
                if (r < 4 * IT_SQ) { const int w = r / IT_SQ; r %= IT_SQ; const int idx[4] = {I_GWO, I_DWO, I_MWO, I_WOUT};
                    W = p.in[w == 0 ? I_GWO : (w == 1 ? I_DWO : (w == 2 ? I_MWO : I_WOUT))]; (void)idx; N = 1024; WT = (bf16_t*)(ws + WS_WOT) + (size_t)w * D * D; kb = r / 32; nb = r % 32; srccol = nb * 32; }
                else { r -= 4 * IT_SQ; const int w = r / IT_W2; r %= IT_W2; W = p.in[w == 0 ? I_MWKV : I_PWQ]; N = 2048; WT = (bf16_t*)(ws + (w == 0 ? WS_WKVT : WS_WQT)); kb = r / 64; nb = r % 64; srccol = nb * 32; }
            }
            const int k0 = kb * 64;
#pragma unroll 8
            for (int i = 0; i < 32; ++i) { const int kk = 2 * i + (lane >> 5); scr[kk * 33 + (lane & 31)] = srccol >= 0 ? W[(size_t)(k0 + kk) * N + srccol + (lane & 31)] : 0.f; }
        }
        __syncthreads();
        if (it < NIT) {
            const int k0 = kb * 64, c = lane & 7;
#pragma unroll
            for (int j = 0; j < 4; ++j) { const int n = (lane >> 3) + 8 * j; const float* s = scr + (8 * c) * 33 + n;
                u32x4 o; o.x = pk2(s[0], s[33]); o.y = pk2(s[66], s[99]); o.z = pk2(s[132], s[165]); o.w = pk2(s[198], s[231]);
                *(u32x4*)(WT + (size_t)(nb * 32 + n) * D + k0 + 8 * c) = o; }
        }
        __syncthreads();
    }
    const size_t gtid = (size_t)blockIdx.x * NTHR + tid, gsz = (size_t)gridDim.x * NTHR;
    {
        const size_t n8 = (size_t)16384 * D / 8;
        for (size_t i = gtid; i < 2 * n8; i += gsz) {
            const int w = i >= n8; const size_t j = w ? i - n8 : i;
            const float* src = p.in[w ? I_PV : I_PU] + j * 8; unsigned char* dst = ws + (w ? WS_PV : WS_PU) + j * 8;
            const float sc = w ? PEER_SV : PEER_SU;
            const f32x4 a = *(const f32x4*)src * sc, b = *(const f32x4*)(src + 4) * sc;
            int lo = __builtin_amdgcn_cvt_pk_fp8_f32(a.x, a.y, 0, false); lo = __builtin_amdgcn_cvt_pk_fp8_f32(a.z, a.w, lo, true);
            int hi = __builtin_amdgcn_cvt_pk_fp8_f32(b.x, b.y, 0, false); hi = __builtin_amdgcn_cvt_pk_fp8_f32(b.z, b.w, hi, true);
            *(u32x2*)dst = (u32x2){(unsigned)lo, (unsigned)hi};
        }
        for (size_t i = gtid; i < 2 * 16384; i += gsz) {
            const int w = i >= 16384; const size_t j = w ? i - 16384 : i;
            ((bf16_t*)(ws + WS_K12))[i] = f2bf(p.in[w ? I_PK2 : I_PK1][j]);
        }
    }
    for (size_t i = gtid; i < (size_t)16384 * 32; i += gsz) {
        const int t = (int)(i >> 5), k = (int)(i & 31);
        const float inv = powf(10000.0f, -(float)(2 * k) / 64.0f);
        const float ang = (float)t * inv;
        double sn, cs; sincos((double)ang, &sn, &cs);
        float* R = (float*)(ws + WS_ROPE) + (size_t)t * 64;
        R[k] = (float)cs; R[32 + k] = (float)sn;
    }
    for (int row = blockIdx.x * 8 + wid; row < 2560; row += gridDim.x * 8) {
        const float* src = row < 512 ? p.in[I_MP] + (size_t)row * D : p.in[I_MS] + (size_t)(row - 512) * D;
        const f32x4* xr = (const f32x4*)src + lane; const f32x4* gr = (const f32x4*)p.in[I_MGN] + lane;
        f32x4 v[4]; float s = 0.f;
#pragma unroll
        for (int j = 0; j < 4; ++j) { v[j] = xr[64 * j]; s += v[j].x * v[j].x + v[j].y * v[j].y + v[j].z * v[j].z + v[j].w * v[j].w; }
        const float r = rsqrtf(wave_sum(s) * (1.f / D) + RMS_EPS);
        u32x2* o = (u32x2*)((bf16_t*)(ws + WS_HM) + (size_t)row * D) + lane;
#pragma unroll
        for (int j = 0; j < 4; ++j) { const f32x4 g = gr[64 * j]; u32x2 w; w.x = pk2(v[j].x * r * g.x, v[j].y * r * g.y); w.y = pk2(v[j].z * r * g.z, v[j].w * r * g.w); o[64 * j] = w; }
    }
}

__device__ __forceinline__ void phase_p0b(const Params& p, char* lds) {
    const int tid_ = otid(), lane = tid_ & 63, wid = tid_ >> 6, wm = wid >> 2, wn = wid & 3, fr = lane & 15, fq = lane >> 4;
    const bf16_t* A = (const bf16_t*)(p.ws + WS_HM); const bf16_t* Bt = (const bf16_t*)(p.ws + WS_WKVT);
    float* C = (float*)(p.ws + WS_KVR);
    const int nM = 20, nN = 8;
    for (int t = blockIdx.x; t < nM * nN; t += gridDim.x) {
        const int pm = t % nM, pn = t / nM, m0 = pm * 128, n0 = pn * 256;
        f32x4 acc[4][4];
#pragma unroll
        for (int i = 0; i < 4; ++i)
#pragma unroll
            for (int j = 0; j < 4; ++j) acc[i][j] = (f32x4){0.f, 0.f, 0.f, 0.f};
        gemm_kloop<true, 4>(acc, A + (size_t)m0 * D, D, Bt + (size_t)n0 * D, D, D, lds);
#pragma unroll
        for (int mt = 0; mt < 4; ++mt)
#pragma unroll
            for (int nt = 0; nt < 4; ++nt) {
                const int row = m0 + wm * 64 + mt * 16 + fr, col = n0 + wn * 64 + nt * 16 + fq * 4;
                *(f32x4*)(C + (size_t)row * 2048 + col) = acc[mt][nt];
            }
    }
}

__device__ __forceinline__ void phase_p0c(const Params& p) {
    const int tid_ = otid(), lane = tid_ & 63, wid = tid_ >> 6;
    const float* KV = (const float*)(p.ws + WS_KVR);
    bf16_t* MK = (bf16_t*)(p.ws + WS_MEMK); bf16_t* MV = (bf16_t*)(p.ws + WS_MEMV);
    for (int it = blockIdx.x * 8 + wid; it < 2560 * 4; it += gridDim.x * 8) {
        const int row = it >> 2, h = it & 3, b = row >> 8, m = row & 255;
        const f32x4 kv = *(const f32x4*)(KV + (size_t)row * 2048 + h * 256 + lane * 4);
        const float ss = wave_sum(kv.x * kv.x + kv.y * kv.y + kv.z * kv.z + kv.w * kv.w);
        const float r = rsqrtf(ss * (1.f / 256.f) + RMS_EPS);
        const f32x4 g = *(const f32x4*)(p.in[I_MGK] + lane * 4);
        u32x2 w; w.x = pk2(kv.x * r * g.x, kv.y * r * g.y); w.y = pk2(kv.z * r * g.z, kv.w * r * g.w);
        *(u32x2*)(MK + ((size_t)(b * 4 + h) * 256 + m) * 256 + lane * 4) = w;
        const f32x4 vv = *(const f32x4*)(KV + (size_t)row * 2048 + 1024 + h * 256 + lane * 4);
        const int pos = (m & ~31) + ((m >> 2) & 3) * 8 + ((m >> 4) & 1) * 4 + (m & 3);
        bf16_t* dst = MV + ((size_t)(b * 4 + h) * 256 + lane * 4) * 256 + pos;
        dst[0] = f2bf(vv.x); dst[256] = f2bf(vv.y); dst[512] = f2bf(vv.z); dst[768] = f2bf(vv.w);
    }
}

__device__ __forceinline__ void phase_rmsnorm(const float* X, const float* gain, bf16_t* O, int row0, int nrows) {
    const int tid_ = otid(), lane = tid_ & 63, wid = tid_ >> 6;
    const f32x4* gr = (const f32x4*)launder(gain) + lane;
    f32x4 g[4];
#pragma unroll
    for (int j = 0; j < 4; ++j) g[j] = gr[64 * j];
    for (int row = row0 + wid; row < row0 + nrows; row += 8) {
        const f32x4* xr = (const f32x4*)(X + (size_t)row * D) + lane;
        f32x4 v[4]; float s = 0.f;
#pragma unroll
        for (int j = 0; j < 4; ++j) { v[j] = xr[64 * j]; s += v[j].x * v[j].x + v[j].y * v[j].y + v[j].z * v[j].z + v[j].w * v[j].w; }
        const float r = rsqrtf(wave_sum(s) * (1.f / D) + RMS_EPS);
        u32x2* o = (u32x2*)(O + (size_t)row * D) + lane;
#pragma unroll
        for (int j = 0; j < 4; ++j) { u32x2 w; w.x = pk2(v[j].x * r * g[j].x, v[j].y * r * g[j].y); w.y = pk2(v[j].z * r * g[j].z, v[j].w * r * g[j].w); o[64 * j] = w; }
    }
}

__device__ __forceinline__ void phase_inproj(const Params& p, int g, char* lds, int u) {
    const Grp G = get_group(p, g);
    const int tid_ = otid(), lane = tid_ & 63, wid = tid_ >> 6, wm = wid >> 2, wn = wid & 3, fr = lane & 15, fq = lane >> 4;
    const bf16_t* A = (const bf16_t*)(p.ws + WS_HB); const bf16_t* Bt = (const bf16_t*)(p.ws + WS_WINT);
    bf16_t* P = (bf16_t*)(p.ws + WS_PROJ); bf16_t* VT = (bf16_t*)(p.ws + WS_VT);
    const int pm = u >> 1, half = u & 1, m0 = pm * 256;
    for (int pi = 0; pi < (half ? 17 : 12); ++pi) {
        const int pn = half ? 24 + pi : pi; const int n0 = pn * 256;
        f32x4 acc[8][4];
#pragma unroll
        for (int i = 0; i < 8; ++i)
#pragma unroll
            for (int j = 0; j < 4; ++j) acc[i][j] = (f32x4){0.f, 0.f, 0.f, 0.f};
        gemm_kloop<true, 8>(acc, A + (size_t)m0 * D, D, Bt + (size_t)n0 * D, D, D, lds);
        const float sc = n0 < 512 ? 0.08838834764831845f : 1.0f;
#pragma unroll
        for (int mt = 0; mt < 8; ++mt)
#pragma unroll
            for (int nt = 0; nt < 4; ++nt) {
                const int row = m0 + wm * 128 + mt * 16 + fr, col = n0 + wn * 64 + nt * 16 + fq * 4;
                u32x2 w; w.x = pk2(acc[mt][nt].x * sc, acc[mt][nt].y * sc); w.y = pk2(acc[mt][nt].z * sc, acc[mt][nt].w * sc);
                *(u32x2*)(P + (size_t)row * NP + col) = w;
            }
    }
    if (half == 0) for (int pn = 12; pn < 20; ++pn) {
        const int n0 = pn * 256;
        f32x4 acc[8][4];
#pragma unroll
        for (int i = 0; i < 8; ++i)
#pragma unroll
            for (int j = 0; j < 4; ++j) acc[i][j] = (f32x4){0.f, 0.f, 0.f, 0.f};
        gemm_kloop<true, 8>(acc, A + (size_t)m0 * D, D, Bt + (size_t)n0 * D, D, D, lds);
        const int te_ = otid(), fr = te_ & 15, fq = (te_ >> 4) & 3, wm = te_ >> 8, wn = (te_ >> 6) & 3;
        const bool isk = n0 >= C_DK;
        const float* gn = launder(p.in[isk ? I_DGK : I_DGQ]) + fq * 4;
        const float qs = isk ? 1.0f : 0.125f * LOG2E;
        const float* ROPE = (const float*)(p.ws + WS_ROPE);
        const int tq0 = m0 % G.T + wm * 128 + fr;
#pragma unroll
        for (int mt = 0; mt < 8; ++mt) {
            const int row = m0 + wm * 128 + mt * 16 + fr, t = tq0 + mt * 16;
            float ss = 0.f;
#pragma unroll
            for (int nt = 0; nt < 4; ++nt) ss += acc[mt][nt].x * acc[mt][nt].x + acc[mt][nt].y * acc[mt][nt].y + acc[mt][nt].z * acc[mt][nt].z + acc[mt][nt].w * acc[mt][nt].w;
            ss += sxor<16>(ss); ss += sxor<32>(ss);
            const float r = rsqrtf(ss * (1.f / 64.f) + RMS_EPS) * qs;
            const float* rp = ROPE + (size_t)t * 64 + fq * 4;
            bf16_t* dst = P + (size_t)row * NP + n0 + wn * 64 + fq * 4;
#pragma unroll
            for (int hh = 0; hh < 2; ++hh) {
                const f32x4 cs = *(const f32x4*)(rp + hh * 16), sn = *(const f32x4*)(rp + 32 + hh * 16);
                const f32x4 ya = acc[mt][hh] * *(const f32x4*)(gn + hh * 16) * r, yb = acc[mt][hh + 2] * *(const f32x4*)(gn + 32 + hh * 16) * r;
                const f32x4 oa = ya * cs - yb * sn, ob = yb * cs + ya * sn;
                *(u32x2*)(dst + hh * 16) = (u32x2){pk2(oa.x, oa.y), pk2(oa.z, oa.w)};
                *(u32x2*)(dst + 32 + hh * 16) = (u32x2){pk2(ob.x, ob.y), pk2(ob.z, ob.w)};
            }
        }
    }
    for (int pn = half ? 21 : 20; pn < (half ? 24 : 21); ++pn) {
        const int n0 = pn * 256;
        f32x4 acc[8][4];
#pragma unroll
        for (int i = 0; i < 8; ++i)
#pragma unroll
            for (int j = 0; j < 4; ++j) acc[i][j] = (f32x4){0.f, 0.f, 0.f, 0.f};
        gemm_kloop<false, 8>(acc, A + (size_t)m0 * D, D, Bt + (size_t)n0 * D, D, D, lds);
        const int b = m0 / G.T, t0 = m0 % G.T + wm * 128;
#pragma unroll
        for (int mt = 0; mt < 8; ++mt)
#pragma unroll
            for (int nt = 0; nt < 4; ++nt) {
                const int n = n0 - C_DV + wn * 64 + nt * 16 + fr, h = n >> 7, dv = n & 127;
                const int pos = t0 + (mt >> 1) * 32 + fq * 8 + (mt & 1) * 4;
                u32x2 w; w.x = pk2(acc[mt][nt].x, acc[mt][nt].y); w.y = pk2(acc[mt][nt].z, acc[mt][nt].w);
                *(u32x2*)(VT + ((size_t)((b * 8 + h) * 128 + dv)) * G.T + pos) = w;
            }
    }
}

__device__ __forceinline__ void phase_qkrope(const Params& p, int g, int tok0, int ntok) {
    const Grp G = get_group(p, g);
    const int tid_ = otid(), lane = tid_ & 63, wid = tid_ >> 6, grp = lane >> 2, sub = lane & 3;
    bf16_t* P = (bf16_t*)(p.ws + WS_PROJ); const float* ROPE = (const float*)(p.ws + WS_ROPE);
    for (int it = tok0 * 2 + wid; it < (tok0 + ntok) * 2; it += 8) {
        const int tok = it >> 1, isk = it & 1, t = tok % G.T;
        bf16_t* base = P + (size_t)tok * NP + (isk ? C_DK : C_DQ) + grp * 64 + sub * 8;
        const u32x4 a = *(const u32x4*)base, b = *(const u32x4*)(base + 32);
        float x1[8], x2[8];
        x1[0] = bflo(a.x); x1[1] = bfhi(a.x); x1[2] = bflo(a.y); x1[3] = bfhi(a.y); x1[4] = bflo(a.z); x1[5] = bfhi(a.z); x1[6] = bflo(a.w); x1[7] = bfhi(a.w);
        x2[0] = bflo(b.x); x2[1] = bfhi(b.x); x2[2] = bflo(b.y); x2[3] = bfhi(b.y); x2[4] = bflo(b.z); x2[5] = bfhi(b.z); x2[6] = bflo(b.w); x2[7] = bfhi(b.w);
        float ss = 0.f;
#pragma unroll
        for (int e = 0; e < 8; ++e) ss += x1[e] * x1[e] + x2[e] * x2[e];
        ss += sxor<1>(ss); ss += sxor<2>(ss);
        const float r = rsqrtf(ss * (1.f / 64.f) + RMS_EPS) * (isk ? 1.0f : 0.125f * LOG2E);
        const float* gn = p.in[isk ? I_DGK : I_DGQ] + sub * 8;
        const float* rp = ROPE + (size_t)t * 64 + sub * 8;
        float o1[8], o2[8];
#pragma unroll
        for (int e = 0; e < 8; ++e) {
            const float y1 = x1[e] * r * gn[e], y2 = x2[e] * r * gn[32 + e], c = rp[e], s = rp[32 + e];
            o1[e] = y1 * c - y2 * s; o2[e] = y2 * c + y1 * s;
        }
        u32x4 w1, w2;
        w1.x = pk2(o1[0], o1[1]); w1.y = pk2(o1[2], o1[3]); w1.z = pk2(o1[4], o1[5]); w1.w = pk2(o1[6], o1[7]);
        w2.x = pk2(o2[0], o2[1]); w2.y = pk2(o2[2], o2[3]); w2.z = pk2(o2[4], o2[5]); w2.w = pk2(o2[6], o2[7]);
        *(u32x4*)base = w1; *(u32x4*)(base + 32) = w2;
    }
}

__device__ __forceinline__ void diff_attn_item(const Params& p, const Grp& G, int item, char* lds, float lam, float shift) {
    const int tid = otid(), lane = tid & 63, wid = tid >> 6, fr = lane & 15, fq = lane >> 4;
    const int c = wid & 1, sub = wid >> 1;
    const int T = G.T, nqb = T / 128;
    const int qb = item % nqb, bh = item / nqb, h = bh & 7, b = bh >> 3;
    bf16_t* P = (bf16_t*)(p.ws + WS_PROJ) + (size_t)b * T * NP;
    const bf16_t* Kg = P + C_DK + h * 128;
    const bf16_t* VTg = (const bf16_t*)(p.ws + WS_VT) + (size_t)bh * 128 * T;
    const int q0 = qb * 128 + sub * 32;
    bf16x8 qf[2][2];
#pragma unroll
    for (int nt = 0; nt < 2; ++nt)
#pragma unroll
        for (int ks = 0; ks < 2; ++ks) qf[nt][ks] = *(const bf16x8*)(P + (size_t)(q0 + nt * 16 + fr) * NP + C_DQ + h * 128 + c * 64 + ks * 32 + fq * 8);
    f32x4 o[8][2];
#pragma unroll
    for (int i = 0; i < 8; ++i) { o[i][0] = (f32x4){0.f, 0.f, 0.f, 0.f}; o[i][1] = (f32x4){0.f, 0.f, 0.f, 0.f}; }
    float l[2] = {0.f, 0.f};
    constexpr int STG = 36864, VOFF = 18432;
    u32x4 rk[2], rv[2];
    const int krow = tid >> 4, kch = tid & 15;
    const int vrow = tid >> 3, vch = tid & 7;
#define AGLOAD(kt) do { const int key0_ = (kt) * 64; \
        _Pragma("unroll") for (int i = 0; i < 2; ++i) rk[i] = *(const u32x4*)(Kg + (size_t)(key0_ + krow + i * 32) * NP + kch * 8); \
        _Pragma("unroll") for (int i = 0; i < 2; ++i) rv[i] = *(const u32x4*)(VTg + (size_t)(vrow + i * 64) * T + key0_ + vch * 8); } while (0)
#define ASWRITE(buf) do { char* b_ = lds + (buf) * STG; \
        _Pragma("unroll") for (int i = 0; i < 2; ++i) *(u32x4*)(b_ + ((kch >> 3) * 64 + krow + i * 32) * 144 + (kch & 7) * 16) = rk[i]; \
        _Pragma("unroll") for (int i = 0; i < 2; ++i) *(u32x4*)(b_ + VOFF + (vrow + i * 64) * 144 + vch * 16) = rv[i]; } while (0)
    const int nkt = T / 64;
#define EXPQ(SRC, NT, DSTP) do { const f32x4 a_ = SRC[0][NT], b_ = SRC[1][NT]; \
        const float p0 = fexp2(a_.x), p1 = fexp2(a_.y), p2 = fexp2(a_.z), p3 = fexp2(a_.w); \
        const float p4 = fexp2(b_.x), p5 = fexp2(b_.y), p6 = fexp2(b_.z), p7 = fexp2(b_.w); \
        l[NT] += ((p0 + p1) + (p2 + p3)) + ((p4 + p5) + (p6 + p7)); \
        u32x4 w_; w_.x = pk2(p0, p1); w_.y = pk2(p2, p3); w_.z = pk2(p4, p5); w_.w = pk2(p6, p7); \
        DSTP[NT] = __builtin_bit_cast(bf16x8, w_); } while (0)
#define SMMA1(DST, I, MT, KBASE) do { \
        const bf16x8 k0_ = *(const bf16x8*)((KBASE) + (c * 64 + (MT) * 16 + fr) * 144 + fq * 16); \
        const bf16x8 k1_ = *(const bf16x8*)((KBASE) + (c * 64 + (MT) * 16 + fr) * 144 + 64 + fq * 16); \
        DST[I][0] = mfma16(k0_, qf[0][0], (f32x4){0.f, 0.f, 0.f, 0.f}); DST[I][1] = mfma16(k0_, qf[1][0], (f32x4){0.f, 0.f, 0.f, 0.f}); \
        DST[I][0] = mfma16(k1_, qf[0][1], DST[I][0]); DST[I][1] = mfma16(k1_, qf[1][1], DST[I][1]); } while (0)
#define PVMMA(DVT, KK, PF, VBASE) do { \
        const bf16x8 vf_ = *(const bf16x8*)((VBASE) + VOFF + ((DVT) * 16 + fr) * 144 + (KK) * 64 + fq * 16); \
        o[DVT][0] = mfma16(vf_, PF[0], o[DVT][0]); o[DVT][1] = mfma16(vf_, PF[1], o[DVT][1]); } while (0)
#define PV8(KK, PF, VBASE) do { PVMMA(0, KK, PF, VBASE); PVMMA(1, KK, PF, VBASE); PVMMA(2, KK, PF, VBASE); PVMMA(3, KK, PF, VBASE); \
        PVMMA(4, KK, PF, VBASE); PVMMA(5, KK, PF, VBASE); PVMMA(6, KK, PF, VBASE); PVMMA(7, KK, PF, VBASE); } while (0)
    f32x4 slo[2][2], shi[2][2];
    bf16x8 pflo[2], pfhi[2];
    AGLOAD(0); ASWRITE(0); AGLOAD(1); ASWRITE(1); __syncthreads();
    SMMA1(slo, 0, 0, lds); SMMA1(slo, 1, 1, lds);
    for (int kt = 0; kt < nkt; ++kt) {
        { const int ktl = kt + 2 < nkt ? kt + 2 : nkt - 1; AGLOAD(ktl); }
        const char* cur = lds + (kt & 3) * STG; const char* nxt = lds + ((kt + 1) & 3) * STG; const char* prv = lds + ((kt + 3) & 3) * STG;
        SMMA1(shi, 0, 2, cur); SMMA1(shi, 1, 3, cur);
        if (kt > 0) PV8(1, pfhi, prv);
        EXPQ(slo, 0, pflo); EXPQ(slo, 1, pflo);
        __builtin_amdgcn_sched_barrier(0);
        SMMA1(slo, 0, 0, nxt); SMMA1(slo, 1, 1, nxt);
        PV8(0, pflo, cur);
        EXPQ(shi, 0, pfhi); EXPQ(shi, 1, pfhi);
        __builtin_amdgcn_sched_barrier(0);
        ASWRITE((kt + 2) & 3);
        __syncthreads();
    }
    { const char* prv = lds + ((nkt - 1) & 3) * STG; PV8(1, pfhi, prv); }
    __syncthreads();
#undef EXPQ
#undef SMMA1
#undef PVMMA
#undef PV8
#undef AGLOAD
#undef ASWRITE
    float inv[2];
#pragma unroll
    for (int nt = 0; nt < 2; ++nt) { float v = l[nt]; v += sxor<16>(v); v += sxor<32>(v); inv[nt] = 1.0f / v; }
    float* xch = (float*)lds + sub * 4096;
    if (c == 1) {
#pragma unroll
        for (int dvt = 0; dvt < 8; ++dvt)
#pragma unroll
            for (int nt = 0; nt < 2; ++nt) {
                xch[(dvt * 16 + fq * 4 + 0) * 32 + nt * 16 + fr] = o[dvt][nt].x * inv[nt];
                xch[(dvt * 16 + fq * 4 + 1) * 32 + nt * 16 + fr] = o[dvt][nt].y * inv[nt];
                xch[(dvt * 16 + fq * 4 + 2) * 32 + nt * 16 + fr] = o[dvt][nt].z * inv[nt];
                xch[(dvt * 16 + fq * 4 + 3) * 32 + nt * 16 + fr] = o[dvt][nt].w * inv[nt];
            }
    }
    __syncthreads();
    if (c == 0) {
        float ss[2] = {0.f, 0.f};
#pragma unroll
        for (int dvt = 0; dvt < 8; ++dvt)
#pragma unroll
            for (int nt = 0; nt < 2; ++nt) {
                f32x4 v = o[dvt][nt] * inv[nt];
                v.x -= lam * xch[(dvt * 16 + fq * 4 + 0) * 32 + nt * 16 + fr];
                v.y -= lam * xch[(dvt * 16 + fq * 4 + 1) * 32 + nt * 16 + fr];
                v.z -= lam * xch[(dvt * 16 + fq * 4 + 2) * 32 + nt * 16 + fr];
                v.w -= lam * xch[(dvt * 16 + fq * 4 + 3) * 32 + nt * 16 + fr];
                o[dvt][nt] = v; ss[nt] += v.x * v.x + v.y * v.y + v.z * v.z + v.w * v.w;
            }
#pragma unroll
        for (int nt = 0; nt < 2; ++nt) {
            float v = ss[nt]; v += sxor<16>(v); v += sxor<32>(v);
            const float r = rsqrtf(v * (1.f / 128.f) + RMS_EPS) * 0.8f;
#pragma unroll
            for (int dvt = 0; dvt < 8; ++dvt) {
                const f32x4 gs = *(const f32x4*)(p.in[I_DGSUB] + dvt * 16 + fq * 4);
                const f32x4 v4 = o[dvt][nt];
                u32x2 w; w.x = pk2(v4.x * r * gs.x, v4.y * r * gs.y); w.y = pk2(v4.z * r * gs.z, v4.w * r * gs.w);
                *(u32x2*)(P + (size_t)(q0 + nt * 16 + fr) * NP + C_DQ + h * 128 + dvt * 16 + fq * 4) = w;
            }
        }
    }
    __syncthreads();
}

__device__ __forceinline__ void mem_attn_item(const Params& p, const Grp& G, int item, char* lds, float shift) {
    const int tid = otid(), lane = tid & 63, wid = tid >> 6, fr = lane & 15, fq = lane >> 4;
    const int T = G.T, nqb = T / 128;
    const int qb = item % nqb, bh = item / nqb, h = bh & 3, b = bh >> 2;
    bf16_t* P = (bf16_t*)(p.ws + WS_PROJ) + (size_t)b * T * NP;
    const bf16_t* MK = (const bf16_t*)(p.ws + WS_MEMK) + (size_t)((G.mb0 + b) * 4 + h) * 256 * 256;
    const bf16_t* MV = (const bf16_t*)(p.ws + WS_MEMV) + (size_t)((G.mb0 + b) * 4 + h) * 256 * 256;
    const int row = qb * 128 + wid * 16 + fr;
    bf16_t* qp = P + (size_t)row * NP + C_MQ + h * 256;
    bf16x8 qf[8];
    {
        float ss = 0.f; u32x4 raw[8];
#pragma unroll
        for (int ks = 0; ks < 8; ++ks) { raw[ks] = *(const u32x4*)(qp + ks * 32 + fq * 8);
            const float a0 = bflo(raw[ks].x), a1 = bfhi(raw[ks].x), a2 = bflo(raw[ks].y), a3 = bfhi(raw[ks].y), a4 = bflo(raw[ks].z), a5 = bfhi(raw[ks].z), a6 = bflo(raw[ks].w), a7 = bfhi(raw[ks].w);
            ss += a0 * a0 + a1 * a1 + a2 * a2 + a3 * a3 + a4 * a4 + a5 * a5 + a6 * a6 + a7 * a7; }
        ss += sxor<16>(ss); ss += sxor<32>(ss);
        const float r = rsqrtf(ss * (1.f / 256.f) + RMS_EPS) * (0.0625f * LOG2E);
#pragma unroll
        for (int ks = 0; ks < 8; ++ks) {
            const f32x4 g0 = *(const f32x4*)(p.in[I_MGQ] + ks * 32 + fq * 8), g1 = *(const f32x4*)(p.in[I_MGQ] + ks * 32 + fq * 8 + 4);
            u32x4 w;
            w.x = pk2(bflo(raw[ks].x) * r * g0.x, bfhi(raw[ks].x) * r * g0.y); w.y = pk2(bflo(raw[ks].y) * r * g0.z, bfhi(raw[ks].y) * r * g0.w);
            w.z = pk2(bflo(raw[ks].z) * r * g1.x, bfhi(raw[ks].z) * r * g1.y); w.w = pk2(bflo(raw[ks].w) * r * g1.z, bfhi(raw[ks].w) * r * g1.w);
            qf[ks] = __builtin_bit_cast(bf16x8, w);
        }
    }
    f32x4 o[16];
#pragma unroll
    for (int i = 0; i < 16; ++i) o[i] = (f32x4){0.f, 0.f, 0.f, 0.f};
    float l = 0.f;
    constexpr int KROW = 528, VOFF = 64 * 528;
    for (int kt = 0; kt < 4; ++kt) {
#pragma unroll
        for (int i = 0; i < 4; ++i) {
            const int idx = tid + i * 512, r = idx >> 5, ch = idx & 31;
            *(u32x4*)(lds + r * KROW + ch * 16) = *(const u32x4*)(MK + (size_t)(kt * 64 + r) * 256 + ch * 8);
            const int vr = idx >> 3, vc = idx & 7;
            *(u32x4*)(lds + VOFF + vr * 144 + vc * 16) = *(const u32x4*)(MV + (size_t)vr * 256 + kt * 64 + vc * 8);
        }
        __syncthreads();
        f32x4 s[4];
#pragma unroll
        for (int mt = 0; mt < 4; ++mt) s[mt] = (f32x4){-shift, -shift, -shift, -shift};
#pragma unroll
        for (int ks = 0; ks < 8; ++ks)
#pragma unroll
            for (int mt = 0; mt < 4; ++mt) {
                const bf16x8 kf = *(const bf16x8*)(lds + (mt * 16 + fr) * KROW + ks * 64 + fq * 16);
                s[mt] = mfma16(kf, qf[ks], s[mt]);
            }
        bf16x8 pf[2];
#pragma unroll
        for (int kk = 0; kk < 2; ++kk) {
            const f32x4 a = s[2 * kk], bb = s[2 * kk + 1];
            const float p0 = fexp2(a.x), p1 = fexp2(a.y), p2 = fexp2(a.z), p3 = fexp2(a.w);
            const float p4 = fexp2(bb.x), p5 = fexp2(bb.y), p6 = fexp2(bb.z), p7 = fexp2(bb.w);
            l += ((p0 + p1) + (p2 + p3)) + ((p4 + p5) + (p6 + p7));
            u32x4 w; w.x = pk2(p0, p1); w.y = pk2(p2, p3); w.z = pk2(p4, p5); w.w = pk2(p6, p7);
            pf[kk] = __builtin_bit_cast(bf16x8, w);
        }
#pragma unroll
        for (int kk = 0; kk < 2; ++kk)
#pragma unroll
            for (int dvt = 0; dvt < 16; ++dvt) {
                const bf16x8 vf = *(const bf16x8*)(lds + VOFF + (dvt * 16 + fr) * 144 + kk * 64 + fq * 16);
                o[dvt] = mfma16(vf, pf[kk], o[dvt]);
            }
        __syncthreads();
    }
    l += sxor<16>(l); l += sxor<32>(l);
    const float inv = 1.0f / l;
#pragma unroll
    for (int dvt = 0; dvt < 16; ++dvt) {
        u32x2 w; w.x = pk2(o[dvt].x * inv, o[dvt].y * inv); w.y = pk2(o[dvt].z * inv, o[dvt].w * inv);
        *(u32x2*)(qp + dvt * 16 + fq * 4) = w;
    }
}

constexpr int L_QE = 0, L_KE = 17408, L_KST = 34816, L_VTL = 53248, L_ATT = 71680, L_SB = 80896, L_LRF = 115712, L_TOT = 119808, L_GDEC = 121856;
__device__ __forceinline__ void gla_item(const Params& p, const Grp& G, int item, char* lds) {
    const int tid = otid(), lane = tid & 63, wid = tid >> 6, fr = lane & 15, fq = lane >> 4;
    const int slice = item & 1, dir = (item >> 1) & 1, h = (item >> 2) & 3, b = item >> 4;
    const int T = G.T, N = T / 64;
    const bf16_t* P = (const bf16_t*)(p.ws + WS_PROJ) + (size_t)b * T * NP;
    bf16_t* OUT = dir ? (bf16_t*)(p.ws + WS_PROJ) + (size_t)b * T * NP + C_DV + h * 256 + slice * 128
                      : (bf16_t*)(p.ws + WS_HB) + (size_t)b * T * D + h * 256 + slice * 128;
    const int ldo = dir ? NP : D;
    const int d = tid & 127, rg = tid >> 7;
    float wdec[16];
    {
        const float* wd = p.in[dir ? I_WDB : I_WDF];
#pragma unroll
        for (int r = 0; r < 16; ++r) wdec[r] = wd[r * 512 + h * 128 + d];
    }
    const float bdec = p.in[dir ? I_BDB : I_BDF][h * 128 + d];
    { unsigned z = 0u; asm volatile("" : "+v"(z)); for (int i = tid; i < 34816 / 16; i += NTHR) *(u32x4*)(lds + L_SB + i * 16) = (u32x4){z, z, z, z}; }
    f32x4 S[8];
#pragma unroll
    for (int i = 0; i < 8; ++i) S[i] = (f32x4){0.f, 0.f, 0.f, 0.f};
    u32x4 rq[2], rk[2], rv[2], rl;
    const int lrow = tid >> 4, lch = tid & 15;
#define GGLOAD(n) do { const int cb_ = (dir ? (N - 1 - (n)) : (n)) * 64; \
        _Pragma("unroll") for (int i = 0; i < 2; ++i) { const int li_ = lrow + i * 32, tk_ = cb_ + (dir ? 63 - li_ : li_); const bf16_t* rp_ = P + (size_t)tk_ * NP; \
            rq[i] = *(const u32x4*)(rp_ + C_GQ + h * 128 + lch * 8); rk[i] = *(const u32x4*)(rp_ + C_GK + h * 128 + lch * 8); rv[i] = *(const u32x4*)(rp_ + C_GV + h * 256 + slice * 128 + lch * 8); } \
        if (tid < 128) { const int li_ = tid >> 1, tk_ = cb_ + (dir ? 63 - li_ : li_); rl = *(const u32x4*)(P + (size_t)tk_ * NP + C_LR + dir * 16 + (tid & 1) * 8); } } while (0)
    GGLOAD(0);
    for (int n = 0; n < N; ++n) {
#pragma unroll
        for (int i = 0; i < 2; ++i) {
            const int li = lrow + i * 32;
            *(u32x4*)(lds + L_QE + li * 272 + lch * 16) = rq[i];
            *(u32x4*)(lds + L_KE + li * 272 + lch * 16) = rk[i];
            bf16_t* vt = (bf16_t*)(lds + L_VTL) + (lch * 8) * 72 + li;
            vt[0 * 72] = (bf16_t)(rv[i].x & 0xffff); vt[1 * 72] = (bf16_t)(rv[i].x >> 16); vt[2 * 72] = (bf16_t)(rv[i].y & 0xffff); vt[3 * 72] = (bf16_t)(rv[i].y >> 16);
            vt[4 * 72] = (bf16_t)(rv[i].z & 0xffff); vt[5 * 72] = (bf16_t)(rv[i].z >> 16); vt[6 * 72] = (bf16_t)(rv[i].w & 0xffff); vt[7 * 72] = (bf16_t)(rv[i].w >> 16);
        }
        if (tid < 128) {
            float* lf = (float*)(lds + L_LRF) + (tid >> 1) * 16 + (tid & 1) * 8;
            *(f32x4*)lf = (f32x4){bflo(rl.x), bfhi(rl.x), bflo(rl.y), bfhi(rl.y)};
            *(f32x4*)(lf + 4) = (f32x4){bflo(rl.z), bfhi(rl.z), bflo(rl.w), bfhi(rl.w)};
        }
        if (n + 1 < N) GGLOAD(n + 1);
        __syncthreads();
        float cs[16]; float run = 0.f;
#pragma unroll
        for (int ii = 0; ii < 16; ++ii) {
            const float* lf = (const float*)(lds + L_LRF) + (rg * 16 + ii) * 16;
            const f32x4 a0 = *(const f32x4*)lf, a1 = *(const f32x4*)(lf + 4), a2 = *(const f32x4*)(lf + 8), a3 = *(const f32x4*)(lf + 12);
            float x = bdec;
            x += a0.x * wdec[0] + a0.y * wdec[1] + a0.z * wdec[2] + a0.w * wdec[3];
            x += a1.x * wdec[4] + a1.y * wdec[5] + a1.z * wdec[6] + a1.w * wdec[7];
            x += a2.x * wdec[8] + a2.y * wdec[9] + a2.z * wdec[10] + a2.w * wdec[11];
            x += a3.x * wdec[12] + a3.y * wdec[13] + a3.z * wdec[14] + a3.w * wdec[15];
            const float ls = fminf(x, 0.f) - __logf(1.0f + __expf(-fabsf(x)));
            run += ls * 0.0625f; cs[ii] = run;
        }
        ((float*)(lds + L_TOT))[rg * 128 + d] = run;
        __syncthreads();
        float off = 0.f, blast = 0.f;
#pragma unroll
        for (int r = 0; r < 4; ++r) { const float tv = ((const float*)(lds + L_TOT))[r * 128 + d]; blast += tv; if (r < rg) off += tv; }
        {
            bf16_t* qe = (bf16_t*)(lds + L_QE) + d; bf16_t* ke = (bf16_t*)(lds + L_KE) + d;
            unsigned ksp[8];
#pragma unroll
            for (int ii = 0; ii < 16; ii += 2) {
                const int i0 = rg * 16 + ii;
                const float b0 = off + cs[ii], b1 = off + cs[ii + 1];
                const float q0v = bf2f(qe[i0 * 136]), q1v = bf2f(qe[(i0 + 1) * 136]), k0v = bf2f(ke[i0 * 136]), k1v = bf2f(ke[(i0 + 1) * 136]);
                qe[i0 * 136] = f2bf(q0v * __expf(b0)); qe[(i0 + 1) * 136] = f2bf(q1v * __expf(b1));
                ke[i0 * 136] = f2bf(k0v * __expf(-b0)); ke[(i0 + 1) * 136] = f2bf(k1v * __expf(-b1));
                ksp[ii >> 1] = pk2(k0v * __expf(blast - b0), k1v * __expf(blast - b1));
            }
            char* kst = lds + L_KST + d * 144 + rg * 32;
            *(u32x4*)kst = (u32x4){ksp[0], ksp[1], ksp[2], ksp[3]};
            *(u32x4*)(kst + 16) = (u32x4){ksp[4], ksp[5], ksp[6], ksp[7]};
            if (rg == 0) ((float*)(lds + L_GDEC))[d] = __expf(blast);
        }
        __syncthreads();
        {
            const int ct = wid & 3;
            f32x4 a[2] = {(f32x4){0.f, 0.f, 0.f, 0.f}, (f32x4){0.f, 0.f, 0.f, 0.f}};
#pragma unroll
            for (int ks = 0; ks < 4; ++ks) {
                const bf16x8 qv = *(const bf16x8*)(lds + L_QE + (ct * 16 + fr) * 272 + ks * 64 + fq * 16);
#pragma unroll
                for (int j = 0; j < 2; ++j) {
                    const int st = (wid >> 2) * 2 + j;
                    const bf16x8 kv = *(const bf16x8*)(lds + L_KE + (st * 16 + fr) * 272 + ks * 64 + fq * 16);
                    a[j] = mfma16(kv, qv, a[j]);
                }
            }
#pragma unroll
            for (int j = 0; j < 2; ++j) {
                const int st = (wid >> 2) * 2 + j, cc = ct * 16 + fr, s0 = st * 16 + fq * 4;
                const float v0 = (s0 + 0 <= cc) ? a[j].x : 0.f, v1 = (s0 + 1 <= cc) ? a[j].y : 0.f, v2 = (s0 + 2 <= cc) ? a[j].z : 0.f, v3 = (s0 + 3 <= cc) ? a[j].w : 0.f;
                *(u32x2*)(lds + L_ATT + cc * 144 + s0 * 2) = (u32x2){pk2(v0, v1), pk2(v2, v3)};
            }
        }
        __syncthreads();
        {
            f32x4 oc[4] = {(f32x4){0.f, 0.f, 0.f, 0.f}, (f32x4){0.f, 0.f, 0.f, 0.f}, (f32x4){0.f, 0.f, 0.f, 0.f}, (f32x4){0.f, 0.f, 0.f, 0.f}};
#pragma unroll
            for (int ks = 0; ks < 2; ++ks) {
                const bf16x8 af = *(const bf16x8*)(lds + L_VTL + (wid * 16 + fr) * 144 + ks * 64 + fq * 16);
#pragma unroll
                for (int ct = 0; ct < 4; ++ct) { const bf16x8 bfv = *(const bf16x8*)(lds + L_ATT + (ct * 16 + fr) * 144 + ks * 64 + fq * 16); oc[ct] = mfma16(af, bfv, oc[ct]); }
            }
#pragma unroll
            for (int ks = 0; ks < 4; ++ks) {
                const bf16x8 af = *(const bf16x8*)(lds + L_SB + (wid * 16 + fr) * 272 + ks * 64 + fq * 16);
#pragma unroll
                for (int ct = 0; ct < 4; ++ct) { const bf16x8 bfv = *(const bf16x8*)(lds + L_QE + (ct * 16 + fr) * 272 + ks * 64 + fq * 16); oc[ct] = mfma16(af, bfv, oc[ct]); }
            }
            const int cb = (dir ? (N - 1 - n) : n) * 64;
#pragma unroll
            for (int ct = 0; ct < 4; ++ct) {
                const int cl = ct * 16 + fr, tk = cb + (dir ? 63 - cl : cl);
                *(u32x2*)(OUT + (size_t)tk * ldo + wid * 16 + fq * 4) = (u32x2){pk2(oc[ct].x, oc[ct].y), pk2(oc[ct].z, oc[ct].w)};
            }
        }
        __syncthreads();
        {
            const f32x4 gd = *(const f32x4*)((const float*)(lds + L_GDEC) + wid * 16 + fq * 4);
#pragma unroll
            for (int et = 0; et < 8; ++et) S[et] = S[et] * gd;
#pragma unroll
            for (int ks = 0; ks < 2; ++ks) {
                const bf16x8 af = *(const bf16x8*)(lds + L_KST + (wid * 16 + fr) * 144 + ks * 64 + fq * 16);
#pragma unroll
                for (int et = 0; et < 8; ++et) { const bf16x8 bfv = *(const bf16x8*)(lds + L_VTL + (et * 16 + fr) * 144 + ks * 64 + fq * 16); S[et] = mfma16(af, bfv, S[et]); }
            }
#pragma unroll
            for (int et = 0; et < 8; ++et)
                *(u32x2*)(lds + L_SB + (et * 16 + fr) * 272 + (wid * 16 + fq * 4) * 2) = (u32x2){pk2(S[et].x, S[et].y), pk2(S[et].z, S[et].w)};
        }
        __syncthreads();
    }
#undef GGLOAD
}

__device__ __forceinline__ void phase_mixer(const Params& p, int g, char* lds, int* s_item) {
    const Grp G = get_group(p, g);
    const int nGLA = G.B * 16, nATT = G.B * 8 * (G.T / 128), nMEM = G.B * 4 * (G.T / 128);
    unsigned* ctr = (unsigned*)(p.ws + WS_CTRL) + g * 4;
    for (;;) {
        if (threadIdx.x == 0) *s_item = (int)atomicAdd(ctr + 0, 1u);
        __syncthreads();
        const int it = *s_item;
        __syncthreads();
        if (it >= nGLA) break;
        gla_item(p, G, it, lds);
    }
    {
        float d1 = 0.f, d2 = 0.f;
        for (int i = 0; i < 64; ++i) { d1 += p.in[I_LQ1][i] * p.in[I_LK1][i]; d2 += p.in[I_LQ2][i] * p.in[I_LK2][i]; }
        const float lam = expf(d1) - expf(d2) + 0.2f;
        for (;;) {
            if (threadIdx.x == 0) *s_item = (int)atomicAdd(ctr + 1, 1u);
            __syncthreads();
            const int it = *s_item;
            __syncthreads();
            if (it >= nATT) break;
            diff_attn_item(p, G, it, lds, lam, 0.f);
        }
    }
    for (;;) {
        if (threadIdx.x == 0) *s_item = (int)atomicAdd(ctr + 2, 1u);
        __syncthreads();
        const int it = *s_item;
        __syncthreads();
        if (it >= nMEM) break;
        mem_attn_item(p, G, it, lds, 0.f);
    }
}

__device__ __forceinline__ void phase_glafin(const Params& p, int g, int tok0, int ntok) {
    const int tid_ = otid(), lane = tid_ & 63, wid = tid_ >> 6;
    bf16_t* P = (bf16_t*)(p.ws + WS_PROJ); const bf16_t* F = (const bf16_t*)(p.ws + WS_HB);
    for (int it = tok0 * 4 + wid; it < (tok0 + ntok) * 4; it += 8) {
        const int tok = it >> 2, h = it & 3;
        bf16_t* row = P + (size_t)tok * NP;
        const unsigned qq = *(const unsigned*)(row + C_GQ + h * 128 + lane * 2), kk = *(const unsigned*)(row + C_GK + h * 128 + lane * 2);
        const float qk = wave_sum(bflo(qq) * bflo(kk) + bfhi(qq) * bfhi(kk));
        const u32x2 f = *(const u32x2*)(F + (size_t)tok * D + h * 256 + lane * 4), bk = *(const u32x2*)(row + C_DV + h * 256 + lane * 4);
        const u32x2 v = *(const u32x2*)(row + C_GV + h * 256 + lane * 4), gt = *(const u32x2*)(row + C_GG + h * 256 + lane * 4);
        float o0 = bflo(f.x) + bflo(bk.x) - qk * bflo(v.x), o1 = bfhi(f.x) + bfhi(bk.x) - qk * bfhi(v.x);
        float o2 = bflo(f.y) + bflo(bk.y) - qk * bflo(v.y), o3 = bfhi(f.y) + bfhi(bk.y) - qk * bfhi(v.y);
        const float r = rsqrtf(wave_sum(o0 * o0 + o1 * o1 + o2 * o2 + o3 * o3) * (1.f / 256.f) + RMS_EPS);
        const f32x4 go = *(const f32x4*)(p.in[I_GOUT] + lane * 4);
        const float g0 = bflo(gt.x), g1 = bfhi(gt.x), g2 = bflo(gt.y), g3 = bfhi(gt.y);
        o0 *= r * go.x * g0 / (1.f + __expf(-g0)); o1 *= r * go.y * g1 / (1.f + __expf(-g1));
        o2 *= r * go.z * g2 / (1.f + __expf(-g2)); o3 *= r * go.w * g3 / (1.f + __expf(-g3));
        *(u32x2*)(row + C_GG + h * 256 + lane * 4) = (u32x2){pk2(o0, o1), pk2(o2, o3)};
    }
}

__device__ __forceinline__ void phase_merge(const Params& p, int g, char* lds, int u) {
    const int tid_ = otid(), lane = tid_ & 63, wid = tid_ >> 6, wm = wid >> 2, wn = wid & 3, fr = lane & 15, fq = lane >> 4;
    const bf16_t* P = (const bf16_t*)(p.ws + WS_PROJ); bf16_t* M = (bf16_t*)(p.ws + WS_VT);
    for (int pn = 0; pn < 4; ++pn) {
        const int m0 = u * 128, n0 = pn * 256;
        f32x4 macc[4][4];
#pragma unroll
        for (int i = 0; i < 4; ++i)
#pragma unroll
            for (int j = 0; j < 4; ++j) macc[i][j] = (f32x4){0.f, 0.f, 0.f, 0.f};
        for (int br = 0; br < 3; ++br) {
            f32x4 acc[4][4];
#pragma unroll
            for (int i = 0; i < 4; ++i)
#pragma unroll
                for (int j = 0; j < 4; ++j) acc[i][j] = (f32x4){0.f, 0.f, 0.f, 0.f};
            const int acol = br == 0 ? C_GG : (br == 1 ? C_DQ : C_MQ);
            gemm_kloop<true, 4>(acc, P + (size_t)m0 * NP + acol, NP, (const bf16_t*)(p.ws + WS_WOT) + (size_t)br * D * D + (size_t)n0 * D, D, D, lds);
#pragma unroll
            for (int mt = 0; mt < 4; ++mt)
#pragma unroll
                for (int nt = 0; nt < 4; ++nt) {
                    const int row = m0 + wm * 64 + mt * 16 + fr, col = n0 + wn * 64 + nt * 16 + fq * 4;
                    const u32x2 gt = *(const u32x2*)(P + (size_t)row * NP + C_BG + br * 1024 + col);
                    f32x4 sg; sg.x = 1.f / (1.f + __expf(-bflo(gt.x))); sg.y = 1.f / (1.f + __expf(-bfhi(gt.x))); sg.z = 1.f / (1.f + __expf(-bflo(gt.y))); sg.w = 1.f / (1.f + __expf(-bfhi(gt.y)));
                    macc[mt][nt] += sg * acc[mt][nt];
                }
        }
#pragma unroll
        for (int mt = 0; mt < 4; ++mt)
#pragma unroll
            for (int nt = 0; nt < 4; ++nt) {
                const int row = m0 + wm * 64 + mt * 16 + fr, col = n0 + wn * 64 + nt * 16 + fq * 4;
                *(u32x2*)(M + (size_t)row * D + col) = (u32x2){pk2(macc[mt][nt].x, macc[mt][nt].y), pk2(macc[mt][nt].z, macc[mt][nt].w)};
            }
    }
}

__device__ __forceinline__ void phase_outproj(const Params& p, int g, char* lds, int u) {
    const Grp G = get_group(p, g);
    const int tid_ = otid(), lane = tid_ & 63, wid = tid_ >> 6, wm = wid >> 2, wn = wid & 3, fr = lane & 15, fq = lane >> 4;
    const bf16_t* M = (const bf16_t*)(p.ws + WS_VT); const bf16_t* W = (const bf16_t*)(p.ws + WS_WOT) + (size_t)3 * D * D;
    for (int pn = 0; pn < 4; ++pn) {
        const int m0 = u * 128, n0 = pn * 256;
        f32x4 acc[4][4];
#pragma unroll
        for (int i = 0; i < 4; ++i)
#pragma unroll
            for (int j = 0; j < 4; ++j) acc[i][j] = (f32x4){0.f, 0.f, 0.f, 0.f};
        gemm_kloop<true, 4>(acc, M + (size_t)m0 * D, D, W + (size_t)n0 * D, D, D, lds);
#pragma unroll
        for (int mt = 0; mt < 4; ++mt)
#pragma unroll
            for (int nt = 0; nt < 4; ++nt) {
                const int row = m0 + wm * 64 + mt * 16 + fr, col = n0 + wn * 64 + nt * 16 + fq * 4;
                const f32x4 xv = *(const f32x4*)(G.x + (size_t)row * D + col);
                *(f32x4*)(G.out + (size_t)row * D + col) = xv + acc[mt][nt];
            }
    }
}

__device__ __forceinline__ void phase_peerq(const Params& p, int g, char* lds, int u) {
    const int tid_ = otid(), lane = tid_ & 63, wid = tid_ >> 6, wm = wid >> 2, wn = wid & 3, fr = lane & 15, fq = lane >> 4;
    const bf16_t* A = (const bf16_t*)(p.ws + WS_HB); const bf16_t* W = (const bf16_t*)(p.ws + WS_WQT); bf16_t* P = (bf16_t*)(p.ws + WS_PROJ);
    for (int pn = 0; pn < 8; ++pn) {
        const int m0 = u * 128, n0 = pn * 256;
        f32x4 acc[4][4];
#pragma unroll
        for (int i = 0; i < 4; ++i)
#pragma unroll
            for (int j = 0; j < 4; ++j) acc[i][j] = (f32x4){0.f, 0.f, 0.f, 0.f};
        gemm_kloop<true, 4>(acc, A + (size_t)m0 * D, D, W + (size_t)n0 * D, D, D, lds);
#pragma unroll
        for (int mt = 0; mt < 4; ++mt)
#pragma unroll
            for (int nt = 0; nt < 4; ++nt) {
                const int row = m0 + wm * 64 + mt * 16 + fr, col = n0 + wn * 64 + nt * 16 + fq * 4;
                *(u32x2*)(P + (size_t)row * NP + col) = (u32x2){pk2(acc[mt][nt].x, acc[mt][nt].y), pk2(acc[mt][nt].z, acc[mt][nt].w)};
            }
    }
}

__device__ __forceinline__ unsigned f2ord(float f) { const unsigned u = __float_as_uint(f); return (u & 0x80000000u) ? ~u : (u | 0x80000000u); }
__device__ __forceinline__ float ord2f(unsigned k) { const unsigned u = (k & 0x80000000u) ? (k & 0x7fffffffu) : ~k; return __uint_as_float(u); }
__device__ __forceinline__ unsigned gmax16(unsigned v) {
    unsigned t;
    t = sxoru<1>(v); v = v > t ? v : t; t = sxoru<2>(v); v = v > t ? v : t; t = sxoru<4>(v); v = v > t ? v : t; t = sxoru<8>(v); v = v > t ? v : t;
    return v;
}
__device__ __forceinline__ float gsum16(float v) { v += sxor<1>(v); v += sxor<2>(v); v += sxor<4>(v); v += sxor<8>(v); return v; }
__device__ __forceinline__ float gelu_exact(float a) { return 0.5f * a * (1.0f + erff(a * 0.70710678118654752f)); }

__device__ __forceinline__ void phase_peer(const Params& p, int g, char* lds, int tile0, int ntile) {
    const Grp G = get_group(p, g);
    const int tid = otid(), lane = tid & 63, wid = tid >> 6, fr = lane & 15, fq = lane >> 4;
    const bf16_t* P = (const bf16_t*)(p.ws + WS_PROJ); const bf16_t* HB = (const bf16_t*)(p.ws + WS_HB);
    const bf16_t* K12 = (const bf16_t*)(p.ws + WS_K12);
    float* SC = (float*)lds;
    int* EIDX = (int*)(lds + 65536);
    float* GATE = (float*)(lds + 65536 + 4096);
    char* KL = lds + 73728;
    for (int i = tid; i < 2 * 128 * 16; i += NTHR) {
        const int r = i >> 4, ch = i & 15;
        *(u32x4*)(KL + r * 272 + ch * 16) = *(const u32x4*)(K12 + (size_t)r * 128 + ch * 8);
    }
    __syncthreads();
    for (int tile = tile0; tile < tile0 + ntile; ++tile) {
        const int tok0 = tile * 8;
        {
            const bf16_t* qtok = P + (size_t)(tok0 + wid) * NP + (fr & 7) * 256;
#pragma unroll
            for (int half = 0; half < 2; ++half) {
                f32x4 acc[8];
#pragma unroll
                for (int i = 0; i < 8; ++i) acc[i] = (f32x4){0.f, 0.f, 0.f, 0.f};
#pragma unroll
                for (int ks = 0; ks < 4; ++ks) {
                    const bf16x8 af = *(const bf16x8*)(qtok + half * 128 + ks * 32 + fq * 8);
#pragma unroll
                    for (int nt = 0; nt < 8; ++nt) { const bf16x8 bfv = *(const bf16x8*)(KL + (half * 128 + nt * 16 + fr) * 272 + ks * 64 + fq * 16); acc[nt] = mfma16(af, bfv, acc[nt]); }
                }
                if (fq < 2) {
#pragma unroll
                    for (int nt = 0; nt < 8; ++nt) {
                        float* dst = SC + (wid * 8 + fq * 4) * 256 + half * 128 + nt * 16 + fr;
                        dst[0] = acc[nt].x; dst[256] = acc[nt].y; dst[512] = acc[nt].z; dst[768] = acc[nt].w;
                    }
                }
            }
        }
        __builtin_amdgcn_wave_barrier();
        for (int pass = 0; pass < 2; ++pass) {
            const int row = wid * 8 + pass * 4 + fq, sl = fr, gb = fq * 16;
            float v1 = 0.f, v2 = 0.f; int i1 = 0, i2 = 0;
#pragma unroll
            for (int hf = 0; hf < 2; ++hf) {
                unsigned key[8];
#pragma unroll
                for (int i = 0; i < 8; ++i) { const int idx = sl + 16 * i; key[i] = (f2ord(SC[row * 256 + hf * 128 + idx]) & ~127u) | (unsigned)(127 - idx); }
                float sv = 0.f; int si = 0;
                for (int r = 0; r < 16; ++r) {
                    unsigned m = key[0];
#pragma unroll
                    for (int i = 1; i < 8; ++i) m = m > key[i] ? m : key[i];
                    m = gmax16(m);
                    if (sl == r) { sv = ord2f(m & ~127u); si = 127 - (int)(m & 127u); }
#pragma unroll
                    for (int i = 0; i < 8; ++i) key[i] = key[i] == m ? 0u : key[i];
                }
                if (hf == 0) { v1 = sv; i1 = si; } else { v2 = sv; i2 = si; }
            }
            int ptr = 0; float ts = 0.f; int pid = 0;
            for (int r = 0; r < 16; ++r) {
                const float v2p = __int_as_float(__builtin_amdgcn_ds_bpermute((gb + (ptr & 15)) << 2, __float_as_int(v2)));
                const unsigned key = ptr < 16 ? ((f2ord(v1 + v2p) & ~255u) | (unsigned)(255 - (sl * 16 + ptr))) : 0u;
                const unsigned m = gmax16(key);
                if (sl == r) { ts = ord2f(m & ~255u); pid = 255 - (int)(m & 255u); }
                if (key == m) ptr++;
            }
            const int e1 = __builtin_amdgcn_ds_bpermute((gb + (pid >> 4)) << 2, i1), e2 = __builtin_amdgcn_ds_bpermute((gb + (pid & 15)) << 2, i2);
            float mx = ts;
            mx = fmaxf(mx, sxor<1>(mx)); mx = fmaxf(mx, sxor<2>(mx)); mx = fmaxf(mx, sxor<4>(mx)); mx = fmaxf(mx, sxor<8>(mx));
            const float ex = __expf(ts - mx), sm = gsum16(ex);
            EIDX[row * 16 + sl] = e1 * 128 + e2; GATE[row * 16 + sl] = ex / sm;
        }
        __builtin_amdgcn_wave_barrier();
        {
            const int tok = tok0 + wid;
            const bf16_t* hrow = HB + (size_t)tok * D;
            const int grp = lane >> 4, sl = lane & 15;
            {
                f32x2 hv[32];
#pragma unroll
                for (int c = 0; c < 8; ++c) {
                    const u32x4 hq = *(const u32x4*)(hrow + sl * 64 + c * 8);
                    hv[c * 4 + 0] = (f32x2){bflo(hq.x), bfhi(hq.x)} * (1.0f / PEER_SU); hv[c * 4 + 1] = (f32x2){bflo(hq.y), bfhi(hq.y)} * (1.0f / PEER_SU);
                    hv[c * 4 + 2] = (f32x2){bflo(hq.z), bfhi(hq.z)} * (1.0f / PEER_SU); hv[c * 4 + 3] = (f32x2){bflo(hq.w), bfhi(hq.w)} * (1.0f / PEER_SU);
                }
                const unsigned char* PU8 = p.ws + WS_PU + sl * 64;
#pragma unroll 2
                for (int it = 0; it < 32; ++it) {
                    const int k = it * 4 + grp;
                    const int e = EIDX[wid * 128 + k]; const float gt = GATE[wid * 128 + k];
                    const unsigned char* ur = PU8 + (size_t)e * D;
                    const u32x4 u0 = *(const u32x4*)ur, u1 = *(const u32x4*)(ur + 16), u2 = *(const u32x4*)(ur + 32), u3 = *(const u32x4*)(ur + 48);
                    f32x2 a2 = (f32x2){0.f, 0.f}, b2 = (f32x2){0.f, 0.f};
#define PDOT(uq, base) \
                    a2 += __builtin_amdgcn_cvt_pk_f32_fp8((int)uq.x, false) * hv[base + 0]; b2 += __builtin_amdgcn_cvt_pk_f32_fp8((int)uq.x, true) * hv[base + 1]; \
                    a2 += __builtin_amdgcn_cvt_pk_f32_fp8((int)uq.y, false) * hv[base + 2]; b2 += __builtin_amdgcn_cvt_pk_f32_fp8((int)uq.y, true) * hv[base + 3]; \
                    a2 += __builtin_amdgcn_cvt_pk_f32_fp8((int)uq.z, false) * hv[base + 4]; b2 += __builtin_amdgcn_cvt_pk_f32_fp8((int)uq.z, true) * hv[base + 5]; \
                    a2 += __builtin_amdgcn_cvt_pk_f32_fp8((int)uq.w, false) * hv[base + 6]; b2 += __builtin_amdgcn_cvt_pk_f32_fp8((int)uq.w, true) * hv[base + 7];
                    PDOT(u0, 0) PDOT(u1, 8) PDOT(u2, 16) PDOT(u3, 24)
#undef PDOT
                    a2 += b2;
                    const float a = gsum16(a2.x + a2.y);
                    GATE[wid * 128 + k] = gt * gelu_exact(a);
                }
            }
            __builtin_amdgcn_wave_barrier();
            f32x2 acc[8];
#pragma unroll
            for (int i = 0; i < 8; ++i) acc[i] = (f32x2){0.f, 0.f};
            const unsigned char* PV8 = p.ws + WS_PV + lane * 16;
#pragma unroll 8
            for (int k = 0; k < 128; ++k) {
                const int e = EIDX[wid * 128 + k]; const float w = GATE[wid * 128 + k];
                const u32x4 v = *(const u32x4*)(PV8 + (size_t)e * D);
                const f32x2 w2 = (f32x2){w, w};
                acc[0] += w2 * __builtin_amdgcn_cvt_pk_f32_fp8((int)v.x, false); acc[1] += w2 * __builtin_amdgcn_cvt_pk_f32_fp8((int)v.x, true);
                acc[2] += w2 * __builtin_amdgcn_cvt_pk_f32_fp8((int)v.y, false); acc[3] += w2 * __builtin_amdgcn_cvt_pk_f32_fp8((int)v.y, true);
                acc[4] += w2 * __builtin_amdgcn_cvt_pk_f32_fp8((int)v.z, false); acc[5] += w2 * __builtin_amdgcn_cvt_pk_f32_fp8((int)v.z, true);
                acc[6] += w2 * __builtin_amdgcn_cvt_pk_f32_fp8((int)v.w, false); acc[7] += w2 * __builtin_amdgcn_cvt_pk_f32_fp8((int)v.w, true);
            }
            float* orow = G.out + (size_t)tok * D + lane * 16;
#pragma unroll
            for (int i = 0; i < 4; ++i) {
                f32x4 t = *(f32x4*)(orow + i * 4);
                t.x += acc[2 * i].x * (1.0f / PEER_SV); t.y += acc[2 * i].y * (1.0f / PEER_SV); t.z += acc[2 * i + 1].x * (1.0f / PEER_SV); t.w += acc[2 * i + 1].y * (1.0f / PEER_SV);
                *(f32x4*)(orow + i * 4) = t;
            }
        }
        __builtin_amdgcn_wave_barrier();
    }
}


constexpr int NPH = 3 + NGROUP * 3;
__device__ __forceinline__ void run_phase(const Params& p, int ph, char* lds, int* s_item) {
    const int g = (ph - 3) / 3, s = (ph - 3) % 3;
    const Grp G = get_group(p, g);
    if (s == 0) {
        for (int u = blockIdx.x; u < 256; u += gridDim.x) {
            const int m0 = (u >> 1) * 256;
            phase_rmsnorm(G.x, p.in[I_GMIX], (bf16_t*)(p.ws + WS_HB), m0, 256);
            __syncthreads();
            phase_inproj(p, g, lds, u);
            __syncthreads();
        }
    } else if (s == 1) {
        phase_mixer(p, g, lds, s_item);
    } else {
        for (int u = blockIdx.x; u < 256; u += gridDim.x) {
            const int m0 = u * 128;
            phase_glafin(p, g, m0, 128);
            __syncthreads();
            phase_merge(p, g, lds, u);
            __syncthreads();
            phase_outproj(p, g, lds, u);
            __syncthreads();
            phase_rmsnorm(G.out, p.in[I_GFFN], (bf16_t*)(p.ws + WS_HB), m0, 128);
            __syncthreads();
            phase_peerq(p, g, lds, u);
            __syncthreads();
            phase_peer(p, g, lds, m0 / 8, 16);
            __syncthreads();
        }
    }
}

__global__ void __launch_bounds__(NTHR) mega_kernel(Params p) {
    extern __shared__ __attribute__((aligned(16))) char lds[];
    __shared__ int s_item;
    cg::grid_group grid = cg::this_grid();
    phase_p0a(p, lds); grid.sync();
    phase_p0b(p, lds); grid.sync();
    phase_p0c(p); grid.sync();
    for (int ph = 3; ph < NPH; ++ph) {
        run_phase(p, ph, lds, &s_item);
        if (ph + 1 < NPH) grid.sync();
    }
}

extern "C" void kernel_launch(void* const* d_in, const int* in_sizes, int n_in, void* d_out, int out_size, void* d_ws, size_t ws_size, hipStream_t stream) {
    static int grid_blocks = 0;
    if (grid_blocks == 0) {
        if (n_in != 32 || ws_size < WS_END) { fprintf(stderr, "kernel_launch: unexpected n_in %d or ws_size %zu (< %zu)\n", n_in, ws_size, (size_t)WS_END); grid_blocks = -1; return; }
        int dev = 0, cus = 0, per_cu = 0;
        hipGetDevice(&dev);
        hipDeviceGetAttribute(&cus, hipDeviceAttributeMultiprocessorCount, dev);
        hipFuncSetAttribute((const void*)mega_kernel, hipFuncAttributeMaxDynamicSharedMemorySize, LDS_BYTES);
        hipOccupancyMaxActiveBlocksPerMultiprocessor(&per_cu, (const void*)mega_kernel, NTHR, LDS_BYTES);
        if (per_cu < 1) per_cu = 1;
        grid_blocks = cus * per_cu;
        (void)hipGetLastError();
    }
    if (grid_blocks < 0) return;
    Params p{};
    for (int i = 0; i < 32; ++i) p.in[i] = (const float*)d_in[i];
    p.out = (float*)d_out; p.ws = (unsigned char*)d_ws; p.ph_lo = 0; p.ph_hi = NPH;
    void* args[] = {&p};
    hipError_t e = hipLaunchCooperativeKernel((const void*)mega_kernel, dim3(grid_blocks), dim3(NTHR), args, LDS_BYTES, stream);
    if (e != hipSuccess) fprintf(stderr, "cooperative launch failed: %s (grid %d)\n", hipGetErrorString(e), grid_blocks);
}
```

```cpp
#include <hip/hip_runtime.h>
#include <hip/hip_cooperative_groups.h>
#include <cstdio>
#include <cstdint>
namespace cg = cooperative_groups;

typedef unsigned short bf16_t;
typedef short bf16x8 __attribute__((ext_vector_type(8)));
typedef float f32x4 __attribute__((ext_vector_type(4)));
typedef unsigned u32x4 __attribute__((ext_vector_type(4)));
typedef unsigned u32x2 __attribute__((ext_vector_type(2)));

constexpr int D = 1024;
constexpr int NP = 10496;
constexpr int IN_COLS = 10272;
constexpr int C_GQ = 0, C_GK = 512, C_GV = 1024, C_GG = 2048, C_DQ = 3072, C_DK = 4096, C_DV = 5120, C_MQ = 6144, C_BG = 7168, C_LR = 10240;
constexpr int G_TOK = 32768;
constexpr int NGROUP = 3;
constexpr int NTHR = 512;
constexpr float RMS_EPS = 1e-6f;
constexpr float LOG2E = 1.4426950408889634f;
constexpr int LDS_BYTES = 147456;
constexpr float PEER_SU = 32.0f, PEER_SV = 8.0f;

enum { I_XP = 0, I_XS, I_MP, I_MS, I_GMIX, I_WIN, I_WDF, I_BDF, I_WDB, I_BDB, I_GOUT, I_GWO, I_DGQ, I_DGK, I_LQ1, I_LK1, I_LQ2, I_LK2,
       I_DGSUB, I_DWO, I_MGN, I_MWKV, I_MGQ, I_MGK, I_MWO, I_WOUT, I_GFFN, I_PWQ, I_PK1, I_PK2, I_PU, I_PV };

constexpr size_t al256(size_t x) { return (x + 255) & ~(size_t)255; }
constexpr size_t WS_CTRL = 0;
constexpr size_t WS_PROJ = 4096;
constexpr size_t WS_HB   = WS_PROJ + (size_t)G_TOK * NP * 2;
constexpr size_t WS_VT   = WS_HB + (size_t)G_TOK * D * 2;
constexpr size_t WS_WINT = WS_VT + (size_t)G_TOK * D * 2;
constexpr size_t WS_WOT  = WS_WINT + (size_t)NP * D * 2;
constexpr size_t WS_WKVT = WS_WOT + (size_t)4 * D * D * 2;
constexpr size_t WS_WQT  = WS_WKVT + (size_t)2048 * D * 2;
constexpr size_t WS_PU   = WS_WQT + (size_t)2048 * D * 2;
constexpr size_t WS_PV   = WS_PU + (size_t)16384 * D * 2;
constexpr size_t WS_K12  = WS_PV + (size_t)16384 * D * 2;
constexpr size_t WS_ROPE = WS_K12 + (size_t)2 * 128 * 128 * 2;
constexpr size_t WS_HM   = WS_ROPE + (size_t)16384 * 64 * 4;
constexpr size_t WS_KVR  = WS_HM + (size_t)2560 * D * 2;
constexpr size_t WS_MEMK = WS_KVR + (size_t)2560 * 2048 * 4;
constexpr size_t WS_MEMV = WS_MEMK + (size_t)10 * 4 * 256 * 256 * 2;
constexpr size_t WS_END  = WS_MEMV + (size_t)10 * 4 * 256 * 256 * 2;

struct Params {
    const float* in[32];
    float* out;
    unsigned char* ws;
    int ph_lo, ph_hi;
};

typedef float f32x2 __attribute__((ext_vector_type(2)));
typedef __bf16 bf16x2v __attribute__((ext_vector_type(2)));
__device__ __forceinline__ unsigned pk2(float lo, float hi) { const f32x2 v = {lo, hi}; const bf16x2v b = __builtin_convertvector(v, bf16x2v); return __builtin_bit_cast(unsigned, b); }
__device__ __forceinline__ float bflo(unsigned u) { return __uint_as_float(u << 16); }
__device__ __forceinline__ float bfhi(unsigned u) { return __uint_as_float(u & 0xffff0000u); }
__device__ __forceinline__ float bf2f(bf16_t b) { return __uint_as_float(((unsigned)b) << 16); }
__device__ __forceinline__ bf16_t f2bf(float f) { return (bf16_t)(pk2(f, 0.f) & 0xffffu); }
__device__ __forceinline__ f32x4 mfma16(bf16x8 a, bf16x8 b, f32x4 c) { return __builtin_amdgcn_mfma_f32_16x16x32_bf16(a, b, c, 0, 0, 0); }
__device__ __forceinline__ float fexp2(float x) { return __builtin_amdgcn_exp2f(x); }
template <class T> __device__ __forceinline__ T* launder(T* q) { asm volatile("" : "+s"(q)); return q; }
__device__ __forceinline__ int otid() { int t = threadIdx.x; asm volatile("" : "+v"(t)); return t; }
template <int M> __device__ __forceinline__ float sxor(float v) {
    if (M < 32) return __int_as_float(__builtin_amdgcn_ds_swizzle(__float_as_int(v), (M << 10) | 0x1F));
    const int l = otid() & 63; return __int_as_float(__builtin_amdgcn_ds_bpermute((l ^ 32) << 2, __float_as_int(v)));
}
template <int M> __device__ __forceinline__ unsigned sxoru(unsigned v) { return (unsigned)__builtin_amdgcn_ds_swizzle((int)v, (M << 10) | 0x1F); }
__device__ __forceinline__ float wave_sum(float v) {
    v += sxor<1>(v); v += sxor<2>(v); v += sxor<4>(v); v += sxor<8>(v); v += sxor<16>(v); v += sxor<32>(v);
    return v;
}

struct Grp { const float* x; const float* mem; float* out; int B, T, mb0; };
__device__ __forceinline__ Grp get_group(const Params& p, int g) {
    Grp r;
    if (g == 0) { r.x = p.in[I_XP]; r.out = p.out; r.B = 2; r.T = 16384; r.mb0 = 0; }
    else { r.x = p.in[I_XS] + (size_t)(g - 1) * G_TOK * D; r.out = p.out + (size_t)g * G_TOK * D; r.B = 4; r.T = 8192; r.mb0 = 2 + (g - 1) * 4; }
    r.mem = nullptr;
    return r;
}

constexpr int G_ROW = 144;
constexpr int G_A_BYTES = 128 * G_ROW;
constexpr int G_B_BYTES = 256 * G_ROW;
constexpr int G_STAGE = G_A_BYTES + G_B_BYTES;

template <bool SWAP, int MT>
__device__ __forceinline__ void gemm_kloop(f32x4 (&acc)[MT][4], const bf16_t* __restrict__ A, int lda, const bf16_t* __restrict__ Bt, int ldb, int K, char* lds) {
    constexpr int A_ROWS = MT * 32, A_BYTES = A_ROWS * G_ROW, STAGE = A_BYTES + G_B_BYTES;
    constexpr int NA = A_BYTES / 1024, NI = STAGE / 1024, NPER = (NI + 7) / 8;
    const int tid = otid(), lane = tid & 63, wid = __builtin_amdgcn_readfirstlane(tid >> 6), wm = wid >> 2, wn = wid & 3, fr = lane & 15, fq = lane >> 4;
    unsigned goff[NPER];
#pragma unroll
    for (int i = 0; i < NPER; ++i) {
        const int j = wid + 8 * i;
        const int ci = (j < NA ? j : j - NA) * 64 + lane, row = ci / 9, ch = ci % 9, chc = ch < 8 ? ch : 7;
        goff[i] = (unsigned)(row * (j < NA ? lda : ldb) + chc * 8);
    }
#define GSTAGE(buf, k0) do { _Pragma("unroll") for (int i = 0; i < NPER; ++i) { const int j = wid + 8 * i; if (j < NI) { \
        const bf16_t* src_ = (j < NA ? A : Bt) + goff[i] + (k0); \
        __builtin_amdgcn_global_load_lds((const unsigned*)src_, (unsigned*)(lds + (buf) * STAGE + j * 1024), 16, 0, 0); } } } while (0)
    const int nk = K / 64;
    GSTAGE(0, 0);
    __syncthreads();
    for (int kt = 0; kt < nk; ++kt) {
        if (kt + 1 < nk) GSTAGE((kt + 1) & 1, (kt + 1) * 64);
        const char* base = lds + (kt & 1) * STAGE;
#pragma unroll
        for (int ks = 0; ks < 2; ++ks) {
            bf16x8 bfr[4];
#pragma unroll
            for (int nt = 0; nt < 4; ++nt) bfr[nt] = *(const bf16x8*)(base + A_BYTES + (wn * 64 + nt * 16 + fr) * G_ROW + ks * 64 + fq * 16);
#pragma unroll
            for (int mt = 0; mt < MT; ++mt) {
                const bf16x8 af = *(const bf16x8*)(base + (wm * (MT * 16) + mt * 16 + fr) * G_ROW + ks * 64 + fq * 16);
#pragma unroll
                for (int nt = 0; nt < 4; ++nt)
                    acc[mt][nt] = SWAP ? mfma16(bfr[nt], af, acc[mt][nt]) : mfma16(af, bfr[nt], acc[mt][nt]);
            }
        }
        __syncthreads();
    }
#undef GSTAGE
}

__device__ __forceinline__ void tile_order(int t, int nM, int nN, int& pm, int& pn) {
    const int per = 8 * nN, grp = t / per, r = t % per;
    pm = grp * 8 + (r & 7); pn = r >> 3;
}

__device__ __forceinline__ void phase_p0a(const Params& p, char* lds) {
    const int tid = otid(), lane = tid & 63, wid = tid >> 6;
    unsigned char* ws = p.ws;
    if (blockIdx.x == 0 && tid < 256) atomicExch((unsigned*)(ws + WS_CTRL) + tid, 0u);
    float* scr = (float*)(lds + wid * 8448);
    constexpr int IT_WIN = 16 * (NP / 32), IT_SQ = 16 * 32, IT_W2 = 16 * 64;
    constexpr int NIT = IT_WIN + 4 * IT_SQ + 2 * IT_W2;
    for (int it0 = blockIdx.x * 8; it0 < NIT; it0 += gridDim.x * 8) {
        int it = it0 + wid;
        const float* W = nullptr; bf16_t* WT = nullptr; int N = 0, nb = 0, kb = 0, srccol = -1;
        if (it < NIT) {
            int r = it;
            if (r < IT_WIN) { W = p.in[I_WIN]; N = IN_COLS; WT = (bf16_t*)(ws + WS_WINT); kb = r / (NP / 32); nb = r % (NP / 32);
                const int n0 = nb * 32; srccol = n0 < 3072 ? n0 : (n0 < 10240 ? n0 + 32 : (n0 == 10240 ? 3072 : -1)); }
            else { r -= IT_WIN;
                if (r < 4 * IT_SQ) { const int w = r / IT_SQ; r %= IT_SQ; const int idx[4] = {I_GWO, I_DWO, I_MWO, I_WOUT};
                    W = p.in[w == 0 ? I_GWO : (w == 1 ? I_DWO : (w == 2 ? I_MWO : I_WOUT))]; (void)idx; N = 1024; WT = (bf16_t*)(ws + WS_WOT) + (size_t)w * D * D; kb = r / 32; nb = r % 32; srccol = nb * 32; }
                else { r -= 4 * IT_SQ; const int w = r / IT_W2; r %= IT_W2; W = p.in[w == 0 ? I_MWKV : I_PWQ]; N = 2048; WT = (bf16_t*)(ws + (w == 0 ? WS_WKVT : WS_WQT)); kb = r / 64; nb = r % 64; srccol = nb * 32; }
            }
            const int k0 = kb * 64;
#pragma unroll 8
            for (int i = 0; i < 32; ++i) { const int kk = 2 * i + (lane >> 5); scr[kk * 33 + (lane & 31)] = srccol >= 0 ? W[(size_t)(k0 + kk) * N + srccol + (lane & 31)] : 0.f; }
        }
        __syncthreads();
        if (it < NIT) {
            const int k0 = kb * 64, c = lane & 7;
#pragma unroll
            for (int j = 0; j < 4; ++j) { const int n = (lane >> 3) + 8 * j; const float* s = scr + (8 * c) * 33 + n;
                u32x4 o; o.x = pk2(s[0], s[33]); o.y = pk2(s[66], s[99]); o.z = pk2(s[132], s[165]); o.w = pk2(s[198], s[231]);
                *(u32x4*)(WT + (size_t)(nb * 32 + n) * D + k0 + 8 * c) = o; }
        }
        __syncthreads();
    }
    const size_t gtid = (size_t)blockIdx.x * NTHR + tid, gsz = (size_t)gridDim.x * NTHR;
    {
        const size_t n8 = (size_t)16384 * D / 8;
        for (size_t i = gtid; i < 2 * n8; i += gsz) {
            const int w = i >= n8; const size_t j = w ? i - n8 : i;
            const float* src = p.in[w ? I_PV : I_PU] + j * 8; unsigned char* dst = ws + (w ? WS_PV : WS_PU) + j * 8;
            const float sc = w ? PEER_SV : PEER_SU;
            const f32x4 a = *(const f32x4*)src * sc, b = *(const f32x4*)(src + 4) * sc;
            int lo = __builtin_amdgcn_cvt_pk_fp8_f32(a.x, a.y, 0, false); lo = __builtin_amdgcn_cvt_pk_fp8_f32(a.z, a.w, lo, true);
            int hi = __builtin_amdgcn_cvt_pk_fp8_f32(b.x, b.y, 0, false); hi = __builtin_amdgcn_cvt_pk_fp8_f32(b.z, b.w, hi, true);
            *(u32x2*)dst = (u32x2){(unsigned)lo, (unsigned)hi};
        }
        for (size_t i = gtid; i < 2 * 16384; i += gsz) {
            const int w = i >= 16384; const size_t j = w ? i - 16384 : i;
            ((bf16_t*)(ws + WS_K12))[i] = f2bf(p.in[w ? I_PK2 : I_PK1][j]);
        }
    }
    for (size_t i = gtid; i < (size_t)16384 * 32; i += gsz) {
        const int t = (int)(i >> 5), k = (int)(i & 31);
        const float inv = powf(10000.0f, -(float)(2 * k) / 64.0f);
        const float ang = (float)t * inv;
        double sn, cs; sincos((double)ang, &sn, &cs);
        float* R = (float*)(ws + WS_ROPE) + (size_t)t * 64;
        R[k] = (float)cs; R[32 + k] = (float)sn;
    }
    for (int row = blockIdx.x * 8 + wid; row < 2560; row += gridDim.x * 8) {
        const float* src = row < 512 ? p.in[I_MP] + (size_t)row * D : p.in[I_MS] + (size_t)(row - 512) * D;
        const f32x4* xr = (const f32x4*)src + lane; const f32x4* gr = (const f32x4*)p.in[I_MGN] + lane;
        f32x4 v[4]; float s = 0.f;
#pragma unroll
        for (int j = 0; j < 4; ++j) { v[j] = xr[64 * j]; s += v[j].x * v[j].x + v[j].y * v[j].y + v[j].z * v[j].z + v[j].w * v[j].w; }
        const float r = rsqrtf(wave_sum(s) * (1.f / D) + RMS_EPS);
        u32x2* o = (u32x2*)((bf16_t*)(ws + WS_HM) + (size_t)row * D) + lane;
#pragma unroll
        for (int j = 0; j < 4; ++j) { const f32x4 g = gr[64 * j]; u32x2 w; w.x = pk2(v[j].x * r * g.x, v[j].y * r * g.y); w.y = pk2(v[j].z * r * g.z, v[j].w * r * g.w); o[64 * j] = w; }
    }
}

__device__ __forceinline__ void phase_p0b(const Params& p, char* lds) {
    const int tid_ = otid(), lane = tid_ & 63, wid = tid_ >> 6, wm = wid >> 2, wn = wid & 3, fr = lane & 15, fq = lane >> 4;
    const bf16_t* A = (const bf16_t*)(p.ws + WS_HM); const bf16_t* Bt = (const bf16_t*)(p.ws + WS_WKVT);
    float* C = (float*)(p.ws + WS_KVR);
    const int nM = 20, nN = 8;
    for (int t = blockIdx.x; t < nM * nN; t += gridDim.x) {
        const int pm = t % nM, pn = t / nM, m0 = pm * 128, n0 = pn * 256;
        f32x4 acc[4][4];
#pragma unroll
        for (int i = 0; i < 4; ++i)
#pragma unroll
            for (int j = 0; j < 4; ++j) acc[i][j] = (f32x4){0.f, 0.f, 0.f, 0.f};
        gemm_kloop<true, 4>(acc, A + (size_t)m0 * D, D, Bt + (size_t)n0 * D, D, D, lds);
#pragma unroll
        for (int mt = 0; mt < 4; ++mt)
#pragma unroll
            for (int nt = 0; nt < 4; ++nt) {
                const int row = m0 + wm * 64 + mt * 16 + fr, col = n0 + wn * 64 + nt * 16 + fq * 4;
                *(f32x4*)(C + (size_t)row * 2048 + col) = acc[mt][nt];
            }
    }
}

__device__ __forceinline__ void phase_p0c(const Params& p) {
    const int tid_ = otid(), lane = tid_ & 63, wid = tid_ >> 6;
    const float* KV = (const float*)(p.ws + WS_KVR);
    bf16_t* MK = (bf16_t*)(p.ws + WS_MEMK); bf16_t* MV = (bf16_t*)(p.ws + WS_MEMV);
    for (int it = blockIdx.x * 8 + wid; it < 2560 * 4; it += gridDim.x * 8) {
        const int row = it >> 2, h = it & 3, b = row >> 8, m = row & 255;
        const f32x4 kv = *(const f32x4*)(KV + (size_t)row * 2048 + h * 256 + lane * 4);
        const float ss = wave_sum(kv.x * kv.x + kv.y * kv.y + kv.z * kv.z + kv.w * kv.w);
        const float r = rsqrtf(ss * (1.f / 256.f) + RMS_EPS);
        const f32x4 g = *(const f32x4*)(p.in[I_MGK] + lane * 4);
        u32x2 w; w.x = pk2(kv.x * r * g.x, kv.y * r * g.y); w.y = pk2(kv.z * r * g.z, kv.w * r * g.w);
        *(u32x2*)(MK + ((size_t)(b * 4 + h) * 256 + m) * 256 + lane * 4) = w;
        const f32x4 vv = *(const f32x4*)(KV + (size_t)row * 2048 + 1024 + h * 256 + lane * 4);
        const int pos = (m & ~31) + ((m >> 2) & 3) * 8 + ((m >> 4) & 1) * 4 + (m & 3);
        bf16_t* dst = MV + ((size_t)(b * 4 + h) * 256 + lane * 4) * 256 + pos;
        dst[0] = f2bf(vv.x); dst[256] = f2bf(vv.y); dst[512] = f2bf(vv.z); dst[768] = f2bf(vv.w);
    }
}

__device__ __forceinline__ void phase_rmsnorm(const float* X, const float* gain, bf16_t* O, int row0, int nrows) {
    const int tid_ = otid(), lane = tid_ & 63, wid = tid_ >> 6;
    const f32x4* gr = (const f32x4*)launder(gain) + lane;
    f32x4 g[4];
#pragma unroll
    for (int j = 0; j < 4; ++j) g[j] = gr[64 * j];
    for (int row = row0 + wid; row < row0 + nrows; row += 8) {
        const f32x4* xr = (const f32x4*)(X + (size_t)row * D) + lane;
        f32x4 v[4]; float s = 0.f;
#pragma unroll
        for (int j = 0; j < 4; ++j) { v[j] = xr[64 * j]; s += v[j].x * v[j].x + v[j].y * v[j].y + v[j].z * v[j].z + v[j].w * v[j].w; }
        const float r = rsqrtf(wave_sum(s) * (1.f / D) + RMS_EPS);
        u32x2* o = (u32x2*)(O + (size_t)row * D) + lane;
#pragma unroll
        for (int j = 0; j < 4; ++j) { u32x2 w; w.x = pk2(v[j].x * r * g[j].x, v[j].y * r * g[j].y); w.y = pk2(v[j].z * r * g[j].z, v[j].w * r * g[j].w); o[64 * j] = w; }
    }
}

__device__ __forceinline__ void phase_inproj(const Params& p, int g, char* lds, int u) {
    const Grp G = get_group(p, g);
    const int tid_ = otid(), lane = tid_ & 63, wid = tid_ >> 6, wm = wid >> 2, wn = wid & 3, fr = lane & 15, fq = lane >> 4;
    const bf16_t* A = (const bf16_t*)(p.ws + WS_HB); const bf16_t* Bt = (const bf16_t*)(p.ws + WS_WINT);
    bf16_t* P = (bf16_t*)(p.ws + WS_PROJ); bf16_t* VT = (bf16_t*)(p.ws + WS_VT);
    const int pm = u >> 1, half = u & 1, m0 = pm * 256;
    for (int pi = 0; pi < (half ? 17 : 12); ++pi) {
        const int pn = half ? 24 + pi : pi; const int n0 = pn * 256;
        f32x4 acc[8][4];
#pragma unroll
        for (int i = 0; i < 8; ++i)
#pragma unroll
            for (int j = 0; j < 4; ++j) acc[i][j] = (f32x4){0.f, 0.f, 0.f, 0.f};
        gemm_kloop<true, 8>(acc, A + (size_t)m0 * D, D, Bt + (size_t)n0 * D, D, D, lds);
        const float sc = n0 < 512 ? 0.08838834764831845f : 1.0f;
#pragma unroll
        for (int mt = 0; mt < 8; ++mt)
#pragma unroll
            for (int nt = 0; nt < 4; ++nt) {
                const int row = m0 + wm * 128 + mt * 16 + fr, col = n0 + wn * 64 + nt * 16 + fq * 4;
                u32x2 w; w.x = pk2(acc[mt][nt].x * sc, acc[mt][nt].y * sc); w.y = pk2(acc[mt][nt].z * sc, acc[mt][nt].w * sc);
                *(u32x2*)(P + (size_t)row * NP + col) = w;
            }
    }
    if (half == 0) for (int pn = 12; pn < 20; ++pn) {
        const int n0 = pn * 256;
        f32x4 acc[8][4];
#pragma unroll
        for (int i = 0; i < 8; ++i)
#pragma unroll
            for (int j = 0; j < 4; ++j) acc[i][j] = (f32x4){0.f, 0.f, 0.f, 0.f};
        gemm_kloop<true, 8>(acc, A + (size_t)m0 * D, D, Bt + (size_t)n0 * D, D, D, lds);
        const int te_ = otid(), fr = te_ & 15, fq = (te_ >> 4) & 3, wm = te_ >> 8, wn = (te_ >> 6) & 3;
        const bool isk = n0 >= C_DK;
        const float* gn = launder(p.in[isk ? I_DGK : I_DGQ]) + fq * 4;
        const float qs = isk ? 1.0f : 0.125f * LOG2E;
        const float* ROPE = (const float*)(p.ws + WS_ROPE);
        const int tq0 = m0 % G.T + wm * 128 + fr;
#pragma unroll
        for (int mt = 0; mt < 8; ++mt) {
            const int row = m0 + wm * 128 + mt * 16 + fr, t = tq0 + mt * 16;
            float ss = 0.f;
#pragma unroll
            for (int nt = 0; nt < 4; ++nt) ss += acc[mt][nt].x * acc[mt][nt].x + acc[mt][nt].y * acc[mt][nt].y + acc[mt][nt].z * acc[mt][nt].z + acc[mt][nt].w * acc[mt][nt].w;
            ss += sxor<16>(ss); ss += sxor<32>(ss);
            const float r = rsqrtf(ss * (1.f / 64.f) + RMS_EPS) * qs;
            const float* rp = ROPE + (size_t)t * 64 + fq * 4;
            bf16_t* dst = P + (size_t)row * NP + n0 + wn * 64 + fq * 4;
#pragma unroll
            for (int hh = 0; hh < 2; ++hh) {
                const f32x4 cs = *(const f32x4*)(rp + hh * 16), sn = *(const f32x4*)(rp + 32 + hh * 16);
                const f32x4 ya = acc[mt][hh] * *(const f32x4*)(gn + hh * 16) * r, yb = acc[mt][hh + 2] * *(const f32x4*)(gn + 32 + hh * 16) * r;
                const f32x4 oa = ya * cs - yb * sn, ob = yb * cs + ya * sn;
                *(u32x2*)(dst + hh * 16) = (u32x2){pk2(oa.x, oa.y), pk2(oa.z, oa.w)};
                *(u32x2*)(dst + 32 + hh * 16) = (u32x2){pk2(ob.x, ob.y), pk2(ob.z, ob.w)};
            }
        }
    }
    for (int pn = half ? 21 : 20; pn < (half ? 24 : 21); ++pn) {
        const int n0 = pn * 256;
        f32x4 acc[8][4];
#pragma unroll
        for (int i = 0; i < 8; ++i)
#pragma unroll
            for (int j = 0; j < 4; ++j) acc[i][j] = (f32x4){0.f, 0.f, 0.f, 0.f};
        gemm_kloop<false, 8>(acc, A + (size_t)m0 * D, D, Bt + (size_t)n0 * D, D, D, lds);
        const int b = m0 / G.T, t0 = m0 % G.T + wm * 128;
#pragma unroll
        for (int mt = 0; mt < 8; ++mt)
#pragma unroll
            for (int nt = 0; nt < 4; ++nt) {
                const int n = n0 - C_DV + wn * 64 + nt * 16 + fr, h = n >> 7, dv = n & 127;
                const int pos = t0 + (mt >> 1) * 32 + fq * 8 + (mt & 1) * 4;
                u32x2 w; w.x = pk2(acc[mt][nt].x, acc[mt][nt].y); w.y = pk2(acc[mt][nt].z, acc[mt][nt].w);
                *(u32x2*)(VT + ((size_t)((b * 8 + h) * 128 + dv)) * G.T + pos) = w;
            }
    }
}

__device__ __forceinline__ void phase_qkrope(const Params& p, int g, int tok0, int ntok) {
    const Grp G = get_group(p, g);
    const int tid_ = otid(), lane = tid_ & 63, wid = tid_ >> 6, grp = lane >> 2, sub = lane & 3;
    bf16_t* P = (bf16_t*)(p.ws + WS_PROJ); const float* ROPE = (const float*)(p.ws + WS_ROPE);
    for (int it = tok0 * 2 + wid; it < (tok0 + ntok) * 2; it += 8) {
        const int tok = it >> 1, isk = it & 1, t = tok % G.T;
        bf16_t* base = P + (size_t)tok * NP + (isk ? C_DK : C_DQ) + grp * 64 + sub * 8;
        const u32x4 a = *(const u32x4*)base, b = *(const u32x4*)(base + 32);
        float x1[8], x2[8];
        x1[0] = bflo(a.x); x1[1] = bfhi(a.x); x1[2] = bflo(a.y); x1[3] = bfhi(a.y); x1[4] = bflo(a.z); x1[5] = bfhi(a.z); x1[6] = bflo(a.w); x1[7] = bfhi(a.w);
        x2[0] = bflo(b.x); x2[1] = bfhi(b.x); x2[2] = bflo(b.y); x2[3] = bfhi(b.y); x2[4] = bflo(b.z); x2[5] = bfhi(b.z); x2[6] = bflo(b.w); x2[7] = bfhi(b.w);
        float ss = 0.f;
#pragma unroll
        for (int e = 0; e < 8; ++e) ss += x1[e] * x1[e] + x2[e] * x2[e];
        ss += sxor<1>(ss); ss += sxor<2>(ss);
        const float r = rsqrtf(ss * (1.f / 64.f) + RMS_EPS) * (isk ? 1.0f : 0.125f * LOG2E);
        const float* gn = p.in[isk ? I_DGK : I_DGQ] + sub * 8;
        const float* rp = ROPE + (size_t)t * 64 + sub * 8;
        float o1[8], o2[8];
#pragma unroll
        for (int e = 0; e < 8; ++e) {
            const float y1 = x1[e] * r * gn[e], y2 = x2[e] * r * gn[32 + e], c = rp[e], s = rp[32 + e];
            o1[e] = y1 * c - y2 * s; o2[e] = y2 * c + y1 * s;
        }
        u32x4 w1, w2;
        w1.x = pk2(o1[0], o1[1]); w1.y = pk2(o1[2], o1[3]); w1.z = pk2(o1[4], o1[5]); w1.w = pk2(o1[6], o1[7]);
        w2.x = pk2(o2[0], o2[1]); w2.y = pk2(o2[2], o2[3]); w2.z = pk2(o2[4], o2[5]); w2.w = pk2(o2[6], o2[7]);
        *(u32x4*)base = w1; *(u32x4*)(base + 32) = w2;
    }
}

__device__ __forceinline__ void diff_attn_item(const Params& p, const Grp& G, int item, char* lds, float lam, float shift) {
    const int tid = otid(), lane = tid & 63, wid = tid >> 6, fr = lane & 15, fq = lane >> 4;
    const int c = wid & 1, sub = wid >> 1;
    const int T = G.T, nqb = T / 128;
    const int qb = item % nqb, bh = item / nqb, h = bh & 7, b = bh >> 3;
    bf16_t* P = (bf16_t*)(p.ws + WS_PROJ) + (size_t)b * T * NP;
    const bf16_t* Kg = P + C_DK + h * 128;
    const bf16_t* VTg = (const bf16_t*)(p.ws + WS_VT) + (size_t)bh * 128 * T;
    const int q0 = qb * 128 + sub * 32;
    bf16x8 qf[2][2];
#pragma unroll
    for (int nt = 0; nt < 2; ++nt)
#pragma unroll
        for (int ks = 0; ks < 2; ++ks) qf[nt][ks] = *(const bf16x8*)(P + (size_t)(q0 + nt * 16 + fr) * NP + C_DQ + h * 128 + c * 64 + ks * 32 + fq * 8);
    f32x4 o[8][2];
#pragma unroll
    for (int i = 0; i < 8; ++i) { o[i][0] = (f32x4){0.f, 0.f, 0.f, 0.f}; o[i][1] = (f32x4){0.f, 0.f, 0.f, 0.f}; }
    float l[2] = {0.f, 0.f};
    constexpr int STG = 36864, VOFF = 18432;
    u32x4 rk[2], rv[2];
    const int krow = tid >> 4, kch = tid & 15;
    const int vrow = tid >> 3, vch = tid & 7;
#define AGLOAD(kt) do { const int key0_ = (kt) * 64; \
        _Pragma("unroll") for (int i = 0; i < 2; ++i) rk[i] = *(const u32x4*)(Kg + (size_t)(key0_ + krow + i * 32) * NP + kch * 8); \
        _Pragma("unroll") for (int i = 0; i < 2; ++i) rv[i] = *(const u32x4*)(VTg + (size_t)(vrow + i * 64) * T + key0_ + vch * 8); } while (0)
#define ASWRITE(buf) do { char* b_ = lds + (buf) * STG; \
        _Pragma("unroll") for (int i = 0; i < 2; ++i) *(u32x4*)(b_ + ((kch >> 3) * 64 + krow + i * 32) * 144 + (kch & 7) * 16) = rk[i]; \
        _Pragma("unroll") for (int i = 0; i < 2; ++i) *(u32x4*)(b_ + VOFF + (vrow + i * 64) * 144 + vch * 16) = rv[i]; } while (0)
    const int nkt = T / 64;
#define EXPQ(SRC, NT, DSTP) do { const f32x4 a_ = SRC[0][NT], b_ = SRC[1][NT]; \
        const float p0 = fexp2(a_.x), p1 = fexp2(a_.y), p2 = fexp2(a_.z), p3 = fexp2(a_.w); \
        const float p4 = fexp2(b_.x), p5 = fexp2(b_.y), p6 = fexp2(b_.z), p7 = fexp2(b_.w); \
        l[NT] += ((p0 + p1) + (p2 + p3)) + ((p4 + p5) + (p6 + p7)); \
        u32x4 w_; w_.x = pk2(p0, p1); w_.y = pk2(p2, p3); w_.z = pk2(p4, p5); w_.w = pk2(p6, p7); \
        DSTP[NT] = __builtin_bit_cast(bf16x8, w_); } while (0)
#define SMMA1(DST, I, MT, KBASE) do { \
        const bf16x8 k0_ = *(const bf16x8*)((KBASE) + (c * 64 + (MT) * 16 + fr) * 144 + fq * 16); \
        const bf16x8 k1_ = *(const bf16x8*)((KBASE) + (c * 64 + (MT) * 16 + fr) * 144 + 64 + fq * 16); \
        DST[I][0] = mfma16(k0_, qf[0][0], (f32x4){0.f, 0.f, 0.f, 0.f}); DST[I][1] = mfma16(k0_, qf[1][0], (f32x4){0.f, 0.f, 0.f, 0.f}); \
        DST[I][0] = mfma16(k1_, qf[0][1], DST[I][0]); DST[I][1] = mfma16(k1_, qf[1][1], DST[I][1]); } while (0)
#define PVMMA(DVT, KK, PF, VBASE) do { \
        const bf16x8 vf_ = *(const bf16x8*)((VBASE) + VOFF + ((DVT) * 16 + fr) * 144 + (KK) * 64 + fq * 16); \
        o[DVT][0] = mfma16(vf_, PF[0], o[DVT][0]); o[DVT][1] = mfma16(vf_, PF[1], o[DVT][1]); } while (0)
#define PV8(KK, PF, VBASE) do { PVMMA(0, KK, PF, VBASE); PVMMA(1, KK, PF, VBASE); PVMMA(2, KK, PF, VBASE); PVMMA(3, KK, PF, VBASE); \
        PVMMA(4, KK, PF, VBASE); PVMMA(5, KK, PF, VBASE); PVMMA(6, KK, PF, VBASE); PVMMA(7, KK, PF, VBASE); } while (0)
    f32x4 slo[2][2], shi[2][2];
    bf16x8 pflo[2], pfhi[2];
    pfhi[0] = (bf16x8){0, 0, 0, 0, 0, 0, 0, 0}; pfhi[1] = pfhi[0];
#define KLOAD(KR, MTA, MTB, KBASE) do { \
        KR[0] = *(const bf16x8*)((KBASE) + (c * 64 + (MTA) * 16 + fr) * 144 + fq * 16); KR[1] = *(const bf16x8*)((KBASE) + (c * 64 + (MTA) * 16 + fr) * 144 + 64 + fq * 16); \
        KR[2] = *(const bf16x8*)((KBASE) + (c * 64 + (MTB) * 16 + fr) * 144 + fq * 16); KR[3] = *(const bf16x8*)((KBASE) + (c * 64 + (MTB) * 16 + fr) * 144 + 64 + fq * 16); } while (0)
#define SMMAK(DST, KR) do { \
        DST[0][0] = mfma16(KR[0], qf[0][0], (f32x4){0.f, 0.f, 0.f, 0.f}); DST[0][1] = mfma16(KR[0], qf[1][0], (f32x4){0.f, 0.f, 0.f, 0.f}); \
        DST[1][0] = mfma16(KR[2], qf[0][0], (f32x4){0.f, 0.f, 0.f, 0.f}); DST[1][1] = mfma16(KR[2], qf[1][0], (f32x4){0.f, 0.f, 0.f, 0.f}); \
        DST[0][0] = mfma16(KR[1], qf[0][1], DST[0][0]); DST[0][1] = mfma16(KR[1], qf[1][1], DST[0][1]); \
        DST[1][0] = mfma16(KR[3], qf[0][1], DST[1][0]); DST[1][1] = mfma16(KR[3], qf[1][1], DST[1][1]); } while (0)
#define VLOAD4(VR, D0, KK, VBASE) do { _Pragma("unroll") for (int i_ = 0; i_ < 4; ++i_) VR[i_] = *(const bf16x8*)((VBASE) + VOFF + (((D0) + i_) * 16 + fr) * 144 + (KK) * 64 + fq * 16); } while (0)
#define PV4(VR, D0, PF) do { _Pragma("unroll") for (int i_ = 0; i_ < 4; ++i_) { o[(D0) + i_][0] = mfma16(VR[i_], PF[0], o[(D0) + i_][0]); o[(D0) + i_][1] = mfma16(VR[i_], PF[1], o[(D0) + i_][1]); } } while (0)
#define FENCE() __builtin_amdgcn_sched_barrier(0)
    AGLOAD(0); ASWRITE(0); AGLOAD(1); ASWRITE(1);
    for (int i = tid; i < 18432 / 16; i += NTHR) *(u32x4*)(lds + 3 * STG + VOFF + i * 16) = (u32x4){0u, 0u, 0u, 0u};
    __syncthreads();
    bf16x8 kr[4], va[4], vb[4];
    KLOAD(kr, 0, 1, lds); SMMAK(slo, kr);
    for (int kt = 0; kt < nkt; ++kt) {
        { const int ktl = kt + 2 < nkt ? kt + 2 : nkt - 1; AGLOAD(ktl); }
        const char* cur = lds + (kt & 3) * STG; const char* nxt = lds + ((kt + 1) & 3) * STG; const char* prv = lds + ((kt + 3) & 3) * STG;
        KLOAD(kr, 2, 3, cur); VLOAD4(va, 0, 1, prv);
        FENCE();
        SMMAK(shi, kr); VLOAD4(vb, 4, 1, prv); EXPQ(slo, 0, pflo);
        FENCE();
        PV4(va, 0, pfhi); KLOAD(kr, 0, 1, nxt); EXPQ(slo, 1, pflo);
        FENCE();
        PV4(vb, 4, pfhi); VLOAD4(va, 0, 0, cur);
        FENCE();
        SMMAK(slo, kr); VLOAD4(vb, 4, 0, cur); EXPQ(shi, 0, pfhi);
        FENCE();
        PV4(va, 0, pflo); EXPQ(shi, 1, pfhi);
        FENCE();
        PV4(vb, 4, pflo);
        FENCE();
        ASWRITE((kt + 2) & 3);
        __syncthreads();
    }
    { const char* prv = lds + ((nkt - 1) & 3) * STG; VLOAD4(va, 0, 1, prv); VLOAD4(vb, 4, 1, prv); PV4(va, 0, pfhi); PV4(vb, 4, pfhi); }
    __syncthreads();
#undef KLOAD
#undef SMMAK
#undef VLOAD4
#undef PV4
#undef FENCE
#undef EXPQ
#undef SMMA1
#undef PVMMA
#undef PV8
#undef AGLOAD
#undef ASWRITE
    float inv[2];
#pragma unroll
    for (int nt = 0; nt < 2; ++nt) { float v = l[nt]; v += sxor<16>(v); v += sxor<32>(v); inv[nt] = 1.0f / v; }
    float* xch = (float*)lds + sub * 4096;
    if (c == 1) {
#pragma unroll
        for (int dvt = 0; dvt < 8; ++dvt)
#pragma unroll
            for (int nt = 0; nt < 2; ++nt) {
                xch[(dvt * 16 + fq * 4 + 0) * 32 + nt * 16 + fr] = o[dvt][nt].x * inv[nt];
                xch[(dvt * 16 + fq * 4 + 1) * 32 + nt * 16 + fr] = o[dvt][nt].y * inv[nt];
                xch[(dvt * 16 + fq * 4 + 2) * 32 + nt * 16 + fr] = o[dvt][nt].z * inv[nt];
                xch[(dvt * 16 + fq * 4 + 3) * 32 + nt * 16 + fr] = o[dvt][nt].w * inv[nt];
            }
    }
    __syncthreads();
    if (c == 0) {
        float ss[2] = {0.f, 0.f};
#pragma unroll
        for (int dvt = 0; dvt < 8; ++dvt)
#pragma unroll
            for (int nt = 0; nt < 2; ++nt) {
                f32x4 v = o[dvt][nt] * inv[nt];
                v.x -= lam * xch[(dvt * 16 + fq * 4 + 0) * 32 + nt * 16 + fr];
                v.y -= lam * xch[(dvt * 16 + fq * 4 + 1) * 32 + nt * 16 + fr];
                v.z -= lam * xch[(dvt * 16 + fq * 4 + 2) * 32 + nt * 16 + fr];
                v.w -= lam * xch[(dvt * 16 + fq * 4 + 3) * 32 + nt * 16 + fr];
                o[dvt][nt] = v; ss[nt] += v.x * v.x + v.y * v.y + v.z * v.z + v.w * v.w;
            }
#pragma unroll
        for (int nt = 0; nt < 2; ++nt) {
            float v = ss[nt]; v += sxor<16>(v); v += sxor<32>(v);
            const float r = rsqrtf(v * (1.f / 128.f) + RMS_EPS) * 0.8f;
#pragma unroll
            for (int dvt = 0; dvt < 8; ++dvt) {
                const f32x4 gs = *(const f32x4*)(p.in[I_DGSUB] + dvt * 16 + fq * 4);
                const f32x4 v4 = o[dvt][nt];
                u32x2 w; w.x = pk2(v4.x * r * gs.x, v4.y * r * gs.y); w.y = pk2(v4.z * r * gs.z, v4.w * r * gs.w);
                *(u32x2*)(P + (size_t)(q0 + nt * 16 + fr) * NP + C_DQ + h * 128 + dvt * 16 + fq * 4) = w;
            }
        }
    }
    __syncthreads();
}

__device__ __forceinline__ void mem_attn_item(const Params& p, const Grp& G, int item, char* lds, float shift) {
    const int tid = otid(), lane = tid & 63, wid = tid >> 6, fr = lane & 15, fq = lane >> 4;
    const int T = G.T, nqb = T / 128;
    const int qb = item % nqb, bh = item / nqb, h = bh & 3, b = bh >> 2;
    bf16_t* P = (bf16_t*)(p.ws + WS_PROJ) + (size_t)b * T * NP;
    const bf16_t* MK = (const bf16_t*)(p.ws + WS_MEMK) + (size_t)((G.mb0 + b) * 4 + h) * 256 * 256;
    const bf16_t* MV = (const bf16_t*)(p.ws + WS_MEMV) + (size_t)((G.mb0 + b) * 4 + h) * 256 * 256;
    const int row = qb * 128 + wid * 16 + fr;
    bf16_t* qp = P + (size_t)row * NP + C_MQ + h * 256;
    bf16x8 qf[8];
    {
        float ss = 0.f; u32x4 raw[8];
#pragma unroll
        for (int ks = 0; ks < 8; ++ks) { raw[ks] = *(const u32x4*)(qp + ks * 32 + fq * 8);
            const float a0 = bflo(raw[ks].x), a1 = bfhi(raw[ks].x), a2 = bflo(raw[ks].y), a3 = bfhi(raw[ks].y), a4 = bflo(raw[ks].z), a5 = bfhi(raw[ks].z), a6 = bflo(raw[ks].w), a7 = bfhi(raw[ks].w);
            ss += a0 * a0 + a1 * a1 + a2 * a2 + a3 * a3 + a4 * a4 + a5 * a5 + a6 * a6 + a7 * a7; }
        ss += sxor<16>(ss); ss += sxor<32>(ss);
        const float r = rsqrtf(ss * (1.f / 256.f) + RMS_EPS) * (0.0625f * LOG2E);
#pragma unroll
        for (int ks = 0; ks < 8; ++ks) {
            const f32x4 g0 = *(const f32x4*)(p.in[I_MGQ] + ks * 32 + fq * 8), g1 = *(const f32x4*)(p.in[I_MGQ] + ks * 32 + fq * 8 + 4);
            u32x4 w;
            w.x = pk2(bflo(raw[ks].x) * r * g0.x, bfhi(raw[ks].x) * r * g0.y); w.y = pk2(bflo(raw[ks].y) * r * g0.z, bfhi(raw[ks].y) * r * g0.w);
            w.z = pk2(bflo(raw[ks].z) * r * g1.x, bfhi(raw[ks].z) * r * g1.y); w.w = pk2(bflo(raw[ks].w) * r * g1.z, bfhi(raw[ks].w) * r * g1.w);
            qf[ks] = __builtin_bit_cast(bf16x8, w);
        }
    }
    f32x4 o[16];
#pragma unroll
    for (int i = 0; i < 16; ++i) o[i] = (f32x4){0.f, 0.f, 0.f, 0.f};
    float l = 0.f;
    constexpr int KROW = 528, VOFF = 64 * 528;
    for (int kt = 0; kt < 4; ++kt) {
#pragma unroll
        for (int i = 0; i < 4; ++i) {
            const int idx = tid + i * 512, r = idx >> 5, ch = idx & 31;
            *(u32x4*)(lds + r * KROW + ch * 16) = *(const u32x4*)(MK + (size_t)(kt * 64 + r) * 256 + ch * 8);
            const int vr = idx >> 3, vc = idx & 7;
            *(u32x4*)(lds + VOFF + vr * 144 + vc * 16) = *(const u32x4*)(MV + (size_t)vr * 256 + kt * 64 + vc * 8);
        }
        __syncthreads();
        f32x4 s[4];
#pragma unroll
        for (int mt = 0; mt < 4; ++mt) s[mt] = (f32x4){-shift, -shift, -shift, -shift};
#pragma unroll
        for (int ks = 0; ks < 8; ++ks)
#pragma unroll
            for (int mt = 0; mt < 4; ++mt) {
                const bf16x8 kf = *(const bf16x8*)(lds + (mt * 16 + fr) * KROW + ks * 64 + fq * 16);
                s[mt] = mfma16(kf, qf[ks], s[mt]);
            }
        bf16x8 pf[2];
#pragma unroll
        for (int kk = 0; kk < 2; ++kk) {
            const f32x4 a = s[2 * kk], bb = s[2 * kk + 1];
            const float p0 = fexp2(a.x), p1 = fexp2(a.y), p2 = fexp2(a.z), p3 = fexp2(a.w);
            const float p4 = fexp2(bb.x), p5 = fexp2(bb.y), p6 = fexp2(bb.z), p7 = fexp2(bb.w);
            l += ((p0 + p1) + (p2 + p3)) + ((p4 + p5) + (p6 + p7));
            u32x4 w; w.x = pk2(p0, p1); w.y = pk2(p2, p3); w.z = pk2(p4, p5); w.w = pk2(p6, p7);
            pf[kk] = __builtin_bit_cast(bf16x8, w);
        }
#pragma unroll
        for (int kk = 0; kk < 2; ++kk)
#pragma unroll
            for (int dvt = 0; dvt < 16; ++dvt) {
                const bf16x8 vf = *(const bf16x8*)(lds + VOFF + (dvt * 16 + fr) * 144 + kk * 64 + fq * 16);
                o[dvt] = mfma16(vf, pf[kk], o[dvt]);
            }
        __syncthreads();
    }
    l += sxor<16>(l); l += sxor<32>(l);
    const float inv = 1.0f / l;
#pragma unroll
    for (int dvt = 0; dvt < 16; ++dvt) {
        u32x2 w; w.x = pk2(o[dvt].x * inv, o[dvt].y * inv); w.y = pk2(o[dvt].z * inv, o[dvt].w * inv);
        *(u32x2*)(qp + dvt * 16 + fq * 4) = w;
    }
}

constexpr int L_QE = 0, L_KE = 17408, L_KST = 34816, L_VTL = 53248, L_ATT = 71680, L_SB = 80896, L_LRF = 115712, L_TOT = 119808, L_GDEC = 121856;
__device__ __forceinline__ void gla_item(const Params& p, const Grp& G, int item, char* lds) {
    const int tid = otid(), lane = tid & 63, wid = tid >> 6, fr = lane & 15, fq = lane >> 4;
    const int slice = item & 1, dir = (item >> 1) & 1, h = (item >> 2) & 3, b = item >> 4;
    const int T = G.T, N = T / 64;
    const bf16_t* P = (const bf16_t*)(p.ws + WS_PROJ) + (size_t)b * T * NP;
    bf16_t* OUT = dir ? (bf16_t*)(p.ws + WS_PROJ) + (size_t)b * T * NP + C_DV + h * 256 + slice * 128
                      : (bf16_t*)(p.ws + WS_HB) + (size_t)b * T * D + h * 256 + slice * 128;
    const int ldo = dir ? NP : D;
    const int d = tid & 127, rg = tid >> 7;
    float wdec[16];
    {
        const float* wd = p.in[dir ? I_WDB : I_WDF];
#pragma unroll
        for (int r = 0; r < 16; ++r) wdec[r] = wd[r * 512 + h * 128 + d];
    }
    const float bdec = p.in[dir ? I_BDB : I_BDF][h * 128 + d];
    { unsigned z = 0u; asm volatile("" : "+v"(z)); for (int i = tid; i < 34816 / 16; i += NTHR) *(u32x4*)(lds + L_SB + i * 16) = (u32x4){z, z, z, z}; }
    f32x4 S[8];
#pragma unroll
    for (int i = 0; i < 8; ++i) S[i] = (f32x4){0.f, 0.f, 0.f, 0.f};
    u32x4 rq[2], rk[2], rv[2], rl;
    const int lrow = tid >> 4, lch = tid & 15;
#define GGLOAD(n) do { const int cb_ = (dir ? (N - 1 - (n)) : (n)) * 64; \
        _Pragma("unroll") for (int i = 0; i < 2; ++i) { const int li_ = lrow + i * 32, tk_ = cb_ + (dir ? 63 - li_ : li_); const bf16_t* rp_ = P + (size_t)tk_ * NP; \
            rq[i] = *(const u32x4*)(rp_ + C_GQ + h * 128 + lch * 8); rk[i] = *(const u32x4*)(rp_ + C_GK + h * 128 + lch * 8); rv[i] = *(const u32x4*)(rp_ + C_GV + h * 256 + slice * 128 + lch * 8); } \
        if (tid < 128) { const int li_ = tid >> 1, tk_ = cb_ + (dir ? 63 - li_ : li_); rl = *(const u32x4*)(P + (size_t)tk_ * NP + C_LR + dir * 16 + (tid & 1) * 8); } } while (0)
    GGLOAD(0);
    for (int n = 0; n < N; ++n) {
#pragma unroll
        for (int i = 0; i < 2; ++i) {
            const int li = lrow + i * 32;
            *(u32x4*)(lds + L_QE + li * 272 + lch * 16) = rq[i];
            *(u32x4*)(lds + L_KE + li * 272 + lch * 16) = rk[i];
            bf16_t* vt = (bf16_t*)(lds + L_VTL) + (lch * 8) * 72 + li;
            vt[0 * 72] = (bf16_t)(rv[i].x & 0xffff); vt[1 * 72] = (bf16_t)(rv[i].x >> 16); vt[2 * 72] = (bf16_t)(rv[i].y & 0xffff); vt[3 * 72] = (bf16_t)(rv[i].y >> 16);
            vt[4 * 72] = (bf16_t)(rv[i].z & 0xffff); vt[5 * 72] = (bf16_t)(rv[i].z >> 16); vt[6 * 72] = (bf16_t)(rv[i].w & 0xffff); vt[7 * 72] = (bf16_t)(rv[i].w >> 16);
        }
        if (tid < 128) {
            float* lf = (float*)(lds + L_LRF) + (tid >> 1) * 16 + (tid & 1) * 8;
            *(f32x4*)lf = (f32x4){bflo(rl.x), bfhi(rl.x), bflo(rl.y), bfhi(rl.y)};
            *(f32x4*)(lf + 4) = (f32x4){bflo(rl.z), bfhi(rl.z), bflo(rl.w), bfhi(rl.w)};
        }
        if (n + 1 < N) GGLOAD(n + 1);
        __syncthreads();
        float cs[16]; float run = 0.f;
#pragma unroll
        for (int ii = 0; ii < 16; ++ii) {
            const float* lf = (const float*)(lds + L_LRF) + (rg * 16 + ii) * 16;
            const f32x4 a0 = *(const f32x4*)lf, a1 = *(const f32x4*)(lf + 4), a2 = *(const f32x4*)(lf + 8), a3 = *(const f32x4*)(lf + 12);
            float x = bdec;
            x += a0.x * wdec[0] + a0.y * wdec[1] + a0.z * wdec[2] + a0.w * wdec[3];
            x += a1.x * wdec[4] + a1.y * wdec[5] + a1.z * wdec[6] + a1.w * wdec[7];
            x += a2.x * wdec[8] + a2.y * wdec[9] + a2.z * wdec[10] + a2.w * wdec[11];
            x += a3.x * wdec[12] + a3.y * wdec[13] + a3.z * wdec[14] + a3.w * wdec[15];
            const float ls = fminf(x, 0.f) - __logf(1.0f + __expf(-fabsf(x)));
            run += ls * 0.0625f; cs[ii] = run;
        }
        ((float*)(lds + L_TOT))[rg * 128 + d] = run;
        __syncthreads();
        float off = 0.f, blast = 0.f;
#pragma unroll
        for (int r = 0; r < 4; ++r) { const float tv = ((const float*)(lds + L_TOT))[r * 128 + d]; blast += tv; if (r < rg) off += tv; }
        {
            bf16_t* qe = (bf16_t*)(lds + L_QE) + d; bf16_t* ke = (bf16_t*)(lds + L_KE) + d;
            unsigned ksp[8];
#pragma unroll
            for (int ii = 0; ii < 16; ii += 2) {
                const int i0 = rg * 16 + ii;
                const float b0 = off + cs[ii], b1 = off + cs[ii + 1];
                const float q0v = bf2f(qe[i0 * 136]), q1v = bf2f(qe[(i0 + 1) * 136]), k0v = bf2f(ke[i0 * 136]), k1v = bf2f(ke[(i0 + 1) * 136]);
                qe[i0 * 136] = f2bf(q0v * __expf(b0)); qe[(i0 + 1) * 136] = f2bf(q1v * __expf(b1));
                ke[i0 * 136] = f2bf(k0v * __expf(-b0)); ke[(i0 + 1) * 136] = f2bf(k1v * __expf(-b1));
                ksp[ii >> 1] = pk2(k0v * __expf(blast - b0), k1v * __expf(blast - b1));
            }
            char* kst = lds + L_KST + d * 144 + rg * 32;
            *(u32x4*)kst = (u32x4){ksp[0], ksp[1], ksp[2], ksp[3]};
            *(u32x4*)(kst + 16) = (u32x4){ksp[4], ksp[5], ksp[6], ksp[7]};
            if (rg == 0) ((float*)(lds + L_GDEC))[d] = __expf(blast);
        }
        __syncthreads();
        {
            const int ct = wid & 3;
            f32x4 a[2] = {(f32x4){0.f, 0.f, 0.f, 0.f}, (f32x4){0.f, 0.f, 0.f, 0.f}};
#pragma unroll
            for (int ks = 0; ks < 4; ++ks) {
                const bf16x8 qv = *(const bf16x8*)(lds + L_QE + (ct * 16 + fr) * 272 + ks * 64 + fq * 16);
#pragma unroll
                for (int j = 0; j < 2; ++j) {
                    const int st = (wid >> 2) * 2 + j;
                    const bf16x8 kv = *(const bf16x8*)(lds + L_KE + (st * 16 + fr) * 272 + ks * 64 + fq * 16);
                    a[j] = mfma16(kv, qv, a[j]);
                }
            }
#pragma unroll
            for (int j = 0; j < 2; ++j) {
                const int st = (wid >> 2) * 2 + j, cc = ct * 16 + fr, s0 = st * 16 + fq * 4;
                const float v0 = (s0 + 0 <= cc) ? a[j].x : 0.f, v1 = (s0 + 1 <= cc) ? a[j].y : 0.f, v2 = (s0 + 2 <= cc) ? a[j].z : 0.f, v3 = (s0 + 3 <= cc) ? a[j].w : 0.f;
                *(u32x2*)(lds + L_ATT + cc * 144 + s0 * 2) = (u32x2){pk2(v0, v1), pk2(v2, v3)};
            }
        }
        __syncthreads();
        {
            f32x4 oc[4] = {(f32x4){0.f, 0.f, 0.f, 0.f}, (f32x4){0.f, 0.f, 0.f, 0.f}, (f32x4){0.f, 0.f, 0.f, 0.f}, (f32x4){0.f, 0.f, 0.f, 0.f}};
#pragma unroll
            for (int ks = 0; ks < 2; ++ks) {
                const bf16x8 af = *(const bf16x8*)(lds + L_VTL + (wid * 16 + fr) * 144 + ks * 64 + fq * 16);
#pragma unroll
                for (int ct = 0; ct < 4; ++ct) { const bf16x8 bfv = *(const bf16x8*)(lds + L_ATT + (ct * 16 + fr) * 144 + ks * 64 + fq * 16); oc[ct] = mfma16(af, bfv, oc[ct]); }
            }
#pragma unroll
            for (int ks = 0; ks < 4; ++ks) {
                const bf16x8 af = *(const bf16x8*)(lds + L_SB + (wid * 16 + fr) * 272 + ks * 64 + fq * 16);
#pragma unroll
                for (int ct = 0; ct < 4; ++ct) { const bf16x8 bfv = *(const bf16x8*)(lds + L_QE + (ct * 16 + fr) * 272 + ks * 64 + fq * 16); oc[ct] = mfma16(af, bfv, oc[ct]); }
            }
            const int cb = (dir ? (N - 1 - n) : n) * 64;
#pragma unroll
            for (int ct = 0; ct < 4; ++ct) {
                const int cl = ct * 16 + fr, tk = cb + (dir ? 63 - cl : cl);
                *(u32x2*)(OUT + (size_t)tk * ldo + wid * 16 + fq * 4) = (u32x2){pk2(oc[ct].x, oc[ct].y), pk2(oc[ct].z, oc[ct].w)};
            }
        }
        __syncthreads();
        {
            const f32x4 gd = *(const f32x4*)((const float*)(lds + L_GDEC) + wid * 16 + fq * 4);
#pragma unroll
            for (int et = 0; et < 8; ++et) S[et] = S[et] * gd;
#pragma unroll
            for (int ks = 0; ks < 2; ++ks) {
                const bf16x8 af = *(const bf16x8*)(lds + L_KST + (wid * 16 + fr) * 144 + ks * 64 + fq * 16);
#pragma unroll
                for (int et = 0; et < 8; ++et) { const bf16x8 bfv = *(const bf16x8*)(lds + L_VTL + (et * 16 + fr) * 144 + ks * 64 + fq * 16); S[et] = mfma16(af, bfv, S[et]); }
            }
#pragma unroll
            for (int et = 0; et < 8; ++et)
                *(u32x2*)(lds + L_SB + (et * 16 + fr) * 272 + (wid * 16 + fq * 4) * 2) = (u32x2){pk2(S[et].x, S[et].y), pk2(S[et].z, S[et].w)};
        }
        __syncthreads();
    }
#undef GGLOAD
}

__device__ __forceinline__ void phase_mixer(const Params& p, int g, char* lds, int* s_item) {
    const Grp G = get_group(p, g);
    const int nGLA = G.B * 16, nATT = G.B * 8 * (G.T / 128), nMEM = G.B * 4 * (G.T / 128);
    unsigned* ctr = (unsigned*)(p.ws + WS_CTRL) + g * 4;
    for (;;) {
        if (threadIdx.x == 0) *s_item = (int)atomicAdd(ctr + 0, 1u);
        __syncthreads();
        const int it = *s_item;
        __syncthreads();
        if (it >= nGLA) break;
        gla_item(p, G, it, lds);
    }
    {
        float d1 = 0.f, d2 = 0.f;
        for (int i = 0; i < 64; ++i) { d1 += p.in[I_LQ1][i] * p.in[I_LK1][i]; d2 += p.in[I_LQ2][i] * p.in[I_LK2][i]; }
        const float lam = expf(d1) - expf(d2) + 0.2f;
        for (;;) {
            if (threadIdx.x == 0) *s_item = (int)atomicAdd(ctr + 1, 1u);
            __syncthreads();
            const int it = *s_item;
            __syncthreads();
            if (it >= nATT) break;
            diff_attn_item(p, G, it, lds, lam, 0.f);
        }
    }
    for (;;) {
        if (threadIdx.x == 0) *s_item = (int)atomicAdd(ctr + 2, 1u);
        __syncthreads();
        const int it = *s_item;
        __syncthreads();
        if (it >= nMEM) break;
        mem_attn_item(p, G, it, lds, 0.f);
    }
}

__device__ __forceinline__ void phase_glafin(const Params& p, int g, int tok0, int ntok) {
    const int tid_ = otid(), lane = tid_ & 63, wid = tid_ >> 6;
    bf16_t* P = (bf16_t*)(p.ws + WS_PROJ); const bf16_t* F = (const bf16_t*)(p.ws + WS_HB);
    for (int it = tok0 * 4 + wid; it < (tok0 + ntok) * 4; it += 8) {
        const int tok = it >> 2, h = it & 3;
        bf16_t* row = P + (size_t)tok * NP;
        const unsigned qq = *(const unsigned*)(row + C_GQ + h * 128 + lane * 2), kk = *(const unsigned*)(row + C_GK + h * 128 + lane * 2);
        const float qk = wave_sum(bflo(qq) * bflo(kk) + bfhi(qq) * bfhi(kk));
        const u32x2 f = *(const u32x2*)(F + (size_t)tok * D + h * 256 + lane * 4), bk = *(const u32x2*)(row + C_DV + h * 256 + lane * 4);
        const u32x2 v = *(const u32x2*)(row + C_GV + h * 256 + lane * 4), gt = *(const u32x2*)(row + C_GG + h * 256 + lane * 4);
        float o0 = bflo(f.x) + bflo(bk.x) - qk * bflo(v.x), o1 = bfhi(f.x) + bfhi(bk.x) - qk * bfhi(v.x);
        float o2 = bflo(f.y) + bflo(bk.y) - qk * bflo(v.y), o3 = bfhi(f.y) + bfhi(bk.y) - qk * bfhi(v.y);
        const float r = rsqrtf(wave_sum(o0 * o0 + o1 * o1 + o2 * o2 + o3 * o3) * (1.f / 256.f) + RMS_EPS);
        const f32x4 go = *(const f32x4*)(p.in[I_GOUT] + lane * 4);
        const float g0 = bflo(gt.x), g1 = bfhi(gt.x), g2 = bflo(gt.y), g3 = bfhi(gt.y);
        o0 *= r * go.x * g0 / (1.f + __expf(-g0)); o1 *= r * go.y * g1 / (1.f + __expf(-g1));
        o2 *= r * go.z * g2 / (1.f + __expf(-g2)); o3 *= r * go.w * g3 / (1.f + __expf(-g3));
        *(u32x2*)(row + C_GG + h * 256 + lane * 4) = (u32x2){pk2(o0, o1), pk2(o2, o3)};
    }
}

__device__ __forceinline__ void phase_merge(const Params& p, int g, char* lds, int u) {
    const int tid_ = otid(), lane = tid_ & 63, wid = tid_ >> 6, wm = wid >> 2, wn = wid & 3, fr = lane & 15, fq = lane >> 4;
    const bf16_t* P = (const bf16_t*)(p.ws + WS_PROJ); bf16_t* M = (bf16_t*)(p.ws + WS_VT);
    for (int pn = 0; pn < 4; ++pn) {
        const int m0 = u * 128, n0 = pn * 256;
        f32x4 macc[4][4];
#pragma unroll
        for (int i = 0; i < 4; ++i)
#pragma unroll
            for (int j = 0; j < 4; ++j) macc[i][j] = (f32x4){0.f, 0.f, 0.f, 0.f};
        for (int br = 0; br < 3; ++br) {
            f32x4 acc[4][4];
#pragma unroll
            for (int i = 0; i < 4; ++i)
#pragma unroll
                for (int j = 0; j < 4; ++j) acc[i][j] = (f32x4){0.f, 0.f, 0.f, 0.f};
            const int acol = br == 0 ? C_GG : (br == 1 ? C_DQ : C_MQ);
            gemm_kloop<true, 4>(acc, P + (size_t)m0 * NP + acol, NP, (const bf16_t*)(p.ws + WS_WOT) + (size_t)br * D * D + (size_t)n0 * D, D, D, lds);
#pragma unroll
            for (int mt = 0; mt < 4; ++mt)
#pragma unroll
                for (int nt = 0; nt < 4; ++nt) {
                    const int row = m0 + wm * 64 + mt * 16 + fr, col = n0 + wn * 64 + nt * 16 + fq * 4;
                    const u32x2 gt = *(const u32x2*)(P + (size_t)row * NP + C_BG + br * 1024 + col);
                    f32x4 sg; sg.x = 1.f / (1.f + __expf(-bflo(gt.x))); sg.y = 1.f / (1.f + __expf(-bfhi(gt.x))); sg.z = 1.f / (1.f + __expf(-bflo(gt.y))); sg.w = 1.f / (1.f + __expf(-bfhi(gt.y)));
                    macc[mt][nt] += sg * acc[mt][nt];
                }
        }
#pragma unroll
        for (int mt = 0; mt < 4; ++mt)
#pragma unroll
            for (int nt = 0; nt < 4; ++nt) {
                const int row = m0 + wm * 64 + mt * 16 + fr, col = n0 + wn * 64 + nt * 16 + fq * 4;
                *(u32x2*)(M + (size_t)row * D + col) = (u32x2){pk2(macc[mt][nt].x, macc[mt][nt].y), pk2(macc[mt][nt].z, macc[mt][nt].w)};
            }
    }
}

__device__ __forceinline__ void phase_outproj(const Params& p, int g, char* lds, int u) {
    const Grp G = get_group(p, g);
    const int tid_ = otid(), lane = tid_ & 63, wid = tid_ >> 6, wm = wid >> 2, wn = wid & 3, fr = lane & 15, fq = lane >> 4;
    const bf16_t* M = (const bf16_t*)(p.ws + WS_VT); const bf16_t* W = (const bf16_t*)(p.ws + WS_WOT) + (size_t)3 * D * D;
    for (int pn = 0; pn < 4; ++pn) {
        const int m0 = u * 128, n0 = pn * 256;
        f32x4 acc[4][4];
#pragma unroll
        for (int i = 0; i < 4; ++i)
#pragma unroll
            for (int j = 0; j < 4; ++j) acc[i][j] = (f32x4){0.f, 0.f, 0.f, 0.f};
        gemm_kloop<true, 4>(acc, M + (size_t)m0 * D, D, W + (size_t)n0 * D, D, D, lds);
#pragma unroll
        for (int mt = 0; mt < 4; ++mt)
#pragma unroll
            for (int nt = 0; nt < 4; ++nt) {
                const int row = m0 + wm * 64 + mt * 16 + fr, col = n0 + wn * 64 + nt * 16 + fq * 4;
                const f32x4 xv = *(const f32x4*)(G.x + (size_t)row * D + col);
                *(f32x4*)(G.out + (size_t)row * D + col) = xv + acc[mt][nt];
            }
    }
}

__device__ __forceinline__ void phase_peerq(const Params& p, int g, char* lds, int u) {
    const int tid_ = otid(), lane = tid_ & 63, wid = tid_ >> 6, wm = wid >> 2, wn = wid & 3, fr = lane & 15, fq = lane >> 4;
    const bf16_t* A = (const bf16_t*)(p.ws + WS_HB); const bf16_t* W = (const bf16_t*)(p.ws + WS_WQT); bf16_t* P = (bf16_t*)(p.ws + WS_PROJ);
    for (int pn = 0; pn < 8; ++pn) {
        const int m0 = u * 128, n0 = pn * 256;
        f32x4 acc[4][4];
#pragma unroll
        for (int i = 0; i < 4; ++i)
#pragma unroll
            for (int j = 0; j < 4; ++j) acc[i][j] = (f32x4){0.f, 0.f, 0.f, 0.f};
        gemm_kloop<true, 4>(acc, A + (size_t)m0 * D, D, W + (size_t)n0 * D, D, D, lds);
#pragma unroll
        for (int mt = 0; mt < 4; ++mt)
#pragma unroll
            for (int nt = 0; nt < 4; ++nt) {
                const int row = m0 + wm * 64 + mt * 16 + fr, col = n0 + wn * 64 + nt * 16 + fq * 4;
                *(u32x2*)(P + (size_t)row * NP + col) = (u32x2){pk2(acc[mt][nt].x, acc[mt][nt].y), pk2(acc[mt][nt].z, acc[mt][nt].w)};
            }
    }
}

__device__ __forceinline__ unsigned f2ord(float f) { const unsigned u = __float_as_uint(f); return (u & 0x80000000u) ? ~u : (u | 0x80000000u); }
__device__ __forceinline__ float ord2f(unsigned k) { const unsigned u = (k & 0x80000000u) ? (k & 0x7fffffffu) : ~k; return __uint_as_float(u); }
__device__ __forceinline__ unsigned gmax16(unsigned v) {
    unsigned t;
    t = sxoru<1>(v); v = v > t ? v : t; t = sxoru<2>(v); v = v > t ? v : t; t = sxoru<4>(v); v = v > t ? v : t; t = sxoru<8>(v); v = v > t ? v : t;
    return v;
}
__device__ __forceinline__ float gsum16(float v) { v += sxor<1>(v); v += sxor<2>(v); v += sxor<4>(v); v += sxor<8>(v); return v; }
__device__ __forceinline__ float gelu_exact(float a) { return 0.5f * a * (1.0f + erff(a * 0.70710678118654752f)); }

__device__ __forceinline__ void phase_peer(const Params& p, int g, char* lds, int tile0, int ntile) {
    const Grp G = get_group(p, g);
    const int tid = otid(), lane = tid & 63, wid = tid >> 6, fr = lane & 15, fq = lane >> 4;
    const bf16_t* P = (const bf16_t*)(p.ws + WS_PROJ); const bf16_t* HB = (const bf16_t*)(p.ws + WS_HB);
    const bf16_t* K12 = (const bf16_t*)(p.ws + WS_K12);
    float* SC = (float*)lds;
    int* EIDX = (int*)(lds + 65536);
    float* GATE = (float*)(lds + 65536 + 4096);
    char* KL = lds + 73728;
    for (int i = tid; i < 2 * 128 * 16; i += NTHR) {
        const int r = i >> 4, ch = i & 15;
        *(u32x4*)(KL + r * 272 + ch * 16) = *(const u32x4*)(K12 + (size_t)r * 128 + ch * 8);
    }
    __syncthreads();
    for (int tile = tile0; tile < tile0 + ntile; ++tile) {
        const int tok0 = tile * 8;
        {
            const bf16_t* qtok = P + (size_t)(tok0 + wid) * NP + (fr & 7) * 256;
#pragma unroll
            for (int half = 0; half < 2; ++half) {
                f32x4 acc[8];
#pragma unroll
                for (int i = 0; i < 8; ++i) acc[i] = (f32x4){0.f, 0.f, 0.f, 0.f};
#pragma unroll
                for (int ks = 0; ks < 4; ++ks) {
                    const bf16x8 af = *(const bf16x8*)(qtok + half * 128 + ks * 32 + fq * 8);
#pragma unroll
                    for (int nt = 0; nt < 8; ++nt) { const bf16x8 bfv = *(const bf16x8*)(KL + (half * 128 + nt * 16 + fr) * 272 + ks * 64 + fq * 16); acc[nt] = mfma16(af, bfv, acc[nt]); }
                }
                if (fq < 2) {
#pragma unroll
                    for (int nt = 0; nt < 8; ++nt) {
                        float* dst = SC + (wid * 8 + fq * 4) * 256 + half * 128 + nt * 16 + fr;
                        dst[0] = acc[nt].x; dst[256] = acc[nt].y; dst[512] = acc[nt].z; dst[768] = acc[nt].w;
                    }
                }
            }
        }
        __builtin_amdgcn_wave_barrier();
        for (int pass = 0; pass < 2; ++pass) {
            const int row = wid * 8 + pass * 4 + fq, sl = fr, gb = fq * 16;
            float v1 = 0.f, v2 = 0.f; int i1 = 0, i2 = 0;
#pragma unroll
            for (int hf = 0; hf < 2; ++hf) {
                unsigned key[8];
#pragma unroll
                for (int i = 0; i < 8; ++i) { const int idx = sl + 16 * i; key[i] = (f2ord(SC[row * 256 + hf * 128 + idx]) & ~127u) | (unsigned)(127 - idx); }
                float sv = 0.f; int si = 0;
                for (int r = 0; r < 16; ++r) {
                    unsigned m = key[0];
#pragma unroll
                    for (int i = 1; i < 8; ++i) m = m > key[i] ? m : key[i];
                    m = gmax16(m);
                    if (sl == r) { sv = ord2f(m & ~127u); si = 127 - (int)(m & 127u); }
#pragma unroll
                    for (int i = 0; i < 8; ++i) key[i] = key[i] == m ? 0u : key[i];
                }
                if (hf == 0) { v1 = sv; i1 = si; } else { v2 = sv; i2 = si; }
            }
            int ptr = 0; float ts = 0.f; int pid = 0;
            for (int r = 0; r < 16; ++r) {
                const float v2p = __int_as_float(__builtin_amdgcn_ds_bpermute((gb + (ptr & 15)) << 2, __float_as_int(v2)));
                const unsigned key = ptr < 16 ? ((f2ord(v1 + v2p) & ~255u) | (unsigned)(255 - (sl * 16 + ptr))) : 0u;
                const unsigned m = gmax16(key);
                if (sl == r) { ts = ord2f(m & ~255u); pid = 255 - (int)(m & 255u); }
                if (key == m) ptr++;
            }
            const int e1 = __builtin_amdgcn_ds_bpermute((gb + (pid >> 4)) << 2, i1), e2 = __builtin_amdgcn_ds_bpermute((gb + (pid & 15)) << 2, i2);
            float mx = ts;
            mx = fmaxf(mx, sxor<1>(mx)); mx = fmaxf(mx, sxor<2>(mx)); mx = fmaxf(mx, sxor<4>(mx)); mx = fmaxf(mx, sxor<8>(mx));
            const float ex = __expf(ts - mx), sm = gsum16(ex);
            EIDX[row * 16 + sl] = e1 * 128 + e2; GATE[row * 16 + sl] = ex / sm;
        }
        __builtin_amdgcn_wave_barrier();
        {
            const int tok = tok0 + wid;
            const bf16_t* hrow = HB + (size_t)tok * D;
            const int grp = lane >> 4, sl = lane & 15;
            {
                f32x2 hv[32];
#pragma unroll
                for (int c = 0; c < 8; ++c) {
                    const u32x4 hq = *(const u32x4*)(hrow + sl * 64 + c * 8);
                    hv[c * 4 + 0] = (f32x2){bflo(hq.x), bfhi(hq.x)} * (1.0f / PEER_SU); hv[c * 4 + 1] = (f32x2){bflo(hq.y), bfhi(hq.y)} * (1.0f / PEER_SU);
                    hv[c * 4 + 2] = (f32x2){bflo(hq.z), bfhi(hq.z)} * (1.0f / PEER_SU); hv[c * 4 + 3] = (f32x2){bflo(hq.w), bfhi(hq.w)} * (1.0f / PEER_SU);
                }
                const unsigned char* PU8 = p.ws + WS_PU + sl * 64;
#pragma unroll 2
                for (int it = 0; it < 32; ++it) {
                    const int k = it * 4 + grp;
                    const int e = EIDX[wid * 128 + k]; const float gt = GATE[wid * 128 + k];
                    const unsigned char* ur = PU8 + (size_t)e * D;
                    const u32x4 u0 = *(const u32x4*)ur, u1 = *(const u32x4*)(ur + 16), u2 = *(const u32x4*)(ur + 32), u3 = *(const u32x4*)(ur + 48);
                    f32x2 a2 = (f32x2){0.f, 0.f}, b2 = (f32x2){0.f, 0.f};
#define PDOT(uq, base) \
                    a2 += __builtin_amdgcn_cvt_pk_f32_fp8((int)uq.x, false) * hv[base + 0]; b2 += __builtin_amdgcn_cvt_pk_f32_fp8((int)uq.x, true) * hv[base + 1]; \
                    a2 += __builtin_amdgcn_cvt_pk_f32_fp8((int)uq.y, false) * hv[base + 2]; b2 += __builtin_amdgcn_cvt_pk_f32_fp8((int)uq.y, true) * hv[base + 3]; \
                    a2 += __builtin_amdgcn_cvt_pk_f32_fp8((int)uq.z, false) * hv[base + 4]; b2 += __builtin_amdgcn_cvt_pk_f32_fp8((int)uq.z, true) * hv[base + 5]; \
                    a2 += __builtin_amdgcn_cvt_pk_f32_fp8((int)uq.w, false) * hv[base + 6]; b2 += __builtin_amdgcn_cvt_pk_f32_fp8((int)uq.w, true) * hv[base + 7];
                    PDOT(u0, 0) PDOT(u1, 8) PDOT(u2, 16) PDOT(u3, 24)
#undef PDOT
                    a2 += b2;
                    const float a = gsum16(a2.x + a2.y);
                    GATE[wid * 128 + k] = gt * gelu_exact(a);
                }
            }
            __builtin_amdgcn_wave_barrier();
            f32x2 acc[8];
#pragma unroll
            for (int i = 0; i < 8; ++i) acc[i] = (f32x2){0.f, 0.f};
            const unsigned char* PV8 = p.ws + WS_PV + lane * 16;
#pragma unroll 8
            for (int k = 0; k < 128; ++k) {
                const int e = EIDX[wid * 128 + k]; const float w = GATE[wid * 128 + k];
                const u32x4 v = *(const u32x4*)(PV8 + (size_t)e * D);
                const f32x2 w2 = (f32x2){w, w};
                acc[0] += w2 * __builtin_amdgcn_cvt_pk_f32_fp8((int)v.x, false); acc[1] += w2 * __builtin_amdgcn_cvt_pk_f32_fp8((int)v.x, true);
                acc[2] += w2 * __builtin_amdgcn_cvt_pk_f32_fp8((int)v.y, false); acc[3] += w2 * __builtin_amdgcn_cvt_pk_f32_fp8((int)v.y, true);
                acc[4] += w2 * __builtin_amdgcn_cvt_pk_f32_fp8((int)v.z, false); acc[5] += w2 * __builtin_amdgcn_cvt_pk_f32_fp8((int)v.z, true);
                acc[6] += w2 * __builtin_amdgcn_cvt_pk_f32_fp8((int)v.w, false); acc[7] += w2 * __builtin_amdgcn_cvt_pk_f32_fp8((int)v.w, true);
            }
            float* orow = G.out + (size_t)tok * D + lane * 16;
#pragma unroll
            for (int i = 0; i < 4; ++i) {
                f32x4 t = *(f32x4*)(orow + i * 4);
                t.x += acc[2 * i].x * (1.0f / PEER_SV); t.y += acc[2 * i].y * (1.0f / PEER_SV); t.z += acc[2 * i + 1].x * (1.0f / PEER_SV); t.w += acc[2 * i + 1].y * (1.0f / PEER_SV);
                *(f32x4*)(orow + i * 4) = t;
            }
        }
        __builtin_amdgcn_wave_barrier();
    }
}


constexpr int NPH = 3 + NGROUP * 3;
__device__ __forceinline__ void run_phase(const Params& p, int ph, char* lds, int* s_item) {
    const int g = (ph - 3) / 3, s = (ph - 3) % 3;
    const Grp G = get_group(p, g);
    if (s == 0) {
        for (int u = blockIdx.x; u < 256; u += gridDim.x) {
            const int m0 = (u >> 1) * 256;
            phase_rmsnorm(G.x, p.in[I_GMIX], (bf16_t*)(p.ws + WS_HB), m0, 256);
            __syncthreads();
            phase_inproj(p, g, lds, u);
            __syncthreads();
        }
    } else if (s == 1) {
        phase_mixer(p, g, lds, s_item);
    } else {
        for (int u = blockIdx.x; u < 256; u += gridDim.x) {
            const int m0 = u * 128;
            phase_glafin(p, g, m0, 128);
            __syncthreads();
            phase_merge(p, g, lds, u);
            __syncthreads();
            phase_outproj(p, g, lds, u);
            __syncthreads();
            phase_rmsnorm(G.out, p.in[I_GFFN], (bf16_t*)(p.ws + WS_HB), m0, 128);
            __syncthreads();
            phase_peerq(p, g, lds, u);
            __syncthreads();
            phase_peer(p, g, lds, m0 / 8, 16);
            __syncthreads();
        }
    }
}

__global__ void __launch_bounds__(NTHR) mega_kernel(Params p) {
    extern __shared__ __attribute__((aligned(16))) char lds[];
    __shared__ int s_item;
    cg::grid_group grid = cg::this_grid();
    phase_p0a(p, lds); grid.sync();
    phase_p0b(p, lds); grid.sync();
    phase_p0c(p); grid.sync();
    for (int ph = 3; ph < NPH; ++ph) {
        run_phase(p, ph, lds, &s_item);
        if (ph + 1 < NPH) grid.sync();
    }
}

extern "C" void kernel_launch(void* const* d_in, const int* in_sizes, int n_in, void* d_out, int out_size, void* d_ws, size_t ws_size, hipStream_t stream) {
    static int grid_blocks = 0;
    if (grid_blocks == 0) {
        if (n_in != 32 || ws_size < WS_END) { fprintf(stderr, "kernel_launch: unexpected n_in %d or ws_size %zu (< %zu)\n", n_in, ws_size, (size_t)WS_END); grid_blocks = -1; return; }
        int dev = 0, cus = 0, per_cu = 0;
        hipGetDevice(&dev);
        hipDeviceGetAttribute(&cus, hipDeviceAttributeMultiprocessorCount, dev);
        hipFuncSetAttribute((const void*)mega_kernel, hipFuncAttributeMaxDynamicSharedMemorySize, LDS_BYTES);
        hipOccupancyMaxActiveBlocksPerMultiprocessor(&per_cu, (const void*)mega_kernel, NTHR, LDS_BYTES);
        if (per_cu < 1) per_cu = 1;
        grid_blocks = cus * per_cu;
        (void)hipGetLastError();
    }
    if (grid_blocks < 0) return;
    Params p{};
    for (int i = 0; i < 32; ++i) p.in[i] = (const float*)d_in[i];
    p.out = (float*)d_out; p.ws = (unsigned char*)d_ws; p.ph_lo = 0; p.ph_hi = NPH;
    void* args[] = {&p};
    hipError_t e = hipLaunchCooperativeKernel((const void*)mega_kernel, dim3(grid_blocks), dim3(NTHR), args, LDS_BYTES, stream);
    if (e != hipSuccess) fprintf(stderr, "cooperative launch failed: %s (grid %d)\n", hipGetErrorString(e), grid_blocks);
}
```

```cpp
#include <hip/hip_runtime.h>
#include <hip/hip_cooperative_groups.h>
#include <cstdio>
#include <cstdint>
namespace cg = cooperative_groups;

typedef unsigned short bf16_t;
typedef short bf16x8 __attribute__((ext_vector_type(8)));
typedef float f32x4 __attribute__((ext_vector_type(4)));
typedef unsigned u32x4 __attribute__((ext_vector_type(4)));
typedef unsigned u32x2 __attribute__((ext_vector_type(2)));

constexpr int D = 1024;
constexpr int NP = 10496;
constexpr int IN_COLS = 10272;
constexpr int C_GQ = 0, C_GK = 512, C_GV = 1024, C_GG = 2048, C_DQ = 3072, C_DK = 4096, C_DV = 5120, C_MQ = 6144, C_BG = 7168, C_LR = 10240;
constexpr int G_TOK = 32768;
constexpr int NGROUP = 3;
constexpr int NTHR = 512;
constexpr float RMS_EPS = 1e-6f;
constexpr float LOG2E = 1.4426950408889634f;
constexpr int LDS_BYTES = 147456;
constexpr float PEER_SU = 32.0f, PEER_SV = 8.0f;

enum { I_XP = 0, I_XS, I_MP, I_MS, I_GMIX, I_WIN, I_WDF, I_BDF, I_WDB, I_BDB, I_GOUT, I_GWO, I_DGQ, I_DGK, I_LQ1, I_LK1, I_LQ2, I_LK2,
       I_DGSUB, I_DWO, I_MGN, I_MWKV, I_MGQ, I_MGK, I_MWO, I_WOUT, I_GFFN, I_PWQ, I_PK1, I_PK2, I_PU, I_PV };

constexpr size_t al256(size_t x) { return (x + 255) & ~(size_t)255; }
constexpr size_t WS_CTRL = 0;
constexpr size_t WS_PROJ = 4096;
constexpr size_t WS_HB   = WS_PROJ + (size_t)G_TOK * NP * 2;
constexpr size_t WS_VT   = WS_HB + (size_t)G_TOK * D * 2;
constexpr size_t WS_WINT = WS_VT + (size_t)G_TOK * D * 2;
constexpr size_t WS_WOT  = WS_WINT + (size_t)NP * D * 2;
constexpr size_t WS_WKVT = WS_WOT + (size_t)4 * D * D * 2;
constexpr size_t WS_WQT  = WS_WKVT + (size_t)2048 * D * 2;
constexpr size_t WS_PU   = WS_WQT + (size_t)2048 * D * 2;
constexpr size_t WS_PV   = WS_PU + (size_t)16384 * D * 2;
constexpr size_t WS_K12  = WS_PV + (size_t)16384 * D * 2;
constexpr size_t WS_ROPE = WS_K12 + (size_t)2 * 128 * 128 * 2;
constexpr size_t WS_HM   = WS_ROPE + (size_t)16384 * 64 * 4;
constexpr size_t WS_KVR  = WS_HM + (size_t)2560 * D * 2;
constexpr size_t WS_MEMK = WS_KVR + (size_t)2560 * 2048 * 4;
constexpr size_t WS_MEMV = WS_MEMK + (size_t)10 * 4 * 256 * 256 * 2;
constexpr size_t WS_END  = WS_MEMV + (size_t)10 * 4 * 256 * 256 * 2;

struct Params {
    const float* in[32];
    float* out;
    unsigned char* ws;
    int ph_lo, ph_hi;
};

typedef float f32x2 __attribute__((ext_vector_type(2)));
typedef __bf16 bf16x2v __attribute__((ext_vector_type(2)));
__device__ __forceinline__ unsigned pk2(float lo, float hi) { const f32x2 v = {lo, hi}; const bf16x2v b = __builtin_convertvector(v, bf16x2v); return __builtin_bit_cast(unsigned, b); }
__device__ __forceinline__ float bflo(unsigned u) { return __uint_as_float(u << 16); }
__device__ __forceinline__ float bfhi(unsigned u) { return __uint_as_float(u & 0xffff0000u); }
__device__ __forceinline__ float bf2f(bf16_t b) { return __uint_as_float(((unsigned)b) << 16); }
__device__ __forceinline__ bf16_t f2bf(float f) { return (bf16_t)(pk2(f, 0.f) & 0xffffu); }
__device__ __forceinline__ f32x4 mfma16(bf16x8 a, bf16x8 b, f32x4 c) { return __builtin_amdgcn_mfma_f32_16x16x32_bf16(a, b, c, 0, 0, 0); }
__device__ __forceinline__ float fexp2(float x) { return __builtin_amdgcn_exp2f(x); }
template <class T> __device__ __forceinline__ T* launder(T* q) { asm volatile("" : "+s"(q)); return q; }
__device__ __forceinline__ int otid() { int t = threadIdx.x; asm volatile("" : "+v"(t)); return t; }
template <int M> __device__ __forceinline__ float sxor(float v) {
    if (M < 32) return __int_as_float(__builtin_amdgcn_ds_swizzle(__float_as_int(v), (M << 10) | 0x1F));
    const int l = otid() & 63; return __int_as_float(__builtin_amdgcn_ds_bpermute((l ^ 32) << 2, __float_as_int(v)));
}
template <int M> __device__ __forceinline__ unsigned sxoru(unsigned v) { return (unsigned)__builtin_amdgcn_ds_swizzle((int)v, (M << 10) | 0x1F); }
__device__ __forceinline__ float wave_sum(float v) {
    v += sxor<1>(v); v += sxor<2>(v); v += sxor<4>(v); v += sxor<8>(v); v += sxor<16>(v); v += sxor<32>(v);
    return v;
}

struct Grp { const float* x; const float* mem; float* out; int B, T, mb0; };
__device__ __forceinline__ Grp get_group(const Params& p, int g) {
    Grp r;
    if (g == 0) { r.x = p.in[I_XP]; r.out = p.out; r.B = 2; r.T = 16384; r.mb0 = 0; }
    else { r.x = p.in[I_XS] + (size_t)(g - 1) * G_TOK * D; r.out = p.out + (size_t)g * G_TOK * D; r.B = 4; r.T = 8192; r.mb0 = 2 + (g - 1) * 4; }
    r.mem = nullptr;
    return r;
}

constexpr int G_ROW = 144;
constexpr int G_A_BYTES = 128 * G_ROW;
constexpr int G_B_BYTES = 256 * G_ROW;
constexpr int G_STAGE = G_A_BYTES + G_B_BYTES;

template <bool SWAP, int MT>
__device__ __forceinline__ void gemm_kloop(f32x4 (&acc)[MT][4], const bf16_t* __restrict__ A, int lda, const bf16_t* __restrict__ Bt, int ldb, int K, char* lds) {
    constexpr int A_ROWS = MT * 32, A_BYTES = A_ROWS * G_ROW, STAGE = A_BYTES + G_B_BYTES;
    constexpr int NA = A_BYTES / 1024, NI = STAGE / 1024, NPER = (NI + 7) / 8;
    const int tid = otid(), lane = tid & 63, wid = __builtin_amdgcn_readfirstlane(tid >> 6), wm = wid >> 2, wn = wid & 3, fr = lane & 15, fq = lane >> 4;
    unsigned goff[NPER];
#pragma unroll
    for (int i = 0; i < NPER; ++i) {
        const int j = wid + 8 * i;
        const int ci = (j < NA ? j : j - NA) * 64 + lane, row = ci / 9, ch = ci % 9, chc = ch < 8 ? ch : 7;
        goff[i] = (unsigned)(row * (j < NA ? lda : ldb) + chc * 8);
    }
#define GSTAGE(buf, k0) do { _Pragma("unroll") for (int i = 0; i < NPER; ++i) { const int j = wid + 8 * i; if (j < NI) { \
        const bf16_t* src_ = (j < NA ? A : Bt) + goff[i] + (k0); \
        __builtin_amdgcn_global_load_lds((const unsigned*)src_, (unsigned*)(lds + (buf) * STAGE + j * 1024), 16, 0, 0); } } } while (0)
    const int nk = K / 64;
    GSTAGE(0, 0);
    __syncthreads();
    for (int kt = 0; kt < nk; ++kt) {
        if (kt + 1 < nk) GSTAGE((kt + 1) & 1, (kt + 1) * 64);
        const char* base = lds + (kt & 1) * STAGE;
        const char* abase = base + (wm * (MT * 16) + fr) * G_ROW + fq * 16;
        const char* bbase = base + A_BYTES + (wn * 64 + fr) * G_ROW + fq * 16;
        bf16x8 b0[4], b1[4], ar[4];
#pragma unroll
        for (int nt = 0; nt < 4; ++nt) b0[nt] = *(const bf16x8*)(bbase + nt * 16 * G_ROW);
        ar[0] = *(const bf16x8*)(abase); ar[1] = *(const bf16x8*)(abase + 16 * G_ROW); ar[2] = *(const bf16x8*)(abase + 32 * G_ROW);
#pragma unroll
        for (int st = 0; st < 2 * MT; ++st) {
            const int ks = st / MT, mt = st % MT;
            __builtin_amdgcn_sched_barrier(0);
            if (st + 3 < 2 * MT) { const int ks2 = (st + 3) / MT, mt2 = (st + 3) % MT; ar[(st + 3) % 4] = *(const bf16x8*)(abase + mt2 * 16 * G_ROW + ks2 * 64); }
            if (ks == 0 && mt >= MT - 3 && mt < MT - 1) {
#pragma unroll
                for (int q = 0; q < 2; ++q) { const int nt = (mt - (MT - 3)) * 2 + q; b1[nt] = *(const bf16x8*)(bbase + nt * 16 * G_ROW + 64); }
            }
#pragma unroll
            for (int nt = 0; nt < 4; ++nt) {
                const bf16x8 bv = ks == 0 ? b0[nt] : b1[nt];
                acc[mt][nt] = SWAP ? mfma16(bv, ar[st % 4], acc[mt][nt]) : mfma16(ar[st % 4], bv, acc[mt][nt]);
            }
        }
        __builtin_amdgcn_sched_barrier(0);
        __syncthreads();
    }
#undef GSTAGE
}

__device__ __forceinline__ void tile_order(int t, int nM, int nN, int& pm, int& pn) {
    const int per = 8 * nN, grp = t / per, r = t % per;
    pm = grp * 8 + (r & 7); pn = r >> 3;
}

__device__ __forceinline__ void phase_p0a(const Params& p, char* lds) {
    const int tid = otid(), lane = tid & 63, wid = tid >> 6;
    unsigned char* ws = p.ws;
    if (blockIdx.x == 0 && tid < 256) atomicExch((unsigned*)(ws + WS_CTRL) + tid, 0u);
    float* scr = (float*)(lds + wid * 8448);
    constexpr int IT_WIN = 16 * (NP / 32), IT_SQ = 16 * 32, IT_W2 = 16 * 64;
    constexpr int NIT = IT_WIN + 4 * IT_SQ + 2 * IT_W2;
    for (int it0 = blockIdx.x * 8; it0 < NIT; it0 += gridDim.x * 8) {
        int it = it0 + wid;
        const float* W = nullptr; bf16_t* WT = nullptr; int N = 0, nb = 0, kb = 0, srccol = -1;
        if (it < NIT) {
            int r = it;
            if (r < IT_WIN) { W = p.in[I_WIN]; N = IN_COLS; WT = (bf16_t*)(ws + WS_WINT); kb = r / (NP / 32); nb = r % (NP / 32);
                const int n0 = nb * 32; srccol = n0 < 3072 ? n0 : (n0 < 10240 ? n0 + 32 : (n0 == 10240 ? 3072 : -1)); }
            else { r -= IT_WIN;
                if (r < 4 * IT_SQ) { const int w = r / IT_SQ; r %= IT_SQ; const int idx[4] = {I_GWO, I_DWO, I_MWO, I_WOUT};
                    W = p.in[w == 0 ? I_GWO : (w == 1 ? I_DWO : (w == 2 ? I_MWO : I_WOUT))]; (void)idx; N = 1024; WT = (bf16_t*)(ws + WS_WOT) + (size_t)w * D * D; kb = r / 32; nb = r % 32; srccol = nb * 32; }
                else { r -= 4 * IT_SQ; const int w = r / IT_W2; r %= IT_W2; W = p.in[w == 0 ? I_MWKV : I_PWQ]; N = 2048; WT = (bf16_t*)(ws + (w == 0 ? WS_WKVT : WS_WQT)); kb = r / 64; nb = r % 64; srccol = nb * 32; }
            }
            const int k0 = kb * 64;
#pragma unroll 8
            for (int i = 0; i < 32; ++i) { const int kk = 2 * i + (lane >> 5); scr[kk * 33 + (lane & 31)] = srccol >= 0 ? W[(size_t)(k0 + kk) * N + srccol + (lane & 31)] : 0.f; }
        }
        __syncthreads();
        if (it < NIT) {
            const int k0 = kb * 64, c = lane & 7;
#pragma unroll
            for (int j = 0; j < 4; ++j) { const int n = (lane >> 3) + 8 * j; const float* s = scr + (8 * c) * 33 + n;
                u32x4 o; o.x = pk2(s[0], s[33]); o.y = pk2(s[66], s[99]); o.z = pk2(s[132], s[165]); o.w = pk2(s[198], s[231]);
                *(u32x4*)(WT + (size_t)(nb * 32 + n) * D + k0 + 8 * c) = o; }
        }
        __syncthreads();
    }
    const size_t gtid = (size_t)blockIdx.x * NTHR + tid, gsz = (size_t)gridDim.x * NTHR;
    {
        const size_t n8 = (size_t)16384 * D / 8;
        for (size_t i = gtid; i < 2 * n8; i += gsz) {
            const int w = i >= n8; const size_t j = w ? i - n8 : i;
            const float* src = p.in[w ? I_PV : I_PU] + j * 8; unsigned char* dst = ws + (w ? WS_PV : WS_PU) + j * 8;
            const float sc = w ? PEER_SV : PEER_SU;
            const f32x4 a = *(const f32x4*)src * sc, b = *(const f32x4*)(src + 4) * sc;
            int lo = __builtin_amdgcn_cvt_pk_fp8_f32(a.x, a.y, 0, false); lo = __builtin_amdgcn_cvt_pk_fp8_f32(a.z, a.w, lo, true);
            int hi = __builtin_amdgcn_cvt_pk_fp8_f32(b.x, b.y, 0, false); hi = __builtin_amdgcn_cvt_pk_fp8_f32(b.z, b.w, hi, true);
            *(u32x2*)dst = (u32x2){(unsigned)lo, (unsigned)hi};
        }
        for (size_t i = gtid; i < 2 * 16384; i += gsz) {
            const int w = i >= 16384; const size_t j = w ? i - 16384 : i;
            ((bf16_t*)(ws + WS_K12))[i] = f2bf(p.in[w ? I_PK2 : I_PK1][j]);
        }
    }
    for (size_t i = gtid; i < (size_t)16384 * 32; i += gsz) {
        const int t = (int)(i >> 5), k = (int)(i & 31);
        const float inv = powf(10000.0f, -(float)(2 * k) / 64.0f);
        const float ang = (float)t * inv;
        double sn, cs; sincos((double)ang, &sn, &cs);
        float* R = (float*)(ws + WS_ROPE) + (size_t)t * 64;
        R[k] = (float)cs; R[32 + k] = (float)sn;
    }
    for (int row = blockIdx.x * 8 + wid; row < 2560; row += gridDim.x * 8) {
        const float* src = row < 512 ? p.in[I_MP] + (size_t)row * D : p.in[I_MS] + (size_t)(row - 512) * D;
        const f32x4* xr = (const f32x4*)src + lane; const f32x4* gr = (const f32x4*)p.in[I_MGN] + lane;
        f32x4 v[4]; float s = 0.f;
#pragma unroll
        for (int j = 0; j < 4; ++j) { v[j] = xr[64 * j]; s += v[j].x * v[j].x + v[j].y * v[j].y + v[j].z * v[j].z + v[j].w * v[j].w; }
        const float r = rsqrtf(wave_sum(s) * (1.f / D) + RMS_EPS);
        u32x2* o = (u32x2*)((bf16_t*)(ws + WS_HM) + (size_t)row * D) + lane;
#pragma unroll
        for (int j = 0; j < 4; ++j) { const f32x4 g = gr[64 * j]; u32x2 w; w.x = pk2(v[j].x * r * g.x, v[j].y * r * g.y); w.y = pk2(v[j].z * r * g.z, v[j].w * r * g.w); o[64 * j] = w; }
    }
}

__device__ __forceinline__ void phase_p0b(const Params& p, char* lds) {
    const int tid_ = otid(), lane = tid_ & 63, wid = tid_ >> 6, wm = wid >> 2, wn = wid & 3, fr = lane & 15, fq = lane >> 4;
    const bf16_t* A = (const bf16_t*)(p.ws + WS_HM); const bf16_t* Bt = (const bf16_t*)(p.ws + WS_WKVT);
    float* C = (float*)(p.ws + WS_KVR);
    const int nM = 20, nN = 8;
    for (int t = blockIdx.x; t < nM * nN; t += gridDim.x) {
        const int pm = t % nM, pn = t / nM, m0 = pm * 128, n0 = pn * 256;
        f32x4 acc[4][4];
#pragma unroll
        for (int i = 0; i < 4; ++i)
#pragma unroll
            for (int j = 0; j < 4; ++j) acc[i][j] = (f32x4){0.f, 0.f, 0.f, 0.f};
        gemm_kloop<true, 4>(acc, A + (size_t)m0 * D, D, Bt + (size_t)n0 * D, D, D, lds);
#pragma unroll
        for (int mt = 0; mt < 4; ++mt)
#pragma unroll
            for (int nt = 0; nt < 4; ++nt) {
                const int row = m0 + wm * 64 + mt * 16 + fr, col = n0 + wn * 64 + nt * 16 + fq * 4;
                *(f32x4*)(C + (size_t)row * 2048 + col) = acc[mt][nt];
            }
    }
}

__device__ __forceinline__ void phase_p0c(const Params& p) {
    const int tid_ = otid(), lane = tid_ & 63, wid = tid_ >> 6;
    const float* KV = (const float*)(p.ws + WS_KVR);
    bf16_t* MK = (bf16_t*)(p.ws + WS_MEMK); bf16_t* MV = (bf16_t*)(p.ws + WS_MEMV);
    for (int it = blockIdx.x * 8 + wid; it < 2560 * 4; it += gridDim.x * 8) {
        const int row = it >> 2, h = it & 3, b = row >> 8, m = row & 255;
        const f32x4 kv = *(const f32x4*)(KV + (size_t)row * 2048 + h * 256 + lane * 4);
        const float ss = wave_sum(kv.x * kv.x + kv.y * kv.y + kv.z * kv.z + kv.w * kv.w);
        const float r = rsqrtf(ss * (1.f / 256.f) + RMS_EPS);
        const f32x4 g = *(const f32x4*)(p.in[I_MGK] + lane * 4);
        u32x2 w; w.x = pk2(kv.x * r * g.x, kv.y * r * g.y); w.y = pk2(kv.z * r * g.z, kv.w * r * g.w);
        *(u32x2*)(MK + ((size_t)(b * 4 + h) * 256 + m) * 256 + lane * 4) = w;
        const f32x4 vv = *(const f32x4*)(KV + (size_t)row * 2048 + 1024 + h * 256 + lane * 4);
        const int pos = (m & ~31) + ((m >> 2) & 3) * 8 + ((m >> 4) & 1) * 4 + (m & 3);
        bf16_t* dst = MV + ((size_t)(b * 4 + h) * 256 + lane * 4) * 256 + pos;
        dst[0] = f2bf(vv.x); dst[256] = f2bf(vv.y); dst[512] = f2bf(vv.z); dst[768] = f2bf(vv.w);
    }
}

__device__ __forceinline__ void phase_rmsnorm(const float* X, const float* gain, bf16_t* O, int row0, int nrows) {
    const int tid_ = otid(), lane = tid_ & 63, wid = tid_ >> 6;
    const f32x4* gr = (const f32x4*)launder(gain) + lane;
    f32x4 g[4];
#pragma unroll
    for (int j = 0; j < 4; ++j) g[j] = gr[64 * j];
    for (int row = row0 + wid; row < row0 + nrows; row += 8) {
        const f32x4* xr = (const f32x4*)(X + (size_t)row * D) + lane;
        f32x4 v[4]; float s = 0.f;
#pragma unroll
        for (int j = 0; j < 4; ++j) { v[j] = xr[64 * j]; s += v[j].x * v[j].x + v[j].y * v[j].y + v[j].z * v[j].z + v[j].w * v[j].w; }
        const float r = rsqrtf(wave_sum(s) * (1.f / D) + RMS_EPS);
        u32x2* o = (u32x2*)(O + (size_t)row * D) + lane;
#pragma unroll
        for (int j = 0; j < 4; ++j) { u32x2 w; w.x = pk2(v[j].x * r * g[j].x, v[j].y * r * g[j].y); w.y = pk2(v[j].z * r * g[j].z, v[j].w * r * g[j].w); o[64 * j] = w; }
    }
}

__device__ __forceinline__ void phase_inproj(const Params& p, int g, char* lds, int u) {
    const Grp G = get_group(p, g);
    const int tid_ = otid(), lane = tid_ & 63, wid = tid_ >> 6, wm = wid >> 2, wn = wid & 3, fr = lane & 15, fq = lane >> 4;
    const bf16_t* A = (const bf16_t*)(p.ws + WS_HB); const bf16_t* Bt = (const bf16_t*)(p.ws + WS_WINT);
    bf16_t* P = (bf16_t*)(p.ws + WS_PROJ); bf16_t* VT = (bf16_t*)(p.ws + WS_VT);
    const int pm = u >> 1, half = u & 1, m0 = pm * 256;
    for (int pi = 0; pi < (half ? 17 : 12); ++pi) {
        const int pn = half ? 24 + pi : pi; const int n0 = pn * 256;
        f32x4 acc[8][4];
#pragma unroll
        for (int i = 0; i < 8; ++i)
#pragma unroll
            for (int j = 0; j < 4; ++j) acc[i][j] = (f32x4){0.f, 0.f, 0.f, 0.f};
        gemm_kloop<true, 8>(acc, A + (size_t)m0 * D, D, Bt + (size_t)n0 * D, D, D, lds);
        const float sc = n0 < 512 ? 0.08838834764831845f : 1.0f;
#pragma unroll
        for (int mt = 0; mt < 8; ++mt)
#pragma unroll
            for (int nt = 0; nt < 4; ++nt) {
                const int row = m0 + wm * 128 + mt * 16 + fr, col = n0 + wn * 64 + nt * 16 + fq * 4;
                u32x2 w; w.x = pk2(acc[mt][nt].x * sc, acc[mt][nt].y * sc); w.y = pk2(acc[mt][nt].z * sc, acc[mt][nt].w * sc);
                *(u32x2*)(P + (size_t)row * NP + col) = w;
            }
    }
    if (half == 0) for (int pn = 12; pn < 20; ++pn) {
        const int n0 = pn * 256;
        f32x4 acc[8][4];
#pragma unroll
        for (int i = 0; i < 8; ++i)
#pragma unroll
            for (int j = 0; j < 4; ++j) acc[i][j] = (f32x4){0.f, 0.f, 0.f, 0.f};
        gemm_kloop<true, 8>(acc, A + (size_t)m0 * D, D, Bt + (size_t)n0 * D, D, D, lds);
        const int te_ = otid(), fr = te_ & 15, fq = (te_ >> 4) & 3, wm = te_ >> 8, wn = (te_ >> 6) & 3;
        const bool isk = n0 >= C_DK;
        const float* gn = launder(p.in[isk ? I_DGK : I_DGQ]) + fq * 4;
        const float qs = isk ? 1.0f : 0.125f * LOG2E;
        const float* ROPE = (const float*)(p.ws + WS_ROPE);
        const int tq0 = m0 % G.T + wm * 128 + fr;
#pragma unroll
        for (int mt = 0; mt < 8; ++mt) {
            const int row = m0 + wm * 128 + mt * 16 + fr, t = tq0 + mt * 16;
            float ss = 0.f;
#pragma unroll
            for (int nt = 0; nt < 4; ++nt) ss += acc[mt][nt].x * acc[mt][nt].x + acc[mt][nt].y * acc[mt][nt].y + acc[mt][nt].z * acc[mt][nt].z + acc[mt][nt].w * acc[mt][nt].w;
            ss += sxor<16>(ss); ss += sxor<32>(ss);
            const float r = rsqrtf(ss * (1.f / 64.f) + RMS_EPS) * qs;
            const float* rp = ROPE + (size_t)t * 64 + fq * 4;
            bf16_t* dst = P + (size_t)row * NP + n0 + wn * 64 + fq * 4;
#pragma unroll
            for (int hh = 0; hh < 2; ++hh) {
                const f32x4 cs = *(const f32x4*)(rp + hh * 16), sn = *(const f32x4*)(rp + 32 + hh * 16);
                const f32x4 ya = acc[mt][hh] * *(const f32x4*)(gn + hh * 16) * r, yb = acc[mt][hh + 2] * *(const f32x4*)(gn + 32 + hh * 16) * r;
                const f32x4 oa = ya * cs - yb * sn, ob = yb * cs + ya * sn;
                *(u32x2*)(dst + hh * 16) = (u32x2){pk2(oa.x, oa.y), pk2(oa.z, oa.w)};
                *(u32x2*)(dst + 32 + hh * 16) = (u32x2){pk2(ob.x, ob.y), pk2(ob.z, ob.w)};
            }
        }
    }
    for (int pn = half ? 21 : 20; pn < (half ? 24 : 21); ++pn) {
        const int n0 = pn * 256;
        f32x4 acc[8][4];
#pragma unroll
        for (int i = 0; i < 8; ++i)
#pragma unroll
            for (int j = 0; j < 4; ++j) acc[i][j] = (f32x4){0.f, 0.f, 0.f, 0.f};
        gemm_kloop<false, 8>(acc, A + (size_t)m0 * D, D, Bt + (size_t)n0 * D, D, D, lds);
        const int b = m0 / G.T, t0 = m0 % G.T + wm * 128;
#pragma unroll
        for (int mt = 0; mt < 8; ++mt)
#pragma unroll
            for (int nt = 0; nt < 4; ++nt) {
                const int n = n0 - C_DV + wn * 64 + nt * 16 + fr, h = n >> 7, dv = n & 127;
                const int pos = t0 + (mt >> 1) * 32 + fq * 8 + (mt & 1) * 4;
                u32x2 w; w.x = pk2(acc[mt][nt].x, acc[mt][nt].y); w.y = pk2(acc[mt][nt].z, acc[mt][nt].w);
                *(u32x2*)(VT + ((size_t)((b * 8 + h) * 128 + dv)) * G.T + pos) = w;
            }
    }
}

__device__ __forceinline__ void phase_qkrope(const Params& p, int g, int tok0, int ntok) {
    const Grp G = get_group(p, g);
    const int tid_ = otid(), lane = tid_ & 63, wid = tid_ >> 6, grp = lane >> 2, sub = lane & 3;
    bf16_t* P = (bf16_t*)(p.ws + WS_PROJ); const float* ROPE = (const float*)(p.ws + WS_ROPE);
    for (int it = tok0 * 2 + wid; it < (tok0 + ntok) * 2; it += 8) {
        const int tok = it >> 1, isk = it & 1, t = tok % G.T;
        bf16_t* base = P + (size_t)tok * NP + (isk ? C_DK : C_DQ) + grp * 64 + sub * 8;
        const u32x4 a = *(const u32x4*)base, b = *(const u32x4*)(base + 32);
        float x1[8], x2[8];
        x1[0] = bflo(a.x); x1[1] = bfhi(a.x); x1[2] = bflo(a.y); x1[3] = bfhi(a.y); x1[4] = bflo(a.z); x1[5] = bfhi(a.z); x1[6] = bflo(a.w); x1[7] = bfhi(a.w);
        x2[0] = bflo(b.x); x2[1] = bfhi(b.x); x2[2] = bflo(b.y); x2[3] = bfhi(b.y); x2[4] = bflo(b.z); x2[5] = bfhi(b.z); x2[6] = bflo(b.w); x2[7] = bfhi(b.w);
        float ss = 0.f;
#pragma unroll
        for (int e = 0; e < 8; ++e) ss += x1[e] * x1[e] + x2[e] * x2[e];
        ss += sxor<1>(ss); ss += sxor<2>(ss);
        const float r = rsqrtf(ss * (1.f / 64.f) + RMS_EPS) * (isk ? 1.0f : 0.125f * LOG2E);
        const float* gn = p.in[isk ? I_DGK : I_DGQ] + sub * 8;
        const float* rp = ROPE + (size_t)t * 64 + sub * 8;
        float o1[8], o2[8];
#pragma unroll
        for (int e = 0; e < 8; ++e) {
            const float y1 = x1[e] * r * gn[e], y2 = x2[e] * r * gn[32 + e], c = rp[e], s = rp[32 + e];
            o1[e] = y1 * c - y2 * s; o2[e] = y2 * c + y1 * s;
        }
        u32x4 w1, w2;
        w1.x = pk2(o1[0], o1[1]); w1.y = pk2(o1[2], o1[3]); w1.z = pk2(o1[4], o1[5]); w1.w = pk2(o1[6], o1[7]);
        w2.x = pk2(o2[0], o2[1]); w2.y = pk2(o2[2], o2[3]); w2.z = pk2(o2[4], o2[5]); w2.w = pk2(o2[6], o2[7]);
        *(u32x4*)base = w1; *(u32x4*)(base + 32) = w2;
    }
}

__device__ __forceinline__ void diff_attn_item(const Params& p, const Grp& G, int item, char* lds, float lam, float shift) {
    const int tid = otid(), lane = tid & 63, wid = tid >> 6, fr = lane & 15, fq = lane >> 4;
    const int c = wid & 1, sub = wid >> 1;
    const int T = G.T, nqb = T / 128;
    const int qb = item % nqb, bh = item / nqb, h = bh & 7, b = bh >> 3;
    bf16_t* P = (bf16_t*)(p.ws + WS_PROJ) + (size_t)b * T * NP;
    const bf16_t* Kg = P + C_DK + h * 128;
    const bf16_t* VTg = (const bf16_t*)(p.ws + WS_VT) + (size_t)bh * 128 * T;
    const int q0 = qb * 128 + sub * 32;
    bf16x8 qf[2][2];
#pragma unroll
    for (int nt = 0; nt < 2; ++nt)
#pragma unroll
        for (int ks = 0; ks < 2; ++ks) qf[nt][ks] = *(const bf16x8*)(P + (size_t)(q0 + nt * 16 + fr) * NP + C_DQ + h * 128 + c * 64 + ks * 32 + fq * 8);
    f32x4 o[8][2];
#pragma unroll
    for (int i = 0; i < 8; ++i) { o[i][0] = (f32x4){0.f, 0.f, 0.f, 0.f}; o[i][1] = (f32x4){0.f, 0.f, 0.f, 0.f}; }
    float l[2] = {0.f, 0.f};
    constexpr int STG = 36864, VOFF = 18432;
    u32x4 rk[2], rv[2];
    const int krow = tid >> 4, kch = tid & 15;
    const int vrow = tid >> 3, vch = tid & 7;
#define AGLOAD(kt) do { const int key0_ = (kt) * 64; \
        _Pragma("unroll") for (int i = 0; i < 2; ++i) rk[i] = *(const u32x4*)(Kg + (size_t)(key0_ + krow + i * 32) * NP + kch * 8); \
        _Pragma("unroll") for (int i = 0; i < 2; ++i) rv[i] = *(const u32x4*)(VTg + (size_t)(vrow + i * 64) * T + key0_ + vch * 8); } while (0)
#define ASWRITE(buf) do { char* b_ = lds + (buf) * STG; \
        _Pragma("unroll") for (int i = 0; i < 2; ++i) *(u32x4*)(b_ + ((kch >> 3) * 64 + krow + i * 32) * 144 + (kch & 7) * 16) = rk[i]; \
        _Pragma("unroll") for (int i = 0; i < 2; ++i) *(u32x4*)(b_ + VOFF + (vrow + i * 64) * 144 + vch * 16) = rv[i]; } while (0)
    const int nkt = T / 64;
#define EXPQ(SRC, NT, DSTP) do { const f32x4 a_ = SRC[0][NT], b_ = SRC[1][NT]; \
        const float p0 = fexp2(a_.x), p1 = fexp2(a_.y), p2 = fexp2(a_.z), p3 = fexp2(a_.w); \
        const float p4 = fexp2(b_.x), p5 = fexp2(b_.y), p6 = fexp2(b_.z), p7 = fexp2(b_.w); \
        l[NT] += ((p0 + p1) + (p2 + p3)) + ((p4 + p5) + (p6 + p7)); \
        u32x4 w_; w_.x = pk2(p0, p1); w_.y = pk2(p2, p3); w_.z = pk2(p4, p5); w_.w = pk2(p6, p7); \
        DSTP[NT] = __builtin_bit_cast(bf16x8, w_); } while (0)
#define SMMA1(DST, I, MT, KBASE) do { \
        const bf16x8 k0_ = *(const bf16x8*)((KBASE) + (c * 64 + (MT) * 16 + fr) * 144 + fq * 16); \
        const bf16x8 k1_ = *(const bf16x8*)((KBASE) + (c * 64 + (MT) * 16 + fr) * 144 + 64 + fq * 16); \
        DST[I][0] = mfma16(k0_, qf[0][0], (f32x4){0.f, 0.f, 0.f, 0.f}); DST[I][1] = mfma16(k0_, qf[1][0], (f32x4){0.f, 0.f, 0.f, 0.f}); \
        DST[I][0] = mfma16(k1_, qf[0][1], DST[I][0]); DST[I][1] = mfma16(k1_, qf[1][1], DST[I][1]); } while (0)
#define PVMMA(DVT, KK, PF, VBASE) do { \
        const bf16x8 vf_ = *(const bf16x8*)((VBASE) + VOFF + ((DVT) * 16 + fr) * 144 + (KK) * 64 + fq * 16); \
        o[DVT][0] = mfma16(vf_, PF[0], o[DVT][0]); o[DVT][1] = mfma16(vf_, PF[1], o[DVT][1]); } while (0)
#define PV8(KK, PF, VBASE) do { PVMMA(0, KK, PF, VBASE); PVMMA(1, KK, PF, VBASE); PVMMA(2, KK, PF, VBASE); PVMMA(3, KK, PF, VBASE); \
        PVMMA(4, KK, PF, VBASE); PVMMA(5, KK, PF, VBASE); PVMMA(6, KK, PF, VBASE); PVMMA(7, KK, PF, VBASE); } while (0)
    f32x4 slo[2][2], shi[2][2];
    bf16x8 pflo[2], pfhi[2];
    pfhi[0] = (bf16x8){0, 0, 0, 0, 0, 0, 0, 0}; pfhi[1] = pfhi[0];
#define KLOAD(KR, MTA, MTB, KBASE) do { \
        KR[0] = *(const bf16x8*)((KBASE) + (c * 64 + (MTA) * 16 + fr) * 144 + fq * 16); KR[1] = *(const bf16x8*)((KBASE) + (c * 64 + (MTA) * 16 + fr) * 144 + 64 + fq * 16); \
        KR[2] = *(const bf16x8*)((KBASE) + (c * 64 + (MTB) * 16 + fr) * 144 + fq * 16); KR[3] = *(const bf16x8*)((KBASE) + (c * 64 + (MTB) * 16 + fr) * 144 + 64 + fq * 16); } while (0)
#define SMMAK(DST, KR) do { \
        DST[0][0] = mfma16(KR[0], qf[0][0], (f32x4){0.f, 0.f, 0.f, 0.f}); DST[0][1] = mfma16(KR[0], qf[1][0], (f32x4){0.f, 0.f, 0.f, 0.f}); \
        DST[1][0] = mfma16(KR[2], qf[0][0], (f32x4){0.f, 0.f, 0.f, 0.f}); DST[1][1] = mfma16(KR[2], qf[1][0], (f32x4){0.f, 0.f, 0.f, 0.f}); \
        DST[0][0] = mfma16(KR[1], qf[0][1], DST[0][0]); DST[0][1] = mfma16(KR[1], qf[1][1], DST[0][1]); \
        DST[1][0] = mfma16(KR[3], qf[0][1], DST[1][0]); DST[1][1] = mfma16(KR[3], qf[1][1], DST[1][1]); } while (0)
#define VLOAD4(VR, D0, KK, VBASE) do { _Pragma("unroll") for (int i_ = 0; i_ < 4; ++i_) VR[i_] = *(const bf16x8*)((VBASE) + VOFF + (((D0) + i_) * 16 + fr) * 144 + (KK) * 64 + fq * 16); } while (0)
#define PV4(VR, D0, PF) do { _Pragma("unroll") for (int i_ = 0; i_ < 4; ++i_) { o[(D0) + i_][0] = mfma16(VR[i_], PF[0], o[(D0) + i_][0]); o[(D0) + i_][1] = mfma16(VR[i_], PF[1], o[(D0) + i_][1]); } } while (0)
#define FENCE() __builtin_amdgcn_sched_barrier(0)
    AGLOAD(0); ASWRITE(0); AGLOAD(1); ASWRITE(1);
    for (int i = tid; i < 18432 / 16; i += NTHR) *(u32x4*)(lds + 3 * STG + VOFF + i * 16) = (u32x4){0u, 0u, 0u, 0u};
    __syncthreads();
    bf16x8 kr[4], va[4], vb[4];
    KLOAD(kr, 0, 1, lds); SMMAK(slo, kr);
    for (int kt = 0; kt < nkt; ++kt) {
        { const int ktl = kt + 2 < nkt ? kt + 2 : nkt - 1; AGLOAD(ktl); }
        const char* cur = lds + (kt & 3) * STG; const char* nxt = lds + ((kt + 1) & 3) * STG; const char* prv = lds + ((kt + 3) & 3) * STG;
        KLOAD(kr, 2, 3, cur); VLOAD4(va, 0, 1, prv);
        FENCE();
        SMMAK(shi, kr); VLOAD4(vb, 4, 1, prv); EXPQ(slo, 0, pflo);
        FENCE();
        PV4(va, 0, pfhi); KLOAD(kr, 0, 1, nxt); EXPQ(slo, 1, pflo);
        FENCE();
        PV4(vb, 4, pfhi); VLOAD4(va, 0, 0, cur);
        FENCE();
        SMMAK(slo, kr); VLOAD4(vb, 4, 0, cur); EXPQ(shi, 0, pfhi);
        FENCE();
        PV4(va, 0, pflo); EXPQ(shi, 1, pfhi);
        FENCE();
        PV4(vb, 4, pflo);
        FENCE();
        ASWRITE((kt + 2) & 3);
        __syncthreads();
    }
    { const char* prv = lds + ((nkt - 1) & 3) * STG; VLOAD4(va, 0, 1, prv); VLOAD4(vb, 4, 1, prv); PV4(va, 0, pfhi); PV4(vb, 4, pfhi); }
    __syncthreads();
#undef KLOAD
#undef SMMAK
#undef VLOAD4
#undef PV4
#undef FENCE
#undef EXPQ
#undef SMMA1
#undef PVMMA
#undef PV8
#undef AGLOAD
#undef ASWRITE
    float inv[2];
#pragma unroll
    for (int nt = 0; nt < 2; ++nt) { float v = l[nt]; v += sxor<16>(v); v += sxor<32>(v); inv[nt] = 1.0f / v; }
    float* xch = (float*)lds + sub * 4096;
    if (c == 1) {
#pragma unroll
        for (int dvt = 0; dvt < 8; ++dvt)
#pragma unroll
            for (int nt = 0; nt < 2; ++nt) {
                xch[(dvt * 16 + fq * 4 + 0) * 32 + nt * 16 + fr] = o[dvt][nt].x * inv[nt];
                xch[(dvt * 16 + fq * 4 + 1) * 32 + nt * 16 + fr] = o[dvt][nt].y * inv[nt];
                xch[(dvt * 16 + fq * 4 + 2) * 32 + nt * 16 + fr] = o[dvt][nt].z * inv[nt];
                xch[(dvt * 16 + fq * 4 + 3) * 32 + nt * 16 + fr] = o[dvt][nt].w * inv[nt];
            }
    }
    __syncthreads();
    if (c == 0) {
        float ss[2] = {0.f, 0.f};
#pragma unroll
        for (int dvt = 0; dvt < 8; ++dvt)
#pragma unroll
            for (int nt = 0; nt < 2; ++nt) {
                f32x4 v = o[dvt][nt] * inv[nt];
                v.x -= lam * xch[(dvt * 16 + fq * 4 + 0) * 32 + nt * 16 + fr];
                v.y -= lam * xch[(dvt * 16 + fq * 4 + 1) * 32 + nt * 16 + fr];
                v.z -= lam * xch[(dvt * 16 + fq * 4 + 2) * 32 + nt * 16 + fr];
                v.w -= lam * xch[(dvt * 16 + fq * 4 + 3) * 32 + nt * 16 + fr];
                o[dvt][nt] = v; ss[nt] += v.x * v.x + v.y * v.y + v.z * v.z + v.w * v.w;
            }
#pragma unroll
        for (int nt = 0; nt < 2; ++nt) {
            float v = ss[nt]; v += sxor<16>(v); v += sxor<32>(v);
            const float r = rsqrtf(v * (1.f / 128.f) + RMS_EPS) * 0.8f;
#pragma unroll
            for (int dvt = 0; dvt < 8; ++dvt) {
                const f32x4 gs = *(const f32x4*)(p.in[I_DGSUB] + dvt * 16 + fq * 4);
                const f32x4 v4 = o[dvt][nt];
                u32x2 w; w.x = pk2(v4.x * r * gs.x, v4.y * r * gs.y); w.y = pk2(v4.z * r * gs.z, v4.w * r * gs.w);
                *(u32x2*)(P + (size_t)(q0 + nt * 16 + fr) * NP + C_DQ + h * 128 + dvt * 16 + fq * 4) = w;
            }
        }
    }
    __syncthreads();
}

__device__ __forceinline__ void mem_attn_item(const Params& p, const Grp& G, int item, char* lds, float shift) {
    const int tid = otid(), lane = tid & 63, wid = tid >> 6, fr = lane & 15, fq = lane >> 4;
    const int T = G.T, nqb = T / 128;
    const int qb = item % nqb, bh = item / nqb, h = bh & 3, b = bh >> 2;
    bf16_t* P = (bf16_t*)(p.ws + WS_PROJ) + (size_t)b * T * NP;
    const bf16_t* MK = (const bf16_t*)(p.ws + WS_MEMK) + (size_t)((G.mb0 + b) * 4 + h) * 256 * 256;
    const bf16_t* MV = (const bf16_t*)(p.ws + WS_MEMV) + (size_t)((G.mb0 + b) * 4 + h) * 256 * 256;
    const int row = qb * 128 + wid * 16 + fr;
    bf16_t* qp = P + (size_t)row * NP + C_MQ + h * 256;
    bf16x8 qf[8];
    {
        float ss = 0.f; u32x4 raw[8];
#pragma unroll
        for (int ks = 0; ks < 8; ++ks) { raw[ks] = *(const u32x4*)(qp + ks * 32 + fq * 8);
            const float a0 = bflo(raw[ks].x), a1 = bfhi(raw[ks].x), a2 = bflo(raw[ks].y), a3 = bfhi(raw[ks].y), a4 = bflo(raw[ks].z), a5 = bfhi(raw[ks].z), a6 = bflo(raw[ks].w), a7 = bfhi(raw[ks].w);
            ss += a0 * a0 + a1 * a1 + a2 * a2 + a3 * a3 + a4 * a4 + a5 * a5 + a6 * a6 + a7 * a7; }
        ss += sxor<16>(ss); ss += sxor<32>(ss);
        const float r = rsqrtf(ss * (1.f / 256.f) + RMS_EPS) * (0.0625f * LOG2E);
#pragma unroll
        for (int ks = 0; ks < 8; ++ks) {
            const f32x4 g0 = *(const f32x4*)(p.in[I_MGQ] + ks * 32 + fq * 8), g1 = *(const f32x4*)(p.in[I_MGQ] + ks * 32 + fq * 8 + 4);
            u32x4 w;
            w.x = pk2(bflo(raw[ks].x) * r * g0.x, bfhi(raw[ks].x) * r * g0.y); w.y = pk2(bflo(raw[ks].y) * r * g0.z, bfhi(raw[ks].y) * r * g0.w);
            w.z = pk2(bflo(raw[ks].z) * r * g1.x, bfhi(raw[ks].z) * r * g1.y); w.w = pk2(bflo(raw[ks].w) * r * g1.z, bfhi(raw[ks].w) * r * g1.w);
            qf[ks] = __builtin_bit_cast(bf16x8, w);
        }
    }
    f32x4 o[16];
#pragma unroll
    for (int i = 0; i < 16; ++i) o[i] = (f32x4){0.f, 0.f, 0.f, 0.f};
    float l = 0.f;
    constexpr int KROW = 528, VOFF = 64 * 528;
    for (int kt = 0; kt < 4; ++kt) {
#pragma unroll
        for (int i = 0; i < 4; ++i) {
            const int idx = tid + i * 512, r = idx >> 5, ch = idx & 31;
            *(u32x4*)(lds + r * KROW + ch * 16) = *(const u32x4*)(MK + (size_t)(kt * 64 + r) * 256 + ch * 8);
            const int vr = idx >> 3, vc = idx & 7;
            *(u32x4*)(lds + VOFF + vr * 144 + vc * 16) = *(const u32x4*)(MV + (size_t)vr * 256 + kt * 64 + vc * 8);
        }
        __syncthreads();
        f32x4 s[4];
#pragma unroll
        for (int mt = 0; mt < 4; ++mt) s[mt] = (f32x4){-shift, -shift, -shift, -shift};
#pragma unroll
        for (int ks = 0; ks < 8; ++ks)
#pragma unroll
            for (int mt = 0; mt < 4; ++mt) {
                const bf16x8 kf = *(const bf16x8*)(lds + (mt * 16 + fr) * KROW + ks * 64 + fq * 16);
                s[mt] = mfma16(kf, qf[ks], s[mt]);
            }
        bf16x8 pf[2];
#pragma unroll
        for (int kk = 0; kk < 2; ++kk) {
            const f32x4 a = s[2 * kk], bb = s[2 * kk + 1];
            const float p0 = fexp2(a.x), p1 = fexp2(a.y), p2 = fexp2(a.z), p3 = fexp2(a.w);
            const float p4 = fexp2(bb.x), p5 = fexp2(bb.y), p6 = fexp2(bb.z), p7 = fexp2(bb.w);
            l += ((p0 + p1) + (p2 + p3)) + ((p4 + p5) + (p6 + p7));
            u32x4 w; w.x = pk2(p0, p1); w.y = pk2(p2, p3); w.z = pk2(p4, p5); w.w = pk2(p6, p7);
            pf[kk] = __builtin_bit_cast(bf16x8, w);
        }
#pragma unroll
        for (int kk = 0; kk < 2; ++kk)
#pragma unroll
            for (int dvt = 0; dvt < 16; ++dvt) {
                const bf16x8 vf = *(const bf16x8*)(lds + VOFF + (dvt * 16 + fr) * 144 + kk * 64 + fq * 16);
                o[dvt] = mfma16(vf, pf[kk], o[dvt]);
            }
        __syncthreads();
    }
    l += sxor<16>(l); l += sxor<32>(l);
    const float inv = 1.0f / l;
#pragma unroll
    for (int dvt = 0; dvt < 16; ++dvt) {
        u32x2 w; w.x = pk2(o[dvt].x * inv, o[dvt].y * inv); w.y = pk2(o[dvt].z * inv, o[dvt].w * inv);
        *(u32x2*)(qp + dvt * 16 + fq * 4) = w;
    }
}

constexpr int L_QE = 0, L_KE = 17408, L_KST = 34816, L_VTL = 53248, L_ATT = 71680, L_SB = 80896, L_LRF = 115712, L_TOT = 119808, L_GDEC = 121856;
__device__ __forceinline__ void gla_item(const Params& p, const Grp& G, int item, char* lds) {
    const int tid = otid(), lane = tid & 63, wid = tid >> 6, fr = lane & 15, fq = lane >> 4;
    const int slice = item & 1, dir = (item >> 1) & 1, h = (item >> 2) & 3, b = item >> 4;
    const int T = G.T, N = T / 64;
    const bf16_t* P = (const bf16_t*)(p.ws + WS_PROJ) + (size_t)b * T * NP;
    bf16_t* OUT = dir ? (bf16_t*)(p.ws + WS_PROJ) + (size_t)b * T * NP + C_DV + h * 256 + slice * 128
                      : (bf16_t*)(p.ws + WS_HB) + (size_t)b * T * D + h * 256 + slice * 128;
    const int ldo = dir ? NP : D;
    const int amt = wid & 3, antg = wid >> 2;
    bf16x8 wdB[4]; float bd4[4];
    {
        const float* wd = p.in[dir ? I_WDB : I_WDF]; const float* bdp = p.in[dir ? I_BDB : I_BDF];
#pragma unroll
        for (int q = 0; q < 4; ++q) {
            const int col = h * 128 + (antg * 4 + q) * 16 + fr;
            u32x4 w = (u32x4){0u, 0u, 0u, 0u};
            if (fq < 2) { const float* wp = wd + (size_t)(fq * 8) * 512 + col;
                w.x = pk2(wp[0], wp[512]); w.y = pk2(wp[1024], wp[1536]); w.z = pk2(wp[2048], wp[2560]); w.w = pk2(wp[3072], wp[3584]); }
            wdB[q] = __builtin_bit_cast(bf16x8, w);
            bd4[q] = bdp[col];
        }
    }
    { unsigned z = 0u; asm volatile("" : "+v"(z)); for (int i = tid; i < 34816 / 16; i += NTHR) *(u32x4*)(lds + L_SB + i * 16) = (u32x4){z, z, z, z}; }
    f32x4 S[8];
#pragma unroll
    for (int i = 0; i < 8; ++i) S[i] = (f32x4){0.f, 0.f, 0.f, 0.f};
    u32x4 rq[2], rk[2], rv[2], rl;
    const int lrow = tid >> 4, lch = tid & 15;
#define GGLOAD(n) do { const int cb_ = (dir ? (N - 1 - (n)) : (n)) * 64; \
        _Pragma("unroll") for (int i = 0; i < 2; ++i) { const int li_ = lrow + i * 32, tk_ = cb_ + (dir ? 63 - li_ : li_); const bf16_t* rp_ = P + (size_t)tk_ * NP; \
            rq[i] = *(const u32x4*)(rp_ + C_GQ + h * 128 + lch * 8); rk[i] = *(const u32x4*)(rp_ + C_GK + h * 128 + lch * 8); rv[i] = *(const u32x4*)(rp_ + C_GV + h * 256 + slice * 128 + lch * 8); } \
        if (tid < 128) { const int li_ = tid >> 1, tk_ = cb_ + (dir ? 63 - li_ : li_); rl = *(const u32x4*)(P + (size_t)tk_ * NP + C_LR + dir * 16 + (tid & 1) * 8); } } while (0)
    GGLOAD(0);
    for (int n = 0; n < N; ++n) {
#pragma unroll
        for (int i = 0; i < 2; ++i) {
            const int li = lrow + i * 32;
            *(u32x4*)(lds + L_QE + li * 272 + lch * 16) = rq[i];
            *(u32x4*)(lds + L_KE + li * 272 + lch * 16) = rk[i];
            bf16_t* vt = (bf16_t*)(lds + L_VTL) + (lch * 8) * 72 + li;
            vt[0 * 72] = (bf16_t)(rv[i].x & 0xffff); vt[1 * 72] = (bf16_t)(rv[i].x >> 16); vt[2 * 72] = (bf16_t)(rv[i].y & 0xffff); vt[3 * 72] = (bf16_t)(rv[i].y >> 16);
            vt[4 * 72] = (bf16_t)(rv[i].z & 0xffff); vt[5 * 72] = (bf16_t)(rv[i].z >> 16); vt[6 * 72] = (bf16_t)(rv[i].w & 0xffff); vt[7 * 72] = (bf16_t)(rv[i].w >> 16);
        }
        if (tid < 128) *(u32x4*)(lds + L_LRF + (tid >> 1) * 32 + (tid & 1) * 16) = rl;
        if (n + 1 < N) GGLOAD(n + 1);
        __syncthreads();
        {
            u32x4 araw = (u32x4){0u, 0u, 0u, 0u};
            if (fq < 2) araw = *(const u32x4*)(lds + L_LRF + (amt * 16 + fr) * 32 + fq * 16);
            const bf16x8 afr = __builtin_bit_cast(bf16x8, araw);
            float pb[4][4]; float E[4], tt[4];
#pragma unroll
            for (int q = 0; q < 4; ++q) {
                const f32x4 x4 = mfma16(afr, wdB[q], (f32x4){bd4[q], bd4[q], bd4[q], bd4[q]});
                float run = 0.f;
#pragma unroll
                for (int j = 0; j < 4; ++j) {
                    const float x = x4[j];
                    const float ls = fminf(x, 0.f) - __logf(1.0f + __expf(-fabsf(x)));
                    run += ls * 0.0625f; pb[q][j] = run;
                }
                const float u = sxor<16>(run), v = run + u, w2 = sxor<32>(v);
                E[q] = ((fq & 1) ? u : 0.f) + ((fq & 2) ? w2 : 0.f);
                tt[q] = v + w2;
                if (fq == 0) ((float*)(lds + L_TOT))[amt * 128 + (antg * 4 + q) * 16 + fr] = tt[q];
            }
            __syncthreads();
#pragma unroll
            for (int q = 0; q < 4; ++q) {
                const int col = (antg * 4 + q) * 16 + fr;
                float off = 0.f, blast = 0.f;
#pragma unroll
                for (int r = 0; r < 4; ++r) { const float tv = ((const float*)(lds + L_TOT))[r * 128 + col]; blast += tv; if (r < amt) off += tv; }
                const float gcol = __expf(blast);
                bf16_t* qe = (bf16_t*)(lds + L_QE) + (amt * 16 + fq * 4) * 136 + col; bf16_t* ke = (bf16_t*)(lds + L_KE) + (amt * 16 + fq * 4) * 136 + col;
                float ksv[4];
#pragma unroll
                for (int j = 0; j < 4; ++j) {
                    const float bb = off + E[q] + pb[q][j];
                    const float qv = bf2f(qe[j * 136]), kv = bf2f(ke[j * 136]);
                    const float kd = kv * __expf(-bb);
                    qe[j * 136] = f2bf(qv * __expf(bb)); ke[j * 136] = f2bf(kd);
                    ksv[j] = kd * gcol;
                }
                *(u32x2*)(lds + L_KST + col * 144 + (amt * 16 + fq * 4) * 2) = (u32x2){pk2(ksv[0], ksv[1]), pk2(ksv[2], ksv[3])};
                if (amt == 0 && fq == 0) ((float*)(lds + L_GDEC))[col] = gcol;
            }
        }
        __syncthreads();
        {
            const int ct = wid & 3;
            f32x4 a[2] = {(f32x4){0.f, 0.f, 0.f, 0.f}, (f32x4){0.f, 0.f, 0.f, 0.f}};
#pragma unroll
            for (int ks = 0; ks < 4; ++ks) {
                const bf16x8 qv = *(const bf16x8*)(lds + L_QE + (ct * 16 + fr) * 272 + ks * 64 + fq * 16);
#pragma unroll
                for (int j = 0; j < 2; ++j) {
                    const int st = (wid >> 2) * 2 + j;
                    const bf16x8 kv = *(const bf16x8*)(lds + L_KE + (st * 16 + fr) * 272 + ks * 64 + fq * 16);
                    a[j] = mfma16(kv, qv, a[j]);
                }
            }
#pragma unroll
            for (int j = 0; j < 2; ++j) {
                const int st = (wid >> 2) * 2 + j, cc = ct * 16 + fr, s0 = st * 16 + fq * 4;
                const float v0 = (s0 + 0 <= cc) ? a[j].x : 0.f, v1 = (s0 + 1 <= cc) ? a[j].y : 0.f, v2 = (s0 + 2 <= cc) ? a[j].z : 0.f, v3 = (s0 + 3 <= cc) ? a[j].w : 0.f;
                *(u32x2*)(lds + L_ATT + cc * 144 + s0 * 2) = (u32x2){pk2(v0, v1), pk2(v2, v3)};
            }
        }
        __syncthreads();
        {
            f32x4 oc[4] = {(f32x4){0.f, 0.f, 0.f, 0.f}, (f32x4){0.f, 0.f, 0.f, 0.f}, (f32x4){0.f, 0.f, 0.f, 0.f}, (f32x4){0.f, 0.f, 0.f, 0.f}};
#pragma unroll
            for (int ks = 0; ks < 2; ++ks) {
                const bf16x8 af = *(const bf16x8*)(lds + L_VTL + (wid * 16 + fr) * 144 + ks * 64 + fq * 16);
#pragma unroll
                for (int ct = 0; ct < 4; ++ct) { const bf16x8 bfv = *(const bf16x8*)(lds + L_ATT + (ct * 16 + fr) * 144 + ks * 64 + fq * 16); oc[ct] = mfma16(af, bfv, oc[ct]); }
            }
#pragma unroll
            for (int ks = 0; ks < 4; ++ks) {
                const bf16x8 af = *(const bf16x8*)(lds + L_SB + (wid * 16 + fr) * 272 + ks * 64 + fq * 16);
#pragma unroll
                for (int ct = 0; ct < 4; ++ct) { const bf16x8 bfv = *(const bf16x8*)(lds + L_QE + (ct * 16 + fr) * 272 + ks * 64 + fq * 16); oc[ct] = mfma16(af, bfv, oc[ct]); }
            }
            const int cb = (dir ? (N - 1 - n) : n) * 64;
#pragma unroll
            for (int ct = 0; ct < 4; ++ct) {
                const int cl = ct * 16 + fr, tk = cb + (dir ? 63 - cl : cl);
                *(u32x2*)(OUT + (size_t)tk * ldo + wid * 16 + fq * 4) = (u32x2){pk2(oc[ct].x, oc[ct].y), pk2(oc[ct].z, oc[ct].w)};
            }
        }
        __syncthreads();
        {
            const f32x4 gd = *(const f32x4*)((const float*)(lds + L_GDEC) + wid * 16 + fq * 4);
#pragma unroll
            for (int et = 0; et < 8; ++et) S[et] = S[et] * gd;
#pragma unroll
            for (int ks = 0; ks < 2; ++ks) {
                const bf16x8 af = *(const bf16x8*)(lds + L_KST + (wid * 16 + fr) * 144 + ks * 64 + fq * 16);
#pragma unroll
                for (int et = 0; et < 8; ++et) { const bf16x8 bfv = *(const bf16x8*)(lds + L_VTL + (et * 16 + fr) * 144 + ks * 64 + fq * 16); S[et] = mfma16(af, bfv, S[et]); }
            }
#pragma unroll
            for (int et = 0; et < 8; ++et)
                *(u32x2*)(lds + L_SB + (et * 16 + fr) * 272 + (wid * 16 + fq * 4) * 2) = (u32x2){pk2(S[et].x, S[et].y), pk2(S[et].z, S[et].w)};
        }
        __syncthreads();
    }
#undef GGLOAD
}

__device__ __forceinline__ void phase_mixer(const Params& p, int g, char* lds, int* s_item) {
    const Grp G = get_group(p, g);
    const int nGLA = G.B * 16, nATT = G.B * 8 * (G.T / 128), nMEM = G.B * 4 * (G.T / 128);
    unsigned* ctr = (unsigned*)(p.ws + WS_CTRL) + g * 4;
    for (;;) {
        if (threadIdx.x == 0) *s_item = (int)atomicAdd(ctr + 0, 1u);
        __syncthreads();
        const int it = *s_item;
        __syncthreads();
        if (it >= nGLA) break;
        gla_item(p, G, it, lds);
    }
    {
        float d1 = 0.f, d2 = 0.f;
        for (int i = 0; i < 64; ++i) { d1 += p.in[I_LQ1][i] * p.in[I_LK1][i]; d2 += p.in[I_LQ2][i] * p.in[I_LK2][i]; }
        const float lam = expf(d1) - expf(d2) + 0.2f;
        for (;;) {
            if (threadIdx.x == 0) *s_item = (int)atomicAdd(ctr + 1, 1u);
            __syncthreads();
            const int it = *s_item;
            __syncthreads();
            if (it >= nATT) break;
            diff_attn_item(p, G, it, lds, lam, 0.f);
        }
    }
    for (;;) {
        if (threadIdx.x == 0) *s_item = (int)atomicAdd(ctr + 2, 1u);
        __syncthreads();
        const int it = *s_item;
        __syncthreads();
        if (it >= nMEM) break;
        mem_attn_item(p, G, it, lds, 0.f);
    }
}

__device__ __forceinline__ void phase_glafin(const Params& p, int g, int tok0, int ntok) {
    const int tid_ = otid(), lane = tid_ & 63, wid = tid_ >> 6;
    bf16_t* P = (bf16_t*)(p.ws + WS_PROJ); const bf16_t* F = (const bf16_t*)(p.ws + WS_HB);
    for (int it = tok0 * 4 + wid; it < (tok0 + ntok) * 4; it += 8) {
        const int tok = it >> 2, h = it & 3;
        bf16_t* row = P + (size_t)tok * NP;
        const unsigned qq = *(const unsigned*)(row + C_GQ + h * 128 + lane * 2), kk = *(const unsigned*)(row + C_GK + h * 128 + lane * 2);
        const float qk = wave_sum(bflo(qq) * bflo(kk) + bfhi(qq) * bfhi(kk));
        const u32x2 f = *(const u32x2*)(F + (size_t)tok * D + h * 256 + lane * 4), bk = *(const u32x2*)(row + C_DV + h * 256 + lane * 4);
        const u32x2 v = *(const u32x2*)(row + C_GV + h * 256 + lane * 4), gt = *(const u32x2*)(row + C_GG + h * 256 + lane * 4);
        float o0 = bflo(f.x) + bflo(bk.x) - qk * bflo(v.x), o1 = bfhi(f.x) + bfhi(bk.x) - qk * bfhi(v.x);
        float o2 = bflo(f.y) + bflo(bk.y) - qk * bflo(v.y), o3 = bfhi(f.y) + bfhi(bk.y) - qk * bfhi(v.y);
        const float r = rsqrtf(wave_sum(o0 * o0 + o1 * o1 + o2 * o2 + o3 * o3) * (1.f / 256.f) + RMS_EPS);
        const f32x4 go = *(const f32x4*)(p.in[I_GOUT] + lane * 4);
        const float g0 = bflo(gt.x), g1 = bfhi(gt.x), g2 = bflo(gt.y), g3 = bfhi(gt.y);
        o0 *= r * go.x * g0 / (1.f + __expf(-g0)); o1 *= r * go.y * g1 / (1.f + __expf(-g1));
        o2 *= r * go.z * g2 / (1.f + __expf(-g2)); o3 *= r * go.w * g3 / (1.f + __expf(-g3));
        *(u32x2*)(row + C_GG + h * 256 + lane * 4) = (u32x2){pk2(o0, o1), pk2(o2, o3)};
    }
}

__device__ __forceinline__ void phase_merge(const Params& p, int g, char* lds, int u) {
    const int tid_ = otid(), lane = tid_ & 63, wid = tid_ >> 6, wm = wid >> 2, wn = wid & 3, fr = lane & 15, fq = lane >> 4;
    const bf16_t* P = (const bf16_t*)(p.ws + WS_PROJ); bf16_t* M = (bf16_t*)(p.ws + WS_VT);
    for (int pn = 0; pn < 4; ++pn) {
        const int m0 = u * 128, n0 = pn * 256;
        f32x4 macc[4][4];
#pragma unroll
        for (int i = 0; i < 4; ++i)
#pragma unroll
            for (int j = 0; j < 4; ++j) macc[i][j] = (f32x4){0.f, 0.f, 0.f, 0.f};
        for (int br = 0; br < 3; ++br) {
            f32x4 acc[4][4];
#pragma unroll
            for (int i = 0; i < 4; ++i)
#pragma unroll
                for (int j = 0; j < 4; ++j) acc[i][j] = (f32x4){0.f, 0.f, 0.f, 0.f};
            const int acol = br == 0 ? C_GG : (br == 1 ? C_DQ : C_MQ);
            gemm_kloop<true, 4>(acc, P + (size_t)m0 * NP + acol, NP, (const bf16_t*)(p.ws + WS_WOT) + (size_t)br * D * D + (size_t)n0 * D, D, D, lds);
#pragma unroll
            for (int mt = 0; mt < 4; ++mt)
#pragma unroll
                for (int nt = 0; nt < 4; ++nt) {
                    const int row = m0 + wm * 64 + mt * 16 + fr, col = n0 + wn * 64 + nt * 16 + fq * 4;
                    const u32x2 gt = *(const u32x2*)(P + (size_t)row * NP + C_BG + br * 1024 + col);
                    f32x4 sg; sg.x = 1.f / (1.f + __expf(-bflo(gt.x))); sg.y = 1.f / (1.f + __expf(-bfhi(gt.x))); sg.z = 1.f / (1.f + __expf(-bflo(gt.y))); sg.w = 1.f / (1.f + __expf(-bfhi(gt.y)));
                    macc[mt][nt] += sg * acc[mt][nt];
                }
        }
#pragma unroll
        for (int mt = 0; mt < 4; ++mt)
#pragma unroll
            for (int nt = 0; nt < 4; ++nt) {
                const int row = m0 + wm * 64 + mt * 16 + fr, col = n0 + wn * 64 + nt * 16 + fq * 4;
                *(u32x2*)(M + (size_t)row * D + col) = (u32x2){pk2(macc[mt][nt].x, macc[mt][nt].y), pk2(macc[mt][nt].z, macc[mt][nt].w)};
            }
    }
}

__device__ __forceinline__ void phase_outproj(const Params& p, int g, char* lds, int u) {
    const Grp G = get_group(p, g);
    const int tid_ = otid(), lane = tid_ & 63, wid = tid_ >> 6, wm = wid >> 2, wn = wid & 3, fr = lane & 15, fq = lane >> 4;
    const bf16_t* M = (const bf16_t*)(p.ws + WS_VT); const bf16_t* W = (const bf16_t*)(p.ws + WS_WOT) + (size_t)3 * D * D;
    for (int pn = 0; pn < 4; ++pn) {
        const int m0 = u * 128, n0 = pn * 256;
        f32x4 acc[4][4];
#pragma unroll
        for (int i = 0; i < 4; ++i)
#pragma unroll
            for (int j = 0; j < 4; ++j) acc[i][j] = (f32x4){0.f, 0.f, 0.f, 0.f};
        gemm_kloop<true, 4>(acc, M + (size_t)m0 * D, D, W + (size_t)n0 * D, D, D, lds);
#pragma unroll
        for (int mt = 0; mt < 4; ++mt)
#pragma unroll
            for (int nt = 0; nt < 4; ++nt) {
                const int row = m0 + wm * 64 + mt * 16 + fr, col = n0 + wn * 64 + nt * 16 + fq * 4;
                const f32x4 xv = *(const f32x4*)(G.x + (size_t)row * D + col);
                *(f32x4*)(G.out + (size_t)row * D + col) = xv + acc[mt][nt];
            }
    }
}

__device__ __forceinline__ void phase_peerq(const Params& p, int g, char* lds, int u) {
    const int tid_ = otid(), lane = tid_ & 63, wid = tid_ >> 6, wm = wid >> 2, wn = wid & 3, fr = lane & 15, fq = lane >> 4;
    const bf16_t* A = (const bf16_t*)(p.ws + WS_HB); const bf16_t* W = (const bf16_t*)(p.ws + WS_WQT); bf16_t* P = (bf16_t*)(p.ws + WS_PROJ);
    for (int pn = 0; pn < 8; ++pn) {
        const int m0 = u * 128, n0 = pn * 256;
        f32x4 acc[4][4];
#pragma unroll
        for (int i = 0; i < 4; ++i)
#pragma unroll
            for (int j = 0; j < 4; ++j) acc[i][j] = (f32x4){0.f, 0.f, 0.f, 0.f};
        gemm_kloop<true, 4>(acc, A + (size_t)m0 * D, D, W + (size_t)n0 * D, D, D, lds);
#pragma unroll
        for (int mt = 0; mt < 4; ++mt)
#pragma unroll
            for (int nt = 0; nt < 4; ++nt) {
                const int row = m0 + wm * 64 + mt * 16 + fr, col = n0 + wn * 64 + nt * 16 + fq * 4;
                *(u32x2*)(P + (size_t)row * NP + col) = (u32x2){pk2(acc[mt][nt].x, acc[mt][nt].y), pk2(acc[mt][nt].z, acc[mt][nt].w)};
            }
    }
}

__device__ __forceinline__ unsigned f2ord(float f) { const unsigned u = __float_as_uint(f); return (u & 0x80000000u) ? ~u : (u | 0x80000000u); }
__device__ __forceinline__ float ord2f(unsigned k) { const unsigned u = (k & 0x80000000u) ? (k & 0x7fffffffu) : ~k; return __uint_as_float(u); }
__device__ __forceinline__ unsigned gmax16(unsigned v) {
    unsigned t;
    t = sxoru<1>(v); v = v > t ? v : t; t = sxoru<2>(v); v = v > t ? v : t; t = sxoru<4>(v); v = v > t ? v : t; t = sxoru<8>(v); v = v > t ? v : t;
    return v;
}
__device__ __forceinline__ float gsum16(float v) { v += sxor<1>(v); v += sxor<2>(v); v += sxor<4>(v); v += sxor<8>(v); return v; }
__device__ __forceinline__ float gelu_exact(float a) { return 0.5f * a * (1.0f + erff(a * 0.70710678118654752f)); }

__device__ __forceinline__ void phase_peer(const Params& p, int g, char* lds, int tile0, int ntile) {
    const Grp G = get_group(p, g);
    const int tid = otid(), lane = tid & 63, wid = tid >> 6, fr = lane & 15, fq = lane >> 4;
    const bf16_t* P = (const bf16_t*)(p.ws + WS_PROJ); const bf16_t* HB = (const bf16_t*)(p.ws + WS_HB);
    const bf16_t* K12 = (const bf16_t*)(p.ws + WS_K12);
    float* SC = (float*)lds;
    int* EIDX = (int*)(lds + 65536);
    float* GATE = (float*)(lds + 65536 + 4096);
    char* KL = lds + 73728;
    for (int i = tid; i < 2 * 128 * 16; i += NTHR) {
        const int r = i >> 4, ch = i & 15;
        *(u32x4*)(KL + r * 272 + ch * 16) = *(const u32x4*)(K12 + (size_t)r * 128 + ch * 8);
    }
    __syncthreads();
    for (int tile = tile0; tile < tile0 + ntile; ++tile) {
        const int tok0 = tile * 8;
        {
            const bf16_t* qtok = P + (size_t)(tok0 + wid) * NP + (fr & 7) * 256;
#pragma unroll
            for (int half = 0; half < 2; ++half) {
                f32x4 acc[8];
#pragma unroll
                for (int i = 0; i < 8; ++i) acc[i] = (f32x4){0.f, 0.f, 0.f, 0.f};
#pragma unroll
                for (int ks = 0; ks < 4; ++ks) {
                    const bf16x8 af = *(const bf16x8*)(qtok + half * 128 + ks * 32 + fq * 8);
#pragma unroll
                    for (int nt = 0; nt < 8; ++nt) { const bf16x8 bfv = *(const bf16x8*)(KL + (half * 128 + nt * 16 + fr) * 272 + ks * 64 + fq * 16); acc[nt] = mfma16(af, bfv, acc[nt]); }
                }
                if (fq < 2) {
#pragma unroll
                    for (int nt = 0; nt < 8; ++nt) {
                        float* dst = SC + (wid * 8 + fq * 4) * 256 + half * 128 + nt * 16 + fr;
                        dst[0] = acc[nt].x; dst[256] = acc[nt].y; dst[512] = acc[nt].z; dst[768] = acc[nt].w;
                    }
                }
            }
        }
        __builtin_amdgcn_wave_barrier();
        for (int pass = 0; pass < 2; ++pass) {
            const int row = wid * 8 + pass * 4 + fq, sl = fr, gb = fq * 16;
            float v1 = 0.f, v2 = 0.f; int i1 = 0, i2 = 0;
#pragma unroll
            for (int hf = 0; hf < 2; ++hf) {
                unsigned key[8];
#pragma unroll
                for (int i = 0; i < 8; ++i) { const int idx = sl + 16 * i; key[i] = (f2ord(SC[row * 256 + hf * 128 + idx]) & ~127u) | (unsigned)(127 - idx); }
                float sv = 0.f; int si = 0;
                for (int r = 0; r < 16; ++r) {
                    unsigned m = key[0];
#pragma unroll
                    for (int i = 1; i < 8; ++i) m = m > key[i] ? m : key[i];
                    m = gmax16(m);
                    if (sl == r) { sv = ord2f(m & ~127u); si = 127 - (int)(m & 127u); }
#pragma unroll
                    for (int i = 0; i < 8; ++i) key[i] = key[i] == m ? 0u : key[i];
                }
                if (hf == 0) { v1 = sv; i1 = si; } else { v2 = sv; i2 = si; }
            }
            int ptr = 0; float ts = 0.f; int pid = 0;
            for (int r = 0; r < 16; ++r) {
                const float v2p = __int_as_float(__builtin_amdgcn_ds_bpermute((gb + (ptr & 15)) << 2, __float_as_int(v2)));
                const unsigned key = ptr < 16 ? ((f2ord(v1 + v2p) & ~255u) | (unsigned)(255 - (sl * 16 + ptr))) : 0u;
                const unsigned m = gmax16(key);
                if (sl == r) { ts = ord2f(m & ~255u); pid = 255 - (int)(m & 255u); }
                if (key == m) ptr++;
            }
            const int e1 = __builtin_amdgcn_ds_bpermute((gb + (pid >> 4)) << 2, i1), e2 = __builtin_amdgcn_ds_bpermute((gb + (pid & 15)) << 2, i2);
            float mx = ts;
            mx = fmaxf(mx, sxor<1>(mx)); mx = fmaxf(mx, sxor<2>(mx)); mx = fmaxf(mx, sxor<4>(mx)); mx = fmaxf(mx, sxor<8>(mx));
            const float ex = __expf(ts - mx), sm = gsum16(ex);
            EIDX[row * 16 + sl] = e1 * 128 + e2; GATE[row * 16 + sl] = ex / sm;
        }
        __builtin_amdgcn_wave_barrier();
        {
            const int tok = tok0 + wid;
            const bf16_t* hrow = HB + (size_t)tok * D;
            const int grp = lane >> 4, sl = lane & 15;
            {
                f32x2 hv[32];
#pragma unroll
                for (int c = 0; c < 8; ++c) {
                    const u32x4 hq = *(const u32x4*)(hrow + sl * 64 + c * 8);
                    hv[c * 4 + 0] = (f32x2){bflo(hq.x), bfhi(hq.x)} * (1.0f / PEER_SU); hv[c * 4 + 1] = (f32x2){bflo(hq.y), bfhi(hq.y)} * (1.0f / PEER_SU);
                    hv[c * 4 + 2] = (f32x2){bflo(hq.z), bfhi(hq.z)} * (1.0f / PEER_SU); hv[c * 4 + 3] = (f32x2){bflo(hq.w), bfhi(hq.w)} * (1.0f / PEER_SU);
                }
                const unsigned char* PU8 = p.ws + WS_PU + sl * 64;
#define ULOADG(BUF, IT) do { _Pragma("unroll") for (int i_ = 0; i_ < 2; ++i_) { const int k_ = ((IT) + i_) * 4 + grp; const unsigned char* ur_ = PU8 + (size_t)EIDX[wid * 128 + k_] * D; \
        BUF[i_ * 4 + 0] = *(const u32x4*)ur_; BUF[i_ * 4 + 1] = *(const u32x4*)(ur_ + 16); BUF[i_ * 4 + 2] = *(const u32x4*)(ur_ + 32); BUF[i_ * 4 + 3] = *(const u32x4*)(ur_ + 48); } } while (0)
#define PDOT(uq, base) \
        a2 += __builtin_amdgcn_cvt_pk_f32_fp8((int)uq.x, false) * hv[base + 0]; b2 += __builtin_amdgcn_cvt_pk_f32_fp8((int)uq.x, true) * hv[base + 1]; \
        a2 += __builtin_amdgcn_cvt_pk_f32_fp8((int)uq.y, false) * hv[base + 2]; b2 += __builtin_amdgcn_cvt_pk_f32_fp8((int)uq.y, true) * hv[base + 3]; \
        a2 += __builtin_amdgcn_cvt_pk_f32_fp8((int)uq.z, false) * hv[base + 4]; b2 += __builtin_amdgcn_cvt_pk_f32_fp8((int)uq.z, true) * hv[base + 5]; \
        a2 += __builtin_amdgcn_cvt_pk_f32_fp8((int)uq.w, false) * hv[base + 6]; b2 += __builtin_amdgcn_cvt_pk_f32_fp8((int)uq.w, true) * hv[base + 7];
#define UCOMP(BUF, IT) do { _Pragma("unroll") for (int i_ = 0; i_ < 2; ++i_) { const int k_ = ((IT) + i_) * 4 + grp; \
        f32x2 a2 = (f32x2){0.f, 0.f}, b2 = (f32x2){0.f, 0.f}; \
        PDOT(BUF[i_ * 4 + 0], 0) PDOT(BUF[i_ * 4 + 1], 8) PDOT(BUF[i_ * 4 + 2], 16) PDOT(BUF[i_ * 4 + 3], 24) \
        a2 += b2; const float a_ = gsum16(a2.x + a2.y); GATE[wid * 128 + k_] = GATE[wid * 128 + k_] * gelu_exact(a_); } } while (0)
                u32x4 ubA[8], ubB[8];
                ULOADG(ubA, 0);
                for (int it0 = 0; it0 < 32; it0 += 4) {
                    ULOADG(ubB, it0 + 2);
                    __builtin_amdgcn_sched_barrier(0);
                    UCOMP(ubA, it0);
                    __builtin_amdgcn_sched_barrier(0);
                    if (it0 + 4 < 32) ULOADG(ubA, it0 + 4);
                    __builtin_amdgcn_sched_barrier(0);
                    UCOMP(ubB, it0 + 2);
                    __builtin_amdgcn_sched_barrier(0);
                }
#undef ULOADG
#undef PDOT
#undef UCOMP
            }
            __builtin_amdgcn_wave_barrier();
            f32x2 acc[8];
#pragma unroll
            for (int i = 0; i < 8; ++i) acc[i] = (f32x2){0.f, 0.f};
            const unsigned char* PV8 = p.ws + WS_PV + lane * 16;
#define VLOADG(BUF, K0) do { _Pragma("unroll") for (int i_ = 0; i_ < 8; ++i_) BUF[i_] = *(const u32x4*)(PV8 + (size_t)EIDX[wid * 128 + (K0) + i_] * D); } while (0)
#define VCOMP(BUF, K0) do { _Pragma("unroll") for (int i_ = 0; i_ < 8; ++i_) { const float w_ = GATE[wid * 128 + (K0) + i_]; const f32x2 w2 = (f32x2){w_, w_}; const u32x4 v = BUF[i_]; \
        acc[0] += w2 * __builtin_amdgcn_cvt_pk_f32_fp8((int)v.x, false); acc[1] += w2 * __builtin_amdgcn_cvt_pk_f32_fp8((int)v.x, true); \
        acc[2] += w2 * __builtin_amdgcn_cvt_pk_f32_fp8((int)v.y, false); acc[3] += w2 * __builtin_amdgcn_cvt_pk_f32_fp8((int)v.y, true); \
        acc[4] += w2 * __builtin_amdgcn_cvt_pk_f32_fp8((int)v.z, false); acc[5] += w2 * __builtin_amdgcn_cvt_pk_f32_fp8((int)v.z, true); \
        acc[6] += w2 * __builtin_amdgcn_cvt_pk_f32_fp8((int)v.w, false); acc[7] += w2 * __builtin_amdgcn_cvt_pk_f32_fp8((int)v.w, true); } } while (0)
            {
                u32x4 vbA[8], vbB[8];
                VLOADG(vbA, 0);
                for (int k0 = 0; k0 < 128; k0 += 16) {
                    VLOADG(vbB, k0 + 8);
                    __builtin_amdgcn_sched_barrier(0);
                    VCOMP(vbA, k0);
                    __builtin_amdgcn_sched_barrier(0);
                    if (k0 + 16 < 128) VLOADG(vbA, k0 + 16);
                    __builtin_amdgcn_sched_barrier(0);
                    VCOMP(vbB, k0 + 8);
                    __builtin_amdgcn_sched_barrier(0);
                }
            }
#undef VLOADG
#undef VCOMP
            float* orow = G.out + (size_t)tok * D + lane * 16;
#pragma unroll
            for (int i = 0; i < 4; ++i) {
                f32x4 t = *(f32x4*)(orow + i * 4);
                t.x += acc[2 * i].x * (1.0f / PEER_SV); t.y += acc[2 * i].y * (1.0f / PEER_SV); t.z += acc[2 * i + 1].x * (1.0f / PEER_SV); t.w += acc[2 * i + 1].y * (1.0f / PEER_SV);
                *(f32x4*)(orow + i * 4) = t;
            }
        }
        __builtin_amdgcn_wave_barrier();
    }
}


constexpr int NPH = 3 + NGROUP * 3;
__device__ __forceinline__ void run_phase(const Params& p, int ph, char* lds, int* s_item) {
    const int g = (ph - 3) / 3, s = (ph - 3) % 3;
    const Grp G = get_group(p, g);
    if (s == 0) {
        for (int u = blockIdx.x; u < 256; u += gridDim.x) {
            const int m0 = (u >> 1) * 256;
            phase_rmsnorm(G.x, p.in[I_GMIX], (bf16_t*)(p.ws + WS_HB), m0, 256);
            __syncthreads();
            phase_inproj(p, g, lds, u);
            __syncthreads();
        }
    } else if (s == 1) {
        phase_mixer(p, g, lds, s_item);
    } else {
        for (int u = blockIdx.x; u < 256; u += gridDim.x) {
            const int m0 = u * 128;
            phase_glafin(p, g, m0, 128);
            __syncthreads();
            phase_merge(p, g, lds, u);
            __syncthreads();
            phase_outproj(p, g, lds, u);
            __syncthreads();
            phase_rmsnorm(G.out, p.in[I_GFFN], (bf16_t*)(p.ws + WS_HB), m0, 128);
            __syncthreads();
            phase_peerq(p, g, lds, u);
            __syncthreads();
            phase_peer(p, g, lds, m0 / 8, 16);
            __syncthreads();
        }
    }
}

__global__ void __launch_bounds__(NTHR) mega_kernel(Params p) {
    extern __shared__ __attribute__((aligned(16))) char lds[];
    __shared__ int s_item;
    cg::grid_group grid = cg::this_grid();
    phase_p0a(p, lds); grid.sync();
    phase_p0b(p, lds); grid.sync();
    phase_p0c(p); grid.sync();
    for (int ph = 3; ph < NPH; ++ph) {
        run_phase(p, ph, lds, &s_item);
        if (ph + 1 < NPH) grid.sync();
    }
}

extern "C" void kernel_launch(void* const* d_in, const int* in_sizes, int n_in, void* d_out, int out_size, void* d_ws, size_t ws_size, hipStream_t stream) {
    static int grid_blocks = 0;
    if (grid_blocks == 0) {
        if (n_in != 32 || ws_size < WS_END) { fprintf(stderr, "kernel_launch: unexpected n_in %d or ws_size %zu (< %zu)\n", n_in, ws_size, (size_t)WS_END); grid_blocks = -1; return; }
        int dev = 0, cus = 0, per_cu = 0;
        hipGetDevice(&dev);
        hipDeviceGetAttribute(&cus, hipDeviceAttributeMultiprocessorCount, dev);
        hipFuncSetAttribute((const void*)mega_kernel, hipFuncAttributeMaxDynamicSharedMemorySize, LDS_BYTES);
        hipOccupancyMaxActiveBlocksPerMultiprocessor(&per_cu, (const void*)mega_kernel, NTHR, LDS_BYTES);
        if (per_cu < 1) per_cu = 1;
        grid_blocks = cus * per_cu;
        (void)hipGetLastError();
    }
    if (grid_blocks < 0) return;
    Params p{};
    for (int i = 0; i < 32; ++i) p.in[i] = (const float*)d_in[i];
    p.out = (float*)d_out; p.ws = (unsigned char*)d_ws; p.ph_lo = 0; p.ph_hi = NPH;
    void* args[] = {&p};
    hipError_t e = hipLaunchCooperativeKernel((const void*)mega_kernel, dim3(grid_blocks), dim3(NTHR), args, LDS_BYTES, stream);
    if (e != hipSuccess) fprintf(stderr, "cooperative launch failed: %s (grid %d)\n", hipGetErrorString(e), grid_blocks);
}
```

```cpp
#include <hip/hip_runtime.h>
#include <hip/hip_cooperative_groups.h>
#include <cstdio>
#include <cstdint>
namespace cg = cooperative_groups;

typedef unsigned short bf16_t;
typedef short bf16x8 __attribute__((ext_vector_type(8)));
typedef float f32x4 __attribute__((ext_vector_type(4)));
typedef unsigned u32x4 __attribute__((ext_vector_type(4)));
typedef unsigned u32x2 __attribute__((ext_vector_type(2)));

constexpr int D = 1024;
constexpr int NP = 10496;
constexpr int IN_COLS = 10272;
constexpr int C_GQ = 0, C_GK = 512, C_GV = 1024, C_GG = 2048, C_DQ = 3072, C_DK = 4096, C_DV = 5120, C_MQ = 6144, C_BG = 7168, C_LR = 10240;
constexpr int G_TOK = 32768;
constexpr int NGROUP = 3;
constexpr int NTHR = 512;
constexpr float RMS_EPS = 1e-6f;
constexpr float LOG2E = 1.4426950408889634f;
constexpr int LDS_BYTES = 147456;
constexpr float PEER_SU = 32.0f, PEER_SV = 8.0f;

enum { I_XP = 0, I_XS, I_MP, I_MS, I_GMIX, I_WIN, I_WDF, I_BDF, I_WDB, I_BDB, I_GOUT, I_GWO, I_DGQ, I_DGK, I_LQ1, I_LK1, I_LQ2, I_LK2,
       I_DGSUB, I_DWO, I_MGN, I_MWKV, I_MGQ, I_MGK, I_MWO, I_WOUT, I_GFFN, I_PWQ, I_PK1, I_PK2, I_PU, I_PV };

constexpr size_t al256(size_t x) { return (x + 255) & ~(size_t)255; }
constexpr size_t WS_CTRL = 0;
constexpr size_t WS_PROJ = 4096;
constexpr size_t WS_HB   = WS_PROJ + (size_t)G_TOK * NP * 2;
constexpr size_t WS_VT   = WS_HB + (size_t)G_TOK * D * 2;
constexpr size_t WS_WINT = WS_VT + (size_t)G_TOK * D * 2;
constexpr size_t WS_WOT  = WS_WINT + (size_t)NP * D * 2;
constexpr size_t WS_WKVT = WS_WOT + (size_t)4 * D * D * 2;
constexpr size_t WS_WQT  = WS_WKVT + (size_t)2048 * D * 2;
constexpr size_t WS_PU   = WS_WQT + (size_t)2048 * D * 2;
constexpr size_t WS_PV   = WS_PU + (size_t)16384 * D * 2;
constexpr size_t WS_K12  = WS_PV + (size_t)16384 * D * 2;
constexpr size_t WS_ROPE = WS_K12 + (size_t)2 * 128 * 128 * 2;
constexpr size_t WS_HM   = WS_ROPE + (size_t)16384 * 64 * 4;
constexpr size_t WS_KVR  = WS_HM + (size_t)2560 * D * 2;
constexpr size_t WS_MEMK = WS_KVR + (size_t)2560 * 2048 * 4;
constexpr size_t WS_MEMV = WS_MEMK + (size_t)10 * 4 * 256 * 256 * 2;
constexpr size_t WS_END  = WS_MEMV + (size_t)10 * 4 * 256 * 256 * 2;

struct Params {
    const float* in[32];
    float* out;
    unsigned char* ws;
    int ph_lo, ph_hi;
};

typedef float f32x2 __attribute__((ext_vector_type(2)));
typedef __bf16 bf16x2v __attribute__((ext_vector_type(2)));
__device__ __forceinline__ unsigned pk2(float lo, float hi) { const f32x2 v = {lo, hi}; const bf16x2v b = __builtin_convertvector(v, bf16x2v); return __builtin_bit_cast(unsigned, b); }
__device__ __forceinline__ float bflo(unsigned u) { return __uint_as_float(u << 16); }
__device__ __forceinline__ float bfhi(unsigned u) { return __uint_as_float(u & 0xffff0000u); }
__device__ __forceinline__ float bf2f(bf16_t b) { return __uint_as_float(((unsigned)b) << 16); }
__device__ __forceinline__ bf16_t f2bf(float f) { return (bf16_t)(pk2(f, 0.f) & 0xffffu); }
__device__ __forceinline__ f32x4 mfma16(bf16x8 a, bf16x8 b, f32x4 c) { return __builtin_amdgcn_mfma_f32_16x16x32_bf16(a, b, c, 0, 0, 0); }
__device__ __forceinline__ float fexp2(float x) { return __builtin_amdgcn_exp2f(x); }
template <class T> __device__ __forceinline__ T* launder(T* q) { asm volatile("" : "+s"(q)); return q; }
__device__ __forceinline__ int otid() { int t = threadIdx.x; asm volatile("" : "+v"(t)); return t; }
template <int M> __device__ __forceinline__ float sxor(float v) {
    if (M < 32) return __int_as_float(__builtin_amdgcn_ds_swizzle(__float_as_int(v), (M << 10) | 0x1F));
    const int l = otid() & 63; return __int_as_float(__builtin_amdgcn_ds_bpermute((l ^ 32) << 2, __float_as_int(v)));
}
template <int M> __device__ __forceinline__ unsigned sxoru(unsigned v) { return (unsigned)__builtin_amdgcn_ds_swizzle((int)v, (M << 10) | 0x1F); }
__device__ __forceinline__ float wave_sum(float v) {
    v += sxor<1>(v); v += sxor<2>(v); v += sxor<4>(v); v += sxor<8>(v); v += sxor<16>(v); v += sxor<32>(v);
    return v;
}

struct Grp { const float* x; const float* mem; float* out; int B, T, mb0; };
__device__ __forceinline__ Grp get_group(const Params& p, int g) {
    Grp r;
    if (g == 0) { r.x = p.in[I_XP]; r.out = p.out; r.B = 2; r.T = 16384; r.mb0 = 0; }
    else { r.x = p.in[I_XS] + (size_t)(g - 1) * G_TOK * D; r.out = p.out + (size_t)g * G_TOK * D; r.B = 4; r.T = 8192; r.mb0 = 2 + (g - 1) * 4; }
    r.mem = nullptr;
    return r;
}

constexpr int G_ROW = 144;
constexpr int G_A_BYTES = 128 * G_ROW;
constexpr int G_B_BYTES = 256 * G_ROW;
constexpr int G_STAGE = G_A_BYTES + G_B_BYTES;

template <bool SWAP, int MT>
__device__ __forceinline__ void gemm_kloop(f32x4 (&acc)[MT][4], const bf16_t* __restrict__ A, int lda, const bf16_t* __restrict__ Bt, int ldb, int K, char* lds) {
    constexpr int A_ROWS = MT * 32, A_BYTES = A_ROWS * G_ROW, STAGE = A_BYTES + G_B_BYTES;
    constexpr int NA = A_BYTES / 1024, NI = STAGE / 1024, NPER = (NI + 7) / 8;
    const int tid = otid(), lane = tid & 63, wid = __builtin_amdgcn_readfirstlane(tid >> 6), wm = wid >> 2, wn = wid & 3, fr = lane & 15, fq = lane >> 4;
    unsigned goff[NPER];
#pragma unroll
    for (int i = 0; i < NPER; ++i) {
        const int j = wid + 8 * i;
        const int ci = (j < NA ? j : j - NA) * 64 + lane, row = ci / 9, ch = ci % 9, chc = ch < 8 ? ch : 7;
        goff[i] = (unsigned)(row * (j < NA ? lda : ldb) + chc * 8);
    }
#define GSTAGE(buf, k0) do { _Pragma("unroll") for (int i = 0; i < NPER; ++i) { const int j = wid + 8 * i; if (j < NI) { \
        const bf16_t* src_ = (j < NA ? A : Bt) + goff[i] + (k0); \
        __builtin_amdgcn_global_load_lds((const unsigned*)src_, (unsigned*)(lds + (buf) * STAGE + j * 1024), 16, 0, 0); } } } while (0)
    const int nk = K / 64;
    GSTAGE(0, 0);
    __syncthreads();
    for (int kt = 0; kt < nk; ++kt) {
        if (kt + 1 < nk) GSTAGE((kt + 1) & 1, (kt + 1) * 64);
        const char* base = lds + (kt & 1) * STAGE;
        const char* abase = base + (wm * (MT * 16) + fr) * G_ROW + fq * 16;
        const char* bbase = base + A_BYTES + (wn * 64 + fr) * G_ROW + fq * 16;
        bf16x8 b0[4], b1[4], ar[4];
#pragma unroll
        for (int nt = 0; nt < 4; ++nt) b0[nt] = *(const bf16x8*)(bbase + nt * 16 * G_ROW);
        ar[0] = *(const bf16x8*)(abase); ar[1] = *(const bf16x8*)(abase + 16 * G_ROW); ar[2] = *(const bf16x8*)(abase + 32 * G_ROW);
#pragma unroll
        for (int st = 0; st < 2 * MT; ++st) {
            const int ks = st / MT, mt = st % MT;
            __builtin_amdgcn_sched_barrier(0);
            if (st + 3 < 2 * MT) { const int ks2 = (st + 3) / MT, mt2 = (st + 3) % MT; ar[(st + 3) % 4] = *(const bf16x8*)(abase + mt2 * 16 * G_ROW + ks2 * 64); }
            if (ks == 0 && mt >= MT - 3 && mt < MT - 1) {
#pragma unroll
                for (int q = 0; q < 2; ++q) { const int nt = (mt - (MT - 3)) * 2 + q; b1[nt] = *(const bf16x8*)(bbase + nt * 16 * G_ROW + 64); }
            }
#pragma unroll
            for (int nt = 0; nt < 4; ++nt) {
                const bf16x8 bv = ks == 0 ? b0[nt] : b1[nt];
                acc[mt][nt] = SWAP ? mfma16(bv, ar[st % 4], acc[mt][nt]) : mfma16(ar[st % 4], bv, acc[mt][nt]);
            }
        }
        __builtin_amdgcn_sched_barrier(0);
        __syncthreads();
    }
#undef GSTAGE
}

__device__ __forceinline__ void tile_order(int t, int nM, int nN, int& pm, int& pn) {
    const int per = 8 * nN, grp = t / per, r = t % per;
    pm = grp * 8 + (r & 7); pn = r >> 3;
}

__device__ __forceinline__ void phase_p0a(const Params& p, char* lds) {
    const int tid = otid(), lane = tid & 63, wid = tid >> 6;
    unsigned char* ws = p.ws;
    if (blockIdx.x == 0 && tid < 256) atomicExch((unsigned*)(ws + WS_CTRL) + tid, 0u);
    float* scr = (float*)(lds + wid * 8448);
    constexpr int IT_WIN = 16 * (NP / 32), IT_SQ = 16 * 32, IT_W2 = 16 * 64;
    constexpr int NIT = IT_WIN + 4 * IT_SQ + 2 * IT_W2;
    for (int it0 = blockIdx.x * 8; it0 < NIT; it0 += gridDim.x * 8) {
        int it = it0 + wid;
        const float* W = nullptr; bf16_t* WT = nullptr; int N = 0, nb = 0, kb = 0, srccol = -1;
        if (it < NIT) {
            int r = it;
            if (r < IT_WIN) { W = p.in[I_WIN]; N = IN_COLS; WT = (bf16_t*)(ws + WS_WINT); kb = r / (NP / 32); nb = r % (NP / 32);
                const int n0 = nb * 32; srccol = n0 < 3072 ? n0 : (n0 < 10240 ? n0 + 32 : (n0 == 10240 ? 3072 : -1)); }
            else { r -= IT_WIN;
                if (r < 4 * IT_SQ) { const int w = r / IT_SQ; r %= IT_SQ; const int idx[4] = {I_GWO, I_DWO, I_MWO, I_WOUT};
                    W = p.in[w == 0 ? I_GWO : (w == 1 ? I_DWO : (w == 2 ? I_MWO : I_WOUT))]; (void)idx; N = 1024; WT = (bf16_t*)(ws + WS_WOT) + (size_t)w * D * D; kb = r / 32; nb = r % 32; srccol = nb * 32; }
                else { r -= 4 * IT_SQ; const int w = r / IT_W2; r %= IT_W2; W = p.in[w == 0 ? I_MWKV : I_PWQ]; N = 2048; WT = (bf16_t*)(ws + (w == 0 ? WS_WKVT : WS_WQT)); kb = r / 64; nb = r % 64; srccol = nb * 32; }
            }
            const int k0 = kb * 64;
#pragma unroll 8
            for (int i = 0; i < 32; ++i) { const int kk = 2 * i + (lane >> 5); scr[kk * 33 + (lane & 31)] = srccol >= 0 ? W[(size_t)(k0 + kk) * N + srccol + (lane & 31)] : 0.f; }
        }
        __syncthreads();
        if (it < NIT) {
            const int k0 = kb * 64, c = lane & 7;
#pragma unroll
            for (int j = 0; j < 4; ++j) { const int n = (lane >> 3) + 8 * j; const float* s = scr + (8 * c) * 33 + n;
                u32x4 o; o.x = pk2(s[0], s[33]); o.y = pk2(s[66], s[99]); o.z = pk2(s[132], s[165]); o.w = pk2(s[198], s[231]);
                *(u32x4*)(WT + (size_t)(nb * 32 + n) * D + k0 + 8 * c) = o; }
        }
        __syncthreads();
    }
    const size_t gtid = (size_t)blockIdx.x * NTHR + tid, gsz = (size_t)gridDim.x * NTHR;
    {
        const size_t n8 = (size_t)16384 * D / 8;
        for (size_t i = gtid; i < 2 * n8; i += gsz) {
            const int w = i >= n8; const size_t j = w ? i - n8 : i;
            const float* src = p.in[w ? I_PV : I_PU] + j * 8; unsigned char* dst = ws + (w ? WS_PV : WS_PU) + j * 8;
            const float sc = w ? PEER_SV : PEER_SU;
            const f32x4 a = *(const f32x4*)src * sc, b = *(const f32x4*)(src + 4) * sc;
            int lo = __builtin_amdgcn_cvt_pk_fp8_f32(a.x, a.y, 0, false); lo = __builtin_amdgcn_cvt_pk_fp8_f32(a.z, a.w, lo, true);
            int hi = __builtin_amdgcn_cvt_pk_fp8_f32(b.x, b.y, 0, false); hi = __builtin_amdgcn_cvt_pk_fp8_f32(b.z, b.w, hi, true);
            *(u32x2*)dst = (u32x2){(unsigned)lo, (unsigned)hi};
        }
        for (size_t i = gtid; i < 2 * 16384; i += gsz) {
            const int w = i >= 16384; const size_t j = w ? i - 16384 : i;
            ((bf16_t*)(ws + WS_K12))[i] = f2bf(p.in[w ? I_PK2 : I_PK1][j]);
        }
    }
    for (size_t i = gtid; i < (size_t)16384 * 32; i += gsz) {
        const int t = (int)(i >> 5), k = (int)(i & 31);
        const float inv = powf(10000.0f, -(float)(2 * k) / 64.0f);
        const float ang = (float)t * inv;
        double sn, cs; sincos((double)ang, &sn, &cs);
        float* R = (float*)(ws + WS_ROPE) + (size_t)t * 64;
        R[k] = (float)cs; R[32 + k] = (float)sn;
    }
    for (int row = blockIdx.x * 8 + wid; row < 2560; row += gridDim.x * 8) {
        const float* src = row < 512 ? p.in[I_MP] + (size_t)row * D : p.in[I_MS] + (size_t)(row - 512) * D;
        const f32x4* xr = (const f32x4*)src + lane; const f32x4* gr = (const f32x4*)p.in[I_MGN] + lane;
        f32x4 v[4]; float s = 0.f;
#pragma unroll
        for (int j = 0; j < 4; ++j) { v[j] = xr[64 * j]; s += v[j].x * v[j].x + v[j].y * v[j].y + v[j].z * v[j].z + v[j].w * v[j].w; }
        const float r = rsqrtf(wave_sum(s) * (1.f / D) + RMS_EPS);
        u32x2* o = (u32x2*)((bf16_t*)(ws + WS_HM) + (size_t)row * D) + lane;
#pragma unroll
        for (int j = 0; j < 4; ++j) { const f32x4 g = gr[64 * j]; u32x2 w; w.x = pk2(v[j].x * r * g.x, v[j].y * r * g.y); w.y = pk2(v[j].z * r * g.z, v[j].w * r * g.w); o[64 * j] = w; }
    }
}

__device__ __forceinline__ void phase_p0b(const Params& p, char* lds) {
    const int tid_ = otid(), lane = tid_ & 63, wid = tid_ >> 6, wm = wid >> 2, wn = wid & 3, fr = lane & 15, fq = lane >> 4;
    const bf16_t* A = (const bf16_t*)(p.ws + WS_HM); const bf16_t* Bt = (const bf16_t*)(p.ws + WS_WKVT);
    float* C = (float*)(p.ws + WS_KVR);
    const int nM = 20, nN = 8;
    for (int t = blockIdx.x; t < nM * nN; t += gridDim.x) {
        const int pm = t % nM, pn = t / nM, m0 = pm * 128, n0 = pn * 256;
        f32x4 acc[4][4];
#pragma unroll
        for (int i = 0; i < 4; ++i)
#pragma unroll
            for (int j = 0; j < 4; ++j) acc[i][j] = (f32x4){0.f, 0.f, 0.f, 0.f};
        gemm_kloop<true, 4>(acc, A + (size_t)m0 * D, D, Bt + (size_t)n0 * D, D, D, lds);
#pragma unroll
        for (int mt = 0; mt < 4; ++mt)
#pragma unroll
            for (int nt = 0; nt < 4; ++nt) {
                const int row = m0 + wm * 64 + mt * 16 + fr, col = n0 + wn * 64 + nt * 16 + fq * 4;
                *(f32x4*)(C + (size_t)row * 2048 + col) = acc[mt][nt];
            }
    }
}

__device__ __forceinline__ void phase_p0c(const Params& p) {
    const int tid_ = otid(), lane = tid_ & 63, wid = tid_ >> 6;
    const float* KV = (const float*)(p.ws + WS_KVR);
    bf16_t* MK = (bf16_t*)(p.ws + WS_MEMK); bf16_t* MV = (bf16_t*)(p.ws + WS_MEMV);
    for (int it = blockIdx.x * 8 + wid; it < 2560 * 4; it += gridDim.x * 8) {
        const int row = it >> 2, h = it & 3, b = row >> 8, m = row & 255;
        const f32x4 kv = *(const f32x4*)(KV + (size_t)row * 2048 + h * 256 + lane * 4);
        const float ss = wave_sum(kv.x * kv.x + kv.y * kv.y + kv.z * kv.z + kv.w * kv.w);
        const float r = rsqrtf(ss * (1.f / 256.f) + RMS_EPS);
        const f32x4 g = *(const f32x4*)(p.in[I_MGK] + lane * 4);
        u32x2 w; w.x = pk2(kv.x * r * g.x, kv.y * r * g.y); w.y = pk2(kv.z * r * g.z, kv.w * r * g.w);
        *(u32x2*)(MK + ((size_t)(b * 4 + h) * 256 + m) * 256 + lane * 4) = w;
        const f32x4 vv = *(const f32x4*)(KV + (size_t)row * 2048 + 1024 + h * 256 + lane * 4);
        const int pos = (m & ~31) + ((m >> 2) & 3) * 8 + ((m >> 4) & 1) * 4 + (m & 3);
        bf16_t* dst = MV + ((size_t)(b * 4 + h) * 256 + lane * 4) * 256 + pos;
        dst[0] = f2bf(vv.x); dst[256] = f2bf(vv.y); dst[512] = f2bf(vv.z); dst[768] = f2bf(vv.w);
    }
}

__device__ __forceinline__ void phase_rmsnorm(const float* X, const float* gain, bf16_t* O, int row0, int nrows) {
    const int tid_ = otid(), lane = tid_ & 63, wid = tid_ >> 6;
    const f32x4* gr = (const f32x4*)launder(gain) + lane;
    f32x4 g[4];
#pragma unroll
    for (int j = 0; j < 4; ++j) g[j] = gr[64 * j];
    f32x4 vn[4];
    { const f32x4* xr = (const f32x4*)(X + (size_t)(row0 + wid) * D) + lane;
#pragma unroll
      for (int j = 0; j < 4; ++j) vn[j] = xr[64 * j]; }
    for (int row = row0 + wid; row < row0 + nrows; row += 8) {
        f32x4 v[4]; float s = 0.f;
#pragma unroll
        for (int j = 0; j < 4; ++j) v[j] = vn[j];
        if (row + 8 < row0 + nrows) { const f32x4* xr = (const f32x4*)(X + (size_t)(row + 8) * D) + lane;
#pragma unroll
            for (int j = 0; j < 4; ++j) vn[j] = xr[64 * j]; }
        __builtin_amdgcn_sched_barrier(0);
#pragma unroll
        for (int j = 0; j < 4; ++j) s += v[j].x * v[j].x + v[j].y * v[j].y + v[j].z * v[j].z + v[j].w * v[j].w;
        const float r = rsqrtf(wave_sum(s) * (1.f / D) + RMS_EPS);
        u32x2* o = (u32x2*)(O + (size_t)row * D) + lane;
#pragma unroll
        for (int j = 0; j < 4; ++j) { u32x2 w; w.x = pk2(v[j].x * r * g[j].x, v[j].y * r * g[j].y); w.y = pk2(v[j].z * r * g[j].z, v[j].w * r * g[j].w); o[64 * j] = w; }
    }
}

__device__ __forceinline__ void phase_inproj(const Params& p, int g, char* lds, int u) {
    const Grp G = get_group(p, g);
    const int tid_ = otid(), lane = tid_ & 63, wid = tid_ >> 6, wm = wid >> 2, wn = wid & 3, fr = lane & 15, fq = lane >> 4;
    const bf16_t* A = (const bf16_t*)(p.ws + WS_HB); const bf16_t* Bt = (const bf16_t*)(p.ws + WS_WINT);
    bf16_t* P = (bf16_t*)(p.ws + WS_PROJ); bf16_t* VT = (bf16_t*)(p.ws + WS_VT);
    const int pm = u >> 1, half = u & 1, m0 = pm * 256;
    for (int pi = 0; pi < (half ? 17 : 12); ++pi) {
        const int pn = half ? 24 + pi : pi; const int n0 = pn * 256;
        f32x4 acc[8][4];
#pragma unroll
        for (int i = 0; i < 8; ++i)
#pragma unroll
            for (int j = 0; j < 4; ++j) acc[i][j] = (f32x4){0.f, 0.f, 0.f, 0.f};
        gemm_kloop<true, 8>(acc, A + (size_t)m0 * D, D, Bt + (size_t)n0 * D, D, D, lds);
        const float sc = n0 < 512 ? 0.08838834764831845f : 1.0f;
#pragma unroll
        for (int mt = 0; mt < 8; ++mt)
#pragma unroll
            for (int nt = 0; nt < 4; ++nt) {
                const int row = m0 + wm * 128 + mt * 16 + fr, col = n0 + wn * 64 + nt * 16 + fq * 4;
                u32x2 w; w.x = pk2(acc[mt][nt].x * sc, acc[mt][nt].y * sc); w.y = pk2(acc[mt][nt].z * sc, acc[mt][nt].w * sc);
                *(u32x2*)(P + (size_t)row * NP + col) = w;
            }
    }
    if (half == 0) for (int pn = 12; pn < 20; ++pn) {
        const int n0 = pn * 256;
        f32x4 acc[8][4];
#pragma unroll
        for (int i = 0; i < 8; ++i)
#pragma unroll
            for (int j = 0; j < 4; ++j) acc[i][j] = (f32x4){0.f, 0.f, 0.f, 0.f};
        gemm_kloop<true, 8>(acc, A + (size_t)m0 * D, D, Bt + (size_t)n0 * D, D, D, lds);
        const int te_ = otid(), fr = te_ & 15, fq = (te_ >> 4) & 3, wm = te_ >> 8, wn = (te_ >> 6) & 3;
        const bool isk = n0 >= C_DK;
        const float* gn = launder(p.in[isk ? I_DGK : I_DGQ]) + fq * 4;
        const float qs = isk ? 1.0f : 0.125f * LOG2E;
        const float* ROPE = (const float*)(p.ws + WS_ROPE);
        const int tq0 = m0 % G.T + wm * 128 + fr;
#pragma unroll
        for (int mt = 0; mt < 8; ++mt) {
            const int row = m0 + wm * 128 + mt * 16 + fr, t = tq0 + mt * 16;
            float ss = 0.f;
#pragma unroll
            for (int nt = 0; nt < 4; ++nt) ss += acc[mt][nt].x * acc[mt][nt].x + acc[mt][nt].y * acc[mt][nt].y + acc[mt][nt].z * acc[mt][nt].z + acc[mt][nt].w * acc[mt][nt].w;
            ss += sxor<16>(ss); ss += sxor<32>(ss);
            const float r = rsqrtf(ss * (1.f / 64.f) + RMS_EPS) * qs;
            const float* rp = ROPE + (size_t)t * 64 + fq * 4;
            bf16_t* dst = P + (size_t)row * NP + n0 + wn * 64 + fq * 4;
#pragma unroll
            for (int hh = 0; hh < 2; ++hh) {
                const f32x4 cs = *(const f32x4*)(rp + hh * 16), sn = *(const f32x4*)(rp + 32 + hh * 16);
                const f32x4 ya = acc[mt][hh] * *(const f32x4*)(gn + hh * 16) * r, yb = acc[mt][hh + 2] * *(const f32x4*)(gn + 32 + hh * 16) * r;
                const f32x4 oa = ya * cs - yb * sn, ob = yb * cs + ya * sn;
                *(u32x2*)(dst + hh * 16) = (u32x2){pk2(oa.x, oa.y), pk2(oa.z, oa.w)};
                *(u32x2*)(dst + 32 + hh * 16) = (u32x2){pk2(ob.x, ob.y), pk2(ob.z, ob.w)};
            }
        }
    }
    for (int pn = half ? 21 : 20; pn < (half ? 24 : 21); ++pn) {
        const int n0 = pn * 256;
        f32x4 acc[8][4];
#pragma unroll
        for (int i = 0; i < 8; ++i)
#pragma unroll
            for (int j = 0; j < 4; ++j) acc[i][j] = (f32x4){0.f, 0.f, 0.f, 0.f};
        gemm_kloop<false, 8>(acc, A + (size_t)m0 * D, D, Bt + (size_t)n0 * D, D, D, lds);
        const int b = m0 / G.T, t0 = m0 % G.T + wm * 128;
#pragma unroll
        for (int mt = 0; mt < 8; ++mt)
#pragma unroll
            for (int nt = 0; nt < 4; ++nt) {
                const int n = n0 - C_DV + wn * 64 + nt * 16 + fr, h = n >> 7, dv = n & 127;
                const int pos = t0 + (mt >> 1) * 32 + fq * 8 + (mt & 1) * 4;
                u32x2 w; w.x = pk2(acc[mt][nt].x, acc[mt][nt].y); w.y = pk2(acc[mt][nt].z, acc[mt][nt].w);
                *(u32x2*)(VT + ((size_t)((b * 8 + h) * 128 + dv)) * G.T + pos) = w;
            }
    }
}

__device__ __forceinline__ void phase_qkrope(const Params& p, int g, int tok0, int ntok) {
    const Grp G = get_group(p, g);
    const int tid_ = otid(), lane = tid_ & 63, wid = tid_ >> 6, grp = lane >> 2, sub = lane & 3;
    bf16_t* P = (bf16_t*)(p.ws + WS_PROJ); const float* ROPE = (const float*)(p.ws + WS_ROPE);
    for (int it = tok0 * 2 + wid; it < (tok0 + ntok) * 2; it += 8) {
        const int tok = it >> 1, isk = it & 1, t = tok % G.T;
        bf16_t* base = P + (size_t)tok * NP + (isk ? C_DK : C_DQ) + grp * 64 + sub * 8;
        const u32x4 a = *(const u32x4*)base, b = *(const u32x4*)(base + 32);
        float x1[8], x2[8];
        x1[0] = bflo(a.x); x1[1] = bfhi(a.x); x1[2] = bflo(a.y); x1[3] = bfhi(a.y); x1[4] = bflo(a.z); x1[5] = bfhi(a.z); x1[6] = bflo(a.w); x1[7] = bfhi(a.w);
        x2[0] = bflo(b.x); x2[1] = bfhi(b.x); x2[2] = bflo(b.y); x2[3] = bfhi(b.y); x2[4] = bflo(b.z); x2[5] = bfhi(b.z); x2[6] = bflo(b.w); x2[7] = bfhi(b.w);
        float ss = 0.f;
#pragma unroll
        for (int e = 0; e < 8; ++e) ss += x1[e] * x1[e] + x2[e] * x2[e];
        ss += sxor<1>(ss); ss += sxor<2>(ss);
        const float r = rsqrtf(ss * (1.f / 64.f) + RMS_EPS) * (isk ? 1.0f : 0.125f * LOG2E);
        const float* gn = p.in[isk ? I_DGK : I_DGQ] + sub * 8;
        const float* rp = ROPE + (size_t)t * 64 + sub * 8;
        float o1[8], o2[8];
#pragma unroll
        for (int e = 0; e < 8; ++e) {
            const float y1 = x1[e] * r * gn[e], y2 = x2[e] * r * gn[32 + e], c = rp[e], s = rp[32 + e];
            o1[e] = y1 * c - y2 * s; o2[e] = y2 * c + y1 * s;
        }
        u32x4 w1, w2;
        w1.x = pk2(o1[0], o1[1]); w1.y = pk2(o1[2], o1[3]); w1.z = pk2(o1[4], o1[5]); w1.w = pk2(o1[6], o1[7]);
        w2.x = pk2(o2[0], o2[1]); w2.y = pk2(o2[2], o2[3]); w2.z = pk2(o2[4], o2[5]); w2.w = pk2(o2[6], o2[7]);
        *(u32x4*)base = w1; *(u32x4*)(base + 32) = w2;
    }
}

__device__ __forceinline__ void diff_attn_item(const Params& p, const Grp& G, int item, char* lds, float lam, float shift) {
    const int tid = otid(), lane = tid & 63, wid = tid >> 6, fr = lane & 15, fq = lane >> 4;
    const int c = wid & 1, sub = wid >> 1;
    const int T = G.T, nqb = T / 128;
    const int qb = item % nqb, bh = item / nqb, h = bh & 7, b = bh >> 3;
    bf16_t* P = (bf16_t*)(p.ws + WS_PROJ) + (size_t)b * T * NP;
    const bf16_t* Kg = P + C_DK + h * 128;
    const bf16_t* VTg = (const bf16_t*)(p.ws + WS_VT) + (size_t)bh * 128 * T;
    const int q0 = qb * 128 + sub * 32;
    bf16x8 qf[2][2];
#pragma unroll
    for (int nt = 0; nt < 2; ++nt)
#pragma unroll
        for (int ks = 0; ks < 2; ++ks) qf[nt][ks] = *(const bf16x8*)(P + (size_t)(q0 + nt * 16 + fr) * NP + C_DQ + h * 128 + c * 64 + ks * 32 + fq * 8);
    f32x4 o[8][2];
#pragma unroll
    for (int i = 0; i < 8; ++i) { o[i][0] = (f32x4){0.f, 0.f, 0.f, 0.f}; o[i][1] = (f32x4){0.f, 0.f, 0.f, 0.f}; }
    float l[2] = {0.f, 0.f};
    constexpr int STG = 36864, VOFF = 18432;
    u32x4 rk[2], rv[2];
    const int krow = tid >> 4, kch = tid & 15;
    const int vrow = tid >> 3, vch = tid & 7;
#define AGLOAD(kt) do { const int key0_ = (kt) * 64; \
        _Pragma("unroll") for (int i = 0; i < 2; ++i) rk[i] = *(const u32x4*)(Kg + (size_t)(key0_ + krow + i * 32) * NP + kch * 8); \
        _Pragma("unroll") for (int i = 0; i < 2; ++i) rv[i] = *(const u32x4*)(VTg + (size_t)(vrow + i * 64) * T + key0_ + vch * 8); } while (0)
#define ASWRITE(buf) do { char* b_ = lds + (buf) * STG; \
        _Pragma("unroll") for (int i = 0; i < 2; ++i) *(u32x4*)(b_ + ((kch >> 3) * 64 + krow + i * 32) * 144 + (kch & 7) * 16) = rk[i]; \
        _Pragma("unroll") for (int i = 0; i < 2; ++i) *(u32x4*)(b_ + VOFF + (vrow + i * 64) * 144 + vch * 16) = rv[i]; } while (0)
    const int nkt = T / 64;
#define EXPQ(SRC, NT, DSTP) do { const f32x4 a_ = SRC[0][NT], b_ = SRC[1][NT]; \
        const float p0 = fexp2(a_.x), p1 = fexp2(a_.y), p2 = fexp2(a_.z), p3 = fexp2(a_.w); \
        const float p4 = fexp2(b_.x), p5 = fexp2(b_.y), p6 = fexp2(b_.z), p7 = fexp2(b_.w); \
        l[NT] += ((p0 + p1) + (p2 + p3)) + ((p4 + p5) + (p6 + p7)); \
        u32x4 w_; w_.x = pk2(p0, p1); w_.y = pk2(p2, p3); w_.z = pk2(p4, p5); w_.w = pk2(p6, p7); \
        DSTP[NT] = __builtin_bit_cast(bf16x8, w_); } while (0)
#define SMMA1(DST, I, MT, KBASE) do { \
        const bf16x8 k0_ = *(const bf16x8*)((KBASE) + (c * 64 + (MT) * 16 + fr) * 144 + fq * 16); \
        const bf16x8 k1_ = *(const bf16x8*)((KBASE) + (c * 64 + (MT) * 16 + fr) * 144 + 64 + fq * 16); \
        DST[I][0] = mfma16(k0_, qf[0][0], (f32x4){0.f, 0.f, 0.f, 0.f}); DST[I][1] = mfma16(k0_, qf[1][0], (f32x4){0.f, 0.f, 0.f, 0.f}); \
        DST[I][0] = mfma16(k1_, qf[0][1], DST[I][0]); DST[I][1] = mfma16(k1_, qf[1][1], DST[I][1]); } while (0)
#define PVMMA(DVT, KK, PF, VBASE) do { \
        const bf16x8 vf_ = *(const bf16x8*)((VBASE) + VOFF + ((DVT) * 16 + fr) * 144 + (KK) * 64 + fq * 16); \
        o[DVT][0] = mfma16(vf_, PF[0], o[DVT][0]); o[DVT][1] = mfma16(vf_, PF[1], o[DVT][1]); } while (0)
#define PV8(KK, PF, VBASE) do { PVMMA(0, KK, PF, VBASE); PVMMA(1, KK, PF, VBASE); PVMMA(2, KK, PF, VBASE); PVMMA(3, KK, PF, VBASE); \
        PVMMA(4, KK, PF, VBASE); PVMMA(5, KK, PF, VBASE); PVMMA(6, KK, PF, VBASE); PVMMA(7, KK, PF, VBASE); } while (0)
    f32x4 slo[2][2], shi[2][2];
    bf16x8 pflo[2], pfhi[2];
    pfhi[0] = (bf16x8){0, 0, 0, 0, 0, 0, 0, 0}; pfhi[1] = pfhi[0];
#define KLOAD(KR, MTA, MTB, KBASE) do { \
        KR[0] = *(const bf16x8*)((KBASE) + (c * 64 + (MTA) * 16 + fr) * 144 + fq * 16); KR[1] = *(const bf16x8*)((KBASE) + (c * 64 + (MTA) * 16 + fr) * 144 + 64 + fq * 16); \
        KR[2] = *(const bf16x8*)((KBASE) + (c * 64 + (MTB) * 16 + fr) * 144 + fq * 16); KR[3] = *(const bf16x8*)((KBASE) + (c * 64 + (MTB) * 16 + fr) * 144 + 64 + fq * 16); } while (0)
#define SMMAK(DST, KR) do { \
        DST[0][0] = mfma16(KR[0], qf[0][0], (f32x4){0.f, 0.f, 0.f, 0.f}); DST[0][1] = mfma16(KR[0], qf[1][0], (f32x4){0.f, 0.f, 0.f, 0.f}); \
        DST[1][0] = mfma16(KR[2], qf[0][0], (f32x4){0.f, 0.f, 0.f, 0.f}); DST[1][1] = mfma16(KR[2], qf[1][0], (f32x4){0.f, 0.f, 0.f, 0.f}); \
        DST[0][0] = mfma16(KR[1], qf[0][1], DST[0][0]); DST[0][1] = mfma16(KR[1], qf[1][1], DST[0][1]); \
        DST[1][0] = mfma16(KR[3], qf[0][1], DST[1][0]); DST[1][1] = mfma16(KR[3], qf[1][1], DST[1][1]); } while (0)
#define VLOAD4(VR, D0, KK, VBASE) do { _Pragma("unroll") for (int i_ = 0; i_ < 4; ++i_) VR[i_] = *(const bf16x8*)((VBASE) + VOFF + (((D0) + i_) * 16 + fr) * 144 + (KK) * 64 + fq * 16); } while (0)
#define PV4(VR, D0, PF) do { _Pragma("unroll") for (int i_ = 0; i_ < 4; ++i_) { o[(D0) + i_][0] = mfma16(VR[i_], PF[0], o[(D0) + i_][0]); o[(D0) + i_][1] = mfma16(VR[i_], PF[1], o[(D0) + i_][1]); } } while (0)
#define FENCE() __builtin_amdgcn_sched_barrier(0)
    AGLOAD(0); ASWRITE(0); AGLOAD(1); ASWRITE(1);
    for (int i = tid; i < 18432 / 16; i += NTHR) *(u32x4*)(lds + 3 * STG + VOFF + i * 16) = (u32x4){0u, 0u, 0u, 0u};
    __syncthreads();
    bf16x8 kr[4], va[4], vb[4];
    KLOAD(kr, 0, 1, lds); SMMAK(slo, kr);
    for (int kt = 0; kt < nkt; ++kt) {
        { const int ktl = kt + 2 < nkt ? kt + 2 : nkt - 1; AGLOAD(ktl); }
        const char* cur = lds + (kt & 3) * STG; const char* nxt = lds + ((kt + 1) & 3) * STG; const char* prv = lds + ((kt + 3) & 3) * STG;
        KLOAD(kr, 2, 3, cur); VLOAD4(va, 0, 1, prv);
        FENCE();
        SMMAK(shi, kr); VLOAD4(vb, 4, 1, prv); EXPQ(slo, 0, pflo);
        FENCE();
        PV4(va, 0, pfhi); KLOAD(kr, 0, 1, nxt); EXPQ(slo, 1, pflo);
        FENCE();
        PV4(vb, 4, pfhi); VLOAD4(va, 0, 0, cur);
        FENCE();
        SMMAK(slo, kr); VLOAD4(vb, 4, 0, cur); EXPQ(shi, 0, pfhi);
        FENCE();
        PV4(va, 0, pflo); EXPQ(shi, 1, pfhi);
        FENCE();
        PV4(vb, 4, pflo);
        FENCE();
        ASWRITE((kt + 2) & 3);
        __syncthreads();
    }
    { const char* prv = lds + ((nkt - 1) & 3) * STG; VLOAD4(va, 0, 1, prv); VLOAD4(vb, 4, 1, prv); PV4(va, 0, pfhi); PV4(vb, 4, pfhi); }
    __syncthreads();
#undef KLOAD
#undef SMMAK
#undef VLOAD4
#undef PV4
#undef FENCE
#undef EXPQ
#undef SMMA1
#undef PVMMA
#undef PV8
#undef AGLOAD
#undef ASWRITE
    float inv[2];
#pragma unroll
    for (int nt = 0; nt < 2; ++nt) { float v = l[nt]; v += sxor<16>(v); v += sxor<32>(v); inv[nt] = 1.0f / v; }
    float* xch = (float*)lds + sub * 4096;
    if (c == 1) {
#pragma unroll
        for (int dvt = 0; dvt < 8; ++dvt)
#pragma unroll
            for (int nt = 0; nt < 2; ++nt) {
                xch[(dvt * 16 + fq * 4 + 0) * 32 + nt * 16 + fr] = o[dvt][nt].x * inv[nt];
                xch[(dvt * 16 + fq * 4 + 1) * 32 + nt * 16 + fr] = o[dvt][nt].y * inv[nt];
                xch[(dvt * 16 + fq * 4 + 2) * 32 + nt * 16 + fr] = o[dvt][nt].z * inv[nt];
                xch[(dvt * 16 + fq * 4 + 3) * 32 + nt * 16 + fr] = o[dvt][nt].w * inv[nt];
            }
    }
    __syncthreads();
    if (c == 0) {
        float ss[2] = {0.f, 0.f};
#pragma unroll
        for (int dvt = 0; dvt < 8; ++dvt)
#pragma unroll
            for (int nt = 0; nt < 2; ++nt) {
                f32x4 v = o[dvt][nt] * inv[nt];
                v.x -= lam * xch[(dvt * 16 + fq * 4 + 0) * 32 + nt * 16 + fr];
                v.y -= lam * xch[(dvt * 16 + fq * 4 + 1) * 32 + nt * 16 + fr];
                v.z -= lam * xch[(dvt * 16 + fq * 4 + 2) * 32 + nt * 16 + fr];
                v.w -= lam * xch[(dvt * 16 + fq * 4 + 3) * 32 + nt * 16 + fr];
                o[dvt][nt] = v; ss[nt] += v.x * v.x + v.y * v.y + v.z * v.z + v.w * v.w;
            }
#pragma unroll
        for (int nt = 0; nt < 2; ++nt) {
            float v = ss[nt]; v += sxor<16>(v); v += sxor<32>(v);
            const float r = rsqrtf(v * (1.f / 128.f) + RMS_EPS) * 0.8f;
#pragma unroll
            for (int dvt = 0; dvt < 8; ++dvt) {
                const f32x4 gs = *(const f32x4*)(p.in[I_DGSUB] + dvt * 16 + fq * 4);
                const f32x4 v4 = o[dvt][nt];
                u32x2 w; w.x = pk2(v4.x * r * gs.x, v4.y * r * gs.y); w.y = pk2(v4.z * r * gs.z, v4.w * r * gs.w);
                *(u32x2*)(P + (size_t)(q0 + nt * 16 + fr) * NP + C_DQ + h * 128 + dvt * 16 + fq * 4) = w;
            }
        }
    }
    __syncthreads();
}

__device__ __forceinline__ void mem_attn_item(const Params& p, const Grp& G, int item, char* lds, float shift) {
    const int tid = otid(), lane = tid & 63, wid = tid >> 6, fr = lane & 15, fq = lane >> 4;
    const int T = G.T, nqb = T / 128;
    const int qb = item % nqb, bh = item / nqb, h = bh & 3, b = bh >> 2;
    bf16_t* P = (bf16_t*)(p.ws + WS_PROJ) + (size_t)b * T * NP;
    const bf16_t* MK = (const bf16_t*)(p.ws + WS_MEMK) + (size_t)((G.mb0 + b) * 4 + h) * 256 * 256;
    const bf16_t* MV = (const bf16_t*)(p.ws + WS_MEMV) + (size_t)((G.mb0 + b) * 4 + h) * 256 * 256;
    const int row = qb * 128 + wid * 16 + fr;
    bf16_t* qp = P + (size_t)row * NP + C_MQ + h * 256;
    bf16x8 qf[8];
    {
        float ss = 0.f; u32x4 raw[8];
#pragma unroll
        for (int ks = 0; ks < 8; ++ks) { raw[ks] = *(const u32x4*)(qp + ks * 32 + fq * 8);
            const float a0 = bflo(raw[ks].x), a1 = bfhi(raw[ks].x), a2 = bflo(raw[ks].y), a3 = bfhi(raw[ks].y), a4 = bflo(raw[ks].z), a5 = bfhi(raw[ks].z), a6 = bflo(raw[ks].w), a7 = bfhi(raw[ks].w);
            ss += a0 * a0 + a1 * a1 + a2 * a2 + a3 * a3 + a4 * a4 + a5 * a5 + a6 * a6 + a7 * a7; }
        ss += sxor<16>(ss); ss += sxor<32>(ss);
        const float r = rsqrtf(ss * (1.f / 256.f) + RMS_EPS) * (0.0625f * LOG2E);
#pragma unroll
        for (int ks = 0; ks < 8; ++ks) {
            const f32x4 g0 = *(const f32x4*)(p.in[I_MGQ] + ks * 32 + fq * 8), g1 = *(const f32x4*)(p.in[I_MGQ] + ks * 32 + fq * 8 + 4);
            u32x4 w;
            w.x = pk2(bflo(raw[ks].x) * r * g0.x, bfhi(raw[ks].x) * r * g0.y); w.y = pk2(bflo(raw[ks].y) * r * g0.z, bfhi(raw[ks].y) * r * g0.w);
            w.z = pk2(bflo(raw[ks].z) * r * g1.x, bfhi(raw[ks].z) * r * g1.y); w.w = pk2(bflo(raw[ks].w) * r * g1.z, bfhi(raw[ks].w) * r * g1.w);
            qf[ks] = __builtin_bit_cast(bf16x8, w);
        }
    }
    f32x4 o[16];
#pragma unroll
    for (int i = 0; i < 16; ++i) o[i] = (f32x4){0.f, 0.f, 0.f, 0.f};
    float l = 0.f;
    constexpr int KROW = 528, VOFF = 64 * 528;
    u32x4 mk[4], mv[4];
#define MLOAD(KT) do { _Pragma("unroll") for (int i = 0; i < 4; ++i) { const int idx = tid + i * 512; \
        mk[i] = *(const u32x4*)(MK + (size_t)((KT) * 64 + (idx >> 5)) * 256 + (idx & 31) * 8); mv[i] = *(const u32x4*)(MV + (size_t)(idx >> 3) * 256 + (KT) * 64 + (idx & 7) * 8); } } while (0)
    MLOAD(0);
    for (int kt = 0; kt < 4; ++kt) {
#pragma unroll
        for (int i = 0; i < 4; ++i) {
            const int idx = tid + i * 512;
            *(u32x4*)(lds + (idx >> 5) * KROW + (idx & 31) * 16) = mk[i];
            *(u32x4*)(lds + VOFF + (idx >> 3) * 144 + (idx & 7) * 16) = mv[i];
        }
        __syncthreads();
        if (kt + 1 < 4) MLOAD(kt + 1);
        __builtin_amdgcn_sched_barrier(0);
        f32x4 s[4];
#pragma unroll
        for (int mt = 0; mt < 4; ++mt) s[mt] = (f32x4){0.f, 0.f, 0.f, 0.f};
#pragma unroll
        for (int ks = 0; ks < 8; ks += 2) {
            bf16x8 kf[8];
#pragma unroll
            for (int u = 0; u < 8; ++u) kf[u] = *(const bf16x8*)(lds + ((u & 3) * 16 + fr) * KROW + (ks + (u >> 2)) * 64 + fq * 16);
            __builtin_amdgcn_sched_barrier(0);
#pragma unroll
            for (int u = 0; u < 8; ++u) s[u & 3] = mfma16(kf[u], qf[ks + (u >> 2)], s[u & 3]);
        }
        bf16x8 pf[2];
#pragma unroll
        for (int kk = 0; kk < 2; ++kk) {
            const f32x4 a = s[2 * kk], bb = s[2 * kk + 1];
            const float p0 = fexp2(a.x), p1 = fexp2(a.y), p2 = fexp2(a.z), p3 = fexp2(a.w);
            const float p4 = fexp2(bb.x), p5 = fexp2(bb.y), p6 = fexp2(bb.z), p7 = fexp2(bb.w);
            l += ((p0 + p1) + (p2 + p3)) + ((p4 + p5) + (p6 + p7));
            u32x4 w; w.x = pk2(p0, p1); w.y = pk2(p2, p3); w.z = pk2(p4, p5); w.w = pk2(p6, p7);
            pf[kk] = __builtin_bit_cast(bf16x8, w);
        }
#pragma unroll
        for (int kk = 0; kk < 2; ++kk)
#pragma unroll
            for (int d0 = 0; d0 < 16; d0 += 8) {
                bf16x8 vf[8];
#pragma unroll
                for (int u = 0; u < 8; ++u) vf[u] = *(const bf16x8*)(lds + VOFF + ((d0 + u) * 16 + fr) * 144 + kk * 64 + fq * 16);
                __builtin_amdgcn_sched_barrier(0);
#pragma unroll
                for (int u = 0; u < 8; ++u) o[d0 + u] = mfma16(vf[u], pf[kk], o[d0 + u]);
            }
        __syncthreads();
    }
#undef MLOAD
    l += sxor<16>(l); l += sxor<32>(l);
    const float inv = 1.0f / l;
#pragma unroll
    for (int dvt = 0; dvt < 16; ++dvt) {
        u32x2 w; w.x = pk2(o[dvt].x * inv, o[dvt].y * inv); w.y = pk2(o[dvt].z * inv, o[dvt].w * inv);
        *(u32x2*)(qp + dvt * 16 + fq * 4) = w;
    }
}

constexpr int L_QE = 0, L_KE = 17408, L_KST = 34816, L_VTL = 53248, L_ATT = 71680, L_SB = 80896, L_LRF = 115712, L_TOT = 119808, L_GDEC = 121856;
__device__ __forceinline__ void gla_item(const Params& p, const Grp& G, int item, char* lds) {
    const int tid = otid(), lane = tid & 63, wid = tid >> 6, fr = lane & 15, fq = lane >> 4;
    const int slice = item & 1, dir = (item >> 1) & 1, h = (item >> 2) & 3, b = item >> 4;
    const int T = G.T, N = T / 64;
    const bf16_t* P = (const bf16_t*)(p.ws + WS_PROJ) + (size_t)b * T * NP;
    bf16_t* OUT = dir ? (bf16_t*)(p.ws + WS_PROJ) + (size_t)b * T * NP + C_DV + h * 256 + slice * 128
                      : (bf16_t*)(p.ws + WS_HB) + (size_t)b * T * D + h * 256 + slice * 128;
    const int ldo = dir ? NP : D;
    const int amt = wid & 3, antg = wid >> 2;
    bf16x8 wdB[4]; float bd4[4];
    {
        const float* wd = p.in[dir ? I_WDB : I_WDF]; const float* bdp = p.in[dir ? I_BDB : I_BDF];
#pragma unroll
        for (int q = 0; q < 4; ++q) {
            const int col = h * 128 + (antg * 4 + q) * 16 + fr;
            u32x4 w = (u32x4){0u, 0u, 0u, 0u};
            if (fq < 2) { const float* wp = wd + (size_t)(fq * 8) * 512 + col;
                w.x = pk2(wp[0], wp[512]); w.y = pk2(wp[1024], wp[1536]); w.z = pk2(wp[2048], wp[2560]); w.w = pk2(wp[3072], wp[3584]); }
            wdB[q] = __builtin_bit_cast(bf16x8, w);
            bd4[q] = bdp[col];
        }
    }
    { unsigned z = 0u; asm volatile("" : "+v"(z)); for (int i = tid; i < 34816 / 16; i += NTHR) *(u32x4*)(lds + L_SB + i * 16) = (u32x4){z, z, z, z}; }
    f32x4 S[8];
#pragma unroll
    for (int i = 0; i < 8; ++i) S[i] = (f32x4){0.f, 0.f, 0.f, 0.f};
    u32x4 rq[2], rk[2], rv[2], rl;
    const int lrow = tid >> 4, lch = tid & 15;
#define GGLOAD(n) do { const int cb_ = (dir ? (N - 1 - (n)) : (n)) * 64; \
        _Pragma("unroll") for (int i = 0; i < 2; ++i) { const int li_ = lrow + i * 32, tk_ = cb_ + (dir ? 63 - li_ : li_); const bf16_t* rp_ = P + (size_t)tk_ * NP; \
            rq[i] = *(const u32x4*)(rp_ + C_GQ + h * 128 + lch * 8); rk[i] = *(const u32x4*)(rp_ + C_GK + h * 128 + lch * 8); rv[i] = *(const u32x4*)(rp_ + C_GV + h * 256 + slice * 128 + lch * 8); } \
        if (tid < 128) { const int li_ = tid >> 1, tk_ = cb_ + (dir ? 63 - li_ : li_); rl = *(const u32x4*)(P + (size_t)tk_ * NP + C_LR + dir * 16 + (tid & 1) * 8); } } while (0)
    GGLOAD(0);
    for (int n = 0; n < N; ++n) {
#pragma unroll
        for (int i = 0; i < 2; ++i) {
            const int li = lrow + i * 32;
            *(u32x4*)(lds + L_QE + li * 272 + lch * 16) = rq[i];
            *(u32x4*)(lds + L_KE + li * 272 + lch * 16) = rk[i];
            bf16_t* vt = (bf16_t*)(lds + L_VTL) + (lch * 8) * 72 + li;
            vt[0 * 72] = (bf16_t)(rv[i].x & 0xffff); vt[1 * 72] = (bf16_t)(rv[i].x >> 16); vt[2 * 72] = (bf16_t)(rv[i].y & 0xffff); vt[3 * 72] = (bf16_t)(rv[i].y >> 16);
            vt[4 * 72] = (bf16_t)(rv[i].z & 0xffff); vt[5 * 72] = (bf16_t)(rv[i].z >> 16); vt[6 * 72] = (bf16_t)(rv[i].w & 0xffff); vt[7 * 72] = (bf16_t)(rv[i].w >> 16);
        }
        if (tid < 128) *(u32x4*)(lds + L_LRF + (tid >> 1) * 32 + (tid & 1) * 16) = rl;
        if (n + 1 < N) GGLOAD(n + 1);
        __syncthreads();
        {
            u32x4 araw = (u32x4){0u, 0u, 0u, 0u};
            if (fq < 2) araw = *(const u32x4*)(lds + L_LRF + (amt * 16 + fr) * 32 + fq * 16);
            const bf16x8 afr = __builtin_bit_cast(bf16x8, araw);
            float pb[4][4]; float E[4], tt[4];
#pragma unroll
            for (int q = 0; q < 4; ++q) {
                const f32x4 x4 = mfma16(afr, wdB[q], (f32x4){bd4[q], bd4[q], bd4[q], bd4[q]});
                float run = 0.f;
#pragma unroll
                for (int j = 0; j < 4; ++j) {
                    const float x = x4[j];
                    const float ls = fminf(x, 0.f) - __logf(1.0f + __expf(-fabsf(x)));
                    run += ls * 0.0625f; pb[q][j] = run;
                }
                const float u = sxor<16>(run), v = run + u, w2 = sxor<32>(v);
                E[q] = ((fq & 1) ? u : 0.f) + ((fq & 2) ? w2 : 0.f);
                tt[q] = v + w2;
                if (fq == 0) ((float*)(lds + L_TOT))[amt * 128 + (antg * 4 + q) * 16 + fr] = tt[q];
            }
            __syncthreads();
#pragma unroll
            for (int q = 0; q < 4; ++q) {
                const int col = (antg * 4 + q) * 16 + fr;
                float off = 0.f, blast = 0.f;
#pragma unroll
                for (int r = 0; r < 4; ++r) { const float tv = ((const float*)(lds + L_TOT))[r * 128 + col]; blast += tv; if (r < amt) off += tv; }
                const float gcol = __expf(blast);
                bf16_t* qe = (bf16_t*)(lds + L_QE) + (amt * 16 + fq * 4) * 136 + col; bf16_t* ke = (bf16_t*)(lds + L_KE) + (amt * 16 + fq * 4) * 136 + col;
                float ksv[4];
#pragma unroll
                for (int j = 0; j < 4; ++j) {
                    const float bb = off + E[q] + pb[q][j];
                    const float qv = bf2f(qe[j * 136]), kv = bf2f(ke[j * 136]);
                    const float kd = kv * __expf(-bb);
                    qe[j * 136] = f2bf(qv * __expf(bb)); ke[j * 136] = f2bf(kd);
                    ksv[j] = kd * gcol;
                }
                *(u32x2*)(lds + L_KST + col * 144 + (amt * 16 + fq * 4) * 2) = (u32x2){pk2(ksv[0], ksv[1]), pk2(ksv[2], ksv[3])};
                if (amt == 0 && fq == 0) ((float*)(lds + L_GDEC))[col] = gcol;
            }
        }
        __syncthreads();
        {
            const int ct = wid & 3;
            f32x4 a[2] = {(f32x4){0.f, 0.f, 0.f, 0.f}, (f32x4){0.f, 0.f, 0.f, 0.f}};
            bf16x8 qv[4], kv[2][4];
#pragma unroll
            for (int ks = 0; ks < 4; ++ks) {
                qv[ks] = *(const bf16x8*)(lds + L_QE + (ct * 16 + fr) * 272 + ks * 64 + fq * 16);
#pragma unroll
                for (int j = 0; j < 2; ++j) kv[j][ks] = *(const bf16x8*)(lds + L_KE + (((wid >> 2) * 2 + j) * 16 + fr) * 272 + ks * 64 + fq * 16);
            }
            __builtin_amdgcn_sched_barrier(0);
#pragma unroll
            for (int ks = 0; ks < 4; ++ks)
#pragma unroll
                for (int j = 0; j < 2; ++j) a[j] = mfma16(kv[j][ks], qv[ks], a[j]);
#pragma unroll
            for (int j = 0; j < 2; ++j) {
                const int st = (wid >> 2) * 2 + j, cc = ct * 16 + fr, s0 = st * 16 + fq * 4;
                const float v0 = (s0 + 0 <= cc) ? a[j].x : 0.f, v1 = (s0 + 1 <= cc) ? a[j].y : 0.f, v2 = (s0 + 2 <= cc) ? a[j].z : 0.f, v3 = (s0 + 3 <= cc) ? a[j].w : 0.f;
                *(u32x2*)(lds + L_ATT + cc * 144 + s0 * 2) = (u32x2){pk2(v0, v1), pk2(v2, v3)};
            }
        }
        __syncthreads();
        {
            f32x4 oc[4] = {(f32x4){0.f, 0.f, 0.f, 0.f}, (f32x4){0.f, 0.f, 0.f, 0.f}, (f32x4){0.f, 0.f, 0.f, 0.f}, (f32x4){0.f, 0.f, 0.f, 0.f}};
            bf16x8 fa[2], fb[2][4], ga[2], gb[2][4];
#define LD_VA(FA, FB) do { _Pragma("unroll") for (int ks = 0; ks < 2; ++ks) { FA[ks] = *(const bf16x8*)(lds + L_VTL + (wid * 16 + fr) * 144 + ks * 64 + fq * 16); \
                _Pragma("unroll") for (int ct = 0; ct < 4; ++ct) FB[ks][ct] = *(const bf16x8*)(lds + L_ATT + (ct * 16 + fr) * 144 + ks * 64 + fq * 16); } } while (0)
#define LD_SQ(FA, FB, K0) do { _Pragma("unroll") for (int ks = 0; ks < 2; ++ks) { FA[ks] = *(const bf16x8*)(lds + L_SB + (wid * 16 + fr) * 272 + ((K0) + ks) * 64 + fq * 16); \
                _Pragma("unroll") for (int ct = 0; ct < 4; ++ct) FB[ks][ct] = *(const bf16x8*)(lds + L_QE + (ct * 16 + fr) * 272 + ((K0) + ks) * 64 + fq * 16); } } while (0)
#define MM10(FA, FB) do { _Pragma("unroll") for (int ks = 0; ks < 2; ++ks) _Pragma("unroll") for (int ct = 0; ct < 4; ++ct) oc[ct] = mfma16(FA[ks], FB[ks][ct], oc[ct]); } while (0)
            LD_VA(fa, fb); LD_SQ(ga, gb, 0);
            __builtin_amdgcn_sched_barrier(0);
            MM10(fa, fb); LD_SQ(fa, fb, 2);
            __builtin_amdgcn_sched_barrier(0);
            MM10(ga, gb);
            __builtin_amdgcn_sched_barrier(0);
            MM10(fa, fb);
#undef LD_VA
#undef LD_SQ
#undef MM10
            const int cb = (dir ? (N - 1 - n) : n) * 64;
#pragma unroll
            for (int ct = 0; ct < 4; ++ct) {
                const int cl = ct * 16 + fr, tk = cb + (dir ? 63 - cl : cl);
                *(u32x2*)(OUT + (size_t)tk * ldo + wid * 16 + fq * 4) = (u32x2){pk2(oc[ct].x, oc[ct].y), pk2(oc[ct].z, oc[ct].w)};
            }
        }
        __syncthreads();
        {
            const f32x4 gd = *(const f32x4*)((const float*)(lds + L_GDEC) + wid * 16 + fq * 4);
#pragma unroll
            for (int et = 0; et < 8; ++et) S[et] = S[et] * gd;
            bf16x8 da[2], db[2][8];
#pragma unroll
            for (int ks = 0; ks < 2; ++ks) {
                da[ks] = *(const bf16x8*)(lds + L_KST + (wid * 16 + fr) * 144 + ks * 64 + fq * 16);
#pragma unroll
                for (int et = 0; et < 8; ++et) db[ks][et] = *(const bf16x8*)(lds + L_VTL + (et * 16 + fr) * 144 + ks * 64 + fq * 16);
            }
            __builtin_amdgcn_sched_barrier(0);
#pragma unroll
            for (int ks = 0; ks < 2; ++ks)
#pragma unroll
                for (int et = 0; et < 8; ++et) S[et] = mfma16(da[ks], db[ks][et], S[et]);
#pragma unroll
            for (int et = 0; et < 8; ++et)
                *(u32x2*)(lds + L_SB + (et * 16 + fr) * 272 + (wid * 16 + fq * 4) * 2) = (u32x2){pk2(S[et].x, S[et].y), pk2(S[et].z, S[et].w)};
        }
        __syncthreads();
    }
#undef GGLOAD
}

__device__ __forceinline__ void phase_mixer(const Params& p, int g, char* lds, int* s_item) {
    const Grp G = get_group(p, g);
    const int nGLA = G.B * 16, nATT = G.B * 8 * (G.T / 128), nMEM = G.B * 4 * (G.T / 128);
    unsigned* ctr = (unsigned*)(p.ws + WS_CTRL) + g * 4;
    for (;;) {
        if (threadIdx.x == 0) *s_item = (int)atomicAdd(ctr + 0, 1u);
        __syncthreads();
        const int it = *s_item;
        __syncthreads();
        if (it >= nGLA) break;
        gla_item(p, G, it, lds);
    }
    {
        float d1 = 0.f, d2 = 0.f;
        for (int i = 0; i < 64; ++i) { d1 += p.in[I_LQ1][i] * p.in[I_LK1][i]; d2 += p.in[I_LQ2][i] * p.in[I_LK2][i]; }
        const float lam = expf(d1) - expf(d2) + 0.2f;
        for (;;) {
            if (threadIdx.x == 0) *s_item = (int)atomicAdd(ctr + 1, 1u);
            __syncthreads();
            const int it = *s_item;
            __syncthreads();
            if (it >= nATT) break;
            diff_attn_item(p, G, it, lds, lam, 0.f);
        }
    }
    for (;;) {
        if (threadIdx.x == 0) *s_item = (int)atomicAdd(ctr + 2, 1u);
        __syncthreads();
        const int it = *s_item;
        __syncthreads();
        if (it >= nMEM) break;
        mem_attn_item(p, G, it, lds, 0.f);
    }
}

__device__ __forceinline__ void phase_glafin(const Params& p, int g, int tok0, int ntok) {
    const int tid_ = otid(), lane = tid_ & 63, wid = tid_ >> 6;
    bf16_t* P = (bf16_t*)(p.ws + WS_PROJ); const bf16_t* F = (const bf16_t*)(p.ws + WS_HB);
    unsigned qq, kk; u32x2 f, bk, v, gt;
#define GFLOAD(IT) do { const int tok_ = (IT) >> 2, h_ = (IT) & 3; const bf16_t* row_ = P + (size_t)tok_ * NP; \
        qq = *(const unsigned*)(row_ + C_GQ + h_ * 128 + lane * 2); kk = *(const unsigned*)(row_ + C_GK + h_ * 128 + lane * 2); \
        f = *(const u32x2*)(F + (size_t)tok_ * D + h_ * 256 + lane * 4); bk = *(const u32x2*)(row_ + C_DV + h_ * 256 + lane * 4); \
        v = *(const u32x2*)(row_ + C_GV + h_ * 256 + lane * 4); gt = *(const u32x2*)(row_ + C_GG + h_ * 256 + lane * 4); } while (0)
    const f32x4 go = *(const f32x4*)(launder(p.in[I_GOUT]) + lane * 4);
    GFLOAD(tok0 * 4 + wid);
    for (int it = tok0 * 4 + wid; it < (tok0 + ntok) * 4; it += 8) {
        const int tok = it >> 2, h = it & 3;
        bf16_t* row = P + (size_t)tok * NP;
        const unsigned cq = qq, ck = kk; const u32x2 cf = f, cbk = bk, cv = v, cgt = gt;
        if (it + 8 < (tok0 + ntok) * 4) GFLOAD(it + 8);
        __builtin_amdgcn_sched_barrier(0);
        const float qk = wave_sum(bflo(cq) * bflo(ck) + bfhi(cq) * bfhi(ck));
        float o0 = bflo(cf.x) + bflo(cbk.x) - qk * bflo(cv.x), o1 = bfhi(cf.x) + bfhi(cbk.x) - qk * bfhi(cv.x);
        float o2 = bflo(cf.y) + bflo(cbk.y) - qk * bflo(cv.y), o3 = bfhi(cf.y) + bfhi(cbk.y) - qk * bfhi(cv.y);
        const float r = rsqrtf(wave_sum(o0 * o0 + o1 * o1 + o2 * o2 + o3 * o3) * (1.f / 256.f) + RMS_EPS);
        const float g0 = bflo(cgt.x), g1 = bfhi(cgt.x), g2 = bflo(cgt.y), g3 = bfhi(cgt.y);
        o0 *= r * go.x * g0 / (1.f + __expf(-g0)); o1 *= r * go.y * g1 / (1.f + __expf(-g1));
        o2 *= r * go.z * g2 / (1.f + __expf(-g2)); o3 *= r * go.w * g3 / (1.f + __expf(-g3));
        *(u32x2*)(row + C_GG + h * 256 + lane * 4) = (u32x2){pk2(o0, o1), pk2(o2, o3)};
    }
#undef GFLOAD
}

__device__ __forceinline__ void phase_merge(const Params& p, int g, char* lds, int u) {
    const int tid_ = otid(), lane = tid_ & 63, wid = tid_ >> 6, wm = wid >> 2, wn = wid & 3, fr = lane & 15, fq = lane >> 4;
    const bf16_t* P = (const bf16_t*)(p.ws + WS_PROJ); bf16_t* M = (bf16_t*)(p.ws + WS_VT);
    for (int pn = 0; pn < 4; ++pn) {
        const int m0 = u * 128, n0 = pn * 256;
        f32x4 macc[4][4];
#pragma unroll
        for (int i = 0; i < 4; ++i)
#pragma unroll
            for (int j = 0; j < 4; ++j) macc[i][j] = (f32x4){0.f, 0.f, 0.f, 0.f};
        for (int br = 0; br < 3; ++br) {
            f32x4 acc[4][4];
#pragma unroll
            for (int i = 0; i < 4; ++i)
#pragma unroll
                for (int j = 0; j < 4; ++j) acc[i][j] = (f32x4){0.f, 0.f, 0.f, 0.f};
            const int acol = br == 0 ? C_GG : (br == 1 ? C_DQ : C_MQ);
            gemm_kloop<true, 4>(acc, P + (size_t)m0 * NP + acol, NP, (const bf16_t*)(p.ws + WS_WOT) + (size_t)br * D * D + (size_t)n0 * D, D, D, lds);
#pragma unroll
            for (int mt = 0; mt < 4; ++mt)
#pragma unroll
                for (int nt = 0; nt < 4; ++nt) {
                    const int row = m0 + wm * 64 + mt * 16 + fr, col = n0 + wn * 64 + nt * 16 + fq * 4;
                    const u32x2 gt = *(const u32x2*)(P + (size_t)row * NP + C_BG + br * 1024 + col);
                    f32x4 sg; sg.x = 1.f / (1.f + __expf(-bflo(gt.x))); sg.y = 1.f / (1.f + __expf(-bfhi(gt.x))); sg.z = 1.f / (1.f + __expf(-bflo(gt.y))); sg.w = 1.f / (1.f + __expf(-bfhi(gt.y)));
                    macc[mt][nt] += sg * acc[mt][nt];
                }
        }
#pragma unroll
        for (int mt = 0; mt < 4; ++mt)
#pragma unroll
            for (int nt = 0; nt < 4; ++nt) {
                const int row = m0 + wm * 64 + mt * 16 + fr, col = n0 + wn * 64 + nt * 16 + fq * 4;
                *(u32x2*)(M + (size_t)row * D + col) = (u32x2){pk2(macc[mt][nt].x, macc[mt][nt].y), pk2(macc[mt][nt].z, macc[mt][nt].w)};
            }
    }
}

__device__ __forceinline__ void phase_outproj(const Params& p, int g, char* lds, int u) {
    const Grp G = get_group(p, g);
    const int tid_ = otid(), lane = tid_ & 63, wid = tid_ >> 6, wm = wid >> 2, wn = wid & 3, fr = lane & 15, fq = lane >> 4;
    const bf16_t* M = (const bf16_t*)(p.ws + WS_VT); const bf16_t* W = (const bf16_t*)(p.ws + WS_WOT) + (size_t)3 * D * D;
    for (int pn = 0; pn < 4; ++pn) {
        const int m0 = u * 128, n0 = pn * 256;
        f32x4 acc[4][4];
#pragma unroll
        for (int i = 0; i < 4; ++i)
#pragma unroll
            for (int j = 0; j < 4; ++j) acc[i][j] = (f32x4){0.f, 0.f, 0.f, 0.f};
        gemm_kloop<true, 4>(acc, M + (size_t)m0 * D, D, W + (size_t)n0 * D, D, D, lds);
#pragma unroll
        for (int mt = 0; mt < 4; ++mt)
#pragma unroll
            for (int nt = 0; nt < 4; ++nt) {
                const int row = m0 + wm * 64 + mt * 16 + fr, col = n0 + wn * 64 + nt * 16 + fq * 4;
                const f32x4 xv = *(const f32x4*)(G.x + (size_t)row * D + col);
                *(f32x4*)(G.out + (size_t)row * D + col) = xv + acc[mt][nt];
            }
    }
}

__device__ __forceinline__ void phase_peerq(const Params& p, int g, char* lds, int u) {
    const int tid_ = otid(), lane = tid_ & 63, wid = tid_ >> 6, wm = wid >> 2, wn = wid & 3, fr = lane & 15, fq = lane >> 4;
    const bf16_t* A = (const bf16_t*)(p.ws + WS_HB); const bf16_t* W = (const bf16_t*)(p.ws + WS_WQT); bf16_t* P = (bf16_t*)(p.ws + WS_PROJ);
    for (int pn = 0; pn < 8; ++pn) {
        const int m0 = u * 128, n0 = pn * 256;
        f32x4 acc[4][4];
#pragma unroll
        for (int i = 0; i < 4; ++i)
#pragma unroll
            for (int j = 0; j < 4; ++j) acc[i][j] = (f32x4){0.f, 0.f, 0.f, 0.f};
        gemm_kloop<true, 4>(acc, A + (size_t)m0 * D, D, W + (size_t)n0 * D, D, D, lds);
#pragma unroll
        for (int mt = 0; mt < 4; ++mt)
#pragma unroll
            for (int nt = 0; nt < 4; ++nt) {
                const int row = m0 + wm * 64 + mt * 16 + fr, col = n0 + wn * 64 + nt * 16 + fq * 4;
                *(u32x2*)(P + (size_t)row * NP + col) = (u32x2){pk2(acc[mt][nt].x, acc[mt][nt].y), pk2(acc[mt][nt].z, acc[mt][nt].w)};
            }
    }
}

__device__ __forceinline__ unsigned f2ord(float f) { const unsigned u = __float_as_uint(f); return (u & 0x80000000u) ? ~u : (u | 0x80000000u); }
__device__ __forceinline__ float ord2f(unsigned k) { const unsigned u = (k & 0x80000000u) ? (k & 0x7fffffffu) : ~k; return __uint_as_float(u); }
__device__ __forceinline__ unsigned gmax16(unsigned v) {
    unsigned t;
    t = sxoru<1>(v); v = v > t ? v : t; t = sxoru<2>(v); v = v > t ? v : t; t = sxoru<4>(v); v = v > t ? v : t; t = sxoru<8>(v); v = v > t ? v : t;
    return v;
}
__device__ __forceinline__ float gsum16(float v) { v += sxor<1>(v); v += sxor<2>(v); v += sxor<4>(v); v += sxor<8>(v); return v; }
__device__ __forceinline__ float gelu_exact(float a) { return 0.5f * a * (1.0f + erff(a * 0.70710678118654752f)); }

__device__ __forceinline__ void phase_peer(const Params& p, int g, char* lds, int tile0, int ntile) {
    const Grp G = get_group(p, g);
    const int tid = otid(), lane = tid & 63, wid = tid >> 6, fr = lane & 15, fq = lane >> 4;
    const bf16_t* P = (const bf16_t*)(p.ws + WS_PROJ); const bf16_t* HB = (const bf16_t*)(p.ws + WS_HB);
    const bf16_t* K12 = (const bf16_t*)(p.ws + WS_K12);
    float* SC = (float*)lds;
    int* EIDX = (int*)(lds + 65536);
    float* GATE = (float*)(lds + 65536 + 4096);
    char* KL = lds + 73728;
    for (int i = tid; i < 2 * 128 * 16; i += NTHR) {
        const int r = i >> 4, ch = i & 15;
        *(u32x4*)(KL + r * 272 + ch * 16) = *(const u32x4*)(K12 + (size_t)r * 128 + ch * 8);
    }
    __syncthreads();
    for (int tile = tile0; tile < tile0 + ntile; ++tile) {
        const int tok0 = tile * 8;
        {
            const bf16_t* qtok = P + (size_t)(tok0 + wid) * NP + (fr & 7) * 256;
#pragma unroll
            for (int half = 0; half < 2; ++half) {
                f32x4 acc[8];
#pragma unroll
                for (int i = 0; i < 8; ++i) acc[i] = (f32x4){0.f, 0.f, 0.f, 0.f};
#pragma unroll
                for (int ks = 0; ks < 4; ++ks) {
                    const bf16x8 af = *(const bf16x8*)(qtok + half * 128 + ks * 32 + fq * 8);
#pragma unroll
                    for (int nt = 0; nt < 8; ++nt) { const bf16x8 bfv = *(const bf16x8*)(KL + (half * 128 + nt * 16 + fr) * 272 + ks * 64 + fq * 16); acc[nt] = mfma16(af, bfv, acc[nt]); }
                }
                if (fq < 2) {
#pragma unroll
                    for (int nt = 0; nt < 8; ++nt) {
                        float* dst = SC + (wid * 8 + fq * 4) * 256 + half * 128 + nt * 16 + fr;
                        dst[0] = acc[nt].x; dst[256] = acc[nt].y; dst[512] = acc[nt].z; dst[768] = acc[nt].w;
                    }
                }
            }
        }
        __builtin_amdgcn_wave_barrier();
        for (int pass = 0; pass < 2; ++pass) {
            const int row = wid * 8 + pass * 4 + fq, sl = fr, gb = fq * 16;
            float v1 = 0.f, v2 = 0.f; int i1 = 0, i2 = 0;
#pragma unroll
            for (int hf = 0; hf < 2; ++hf) {
                unsigned key[8];
#pragma unroll
                for (int i = 0; i < 8; ++i) { const int idx = sl + 16 * i; key[i] = (f2ord(SC[row * 256 + hf * 128 + idx]) & ~127u) | (unsigned)(127 - idx); }
                float sv = 0.f; int si = 0;
                for (int r = 0; r < 16; ++r) {
                    unsigned m = key[0];
#pragma unroll
                    for (int i = 1; i < 8; ++i) m = m > key[i] ? m : key[i];
                    m = gmax16(m);
                    if (sl == r) { sv = ord2f(m & ~127u); si = 127 - (int)(m & 127u); }
#pragma unroll
                    for (int i = 0; i < 8; ++i) key[i] = key[i] == m ? 0u : key[i];
                }
                if (hf == 0) { v1 = sv; i1 = si; } else { v2 = sv; i2 = si; }
            }
            int ptr = 0; float ts = 0.f; int pid = 0;
            for (int r = 0; r < 16; ++r) {
                const float v2p = __int_as_float(__builtin_amdgcn_ds_bpermute((gb + (ptr & 15)) << 2, __float_as_int(v2)));
                const unsigned key = ptr < 16 ? ((f2ord(v1 + v2p) & ~255u) | (unsigned)(255 - (sl * 16 + ptr))) : 0u;
                const unsigned m = gmax16(key);
                if (sl == r) { ts = ord2f(m & ~255u); pid = 255 - (int)(m & 255u); }
                if (key == m) ptr++;
            }
            const int e1 = __builtin_amdgcn_ds_bpermute((gb + (pid >> 4)) << 2, i1), e2 = __builtin_amdgcn_ds_bpermute((gb + (pid & 15)) << 2, i2);
            float mx = ts;
            mx = fmaxf(mx, sxor<1>(mx)); mx = fmaxf(mx, sxor<2>(mx)); mx = fmaxf(mx, sxor<4>(mx)); mx = fmaxf(mx, sxor<8>(mx));
            const float ex = __expf(ts - mx), sm = gsum16(ex);
            EIDX[row * 16 + sl] = e1 * 128 + e2; GATE[row * 16 + sl] = ex / sm;
        }
        __builtin_amdgcn_wave_barrier();
        {
            const int tok = tok0 + wid;
            const bf16_t* hrow = HB + (size_t)tok * D;
            const int grp = lane >> 4, sl = lane & 15;
            {
                f32x2 hv[32];
#pragma unroll
                for (int c = 0; c < 8; ++c) {
                    const u32x4 hq = *(const u32x4*)(hrow + sl * 64 + c * 8);
                    hv[c * 4 + 0] = (f32x2){bflo(hq.x), bfhi(hq.x)} * (1.0f / PEER_SU); hv[c * 4 + 1] = (f32x2){bflo(hq.y), bfhi(hq.y)} * (1.0f / PEER_SU);
                    hv[c * 4 + 2] = (f32x2){bflo(hq.z), bfhi(hq.z)} * (1.0f / PEER_SU); hv[c * 4 + 3] = (f32x2){bflo(hq.w), bfhi(hq.w)} * (1.0f / PEER_SU);
                }
                const unsigned char* PU8 = p.ws + WS_PU + sl * 64;
#define ULOADG(BUF, IT) do { _Pragma("unroll") for (int i_ = 0; i_ < 2; ++i_) { const int k_ = ((IT) + i_) * 4 + grp; const unsigned char* ur_ = PU8 + (size_t)EIDX[wid * 128 + k_] * D; \
        BUF[i_ * 4 + 0] = *(const u32x4*)ur_; BUF[i_ * 4 + 1] = *(const u32x4*)(ur_ + 16); BUF[i_ * 4 + 2] = *(const u32x4*)(ur_ + 32); BUF[i_ * 4 + 3] = *(const u32x4*)(ur_ + 48); } } while (0)
#define PDOT(uq, base) \
        a2 += __builtin_amdgcn_cvt_pk_f32_fp8((int)uq.x, false) * hv[base + 0]; b2 += __builtin_amdgcn_cvt_pk_f32_fp8((int)uq.x, true) * hv[base + 1]; \
        a2 += __builtin_amdgcn_cvt_pk_f32_fp8((int)uq.y, false) * hv[base + 2]; b2 += __builtin_amdgcn_cvt_pk_f32_fp8((int)uq.y, true) * hv[base + 3]; \
        a2 += __builtin_amdgcn_cvt_pk_f32_fp8((int)uq.z, false) * hv[base + 4]; b2 += __builtin_amdgcn_cvt_pk_f32_fp8((int)uq.z, true) * hv[base + 5]; \
        a2 += __builtin_amdgcn_cvt_pk_f32_fp8((int)uq.w, false) * hv[base + 6]; b2 += __builtin_amdgcn_cvt_pk_f32_fp8((int)uq.w, true) * hv[base + 7];
#define UCOMP(BUF, IT) do { _Pragma("unroll") for (int i_ = 0; i_ < 2; ++i_) { const int k_ = ((IT) + i_) * 4 + grp; \
        f32x2 a2 = (f32x2){0.f, 0.f}, b2 = (f32x2){0.f, 0.f}; \
        PDOT(BUF[i_ * 4 + 0], 0) PDOT(BUF[i_ * 4 + 1], 8) PDOT(BUF[i_ * 4 + 2], 16) PDOT(BUF[i_ * 4 + 3], 24) \
        a2 += b2; const float a_ = gsum16(a2.x + a2.y); GATE[wid * 128 + k_] = GATE[wid * 128 + k_] * gelu_exact(a_); } } while (0)
                u32x4 ubA[8], ubB[8];
                ULOADG(ubA, 0);
                for (int it0 = 0; it0 < 32; it0 += 4) {
                    ULOADG(ubB, it0 + 2);
                    __builtin_amdgcn_sched_barrier(0);
                    UCOMP(ubA, it0);
                    __builtin_amdgcn_sched_barrier(0);
                    if (it0 + 4 < 32) ULOADG(ubA, it0 + 4);
                    __builtin_amdgcn_sched_barrier(0);
                    UCOMP(ubB, it0 + 2);
                    __builtin_amdgcn_sched_barrier(0);
                }
#undef ULOADG
#undef PDOT
#undef UCOMP
            }
            __builtin_amdgcn_wave_barrier();
            f32x2 acc[8];
#pragma unroll
            for (int i = 0; i < 8; ++i) acc[i] = (f32x2){0.f, 0.f};
            const unsigned char* PV8 = p.ws + WS_PV + lane * 16;
#define VLOADG(BUF, K0) do { _Pragma("unroll") for (int i_ = 0; i_ < 8; ++i_) BUF[i_] = *(const u32x4*)(PV8 + (size_t)EIDX[wid * 128 + (K0) + i_] * D); } while (0)
#define VCOMP(BUF, K0) do { _Pragma("unroll") for (int i_ = 0; i_ < 8; ++i_) { const float w_ = GATE[wid * 128 + (K0) + i_]; const f32x2 w2 = (f32x2){w_, w_}; const u32x4 v = BUF[i_]; \
        acc[0] += w2 * __builtin_amdgcn_cvt_pk_f32_fp8((int)v.x, false); acc[1] += w2 * __builtin_amdgcn_cvt_pk_f32_fp8((int)v.x, true); \
        acc[2] += w2 * __builtin_amdgcn_cvt_pk_f32_fp8((int)v.y, false); acc[3] += w2 * __builtin_amdgcn_cvt_pk_f32_fp8((int)v.y, true); \
        acc[4] += w2 * __builtin_amdgcn_cvt_pk_f32_fp8((int)v.z, false); acc[5] += w2 * __builtin_amdgcn_cvt_pk_f32_fp8((int)v.z, true); \
        acc[6] += w2 * __builtin_amdgcn_cvt_pk_f32_fp8((int)v.w, false); acc[7] += w2 * __builtin_amdgcn_cvt_pk_f32_fp8((int)v.w, true); } } while (0)
            {
                u32x4 vbA[8], vbB[8];
                VLOADG(vbA, 0);
                for (int k0 = 0; k0 < 128; k0 += 16) {
                    VLOADG(vbB, k0 + 8);
                    __builtin_amdgcn_sched_barrier(0);
                    VCOMP(vbA, k0);
                    __builtin_amdgcn_sched_barrier(0);
                    if (k0 + 16 < 128) VLOADG(vbA, k0 + 16);
                    __builtin_amdgcn_sched_barrier(0);
                    VCOMP(vbB, k0 + 8);
                    __builtin_amdgcn_sched_barrier(0);
                }
            }
#undef VLOADG
#undef VCOMP
            float* orow = G.out + (size_t)tok * D + lane * 16;
#pragma unroll
            for (int i = 0; i < 4; ++i) {
                f32x4 t = *(f32x4*)(orow + i * 4);
                t.x += acc[2 * i].x * (1.0f / PEER_SV); t.y += acc[2 * i].y * (1.0f / PEER_SV); t.z += acc[2 * i + 1].x * (1.0f / PEER_SV); t.w += acc[2 * i + 1].y * (1.0f / PEER_SV);
                *(f32x4*)(orow + i * 4) = t;
            }
        }
        __builtin_amdgcn_wave_barrier();
    }
}


constexpr int NPH = 3 + NGROUP * 3;
__device__ __forceinline__ void run_phase(const Params& p, int ph, char* lds, int* s_item) {
    const int g = (ph - 3) / 3, s = (ph - 3) % 3;
    const Grp G = get_group(p, g);
    if (s == 0) {
        for (int u = blockIdx.x; u < 256; u += gridDim.x) {
            const int m0 = (u >> 1) * 256;
            phase_rmsnorm(G.x, p.in[I_GMIX], (bf16_t*)(p.ws + WS_HB), m0, 256);
            __syncthreads();
            phase_inproj(p, g, lds, u);
            __syncthreads();
        }
    } else if (s == 1) {
        phase_mixer(p, g, lds, s_item);
    } else {
        for (int u = blockIdx.x; u < 256; u += gridDim.x) {
            const int m0 = u * 128;
            phase_glafin(p, g, m0, 128);
            __syncthreads();
            phase_merge(p, g, lds, u);
            __syncthreads();
            phase_outproj(p, g, lds, u);
            __syncthreads();
            phase_rmsnorm(G.out, p.in[I_GFFN], (bf16_t*)(p.ws + WS_HB), m0, 128);
            __syncthreads();
            phase_peerq(p, g, lds, u);
            __syncthreads();
            phase_peer(p, g, lds, m0 / 8, 16);
            __syncthreads();
        }
    }
}

__global__ void __launch_bounds__(NTHR) mega_kernel(Params p) {
    extern __shared__ __attribute__((aligned(16))) char lds[];
    __shared__ int s_item;
    cg::grid_group grid = cg::this_grid();
    phase_p0a(p, lds); grid.sync();
    phase_p0b(p, lds); grid.sync();
    phase_p0c(p); grid.sync();
    for (int ph = 3; ph < NPH; ++ph) {
        run_phase(p, ph, lds, &s_item);
        if (ph + 1 < NPH) grid.sync();
    }
}

extern "C" void kernel_launch(void* const* d_in, const int* in_sizes, int n_in, void* d_out, int out_size, void* d_ws, size_t ws_size, hipStream_t stream) {
    static int grid_blocks = 0;
    if (grid_blocks == 0) {
        if (n_in != 32 || ws_size < WS_END) { fprintf(stderr, "kernel_launch: unexpected n_in %d or ws_size %zu (< %zu)\n", n_in, ws_size, (size_t)WS_END); grid_blocks = -1; return; }
        int dev = 0, cus = 0, per_cu = 0;
        hipGetDevice(&dev);
        hipDeviceGetAttribute(&cus, hipDeviceAttributeMultiprocessorCount, dev);
        hipFuncSetAttribute((const void*)mega_kernel, hipFuncAttributeMaxDynamicSharedMemorySize, LDS_BYTES);
        hipOccupancyMaxActiveBlocksPerMultiprocessor(&per_cu, (const void*)mega_kernel, NTHR, LDS_BYTES);
        if (per_cu < 1) per_cu = 1;
        grid_blocks = cus * per_cu;
        (void)hipGetLastError();
    }
    if (grid_blocks < 0) return;
    Params p{};
    for (int i = 0; i < 32; ++i) p.in[i] = (const float*)d_in[i];
    p.out = (float*)d_out; p.ws = (unsigned char*)d_ws; p.ph_lo = 0; p.ph_hi = NPH;
    void* args[] = {&p};
    hipError_t e = hipLaunchCooperativeKernel((const void*)mega_kernel, dim3(grid_blocks), dim3(NTHR), args, LDS_BYTES, stream);
    if (e != hipSuccess) fprintf(stderr, "cooperative launch failed: %s (grid %d)\n", hipGetErrorString(e), grid_blocks);
}
```

```cpp
#include <hip/hip_runtime.h>
#include <hip/hip_cooperative_groups.h>
#include <cstdio>
#include <cstdint>
namespace cg = cooperative_groups;

typedef unsigned short bf16_t;
typedef short bf16x8 __attribute__((ext_vector_type(8)));
typedef float f32x4 __attribute__((ext_vector_type(4)));
typedef unsigned u32x4 __attribute__((ext_vector_type(4)));
typedef unsigned u32x2 __attribute__((ext_vector_type(2)));

constexpr int D = 1024;
constexpr int NP = 10496;
constexpr int IN_COLS = 10272;
constexpr int C_GQ = 0, C_GK = 512, C_GV = 1024, C_GG = 2048, C_DQ = 3072, C_DK = 4096, C_DV = 5120, C_MQ = 6144, C_BG = 7168, C_LR = 10240;
constexpr int G_TOK = 32768;
constexpr int NGROUP = 3;
constexpr int NTHR = 512;
constexpr float RMS_EPS = 1e-6f;
constexpr float LOG2E = 1.4426950408889634f;
constexpr int LDS_BYTES = 147456;
constexpr float PEER_SU = 32.0f, PEER_SV = 8.0f;

enum { I_XP = 0, I_XS, I_MP, I_MS, I_GMIX, I_WIN, I_WDF, I_BDF, I_WDB, I_BDB, I_GOUT, I_GWO, I_DGQ, I_DGK, I_LQ1, I_LK1, I_LQ2, I_LK2,
       I_DGSUB, I_DWO, I_MGN, I_MWKV, I_MGQ, I_MGK, I_MWO, I_WOUT, I_GFFN, I_PWQ, I_PK1, I_PK2, I_PU, I_PV };

constexpr size_t al256(size_t x) { return (x + 255) & ~(size_t)255; }
constexpr size_t WS_CTRL = 0;
constexpr size_t WS_PROJ = 4096;
constexpr size_t WS_HB   = WS_PROJ + (size_t)G_TOK * NP * 2;
constexpr size_t WS_VT   = WS_HB + (size_t)G_TOK * D * 2;
constexpr size_t WS_WINT = WS_VT + (size_t)G_TOK * D * 2;
constexpr size_t WS_WOT  = WS_WINT + (size_t)NP * D * 2;
constexpr size_t WS_WKVT = WS_WOT + (size_t)4 * D * D * 2;
constexpr size_t WS_WQT  = WS_WKVT + (size_t)2048 * D * 2;
constexpr size_t WS_PU   = WS_WQT + (size_t)2048 * D * 2;
constexpr size_t WS_PV   = WS_PU + (size_t)16384 * D * 2;
constexpr size_t WS_K12  = WS_PV + (size_t)16384 * D * 2;
constexpr size_t WS_ROPE = WS_K12 + (size_t)2 * 128 * 128 * 2;
constexpr size_t WS_HM   = WS_ROPE + (size_t)16384 * 64 * 4;
constexpr size_t WS_KVR  = WS_HM + (size_t)2560 * D * 2;
constexpr size_t WS_MEMK = WS_KVR + (size_t)2560 * 2048 * 4;
constexpr size_t WS_MEMV = WS_MEMK + (size_t)10 * 4 * 256 * 256 * 2;
constexpr size_t WS_END  = WS_MEMV + (size_t)10 * 4 * 256 * 256 * 2;

struct Params {
    const float* in[32];
    float* out;
    unsigned char* ws;
    int ph_lo, ph_hi;
};

typedef float f32x2 __attribute__((ext_vector_type(2)));
typedef __bf16 bf16x2v __attribute__((ext_vector_type(2)));
__device__ __forceinline__ unsigned pk2(float lo, float hi) { const f32x2 v = {lo, hi}; const bf16x2v b = __builtin_convertvector(v, bf16x2v); return __builtin_bit_cast(unsigned, b); }
__device__ __forceinline__ float bflo(unsigned u) { return __uint_as_float(u << 16); }
__device__ __forceinline__ float bfhi(unsigned u) { return __uint_as_float(u & 0xffff0000u); }
__device__ __forceinline__ float bf2f(bf16_t b) { return __uint_as_float(((unsigned)b) << 16); }
__device__ __forceinline__ bf16_t f2bf(float f) { return (bf16_t)(pk2(f, 0.f) & 0xffffu); }
__device__ __forceinline__ f32x4 mfma16(bf16x8 a, bf16x8 b, f32x4 c) { return __builtin_amdgcn_mfma_f32_16x16x32_bf16(a, b, c, 0, 0, 0); }
__device__ __forceinline__ float fexp2(float x) { return __builtin_amdgcn_exp2f(x); }
template <class T> __device__ __forceinline__ T* launder(T* q) { asm volatile("" : "+s"(q)); return q; }
__device__ __forceinline__ int otid() { int t = threadIdx.x; asm volatile("" : "+v"(t)); return t; }
template <int M> __device__ __forceinline__ float sxor(float v) {
    if (M < 32) return __int_as_float(__builtin_amdgcn_ds_swizzle(__float_as_int(v), (M << 10) | 0x1F));
    const int l = otid() & 63; return __int_as_float(__builtin_amdgcn_ds_bpermute((l ^ 32) << 2, __float_as_int(v)));
}
template <int M> __device__ __forceinline__ unsigned sxoru(unsigned v) { return (unsigned)__builtin_amdgcn_ds_swizzle((int)v, (M << 10) | 0x1F); }
__device__ __forceinline__ float wave_sum(float v) {
    v += sxor<1>(v); v += sxor<2>(v); v += sxor<4>(v); v += sxor<8>(v); v += sxor<16>(v); v += sxor<32>(v);
    return v;
}

struct Grp { const float* x; const float* mem; float* out; int B, T, mb0; };
__device__ __forceinline__ Grp get_group(const Params& p, int g) {
    Grp r;
    if (g == 0) { r.x = p.in[I_XP]; r.out = p.out; r.B = 2; r.T = 16384; r.mb0 = 0; }
    else { r.x = p.in[I_XS] + (size_t)(g - 1) * G_TOK * D; r.out = p.out + (size_t)g * G_TOK * D; r.B = 4; r.T = 8192; r.mb0 = 2 + (g - 1) * 4; }
    r.mem = nullptr;
    return r;
}

constexpr int G_ROW = 144;
constexpr int G_A_BYTES = 128 * G_ROW;
constexpr int G_B_BYTES = 256 * G_ROW;
constexpr int G_STAGE = G_A_BYTES + G_B_BYTES;

template <bool SWAP, int MT>
__device__ __forceinline__ void gemm_kloop(f32x4 (&acc)[MT][4], const bf16_t* __restrict__ A, int lda, const bf16_t* __restrict__ Bt, int ldb, int K, char* lds) {
    constexpr int A_ROWS = MT * 32, A_BYTES = A_ROWS * G_ROW, STAGE = A_BYTES + G_B_BYTES;
    constexpr int NA = A_BYTES / 1024, NI = STAGE / 1024, NPER = (NI + 7) / 8;
    const int tid = otid(), lane = tid & 63, wid = __builtin_amdgcn_readfirstlane(tid >> 6), wm = wid >> 2, wn = wid & 3, fr = lane & 15, fq = lane >> 4;
    unsigned goff[NPER];
#pragma unroll
    for (int i = 0; i < NPER; ++i) {
        const int j = wid + 8 * i;
        const int ci = (j < NA ? j : j - NA) * 64 + lane, row = ci / 9, ch = ci % 9, chc = ch < 8 ? ch : 7;
        goff[i] = (unsigned)(row * (j < NA ? lda : ldb) + chc * 8);
    }
#define GSTAGE(buf, k0) do { _Pragma("unroll") for (int i = 0; i < NPER; ++i) { const int j = wid + 8 * i; if (j < NI) { \
        const bf16_t* src_ = (j < NA ? A : Bt) + goff[i] + (k0); \
        __builtin_amdgcn_global_load_lds((const unsigned*)src_, (unsigned*)(lds + (buf) * STAGE + j * 1024), 16, 0, 0); } } } while (0)
    const int nk = K / 64;
    GSTAGE(0, 0);
    __syncthreads();
    for (int kt = 0; kt < nk; ++kt) {
        if (kt + 1 < nk) GSTAGE((kt + 1) & 1, (kt + 1) * 64);
        const char* base = lds + (kt & 1) * STAGE;
        const char* abase = base + (wm * (MT * 16) + fr) * G_ROW + fq * 16;
        const char* bbase = base + A_BYTES + (wn * 64 + fr) * G_ROW + fq * 16;
        bf16x8 b0[4], b1[4], ar[4];
#pragma unroll
        for (int nt = 0; nt < 4; ++nt) b0[nt] = *(const bf16x8*)(bbase + nt * 16 * G_ROW);
        ar[0] = *(const bf16x8*)(abase); ar[1] = *(const bf16x8*)(abase + 16 * G_ROW); ar[2] = *(const bf16x8*)(abase + 32 * G_ROW);
#pragma unroll
        for (int st = 0; st < 2 * MT; ++st) {
            const int ks = st / MT, mt = st % MT;
            __builtin_amdgcn_sched_barrier(0);
            if (st + 3 < 2 * MT) { const int ks2 = (st + 3) / MT, mt2 = (st + 3) % MT; ar[(st + 3) % 4] = *(const bf16x8*)(abase + mt2 * 16 * G_ROW + ks2 * 64); }
            if (ks == 0 && mt >= MT - 3 && mt < MT - 1) {
#pragma unroll
                for (int q = 0; q < 2; ++q) { const int nt = (mt - (MT - 3)) * 2 + q; b1[nt] = *(const bf16x8*)(bbase + nt * 16 * G_ROW + 64); }
            }
#pragma unroll
            for (int nt = 0; nt < 4; ++nt) {
                const bf16x8 bv = ks == 0 ? b0[nt] : b1[nt];
                acc[mt][nt] = SWAP ? mfma16(bv, ar[st % 4], acc[mt][nt]) : mfma16(ar[st % 4], bv, acc[mt][nt]);
            }
        }
        __builtin_amdgcn_sched_barrier(0);
        __syncthreads();
    }
#undef GSTAGE
}

__device__ __forceinline__ void tile_order(int t, int nM, int nN, int& pm, int& pn) {
    const int per = 8 * nN, grp = t / per, r = t % per;
    pm = grp * 8 + (r & 7); pn = r >> 3;
}

__device__ __forceinline__ void phase_p0a(const Params& p, char* lds) {
    const int tid = otid(), lane = tid & 63, wid = tid >> 6;
    unsigned char* ws = p.ws;
    if (blockIdx.x == 0 && tid < 256) atomicExch((unsigned*)(ws + WS_CTRL) + tid, 0u);
    float* scr = (float*)(lds + wid * 8448);
    constexpr int IT_WIN = 16 * (NP / 32), IT_SQ = 16 * 32, IT_W2 = 16 * 64;
    constexpr int NIT = IT_WIN + 4 * IT_SQ + 2 * IT_W2;
    for (int it0 = blockIdx.x * 8; it0 < NIT; it0 += gridDim.x * 8) {
        int it = it0 + wid;
        const float* W = nullptr; bf16_t* WT = nullptr; int N = 0, nb = 0, kb = 0, srccol = -1;
        if (it < NIT) {
            int r = it;
            if (r < IT_WIN) { W = p.in[I_WIN]; N = IN_COLS; WT = (bf16_t*)(ws + WS_WINT); kb = r / (NP / 32); nb = r % (NP / 32);
                const int n0 = nb * 32; srccol = n0 < 3072 ? n0 : (n0 < 10240 ? n0 + 32 : (n0 == 10240 ? 3072 : -1)); }
            else { r -= IT_WIN;
                if (r < 4 * IT_SQ) { const int w = r / IT_SQ; r %= IT_SQ; const int idx[4] = {I_GWO, I_DWO, I_MWO, I_WOUT};
                    W = p.in[w == 0 ? I_GWO : (w == 1 ? I_DWO : (w == 2 ? I_MWO : I_WOUT))]; (void)idx; N = 1024; WT = (bf16_t*)(ws + WS_WOT) + (size_t)w * D * D; kb = r / 32; nb = r % 32; srccol = nb * 32; }
                else { r -= 4 * IT_SQ; const int w = r / IT_W2; r %= IT_W2; W = p.in[w == 0 ? I_MWKV : I_PWQ]; N = 2048; WT = (bf16_t*)(ws + (w == 0 ? WS_WKVT : WS_WQT)); kb = r / 64; nb = r % 64; srccol = nb * 32; }
            }
            const int k0 = kb * 64;
#pragma unroll 8
            for (int i = 0; i < 32; ++i) { const int kk = 2 * i + (lane >> 5); scr[kk * 33 + (lane & 31)] = srccol >= 0 ? W[(size_t)(k0 + kk) * N + srccol + (lane & 31)] : 0.f; }
        }
        __syncthreads();
        if (it < NIT) {
            const int k0 = kb * 64, c = lane & 7;
#pragma unroll
            for (int j = 0; j < 4; ++j) { const int n = (lane >> 3) + 8 * j; const float* s = scr + (8 * c) * 33 + n;
                u32x4 o; o.x = pk2(s[0], s[33]); o.y = pk2(s[66], s[99]); o.z = pk2(s[132], s[165]); o.w = pk2(s[198], s[231]);
                *(u32x4*)(WT + (size_t)(nb * 32 + n) * D + k0 + 8 * c) = o; }
        }
        __syncthreads();
    }
    const size_t gtid = (size_t)blockIdx.x * NTHR + tid, gsz = (size_t)gridDim.x * NTHR;
    {
        const size_t n8 = (size_t)16384 * D / 8;
        for (size_t i = gtid; i < 2 * n8; i += gsz) {
            const int w = i >= n8; const size_t j = w ? i - n8 : i;
            const float* src = p.in[w ? I_PV : I_PU] + j * 8; unsigned char* dst = ws + (w ? WS_PV : WS_PU) + j * 8;
            const float sc = w ? PEER_SV : PEER_SU;
            const f32x4 a = *(const f32x4*)src * sc, b = *(const f32x4*)(src + 4) * sc;
            int lo = __builtin_amdgcn_cvt_pk_fp8_f32(a.x, a.y, 0, false); lo = __builtin_amdgcn_cvt_pk_fp8_f32(a.z, a.w, lo, true);
            int hi = __builtin_amdgcn_cvt_pk_fp8_f32(b.x, b.y, 0, false); hi = __builtin_amdgcn_cvt_pk_fp8_f32(b.z, b.w, hi, true);
            *(u32x2*)dst = (u32x2){(unsigned)lo, (unsigned)hi};
        }
        for (size_t i = gtid; i < 2 * 16384; i += gsz) {
            const int w = i >= 16384; const size_t j = w ? i - 16384 : i;
            ((bf16_t*)(ws + WS_K12))[i] = f2bf(p.in[w ? I_PK2 : I_PK1][j]);
        }
    }
    for (size_t i = gtid; i < (size_t)16384 * 32; i += gsz) {
        const int t = (int)(i >> 5), k = (int)(i & 31);
        const float inv = powf(10000.0f, -(float)(2 * k) / 64.0f);
        const float ang = (float)t * inv;
        double sn, cs; sincos((double)ang, &sn, &cs);
        float* R = (float*)(ws + WS_ROPE) + (size_t)t * 64;
        R[k] = (float)cs; R[32 + k] = (float)sn;
    }
    for (int row = blockIdx.x * 8 + wid; row < 2560; row += gridDim.x * 8) {
        const float* src = row < 512 ? p.in[I_MP] + (size_t)row * D : p.in[I_MS] + (size_t)(row - 512) * D;
        const f32x4* xr = (const f32x4*)src + lane; const f32x4* gr = (const f32x4*)p.in[I_MGN] + lane;
        f32x4 v[4]; float s = 0.f;
#pragma unroll
        for (int j = 0; j < 4; ++j) { v[j] = xr[64 * j]; s += v[j].x * v[j].x + v[j].y * v[j].y + v[j].z * v[j].z + v[j].w * v[j].w; }
        const float r = rsqrtf(wave_sum(s) * (1.f / D) + RMS_EPS);
        u32x2* o = (u32x2*)((bf16_t*)(ws + WS_HM) + (size_t)row * D) + lane;
#pragma unroll
        for (int j = 0; j < 4; ++j) { const f32x4 g = gr[64 * j]; u32x2 w; w.x = pk2(v[j].x * r * g.x, v[j].y * r * g.y); w.y = pk2(v[j].z * r * g.z, v[j].w * r * g.w); o[64 * j] = w; }
    }
}

__device__ __forceinline__ void phase_p0b(const Params& p, char* lds) {
    const int tid_ = otid(), lane = tid_ & 63, wid = tid_ >> 6, wm = wid >> 2, wn = wid & 3, fr = lane & 15, fq = lane >> 4;
    const bf16_t* A = (const bf16_t*)(p.ws + WS_HM); const bf16_t* Bt = (const bf16_t*)(p.ws + WS_WKVT);
    float* C = (float*)(p.ws + WS_KVR);
    const int nM = 20, nN = 8;
    for (int t = blockIdx.x; t < nM * nN; t += gridDim.x) {
        const int pm = t % nM, pn = t / nM, m0 = pm * 128, n0 = pn * 256;
        f32x4 acc[4][4];
#pragma unroll
        for (int i = 0; i < 4; ++i)
#pragma unroll
            for (int j = 0; j < 4; ++j) acc[i][j] = (f32x4){0.f, 0.f, 0.f, 0.f};
        gemm_kloop<true, 4>(acc, A + (size_t)m0 * D, D, Bt + (size_t)n0 * D, D, D, lds);
#pragma unroll
        for (int mt = 0; mt < 4; ++mt)
#pragma unroll
            for (int nt = 0; nt < 4; ++nt) {
                const int row = m0 + wm * 64 + mt * 16 + fr, col = n0 + wn * 64 + nt * 16 + fq * 4;
                *(f32x4*)(C + (size_t)row * 2048 + col) = acc[mt][nt];
            }
    }
}

__device__ __forceinline__ void phase_p0c(const Params& p) {
    const int tid_ = otid(), lane = tid_ & 63, wid = tid_ >> 6;
    const float* KV = (const float*)(p.ws + WS_KVR);
    bf16_t* MK = (bf16_t*)(p.ws + WS_MEMK); bf16_t* MV = (bf16_t*)(p.ws + WS_MEMV);
    for (int it = blockIdx.x * 8 + wid; it < 2560 * 4; it += gridDim.x * 8) {
        const int row = it >> 2, h = it & 3, b = row >> 8, m = row & 255;
        const f32x4 kv = *(const f32x4*)(KV + (size_t)row * 2048 + h * 256 + lane * 4);
        const float ss = wave_sum(kv.x * kv.x + kv.y * kv.y + kv.z * kv.z + kv.w * kv.w);
        const float r = rsqrtf(ss * (1.f / 256.f) + RMS_EPS);
        const f32x4 g = *(const f32x4*)(p.in[I_MGK] + lane * 4);
        u32x2 w; w.x = pk2(kv.x * r * g.x, kv.y * r * g.y); w.y = pk2(kv.z * r * g.z, kv.w * r * g.w);
        *(u32x2*)(MK + ((size_t)(b * 4 + h) * 256 + m) * 256 + lane * 4) = w;
        const f32x4 vv = *(const f32x4*)(KV + (size_t)row * 2048 + 1024 + h * 256 + lane * 4);
        const int pos = (m & ~31) + ((m >> 2) & 3) * 8 + ((m >> 4) & 1) * 4 + (m & 3);
        bf16_t* dst = MV + ((size_t)(b * 4 + h) * 256 + lane * 4) * 256 + pos;
        dst[0] = f2bf(vv.x); dst[256] = f2bf(vv.y); dst[512] = f2bf(vv.z); dst[768] = f2bf(vv.w);
    }
}

__device__ __forceinline__ void phase_rmsnorm(const float* X, const float* gain, bf16_t* O, int row0, int nrows) {
    const int tid_ = otid(), lane = tid_ & 63, wid = tid_ >> 6;
    const f32x4* gr = (const f32x4*)launder(gain) + lane;
    f32x4 g[4];
#pragma unroll
    for (int j = 0; j < 4; ++j) g[j] = gr[64 * j];
    f32x4 vn[4];
    { const f32x4* xr = (const f32x4*)(X + (size_t)(row0 + wid) * D) + lane;
#pragma unroll
      for (int j = 0; j < 4; ++j) vn[j] = xr[64 * j]; }
    for (int row = row0 + wid; row < row0 + nrows; row += 8) {
        f32x4 v[4]; float s = 0.f;
#pragma unroll
        for (int j = 0; j < 4; ++j) v[j] = vn[j];
        if (row + 8 < row0 + nrows) { const f32x4* xr = (const f32x4*)(X + (size_t)(row + 8) * D) + lane;
#pragma unroll
            for (int j = 0; j < 4; ++j) vn[j] = xr[64 * j]; }
        __builtin_amdgcn_sched_barrier(0);
#pragma unroll
        for (int j = 0; j < 4; ++j) s += v[j].x * v[j].x + v[j].y * v[j].y + v[j].z * v[j].z + v[j].w * v[j].w;
        const float r = rsqrtf(wave_sum(s) * (1.f / D) + RMS_EPS);
        u32x2* o = (u32x2*)(O + (size_t)row * D) + lane;
#pragma unroll
        for (int j = 0; j < 4; ++j) { u32x2 w; w.x = pk2(v[j].x * r * g[j].x, v[j].y * r * g[j].y); w.y = pk2(v[j].z * r * g[j].z, v[j].w * r * g[j].w); o[64 * j] = w; }
    }
}

__device__ __forceinline__ void phase_inproj(const Params& p, int g, char* lds, int u) {
    const Grp G = get_group(p, g);
    const int tid_ = otid(), lane = tid_ & 63, wid = tid_ >> 6, wm = wid >> 2, wn = wid & 3, fr = lane & 15, fq = lane >> 4;
    const bf16_t* A = (const bf16_t*)(p.ws + WS_HB); const bf16_t* Bt = (const bf16_t*)(p.ws + WS_WINT);
    bf16_t* P = (bf16_t*)(p.ws + WS_PROJ); bf16_t* VT = (bf16_t*)(p.ws + WS_VT);
    const int pm = u >> 1, half = u & 1, m0 = pm * 256;
    for (int pi = 0; pi < (half ? 17 : 12); ++pi) {
        const int pn = half ? 24 + pi : pi; const int n0 = pn * 256;
        f32x4 acc[8][4];
#pragma unroll
        for (int i = 0; i < 8; ++i)
#pragma unroll
            for (int j = 0; j < 4; ++j) acc[i][j] = (f32x4){0.f, 0.f, 0.f, 0.f};
        gemm_kloop<true, 8>(acc, A + (size_t)m0 * D, D, Bt + (size_t)n0 * D, D, D, lds);
        const float sc = n0 < 512 ? 0.08838834764831845f : 1.0f;
#pragma unroll
        for (int mt = 0; mt < 8; ++mt)
#pragma unroll
            for (int nt = 0; nt < 4; ++nt) {
                const int row = m0 + wm * 128 + mt * 16 + fr, col = n0 + wn * 64 + nt * 16 + fq * 4;
                u32x2 w; w.x = pk2(acc[mt][nt].x * sc, acc[mt][nt].y * sc); w.y = pk2(acc[mt][nt].z * sc, acc[mt][nt].w * sc);
                *(u32x2*)(P + (size_t)row * NP + col) = w;
            }
    }
    if (half == 0) for (int pn = 12; pn < 20; ++pn) {
        const int n0 = pn * 256;
        f32x4 acc[8][4];
#pragma unroll
        for (int i = 0; i < 8; ++i)
#pragma unroll
            for (int j = 0; j < 4; ++j) acc[i][j] = (f32x4){0.f, 0.f, 0.f, 0.f};
        gemm_kloop<true, 8>(acc, A + (size_t)m0 * D, D, Bt + (size_t)n0 * D, D, D, lds);
        const int te_ = otid(), fr = te_ & 15, fq = (te_ >> 4) & 3, wm = te_ >> 8, wn = (te_ >> 6) & 3;
        const bool isk = n0 >= C_DK;
        const float* gn = launder(p.in[isk ? I_DGK : I_DGQ]) + fq * 4;
        const float qs = isk ? 1.0f : 0.125f * LOG2E;
        const float* ROPE = (const float*)(p.ws + WS_ROPE);
        const int tq0 = m0 % G.T + wm * 128 + fr;
#pragma unroll
        for (int mt = 0; mt < 8; ++mt) {
            const int row = m0 + wm * 128 + mt * 16 + fr, t = tq0 + mt * 16;
            float ss = 0.f;
#pragma unroll
            for (int nt = 0; nt < 4; ++nt) ss += acc[mt][nt].x * acc[mt][nt].x + acc[mt][nt].y * acc[mt][nt].y + acc[mt][nt].z * acc[mt][nt].z + acc[mt][nt].w * acc[mt][nt].w;
            ss += sxor<16>(ss); ss += sxor<32>(ss);
            const float r = rsqrtf(ss * (1.f / 64.f) + RMS_EPS) * qs;
            const float* rp = ROPE + (size_t)t * 64 + fq * 4;
            bf16_t* dst = P + (size_t)row * NP + n0 + wn * 64 + fq * 4;
#pragma unroll
            for (int hh = 0; hh < 2; ++hh) {
                const f32x4 cs = *(const f32x4*)(rp + hh * 16), sn = *(const f32x4*)(rp + 32 + hh * 16);
                const f32x4 ya = acc[mt][hh] * *(const f32x4*)(gn + hh * 16) * r, yb = acc[mt][hh + 2] * *(const f32x4*)(gn + 32 + hh * 16) * r;
                const f32x4 oa = ya * cs - yb * sn, ob = yb * cs + ya * sn;
                *(u32x2*)(dst + hh * 16) = (u32x2){pk2(oa.x, oa.y), pk2(oa.z, oa.w)};
                *(u32x2*)(dst + 32 + hh * 16) = (u32x2){pk2(ob.x, ob.y), pk2(ob.z, ob.w)};
            }
        }
    }
    for (int pn = half ? 21 : 20; pn < (half ? 24 : 21); ++pn) {
        const int n0 = pn * 256;
        f32x4 acc[8][4];
#pragma unroll
        for (int i = 0; i < 8; ++i)
#pragma unroll
            for (int j = 0; j < 4; ++j) acc[i][j] = (f32x4){0.f, 0.f, 0.f, 0.f};
        gemm_kloop<false, 8>(acc, A + (size_t)m0 * D, D, Bt + (size_t)n0 * D, D, D, lds);
        const int b = m0 / G.T, t0 = m0 % G.T + wm * 128;
#pragma unroll
        for (int mt = 0; mt < 8; ++mt)
#pragma unroll
            for (int nt = 0; nt < 4; ++nt) {
                const int n = n0 - C_DV + wn * 64 + nt * 16 + fr, h = n >> 7, dv = n & 127;
                const int pos = t0 + (mt >> 1) * 32 + fq * 8 + (mt & 1) * 4;
                u32x2 w; w.x = pk2(acc[mt][nt].x, acc[mt][nt].y); w.y = pk2(acc[mt][nt].z, acc[mt][nt].w);
                *(u32x2*)(VT + ((size_t)((b * 8 + h) * 128 + dv)) * G.T + pos) = w;
            }
    }
}

__device__ __forceinline__ void phase_qkrope(const Params& p, int g, int tok0, int ntok) {
    const Grp G = get_group(p, g);
    const int tid_ = otid(), lane = tid_ & 63, wid = tid_ >> 6, grp = lane >> 2, sub = lane & 3;
    bf16_t* P = (bf16_t*)(p.ws + WS_PROJ); const float* ROPE = (const float*)(p.ws + WS_ROPE);
    for (int it = tok0 * 2 + wid; it < (tok0 + ntok) * 2; it += 8) {
        const int tok = it >> 1, isk = it & 1, t = tok % G.T;
        bf16_t* base = P + (size_t)tok * NP + (isk ? C_DK : C_DQ) + grp * 64 + sub * 8;
        const u32x4 a = *(const u32x4*)base, b = *(const u32x4*)(base + 32);
        float x1[8], x2[8];
        x1[0] = bflo(a.x); x1[1] = bfhi(a.x); x1[2] = bflo(a.y); x1[3] = bfhi(a.y); x1[4] = bflo(a.z); x1[5] = bfhi(a.z); x1[6] = bflo(a.w); x1[7] = bfhi(a.w);
        x2[0] = bflo(b.x); x2[1] = bfhi(b.x); x2[2] = bflo(b.y); x2[3] = bfhi(b.y); x2[4] = bflo(b.z); x2[5] = bfhi(b.z); x2[6] = bflo(b.w); x2[7] = bfhi(b.w);
        float ss = 0.f;
#pragma unroll
        for (int e = 0; e < 8; ++e) ss += x1[e] * x1[e] + x2[e] * x2[e];
        ss += sxor<1>(ss); ss += sxor<2>(ss);
        const float r = rsqrtf(ss * (1.f / 64.f) + RMS_EPS) * (isk ? 1.0f : 0.125f * LOG2E);
        const float* gn = p.in[isk ? I_DGK : I_DGQ] + sub * 8;
        const float* rp = ROPE + (size_t)t * 64 + sub * 8;
        float o1[8], o2[8];
#pragma unroll
        for (int e = 0; e < 8; ++e) {
            const float y1 = x1[e] * r * gn[e], y2 = x2[e] * r * gn[32 + e], c = rp[e], s = rp[32 + e];
            o1[e] = y1 * c - y2 * s; o2[e] = y2 * c + y1 * s;
        }
        u32x4 w1, w2;
        w1.x = pk2(o1[0], o1[1]); w1.y = pk2(o1[2], o1[3]); w1.z = pk2(o1[4], o1[5]); w1.w = pk2(o1[6], o1[7]);
        w2.x = pk2(o2[0], o2[1]); w2.y = pk2(o2[2], o2[3]); w2.z = pk2(o2[4], o2[5]); w2.w = pk2(o2[6], o2[7]);
        *(u32x4*)base = w1; *(u32x4*)(base + 32) = w2;
    }
}

__device__ __forceinline__ void diff_attn_item(const Params& p, const Grp& G, int item, char* lds, float lam, float shift) {
    const int tid = otid(), lane = tid & 63, wid = tid >> 6, fr = lane & 15, fq = lane >> 4;
    const int c = wid & 1, sub = wid >> 1;
    const int T = G.T, nqb = T / 128;
    const int qb = item % nqb, bh = item / nqb, h = bh & 7, b = bh >> 3;
    bf16_t* P = (bf16_t*)(p.ws + WS_PROJ) + (size_t)b * T * NP;
    const bf16_t* Kg = P + C_DK + h * 128;
    const bf16_t* VTg = (const bf16_t*)(p.ws + WS_VT) + (size_t)bh * 128 * T;
    const int q0 = qb * 128 + sub * 32;
    bf16x8 qf[2][2];
#pragma unroll
    for (int nt = 0; nt < 2; ++nt)
#pragma unroll
        for (int ks = 0; ks < 2; ++ks) qf[nt][ks] = *(const bf16x8*)(P + (size_t)(q0 + nt * 16 + fr) * NP + C_DQ + h * 128 + c * 64 + ks * 32 + fq * 8);
    f32x4 o[8][2];
#pragma unroll
    for (int i = 0; i < 8; ++i) { o[i][0] = (f32x4){0.f, 0.f, 0.f, 0.f}; o[i][1] = (f32x4){0.f, 0.f, 0.f, 0.f}; }
    float l[2] = {0.f, 0.f};
    constexpr int STG = 36864, VOFF = 18432;
    u32x4 rk[2], rv[2];
    const int krow = tid >> 4, kch = tid & 15;
    const int vrow = tid >> 3, vch = tid & 7;
#define AGLOAD(kt) do { const int key0_ = (kt) * 64; \
        _Pragma("unroll") for (int i = 0; i < 2; ++i) rk[i] = *(const u32x4*)(Kg + (size_t)(key0_ + krow + i * 32) * NP + kch * 8); \
        _Pragma("unroll") for (int i = 0; i < 2; ++i) rv[i] = *(const u32x4*)(VTg + (size_t)(vrow + i * 64) * T + key0_ + vch * 8); } while (0)
#define ASWRITE(buf) do { char* b_ = lds + (buf) * STG; \
        _Pragma("unroll") for (int i = 0; i < 2; ++i) *(u32x4*)(b_ + ((kch >> 3) * 64 + krow + i * 32) * 144 + (kch & 7) * 16) = rk[i]; \
        _Pragma("unroll") for (int i = 0; i < 2; ++i) *(u32x4*)(b_ + VOFF + (vrow + i * 64) * 144 + vch * 16) = rv[i]; } while (0)
    const int nkt = T / 64;
#define EXPQ(SRC, NT, DSTP) do { const f32x4 a_ = SRC[0][NT], b_ = SRC[1][NT]; \
        const float p0 = fexp2(a_.x), p1 = fexp2(a_.y), p2 = fexp2(a_.z), p3 = fexp2(a_.w); \
        const float p4 = fexp2(b_.x), p5 = fexp2(b_.y), p6 = fexp2(b_.z), p7 = fexp2(b_.w); \
        l[NT] += ((p0 + p1) + (p2 + p3)) + ((p4 + p5) + (p6 + p7)); \
        u32x4 w_; w_.x = pk2(p0, p1); w_.y = pk2(p2, p3); w_.z = pk2(p4, p5); w_.w = pk2(p6, p7); \
        DSTP[NT] = __builtin_bit_cast(bf16x8, w_); } while (0)
#define SMMA1(DST, I, MT, KBASE) do { \
        const bf16x8 k0_ = *(const bf16x8*)((KBASE) + (c * 64 + (MT) * 16 + fr) * 144 + fq * 16); \
        const bf16x8 k1_ = *(const bf16x8*)((KBASE) + (c * 64 + (MT) * 16 + fr) * 144 + 64 + fq * 16); \
        DST[I][0] = mfma16(k0_, qf[0][0], (f32x4){0.f, 0.f, 0.f, 0.f}); DST[I][1] = mfma16(k0_, qf[1][0], (f32x4){0.f, 0.f, 0.f, 0.f}); \
        DST[I][0] = mfma16(k1_, qf[0][1], DST[I][0]); DST[I][1] = mfma16(k1_, qf[1][1], DST[I][1]); } while (0)
#define PVMMA(DVT, KK, PF, VBASE) do { \
        const bf16x8 vf_ = *(const bf16x8*)((VBASE) + VOFF + ((DVT) * 16 + fr) * 144 + (KK) * 64 + fq * 16); \
        o[DVT][0] = mfma16(vf_, PF[0], o[DVT][0]); o[DVT][1] = mfma16(vf_, PF[1], o[DVT][1]); } while (0)
#define PV8(KK, PF, VBASE) do { PVMMA(0, KK, PF, VBASE); PVMMA(1, KK, PF, VBASE); PVMMA(2, KK, PF, VBASE); PVMMA(3, KK, PF, VBASE); \
        PVMMA(4, KK, PF, VBASE); PVMMA(5, KK, PF, VBASE); PVMMA(6, KK, PF, VBASE); PVMMA(7, KK, PF, VBASE); } while (0)
    f32x4 slo[2][2], shi[2][2];
    bf16x8 pflo[2], pfhi[2];
    pfhi[0] = (bf16x8){0, 0, 0, 0, 0, 0, 0, 0}; pfhi[1] = pfhi[0];
#define KLOAD(KR, MTA, MTB, KBASE) do { \
        KR[0] = *(const bf16x8*)((KBASE) + (c * 64 + (MTA) * 16 + fr) * 144 + fq * 16); KR[1] = *(const bf16x8*)((KBASE) + (c * 64 + (MTA) * 16 + fr) * 144 + 64 + fq * 16); \
        KR[2] = *(const bf16x8*)((KBASE) + (c * 64 + (MTB) * 16 + fr) * 144 + fq * 16); KR[3] = *(const bf16x8*)((KBASE) + (c * 64 + (MTB) * 16 + fr) * 144 + 64 + fq * 16); } while (0)
#define SMMAK(DST, KR) do { \
        DST[0][0] = mfma16(KR[0], qf[0][0], (f32x4){0.f, 0.f, 0.f, 0.f}); DST[0][1] = mfma16(KR[0], qf[1][0], (f32x4){0.f, 0.f, 0.f, 0.f}); \
        DST[1][0] = mfma16(KR[2], qf[0][0], (f32x4){0.f, 0.f, 0.f, 0.f}); DST[1][1] = mfma16(KR[2], qf[1][0], (f32x4){0.f, 0.f, 0.f, 0.f}); \
        DST[0][0] = mfma16(KR[1], qf[0][1], DST[0][0]); DST[0][1] = mfma16(KR[1], qf[1][1], DST[0][1]); \
        DST[1][0] = mfma16(KR[3], qf[0][1], DST[1][0]); DST[1][1] = mfma16(KR[3], qf[1][1], DST[1][1]); } while (0)
#define VLOAD4(VR, D0, KK, VBASE) do { _Pragma("unroll") for (int i_ = 0; i_ < 4; ++i_) VR[i_] = *(const bf16x8*)((VBASE) + VOFF + (((D0) + i_) * 16 + fr) * 144 + (KK) * 64 + fq * 16); } while (0)
#define PV4(VR, D0, PF) do { _Pragma("unroll") for (int i_ = 0; i_ < 4; ++i_) { o[(D0) + i_][0] = mfma16(VR[i_], PF[0], o[(D0) + i_][0]); o[(D0) + i_][1] = mfma16(VR[i_], PF[1], o[(D0) + i_][1]); } } while (0)
#define FENCE() __builtin_amdgcn_sched_barrier(0)
    AGLOAD(0); ASWRITE(0); AGLOAD(1); ASWRITE(1);
    for (int i = tid; i < 18432 / 16; i += NTHR) *(u32x4*)(lds + 3 * STG + VOFF + i * 16) = (u32x4){0u, 0u, 0u, 0u};
    __syncthreads();
    bf16x8 kr[4], va[4], vb[4];
    KLOAD(kr, 0, 1, lds); SMMAK(slo, kr);
    for (int kt = 0; kt < nkt; ++kt) {
        { const int ktl = kt + 2 < nkt ? kt + 2 : nkt - 1; AGLOAD(ktl); }
        const char* cur = lds + (kt & 3) * STG; const char* nxt = lds + ((kt + 1) & 3) * STG; const char* prv = lds + ((kt + 3) & 3) * STG;
        KLOAD(kr, 2, 3, cur); VLOAD4(va, 0, 1, prv);
        FENCE();
        SMMAK(shi, kr); VLOAD4(vb, 4, 1, prv); EXPQ(slo, 0, pflo);
        FENCE();
        PV4(va, 0, pfhi); KLOAD(kr, 0, 1, nxt); EXPQ(slo, 1, pflo);
        FENCE();
        PV4(vb, 4, pfhi); VLOAD4(va, 0, 0, cur);
        FENCE();
        SMMAK(slo, kr); VLOAD4(vb, 4, 0, cur); EXPQ(shi, 0, pfhi);
        FENCE();
        PV4(va, 0, pflo); EXPQ(shi, 1, pfhi);
        FENCE();
        PV4(vb, 4, pflo);
        FENCE();
        ASWRITE((kt + 2) & 3);
        __syncthreads();
    }
    { const char* prv = lds + ((nkt - 1) & 3) * STG; VLOAD4(va, 0, 1, prv); VLOAD4(vb, 4, 1, prv); PV4(va, 0, pfhi); PV4(vb, 4, pfhi); }
    __syncthreads();
#undef KLOAD
#undef SMMAK
#undef VLOAD4
#undef PV4
#undef FENCE
#undef EXPQ
#undef SMMA1
#undef PVMMA
#undef PV8
#undef AGLOAD
#undef ASWRITE
    float inv[2];
#pragma unroll
    for (int nt = 0; nt < 2; ++nt) { float v = l[nt]; v += sxor<16>(v); v += sxor<32>(v); inv[nt] = 1.0f / v; }
    float* xch = (float*)lds + sub * 4096;
    if (c == 1) {
#pragma unroll
        for (int dvt = 0; dvt < 8; ++dvt)
#pragma unroll
            for (int nt = 0; nt < 2; ++nt) {
                xch[(dvt * 16 + fq * 4 + 0) * 32 + nt * 16 + fr] = o[dvt][nt].x * inv[nt];
                xch[(dvt * 16 + fq * 4 + 1) * 32 + nt * 16 + fr] = o[dvt][nt].y * inv[nt];
                xch[(dvt * 16 + fq * 4 + 2) * 32 + nt * 16 + fr] = o[dvt][nt].z * inv[nt];
                xch[(dvt * 16 + fq * 4 + 3) * 32 + nt * 16 + fr] = o[dvt][nt].w * inv[nt];
            }
    }
    __syncthreads();
    if (c == 0) {
        float ss[2] = {0.f, 0.f};
#pragma unroll
        for (int dvt = 0; dvt < 8; ++dvt)
#pragma unroll
            for (int nt = 0; nt < 2; ++nt) {
                f32x4 v = o[dvt][nt] * inv[nt];
                v.x -= lam * xch[(dvt * 16 + fq * 4 + 0) * 32 + nt * 16 + fr];
                v.y -= lam * xch[(dvt * 16 + fq * 4 + 1) * 32 + nt * 16 + fr];
                v.z -= lam * xch[(dvt * 16 + fq * 4 + 2) * 32 + nt * 16 + fr];
                v.w -= lam * xch[(dvt * 16 + fq * 4 + 3) * 32 + nt * 16 + fr];
                o[dvt][nt] = v; ss[nt] += v.x * v.x + v.y * v.y + v.z * v.z + v.w * v.w;
            }
#pragma unroll
        for (int nt = 0; nt < 2; ++nt) {
            float v = ss[nt]; v += sxor<16>(v); v += sxor<32>(v);
            const float r = rsqrtf(v * (1.f / 128.f) + RMS_EPS) * 0.8f;
#pragma unroll
            for (int dvt = 0; dvt < 8; ++dvt) {
                const f32x4 gs = *(const f32x4*)(p.in[I_DGSUB] + dvt * 16 + fq * 4);
                const f32x4 v4 = o[dvt][nt];
                u32x2 w; w.x = pk2(v4.x * r * gs.x, v4.y * r * gs.y); w.y = pk2(v4.z * r * gs.z, v4.w * r * gs.w);
                *(u32x2*)(P + (size_t)(q0 + nt * 16 + fr) * NP + C_DQ + h * 128 + dvt * 16 + fq * 4) = w;
            }
        }
    }
    __syncthreads();
}

__device__ __forceinline__ void mem_attn_item(const Params& p, const Grp& G, int item, char* lds, float shift) {
    const int tid = otid(), lane = tid & 63, wid = tid >> 6, fr = lane & 15, fq = lane >> 4;
    const int T = G.T, nqb = T / 128;
    const int qb = item % nqb, bh = item / nqb, h = bh & 3, b = bh >> 2;
    bf16_t* P = (bf16_t*)(p.ws + WS_PROJ) + (size_t)b * T * NP;
    const bf16_t* MK = (const bf16_t*)(p.ws + WS_MEMK) + (size_t)((G.mb0 + b) * 4 + h) * 256 * 256;
    const bf16_t* MV = (const bf16_t*)(p.ws + WS_MEMV) + (size_t)((G.mb0 + b) * 4 + h) * 256 * 256;
    const int row = qb * 128 + wid * 16 + fr;
    bf16_t* qp = P + (size_t)row * NP + C_MQ + h * 256;
    bf16x8 qf[8];
    {
        float ss = 0.f; u32x4 raw[8];
#pragma unroll
        for (int ks = 0; ks < 8; ++ks) { raw[ks] = *(const u32x4*)(qp + ks * 32 + fq * 8);
            const float a0 = bflo(raw[ks].x), a1 = bfhi(raw[ks].x), a2 = bflo(raw[ks].y), a3 = bfhi(raw[ks].y), a4 = bflo(raw[ks].z), a5 = bfhi(raw[ks].z), a6 = bflo(raw[ks].w), a7 = bfhi(raw[ks].w);
            ss += a0 * a0 + a1 * a1 + a2 * a2 + a3 * a3 + a4 * a4 + a5 * a5 + a6 * a6 + a7 * a7; }
        ss += sxor<16>(ss); ss += sxor<32>(ss);
        const float r = rsqrtf(ss * (1.f / 256.f) + RMS_EPS) * (0.0625f * LOG2E);
#pragma unroll
        for (int ks = 0; ks < 8; ++ks) {
            const f32x4 g0 = *(const f32x4*)(p.in[I_MGQ] + ks * 32 + fq * 8), g1 = *(const f32x4*)(p.in[I_MGQ] + ks * 32 + fq * 8 + 4);
            u32x4 w;
            w.x = pk2(bflo(raw[ks].x) * r * g0.x, bfhi(raw[ks].x) * r * g0.y); w.y = pk2(bflo(raw[ks].y) * r * g0.z, bfhi(raw[ks].y) * r * g0.w);
            w.z = pk2(bflo(raw[ks].z) * r * g1.x, bfhi(raw[ks].z) * r * g1.y); w.w = pk2(bflo(raw[ks].w) * r * g1.z, bfhi(raw[ks].w) * r * g1.w);
            qf[ks] = __builtin_bit_cast(bf16x8, w);
        }
    }
    f32x4 o[16];
#pragma unroll
    for (int i = 0; i < 16; ++i) o[i] = (f32x4){0.f, 0.f, 0.f, 0.f};
    float l = 0.f;
    constexpr int KROW = 528, VOFF = 64 * 528;
    u32x4 mk[4], mv[4];
#define MLOAD(KT) do { _Pragma("unroll") for (int i = 0; i < 4; ++i) { const int idx = tid + i * 512; \
        mk[i] = *(const u32x4*)(MK + (size_t)((KT) * 64 + (idx >> 5)) * 256 + (idx & 31) * 8); mv[i] = *(const u32x4*)(MV + (size_t)(idx >> 3) * 256 + (KT) * 64 + (idx & 7) * 8); } } while (0)
    MLOAD(0);
    for (int kt = 0; kt < 4; ++kt) {
#pragma unroll
        for (int i = 0; i < 4; ++i) {
            const int idx = tid + i * 512;
            *(u32x4*)(lds + (idx >> 5) * KROW + (idx & 31) * 16) = mk[i];
            *(u32x4*)(lds + VOFF + (idx >> 3) * 144 + (idx & 7) * 16) = mv[i];
        }
        __syncthreads();
        if (kt + 1 < 4) MLOAD(kt + 1);
        __builtin_amdgcn_sched_barrier(0);
        f32x4 s[4];
#pragma unroll
        for (int mt = 0; mt < 4; ++mt) s[mt] = (f32x4){0.f, 0.f, 0.f, 0.f};
#pragma unroll
        for (int ks = 0; ks < 8; ks += 2) {
            bf16x8 kf[8];
#pragma unroll
            for (int u = 0; u < 8; ++u) kf[u] = *(const bf16x8*)(lds + ((u & 3) * 16 + fr) * KROW + (ks + (u >> 2)) * 64 + fq * 16);
            __builtin_amdgcn_sched_barrier(0);
#pragma unroll
            for (int u = 0; u < 8; ++u) s[u & 3] = mfma16(kf[u], qf[ks + (u >> 2)], s[u & 3]);
        }
        bf16x8 pf[2];
#pragma unroll
        for (int kk = 0; kk < 2; ++kk) {
            const f32x4 a = s[2 * kk], bb = s[2 * kk + 1];
            const float p0 = fexp2(a.x), p1 = fexp2(a.y), p2 = fexp2(a.z), p3 = fexp2(a.w);
            const float p4 = fexp2(bb.x), p5 = fexp2(bb.y), p6 = fexp2(bb.z), p7 = fexp2(bb.w);
            l += ((p0 + p1) + (p2 + p3)) + ((p4 + p5) + (p6 + p7));
            u32x4 w; w.x = pk2(p0, p1); w.y = pk2(p2, p3); w.z = pk2(p4, p5); w.w = pk2(p6, p7);
            pf[kk] = __builtin_bit_cast(bf16x8, w);
        }
#pragma unroll
        for (int kk = 0; kk < 2; ++kk)
#pragma unroll
            for (int d0 = 0; d0 < 16; d0 += 8) {
                bf16x8 vf[8];
#pragma unroll
                for (int u = 0; u < 8; ++u) vf[u] = *(const bf16x8*)(lds + VOFF + ((d0 + u) * 16 + fr) * 144 + kk * 64 + fq * 16);
                __builtin_amdgcn_sched_barrier(0);
#pragma unroll
                for (int u = 0; u < 8; ++u) o[d0 + u] = mfma16(vf[u], pf[kk], o[d0 + u]);
            }
        __syncthreads();
    }
#undef MLOAD
    l += sxor<16>(l); l += sxor<32>(l);
    const float inv = 1.0f / l;
#pragma unroll
    for (int dvt = 0; dvt < 16; ++dvt) {
        u32x2 w; w.x = pk2(o[dvt].x * inv, o[dvt].y * inv); w.y = pk2(o[dvt].z * inv, o[dvt].w * inv);
        *(u32x2*)(qp + dvt * 16 + fq * 4) = w;
    }
}

constexpr int L_QE = 0, L_KE = 17408, L_KST = 34816, L_VTL = 53248, L_ATT = 71680, L_SB = 80896, L_LRF = 115712, L_TOT = 119808, L_GDEC = 121856;
__device__ __forceinline__ void gla_item(const Params& p, const Grp& G, int item, char* lds) {
    const int tid = otid(), lane = tid & 63, wid = tid >> 6, fr = lane & 15, fq = lane >> 4;
    const int slice = item & 1, dir = (item >> 1) & 1, h = (item >> 2) & 3, b = item >> 4;
    const int T = G.T, N = T / 64;
    const bf16_t* P = (const bf16_t*)(p.ws + WS_PROJ) + (size_t)b * T * NP;
    bf16_t* OUT = dir ? (bf16_t*)(p.ws + WS_PROJ) + (size_t)b * T * NP + C_DV + h * 256 + slice * 128
                      : (bf16_t*)(p.ws + WS_HB) + (size_t)b * T * D + h * 256 + slice * 128;
    const int ldo = dir ? NP : D;
    const int amt = wid & 3, antg = wid >> 2;
    bf16x8 wdB[4]; float bd4[4];
    {
        const float* wd = p.in[dir ? I_WDB : I_WDF]; const float* bdp = p.in[dir ? I_BDB : I_BDF];
#pragma unroll
        for (int q = 0; q < 4; ++q) {
            const int col = h * 128 + (antg * 4 + q) * 16 + fr;
            u32x4 w = (u32x4){0u, 0u, 0u, 0u};
            if (fq < 2) { const float* wp = wd + (size_t)(fq * 8) * 512 + col;
                w.x = pk2(wp[0], wp[512]); w.y = pk2(wp[1024], wp[1536]); w.z = pk2(wp[2048], wp[2560]); w.w = pk2(wp[3072], wp[3584]); }
            wdB[q] = __builtin_bit_cast(bf16x8, w);
            bd4[q] = bdp[col];
        }
    }
    { unsigned z = 0u; asm volatile("" : "+v"(z)); for (int i = tid; i < 34816 / 16; i += NTHR) *(u32x4*)(lds + L_SB + i * 16) = (u32x4){z, z, z, z}; }
    f32x4 S[8];
#pragma unroll
    for (int i = 0; i < 8; ++i) S[i] = (f32x4){0.f, 0.f, 0.f, 0.f};
    u32x4 rq[2], rk[2], rv[2], rl;
    const int lrow = tid >> 4, lch = tid & 15;
#define GGLOAD(n) do { const int cb_ = (dir ? (N - 1 - (n)) : (n)) * 64; \
        _Pragma("unroll") for (int i = 0; i < 2; ++i) { const int li_ = lrow + i * 32, tk_ = cb_ + (dir ? 63 - li_ : li_); const bf16_t* rp_ = P + (size_t)tk_ * NP; \
            rq[i] = *(const u32x4*)(rp_ + C_GQ + h * 128 + lch * 8); rk[i] = *(const u32x4*)(rp_ + C_GK + h * 128 + lch * 8); rv[i] = *(const u32x4*)(rp_ + C_GV + h * 256 + slice * 128 + lch * 8); } \
        if (tid < 128) { const int li_ = tid >> 1, tk_ = cb_ + (dir ? 63 - li_ : li_); rl = *(const u32x4*)(P + (size_t)tk_ * NP + C_LR + dir * 16 + (tid & 1) * 8); } } while (0)
    GGLOAD(0);
    for (int n = 0; n < N; ++n) {
#pragma unroll
        for (int i = 0; i < 2; ++i) {
            const int li = lrow + i * 32;
            *(u32x4*)(lds + L_QE + li * 272 + lch * 16) = rq[i];
            *(u32x4*)(lds + L_KE + li * 272 + lch * 16) = rk[i];
            bf16_t* vt = (bf16_t*)(lds + L_VTL) + (lch * 8) * 72 + li;
            vt[0 * 72] = (bf16_t)(rv[i].x & 0xffff); vt[1 * 72] = (bf16_t)(rv[i].x >> 16); vt[2 * 72] = (bf16_t)(rv[i].y & 0xffff); vt[3 * 72] = (bf16_t)(rv[i].y >> 16);
            vt[4 * 72] = (bf16_t)(rv[i].z & 0xffff); vt[5 * 72] = (bf16_t)(rv[i].z >> 16); vt[6 * 72] = (bf16_t)(rv[i].w & 0xffff); vt[7 * 72] = (bf16_t)(rv[i].w >> 16);
        }
        if (tid < 128) *(u32x4*)(lds + L_LRF + (tid >> 1) * 32 + (tid & 1) * 16) = rl;
        if (n + 1 < N) GGLOAD(n + 1);
        __syncthreads();
        {
            u32x4 araw = (u32x4){0u, 0u, 0u, 0u};
            if (fq < 2) araw = *(const u32x4*)(lds + L_LRF + (amt * 16 + fr) * 32 + fq * 16);
            const bf16x8 afr = __builtin_bit_cast(bf16x8, araw);
            float pb[4][4]; float E[4], tt[4];
#pragma unroll
            for (int q = 0; q < 4; ++q) {
                const f32x4 x4 = mfma16(afr, wdB[q], (f32x4){bd4[q], bd4[q], bd4[q], bd4[q]});
                float run = 0.f;
#pragma unroll
                for (int j = 0; j < 4; ++j) {
                    const float x = x4[j];
                    const float ls = fminf(x, 0.f) - __logf(1.0f + __expf(-fabsf(x)));
                    run += ls * 0.0625f; pb[q][j] = run;
                }
                const float u = sxor<16>(run), v = run + u, w2 = sxor<32>(v);
                E[q] = ((fq & 1) ? u : 0.f) + ((fq & 2) ? w2 : 0.f);
                tt[q] = v + w2;
                if (fq == 0) ((float*)(lds + L_TOT))[amt * 128 + (antg * 4 + q) * 16 + fr] = tt[q];
            }
            __syncthreads();
#pragma unroll
            for (int q = 0; q < 4; ++q) {
                const int col = (antg * 4 + q) * 16 + fr;
                float off = 0.f, blast = 0.f;
#pragma unroll
                for (int r = 0; r < 4; ++r) { const float tv = ((const float*)(lds + L_TOT))[r * 128 + col]; blast += tv; if (r < amt) off += tv; }
                const float gcol = __expf(blast);
                bf16_t* qe = (bf16_t*)(lds + L_QE) + (amt * 16 + fq * 4) * 136 + col; bf16_t* ke = (bf16_t*)(lds + L_KE) + (amt * 16 + fq * 4) * 136 + col;
                float ksv[4];
#pragma unroll
                for (int j = 0; j < 4; ++j) {
                    const float bb = off + E[q] + pb[q][j];
                    const float qv = bf2f(qe[j * 136]), kv = bf2f(ke[j * 136]);
                    const float kd = kv * __expf(-bb);
                    qe[j * 136] = f2bf(qv * __expf(bb)); ke[j * 136] = f2bf(kd);
                    ksv[j] = kd * gcol;
                }
                *(u32x2*)(lds + L_KST + col * 144 + (amt * 16 + fq * 4) * 2) = (u32x2){pk2(ksv[0], ksv[1]), pk2(ksv[2], ksv[3])};
                if (amt == 0 && fq == 0) ((float*)(lds + L_GDEC))[col] = gcol;
            }
        }
        __syncthreads();
        {
            const int ct = wid & 3;
            f32x4 a[2] = {(f32x4){0.f, 0.f, 0.f, 0.f}, (f32x4){0.f, 0.f, 0.f, 0.f}};
            bf16x8 qv[4], kv[2][4];
#pragma unroll
            for (int ks = 0; ks < 4; ++ks) {
                qv[ks] = *(const bf16x8*)(lds + L_QE + (ct * 16 + fr) * 272 + ks * 64 + fq * 16);
#pragma unroll
                for (int j = 0; j < 2; ++j) kv[j][ks] = *(const bf16x8*)(lds + L_KE + (((wid >> 2) * 2 + j) * 16 + fr) * 272 + ks * 64 + fq * 16);
            }
            __builtin_amdgcn_sched_barrier(0);
#pragma unroll
            for (int ks = 0; ks < 4; ++ks)
#pragma unroll
                for (int j = 0; j < 2; ++j) a[j] = mfma16(kv[j][ks], qv[ks], a[j]);
#pragma unroll
            for (int j = 0; j < 2; ++j) {
                const int st = (wid >> 2) * 2 + j, cc = ct * 16 + fr, s0 = st * 16 + fq * 4;
                const float v0 = (s0 + 0 <= cc) ? a[j].x : 0.f, v1 = (s0 + 1 <= cc) ? a[j].y : 0.f, v2 = (s0 + 2 <= cc) ? a[j].z : 0.f, v3 = (s0 + 3 <= cc) ? a[j].w : 0.f;
                *(u32x2*)(lds + L_ATT + cc * 144 + s0 * 2) = (u32x2){pk2(v0, v1), pk2(v2, v3)};
            }
        }
        __syncthreads();
        {
            f32x4 oc[4] = {(f32x4){0.f, 0.f, 0.f, 0.f}, (f32x4){0.f, 0.f, 0.f, 0.f}, (f32x4){0.f, 0.f, 0.f, 0.f}, (f32x4){0.f, 0.f, 0.f, 0.f}};
            bf16x8 fa[2], fb[2][4], ga[2], gb[2][4];
#define LD_VA(FA, FB) do { _Pragma("unroll") for (int ks = 0; ks < 2; ++ks) { FA[ks] = *(const bf16x8*)(lds + L_VTL + (wid * 16 + fr) * 144 + ks * 64 + fq * 16); \
                _Pragma("unroll") for (int ct = 0; ct < 4; ++ct) FB[ks][ct] = *(const bf16x8*)(lds + L_ATT + (ct * 16 + fr) * 144 + ks * 64 + fq * 16); } } while (0)
#define LD_SQ(FA, FB, K0) do { _Pragma("unroll") for (int ks = 0; ks < 2; ++ks) { FA[ks] = *(const bf16x8*)(lds + L_SB + (wid * 16 + fr) * 272 + ((K0) + ks) * 64 + fq * 16); \
                _Pragma("unroll") for (int ct = 0; ct < 4; ++ct) FB[ks][ct] = *(const bf16x8*)(lds + L_QE + (ct * 16 + fr) * 272 + ((K0) + ks) * 64 + fq * 16); } } while (0)
#define MM10(FA, FB) do { _Pragma("unroll") for (int ks = 0; ks < 2; ++ks) _Pragma("unroll") for (int ct = 0; ct < 4; ++ct) oc[ct] = mfma16(FA[ks], FB[ks][ct], oc[ct]); } while (0)
            LD_VA(fa, fb); LD_SQ(ga, gb, 0);
            __builtin_amdgcn_sched_barrier(0);
            MM10(fa, fb); LD_SQ(fa, fb, 2);
            __builtin_amdgcn_sched_barrier(0);
            MM10(ga, gb);
            __builtin_amdgcn_sched_barrier(0);
            MM10(fa, fb);
#undef LD_VA
#undef LD_SQ
#undef MM10
            const int cb = (dir ? (N - 1 - n) : n) * 64;
#pragma unroll
            for (int ct = 0; ct < 4; ++ct) {
                const int cl = ct * 16 + fr, tk = cb + (dir ? 63 - cl : cl);
                *(u32x2*)(OUT + (size_t)tk * ldo + wid * 16 + fq * 4) = (u32x2){pk2(oc[ct].x, oc[ct].y), pk2(oc[ct].z, oc[ct].w)};
            }
        }
        __syncthreads();
        {
            const f32x4 gd = *(const f32x4*)((const float*)(lds + L_GDEC) + wid * 16 + fq * 4);
#pragma unroll
            for (int et = 0; et < 8; ++et) S[et] = S[et] * gd;
            bf16x8 da[2], db[2][8];
#pragma unroll
            for (int ks = 0; ks < 2; ++ks) {
                da[ks] = *(const bf16x8*)(lds + L_KST + (wid * 16 + fr) * 144 + ks * 64 + fq * 16);
#pragma unroll
                for (int et = 0; et < 8; ++et) db[ks][et] = *(const bf16x8*)(lds + L_VTL + (et * 16 + fr) * 144 + ks * 64 + fq * 16);
            }
            __builtin_amdgcn_sched_barrier(0);
#pragma unroll
            for (int ks = 0; ks < 2; ++ks)
#pragma unroll
                for (int et = 0; et < 8; ++et) S[et] = mfma16(da[ks], db[ks][et], S[et]);
#pragma unroll
            for (int et = 0; et < 8; ++et)
                *(u32x2*)(lds + L_SB + (et * 16 + fr) * 272 + (wid * 16 + fq * 4) * 2) = (u32x2){pk2(S[et].x, S[et].y), pk2(S[et].z, S[et].w)};
        }
        __syncthreads();
    }
#undef GGLOAD
}

__device__ __forceinline__ void phase_mixer(const Params& p, int g, char* lds, int* s_item) {
    const Grp G = get_group(p, g);
    const int nGLA = G.B * 16, nATT = G.B * 8 * (G.T / 128), nMEM = G.B * 4 * (G.T / 128);
    unsigned* ctr = (unsigned*)(p.ws + WS_CTRL) + g * 4;
    for (;;) {
        if (threadIdx.x == 0) *s_item = (int)atomicAdd(ctr + 0, 1u);
        __syncthreads();
        const int it = *s_item;
        __syncthreads();
        if (it >= nGLA) break;
        gla_item(p, G, it, lds);
    }
    {
        float d1 = 0.f, d2 = 0.f;
        for (int i = 0; i < 64; ++i) { d1 += p.in[I_LQ1][i] * p.in[I_LK1][i]; d2 += p.in[I_LQ2][i] * p.in[I_LK2][i]; }
        const float lam = expf(d1) - expf(d2) + 0.2f;
        for (;;) {
            if (threadIdx.x == 0) *s_item = (int)atomicAdd(ctr + 1, 1u);
            __syncthreads();
            const int it = *s_item;
            __syncthreads();
            if (it >= nATT) break;
            diff_attn_item(p, G, it, lds, lam, 0.f);
        }
    }
    for (;;) {
        if (threadIdx.x == 0) *s_item = (int)atomicAdd(ctr + 2, 1u);
        __syncthreads();
        const int it = *s_item;
        __syncthreads();
        if (it >= nMEM) break;
        mem_attn_item(p, G, it, lds, 0.f);
    }
}

__device__ __forceinline__ void phase_glafin(const Params& p, int g, int tok0, int ntok) {
    const int tid_ = otid(), lane = tid_ & 63, wid = tid_ >> 6;
    bf16_t* P = (bf16_t*)(p.ws + WS_PROJ); const bf16_t* F = (const bf16_t*)(p.ws + WS_HB);
    unsigned qq, kk; u32x2 f, bk, v, gt;
#define GFLOAD(IT) do { const int tok_ = (IT) >> 2, h_ = (IT) & 3; const bf16_t* row_ = P + (size_t)tok_ * NP; \
        qq = *(const unsigned*)(row_ + C_GQ + h_ * 128 + lane * 2); kk = *(const unsigned*)(row_ + C_GK + h_ * 128 + lane * 2); \
        f = *(const u32x2*)(F + (size_t)tok_ * D + h_ * 256 + lane * 4); bk = *(const u32x2*)(row_ + C_DV + h_ * 256 + lane * 4); \
        v = *(const u32x2*)(row_ + C_GV + h_ * 256 + lane * 4); gt = *(const u32x2*)(row_ + C_GG + h_ * 256 + lane * 4); } while (0)
    const f32x4 go = *(const f32x4*)(launder(p.in[I_GOUT]) + lane * 4);
    GFLOAD(tok0 * 4 + wid);
    for (int it = tok0 * 4 + wid; it < (tok0 + ntok) * 4; it += 8) {
        const int tok = it >> 2, h = it & 3;
        bf16_t* row = P + (size_t)tok * NP;
        const unsigned cq = qq, ck = kk; const u32x2 cf = f, cbk = bk, cv = v, cgt = gt;
        if (it + 8 < (tok0 + ntok) * 4) GFLOAD(it + 8);
        __builtin_amdgcn_sched_barrier(0);
        const float qk = wave_sum(bflo(cq) * bflo(ck) + bfhi(cq) * bfhi(ck));
        float o0 = bflo(cf.x) + bflo(cbk.x) - qk * bflo(cv.x), o1 = bfhi(cf.x) + bfhi(cbk.x) - qk * bfhi(cv.x);
        float o2 = bflo(cf.y) + bflo(cbk.y) - qk * bflo(cv.y), o3 = bfhi(cf.y) + bfhi(cbk.y) - qk * bfhi(cv.y);
        const float r = rsqrtf(wave_sum(o0 * o0 + o1 * o1 + o2 * o2 + o3 * o3) * (1.f / 256.f) + RMS_EPS);
        const float g0 = bflo(cgt.x), g1 = bfhi(cgt.x), g2 = bflo(cgt.y), g3 = bfhi(cgt.y);
        o0 *= r * go.x * g0 / (1.f + __expf(-g0)); o1 *= r * go.y * g1 / (1.f + __expf(-g1));
        o2 *= r * go.z * g2 / (1.f + __expf(-g2)); o3 *= r * go.w * g3 / (1.f + __expf(-g3));
        *(u32x2*)(row + C_GG + h * 256 + lane * 4) = (u32x2){pk2(o0, o1), pk2(o2, o3)};
    }
#undef GFLOAD
}

__device__ __forceinline__ void phase_merge(const Params& p, int g, char* lds, int u) {
    const int tid_ = otid(), lane = tid_ & 63, wid = tid_ >> 6, wm = wid >> 2, wn = wid & 3, fr = lane & 15, fq = lane >> 4;
    const bf16_t* P = (const bf16_t*)(p.ws + WS_PROJ); bf16_t* M = (bf16_t*)(p.ws + WS_VT);
    for (int pn = 0; pn < 4; ++pn) {
        const int m0 = u * 128, n0 = pn * 256;
        f32x4 macc[4][4];
#pragma unroll
        for (int i = 0; i < 4; ++i)
#pragma unroll
            for (int j = 0; j < 4; ++j) macc[i][j] = (f32x4){0.f, 0.f, 0.f, 0.f};
        for (int br = 0; br < 3; ++br) {
            f32x4 acc[4][4];
#pragma unroll
            for (int i = 0; i < 4; ++i)
#pragma unroll
                for (int j = 0; j < 4; ++j) acc[i][j] = (f32x4){0.f, 0.f, 0.f, 0.f};
            const int acol = br == 0 ? C_GG : (br == 1 ? C_DQ : C_MQ);
            gemm_kloop<true, 4>(acc, P + (size_t)m0 * NP + acol, NP, (const bf16_t*)(p.ws + WS_WOT) + (size_t)br * D * D + (size_t)n0 * D, D, D, lds);
#pragma unroll
            for (int mt = 0; mt < 4; ++mt)
#pragma unroll
                for (int nt = 0; nt < 4; ++nt) {
                    const int row = m0 + wm * 64 + mt * 16 + fr, col = n0 + wn * 64 + nt * 16 + fq * 4;
                    const u32x2 gt = *(const u32x2*)(P + (size_t)row * NP + C_BG + br * 1024 + col);
                    f32x4 sg; sg.x = 1.f / (1.f + __expf(-bflo(gt.x))); sg.y = 1.f / (1.f + __expf(-bfhi(gt.x))); sg.z = 1.f / (1.f + __expf(-bflo(gt.y))); sg.w = 1.f / (1.f + __expf(-bfhi(gt.y)));
                    macc[mt][nt] += sg * acc[mt][nt];
                }
        }
#pragma unroll
        for (int mt = 0; mt < 4; ++mt)
#pragma unroll
            for (int nt = 0; nt < 4; ++nt) {
                const int row = m0 + wm * 64 + mt * 16 + fr, col = n0 + wn * 64 + nt * 16 + fq * 4;
                *(u32x2*)(M + (size_t)row * D + col) = (u32x2){pk2(macc[mt][nt].x, macc[mt][nt].y), pk2(macc[mt][nt].z, macc[mt][nt].w)};
            }
    }
}

__device__ __forceinline__ void phase_outproj(const Params& p, int g, char* lds, int u) {
    const Grp G = get_group(p, g);
    const int tid_ = otid(), lane = tid_ & 63, wid = tid_ >> 6, wm = wid >> 2, wn = wid & 3, fr = lane & 15, fq = lane >> 4;
    const bf16_t* M = (const bf16_t*)(p.ws + WS_VT); const bf16_t* W = (const bf16_t*)(p.ws + WS_WOT) + (size_t)3 * D * D;
    for (int pn = 0; pn < 4; ++pn) {
        const int m0 = u * 128, n0 = pn * 256;
        f32x4 acc[4][4];
#pragma unroll
        for (int i = 0; i < 4; ++i)
#pragma unroll
            for (int j = 0; j < 4; ++j) acc[i][j] = (f32x4){0.f, 0.f, 0.f, 0.f};
        gemm_kloop<true, 4>(acc, M + (size_t)m0 * D, D, W + (size_t)n0 * D, D, D, lds);
#pragma unroll
        for (int mt = 0; mt < 4; ++mt)
#pragma unroll
            for (int nt = 0; nt < 4; ++nt) {
                const int row = m0 + wm * 64 + mt * 16 + fr, col = n0 + wn * 64 + nt * 16 + fq * 4;
                const f32x4 xv = *(const f32x4*)(G.x + (size_t)row * D + col);
                *(f32x4*)(G.out + (size_t)row * D + col) = xv + acc[mt][nt];
            }
    }
}

__device__ __forceinline__ void phase_peerq(const Params& p, int g, char* lds, int u) {
    const int tid_ = otid(), lane = tid_ & 63, wid = tid_ >> 6, wm = wid >> 2, wn = wid & 3, fr = lane & 15, fq = lane >> 4;
    const bf16_t* A = (const bf16_t*)(p.ws + WS_HB); const bf16_t* W = (const bf16_t*)(p.ws + WS_WQT); bf16_t* P = (bf16_t*)(p.ws + WS_PROJ);
    for (int pn = 0; pn < 8; ++pn) {
        const int m0 = u * 128, n0 = pn * 256;
        f32x4 acc[4][4];
#pragma unroll
        for (int i = 0; i < 4; ++i)
#pragma unroll
            for (int j = 0; j < 4; ++j) acc[i][j] = (f32x4){0.f, 0.f, 0.f, 0.f};
        gemm_kloop<true, 4>(acc, A + (size_t)m0 * D, D, W + (size_t)n0 * D, D, D, lds);
#pragma unroll
        for (int mt = 0; mt < 4; ++mt)
#pragma unroll
            for (int nt = 0; nt < 4; ++nt) {
                const int row = m0 + wm * 64 + mt * 16 + fr, col = n0 + wn * 64 + nt * 16 + fq * 4;
                *(u32x2*)(P + (size_t)row * NP + col) = (u32x2){pk2(acc[mt][nt].x, acc[mt][nt].y), pk2(acc[mt][nt].z, acc[mt][nt].w)};
            }
    }
}

__device__ __forceinline__ unsigned f2ord(float f) { const unsigned u = __float_as_uint(f); return (u & 0x80000000u) ? ~u : (u | 0x80000000u); }
__device__ __forceinline__ float ord2f(unsigned k) { const unsigned u = (k & 0x80000000u) ? (k & 0x7fffffffu) : ~k; return __uint_as_float(u); }
__device__ __forceinline__ unsigned gmax16(unsigned v) {
    unsigned t;
    t = sxoru<1>(v); v = v > t ? v : t; t = sxoru<2>(v); v = v > t ? v : t; t = sxoru<4>(v); v = v > t ? v : t; t = sxoru<8>(v); v = v > t ? v : t;
    return v;
}
__device__ __forceinline__ float gsum16(float v) { v += sxor<1>(v); v += sxor<2>(v); v += sxor<4>(v); v += sxor<8>(v); return v; }
__device__ __forceinline__ float gelu_exact(float a) { return 0.5f * a * (1.0f + erff(a * 0.70710678118654752f)); }

__device__ __forceinline__ void phase_peer(const Params& p, int g, char* lds, int tile0, int ntile) {
    const Grp G = get_group(p, g);
    const int tid = otid(), lane = tid & 63, wid = tid >> 6, fr = lane & 15, fq = lane >> 4;
    const bf16_t* P = (const bf16_t*)(p.ws + WS_PROJ); const bf16_t* HB = (const bf16_t*)(p.ws + WS_HB);
    const bf16_t* K12 = (const bf16_t*)(p.ws + WS_K12);
    float* SC = (float*)lds;
    int* EIDX = (int*)(lds + 65536);
    float* GATE = (float*)(lds + 65536 + 4096);
    char* KL = lds + 73728;
    for (int i = tid; i < 2 * 128 * 16; i += NTHR) {
        const int r = i >> 4, ch = i & 15;
        *(u32x4*)(KL + r * 272 + ch * 16) = *(const u32x4*)(K12 + (size_t)r * 128 + ch * 8);
    }
    __syncthreads();
    for (int tile = tile0; tile < tile0 + ntile; ++tile) {
        const int tok0 = tile * 8;
        {
            const bf16_t* qtok = P + (size_t)(tok0 + wid) * NP + (fr & 7) * 256;
#pragma unroll
            for (int half = 0; half < 2; ++half) {
                f32x4 acc[8];
#pragma unroll
                for (int i = 0; i < 8; ++i) acc[i] = (f32x4){0.f, 0.f, 0.f, 0.f};
#pragma unroll
                for (int ks = 0; ks < 4; ++ks) {
                    const bf16x8 af = *(const bf16x8*)(qtok + half * 128 + ks * 32 + fq * 8);
#pragma unroll
                    for (int nt = 0; nt < 8; ++nt) { const bf16x8 bfv = *(const bf16x8*)(KL + (half * 128 + nt * 16 + fr) * 272 + ks * 64 + fq * 16); acc[nt] = mfma16(af, bfv, acc[nt]); }
                }
                if (fq < 2) {
#pragma unroll
                    for (int nt = 0; nt < 8; ++nt) {
                        float* dst = SC + (wid * 8 + fq * 4) * 256 + half * 128 + nt * 16 + fr;
                        dst[0] = acc[nt].x; dst[256] = acc[nt].y; dst[512] = acc[nt].z; dst[768] = acc[nt].w;
                    }
                }
            }
        }
        __builtin_amdgcn_wave_barrier();
        {
            const int sl = fr, gb = fq * 16;
            const int row0_ = wid * 8 + fq, row1_ = wid * 8 + 4 + fq;
            float v1[2] = {0.f, 0.f}, v2[2] = {0.f, 0.f}; int i1[2] = {0, 0}, i2[2] = {0, 0};
#pragma unroll
            for (int hf = 0; hf < 2; ++hf) {
                unsigned ka[8], kb[8];
#pragma unroll
                for (int i = 0; i < 8; ++i) { const int idx = sl + 16 * i;
                    ka[i] = (f2ord(SC[row0_ * 256 + hf * 128 + idx]) & ~127u) | (unsigned)(127 - idx);
                    kb[i] = (f2ord(SC[row1_ * 256 + hf * 128 + idx]) & ~127u) | (unsigned)(127 - idx); }
                float sva = 0.f, svb = 0.f; int sia = 0, sib = 0;
                for (int r = 0; r < 16; ++r) {
                    unsigned ma = ka[0], mb = kb[0];
#pragma unroll
                    for (int i = 1; i < 8; ++i) { ma = ma > ka[i] ? ma : ka[i]; mb = mb > kb[i] ? mb : kb[i]; }
                    unsigned ta, tb;
                    ta = sxoru<1>(ma); tb = sxoru<1>(mb); ma = ma > ta ? ma : ta; mb = mb > tb ? mb : tb;
                    ta = sxoru<2>(ma); tb = sxoru<2>(mb); ma = ma > ta ? ma : ta; mb = mb > tb ? mb : tb;
                    ta = sxoru<4>(ma); tb = sxoru<4>(mb); ma = ma > ta ? ma : ta; mb = mb > tb ? mb : tb;
                    ta = sxoru<8>(ma); tb = sxoru<8>(mb); ma = ma > ta ? ma : ta; mb = mb > tb ? mb : tb;
                    if (sl == r) { sva = ord2f(ma & ~127u); sia = 127 - (int)(ma & 127u); svb = ord2f(mb & ~127u); sib = 127 - (int)(mb & 127u); }
#pragma unroll
                    for (int i = 0; i < 8; ++i) { ka[i] = ka[i] == ma ? 0u : ka[i]; kb[i] = kb[i] == mb ? 0u : kb[i]; }
                }
                if (hf == 0) { v1[0] = sva; i1[0] = sia; v1[1] = svb; i1[1] = sib; } else { v2[0] = sva; i2[0] = sia; v2[1] = svb; i2[1] = sib; }
            }
            int pa = 0, pb = 0; float tsa = 0.f, tsb = 0.f; int pida = 0, pidb = 0;
            for (int r = 0; r < 16; ++r) {
                const float va = __int_as_float(__builtin_amdgcn_ds_bpermute((gb + (pa & 15)) << 2, __float_as_int(v2[0])));
                const float vb = __int_as_float(__builtin_amdgcn_ds_bpermute((gb + (pb & 15)) << 2, __float_as_int(v2[1])));
                const unsigned keya = pa < 16 ? ((f2ord(v1[0] + va) & ~255u) | (unsigned)(255 - (sl * 16 + pa))) : 0u;
                const unsigned keyb = pb < 16 ? ((f2ord(v1[1] + vb) & ~255u) | (unsigned)(255 - (sl * 16 + pb))) : 0u;
                unsigned ma = keya, mb = keyb, ta, tb;
                ta = sxoru<1>(ma); tb = sxoru<1>(mb); ma = ma > ta ? ma : ta; mb = mb > tb ? mb : tb;
                ta = sxoru<2>(ma); tb = sxoru<2>(mb); ma = ma > ta ? ma : ta; mb = mb > tb ? mb : tb;
                ta = sxoru<4>(ma); tb = sxoru<4>(mb); ma = ma > ta ? ma : ta; mb = mb > tb ? mb : tb;
                ta = sxoru<8>(ma); tb = sxoru<8>(mb); ma = ma > ta ? ma : ta; mb = mb > tb ? mb : tb;
                if (sl == r) { tsa = ord2f(ma & ~255u); pida = 255 - (int)(ma & 255u); tsb = ord2f(mb & ~255u); pidb = 255 - (int)(mb & 255u); }
                if (keya == ma) pa++;
                if (keyb == mb) pb++;
            }
#pragma unroll
            for (int ps = 0; ps < 2; ++ps) {
                const int pid = ps ? pidb : pida; const float ts = ps ? tsb : tsa; const int row = ps ? row1_ : row0_;
                const int e1 = __builtin_amdgcn_ds_bpermute((gb + (pid >> 4)) << 2, i1[ps]), e2 = __builtin_amdgcn_ds_bpermute((gb + (pid & 15)) << 2, i2[ps]);
                float mx = ts;
                mx = fmaxf(mx, sxor<1>(mx)); mx = fmaxf(mx, sxor<2>(mx)); mx = fmaxf(mx, sxor<4>(mx)); mx = fmaxf(mx, sxor<8>(mx));
                const float ex = __expf(ts - mx), sm = gsum16(ex);
                EIDX[row * 16 + sl] = e1 * 128 + e2; GATE[row * 16 + sl] = ex / sm;
            }
        }
        __builtin_amdgcn_wave_barrier();
        {
            const int tok = tok0 + wid;
            const bf16_t* hrow = HB + (size_t)tok * D;
            const int grp = lane >> 4, sl = lane & 15;
            {
                f32x2 hv[32];
#pragma unroll
                for (int c = 0; c < 8; ++c) {
                    const u32x4 hq = *(const u32x4*)(hrow + sl * 64 + c * 8);
                    hv[c * 4 + 0] = (f32x2){bflo(hq.x), bfhi(hq.x)} * (1.0f / PEER_SU); hv[c * 4 + 1] = (f32x2){bflo(hq.y), bfhi(hq.y)} * (1.0f / PEER_SU);
                    hv[c * 4 + 2] = (f32x2){bflo(hq.z), bfhi(hq.z)} * (1.0f / PEER_SU); hv[c * 4 + 3] = (f32x2){bflo(hq.w), bfhi(hq.w)} * (1.0f / PEER_SU);
                }
                const unsigned char* PU8 = p.ws + WS_PU + sl * 64;
#define ULOADG(BUF, IT) do { _Pragma("unroll") for (int i_ = 0; i_ < 2; ++i_) { const int k_ = ((IT) + i_) * 4 + grp; const unsigned char* ur_ = PU8 + (size_t)EIDX[wid * 128 + k_] * D; \
        BUF[i_ * 4 + 0] = *(const u32x4*)ur_; BUF[i_ * 4 + 1] = *(const u32x4*)(ur_ + 16); BUF[i_ * 4 + 2] = *(const u32x4*)(ur_ + 32); BUF[i_ * 4 + 3] = *(const u32x4*)(ur_ + 48); } } while (0)
#define PDOT(uq, base) \
        a2 += __builtin_amdgcn_cvt_pk_f32_fp8((int)uq.x, false) * hv[base + 0]; b2 += __builtin_amdgcn_cvt_pk_f32_fp8((int)uq.x, true) * hv[base + 1]; \
        a2 += __builtin_amdgcn_cvt_pk_f32_fp8((int)uq.y, false) * hv[base + 2]; b2 += __builtin_amdgcn_cvt_pk_f32_fp8((int)uq.y, true) * hv[base + 3]; \
        a2 += __builtin_amdgcn_cvt_pk_f32_fp8((int)uq.z, false) * hv[base + 4]; b2 += __builtin_amdgcn_cvt_pk_f32_fp8((int)uq.z, true) * hv[base + 5]; \
        a2 += __builtin_amdgcn_cvt_pk_f32_fp8((int)uq.w, false) * hv[base + 6]; b2 += __builtin_amdgcn_cvt_pk_f32_fp8((int)uq.w, true) * hv[base + 7];
#define UCOMP(BUF, IT) do { _Pragma("unroll") for (int i_ = 0; i_ < 2; ++i_) { const int k_ = ((IT) + i_) * 4 + grp; \
        f32x2 a2 = (f32x2){0.f, 0.f}, b2 = (f32x2){0.f, 0.f}; \
        PDOT(BUF[i_ * 4 + 0], 0) PDOT(BUF[i_ * 4 + 1], 8) PDOT(BUF[i_ * 4 + 2], 16) PDOT(BUF[i_ * 4 + 3], 24) \
        a2 += b2; const float a_ = gsum16(a2.x + a2.y); GATE[wid * 128 + k_] = GATE[wid * 128 + k_] * gelu_exact(a_); } } while (0)
                u32x4 ubA[8], ubB[8];
                ULOADG(ubA, 0);
                for (int it0 = 0; it0 < 32; it0 += 4) {
                    ULOADG(ubB, it0 + 2);
                    __builtin_amdgcn_sched_barrier(0);
                    UCOMP(ubA, it0);
                    __builtin_amdgcn_sched_barrier(0);
                    if (it0 + 4 < 32) ULOADG(ubA, it0 + 4);
                    __builtin_amdgcn_sched_barrier(0);
                    UCOMP(ubB, it0 + 2);
                    __builtin_amdgcn_sched_barrier(0);
                }
#undef ULOADG
#undef PDOT
#undef UCOMP
            }
            __builtin_amdgcn_wave_barrier();
            f32x2 acc[8];
#pragma unroll
            for (int i = 0; i < 8; ++i) acc[i] = (f32x2){0.f, 0.f};
            const unsigned char* PV8 = p.ws + WS_PV + lane * 16;
#define VLOADG(BUF, K0) do { _Pragma("unroll") for (int i_ = 0; i_ < 8; ++i_) BUF[i_] = *(const u32x4*)(PV8 + (size_t)EIDX[wid * 128 + (K0) + i_] * D); } while (0)
#define VCOMP(BUF, K0) do { _Pragma("unroll") for (int i_ = 0; i_ < 8; ++i_) { const float w_ = GATE[wid * 128 + (K0) + i_]; const f32x2 w2 = (f32x2){w_, w_}; const u32x4 v = BUF[i_]; \
        acc[0] += w2 * __builtin_amdgcn_cvt_pk_f32_fp8((int)v.x, false); acc[1] += w2 * __builtin_amdgcn_cvt_pk_f32_fp8((int)v.x, true); \
        acc[2] += w2 * __builtin_amdgcn_cvt_pk_f32_fp8((int)v.y, false); acc[3] += w2 * __builtin_amdgcn_cvt_pk_f32_fp8((int)v.y, true); \
        acc[4] += w2 * __builtin_amdgcn_cvt_pk_f32_fp8((int)v.z, false); acc[5] += w2 * __builtin_amdgcn_cvt_pk_f32_fp8((int)v.z, true); \
        acc[6] += w2 * __builtin_amdgcn_cvt_pk_f32_fp8((int)v.w, false); acc[7] += w2 * __builtin_amdgcn_cvt_pk_f32_fp8((int)v.w, true); } } while (0)
            {
                u32x4 vbA[8], vbB[8];
                VLOADG(vbA, 0);
                for (int k0 = 0; k0 < 128; k0 += 16) {
                    VLOADG(vbB, k0 + 8);
                    __builtin_amdgcn_sched_barrier(0);
                    VCOMP(vbA, k0);
                    __builtin_amdgcn_sched_barrier(0);
                    if (k0 + 16 < 128) VLOADG(vbA, k0 + 16);
                    __builtin_amdgcn_sched_barrier(0);
                    VCOMP(vbB, k0 + 8);
                    __builtin_amdgcn_sched_barrier(0);
                }
            }
#undef VLOADG
#undef VCOMP
            float* orow = G.out + (size_t)tok * D + lane * 16;
#pragma unroll
            for (int i = 0; i < 4; ++i) {
                f32x4 t = *(f32x4*)(orow + i * 4);
                t.x += acc[2 * i].x * (1.0f / PEER_SV); t.y += acc[2 * i].y * (1.0f / PEER_SV); t.z += acc[2 * i + 1].x * (1.0f / PEER_SV); t.w += acc[2 * i + 1].y * (1.0f / PEER_SV);
                *(f32x4*)(orow + i * 4) = t;
            }
        }
        __builtin_amdgcn_wave_barrier();
    }
}


constexpr int NPH = 3 + NGROUP * 3;
__device__ __forceinline__ void run_phase(const Params& p, int ph, char* lds, int* s_item) {
    const int g = (ph - 3) / 3, s = (ph - 3) % 3;
    const Grp G = get_group(p, g);
    if (s == 0) {
        for (int u = blockIdx.x; u < 256; u += gridDim.x) {
            const int m0 = (u >> 1) * 256;
            phase_rmsnorm(G.x, p.in[I_GMIX], (bf16_t*)(p.ws + WS_HB), m0, 256);
            __syncthreads();
            phase_inproj(p, g, lds, u);
            __syncthreads();
        }
    } else if (s == 1) {
        phase_mixer(p, g, lds, s_item);
    } else {
        for (int u = blockIdx.x; u < 256; u += gridDim.x) {
            const int m0 = u * 128;
            phase_glafin(p, g, m0, 128);
            __syncthreads();
            phase_merge(p, g, lds, u);
            __syncthreads();
            phase_outproj(p, g, lds, u);
            __syncthreads();
            phase_rmsnorm(G.out, p.in[I_GFFN], (bf16_t*)(p.ws + WS_HB), m0, 128);
            __syncthreads();
            phase_peerq(p, g, lds, u);
            __syncthreads();
            phase_peer(p, g, lds, m0 / 8, 16);
            __syncthreads();
        }
    }
}

__global__ void __launch_bounds__(NTHR) mega_kernel(Params p) {
    extern __shared__ __attribute__((aligned(16))) char lds[];
    __shared__ int s_item;
    cg::grid_group grid = cg::this_grid();
    phase_p0a(p, lds); grid.sync();
    phase_p0b(p, lds); grid.sync();
    phase_p0c(p); grid.sync();
    for (int ph = 3; ph < NPH; ++ph) {
        run_phase(p, ph, lds, &s_item);
        if (ph + 1 < NPH) grid.sync();
    }
}

extern "C" void kernel_launch(void* const* d_in, const int* in_sizes, int n_in, void* d_out, int out_size, void* d_ws, size_t ws_size, hipStream_t stream) {
    static int grid_blocks = 0;
    if (grid_blocks == 0) {
        if (n_in != 32 || ws_size < WS_END) { fprintf(stderr, "kernel_launch: unexpected n_in %d or ws_size %zu (< %zu)\n", n_in, ws_size, (size_t)WS_END); grid_blocks = -1; return; }
        int dev = 0, cus = 0, per_cu = 0;
        hipGetDevice(&dev);
        hipDeviceGetAttribute(&cus, hipDeviceAttributeMultiprocessorCount, dev);
        hipFuncSetAttribute((const void*)mega_kernel, hipFuncAttributeMaxDynamicSharedMemorySize, LDS_BYTES);
        hipOccupancyMaxActiveBlocksPerMultiprocessor(&per_cu, (const void*)mega_kernel, NTHR, LDS_BYTES);
        if (per_cu < 1) per_cu = 1;
        grid_blocks = cus * per_cu;
        (void)hipGetLastError();
    }
    if (grid_blocks < 0) return;
    Params p{};
    for (int i = 0; i < 32; ++i) p.in[i] = (const float*)d_in[i];
    p.out = (float*)d_out; p.ws = (unsigned char*)d_ws; p.ph_lo = 0; p.ph_hi = NPH;
    void* args[] = {&p};
    hipError_t e = hipLaunchCooperativeKernel((const void*)mega_kernel, dim3(grid_blocks), dim3(NTHR), args, LDS_BYTES, stream);
    if (e != hipSuccess) fprintf(stderr, "cooperative launch failed: %s (grid %d)\n", hipGetErrorString(e), grid_blocks);
}
```

```cpp
#include <hip/hip_runtime.h>
#include <hip/hip_cooperative_groups.h>
#include <cstdio>
#include <cstdint>
namespace cg = cooperative_groups;

typedef unsigned short bf16_t;
typedef short bf16x8 __attribute__((ext_vector_type(8)));
typedef float f32x4 __attribute__((ext_vector_type(4)));
typedef unsigned u32x4 __attribute__((ext_vector_type(4)));
typedef unsigned u32x2 __attribute__((ext_vector_type(2)));

constexpr int D = 1024;
constexpr int NP = 10496;
constexpr int IN_COLS = 10272;
constexpr int C_GQ = 0, C_GK = 512, C_GV = 1024, C_GG = 2048, C_DQ = 3072, C_DK = 4096, C_DV = 5120, C_MQ = 6144, C_BG = 7168, C_LR = 10240;
constexpr int G_TOK = 32768;
constexpr int NGROUP = 3;
constexpr int NTHR = 512;
constexpr float RMS_EPS = 1e-6f;
constexpr float LOG2E = 1.4426950408889634f;
constexpr int LDS_BYTES = 147456;
constexpr float PEER_SU = 32.0f, PEER_SV = 8.0f;

enum { I_XP = 0, I_XS, I_MP, I_MS, I_GMIX, I_WIN, I_WDF, I_BDF, I_WDB, I_BDB, I_GOUT, I_GWO, I_DGQ, I_DGK, I_LQ1, I_LK1, I_LQ2, I_LK2,
       I_DGSUB, I_DWO, I_MGN, I_MWKV, I_MGQ, I_MGK, I_MWO, I_WOUT, I_GFFN, I_PWQ, I_PK1, I_PK2, I_PU, I_PV };

constexpr size_t al256(size_t x) { return (x + 255) & ~(size_t)255; }
constexpr size_t WS_CTRL = 0;
constexpr size_t WS_PROJ = 4096;
constexpr size_t WS_HB   = WS_PROJ + (size_t)G_TOK * NP * 2;
constexpr size_t WS_VT   = WS_HB + (size_t)G_TOK * D * 2;
constexpr size_t WS_WINT = WS_VT + (size_t)G_TOK * D * 2;
constexpr size_t WS_WOT  = WS_WINT + (size_t)NP * D * 2;
constexpr size_t WS_WKVT = WS_WOT + (size_t)4 * D * D * 2;
constexpr size_t WS_WQT  = WS_WKVT + (size_t)2048 * D * 2;
constexpr size_t WS_PU   = WS_WQT + (size_t)2048 * D * 2;
constexpr size_t WS_PV   = WS_PU + (size_t)16384 * D * 2;
constexpr size_t WS_K12  = WS_PV + (size_t)16384 * D * 2;
constexpr size_t WS_ROPE = WS_K12 + (size_t)2 * 128 * 128 * 2;
constexpr size_t WS_HM   = WS_ROPE + (size_t)16384 * 64 * 4;
constexpr size_t WS_KVR  = WS_HM + (size_t)2560 * D * 2;
constexpr size_t WS_MEMK = WS_KVR + (size_t)2560 * 2048 * 4;
constexpr size_t WS_MEMV = WS_MEMK + (size_t)10 * 4 * 256 * 256 * 2;
constexpr size_t WS_END  = WS_MEMV + (size_t)10 * 4 * 256 * 256 * 2;

struct Params {
    const float* in[32];
    float* out;
    unsigned char* ws;
    int ph_lo, ph_hi;
};

typedef float f32x2 __attribute__((ext_vector_type(2)));
typedef __bf16 bf16x2v __attribute__((ext_vector_type(2)));
__device__ __forceinline__ unsigned pk2(float lo, float hi) { const f32x2 v = {lo, hi}; const bf16x2v b = __builtin_convertvector(v, bf16x2v); return __builtin_bit_cast(unsigned, b); }
__device__ __forceinline__ float bflo(unsigned u) { return __uint_as_float(u << 16); }
__device__ __forceinline__ float bfhi(unsigned u) { return __uint_as_float(u & 0xffff0000u); }
__device__ __forceinline__ float bf2f(bf16_t b) { return __uint_as_float(((unsigned)b) << 16); }
__device__ __forceinline__ bf16_t f2bf(float f) { return (bf16_t)(pk2(f, 0.f) & 0xffffu); }
__device__ __forceinline__ f32x4 mfma16(bf16x8 a, bf16x8 b, f32x4 c) { return __builtin_amdgcn_mfma_f32_16x16x32_bf16(a, b, c, 0, 0, 0); }
__device__ __forceinline__ float fexp2(float x) { return __builtin_amdgcn_exp2f(x); }
template <class T> __device__ __forceinline__ T* launder(T* q) { asm volatile("" : "+s"(q)); return q; }
__device__ __forceinline__ int otid() { int t = threadIdx.x; asm volatile("" : "+v"(t)); return t; }
template <int M> __device__ __forceinline__ float sxor(float v) {
    if (M < 32) return __int_as_float(__builtin_amdgcn_ds_swizzle(__float_as_int(v), (M << 10) | 0x1F));
    const int l = otid() & 63; return __int_as_float(__builtin_amdgcn_ds_bpermute((l ^ 32) << 2, __float_as_int(v)));
}
template <int M> __device__ __forceinline__ unsigned sxoru(unsigned v) { return (unsigned)__builtin_amdgcn_ds_swizzle((int)v, (M << 10) | 0x1F); }
__device__ __forceinline__ float wave_sum(float v) {
    v += sxor<1>(v); v += sxor<2>(v); v += sxor<4>(v); v += sxor<8>(v); v += sxor<16>(v); v += sxor<32>(v);
    return v;
}

struct Grp { const float* x; const float* mem; float* out; int B, T, mb0; };
__device__ __forceinline__ Grp get_group(const Params& p, int g) {
    Grp r;
    if (g == 0) { r.x = p.in[I_XP]; r.out = p.out; r.B = 2; r.T = 16384; r.mb0 = 0; }
    else { r.x = p.in[I_XS] + (size_t)(g - 1) * G_TOK * D; r.out = p.out + (size_t)g * G_TOK * D; r.B = 4; r.T = 8192; r.mb0 = 2 + (g - 1) * 4; }
    r.mem = nullptr;
    return r;
}

constexpr int G_ROW = 144;
constexpr int G_A_BYTES = 128 * G_ROW;
constexpr int G_B_BYTES = 256 * G_ROW;
constexpr int G_STAGE = G_A_BYTES + G_B_BYTES;

template <bool SWAP, int MT>
__device__ __forceinline__ void gemm_kloop(f32x4 (&acc)[MT][4], const bf16_t* __restrict__ A, int lda, const bf16_t* __restrict__ Bt, int ldb, int K, char* lds) {
    constexpr int A_ROWS = MT * 32, A_BYTES = A_ROWS * G_ROW, STAGE = A_BYTES + G_B_BYTES;
    constexpr int NA = A_BYTES / 1024, NI = STAGE / 1024, NPER = (NI + 7) / 8;
    const int tid = otid(), lane = tid & 63, wid = __builtin_amdgcn_readfirstlane(tid >> 6), wm = wid >> 2, wn = wid & 3, fr = lane & 15, fq = lane >> 4;
    unsigned goff[NPER];
#pragma unroll
    for (int i = 0; i < NPER; ++i) {
        const int j = wid + 8 * i;
        const int ci = (j < NA ? j : j - NA) * 64 + lane, row = ci / 9, ch = ci % 9, chc = ch < 8 ? ch : 7;
        goff[i] = (unsigned)(row * (j < NA ? lda : ldb) + chc * 8);
    }
#define GSTAGE(buf, k0) do { _Pragma("unroll") for (int i = 0; i < NPER; ++i) { const int j = wid + 8 * i; if (j < NI) { \
        const bf16_t* src_ = (j < NA ? A : Bt) + goff[i] + (k0); \
        __builtin_amdgcn_global_load_lds((const unsigned*)src_, (unsigned*)(lds + (buf) * STAGE + j * 1024), 16, 0, 0); } } } while (0)
    const int nk = K / 64;
    GSTAGE(0, 0);
    __syncthreads();
    for (int kt = 0; kt < nk; ++kt) {
        if (kt + 1 < nk) GSTAGE((kt + 1) & 1, (kt + 1) * 64);
        const char* base = lds + (kt & 1) * STAGE;
        const char* abase = base + (wm * (MT * 16) + fr) * G_ROW + fq * 16;
        const char* bbase = base + A_BYTES + (wn * 64 + fr) * G_ROW + fq * 16;
        bf16x8 b0[4], b1[4], ar[4];
#pragma unroll
        for (int nt = 0; nt < 4; ++nt) b0[nt] = *(const bf16x8*)(bbase + nt * 16 * G_ROW);
        ar[0] = *(const bf16x8*)(abase); ar[1] = *(const bf16x8*)(abase + 16 * G_ROW); ar[2] = *(const bf16x8*)(abase + 32 * G_ROW);
#pragma unroll
        for (int st = 0; st < 2 * MT; ++st) {
            const int ks = st / MT, mt = st % MT;
            __builtin_amdgcn_sched_barrier(0);
            if (st + 3 < 2 * MT) { const int ks2 = (st + 3) / MT, mt2 = (st + 3) % MT; ar[(st + 3) % 4] = *(const bf16x8*)(abase + mt2 * 16 * G_ROW + ks2 * 64); }
            if (ks == 0 && mt >= MT - 3 && mt < MT - 1) {
#pragma unroll
                for (int q = 0; q < 2; ++q) { const int nt = (mt - (MT - 3)) * 2 + q; b1[nt] = *(const bf16x8*)(bbase + nt * 16 * G_ROW + 64); }
            }
#pragma unroll
            for (int nt = 0; nt < 4; ++nt) {
                const bf16x8 bv = ks == 0 ? b0[nt] : b1[nt];
                acc[mt][nt] = SWAP ? mfma16(bv, ar[st % 4], acc[mt][nt]) : mfma16(ar[st % 4], bv, acc[mt][nt]);
            }
        }
        __builtin_amdgcn_sched_barrier(0);
        __syncthreads();
    }
#undef GSTAGE
}

__device__ __forceinline__ void tile_order(int t, int nM, int nN, int& pm, int& pn) {
    const int per = 8 * nN, grp = t / per, r = t % per;
    pm = grp * 8 + (r & 7); pn = r >> 3;
}

__device__ __forceinline__ void phase_p0a(const Params& p, char* lds) {
    const int tid = otid(), lane = tid & 63, wid = tid >> 6;
    unsigned char* ws = p.ws;
    if (blockIdx.x == 0 && tid < 256) atomicExch((unsigned*)(ws + WS_CTRL) + tid, 0u);
    float* scr = (float*)(lds + wid * 8448);
    constexpr int IT_WIN = 16 * (NP / 32), IT_SQ = 16 * 32, IT_W2 = 16 * 64;
    constexpr int NIT = IT_WIN + 4 * IT_SQ + 2 * IT_W2;
    for (int it0 = blockIdx.x * 8; it0 < NIT; it0 += gridDim.x * 8) {
        int it = it0 + wid;
        const float* W = nullptr; bf16_t* WT = nullptr; int N = 0, nb = 0, kb = 0, srccol = -1;
        if (it < NIT) {
            int r = it;
            if (r < IT_WIN) { W = p.in[I_WIN]; N = IN_COLS; WT = (bf16_t*)(ws + WS_WINT); kb = r / (NP / 32); nb = r % (NP / 32);
                const int n0 = nb * 32; srccol = n0 < 3072 ? n0 : (n0 < 10240 ? n0 + 32 : (n0 == 10240 ? 3072 : -1)); }
            else { r -= IT_WIN;
                if (r < 4 * IT_SQ) { const int w = r / IT_SQ; r %= IT_SQ; const int idx[4] = {I_GWO, I_DWO, I_MWO, I_WOUT};
                    W = p.in[w == 0 ? I_GWO : (w == 1 ? I_DWO : (w == 2 ? I_MWO : I_WOUT))]; (void)idx; N = 1024; WT = (bf16_t*)(ws + WS_WOT) + (size_t)w * D * D; kb = r / 32; nb = r % 32; srccol = nb * 32; }
                else { r -= 4 * IT_SQ; const int w = r / IT_W2; r %= IT_W2; W = p.in[w == 0 ? I_MWKV : I_PWQ]; N = 2048; WT = (bf16_t*)(ws + (w == 0 ? WS_WKVT : WS_WQT)); kb = r / 64; nb = r % 64; srccol = nb * 32; }
            }
            const int k0 = kb * 64;
#pragma unroll 8
            for (int i = 0; i < 32; ++i) { const int kk = 2 * i + (lane >> 5); scr[kk * 33 + (lane & 31)] = srccol >= 0 ? W[(size_t)(k0 + kk) * N + srccol + (lane & 31)] : 0.f; }
        }
        __syncthreads();
        if (it < NIT) {
            const int k0 = kb * 64, c = lane & 7;
#pragma unroll
            for (int j = 0; j < 4; ++j) { const int n = (lane >> 3) + 8 * j; const float* s = scr + (8 * c) * 33 + n;
                u32x4 o; o.x = pk2(s[0], s[33]); o.y = pk2(s[66], s[99]); o.z = pk2(s[132], s[165]); o.w = pk2(s[198], s[231]);
                *(u32x4*)(WT + (size_t)(nb * 32 + n) * D + k0 + 8 * c) = o; }
        }
        __syncthreads();
    }
    const size_t gtid = (size_t)blockIdx.x * NTHR + tid, gsz = (size_t)gridDim.x * NTHR;
    {
        const size_t n8 = (size_t)16384 * D / 8;
        for (size_t i = gtid; i < 2 * n8; i += gsz) {
            const int w = i >= n8; const size_t j = w ? i - n8 : i;
            const float* src = p.in[w ? I_PV : I_PU] + j * 8; unsigned char* dst = ws + (w ? WS_PV : WS_PU) + j * 8;
            const float sc = w ? PEER_SV : PEER_SU;
            const f32x4 a = *(const f32x4*)src * sc, b = *(const f32x4*)(src + 4) * sc;
            int lo = __builtin_amdgcn_cvt_pk_fp8_f32(a.x, a.y, 0, false); lo = __builtin_amdgcn_cvt_pk_fp8_f32(a.z, a.w, lo, true);
            int hi = __builtin_amdgcn_cvt_pk_fp8_f32(b.x, b.y, 0, false); hi = __builtin_amdgcn_cvt_pk_fp8_f32(b.z, b.w, hi, true);
            *(u32x2*)dst = (u32x2){(unsigned)lo, (unsigned)hi};
        }
        for (size_t i = gtid; i < 2 * 16384; i += gsz) {
            const int w = i >= 16384; const size_t j = w ? i - 16384 : i;
            ((bf16_t*)(ws + WS_K12))[i] = f2bf(p.in[w ? I_PK2 : I_PK1][j]);
        }
    }
    for (size_t i = gtid; i < (size_t)16384 * 32; i += gsz) {
        const int t = (int)(i >> 5), k = (int)(i & 31);
        const float inv = powf(10000.0f, -(float)(2 * k) / 64.0f);
        const float ang = (float)t * inv;
        double sn, cs; sincos((double)ang, &sn, &cs);
        float* R = (float*)(ws + WS_ROPE) + (size_t)t * 64;
        R[k] = (float)cs; R[32 + k] = (float)sn;
    }
    for (int row = blockIdx.x * 8 + wid; row < 2560; row += gridDim.x * 8) {
        const float* src = row < 512 ? p.in[I_MP] + (size_t)row * D : p.in[I_MS] + (size_t)(row - 512) * D;
        const f32x4* xr = (const f32x4*)src + lane; const f32x4* gr = (const f32x4*)p.in[I_MGN] + lane;
        f32x4 v[4]; float s = 0.f;
#pragma unroll
        for (int j = 0; j < 4; ++j) { v[j] = xr[64 * j]; s += v[j].x * v[j].x + v[j].y * v[j].y + v[j].z * v[j].z + v[j].w * v[j].w; }
        const float r = rsqrtf(wave_sum(s) * (1.f / D) + RMS_EPS);
        u32x2* o = (u32x2*)((bf16_t*)(ws + WS_HM) + (size_t)row * D) + lane;
#pragma unroll
        for (int j = 0; j < 4; ++j) { const f32x4 g = gr[64 * j]; u32x2 w; w.x = pk2(v[j].x * r * g.x, v[j].y * r * g.y); w.y = pk2(v[j].z * r * g.z, v[j].w * r * g.w); o[64 * j] = w; }
    }
}

__device__ __forceinline__ void phase_p0b(const Params& p, char* lds) {
    const int tid_ = otid(), lane = tid_ & 63, wid = tid_ >> 6, wm = wid >> 2, wn = wid & 3, fr = lane & 15, fq = lane >> 4;
    const bf16_t* A = (const bf16_t*)(p.ws + WS_HM); const bf16_t* Bt = (const bf16_t*)(p.ws + WS_WKVT);
    float* C = (float*)(p.ws + WS_KVR);
    const int nM = 20, nN = 8;
    for (int t = blockIdx.x; t < nM * nN; t += gridDim.x) {
        const int pm = t % nM, pn = t / nM, m0 = pm * 128, n0 = pn * 256;
        f32x4 acc[4][4];
#pragma unroll
        for (int i = 0; i < 4; ++i)
#pragma unroll
            for (int j = 0; j < 4; ++j) acc[i][j] = (f32x4){0.f, 0.f, 0.f, 0.f};
        gemm_kloop<true, 4>(acc, A + (size_t)m0 * D, D, Bt + (size_t)n0 * D, D, D, lds);
#pragma unroll
        for (int mt = 0; mt < 4; ++mt)
#pragma unroll
            for (int nt = 0; nt < 4; ++nt) {
                const int row = m0 + wm * 64 + mt * 16 + fr, col = n0 + wn * 64 + nt * 16 + fq * 4;
                *(f32x4*)(C + (size_t)row * 2048 + col) = acc[mt][nt];
            }
    }
}

__device__ __forceinline__ void phase_p0c(const Params& p) {
    const int tid_ = otid(), lane = tid_ & 63, wid = tid_ >> 6;
    const float* KV = (const float*)(p.ws + WS_KVR);
    bf16_t* MK = (bf16_t*)(p.ws + WS_MEMK); bf16_t* MV = (bf16_t*)(p.ws + WS_MEMV);
    for (int it = blockIdx.x * 8 + wid; it < 2560 * 4; it += gridDim.x * 8) {
        const int row = it >> 2, h = it & 3, b = row >> 8, m = row & 255;
        const f32x4 kv = *(const f32x4*)(KV + (size_t)row * 2048 + h * 256 + lane * 4);
        const float ss = wave_sum(kv.x * kv.x + kv.y * kv.y + kv.z * kv.z + kv.w * kv.w);
        const float r = rsqrtf(ss * (1.f / 256.f) + RMS_EPS);
        const f32x4 g = *(const f32x4*)(p.in[I_MGK] + lane * 4);
        u32x2 w; w.x = pk2(kv.x * r * g.x, kv.y * r * g.y); w.y = pk2(kv.z * r * g.z, kv.w * r * g.w);
        *(u32x2*)(MK + ((size_t)(b * 4 + h) * 256 + m) * 256 + lane * 4) = w;
        const f32x4 vv = *(const f32x4*)(KV + (size_t)row * 2048 + 1024 + h * 256 + lane * 4);
        const int pos = (m & ~31) + ((m >> 2) & 3) * 8 + ((m >> 4) & 1) * 4 + (m & 3);
        bf16_t* dst = MV + ((size_t)(b * 4 + h) * 256 + lane * 4) * 256 + pos;
        dst[0] = f2bf(vv.x); dst[256] = f2bf(vv.y); dst[512] = f2bf(vv.z); dst[768] = f2bf(vv.w);
    }
}

__device__ __forceinline__ void phase_rmsnorm(const float* X, const float* gain, bf16_t* O, int row0, int nrows) {
    const int tid_ = otid(), lane = tid_ & 63, wid = tid_ >> 6;
    const f32x4* gr = (const f32x4*)launder(gain) + lane;
    f32x4 g[4];
#pragma unroll
    for (int j = 0; j < 4; ++j) g[j] = gr[64 * j];
    f32x4 vn[4];
    { const f32x4* xr = (const f32x4*)(X + (size_t)(row0 + wid) * D) + lane;
#pragma unroll
      for (int j = 0; j < 4; ++j) vn[j] = xr[64 * j]; }
    for (int row = row0 + wid; row < row0 + nrows; row += 8) {
        f32x4 v[4]; float s = 0.f;
#pragma unroll
        for (int j = 0; j < 4; ++j) v[j] = vn[j];
        if (row + 8 < row0 + nrows) { const f32x4* xr = (const f32x4*)(X + (size_t)(row + 8) * D) + lane;
#pragma unroll
            for (int j = 0; j < 4; ++j) vn[j] = xr[64 * j]; }
        __builtin_amdgcn_sched_barrier(0);
#pragma unroll
        for (int j = 0; j < 4; ++j) s += v[j].x * v[j].x + v[j].y * v[j].y + v[j].z * v[j].z + v[j].w * v[j].w;
        const float r = rsqrtf(wave_sum(s) * (1.f / D) + RMS_EPS);
        u32x2* o = (u32x2*)(O + (size_t)row * D) + lane;
#pragma unroll
        for (int j = 0; j < 4; ++j) { u32x2 w; w.x = pk2(v[j].x * r * g[j].x, v[j].y * r * g[j].y); w.y = pk2(v[j].z * r * g[j].z, v[j].w * r * g[j].w); o[64 * j] = w; }
    }
}

__device__ __forceinline__ void phase_inproj(const Params& p, int g, char* lds, int u) {
    const Grp G = get_group(p, g);
    const int tid_ = otid(), lane = tid_ & 63, wid = tid_ >> 6, wm = wid >> 2, wn = wid & 3, fr = lane & 15, fq = lane >> 4;
    const bf16_t* A = (const bf16_t*)(p.ws + WS_HB); const bf16_t* Bt = (const bf16_t*)(p.ws + WS_WINT);
    bf16_t* P = (bf16_t*)(p.ws + WS_PROJ); bf16_t* VT = (bf16_t*)(p.ws + WS_VT);
    const int pm = u >> 1, half = u & 1, m0 = pm * 256;
    for (int pi = 0; pi < (half ? 17 : 12); ++pi) {
        const int pn = half ? 24 + pi : pi; const int n0 = pn * 256;
        f32x4 acc[8][4];
#pragma unroll
        for (int i = 0; i < 8; ++i)
#pragma unroll
            for (int j = 0; j < 4; ++j) acc[i][j] = (f32x4){0.f, 0.f, 0.f, 0.f};
        gemm_kloop<true, 8>(acc, A + (size_t)m0 * D, D, Bt + (size_t)n0 * D, D, D, lds);
        const float sc = n0 < 512 ? 0.08838834764831845f : 1.0f;
#pragma unroll
        for (int mt = 0; mt < 8; ++mt)
#pragma unroll
            for (int nt = 0; nt < 4; ++nt) {
                const int row = m0 + wm * 128 + mt * 16 + fr, col = n0 + wn * 64 + nt * 16 + fq * 4;
                u32x2 w; w.x = pk2(acc[mt][nt].x * sc, acc[mt][nt].y * sc); w.y = pk2(acc[mt][nt].z * sc, acc[mt][nt].w * sc);
                *(u32x2*)(P + (size_t)row * NP + col) = w;
            }
    }
    if (half == 0) for (int pn = 12; pn < 20; ++pn) {
        const int n0 = pn * 256;
        f32x4 acc[8][4];
#pragma unroll
        for (int i = 0; i < 8; ++i)
#pragma unroll
            for (int j = 0; j < 4; ++j) acc[i][j] = (f32x4){0.f, 0.f, 0.f, 0.f};
        gemm_kloop<true, 8>(acc, A + (size_t)m0 * D, D, Bt + (size_t)n0 * D, D, D, lds);
        const int te_ = otid(), fr = te_ & 15, fq = (te_ >> 4) & 3, wm = te_ >> 8, wn = (te_ >> 6) & 3;
        const bool isk = n0 >= C_DK;
        const float* gn = launder(p.in[isk ? I_DGK : I_DGQ]) + fq * 4;
        const float qs = isk ? 1.0f : 0.125f * LOG2E;
        const float* ROPE = (const float*)(p.ws + WS_ROPE);
        const int tq0 = m0 % G.T + wm * 128 + fr;
#pragma unroll
        for (int mt = 0; mt < 8; ++mt) {
            const int row = m0 + wm * 128 + mt * 16 + fr, t = tq0 + mt * 16;
            float ss = 0.f;
#pragma unroll
            for (int nt = 0; nt < 4; ++nt) ss += acc[mt][nt].x * acc[mt][nt].x + acc[mt][nt].y * acc[mt][nt].y + acc[mt][nt].z * acc[mt][nt].z + acc[mt][nt].w * acc[mt][nt].w;
            ss += sxor<16>(ss); ss += sxor<32>(ss);
            const float r = rsqrtf(ss * (1.f / 64.f) + RMS_EPS) * qs;
            const float* rp = ROPE + (size_t)t * 64 + fq * 4;
            bf16_t* dst = P + (size_t)row * NP + n0 + wn * 64 + fq * 4;
#pragma unroll
            for (int hh = 0; hh < 2; ++hh) {
                const f32x4 cs = *(const f32x4*)(rp + hh * 16), sn = *(const f32x4*)(rp + 32 + hh * 16);
                const f32x4 ya = acc[mt][hh] * *(const f32x4*)(gn + hh * 16) * r, yb = acc[mt][hh + 2] * *(const f32x4*)(gn + 32 + hh * 16) * r;
                const f32x4 oa = ya * cs - yb * sn, ob = yb * cs + ya * sn;
                *(u32x2*)(dst + hh * 16) = (u32x2){pk2(oa.x, oa.y), pk2(oa.z, oa.w)};
                *(u32x2*)(dst + 32 + hh * 16) = (u32x2){pk2(ob.x, ob.y), pk2(ob.z, ob.w)};
            }
        }
    }
    for (int pn = half ? 21 : 20; pn < (half ? 24 : 21); ++pn) {
        const int n0 = pn * 256;
        f32x4 acc[8][4];
#pragma unroll
        for (int i = 0; i < 8; ++i)
#pragma unroll
            for (int j = 0; j < 4; ++j) acc[i][j] = (f32x4){0.f, 0.f, 0.f, 0.f};
        gemm_kloop<false, 8>(acc, A + (size_t)m0 * D, D, Bt + (size_t)n0 * D, D, D, lds);
        const int b = m0 / G.T, t0 = m0 % G.T + wm * 128;
#pragma unroll
        for (int mt = 0; mt < 8; ++mt)
#pragma unroll
            for (int nt = 0; nt < 4; ++nt) {
                const int n = n0 - C_DV + wn * 64 + nt * 16 + fr, h = n >> 7, dv = n & 127;
                const int pos = t0 + (mt >> 1) * 32 + fq * 8 + (mt & 1) * 4;
                u32x2 w; w.x = pk2(acc[mt][nt].x, acc[mt][nt].y); w.y = pk2(acc[mt][nt].z, acc[mt][nt].w);
                *(u32x2*)(VT + ((size_t)((b * 8 + h) * 128 + dv)) * G.T + pos) = w;
            }
    }
}

__device__ __forceinline__ void phase_qkrope(const Params& p, int g, int tok0, int ntok) {
    const Grp G = get_group(p, g);
    const int tid_ = otid(), lane = tid_ & 63, wid = tid_ >> 6, grp = lane >> 2, sub = lane & 3;
    bf16_t* P = (bf16_t*)(p.ws + WS_PROJ); const float* ROPE = (const float*)(p.ws + WS_ROPE);
    for (int it = tok0 * 2 + wid; it < (tok0 + ntok) * 2; it += 8) {
        const int tok = it >> 1, isk = it & 1, t = tok % G.T;
        bf16_t* base = P + (size_t)tok * NP + (isk ? C_DK : C_DQ) + grp * 64 + sub * 8;
        const u32x4 a = *(const u32x4*)base, b = *(const u32x4*)(base + 32);
        float x1[8], x2[8];
        x1[0] = bflo(a.x); x1[1] = bfhi(a.x); x1[2] = bflo(a.y); x1[3] = bfhi(a.y); x1[4] = bflo(a.z); x1[5] = bfhi(a.z); x1[6] = bflo(a.w); x1[7] = bfhi(a.w);
        x2[0] = bflo(b.x); x2[1] = bfhi(b.x); x2[2] = bflo(b.y); x2[3] = bfhi(b.y); x2[4] = bflo(b.z); x2[5] = bfhi(b.z); x2[6] = bflo(b.w); x2[7] = bfhi(b.w);
        float ss = 0.f;
#pragma unroll
        for (int e = 0; e < 8; ++e) ss += x1[e] * x1[e] + x2[e] * x2[e];
        ss += sxor<1>(ss); ss += sxor<2>(ss);
        const float r = rsqrtf(ss * (1.f / 64.f) + RMS_EPS) * (isk ? 1.0f : 0.125f * LOG2E);
        const float* gn = p.in[isk ? I_DGK : I_DGQ] + sub * 8;
        const float* rp = ROPE + (size_t)t * 64 + sub * 8;
        float o1[8], o2[8];
#pragma unroll
        for (int e = 0; e < 8; ++e) {
            const float y1 = x1[e] * r * gn[e], y2 = x2[e] * r * gn[32 + e], c = rp[e], s = rp[32 + e];
            o1[e] = y1 * c - y2 * s; o2[e] = y2 * c + y1 * s;
        }
        u32x4 w1, w2;
        w1.x = pk2(o1[0], o1[1]); w1.y = pk2(o1[2], o1[3]); w1.z = pk2(o1[4], o1[5]); w1.w = pk2(o1[6], o1[7]);
        w2.x = pk2(o2[0], o2[1]); w2.y = pk2(o2[2], o2[3]); w2.z = pk2(o2[4], o2[5]); w2.w = pk2(o2[6], o2[7]);
        *(u32x4*)base = w1; *(u32x4*)(base + 32) = w2;
    }
}

__device__ __forceinline__ void diff_attn_item(const Params& p, const Grp& G, int item, char* lds, float lam, float shift) {
    const int tid = otid(), lane = tid & 63, wid = tid >> 6, fr = lane & 15, fq = lane >> 4;
    const int c = wid & 1, sub = wid >> 1;
    const int T = G.T, nqb = T / 128;
    const int qb = item % nqb, bh = item / nqb, h = bh & 7, b = bh >> 3;
    bf16_t* P = (bf16_t*)(p.ws + WS_PROJ) + (size_t)b * T * NP;
    const bf16_t* Kg = P + C_DK + h * 128;
    const bf16_t* VTg = (const bf16_t*)(p.ws + WS_VT) + (size_t)bh * 128 * T;
    const int q0 = qb * 128 + sub * 32;
    bf16x8 qf[2][2];
#pragma unroll
    for (int nt = 0; nt < 2; ++nt)
#pragma unroll
        for (int ks = 0; ks < 2; ++ks) qf[nt][ks] = *(const bf16x8*)(P + (size_t)(q0 + nt * 16 + fr) * NP + C_DQ + h * 128 + c * 64 + ks * 32 + fq * 8);
    f32x4 o[8][2];
#pragma unroll
    for (int i = 0; i < 8; ++i) { o[i][0] = (f32x4){0.f, 0.f, 0.f, 0.f}; o[i][1] = (f32x4){0.f, 0.f, 0.f, 0.f}; }
    float l[2] = {0.f, 0.f};
    constexpr int STG = 36864, VOFF = 18432;
    u32x4 rk[2], rv[2];
    const int krow = tid >> 4, kch = tid & 15;
    const int vrow = tid >> 3, vch = tid & 7;
#define AGLOAD(kt) do { const int key0_ = (kt) * 64; \
        _Pragma("unroll") for (int i = 0; i < 2; ++i) rk[i] = *(const u32x4*)(Kg + (size_t)(key0_ + krow + i * 32) * NP + kch * 8); \
        _Pragma("unroll") for (int i = 0; i < 2; ++i) rv[i] = *(const u32x4*)(VTg + (size_t)(vrow + i * 64) * T + key0_ + vch * 8); } while (0)
#define ASWRITE(buf) do { char* b_ = lds + (buf) * STG; \
        _Pragma("unroll") for (int i = 0; i < 2; ++i) *(u32x4*)(b_ + ((kch >> 3) * 64 + krow + i * 32) * 144 + (kch & 7) * 16) = rk[i]; \
        _Pragma("unroll") for (int i = 0; i < 2; ++i) *(u32x4*)(b_ + VOFF + (vrow + i * 64) * 144 + vch * 16) = rv[i]; } while (0)
    const int nkt = T / 64;
#define EXPQ(SRC, NT, DSTP) do { const f32x4 a_ = SRC[0][NT], b_ = SRC[1][NT]; \
        const float p0 = fexp2(a_.x), p1 = fexp2(a_.y), p2 = fexp2(a_.z), p3 = fexp2(a_.w); \
        const float p4 = fexp2(b_.x), p5 = fexp2(b_.y), p6 = fexp2(b_.z), p7 = fexp2(b_.w); \
        l[NT] += ((p0 + p1) + (p2 + p3)) + ((p4 + p5) + (p6 + p7)); \
        u32x4 w_; w_.x = pk2(p0, p1); w_.y = pk2(p2, p3); w_.z = pk2(p4, p5); w_.w = pk2(p6, p7); \
        DSTP[NT] = __builtin_bit_cast(bf16x8, w_); } while (0)
#define SMMA1(DST, I, MT, KBASE) do { \
        const bf16x8 k0_ = *(const bf16x8*)((KBASE) + (c * 64 + (MT) * 16 + fr) * 144 + fq * 16); \
        const bf16x8 k1_ = *(const bf16x8*)((KBASE) + (c * 64 + (MT) * 16 + fr) * 144 + 64 + fq * 16); \
        DST[I][0] = mfma16(k0_, qf[0][0], (f32x4){0.f, 0.f, 0.f, 0.f}); DST[I][1] = mfma16(k0_, qf[1][0], (f32x4){0.f, 0.f, 0.f, 0.f}); \
        DST[I][0] = mfma16(k1_, qf[0][1], DST[I][0]); DST[I][1] = mfma16(k1_, qf[1][1], DST[I][1]); } while (0)
#define PVMMA(DVT, KK, PF, VBASE) do { \
        const bf16x8 vf_ = *(const bf16x8*)((VBASE) + VOFF + ((DVT) * 16 + fr) * 144 + (KK) * 64 + fq * 16); \
        o[DVT][0] = mfma16(vf_, PF[0], o[DVT][0]); o[DVT][1] = mfma16(vf_, PF[1], o[DVT][1]); } while (0)
#define PV8(KK, PF, VBASE) do { PVMMA(0, KK, PF, VBASE); PVMMA(1, KK, PF, VBASE); PVMMA(2, KK, PF, VBASE); PVMMA(3, KK, PF, VBASE); \
        PVMMA(4, KK, PF, VBASE); PVMMA(5, KK, PF, VBASE); PVMMA(6, KK, PF, VBASE); PVMMA(7, KK, PF, VBASE); } while (0)
    f32x4 slo[2][2], shi[2][2];
    bf16x8 pflo[2], pfhi[2];
    pfhi[0] = (bf16x8){0, 0, 0, 0, 0, 0, 0, 0}; pfhi[1] = pfhi[0];
#define KLOAD(KR, MTA, MTB, KBASE) do { \
        KR[0] = *(const bf16x8*)((KBASE) + (c * 64 + (MTA) * 16 + fr) * 144 + fq * 16); KR[1] = *(const bf16x8*)((KBASE) + (c * 64 + (MTA) * 16 + fr) * 144 + 64 + fq * 16); \
        KR[2] = *(const bf16x8*)((KBASE) + (c * 64 + (MTB) * 16 + fr) * 144 + fq * 16); KR[3] = *(const bf16x8*)((KBASE) + (c * 64 + (MTB) * 16 + fr) * 144 + 64 + fq * 16); } while (0)
#define SMMAK(DST, KR) do { \
        DST[0][0] = mfma16(KR[0], qf[0][0], (f32x4){0.f, 0.f, 0.f, 0.f}); DST[0][1] = mfma16(KR[0], qf[1][0], (f32x4){0.f, 0.f, 0.f, 0.f}); \
        DST[1][0] = mfma16(KR[2], qf[0][0], (f32x4){0.f, 0.f, 0.f, 0.f}); DST[1][1] = mfma16(KR[2], qf[1][0], (f32x4){0.f, 0.f, 0.f, 0.f}); \
        DST[0][0] = mfma16(KR[1], qf[0][1], DST[0][0]); DST[0][1] = mfma16(KR[1], qf[1][1], DST[0][1]); \
        DST[1][0] = mfma16(KR[3], qf[0][1], DST[1][0]); DST[1][1] = mfma16(KR[3], qf[1][1], DST[1][1]); } while (0)
#define VLOAD4(VR, D0, KK, VBASE) do { _Pragma("unroll") for (int i_ = 0; i_ < 4; ++i_) VR[i_] = *(const bf16x8*)((VBASE) + VOFF + (((D0) + i_) * 16 + fr) * 144 + (KK) * 64 + fq * 16); } while (0)
#define PV4(VR, D0, PF) do { _Pragma("unroll") for (int i_ = 0; i_ < 4; ++i_) { o[(D0) + i_][0] = mfma16(VR[i_], PF[0], o[(D0) + i_][0]); o[(D0) + i_][1] = mfma16(VR[i_], PF[1], o[(D0) + i_][1]); } } while (0)
#define FENCE() __builtin_amdgcn_sched_barrier(0)
    AGLOAD(0); ASWRITE(0); AGLOAD(1); ASWRITE(1);
    for (int i = tid; i < 18432 / 16; i += NTHR) *(u32x4*)(lds + 3 * STG + VOFF + i * 16) = (u32x4){0u, 0u, 0u, 0u};
    __syncthreads();
    bf16x8 kr[4], va[4], vb[4];
    KLOAD(kr, 0, 1, lds); SMMAK(slo, kr);
    for (int kt = 0; kt < nkt; ++kt) {
        { const int ktl = kt + 2 < nkt ? kt + 2 : nkt - 1; AGLOAD(ktl); }
        const char* cur = lds + (kt & 3) * STG; const char* nxt = lds + ((kt + 1) & 3) * STG; const char* prv = lds + ((kt + 3) & 3) * STG;
        KLOAD(kr, 2, 3, cur); VLOAD4(va, 0, 1, prv);
        FENCE();
        SMMAK(shi, kr); VLOAD4(vb, 4, 1, prv); EXPQ(slo, 0, pflo);
        FENCE();
        PV4(va, 0, pfhi); KLOAD(kr, 0, 1, nxt); EXPQ(slo, 1, pflo);
        FENCE();
        PV4(vb, 4, pfhi); VLOAD4(va, 0, 0, cur);
        FENCE();
        SMMAK(slo, kr); VLOAD4(vb, 4, 0, cur); EXPQ(shi, 0, pfhi);
        FENCE();
        PV4(va, 0, pflo); EXPQ(shi, 1, pfhi);
        FENCE();
        PV4(vb, 4, pflo);
        FENCE();
        ASWRITE((kt + 2) & 3);
        __syncthreads();
    }
    { const char* prv = lds + ((nkt - 1) & 3) * STG; VLOAD4(va, 0, 1, prv); VLOAD4(vb, 4, 1, prv); PV4(va, 0, pfhi); PV4(vb, 4, pfhi); }
    __syncthreads();
#undef KLOAD
#undef SMMAK
#undef VLOAD4
#undef PV4
#undef FENCE
#undef EXPQ
#undef SMMA1
#undef PVMMA
#undef PV8
#undef AGLOAD
#undef ASWRITE
    float inv[2];
#pragma unroll
    for (int nt = 0; nt < 2; ++nt) { float v = l[nt]; v += sxor<16>(v); v += sxor<32>(v); inv[nt] = 1.0f / v; }
    float* xch = (float*)lds + sub * 4096;
    if (c == 1) {
#pragma unroll
        for (int dvt = 0; dvt < 8; ++dvt)
#pragma unroll
            for (int nt = 0; nt < 2; ++nt) {
                xch[(dvt * 16 + fq * 4 + 0) * 32 + nt * 16 + fr] = o[dvt][nt].x * inv[nt];
                xch[(dvt * 16 + fq * 4 + 1) * 32 + nt * 16 + fr] = o[dvt][nt].y * inv[nt];
                xch[(dvt * 16 + fq * 4 + 2) * 32 + nt * 16 + fr] = o[dvt][nt].z * inv[nt];
                xch[(dvt * 16 + fq * 4 + 3) * 32 + nt * 16 + fr] = o[dvt][nt].w * inv[nt];
            }
    }
    __syncthreads();
    if (c == 0) {
        float ss[2] = {0.f, 0.f};
#pragma unroll
        for (int dvt = 0; dvt < 8; ++dvt)
#pragma unroll
            for (int nt = 0; nt < 2; ++nt) {
                f32x4 v = o[dvt][nt] * inv[nt];
                v.x -= lam * xch[(dvt * 16 + fq * 4 + 0) * 32 + nt * 16 + fr];
                v.y -= lam * xch[(dvt * 16 + fq * 4 + 1) * 32 + nt * 16 + fr];
                v.z -= lam * xch[(dvt * 16 + fq * 4 + 2) * 32 + nt * 16 + fr];
                v.w -= lam * xch[(dvt * 16 + fq * 4 + 3) * 32 + nt * 16 + fr];
                o[dvt][nt] = v; ss[nt] += v.x * v.x + v.y * v.y + v.z * v.z + v.w * v.w;
            }
#pragma unroll
        for (int nt = 0; nt < 2; ++nt) {
            float v = ss[nt]; v += sxor<16>(v); v += sxor<32>(v);
            const float r = rsqrtf(v * (1.f / 128.f) + RMS_EPS) * 0.8f;
#pragma unroll
            for (int dvt = 0; dvt < 8; ++dvt) {
                const f32x4 gs = *(const f32x4*)(p.in[I_DGSUB] + dvt * 16 + fq * 4);
                const f32x4 v4 = o[dvt][nt];
                u32x2 w; w.x = pk2(v4.x * r * gs.x, v4.y * r * gs.y); w.y = pk2(v4.z * r * gs.z, v4.w * r * gs.w);
                *(u32x2*)(P + (size_t)(q0 + nt * 16 + fr) * NP + C_DQ + h * 128 + dvt * 16 + fq * 4) = w;
            }
        }
    }
    __syncthreads();
}

__device__ __forceinline__ void mem_attn_item(const Params& p, const Grp& G, int item, char* lds, float shift) {
    const int tid = otid(), lane = tid & 63, wid = tid >> 6, fr = lane & 15, fq = lane >> 4;
    const int T = G.T, nqb = T / 128;
    const int qb = item % nqb, bh = item / nqb, h = bh & 3, b = bh >> 2;
    bf16_t* P = (bf16_t*)(p.ws + WS_PROJ) + (size_t)b * T * NP;
    const bf16_t* MK = (const bf16_t*)(p.ws + WS_MEMK) + (size_t)((G.mb0 + b) * 4 + h) * 256 * 256;
    const bf16_t* MV = (const bf16_t*)(p.ws + WS_MEMV) + (size_t)((G.mb0 + b) * 4 + h) * 256 * 256;
    const int row = qb * 128 + wid * 16 + fr;
    bf16_t* qp = P + (size_t)row * NP + C_MQ + h * 256;
    bf16x8 qf[8];
    {
        float ss = 0.f; u32x4 raw[8];
#pragma unroll
        for (int ks = 0; ks < 8; ++ks) { raw[ks] = *(const u32x4*)(qp + ks * 32 + fq * 8);
            const float a0 = bflo(raw[ks].x), a1 = bfhi(raw[ks].x), a2 = bflo(raw[ks].y), a3 = bfhi(raw[ks].y), a4 = bflo(raw[ks].z), a5 = bfhi(raw[ks].z), a6 = bflo(raw[ks].w), a7 = bfhi(raw[ks].w);
            ss += a0 * a0 + a1 * a1 + a2 * a2 + a3 * a3 + a4 * a4 + a5 * a5 + a6 * a6 + a7 * a7; }
        ss += sxor<16>(ss); ss += sxor<32>(ss);
        const float r = rsqrtf(ss * (1.f / 256.f) + RMS_EPS) * (0.0625f * LOG2E);
#pragma unroll
        for (int ks = 0; ks < 8; ++ks) {
            const f32x4 g0 = *(const f32x4*)(p.in[I_MGQ] + ks * 32 + fq * 8), g1 = *(const f32x4*)(p.in[I_MGQ] + ks * 32 + fq * 8 + 4);
            u32x4 w;
            w.x = pk2(bflo(raw[ks].x) * r * g0.x, bfhi(raw[ks].x) * r * g0.y); w.y = pk2(bflo(raw[ks].y) * r * g0.z, bfhi(raw[ks].y) * r * g0.w);
            w.z = pk2(bflo(raw[ks].z) * r * g1.x, bfhi(raw[ks].z) * r * g1.y); w.w = pk2(bflo(raw[ks].w) * r * g1.z, bfhi(raw[ks].w) * r * g1.w);
            qf[ks] = __builtin_bit_cast(bf16x8, w);
        }
    }
    f32x4 o[16];
#pragma unroll
    for (int i = 0; i < 16; ++i) o[i] = (f32x4){0.f, 0.f, 0.f, 0.f};
    float l = 0.f;
    constexpr int KROW = 528, VOFF = 64 * 528;
    u32x4 mk[4], mv[4];
#define MLOAD(KT) do { _Pragma("unroll") for (int i = 0; i < 4; ++i) { const int idx = tid + i * 512; \
        mk[i] = *(const u32x4*)(MK + (size_t)((KT) * 64 + (idx >> 5)) * 256 + (idx & 31) * 8); mv[i] = *(const u32x4*)(MV + (size_t)(idx >> 3) * 256 + (KT) * 64 + (idx & 7) * 8); } } while (0)
    MLOAD(0);
    for (int kt = 0; kt < 4; ++kt) {
#pragma unroll
        for (int i = 0; i < 4; ++i) {
            const int idx = tid + i * 512;
            *(u32x4*)(lds + (idx >> 5) * KROW + (idx & 31) * 16) = mk[i];
            *(u32x4*)(lds + VOFF + (idx >> 3) * 144 + (idx & 7) * 16) = mv[i];
        }
        __syncthreads();
        if (kt + 1 < 4) MLOAD(kt + 1);
        __builtin_amdgcn_sched_barrier(0);
        f32x4 s[4];
#pragma unroll
        for (int mt = 0; mt < 4; ++mt) s[mt] = (f32x4){0.f, 0.f, 0.f, 0.f};
#pragma unroll
        for (int ks = 0; ks < 8; ks += 2) {
            bf16x8 kf[8];
#pragma unroll
            for (int u = 0; u < 8; ++u) kf[u] = *(const bf16x8*)(lds + ((u & 3) * 16 + fr) * KROW + (ks + (u >> 2)) * 64 + fq * 16);
            __builtin_amdgcn_sched_barrier(0);
#pragma unroll
            for (int u = 0; u < 8; ++u) s[u & 3] = mfma16(kf[u], qf[ks + (u >> 2)], s[u & 3]);
        }
        bf16x8 pf[2];
#pragma unroll
        for (int kk = 0; kk < 2; ++kk) {
            const f32x4 a = s[2 * kk], bb = s[2 * kk + 1];
            const float p0 = fexp2(a.x), p1 = fexp2(a.y), p2 = fexp2(a.z), p3 = fexp2(a.w);
            const float p4 = fexp2(bb.x), p5 = fexp2(bb.y), p6 = fexp2(bb.z), p7 = fexp2(bb.w);
            l += ((p0 + p1) + (p2 + p3)) + ((p4 + p5) + (p6 + p7));
            u32x4 w; w.x = pk2(p0, p1); w.y = pk2(p2, p3); w.z = pk2(p4, p5); w.w = pk2(p6, p7);
            pf[kk] = __builtin_bit_cast(bf16x8, w);
        }
#pragma unroll
        for (int kk = 0; kk < 2; ++kk)
#pragma unroll
            for (int d0 = 0; d0 < 16; d0 += 8) {
                bf16x8 vf[8];
#pragma unroll
                for (int u = 0; u < 8; ++u) vf[u] = *(const bf16x8*)(lds + VOFF + ((d0 + u) * 16 + fr) * 144 + kk * 64 + fq * 16);
                __builtin_amdgcn_sched_barrier(0);
#pragma unroll
                for (int u = 0; u < 8; ++u) o[d0 + u] = mfma16(vf[u], pf[kk], o[d0 + u]);
            }
        __syncthreads();
    }
#undef MLOAD
    l += sxor<16>(l); l += sxor<32>(l);
    const float inv = 1.0f / l;
#pragma unroll
    for (int dvt = 0; dvt < 16; ++dvt) {
        u32x2 w; w.x = pk2(o[dvt].x * inv, o[dvt].y * inv); w.y = pk2(o[dvt].z * inv, o[dvt].w * inv);
        *(u32x2*)(qp + dvt * 16 + fq * 4) = w;
    }
}

constexpr int L_QE = 0, L_KE = 17408, L_KST = 34816, L_VTL = 53248, L_ATT = 71680, L_SB = 80896, L_LRF = 115712, L_TOT = 119808, L_GDEC = 121856;
__device__ __forceinline__ void gla_item(const Params& p, const Grp& G, int item, char* lds) {
    const int tid = otid(), lane = tid & 63, wid = tid >> 6, fr = lane & 15, fq = lane >> 4;
    const int slice = item & 1, dir = (item >> 1) & 1, h = (item >> 2) & 3, b = item >> 4;
    const int T = G.T, N = T / 64;
    const bf16_t* P = (const bf16_t*)(p.ws + WS_PROJ) + (size_t)b * T * NP;
    bf16_t* OUT = dir ? (bf16_t*)(p.ws + WS_PROJ) + (size_t)b * T * NP + C_DV + h * 256 + slice * 128
                      : (bf16_t*)(p.ws + WS_HB) + (size_t)b * T * D + h * 256 + slice * 128;
    const int ldo = dir ? NP : D;
    const int amt = wid & 3, antg = wid >> 2;
    bf16x8 wdB[4]; float bd4[4];
    {
        const float* wd = p.in[dir ? I_WDB : I_WDF]; const float* bdp = p.in[dir ? I_BDB : I_BDF];
#pragma unroll
        for (int q = 0; q < 4; ++q) {
            const int col = h * 128 + (antg * 4 + q) * 16 + fr;
            u32x4 w = (u32x4){0u, 0u, 0u, 0u};
            if (fq < 2) { const float* wp = wd + (size_t)(fq * 8) * 512 + col;
                w.x = pk2(wp[0], wp[512]); w.y = pk2(wp[1024], wp[1536]); w.z = pk2(wp[2048], wp[2560]); w.w = pk2(wp[3072], wp[3584]); }
            wdB[q] = __builtin_bit_cast(bf16x8, w);
            bd4[q] = bdp[col];
        }
    }
    { unsigned z = 0u; asm volatile("" : "+v"(z)); for (int i = tid; i < 34816 / 16; i += NTHR) *(u32x4*)(lds + L_SB + i * 16) = (u32x4){z, z, z, z}; }
    f32x4 S[8];
#pragma unroll
    for (int i = 0; i < 8; ++i) S[i] = (f32x4){0.f, 0.f, 0.f, 0.f};
    u32x4 rq[2], rk[2], rv[2], rl;
    const int lrow = tid >> 4, lch = tid & 15;
#define GGLOAD(n) do { const int cb_ = (dir ? (N - 1 - (n)) : (n)) * 64; \
        _Pragma("unroll") for (int i = 0; i < 2; ++i) { const int li_ = lrow + i * 32, tk_ = cb_ + (dir ? 63 - li_ : li_); const bf16_t* rp_ = P + (size_t)tk_ * NP; \
            rq[i] = *(const u32x4*)(rp_ + C_GQ + h * 128 + lch * 8); rk[i] = *(const u32x4*)(rp_ + C_GK + h * 128 + lch * 8); rv[i] = *(const u32x4*)(rp_ + C_GV + h * 256 + slice * 128 + lch * 8); } \
        if (tid < 128) { const int li_ = tid >> 1, tk_ = cb_ + (dir ? 63 - li_ : li_); rl = *(const u32x4*)(P + (size_t)tk_ * NP + C_LR + dir * 16 + (tid & 1) * 8); } } while (0)
    GGLOAD(0);
    for (int n = 0; n < N; ++n) {
#pragma unroll
        for (int i = 0; i < 2; ++i) {
            const int li = lrow + i * 32;
            *(u32x4*)(lds + L_QE + li * 272 + lch * 16) = rq[i];
            *(u32x4*)(lds + L_KE + li * 272 + lch * 16) = rk[i];
            bf16_t* vt = (bf16_t*)(lds + L_VTL) + (lch * 8) * 72 + li;
            vt[0 * 72] = (bf16_t)(rv[i].x & 0xffff); vt[1 * 72] = (bf16_t)(rv[i].x >> 16); vt[2 * 72] = (bf16_t)(rv[i].y & 0xffff); vt[3 * 72] = (bf16_t)(rv[i].y >> 16);
            vt[4 * 72] = (bf16_t)(rv[i].z & 0xffff); vt[5 * 72] = (bf16_t)(rv[i].z >> 16); vt[6 * 72] = (bf16_t)(rv[i].w & 0xffff); vt[7 * 72] = (bf16_t)(rv[i].w >> 16);
        }
        if (tid < 128) *(u32x4*)(lds + L_LRF + (tid >> 1) * 32 + (tid & 1) * 16) = rl;
        if (n + 1 < N) GGLOAD(n + 1);
        __syncthreads();
        {
            u32x4 araw = (u32x4){0u, 0u, 0u, 0u};
            if (fq < 2) araw = *(const u32x4*)(lds + L_LRF + (amt * 16 + fr) * 32 + fq * 16);
            const bf16x8 afr = __builtin_bit_cast(bf16x8, araw);
            float pb[4][4]; float E[4], tt[4];
#pragma unroll
            for (int q = 0; q < 4; ++q) {
                const f32x4 x4 = mfma16(afr, wdB[q], (f32x4){bd4[q], bd4[q], bd4[q], bd4[q]});
                float run = 0.f;
#pragma unroll
                for (int j = 0; j < 4; ++j) {
                    const float x = x4[j];
                    const float ls = fminf(x, 0.f) - __logf(1.0f + __expf(-fabsf(x)));
                    run += ls * 0.0625f; pb[q][j] = run;
                }
                const float u = sxor<16>(run), v = run + u, w2 = sxor<32>(v);
                E[q] = ((fq & 1) ? u : 0.f) + ((fq & 2) ? w2 : 0.f);
                tt[q] = v + w2;
                if (fq == 0) ((float*)(lds + L_TOT))[amt * 128 + (antg * 4 + q) * 16 + fr] = tt[q];
            }
            __syncthreads();
#pragma unroll
            for (int q = 0; q < 4; ++q) {
                const int col = (antg * 4 + q) * 16 + fr;
                float off = 0.f, blast = 0.f;
#pragma unroll
                for (int r = 0; r < 4; ++r) { const float tv = ((const float*)(lds + L_TOT))[r * 128 + col]; blast += tv; if (r < amt) off += tv; }
                const float gcol = __expf(blast);
                bf16_t* qe = (bf16_t*)(lds + L_QE) + (amt * 16 + fq * 4) * 136 + col; bf16_t* ke = (bf16_t*)(lds + L_KE) + (amt * 16 + fq * 4) * 136 + col;
                float ksv[4];
#pragma unroll
                for (int j = 0; j < 4; ++j) {
                    const float bb = off + E[q] + pb[q][j];
                    const float qv = bf2f(qe[j * 136]), kv = bf2f(ke[j * 136]);
                    const float kd = kv * __expf(-bb);
                    qe[j * 136] = f2bf(qv * __expf(bb)); ke[j * 136] = f2bf(kd);
                    ksv[j] = kd * gcol;
                }
                *(u32x2*)(lds + L_KST + col * 144 + (amt * 16 + fq * 4) * 2) = (u32x2){pk2(ksv[0], ksv[1]), pk2(ksv[2], ksv[3])};
                if (amt == 0 && fq == 0) ((float*)(lds + L_GDEC))[col] = gcol;
            }
        }
        __syncthreads();
        {
            const int ct = wid & 3;
            f32x4 a[2] = {(f32x4){0.f, 0.f, 0.f, 0.f}, (f32x4){0.f, 0.f, 0.f, 0.f}};
            bf16x8 qv[4], kv[2][4];
#pragma unroll
            for (int ks = 0; ks < 4; ++ks) {
                qv[ks] = *(const bf16x8*)(lds + L_QE + (ct * 16 + fr) * 272 + ks * 64 + fq * 16);
#pragma unroll
                for (int j = 0; j < 2; ++j) kv[j][ks] = *(const bf16x8*)(lds + L_KE + (((wid >> 2) * 2 + j) * 16 + fr) * 272 + ks * 64 + fq * 16);
            }
            __builtin_amdgcn_sched_barrier(0);
#pragma unroll
            for (int ks = 0; ks < 4; ++ks)
#pragma unroll
                for (int j = 0; j < 2; ++j) a[j] = mfma16(kv[j][ks], qv[ks], a[j]);
#pragma unroll
            for (int j = 0; j < 2; ++j) {
                const int st = (wid >> 2) * 2 + j, cc = ct * 16 + fr, s0 = st * 16 + fq * 4;
                const float v0 = (s0 + 0 <= cc) ? a[j].x : 0.f, v1 = (s0 + 1 <= cc) ? a[j].y : 0.f, v2 = (s0 + 2 <= cc) ? a[j].z : 0.f, v3 = (s0 + 3 <= cc) ? a[j].w : 0.f;
                *(u32x2*)(lds + L_ATT + cc * 144 + s0 * 2) = (u32x2){pk2(v0, v1), pk2(v2, v3)};
            }
        }
        __syncthreads();
        {
            f32x4 oc[4] = {(f32x4){0.f, 0.f, 0.f, 0.f}, (f32x4){0.f, 0.f, 0.f, 0.f}, (f32x4){0.f, 0.f, 0.f, 0.f}, (f32x4){0.f, 0.f, 0.f, 0.f}};
            bf16x8 fa[2], fb[2][4], ga[2], gb[2][4];
#define LD_VA(FA, FB) do { _Pragma("unroll") for (int ks = 0; ks < 2; ++ks) { FA[ks] = *(const bf16x8*)(lds + L_VTL + (wid * 16 + fr) * 144 + ks * 64 + fq * 16); \
                _Pragma("unroll") for (int ct = 0; ct < 4; ++ct) FB[ks][ct] = *(const bf16x8*)(lds + L_ATT + (ct * 16 + fr) * 144 + ks * 64 + fq * 16); } } while (0)
#define LD_SQ(FA, FB, K0) do { _Pragma("unroll") for (int ks = 0; ks < 2; ++ks) { FA[ks] = *(const bf16x8*)(lds + L_SB + (wid * 16 + fr) * 272 + ((K0) + ks) * 64 + fq * 16); \
                _Pragma("unroll") for (int ct = 0; ct < 4; ++ct) FB[ks][ct] = *(const bf16x8*)(lds + L_QE + (ct * 16 + fr) * 272 + ((K0) + ks) * 64 + fq * 16); } } while (0)
#define MM10(FA, FB) do { _Pragma("unroll") for (int ks = 0; ks < 2; ++ks) _Pragma("unroll") for (int ct = 0; ct < 4; ++ct) oc[ct] = mfma16(FA[ks], FB[ks][ct], oc[ct]); } while (0)
            LD_VA(fa, fb); LD_SQ(ga, gb, 0);
            __builtin_amdgcn_sched_barrier(0);
            MM10(fa, fb); LD_SQ(fa, fb, 2);
            __builtin_amdgcn_sched_barrier(0);
            MM10(ga, gb);
            __builtin_amdgcn_sched_barrier(0);
            MM10(fa, fb);
#undef LD_VA
#undef LD_SQ
#undef MM10
            const int cb = (dir ? (N - 1 - n) : n) * 64;
#pragma unroll
            for (int ct = 0; ct < 4; ++ct) {
                const int cl = ct * 16 + fr, tk = cb + (dir ? 63 - cl : cl);
                *(u32x2*)(OUT + (size_t)tk * ldo + wid * 16 + fq * 4) = (u32x2){pk2(oc[ct].x, oc[ct].y), pk2(oc[ct].z, oc[ct].w)};
            }
        }
        __syncthreads();
        {
            const f32x4 gd = *(const f32x4*)((const float*)(lds + L_GDEC) + wid * 16 + fq * 4);
#pragma unroll
            for (int et = 0; et < 8; ++et) S[et] = S[et] * gd;
            bf16x8 da[2], db[2][8];
#pragma unroll
            for (int ks = 0; ks < 2; ++ks) {
                da[ks] = *(const bf16x8*)(lds + L_KST + (wid * 16 + fr) * 144 + ks * 64 + fq * 16);
#pragma unroll
                for (int et = 0; et < 8; ++et) db[ks][et] = *(const bf16x8*)(lds + L_VTL + (et * 16 + fr) * 144 + ks * 64 + fq * 16);
            }
            __builtin_amdgcn_sched_barrier(0);
#pragma unroll
            for (int ks = 0; ks < 2; ++ks)
#pragma unroll
                for (int et = 0; et < 8; ++et) S[et] = mfma16(da[ks], db[ks][et], S[et]);
#pragma unroll
            for (int et = 0; et < 8; ++et)
                *(u32x2*)(lds + L_SB + (et * 16 + fr) * 272 + (wid * 16 + fq * 4) * 2) = (u32x2){pk2(S[et].x, S[et].y), pk2(S[et].z, S[et].w)};
        }
        __syncthreads();
    }
#undef GGLOAD
}

__device__ __forceinline__ void phase_mixer(const Params& p, int g, char* lds, int* s_item) {
    const Grp G = get_group(p, g);
    const int nGLA = G.B * 16, nATT = G.B * 8 * (G.T / 128), nMEM = G.B * 4 * (G.T / 128);
    unsigned* ctr = (unsigned*)(p.ws + WS_CTRL) + g * 4;
    for (;;) {
        if (threadIdx.x == 0) *s_item = (int)atomicAdd(ctr + 0, 1u);
        __syncthreads();
        const int it = *s_item;
        __syncthreads();
        if (it >= nGLA) break;
        gla_item(p, G, it, lds);
    }
    {
        float d1 = 0.f, d2 = 0.f;
        for (int i = 0; i < 64; ++i) { d1 += p.in[I_LQ1][i] * p.in[I_LK1][i]; d2 += p.in[I_LQ2][i] * p.in[I_LK2][i]; }
        const float lam = expf(d1) - expf(d2) + 0.2f;
        for (;;) {
            if (threadIdx.x == 0) *s_item = (int)atomicAdd(ctr + 1, 1u);
            __syncthreads();
            const int it = *s_item;
            __syncthreads();
            if (it >= nATT) break;
            diff_attn_item(p, G, it, lds, lam, 0.f);
        }
    }
    for (;;) {
        if (threadIdx.x == 0) *s_item = (int)atomicAdd(ctr + 2, 1u);
        __syncthreads();
        const int it = *s_item;
        __syncthreads();
        if (it >= nMEM) break;
        mem_attn_item(p, G, it, lds, 0.f);
    }
}

__device__ __forceinline__ void phase_glafin(const Params& p, int g, int tok0, int ntok) {
    const int tid_ = otid(), lane = tid_ & 63, wid = tid_ >> 6;
    bf16_t* P = (bf16_t*)(p.ws + WS_PROJ); const bf16_t* F = (const bf16_t*)(p.ws + WS_HB);
    unsigned qq, kk; u32x2 f, bk, v, gt;
#define GFLOAD(IT) do { const int tok_ = (IT) >> 2, h_ = (IT) & 3; const bf16_t* row_ = P + (size_t)tok_ * NP; \
        qq = *(const unsigned*)(row_ + C_GQ + h_ * 128 + lane * 2); kk = *(const unsigned*)(row_ + C_GK + h_ * 128 + lane * 2); \
        f = *(const u32x2*)(F + (size_t)tok_ * D + h_ * 256 + lane * 4); bk = *(const u32x2*)(row_ + C_DV + h_ * 256 + lane * 4); \
        v = *(const u32x2*)(row_ + C_GV + h_ * 256 + lane * 4); gt = *(const u32x2*)(row_ + C_GG + h_ * 256 + lane * 4); } while (0)
    const f32x4 go = *(const f32x4*)(launder(p.in[I_GOUT]) + lane * 4);
    GFLOAD(tok0 * 4 + wid);
    for (int it = tok0 * 4 + wid; it < (tok0 + ntok) * 4; it += 8) {
        const int tok = it >> 2, h = it & 3;
        bf16_t* row = P + (size_t)tok * NP;
        const unsigned cq = qq, ck = kk; const u32x2 cf = f, cbk = bk, cv = v, cgt = gt;
        if (it + 8 < (tok0 + ntok) * 4) GFLOAD(it + 8);
        __builtin_amdgcn_sched_barrier(0);
        const float qk = wave_sum(bflo(cq) * bflo(ck) + bfhi(cq) * bfhi(ck));
        float o0 = bflo(cf.x) + bflo(cbk.x) - qk * bflo(cv.x), o1 = bfhi(cf.x) + bfhi(cbk.x) - qk * bfhi(cv.x);
        float o2 = bflo(cf.y) + bflo(cbk.y) - qk * bflo(cv.y), o3 = bfhi(cf.y) + bfhi(cbk.y) - qk * bfhi(cv.y);
        const float r = rsqrtf(wave_sum(o0 * o0 + o1 * o1 + o2 * o2 + o3 * o3) * (1.f / 256.f) + RMS_EPS);
        const float g0 = bflo(cgt.x), g1 = bfhi(cgt.x), g2 = bflo(cgt.y), g3 = bfhi(cgt.y);
        o0 *= r * go.x * g0 / (1.f + __expf(-g0)); o1 *= r * go.y * g1 / (1.f + __expf(-g1));
        o2 *= r * go.z * g2 / (1.f + __expf(-g2)); o3 *= r * go.w * g3 / (1.f + __expf(-g3));
        *(u32x2*)(row + C_GG + h * 256 + lane * 4) = (u32x2){pk2(o0, o1), pk2(o2, o3)};
    }
#undef GFLOAD
}

__device__ __forceinline__ void phase_merge(const Params& p, int g, char* lds, int u) {
    const int tid_ = otid(), lane = tid_ & 63, wid = tid_ >> 6, wm = wid >> 2, wn = wid & 3, fr = lane & 15, fq = lane >> 4;
    const bf16_t* P = (const bf16_t*)(p.ws + WS_PROJ); bf16_t* M = (bf16_t*)(p.ws + WS_VT);
    for (int pn = 0; pn < 4; ++pn) {
        const int m0 = u * 128, n0 = pn * 256;
        f32x4 macc[4][4];
#pragma unroll
        for (int i = 0; i < 4; ++i)
#pragma unroll
            for (int j = 0; j < 4; ++j) macc[i][j] = (f32x4){0.f, 0.f, 0.f, 0.f};
        for (int br = 0; br < 3; ++br) {
            f32x4 acc[4][4];
#pragma unroll
            for (int i = 0; i < 4; ++i)
#pragma unroll
                for (int j = 0; j < 4; ++j) acc[i][j] = (f32x4){0.f, 0.f, 0.f, 0.f};
            const int acol = br == 0 ? C_GG : (br == 1 ? C_DQ : C_MQ);
            gemm_kloop<true, 4>(acc, P + (size_t)m0 * NP + acol, NP, (const bf16_t*)(p.ws + WS_WOT) + (size_t)br * D * D + (size_t)n0 * D, D, D, lds);
#pragma unroll
            for (int mt = 0; mt < 4; ++mt)
#pragma unroll
                for (int nt = 0; nt < 4; ++nt) {
                    const int row = m0 + wm * 64 + mt * 16 + fr, col = n0 + wn * 64 + nt * 16 + fq * 4;
                    const u32x2 gt = *(const u32x2*)(P + (size_t)row * NP + C_BG + br * 1024 + col);
                    f32x4 sg; sg.x = 1.f / (1.f + __expf(-bflo(gt.x))); sg.y = 1.f / (1.f + __expf(-bfhi(gt.x))); sg.z = 1.f / (1.f + __expf(-bflo(gt.y))); sg.w = 1.f / (1.f + __expf(-bfhi(gt.y)));
                    macc[mt][nt] += sg * acc[mt][nt];
                }
        }
#pragma unroll
        for (int mt = 0; mt < 4; ++mt)
#pragma unroll
            for (int nt = 0; nt < 4; ++nt) {
                const int row = m0 + wm * 64 + mt * 16 + fr, col = n0 + wn * 64 + nt * 16 + fq * 4;
                *(u32x2*)(M + (size_t)row * D + col) = (u32x2){pk2(macc[mt][nt].x, macc[mt][nt].y), pk2(macc[mt][nt].z, macc[mt][nt].w)};
            }
    }
}

__device__ __forceinline__ void phase_outproj(const Params& p, int g, char* lds, int u) {
    const Grp G = get_group(p, g);
    const int tid_ = otid(), lane = tid_ & 63, wid = tid_ >> 6, wm = wid >> 2, wn = wid & 3, fr = lane & 15, fq = lane >> 4;
    const bf16_t* M = (const bf16_t*)(p.ws + WS_VT); const bf16_t* W = (const bf16_t*)(p.ws + WS_WOT) + (size_t)3 * D * D;
    for (int pn = 0; pn < 4; ++pn) {
        const int m0 = u * 128, n0 = pn * 256;
        f32x4 acc[4][4];
#pragma unroll
        for (int i = 0; i < 4; ++i)
#pragma unroll
            for (int j = 0; j < 4; ++j) acc[i][j] = (f32x4){0.f, 0.f, 0.f, 0.f};
        gemm_kloop<true, 4>(acc, M + (size_t)m0 * D, D, W + (size_t)n0 * D, D, D, lds);
#pragma unroll
        for (int mt = 0; mt < 4; ++mt)
#pragma unroll
            for (int nt = 0; nt < 4; ++nt) {
                const int row = m0 + wm * 64 + mt * 16 + fr, col = n0 + wn * 64 + nt * 16 + fq * 4;
                const f32x4 xv = *(const f32x4*)(G.x + (size_t)row * D + col);
                *(f32x4*)(G.out + (size_t)row * D + col) = xv + acc[mt][nt];
            }
    }
}

__device__ __forceinline__ void phase_peerq(const Params& p, int g, char* lds, int u) {
    const int tid_ = otid(), lane = tid_ & 63, wid = tid_ >> 6, wm = wid >> 2, wn = wid & 3, fr = lane & 15, fq = lane >> 4;
    const bf16_t* A = (const bf16_t*)(p.ws + WS_HB); const bf16_t* W = (const bf16_t*)(p.ws + WS_WQT); bf16_t* P = (bf16_t*)(p.ws + WS_PROJ);
    for (int pn = 0; pn < 8; ++pn) {
        const int m0 = u * 128, n0 = pn * 256;
        f32x4 acc[4][4];
#pragma unroll
        for (int i = 0; i < 4; ++i)
#pragma unroll
            for (int j = 0; j < 4; ++j) acc[i][j] = (f32x4){0.f, 0.f, 0.f, 0.f};
        gemm_kloop<true, 4>(acc, A + (size_t)m0 * D, D, W + (size_t)n0 * D, D, D, lds);
#pragma unroll
        for (int mt = 0; mt < 4; ++mt)
#pragma unroll
            for (int nt = 0; nt < 4; ++nt) {
                const int row = m0 + wm * 64 + mt * 16 + fr, col = n0 + wn * 64 + nt * 16 + fq * 4;
                *(u32x2*)(P + (size_t)row * NP + col) = (u32x2){pk2(acc[mt][nt].x, acc[mt][nt].y), pk2(acc[mt][nt].z, acc[mt][nt].w)};
            }
    }
}

__device__ __forceinline__ unsigned f2ord(float f) { const unsigned u = __float_as_uint(f); return (u & 0x80000000u) ? ~u : (u | 0x80000000u); }
__device__ __forceinline__ float ord2f(unsigned k) { const unsigned u = (k & 0x80000000u) ? (k & 0x7fffffffu) : ~k; return __uint_as_float(u); }
__device__ __forceinline__ unsigned gmax16(unsigned v) {
    unsigned t;
    t = sxoru<1>(v); v = v > t ? v : t; t = sxoru<2>(v); v = v > t ? v : t; t = sxoru<4>(v); v = v > t ? v : t; t = sxoru<8>(v); v = v > t ? v : t;
    return v;
}
__device__ __forceinline__ float gsum16(float v) { v += sxor<1>(v); v += sxor<2>(v); v += sxor<4>(v); v += sxor<8>(v); return v; }
__device__ __forceinline__ float gelu_exact(float a) { return 0.5f * a * (1.0f + erff(a * 0.70710678118654752f)); }

__device__ __forceinline__ void phase_peer(const Params& p, int g, char* lds, int tile0, int ntile) {
    const Grp G = get_group(p, g);
    const int tid = otid(), lane = tid & 63, wid = tid >> 6, fr = lane & 15, fq = lane >> 4;
    const bf16_t* P = (const bf16_t*)(p.ws + WS_PROJ); const bf16_t* HB = (const bf16_t*)(p.ws + WS_HB);
    const bf16_t* K12 = (const bf16_t*)(p.ws + WS_K12);
    float* SC = (float*)lds;
    int* EIDX = (int*)(lds + 65536);
    float* GATE = (float*)(lds + 65536 + 4096);
    char* KL = lds + 73728;
    for (int i = tid; i < 2 * 128 * 16; i += NTHR) {
        const int r = i >> 4, ch = i & 15;
        *(u32x4*)(KL + r * 272 + ch * 16) = *(const u32x4*)(K12 + (size_t)r * 128 + ch * 8);
    }
    __syncthreads();
    for (int tile = tile0; tile < tile0 + ntile; ++tile) {
        const int tok0 = tile * 8;
        {
            const bf16_t* qtok = P + (size_t)(tok0 + wid) * NP + (fr & 7) * 256;
#pragma unroll
            for (int half = 0; half < 2; ++half) {
                f32x4 acc[8];
#pragma unroll
                for (int i = 0; i < 8; ++i) acc[i] = (f32x4){0.f, 0.f, 0.f, 0.f};
#pragma unroll
                for (int ks = 0; ks < 4; ++ks) {
                    const bf16x8 af = *(const bf16x8*)(qtok + half * 128 + ks * 32 + fq * 8);
#pragma unroll
                    for (int nt = 0; nt < 8; ++nt) { const bf16x8 bfv = *(const bf16x8*)(KL + (half * 128 + nt * 16 + fr) * 272 + ks * 64 + fq * 16); acc[nt] = mfma16(af, bfv, acc[nt]); }
                }
                if (fq < 2) {
#pragma unroll
                    for (int nt = 0; nt < 8; ++nt) {
                        float* dst = SC + (wid * 8 + fq * 4) * 256 + half * 128 + nt * 16 + fr;
                        dst[0] = acc[nt].x; dst[256] = acc[nt].y; dst[512] = acc[nt].z; dst[768] = acc[nt].w;
                    }
                }
            }
        }
        __builtin_amdgcn_wave_barrier();
        {
            const int sl = fr, gb = fq * 16;
            const int row0_ = wid * 8 + fq, row1_ = wid * 8 + 4 + fq;
            float v1[2] = {0.f, 0.f}, v2[2] = {0.f, 0.f}; int i1[2] = {0, 0}, i2[2] = {0, 0};
            {
                unsigned kc[4][8];
#pragma unroll
                for (int c4 = 0; c4 < 4; ++c4)
#pragma unroll
                    for (int i = 0; i < 8; ++i) { const int idx = sl + 16 * i;
                        kc[c4][i] = (f2ord(SC[((c4 & 1) ? row1_ : row0_) * 256 + (c4 >> 1) * 128 + idx]) & ~127u) | (unsigned)(127 - idx); }
                float sv[4] = {0.f, 0.f, 0.f, 0.f}; int si[4] = {0, 0, 0, 0};
                for (int r = 0; r < 16; ++r) {
                    unsigned m[4], t[4];
#pragma unroll
                    for (int c4 = 0; c4 < 4; ++c4) {
                        const unsigned x0 = kc[c4][0] > kc[c4][1] ? kc[c4][0] : kc[c4][1], x1 = kc[c4][2] > kc[c4][3] ? kc[c4][2] : kc[c4][3];
                        const unsigned x2 = kc[c4][4] > kc[c4][5] ? kc[c4][4] : kc[c4][5], x3 = kc[c4][6] > kc[c4][7] ? kc[c4][6] : kc[c4][7];
                        const unsigned y0 = x0 > x1 ? x0 : x1, y1 = x2 > x3 ? x2 : x3; m[c4] = y0 > y1 ? y0 : y1;
                    }
#pragma unroll
                    for (int c4 = 0; c4 < 4; ++c4) t[c4] = sxoru<1>(m[c4]);
#pragma unroll
                    for (int c4 = 0; c4 < 4; ++c4) m[c4] = m[c4] > t[c4] ? m[c4] : t[c4];
#pragma unroll
                    for (int c4 = 0; c4 < 4; ++c4) t[c4] = sxoru<2>(m[c4]);
#pragma unroll
                    for (int c4 = 0; c4 < 4; ++c4) m[c4] = m[c4] > t[c4] ? m[c4] : t[c4];
#pragma unroll
                    for (int c4 = 0; c4 < 4; ++c4) t[c4] = sxoru<4>(m[c4]);
#pragma unroll
                    for (int c4 = 0; c4 < 4; ++c4) m[c4] = m[c4] > t[c4] ? m[c4] : t[c4];
#pragma unroll
                    for (int c4 = 0; c4 < 4; ++c4) t[c4] = sxoru<8>(m[c4]);
#pragma unroll
                    for (int c4 = 0; c4 < 4; ++c4) m[c4] = m[c4] > t[c4] ? m[c4] : t[c4];
#pragma unroll
                    for (int c4 = 0; c4 < 4; ++c4) {
                        if (sl == r) { sv[c4] = ord2f(m[c4] & ~127u); si[c4] = 127 - (int)(m[c4] & 127u); }
#pragma unroll
                        for (int i = 0; i < 8; ++i) kc[c4][i] = kc[c4][i] == m[c4] ? 0u : kc[c4][i];
                    }
                }
                v1[0] = sv[0]; i1[0] = si[0]; v1[1] = sv[1]; i1[1] = si[1]; v2[0] = sv[2]; i2[0] = si[2]; v2[1] = sv[3]; i2[1] = si[3];
            }
            int pa = 0, pb = 0; float tsa = 0.f, tsb = 0.f; int pida = 0, pidb = 0;
            for (int r = 0; r < 16; ++r) {
                const float va = __int_as_float(__builtin_amdgcn_ds_bpermute((gb + (pa & 15)) << 2, __float_as_int(v2[0])));
                const float vb = __int_as_float(__builtin_amdgcn_ds_bpermute((gb + (pb & 15)) << 2, __float_as_int(v2[1])));
                const unsigned keya = pa < 16 ? ((f2ord(v1[0] + va) & ~255u) | (unsigned)(255 - (sl * 16 + pa))) : 0u;
                const unsigned keyb = pb < 16 ? ((f2ord(v1[1] + vb) & ~255u) | (unsigned)(255 - (sl * 16 + pb))) : 0u;
                unsigned ma = keya, mb = keyb, ta, tb;
                ta = sxoru<1>(ma); tb = sxoru<1>(mb); ma = ma > ta ? ma : ta; mb = mb > tb ? mb : tb;
                ta = sxoru<2>(ma); tb = sxoru<2>(mb); ma = ma > ta ? ma : ta; mb = mb > tb ? mb : tb;
                ta = sxoru<4>(ma); tb = sxoru<4>(mb); ma = ma > ta ? ma : ta; mb = mb > tb ? mb : tb;
                ta = sxoru<8>(ma); tb = sxoru<8>(mb); ma = ma > ta ? ma : ta; mb = mb > tb ? mb : tb;
                if (sl == r) { tsa = ord2f(ma & ~255u); pida = 255 - (int)(ma & 255u); tsb = ord2f(mb & ~255u); pidb = 255 - (int)(mb & 255u); }
                if (keya == ma) pa++;
                if (keyb == mb) pb++;
            }
#pragma unroll
            for (int ps = 0; ps < 2; ++ps) {
                const int pid = ps ? pidb : pida; const float ts = ps ? tsb : tsa; const int row = ps ? row1_ : row0_;
                const int e1 = __builtin_amdgcn_ds_bpermute((gb + (pid >> 4)) << 2, i1[ps]), e2 = __builtin_amdgcn_ds_bpermute((gb + (pid & 15)) << 2, i2[ps]);
                float mx = ts;
                mx = fmaxf(mx, sxor<1>(mx)); mx = fmaxf(mx, sxor<2>(mx)); mx = fmaxf(mx, sxor<4>(mx)); mx = fmaxf(mx, sxor<8>(mx));
                const float ex = __expf(ts - mx), sm = gsum16(ex);
                EIDX[row * 16 + sl] = e1 * 128 + e2; GATE[row * 16 + sl] = ex / sm;
            }
        }
        __builtin_amdgcn_wave_barrier();
        {
            const int tok = tok0 + wid;
            const bf16_t* hrow = HB + (size_t)tok * D;
            const int grp = lane >> 4, sl = lane & 15;
            {
                f32x2 hv[32];
#pragma unroll
                for (int c = 0; c < 8; ++c) {
                    const u32x4 hq = *(const u32x4*)(hrow + sl * 64 + c * 8);
                    hv[c * 4 + 0] = (f32x2){bflo(hq.x), bfhi(hq.x)} * (1.0f / PEER_SU); hv[c * 4 + 1] = (f32x2){bflo(hq.y), bfhi(hq.y)} * (1.0f / PEER_SU);
                    hv[c * 4 + 2] = (f32x2){bflo(hq.z), bfhi(hq.z)} * (1.0f / PEER_SU); hv[c * 4 + 3] = (f32x2){bflo(hq.w), bfhi(hq.w)} * (1.0f / PEER_SU);
                }
                const unsigned char* PU8 = p.ws + WS_PU + sl * 64;
#define ULOADG(BUF, IT) do { _Pragma("unroll") for (int i_ = 0; i_ < 2; ++i_) { const int k_ = ((IT) + i_) * 4 + grp; const unsigned char* ur_ = PU8 + (size_t)EIDX[wid * 128 + k_] * D; \
        BUF[i_ * 4 + 0] = *(const u32x4*)ur_; BUF[i_ * 4 + 1] = *(const u32x4*)(ur_ + 16); BUF[i_ * 4 + 2] = *(const u32x4*)(ur_ + 32); BUF[i_ * 4 + 3] = *(const u32x4*)(ur_ + 48); } } while (0)
#define PDOT(uq, base) \
        a2 += __builtin_amdgcn_cvt_pk_f32_fp8((int)uq.x, false) * hv[base + 0]; b2 += __builtin_amdgcn_cvt_pk_f32_fp8((int)uq.x, true) * hv[base + 1]; \
        a2 += __builtin_amdgcn_cvt_pk_f32_fp8((int)uq.y, false) * hv[base + 2]; b2 += __builtin_amdgcn_cvt_pk_f32_fp8((int)uq.y, true) * hv[base + 3]; \
        a2 += __builtin_amdgcn_cvt_pk_f32_fp8((int)uq.z, false) * hv[base + 4]; b2 += __builtin_amdgcn_cvt_pk_f32_fp8((int)uq.z, true) * hv[base + 5]; \
        a2 += __builtin_amdgcn_cvt_pk_f32_fp8((int)uq.w, false) * hv[base + 6]; b2 += __builtin_amdgcn_cvt_pk_f32_fp8((int)uq.w, true) * hv[base + 7];
#define UCOMP(BUF, IT) do { _Pragma("unroll") for (int i_ = 0; i_ < 2; ++i_) { const int k_ = ((IT) + i_) * 4 + grp; \
        f32x2 a2 = (f32x2){0.f, 0.f}, b2 = (f32x2){0.f, 0.f}; \
        PDOT(BUF[i_ * 4 + 0], 0) PDOT(BUF[i_ * 4 + 1], 8) PDOT(BUF[i_ * 4 + 2], 16) PDOT(BUF[i_ * 4 + 3], 24) \
        a2 += b2; const float a_ = gsum16(a2.x + a2.y); GATE[wid * 128 + k_] = GATE[wid * 128 + k_] * gelu_exact(a_); } } while (0)
                u32x4 ubA[8], ubB[8];
                ULOADG(ubA, 0);
                for (int it0 = 0; it0 < 32; it0 += 4) {
                    ULOADG(ubB, it0 + 2);
                    __builtin_amdgcn_sched_barrier(0);
                    UCOMP(ubA, it0);
                    __builtin_amdgcn_sched_barrier(0);
                    if (it0 + 4 < 32) ULOADG(ubA, it0 + 4);
                    __builtin_amdgcn_sched_barrier(0);
                    UCOMP(ubB, it0 + 2);
                    __builtin_amdgcn_sched_barrier(0);
                }
#undef ULOADG
#undef PDOT
#undef UCOMP
            }
            __builtin_amdgcn_wave_barrier();
            f32x2 acc[8];
#pragma unroll
            for (int i = 0; i < 8; ++i) acc[i] = (f32x2){0.f, 0.f};
            const unsigned char* PV8 = p.ws + WS_PV + lane * 16;
#define VLOADG(BUF, K0) do { _Pragma("unroll") for (int i_ = 0; i_ < 8; ++i_) BUF[i_] = *(const u32x4*)(PV8 + (size_t)EIDX[wid * 128 + (K0) + i_] * D); } while (0)
#define VCOMP(BUF, K0) do { _Pragma("unroll") for (int i_ = 0; i_ < 8; ++i_) { const float w_ = GATE[wid * 128 + (K0) + i_]; const f32x2 w2 = (f32x2){w_, w_}; const u32x4 v = BUF[i_]; \
        acc[0] += w2 * __builtin_amdgcn_cvt_pk_f32_fp8((int)v.x, false); acc[1] += w2 * __builtin_amdgcn_cvt_pk_f32_fp8((int)v.x, true); \
        acc[2] += w2 * __builtin_amdgcn_cvt_pk_f32_fp8((int)v.y, false); acc[3] += w2 * __builtin_amdgcn_cvt_pk_f32_fp8((int)v.y, true); \
        acc[4] += w2 * __builtin_amdgcn_cvt_pk_f32_fp8((int)v.z, false); acc[5] += w2 * __builtin_amdgcn_cvt_pk_f32_fp8((int)v.z, true); \
        acc[6] += w2 * __builtin_amdgcn_cvt_pk_f32_fp8((int)v.w, false); acc[7] += w2 * __builtin_amdgcn_cvt_pk_f32_fp8((int)v.w, true); } } while (0)
            {
                u32x4 vbA[8], vbB[8];
                VLOADG(vbA, 0);
                for (int k0 = 0; k0 < 128; k0 += 16) {
                    VLOADG(vbB, k0 + 8);
                    __builtin_amdgcn_sched_barrier(0);
                    VCOMP(vbA, k0);
                    __builtin_amdgcn_sched_barrier(0);
                    if (k0 + 16 < 128) VLOADG(vbA, k0 + 16);
                    __builtin_amdgcn_sched_barrier(0);
                    VCOMP(vbB, k0 + 8);
                    __builtin_amdgcn_sched_barrier(0);
                }
            }
#undef VLOADG
#undef VCOMP
            float* orow = G.out + (size_t)tok * D + lane * 16;
#pragma unroll
            for (int i = 0; i < 4; ++i) {
                f32x4 t = *(f32x4*)(orow + i * 4);
                t.x += acc[2 * i].x * (1.0f / PEER_SV); t.y += acc[2 * i].y * (1.0f / PEER_SV); t.z += acc[2 * i + 1].x * (1.0f / PEER_SV); t.w += acc[2 * i + 1].y * (1.0f / PEER_SV);
                *(f32x4*)(orow + i * 4) = t;
            }
        }
        __builtin_amdgcn_wave_barrier();
    }
}


constexpr int NPH = 3 + NGROUP * 3;
__device__ __forceinline__ void run_phase(const Params& p, int ph, char* lds, int* s_item) {
    const int g = (ph - 3) / 3, s = (ph - 3) % 3;
    const Grp G = get_group(p, g);
    if (s == 0) {
        for (int u = blockIdx.x; u < 256; u += gridDim.x) {
            const int m0 = (u >> 1) * 256;
            phase_rmsnorm(G.x, p.in[I_GMIX], (bf16_t*)(p.ws + WS_HB), m0, 256);
            __syncthreads();
            phase_inproj(p, g, lds, u);
            __syncthreads();
        }
    } else if (s == 1) {
        phase_mixer(p, g, lds, s_item);
    } else {
        for (int u = blockIdx.x; u < 256; u += gridDim.x) {
            const int m0 = u * 128;
            phase_glafin(p, g, m0, 128);
            __syncthreads();
            phase_merge(p, g, lds, u);
            __syncthreads();
            phase_outproj(p, g, lds, u);
            __syncthreads();
            phase_rmsnorm(G.out, p.in[I_GFFN], (bf16_t*)(p.ws + WS_HB), m0, 128);
            __syncthreads();
            phase_peerq(p, g, lds, u);
            __syncthreads();
            phase_peer(p, g, lds, m0 / 8, 16);
            __syncthreads();
        }
    }
}

__global__ void __launch_bounds__(NTHR) mega_kernel(Params p) {
    extern __shared__ __attribute__((aligned(16))) char lds[];
    __shared__ int s_item;
    cg::grid_group grid = cg::this_grid();
    phase_p0a(p, lds); grid.sync();
    phase_p0b(p, lds); grid.sync();
    phase_p0c(p); grid.sync();
    for (int ph = 3; ph < NPH; ++ph) {
        run_phase(p, ph, lds, &s_item);
        if (ph + 1 < NPH) grid.sync();
    }
}

extern "C" void kernel_launch(void* const* d_in, const int* in_sizes, int n_in, void* d_out, int out_size, void* d_ws, size_t ws_size, hipStream_t stream) {
    static int grid_blocks = 0;
    if (grid_blocks == 0) {
        if (n_in != 32 || ws_size < WS_END) { fprintf(stderr, "kernel_launch: unexpected n_in %d or ws_size %zu (< %zu)\n", n_in, ws_size, (size_t)WS_END); grid_blocks = -1; return; }
        int dev = 0, cus = 0, per_cu = 0;
        hipGetDevice(&dev);
        hipDeviceGetAttribute(&cus, hipDeviceAttributeMultiprocessorCount, dev);
        hipFuncSetAttribute((const void*)mega_kernel, hipFuncAttributeMaxDynamicSharedMemorySize, LDS_BYTES);
        hipOccupancyMaxActiveBlocksPerMultiprocessor(&per_cu, (const void*)mega_kernel, NTHR, LDS_BYTES);
        if (per_cu < 1) per_cu = 1;
        grid_blocks = cus * per_cu;
        (void)hipGetLastError();
    }
    if (grid_blocks < 0) return;
    Params p{};
    for (int i = 0; i < 32; ++i) p.in[i] = (const float*)d_in[i];
    p.out = (float*)d_out; p.ws = (unsigned char*)d_ws; p.ph_lo = 0; p.ph_hi = NPH;
    void* args[] = {&p};
    hipError_t e = hipLaunchCooperativeKernel((const void*)mega_kernel, dim3(grid_blocks), dim3(NTHR), args, LDS_BYTES, stream);
    if (e != hipSuccess) fprintf(stderr, "cooperative launch failed: %s (grid %d)\n", hipGetErrorString(e), grid_blocks);
}
```

```cpp
#include <hip/hip_runtime.h>
#include <hip/hip_cooperative_groups.h>
#include <cstdio>
#include <cstdint>
namespace cg = cooperative_groups;

typedef unsigned short bf16_t;
typedef short bf16x8 __attribute__((ext_vector_type(8)));
typedef float f32x4 __attribute__((ext_vector_type(4)));
typedef unsigned u32x4 __attribute__((ext_vector_type(4)));
typedef unsigned u32x2 __attribute__((ext_vector_type(2)));

constexpr int D = 1024;
constexpr int NP = 10496;
constexpr int IN_COLS = 10272;
constexpr int C_GQ = 0, C_GK = 512, C_GV = 1024, C_GG = 2048, C_DQ = 3072, C_DK = 4096, C_DV = 5120, C_MQ = 6144, C_BG = 7168, C_LR = 10240;
constexpr int G_TOK = 32768;
constexpr int NGROUP = 3;
constexpr int NTHR = 512;
constexpr float RMS_EPS = 1e-6f;
constexpr float LOG2E = 1.4426950408889634f;
constexpr int LDS_BYTES = 147456;
constexpr float PEER_SU = 32.0f, PEER_SV = 8.0f;

enum { I_XP = 0, I_XS, I_MP, I_MS, I_GMIX, I_WIN, I_WDF, I_BDF, I_WDB, I_BDB, I_GOUT, I_GWO, I_DGQ, I_DGK, I_LQ1, I_LK1, I_LQ2, I_LK2,
       I_DGSUB, I_DWO, I_MGN, I_MWKV, I_MGQ, I_MGK, I_MWO, I_WOUT, I_GFFN, I_PWQ, I_PK1, I_PK2, I_PU, I_PV };

constexpr size_t al256(size_t x) { return (x + 255) & ~(size_t)255; }
constexpr size_t WS_CTRL = 0;
constexpr size_t WS_PROJ = 4096;
constexpr size_t WS_HB   = WS_PROJ + (size_t)G_TOK * NP * 2;
constexpr size_t WS_VT   = WS_HB + (size_t)G_TOK * D * 2;
constexpr size_t WS_WINT = WS_VT + (size_t)G_TOK * D * 2;
constexpr size_t WS_WOT  = WS_WINT + (size_t)NP * D * 2;
constexpr size_t WS_WKVT = WS_WOT + (size_t)4 * D * D * 2;
constexpr size_t WS_WQT  = WS_WKVT + (size_t)2048 * D * 2;
constexpr size_t WS_PU   = WS_WQT + (size_t)2048 * D * 2;
constexpr size_t WS_PV   = WS_PU + (size_t)16384 * D * 2;
constexpr size_t WS_K12  = WS_PV + (size_t)16384 * D * 2;
constexpr size_t WS_ROPE = WS_K12 + (size_t)2 * 128 * 128 * 2;
constexpr size_t WS_HM   = WS_ROPE + (size_t)16384 * 64 * 4;
constexpr size_t WS_KVR  = WS_HM + (size_t)2560 * D * 2;
constexpr size_t WS_MEMK = WS_KVR + (size_t)2560 * 2048 * 4;
constexpr size_t WS_MEMV = WS_MEMK + (size_t)10 * 4 * 256 * 256 * 2;
constexpr size_t WS_END  = WS_MEMV + (size_t)10 * 4 * 256 * 256 * 2;

struct Params {
    const float* in[32];
    float* out;
    unsigned char* ws;
    int ph_lo, ph_hi;
};

typedef float f32x2 __attribute__((ext_vector_type(2)));
typedef __bf16 bf16x2v __attribute__((ext_vector_type(2)));
__device__ __forceinline__ unsigned pk2(float lo, float hi) { const f32x2 v = {lo, hi}; const bf16x2v b = __builtin_convertvector(v, bf16x2v); return __builtin_bit_cast(unsigned, b); }
__device__ __forceinline__ float bflo(unsigned u) { return __uint_as_float(u << 16); }
__device__ __forceinline__ float bfhi(unsigned u) { return __uint_as_float(u & 0xffff0000u); }
__device__ __forceinline__ float bf2f(bf16_t b) { return __uint_as_float(((unsigned)b) << 16); }
__device__ __forceinline__ bf16_t f2bf(float f) { return (bf16_t)(pk2(f, 0.f) & 0xffffu); }
__device__ __forceinline__ f32x4 mfma16(bf16x8 a, bf16x8 b, f32x4 c) { return __builtin_amdgcn_mfma_f32_16x16x32_bf16(a, b, c, 0, 0, 0); }
__device__ __forceinline__ float fexp2(float x) { return __builtin_amdgcn_exp2f(x); }
template <class T> __device__ __forceinline__ T* launder(T* q) { asm volatile("" : "+s"(q)); return q; }
__device__ __forceinline__ int otid() { int t = threadIdx.x; asm volatile("" : "+v"(t)); return t; }
template <int M> __device__ __forceinline__ float sxor(float v) {
    if (M < 32) return __int_as_float(__builtin_amdgcn_ds_swizzle(__float_as_int(v), (M << 10) | 0x1F));
    const int l = otid() & 63; return __int_as_float(__builtin_amdgcn_ds_bpermute((l ^ 32) << 2, __float_as_int(v)));
}
template <int M> __device__ __forceinline__ unsigned sxoru(unsigned v) { return (unsigned)__builtin_amdgcn_ds_swizzle((int)v, (M << 10) | 0x1F); }
__device__ __forceinline__ float wave_sum(float v) {
    v += sxor<1>(v); v += sxor<2>(v); v += sxor<4>(v); v += sxor<8>(v); v += sxor<16>(v); v += sxor<32>(v);
    return v;
}

struct Grp { const float* x; const float* mem; float* out; int B, T, mb0; };
__device__ __forceinline__ Grp get_group(const Params& p, int g) {
    Grp r;
    if (g == 0) { r.x = p.in[I_XP]; r.out = p.out; r.B = 2; r.T = 16384; r.mb0 = 0; }
    else { r.x = p.in[I_XS] + (size_t)(g - 1) * G_TOK * D; r.out = p.out + (size_t)g * G_TOK * D; r.B = 4; r.T = 8192; r.mb0 = 2 + (g - 1) * 4; }
    r.mem = nullptr;
    return r;
}

constexpr int G_ROW = 144;
constexpr int G_A_BYTES = 128 * G_ROW;
constexpr int G_B_BYTES = 256 * G_ROW;
constexpr int G_STAGE = G_A_BYTES + G_B_BYTES;

template <bool SWAP, int MT>
__device__ __forceinline__ void gemm_kloop(f32x4 (&acc)[MT][4], const bf16_t* __restrict__ A, int lda, const bf16_t* __restrict__ Bt, int ldb, int K, char* lds) {
    constexpr int A_ROWS = MT * 32, A_BYTES = A_ROWS * G_ROW, STAGE = A_BYTES + G_B_BYTES;
    constexpr int NA = A_BYTES / 1024, NI = STAGE / 1024, NPER = (NI + 7) / 8;
    const int tid = otid(), lane = tid & 63, wid = __builtin_amdgcn_readfirstlane(tid >> 6), wm = wid >> 2, wn = wid & 3, fr = lane & 15, fq = lane >> 4;
    unsigned goff[NPER];
#pragma unroll
    for (int i = 0; i < NPER; ++i) {
        const int j = wid + 8 * i;
        const int ci = (j < NA ? j : j - NA) * 64 + lane, row = ci / 9, ch = ci % 9, chc = ch < 8 ? ch : 7;
        goff[i] = (unsigned)(row * (j < NA ? lda : ldb) + chc * 8);
    }
#define GSTAGE(buf, k0) do { _Pragma("unroll") for (int i = 0; i < NPER; ++i) { const int j = wid + 8 * i; if (j < NI) { \
        const bf16_t* src_ = (j < NA ? A : Bt) + goff[i] + (k0); \
        __builtin_amdgcn_global_load_lds((const unsigned*)src_, (unsigned*)(lds + (buf) * STAGE + j * 1024), 16, 0, 0); } } } while (0)
    const int nk = K / 64;
    GSTAGE(0, 0);
    __syncthreads();
    for (int kt = 0; kt < nk; ++kt) {
        if (kt + 1 < nk) GSTAGE((kt + 1) & 1, (kt + 1) * 64);
        const char* base = lds + (kt & 1) * STAGE;
        const char* abase = base + (wm * (MT * 16) + fr) * G_ROW + fq * 16;
        const char* bbase = base + A_BYTES + (wn * 64 + fr) * G_ROW + fq * 16;
        bf16x8 b0[4], b1[4], ar[4];
#pragma unroll
        for (int nt = 0; nt < 4; ++nt) b0[nt] = *(const bf16x8*)(bbase + nt * 16 * G_ROW);
        ar[0] = *(const bf16x8*)(abase); ar[1] = *(const bf16x8*)(abase + 16 * G_ROW); ar[2] = *(const bf16x8*)(abase + 32 * G_ROW);
#pragma unroll
        for (int st = 0; st < 2 * MT; ++st) {
            const int ks = st / MT, mt = st % MT;
            __builtin_amdgcn_sched_barrier(0);
            if (st + 3 < 2 * MT) { const int ks2 = (st + 3) / MT, mt2 = (st + 3) % MT; ar[(st + 3) % 4] = *(const bf16x8*)(abase + mt2 * 16 * G_ROW + ks2 * 64); }
            if (ks == 0 && mt >= MT - 3 && mt < MT - 1) {
#pragma unroll
                for (int q = 0; q < 2; ++q) { const int nt = (mt - (MT - 3)) * 2 + q; b1[nt] = *(const bf16x8*)(bbase + nt * 16 * G_ROW + 64); }
            }
#pragma unroll
            for (int nt = 0; nt < 4; ++nt) {
                const bf16x8 bv = ks == 0 ? b0[nt] : b1[nt];
                acc[mt][nt] = SWAP ? mfma16(bv, ar[st % 4], acc[mt][nt]) : mfma16(ar[st % 4], bv, acc[mt][nt]);
            }
        }
        __builtin_amdgcn_sched_barrier(0);
        __syncthreads();
    }
#undef GSTAGE
}

__device__ __forceinline__ void tile_order(int t, int nM, int nN, int& pm, int& pn) {
    const int per = 8 * nN, grp = t / per, r = t % per;
    pm = grp * 8 + (r & 7); pn = r >> 3;
}

__device__ __forceinline__ void phase_p0a(const Params& p, char* lds) {
    const int tid = otid(), lane = tid & 63, wid = tid >> 6;
    unsigned char* ws = p.ws;
    if (blockIdx.x == 0 && tid < 256) atomicExch((unsigned*)(ws + WS_CTRL) + tid, 0u);
    float* scr = (float*)(lds + wid * 8448);
    constexpr int IT_WIN = 16 * (NP / 32), IT_SQ = 16 * 32, IT_W2 = 16 * 64;
    constexpr int NIT = IT_WIN + 4 * IT_SQ + 2 * IT_W2;
    for (int it0 = blockIdx.x * 8; it0 < NIT; it0 += gridDim.x * 8) {
        int it = it0 + wid;
        const float* W = nullptr; bf16_t* WT = nullptr; int N = 0, nb = 0, kb = 0, srccol = -1;
        if (it < NIT) {
            int r = it;
            if (r < IT_WIN) { W = p.in[I_WIN]; N = IN_COLS; WT = (bf16_t*)(ws + WS_WINT); kb = r / (NP / 32); nb = r % (NP / 32);
                const int n0 = nb * 32; srccol = n0 < 3072 ? n0 : (n0 < 10240 ? n0 + 32 : (n0 == 10240 ? 3072 : -1)); }
            else { r -= IT_WIN;
                if (r < 4 * IT_SQ) { const int w = r / IT_SQ; r %= IT_SQ; const int idx[4] = {I_GWO, I_DWO, I_MWO, I_WOUT};
                    W = p.in[w == 0 ? I_GWO : (w == 1 ? I_DWO : (w == 2 ? I_MWO : I_WOUT))]; (void)idx; N = 1024; WT = (bf16_t*)(ws + WS_WOT) + (size_t)w * D * D; kb = r / 32; nb = r % 32; srccol = nb * 32; }
                else { r -= 4 * IT_SQ; const int w = r / IT_W2; r %= IT_W2; W = p.in[w == 0 ? I_MWKV : I_PWQ]; N = 2048; WT = (bf16_t*)(ws + (w == 0 ? WS_WKVT : WS_WQT)); kb = r / 64; nb = r % 64; srccol = nb * 32; }
            }
            const int k0 = kb * 64;
#pragma unroll 8
            for (int i = 0; i < 32; ++i) { const int kk = 2 * i + (lane >> 5); scr[kk * 33 + (lane & 31)] = srccol >= 0 ? W[(size_t)(k0 + kk) * N + srccol + (lane & 31)] : 0.f; }
        }
        __syncthreads();
        if (it < NIT) {
            const int k0 = kb * 64, c = lane & 7;
#pragma unroll
            for (int j = 0; j < 4; ++j) { const int n = (lane >> 3) + 8 * j; const float* s = scr + (8 * c) * 33 + n;
                u32x4 o; o.x = pk2(s[0], s[33]); o.y = pk2(s[66], s[99]); o.z = pk2(s[132], s[165]); o.w = pk2(s[198], s[231]);
                *(u32x4*)(WT + (size_t)(nb * 32 + n) * D + k0 + 8 * c) = o; }
        }
        __syncthreads();
    }
    const size_t gtid = (size_t)blockIdx.x * NTHR + tid, gsz = (size_t)gridDim.x * NTHR;
    {
        const size_t n8 = (size_t)16384 * D / 8;
        for (size_t i = gtid; i < 2 * n8; i += gsz) {
            const int w = i >= n8; const size_t j = w ? i - n8 : i;
            const float* src = p.in[w ? I_PV : I_PU] + j * 8; unsigned char* dst = ws + (w ? WS_PV : WS_PU) + j * 8;
            const float sc = w ? PEER_SV : PEER_SU;
            const f32x4 a = *(const f32x4*)src * sc, b = *(const f32x4*)(src + 4) * sc;
            int lo = __builtin_amdgcn_cvt_pk_fp8_f32(a.x, a.y, 0, false); lo = __builtin_amdgcn_cvt_pk_fp8_f32(a.z, a.w, lo, true);
            int hi = __builtin_amdgcn_cvt_pk_fp8_f32(b.x, b.y, 0, false); hi = __builtin_amdgcn_cvt_pk_fp8_f32(b.z, b.w, hi, true);
            *(u32x2*)dst = (u32x2){(unsigned)lo, (unsigned)hi};
        }
        for (size_t i = gtid; i < 2 * 16384; i += gsz) {
            const int w = i >= 16384; const size_t j = w ? i - 16384 : i;
            ((bf16_t*)(ws + WS_K12))[i] = f2bf(p.in[w ? I_PK2 : I_PK1][j]);
        }
    }
    for (size_t i = gtid; i < (size_t)16384 * 32; i += gsz) {
        const int t = (int)(i >> 5), k = (int)(i & 31);
        const float inv = powf(10000.0f, -(float)(2 * k) / 64.0f);
        const float ang = (float)t * inv;
        double sn, cs; sincos((double)ang, &sn, &cs);
        float* R = (float*)(ws + WS_ROPE) + (size_t)t * 64;
        R[k] = (float)cs; R[32 + k] = (float)sn;
    }
    for (int row = blockIdx.x * 8 + wid; row < 2560; row += gridDim.x * 8) {
        const float* src = row < 512 ? p.in[I_MP] + (size_t)row * D : p.in[I_MS] + (size_t)(row - 512) * D;
        const f32x4* xr = (const f32x4*)src + lane; const f32x4* gr = (const f32x4*)p.in[I_MGN] + lane;
        f32x4 v[4]; float s = 0.f;
#pragma unroll
        for (int j = 0; j < 4; ++j) { v[j] = xr[64 * j]; s += v[j].x * v[j].x + v[j].y * v[j].y + v[j].z * v[j].z + v[j].w * v[j].w; }
        const float r = rsqrtf(wave_sum(s) * (1.f / D) + RMS_EPS);
        u32x2* o = (u32x2*)((bf16_t*)(ws + WS_HM) + (size_t)row * D) + lane;
#pragma unroll
        for (int j = 0; j < 4; ++j) { const f32x4 g = gr[64 * j]; u32x2 w; w.x = pk2(v[j].x * r * g.x, v[j].y * r * g.y); w.y = pk2(v[j].z * r * g.z, v[j].w * r * g.w); o[64 * j] = w; }
    }
}

__device__ __forceinline__ void phase_p0b(const Params& p, char* lds) {
    const int tid_ = otid(), lane = tid_ & 63, wid = tid_ >> 6, wm = wid >> 2, wn = wid & 3, fr = lane & 15, fq = lane >> 4;
    const bf16_t* A = (const bf16_t*)(p.ws + WS_HM); const bf16_t* Bt = (const bf16_t*)(p.ws + WS_WKVT);
    float* C = (float*)(p.ws + WS_KVR);
    const int nM = 20, nN = 8;
    for (int t = blockIdx.x; t < nM * nN; t += gridDim.x) {
        const int pm = t % nM, pn = t / nM, m0 = pm * 128, n0 = pn * 256;
        f32x4 acc[4][4];
#pragma unroll
        for (int i = 0; i < 4; ++i)
#pragma unroll
            for (int j = 0; j < 4; ++j) acc[i][j] = (f32x4){0.f, 0.f, 0.f, 0.f};
        gemm_kloop<true, 4>(acc, A + (size_t)m0 * D, D, Bt + (size_t)n0 * D, D, D, lds);
#pragma unroll
        for (int mt = 0; mt < 4; ++mt)
#pragma unroll
            for (int nt = 0; nt < 4; ++nt) {
                const int row = m0 + wm * 64 + mt * 16 + fr, col = n0 + wn * 64 + nt * 16 + fq * 4;
                *(f32x4*)(C + (size_t)row * 2048 + col) = acc[mt][nt];
            }
    }
}

__device__ __forceinline__ void phase_p0c(const Params& p) {
    const int tid_ = otid(), lane = tid_ & 63, wid = tid_ >> 6;
    const float* KV = (const float*)(p.ws + WS_KVR);
    bf16_t* MK = (bf16_t*)(p.ws + WS_MEMK); bf16_t* MV = (bf16_t*)(p.ws + WS_MEMV);
    for (int it = blockIdx.x * 8 + wid; it < 2560 * 4; it += gridDim.x * 8) {
        const int row = it >> 2, h = it & 3, b = row >> 8, m = row & 255;
        const f32x4 kv = *(const f32x4*)(KV + (size_t)row * 2048 + h * 256 + lane * 4);
        const float ss = wave_sum(kv.x * kv.x + kv.y * kv.y + kv.z * kv.z + kv.w * kv.w);
        const float r = rsqrtf(ss * (1.f / 256.f) + RMS_EPS);
        const f32x4 g = *(const f32x4*)(p.in[I_MGK] + lane * 4);
        u32x2 w; w.x = pk2(kv.x * r * g.x, kv.y * r * g.y); w.y = pk2(kv.z * r * g.z, kv.w * r * g.w);
        *(u32x2*)(MK + ((size_t)(b * 4 + h) * 256 + m) * 256 + lane * 4) = w;
        const f32x4 vv = *(const f32x4*)(KV + (size_t)row * 2048 + 1024 + h * 256 + lane * 4);
        const int pos = (m & ~31) + ((m >> 2) & 3) * 8 + ((m >> 4) & 1) * 4 + (m & 3);
        bf16_t* dst = MV + ((size_t)(b * 4 + h) * 256 + lane * 4) * 256 + pos;
        dst[0] = f2bf(vv.x); dst[256] = f2bf(vv.y); dst[512] = f2bf(vv.z); dst[768] = f2bf(vv.w);
    }
}

__device__ __forceinline__ void phase_rmsnorm(const float* X, const float* gain, bf16_t* O, int row0, int nrows) {
    const int tid_ = otid(), lane = tid_ & 63, wid = tid_ >> 6;
    const f32x4* gr = (const f32x4*)launder(gain) + lane;
    f32x4 g[4];
#pragma unroll
    for (int j = 0; j < 4; ++j) g[j] = gr[64 * j];
    f32x4 vn[4];
    { const f32x4* xr = (const f32x4*)(X + (size_t)(row0 + wid) * D) + lane;
#pragma unroll
      for (int j = 0; j < 4; ++j) vn[j] = xr[64 * j]; }
    for (int row = row0 + wid; row < row0 + nrows; row += 8) {
        f32x4 v[4]; float s = 0.f;
#pragma unroll
        for (int j = 0; j < 4; ++j) v[j] = vn[j];
        if (row + 8 < row0 + nrows) { const f32x4* xr = (const f32x4*)(X + (size_t)(row + 8) * D) + lane;
#pragma unroll
            for (int j = 0; j < 4; ++j) vn[j] = xr[64 * j]; }
        __builtin_amdgcn_sched_barrier(0);
#pragma unroll
        for (int j = 0; j < 4; ++j) s += v[j].x * v[j].x + v[j].y * v[j].y + v[j].z * v[j].z + v[j].w * v[j].w;
        const float r = rsqrtf(wave_sum(s) * (1.f / D) + RMS_EPS);
        u32x2* o = (u32x2*)(O + (size_t)row * D) + lane;
#pragma unroll
        for (int j = 0; j < 4; ++j) { u32x2 w; w.x = pk2(v[j].x * r * g[j].x, v[j].y * r * g[j].y); w.y = pk2(v[j].z * r * g[j].z, v[j].w * r * g[j].w); o[64 * j] = w; }
    }
}

__device__ __forceinline__ void phase_inproj(const Params& p, int g, char* lds, int u) {
    const Grp G = get_group(p, g);
    const int tid_ = otid(), lane = tid_ & 63, wid = tid_ >> 6, wm = wid >> 2, wn = wid & 3, fr = lane & 15, fq = lane >> 4;
    const bf16_t* A = (const bf16_t*)(p.ws + WS_HB); const bf16_t* Bt = (const bf16_t*)(p.ws + WS_WINT);
    bf16_t* P = (bf16_t*)(p.ws + WS_PROJ); bf16_t* VT = (bf16_t*)(p.ws + WS_VT);
    const int pm = u >> 1, half = u & 1, m0 = pm * 256;
    for (int pi = 0; pi < (half ? 17 : 12); ++pi) {
        const int pn = half ? 24 + pi : pi; const int n0 = pn * 256;
        f32x4 acc[8][4];
#pragma unroll
        for (int i = 0; i < 8; ++i)
#pragma unroll
            for (int j = 0; j < 4; ++j) acc[i][j] = (f32x4){0.f, 0.f, 0.f, 0.f};
        gemm_kloop<true, 8>(acc, A + (size_t)m0 * D, D, Bt + (size_t)n0 * D, D, D, lds);
        const float sc = n0 < 512 ? 0.08838834764831845f : 1.0f;
#pragma unroll
        for (int mt = 0; mt < 8; ++mt)
#pragma unroll
            for (int nt = 0; nt < 4; ++nt) {
                const int row = m0 + wm * 128 + mt * 16 + fr, col = n0 + wn * 64 + nt * 16 + fq * 4;
                u32x2 w; w.x = pk2(acc[mt][nt].x * sc, acc[mt][nt].y * sc); w.y = pk2(acc[mt][nt].z * sc, acc[mt][nt].w * sc);
                *(u32x2*)(P + (size_t)row * NP + col) = w;
            }
    }
    if (half == 0) for (int pn = 12; pn < 20; ++pn) {
        const int n0 = pn * 256;
        f32x4 acc[8][4];
#pragma unroll
        for (int i = 0; i < 8; ++i)
#pragma unroll
            for (int j = 0; j < 4; ++j) acc[i][j] = (f32x4){0.f, 0.f, 0.f, 0.f};
        gemm_kloop<true, 8>(acc, A + (size_t)m0 * D, D, Bt + (size_t)n0 * D, D, D, lds);
        const int te_ = otid(), fr = te_ & 15, fq = (te_ >> 4) & 3, wm = te_ >> 8, wn = (te_ >> 6) & 3;
        const bool isk = n0 >= C_DK;
        const float* gn = launder(p.in[isk ? I_DGK : I_DGQ]) + fq * 4;
        const float qs = isk ? 1.0f : 0.125f * LOG2E;
        const float* ROPE = (const float*)(p.ws + WS_ROPE);
        const int tq0 = m0 % G.T + wm * 128 + fr;
#pragma unroll
        for (int mt = 0; mt < 8; ++mt) {
            const int row = m0 + wm * 128 + mt * 16 + fr, t = tq0 + mt * 16;
            float ss = 0.f;
#pragma unroll
            for (int nt = 0; nt < 4; ++nt) ss += acc[mt][nt].x * acc[mt][nt].x + acc[mt][nt].y * acc[mt][nt].y + acc[mt][nt].z * acc[mt][nt].z + acc[mt][nt].w * acc[mt][nt].w;
            ss += sxor<16>(ss); ss += sxor<32>(ss);
            const float r = rsqrtf(ss * (1.f / 64.f) + RMS_EPS) * qs;
            const float* rp = ROPE + (size_t)t * 64 + fq * 4;
            bf16_t* dst = P + (size_t)row * NP + n0 + wn * 64 + fq * 4;
#pragma unroll
            for (int hh = 0; hh < 2; ++hh) {
                const f32x4 cs = *(const f32x4*)(rp + hh * 16), sn = *(const f32x4*)(rp + 32 + hh * 16);
                const f32x4 ya = acc[mt][hh] * *(const f32x4*)(gn + hh * 16) * r, yb = acc[mt][hh + 2] * *(const f32x4*)(gn + 32 + hh * 16) * r;
                const f32x4 oa = ya * cs - yb * sn, ob = yb * cs + ya * sn;
                *(u32x2*)(dst + hh * 16) = (u32x2){pk2(oa.x, oa.y), pk2(oa.z, oa.w)};
                *(u32x2*)(dst + 32 + hh * 16) = (u32x2){pk2(ob.x, ob.y), pk2(ob.z, ob.w)};
            }
        }
    }
    for (int pn = half ? 21 : 20; pn < (half ? 24 : 21); ++pn) {
        const int n0 = pn * 256;
        f32x4 acc[8][4];
#pragma unroll
        for (int i = 0; i < 8; ++i)
#pragma unroll
            for (int j = 0; j < 4; ++j) acc[i][j] = (f32x4){0.f, 0.f, 0.f, 0.f};
        gemm_kloop<false, 8>(acc, A + (size_t)m0 * D, D, Bt + (size_t)n0 * D, D, D, lds);
        const int b = m0 / G.T, t0 = m0 % G.T + wm * 128;
#pragma unroll
        for (int mt = 0; mt < 8; ++mt)
#pragma unroll
            for (int nt = 0; nt < 4; ++nt) {
                const int n = n0 - C_DV + wn * 64 + nt * 16 + fr, h = n >> 7, dv = n & 127;
                const int pos = t0 + (mt >> 1) * 32 + fq * 8 + (mt & 1) * 4;
                u32x2 w; w.x = pk2(acc[mt][nt].x, acc[mt][nt].y); w.y = pk2(acc[mt][nt].z, acc[mt][nt].w);
                *(u32x2*)(VT + ((size_t)((b * 8 + h) * 128 + dv)) * G.T + pos) = w;
            }
    }
}

__device__ __forceinline__ void phase_qkrope(const Params& p, int g, int tok0, int ntok) {
    const Grp G = get_group(p, g);
    const int tid_ = otid(), lane = tid_ & 63, wid = tid_ >> 6, grp = lane >> 2, sub = lane & 3;
    bf16_t* P = (bf16_t*)(p.ws + WS_PROJ); const float* ROPE = (const float*)(p.ws + WS_ROPE);
    for (int it = tok0 * 2 + wid; it < (tok0 + ntok) * 2; it += 8) {
        const int tok = it >> 1, isk = it & 1, t = tok % G.T;
        bf16_t* base = P + (size_t)tok * NP + (isk ? C_DK : C_DQ) + grp * 64 + sub * 8;
        const u32x4 a = *(const u32x4*)base, b = *(const u32x4*)(base + 32);
        float x1[8], x2[8];
        x1[0] = bflo(a.x); x1[1] = bfhi(a.x); x1[2] = bflo(a.y); x1[3] = bfhi(a.y); x1[4] = bflo(a.z); x1[5] = bfhi(a.z); x1[6] = bflo(a.w); x1[7] = bfhi(a.w);
        x2[0] = bflo(b.x); x2[1] = bfhi(b.x); x2[2] = bflo(b.y); x2[3] = bfhi(b.y); x2[4] = bflo(b.z); x2[5] = bfhi(b.z); x2[6] = bflo(b.w); x2[7] = bfhi(b.w);
        float ss = 0.f;
#pragma unroll
        for (int e = 0; e < 8; ++e) ss += x1[e] * x1[e] + x2[e] * x2[e];
        ss += sxor<1>(ss); ss += sxor<2>(ss);
        const float r = rsqrtf(ss * (1.f / 64.f) + RMS_EPS) * (isk ? 1.0f : 0.125f * LOG2E);
        const float* gn = p.in[isk ? I_DGK : I_DGQ] + sub * 8;
        const float* rp = ROPE + (size_t)t * 64 + sub * 8;
        float o1[8], o2[8];
#pragma unroll
        for (int e = 0; e < 8; ++e) {
            const float y1 = x1[e] * r * gn[e], y2 = x2[e] * r * gn[32 + e], c = rp[e], s = rp[32 + e];
            o1[e] = y1 * c - y2 * s; o2[e] = y2 * c + y1 * s;
        }
        u32x4 w1, w2;
        w1.x = pk2(o1[0], o1[1]); w1.y = pk2(o1[2], o1[3]); w1.z = pk2(o1[4], o1[5]); w1.w = pk2(o1[6], o1[7]);
        w2.x = pk2(o2[0], o2[1]); w2.y = pk2(o2[2], o2[3]); w2.z = pk2(o2[4], o2[5]); w2.w = pk2(o2[6], o2[7]);
        *(u32x4*)base = w1; *(u32x4*)(base + 32) = w2;
    }
}

__device__ __forceinline__ void diff_attn_item(const Params& p, const Grp& G, int item, char* lds, float lam, float shift) {
    const int tid = otid(), lane = tid & 63, wid = tid >> 6, fr = lane & 15, fq = lane >> 4;
    const int c = wid & 1, sub = wid >> 1;
    const int T = G.T, nqb = T / 128;
    const int qb = item % nqb, bh = item / nqb, h = bh & 7, b = bh >> 3;
    bf16_t* P = (bf16_t*)(p.ws + WS_PROJ) + (size_t)b * T * NP;
    const bf16_t* Kg = P + C_DK + h * 128;
    const bf16_t* VTg = (const bf16_t*)(p.ws + WS_VT) + (size_t)bh * 128 * T;
    const int q0 = qb * 128 + sub * 32;
    bf16x8 qf[2][2];
#pragma unroll
    for (int nt = 0; nt < 2; ++nt)
#pragma unroll
        for (int ks = 0; ks < 2; ++ks) qf[nt][ks] = *(const bf16x8*)(P + (size_t)(q0 + nt * 16 + fr) * NP + C_DQ + h * 128 + c * 64 + ks * 32 + fq * 8);
    f32x4 o[8][2];
#pragma unroll
    for (int i = 0; i < 8; ++i) { o[i][0] = (f32x4){0.f, 0.f, 0.f, 0.f}; o[i][1] = (f32x4){0.f, 0.f, 0.f, 0.f}; }
    float l[2] = {0.f, 0.f};
    constexpr int STG = 36864, VOFF = 18432;
    u32x4 rk[2], rv[2];
    const int krow = tid >> 4, kch = tid & 15;
    const int vrow = tid >> 3, vch = tid & 7;
#define AGLOAD(kt) do { const int key0_ = (kt) * 64; \
        _Pragma("unroll") for (int i = 0; i < 2; ++i) rk[i] = *(const u32x4*)(Kg + (size_t)(key0_ + krow + i * 32) * NP + kch * 8); \
        _Pragma("unroll") for (int i = 0; i < 2; ++i) rv[i] = *(const u32x4*)(VTg + (size_t)(vrow + i * 64) * T + key0_ + vch * 8); } while (0)
#define ASWRITE(buf) do { char* b_ = lds + (buf) * STG; \
        _Pragma("unroll") for (int i = 0; i < 2; ++i) *(u32x4*)(b_ + ((kch >> 3) * 64 + krow + i * 32) * 144 + (kch & 7) * 16) = rk[i]; \
        _Pragma("unroll") for (int i = 0; i < 2; ++i) *(u32x4*)(b_ + VOFF + (vrow + i * 64) * 144 + vch * 16) = rv[i]; } while (0)
    const int nkt = T / 64;
#define EXPQ(SRC, NT, DSTP) do { const f32x4 a_ = SRC[0][NT], b_ = SRC[1][NT]; \
        const float p0 = fexp2(a_.x), p1 = fexp2(a_.y), p2 = fexp2(a_.z), p3 = fexp2(a_.w); \
        const float p4 = fexp2(b_.x), p5 = fexp2(b_.y), p6 = fexp2(b_.z), p7 = fexp2(b_.w); \
        l[NT] += ((p0 + p1) + (p2 + p3)) + ((p4 + p5) + (p6 + p7)); \
        u32x4 w_; w_.x = pk2(p0, p1); w_.y = pk2(p2, p3); w_.z = pk2(p4, p5); w_.w = pk2(p6, p7); \
        DSTP[NT] = __builtin_bit_cast(bf16x8, w_); } while (0)
#define SMMA1(DST, I, MT, KBASE) do { \
        const bf16x8 k0_ = *(const bf16x8*)((KBASE) + (c * 64 + (MT) * 16 + fr) * 144 + fq * 16); \
        const bf16x8 k1_ = *(const bf16x8*)((KBASE) + (c * 64 + (MT) * 16 + fr) * 144 + 64 + fq * 16); \
        DST[I][0] = mfma16(k0_, qf[0][0], (f32x4){0.f, 0.f, 0.f, 0.f}); DST[I][1] = mfma16(k0_, qf[1][0], (f32x4){0.f, 0.f, 0.f, 0.f}); \
        DST[I][0] = mfma16(k1_, qf[0][1], DST[I][0]); DST[I][1] = mfma16(k1_, qf[1][1], DST[I][1]); } while (0)
#define PVMMA(DVT, KK, PF, VBASE) do { \
        const bf16x8 vf_ = *(const bf16x8*)((VBASE) + VOFF + ((DVT) * 16 + fr) * 144 + (KK) * 64 + fq * 16); \
        o[DVT][0] = mfma16(vf_, PF[0], o[DVT][0]); o[DVT][1] = mfma16(vf_, PF[1], o[DVT][1]); } while (0)
#define PV8(KK, PF, VBASE) do { PVMMA(0, KK, PF, VBASE); PVMMA(1, KK, PF, VBASE); PVMMA(2, KK, PF, VBASE); PVMMA(3, KK, PF, VBASE); \
        PVMMA(4, KK, PF, VBASE); PVMMA(5, KK, PF, VBASE); PVMMA(6, KK, PF, VBASE); PVMMA(7, KK, PF, VBASE); } while (0)
    f32x4 slo[2][2], shi[2][2];
    bf16x8 pflo[2], pfhi[2];
    pfhi[0] = (bf16x8){0, 0, 0, 0, 0, 0, 0, 0}; pfhi[1] = pfhi[0];
#define KLOAD(KR, MTA, MTB, KBASE) do { \
        KR[0] = *(const bf16x8*)((KBASE) + (c * 64 + (MTA) * 16 + fr) * 144 + fq * 16); KR[1] = *(const bf16x8*)((KBASE) + (c * 64 + (MTA) * 16 + fr) * 144 + 64 + fq * 16); \
        KR[2] = *(const bf16x8*)((KBASE) + (c * 64 + (MTB) * 16 + fr) * 144 + fq * 16); KR[3] = *(const bf16x8*)((KBASE) + (c * 64 + (MTB) * 16 + fr) * 144 + 64 + fq * 16); } while (0)
#define SMMAK(DST, KR) do { \
        DST[0][0] = mfma16(KR[0], qf[0][0], (f32x4){0.f, 0.f, 0.f, 0.f}); DST[0][1] = mfma16(KR[0], qf[1][0], (f32x4){0.f, 0.f, 0.f, 0.f}); \
        DST[1][0] = mfma16(KR[2], qf[0][0], (f32x4){0.f, 0.f, 0.f, 0.f}); DST[1][1] = mfma16(KR[2], qf[1][0], (f32x4){0.f, 0.f, 0.f, 0.f}); \
        DST[0][0] = mfma16(KR[1], qf[0][1], DST[0][0]); DST[0][1] = mfma16(KR[1], qf[1][1], DST[0][1]); \
        DST[1][0] = mfma16(KR[3], qf[0][1], DST[1][0]); DST[1][1] = mfma16(KR[3], qf[1][1], DST[1][1]); } while (0)
#define VLOAD4(VR, D0, KK, VBASE) do { _Pragma("unroll") for (int i_ = 0; i_ < 4; ++i_) VR[i_] = *(const bf16x8*)((VBASE) + VOFF + (((D0) + i_) * 16 + fr) * 144 + (KK) * 64 + fq * 16); } while (0)
#define PV4(VR, D0, PF) do { _Pragma("unroll") for (int i_ = 0; i_ < 4; ++i_) { o[(D0) + i_][0] = mfma16(VR[i_], PF[0], o[(D0) + i_][0]); o[(D0) + i_][1] = mfma16(VR[i_], PF[1], o[(D0) + i_][1]); } } while (0)
#define FENCE() __builtin_amdgcn_sched_barrier(0)
    AGLOAD(0); ASWRITE(0); AGLOAD(1); ASWRITE(1);
    for (int i = tid; i < 18432 / 16; i += NTHR) *(u32x4*)(lds + 3 * STG + VOFF + i * 16) = (u32x4){0u, 0u, 0u, 0u};
    __syncthreads();
    bf16x8 kr[4], va[4], vb[4];
    KLOAD(kr, 0, 1, lds); SMMAK(slo, kr);
    for (int kt = 0; kt < nkt; ++kt) {
        { const int ktl = kt + 2 < nkt ? kt + 2 : nkt - 1; AGLOAD(ktl); }
        const char* cur = lds + (kt & 3) * STG; const char* nxt = lds + ((kt + 1) & 3) * STG; const char* prv = lds + ((kt + 3) & 3) * STG;
        KLOAD(kr, 2, 3, cur); VLOAD4(va, 0, 1, prv);
        FENCE();
        SMMAK(shi, kr); VLOAD4(vb, 4, 1, prv); EXPQ(slo, 0, pflo);
        FENCE();
        PV4(va, 0, pfhi); KLOAD(kr, 0, 1, nxt); EXPQ(slo, 1, pflo);
        FENCE();
        PV4(vb, 4, pfhi); VLOAD4(va, 0, 0, cur);
        FENCE();
        SMMAK(slo, kr); VLOAD4(vb, 4, 0, cur); EXPQ(shi, 0, pfhi);
        FENCE();
        PV4(va, 0, pflo); EXPQ(shi, 1, pfhi);
        FENCE();
        PV4(vb, 4, pflo);
        FENCE();
        ASWRITE((kt + 2) & 3);
        __syncthreads();
    }
    { const char* prv = lds + ((nkt - 1) & 3) * STG; VLOAD4(va, 0, 1, prv); VLOAD4(vb, 4, 1, prv); PV4(va, 0, pfhi); PV4(vb, 4, pfhi); }
    __syncthreads();
#undef KLOAD
#undef SMMAK
#undef VLOAD4
#undef PV4
#undef FENCE
#undef EXPQ
#undef SMMA1
#undef PVMMA
#undef PV8
#undef AGLOAD
#undef ASWRITE
    float inv[2];
#pragma unroll
    for (int nt = 0; nt < 2; ++nt) { float v = l[nt]; v += sxor<16>(v); v += sxor<32>(v); inv[nt] = 1.0f / v; }
    float* xch = (float*)lds + sub * 4096;
    if (c == 1) {
#pragma unroll
        for (int dvt = 0; dvt < 8; ++dvt)
#pragma unroll
            for (int nt = 0; nt < 2; ++nt) {
                xch[(dvt * 16 + fq * 4 + 0) * 32 + nt * 16 + fr] = o[dvt][nt].x * inv[nt];
                xch[(dvt * 16 + fq * 4 + 1) * 32 + nt * 16 + fr] = o[dvt][nt].y * inv[nt];
                xch[(dvt * 16 + fq * 4 + 2) * 32 + nt * 16 + fr] = o[dvt][nt].z * inv[nt];
                xch[(dvt * 16 + fq * 4 + 3) * 32 + nt * 16 + fr] = o[dvt][nt].w * inv[nt];
            }
    }
    __syncthreads();
    if (c == 0) {
        float ss[2] = {0.f, 0.f};
#pragma unroll
        for (int dvt = 0; dvt < 8; ++dvt)
#pragma unroll
            for (int nt = 0; nt < 2; ++nt) {
                f32x4 v = o[dvt][nt] * inv[nt];
                v.x -= lam * xch[(dvt * 16 + fq * 4 + 0) * 32 + nt * 16 + fr];
                v.y -= lam * xch[(dvt * 16 + fq * 4 + 1) * 32 + nt * 16 + fr];
                v.z -= lam * xch[(dvt * 16 + fq * 4 + 2) * 32 + nt * 16 + fr];
                v.w -= lam * xch[(dvt * 16 + fq * 4 + 3) * 32 + nt * 16 + fr];
                o[dvt][nt] = v; ss[nt] += v.x * v.x + v.y * v.y + v.z * v.z + v.w * v.w;
            }
#pragma unroll
        for (int nt = 0; nt < 2; ++nt) {
            float v = ss[nt]; v += sxor<16>(v); v += sxor<32>(v);
            const float r = rsqrtf(v * (1.f / 128.f) + RMS_EPS) * 0.8f;
#pragma unroll
            for (int dvt = 0; dvt < 8; ++dvt) {
                const f32x4 gs = *(const f32x4*)(p.in[I_DGSUB] + dvt * 16 + fq * 4);
                const f32x4 v4 = o[dvt][nt];
                u32x2 w; w.x = pk2(v4.x * r * gs.x, v4.y * r * gs.y); w.y = pk2(v4.z * r * gs.z, v4.w * r * gs.w);
                *(u32x2*)(P + (size_t)(q0 + nt * 16 + fr) * NP + C_DQ + h * 128 + dvt * 16 + fq * 4) = w;
            }
        }
    }
    __syncthreads();
}

__device__ __forceinline__ void mem_attn_item(const Params& p, const Grp& G, int item, char* lds, float shift) {
    const int tid = otid(), lane = tid & 63, wid = tid >> 6, fr = lane & 15, fq = lane >> 4;
    const int T = G.T, nqb = T / 128;
    const int qb = item % nqb, bh = item / nqb, h = bh & 3, b = bh >> 2;
    bf16_t* P = (bf16_t*)(p.ws + WS_PROJ) + (size_t)b * T * NP;
    const bf16_t* MK = (const bf16_t*)(p.ws + WS_MEMK) + (size_t)((G.mb0 + b) * 4 + h) * 256 * 256;
    const bf16_t* MV = (const bf16_t*)(p.ws + WS_MEMV) + (size_t)((G.mb0 + b) * 4 + h) * 256 * 256;
    const int row = qb * 128 + wid * 16 + fr;
    bf16_t* qp = P + (size_t)row * NP + C_MQ + h * 256;
    bf16x8 qf[8];
    {
        float ss = 0.f; u32x4 raw[8];
#pragma unroll
        for (int ks = 0; ks < 8; ++ks) { raw[ks] = *(const u32x4*)(qp + ks * 32 + fq * 8);
            const float a0 = bflo(raw[ks].x), a1 = bfhi(raw[ks].x), a2 = bflo(raw[ks].y), a3 = bfhi(raw[ks].y), a4 = bflo(raw[ks].z), a5 = bfhi(raw[ks].z), a6 = bflo(raw[ks].w), a7 = bfhi(raw[ks].w);
            ss += a0 * a0 + a1 * a1 + a2 * a2 + a3 * a3 + a4 * a4 + a5 * a5 + a6 * a6 + a7 * a7; }
        ss += sxor<16>(ss); ss += sxor<32>(ss);
        const float r = rsqrtf(ss * (1.f / 256.f) + RMS_EPS) * (0.0625f * LOG2E);
#pragma unroll
        for (int ks = 0; ks < 8; ++ks) {
            const f32x4 g0 = *(const f32x4*)(p.in[I_MGQ] + ks * 32 + fq * 8), g1 = *(const f32x4*)(p.in[I_MGQ] + ks * 32 + fq * 8 + 4);
            u32x4 w;
            w.x = pk2(bflo(raw[ks].x) * r * g0.x, bfhi(raw[ks].x) * r * g0.y); w.y = pk2(bflo(raw[ks].y) * r * g0.z, bfhi(raw[ks].y) * r * g0.w);
            w.z = pk2(bflo(raw[ks].z) * r * g1.x, bfhi(raw[ks].z) * r * g1.y); w.w = pk2(bflo(raw[ks].w) * r * g1.z, bfhi(raw[ks].w) * r * g1.w);
            qf[ks] = __builtin_bit_cast(bf16x8, w);
        }
    }
    f32x4 o[16];
#pragma unroll
    for (int i = 0; i < 16; ++i) o[i] = (f32x4){0.f, 0.f, 0.f, 0.f};
    float l = 0.f;
    constexpr int KROW = 528, VOFF = 64 * 528;
    u32x4 mk[4], mv[4];
#define MLOAD(KT) do { _Pragma("unroll") for (int i = 0; i < 4; ++i) { const int idx = tid + i * 512; \
        mk[i] = *(const u32x4*)(MK + (size_t)((KT) * 64 + (idx >> 5)) * 256 + (idx & 31) * 8); mv[i] = *(const u32x4*)(MV + (size_t)(idx >> 3) * 256 + (KT) * 64 + (idx & 7) * 8); } } while (0)
    MLOAD(0);
    for (int kt = 0; kt < 4; ++kt) {
#pragma unroll
        for (int i = 0; i < 4; ++i) {
            const int idx = tid + i * 512;
            *(u32x4*)(lds + (idx >> 5) * KROW + (idx & 31) * 16) = mk[i];
            *(u32x4*)(lds + VOFF + (idx >> 3) * 144 + (idx & 7) * 16) = mv[i];
        }
        __syncthreads();
        if (kt + 1 < 4) MLOAD(kt + 1);
        __builtin_amdgcn_sched_barrier(0);
        f32x4 s[4];
#pragma unroll
        for (int mt = 0; mt < 4; ++mt) s[mt] = (f32x4){0.f, 0.f, 0.f, 0.f};
#pragma unroll
        for (int ks = 0; ks < 8; ks += 2) {
            bf16x8 kf[8];
#pragma unroll
            for (int u = 0; u < 8; ++u) kf[u] = *(const bf16x8*)(lds + ((u & 3) * 16 + fr) * KROW + (ks + (u >> 2)) * 64 + fq * 16);
            __builtin_amdgcn_sched_barrier(0);
#pragma unroll
            for (int u = 0; u < 8; ++u) s[u & 3] = mfma16(kf[u], qf[ks + (u >> 2)], s[u & 3]);
        }
        bf16x8 pf[2];
#pragma unroll
        for (int kk = 0; kk < 2; ++kk) {
            const f32x4 a = s[2 * kk], bb = s[2 * kk + 1];
            const float p0 = fexp2(a.x), p1 = fexp2(a.y), p2 = fexp2(a.z), p3 = fexp2(a.w);
            const float p4 = fexp2(bb.x), p5 = fexp2(bb.y), p6 = fexp2(bb.z), p7 = fexp2(bb.w);
            l += ((p0 + p1) + (p2 + p3)) + ((p4 + p5) + (p6 + p7));
            u32x4 w; w.x = pk2(p0, p1); w.y = pk2(p2, p3); w.z = pk2(p4, p5); w.w = pk2(p6, p7);
            pf[kk] = __builtin_bit_cast(bf16x8, w);
        }
#pragma unroll
        for (int kk = 0; kk < 2; ++kk)
#pragma unroll
            for (int d0 = 0; d0 < 16; d0 += 8) {
                bf16x8 vf[8];
#pragma unroll
                for (int u = 0; u < 8; ++u) vf[u] = *(const bf16x8*)(lds + VOFF + ((d0 + u) * 16 + fr) * 144 + kk * 64 + fq * 16);
                __builtin_amdgcn_sched_barrier(0);
#pragma unroll
                for (int u = 0; u < 8; ++u) o[d0 + u] = mfma16(vf[u], pf[kk], o[d0 + u]);
            }
        __syncthreads();
    }
#undef MLOAD
    l += sxor<16>(l); l += sxor<32>(l);
    const float inv = 1.0f / l;
#pragma unroll
    for (int dvt = 0; dvt < 16; ++dvt) {
        u32x2 w; w.x = pk2(o[dvt].x * inv, o[dvt].y * inv); w.y = pk2(o[dvt].z * inv, o[dvt].w * inv);
        *(u32x2*)(qp + dvt * 16 + fq * 4) = w;
    }
}

constexpr int L_QE = 0, L_KE = 17408, L_KST = 34816, L_VTL = 53248, L_ATT = 71680, L_SB = 80896, L_LRF = 115712, L_TOT = 119808, L_GDEC = 121856;
__device__ __forceinline__ void gla_item(const Params& p, const Grp& G, int item, char* lds) {
    const int tid = otid(), lane = tid & 63, wid = tid >> 6, fr = lane & 15, fq = lane >> 4;
    const int slice = item & 1, dir = (item >> 1) & 1, h = (item >> 2) & 3, b = item >> 4;
    const int T = G.T, N = T / 64;
    const bf16_t* P = (const bf16_t*)(p.ws + WS_PROJ) + (size_t)b * T * NP;
    bf16_t* OUT = dir ? (bf16_t*)(p.ws + WS_PROJ) + (size_t)b * T * NP + C_DV + h * 256 + slice * 128
                      : (bf16_t*)(p.ws + WS_HB) + (size_t)b * T * D + h * 256 + slice * 128;
    const int ldo = dir ? NP : D;
    const int amt = wid & 3, antg = wid >> 2;
    bf16x8 wdB[4]; float bd4[4];
    {
        const float* wd = p.in[dir ? I_WDB : I_WDF]; const float* bdp = p.in[dir ? I_BDB : I_BDF];
#pragma unroll
        for (int q = 0; q < 4; ++q) {
            const int col = h * 128 + (antg * 4 + q) * 16 + fr;
            u32x4 w = (u32x4){0u, 0u, 0u, 0u};
            if (fq < 2) { const float* wp = wd + (size_t)(fq * 8) * 512 + col;
                w.x = pk2(wp[0], wp[512]); w.y = pk2(wp[1024], wp[1536]); w.z = pk2(wp[2048], wp[2560]); w.w = pk2(wp[3072], wp[3584]); }
            wdB[q] = __builtin_bit_cast(bf16x8, w);
            bd4[q] = bdp[col];
        }
    }
    { unsigned z = 0u; asm volatile("" : "+v"(z)); for (int i = tid; i < 34816 / 16; i += NTHR) *(u32x4*)(lds + L_SB + i * 16) = (u32x4){z, z, z, z}; }
    f32x4 S[8];
#pragma unroll
    for (int i = 0; i < 8; ++i) S[i] = (f32x4){0.f, 0.f, 0.f, 0.f};
    u32x4 rq[2], rk[2], rv[2], rl;
    const int lrow = tid >> 4, lch = tid & 15;
#define GGLOAD(n) do { const int cb_ = (dir ? (N - 1 - (n)) : (n)) * 64; \
        _Pragma("unroll") for (int i = 0; i < 2; ++i) { const int li_ = lrow + i * 32, tk_ = cb_ + (dir ? 63 - li_ : li_); const bf16_t* rp_ = P + (size_t)tk_ * NP; \
            rq[i] = *(const u32x4*)(rp_ + C_GQ + h * 128 + lch * 8); rk[i] = *(const u32x4*)(rp_ + C_GK + h * 128 + lch * 8); rv[i] = *(const u32x4*)(rp_ + C_GV + h * 256 + slice * 128 + lch * 8); } \
        if (tid < 128) { const int li_ = tid >> 1, tk_ = cb_ + (dir ? 63 - li_ : li_); rl = *(const u32x4*)(P + (size_t)tk_ * NP + C_LR + dir * 16 + (tid & 1) * 8); } } while (0)
    GGLOAD(0);
    for (int n = 0; n < N; ++n) {
#pragma unroll
        for (int i = 0; i < 2; ++i) {
            const int li = lrow + i * 32;
            *(u32x4*)(lds + L_QE + li * 272 + lch * 16) = rq[i];
            *(u32x4*)(lds + L_KE + li * 272 + lch * 16) = rk[i];
            bf16_t* vt = (bf16_t*)(lds + L_VTL) + (lch * 8) * 72 + li;
            vt[0 * 72] = (bf16_t)(rv[i].x & 0xffff); vt[1 * 72] = (bf16_t)(rv[i].x >> 16); vt[2 * 72] = (bf16_t)(rv[i].y & 0xffff); vt[3 * 72] = (bf16_t)(rv[i].y >> 16);
            vt[4 * 72] = (bf16_t)(rv[i].z & 0xffff); vt[5 * 72] = (bf16_t)(rv[i].z >> 16); vt[6 * 72] = (bf16_t)(rv[i].w & 0xffff); vt[7 * 72] = (bf16_t)(rv[i].w >> 16);
        }
        if (tid < 128) *(u32x4*)(lds + L_LRF + (tid >> 1) * 32 + (tid & 1) * 16) = rl;
        if (n + 1 < N) GGLOAD(n + 1);
        __syncthreads();
        {
            u32x4 araw = (u32x4){0u, 0u, 0u, 0u};
            if (fq < 2) araw = *(const u32x4*)(lds + L_LRF + (amt * 16 + fr) * 32 + fq * 16);
            const bf16x8 afr = __builtin_bit_cast(bf16x8, araw);
            float pb[4][4]; float E[4], tt[4];
#pragma unroll
            for (int q = 0; q < 4; ++q) {
                const f32x4 x4 = mfma16(afr, wdB[q], (f32x4){bd4[q], bd4[q], bd4[q], bd4[q]});
                float run = 0.f;
#pragma unroll
                for (int j = 0; j < 4; ++j) {
                    const float x = x4[j];
                    const float ls = fminf(x, 0.f) - __logf(1.0f + __expf(-fabsf(x)));
                    run += ls * 0.0625f; pb[q][j] = run;
                }
                const float u = sxor<16>(run), v = run + u, w2 = sxor<32>(v);
                E[q] = ((fq & 1) ? u : 0.f) + ((fq & 2) ? w2 : 0.f);
                tt[q] = v + w2;
                if (fq == 0) ((float*)(lds + L_TOT))[amt * 128 + (antg * 4 + q) * 16 + fr] = tt[q];
            }
            __syncthreads();
#pragma unroll
            for (int q = 0; q < 4; ++q) {
                const int col = (antg * 4 + q) * 16 + fr;
                float off = 0.f, blast = 0.f;
#pragma unroll
                for (int r = 0; r < 4; ++r) { const float tv = ((const float*)(lds + L_TOT))[r * 128 + col]; blast += tv; if (r < amt) off += tv; }
                const float gcol = __expf(blast);
                bf16_t* qe = (bf16_t*)(lds + L_QE) + (amt * 16 + fq * 4) * 136 + col; bf16_t* ke = (bf16_t*)(lds + L_KE) + (amt * 16 + fq * 4) * 136 + col;
                float ksv[4];
#pragma unroll
                for (int j = 0; j < 4; ++j) {
                    const float bb = off + E[q] + pb[q][j];
                    const float qv = bf2f(qe[j * 136]), kv = bf2f(ke[j * 136]);
                    const float kd = kv * __expf(-bb);
                    qe[j * 136] = f2bf(qv * __expf(bb)); ke[j * 136] = f2bf(kd);
                    ksv[j] = kd * gcol;
                }
                *(u32x2*)(lds + L_KST + col * 144 + (amt * 16 + fq * 4) * 2) = (u32x2){pk2(ksv[0], ksv[1]), pk2(ksv[2], ksv[3])};
                if (amt == 0 && fq == 0) ((float*)(lds + L_GDEC))[col] = gcol;
            }
        }
        __syncthreads();
        {
            const int ct = wid & 3;
            f32x4 a[2] = {(f32x4){0.f, 0.f, 0.f, 0.f}, (f32x4){0.f, 0.f, 0.f, 0.f}};
            bf16x8 qv[4], kv[2][4];
#pragma unroll
            for (int ks = 0; ks < 4; ++ks) {
                qv[ks] = *(const bf16x8*)(lds + L_QE + (ct * 16 + fr) * 272 + ks * 64 + fq * 16);
#pragma unroll
                for (int j = 0; j < 2; ++j) kv[j][ks] = *(const bf16x8*)(lds + L_KE + (((wid >> 2) * 2 + j) * 16 + fr) * 272 + ks * 64 + fq * 16);
            }
            __builtin_amdgcn_sched_barrier(0);
#pragma unroll
            for (int ks = 0; ks < 4; ++ks)
#pragma unroll
                for (int j = 0; j < 2; ++j) a[j] = mfma16(kv[j][ks], qv[ks], a[j]);
#pragma unroll
            for (int j = 0; j < 2; ++j) {
                const int st = (wid >> 2) * 2 + j, cc = ct * 16 + fr, s0 = st * 16 + fq * 4;
                const float v0 = (s0 + 0 <= cc) ? a[j].x : 0.f, v1 = (s0 + 1 <= cc) ? a[j].y : 0.f, v2 = (s0 + 2 <= cc) ? a[j].z : 0.f, v3 = (s0 + 3 <= cc) ? a[j].w : 0.f;
                *(u32x2*)(lds + L_ATT + cc * 144 + s0 * 2) = (u32x2){pk2(v0, v1), pk2(v2, v3)};
            }
        }
        __syncthreads();
        {
            f32x4 oc[4] = {(f32x4){0.f, 0.f, 0.f, 0.f}, (f32x4){0.f, 0.f, 0.f, 0.f}, (f32x4){0.f, 0.f, 0.f, 0.f}, (f32x4){0.f, 0.f, 0.f, 0.f}};
            bf16x8 fa[2], fb[2][4], ga[2], gb[2][4];
#define LD_VA(FA, FB) do { _Pragma("unroll") for (int ks = 0; ks < 2; ++ks) { FA[ks] = *(const bf16x8*)(lds + L_VTL + (wid * 16 + fr) * 144 + ks * 64 + fq * 16); \
                _Pragma("unroll") for (int ct = 0; ct < 4; ++ct) FB[ks][ct] = *(const bf16x8*)(lds + L_ATT + (ct * 16 + fr) * 144 + ks * 64 + fq * 16); } } while (0)
#define LD_SQ(FA, FB, K0) do { _Pragma("unroll") for (int ks = 0; ks < 2; ++ks) { FA[ks] = *(const bf16x8*)(lds + L_SB + (wid * 16 + fr) * 272 + ((K0) + ks) * 64 + fq * 16); \
                _Pragma("unroll") for (int ct = 0; ct < 4; ++ct) FB[ks][ct] = *(const bf16x8*)(lds + L_QE + (ct * 16 + fr) * 272 + ((K0) + ks) * 64 + fq * 16); } } while (0)
#define MM10(FA, FB) do { _Pragma("unroll") for (int ks = 0; ks < 2; ++ks) _Pragma("unroll") for (int ct = 0; ct < 4; ++ct) oc[ct] = mfma16(FA[ks], FB[ks][ct], oc[ct]); } while (0)
            LD_VA(fa, fb); LD_SQ(ga, gb, 0);
            __builtin_amdgcn_sched_barrier(0);
            MM10(fa, fb); LD_SQ(fa, fb, 2);
            __builtin_amdgcn_sched_barrier(0);
            MM10(ga, gb);
            __builtin_amdgcn_sched_barrier(0);
            MM10(fa, fb);
#undef LD_VA
#undef LD_SQ
#undef MM10
            const int cb = (dir ? (N - 1 - n) : n) * 64;
#pragma unroll
            for (int ct = 0; ct < 4; ++ct) {
                const int cl = ct * 16 + fr, tk = cb + (dir ? 63 - cl : cl);
                *(u32x2*)(OUT + (size_t)tk * ldo + wid * 16 + fq * 4) = (u32x2){pk2(oc[ct].x, oc[ct].y), pk2(oc[ct].z, oc[ct].w)};
            }
        }
        __syncthreads();
        {
            const f32x4 gd = *(const f32x4*)((const float*)(lds + L_GDEC) + wid * 16 + fq * 4);
#pragma unroll
            for (int et = 0; et < 8; ++et) S[et] = S[et] * gd;
            bf16x8 da[2], db[2][8];
#pragma unroll
            for (int ks = 0; ks < 2; ++ks) {
                da[ks] = *(const bf16x8*)(lds + L_KST + (wid * 16 + fr) * 144 + ks * 64 + fq * 16);
#pragma unroll
                for (int et = 0; et < 8; ++et) db[ks][et] = *(const bf16x8*)(lds + L_VTL + (et * 16 + fr) * 144 + ks * 64 + fq * 16);
            }
            __builtin_amdgcn_sched_barrier(0);
#pragma unroll
            for (int ks = 0; ks < 2; ++ks)
#pragma unroll
                for (int et = 0; et < 8; ++et) S[et] = mfma16(da[ks], db[ks][et], S[et]);
#pragma unroll
            for (int et = 0; et < 8; ++et)
                *(u32x2*)(lds + L_SB + (et * 16 + fr) * 272 + (wid * 16 + fq * 4) * 2) = (u32x2){pk2(S[et].x, S[et].y), pk2(S[et].z, S[et].w)};
        }
        __syncthreads();
    }
#undef GGLOAD
}

__device__ __forceinline__ void phase_mixer(const Params& p, int g, char* lds, int* s_item) {
    const Grp G = get_group(p, g);
    const int nGLA = G.B * 16, nATT = G.B * 8 * (G.T / 128), nMEM = G.B * 4 * (G.T / 128);
    unsigned* ctr = (unsigned*)(p.ws + WS_CTRL) + g * 4;
    for (;;) {
        if (threadIdx.x == 0) *s_item = (int)atomicAdd(ctr + 0, 1u);
        __syncthreads();
        const int it = *s_item;
        __syncthreads();
        if (it >= nGLA) break;
        gla_item(p, G, it, lds);
    }
    {
        float d1 = 0.f, d2 = 0.f;
        for (int i = 0; i < 64; ++i) { d1 += p.in[I_LQ1][i] * p.in[I_LK1][i]; d2 += p.in[I_LQ2][i] * p.in[I_LK2][i]; }
        const float lam = expf(d1) - expf(d2) + 0.2f;
        for (;;) {
            if (threadIdx.x == 0) *s_item = (int)atomicAdd(ctr + 1, 1u);
            __syncthreads();
            const int it = *s_item;
            __syncthreads();
            if (it >= nATT) break;
            diff_attn_item(p, G, it, lds, lam, 0.f);
        }
    }
    for (;;) {
        if (threadIdx.x == 0) *s_item = (int)atomicAdd(ctr + 2, 1u);
        __syncthreads();
        const int it = *s_item;
        __syncthreads();
        if (it >= nMEM) break;
        mem_attn_item(p, G, it, lds, 0.f);
    }
}

__device__ __forceinline__ void phase_glafin(const Params& p, int g, int tok0, int ntok) {
    const int tid_ = otid(), lane = tid_ & 63, wid = tid_ >> 6;
    bf16_t* P = (bf16_t*)(p.ws + WS_PROJ); const bf16_t* F = (const bf16_t*)(p.ws + WS_HB);
    unsigned qq, kk; u32x2 f, bk, v, gt;
#define GFLOAD(IT) do { const int tok_ = (IT) >> 2, h_ = (IT) & 3; const bf16_t* row_ = P + (size_t)tok_ * NP; \
        qq = *(const unsigned*)(row_ + C_GQ + h_ * 128 + lane * 2); kk = *(const unsigned*)(row_ + C_GK + h_ * 128 + lane * 2); \
        f = *(const u32x2*)(F + (size_t)tok_ * D + h_ * 256 + lane * 4); bk = *(const u32x2*)(row_ + C_DV + h_ * 256 + lane * 4); \
        v = *(const u32x2*)(row_ + C_GV + h_ * 256 + lane * 4); gt = *(const u32x2*)(row_ + C_GG + h_ * 256 + lane * 4); } while (0)
    const f32x4 go = *(const f32x4*)(launder(p.in[I_GOUT]) + lane * 4);
    GFLOAD(tok0 * 4 + wid);
    for (int it = tok0 * 4 + wid; it < (tok0 + ntok) * 4; it += 8) {
        const int tok = it >> 2, h = it & 3;
        bf16_t* row = P + (size_t)tok * NP;
        const unsigned cq = qq, ck = kk; const u32x2 cf = f, cbk = bk, cv = v, cgt = gt;
        if (it + 8 < (tok0 + ntok) * 4) GFLOAD(it + 8);
        __builtin_amdgcn_sched_barrier(0);
        const float qk = wave_sum(bflo(cq) * bflo(ck) + bfhi(cq) * bfhi(ck));
        float o0 = bflo(cf.x) + bflo(cbk.x) - qk * bflo(cv.x), o1 = bfhi(cf.x) + bfhi(cbk.x) - qk * bfhi(cv.x);
        float o2 = bflo(cf.y) + bflo(cbk.y) - qk * bflo(cv.y), o3 = bfhi(cf.y) + bfhi(cbk.y) - qk * bfhi(cv.y);
        const float r = rsqrtf(wave_sum(o0 * o0 + o1 * o1 + o2 * o2 + o3 * o3) * (1.f / 256.f) + RMS_EPS);
        const float g0 = bflo(cgt.x), g1 = bfhi(cgt.x), g2 = bflo(cgt.y), g3 = bfhi(cgt.y);
        o0 *= r * go.x * g0 / (1.f + __expf(-g0)); o1 *= r * go.y * g1 / (1.f + __expf(-g1));
        o2 *= r * go.z * g2 / (1.f + __expf(-g2)); o3 *= r * go.w * g3 / (1.f + __expf(-g3));
        *(u32x2*)(row + C_GG + h * 256 + lane * 4) = (u32x2){pk2(o0, o1), pk2(o2, o3)};
    }
#undef GFLOAD
}

__device__ __forceinline__ void phase_merge(const Params& p, int g, char* lds, int u) {
    const int tid_ = otid(), lane = tid_ & 63, wid = tid_ >> 6, wm = wid >> 2, wn = wid & 3, fr = lane & 15, fq = lane >> 4;
    const bf16_t* P = (const bf16_t*)(p.ws + WS_PROJ); bf16_t* M = (bf16_t*)(p.ws + WS_VT);
    for (int pn = 0; pn < 4; ++pn) {
        const int m0 = u * 128, n0 = pn * 256;
        f32x4 macc[4][4];
#pragma unroll
        for (int i = 0; i < 4; ++i)
#pragma unroll
            for (int j = 0; j < 4; ++j) macc[i][j] = (f32x4){0.f, 0.f, 0.f, 0.f};
        for (int br = 0; br < 3; ++br) {
            f32x4 acc[4][4];
#pragma unroll
            for (int i = 0; i < 4; ++i)
#pragma unroll
                for (int j = 0; j < 4; ++j) acc[i][j] = (f32x4){0.f, 0.f, 0.f, 0.f};
            const int acol = br == 0 ? C_GG : (br == 1 ? C_DQ : C_MQ);
            gemm_kloop<true, 4>(acc, P + (size_t)m0 * NP + acol, NP, (const bf16_t*)(p.ws + WS_WOT) + (size_t)br * D * D + (size_t)n0 * D, D, D, lds);
#pragma unroll
            for (int mt = 0; mt < 4; ++mt)
#pragma unroll
                for (int nt = 0; nt < 4; ++nt) {
                    const int row = m0 + wm * 64 + mt * 16 + fr, col = n0 + wn * 64 + nt * 16 + fq * 4;
                    const u32x2 gt = *(const u32x2*)(P + (size_t)row * NP + C_BG + br * 1024 + col);
                    f32x4 sg; sg.x = 1.f / (1.f + __expf(-bflo(gt.x))); sg.y = 1.f / (1.f + __expf(-bfhi(gt.x))); sg.z = 1.f / (1.f + __expf(-bflo(gt.y))); sg.w = 1.f / (1.f + __expf(-bfhi(gt.y)));
                    macc[mt][nt] += sg * acc[mt][nt];
                }
        }
#pragma unroll
        for (int mt = 0; mt < 4; ++mt)
#pragma unroll
            for (int nt = 0; nt < 4; ++nt) {
                const int row = m0 + wm * 64 + mt * 16 + fr, col = n0 + wn * 64 + nt * 16 + fq * 4;
                *(u32x2*)(M + (size_t)row * D + col) = (u32x2){pk2(macc[mt][nt].x, macc[mt][nt].y), pk2(macc[mt][nt].z, macc[mt][nt].w)};
            }
    }
}

__device__ __forceinline__ void phase_outproj(const Params& p, int g, char* lds, int u) {
    const Grp G = get_group(p, g);
    const int tid_ = otid(), lane = tid_ & 63, wid = tid_ >> 6, wm = wid >> 2, wn = wid & 3, fr = lane & 15, fq = lane >> 4;
    const bf16_t* M = (const bf16_t*)(p.ws + WS_VT); const bf16_t* W = (const bf16_t*)(p.ws + WS_WOT) + (size_t)3 * D * D;
    for (int pn = 0; pn < 4; ++pn) {
        const int m0 = u * 128, n0 = pn * 256;
        f32x4 acc[4][4];
#pragma unroll
        for (int i = 0; i < 4; ++i)
#pragma unroll
            for (int j = 0; j < 4; ++j) acc[i][j] = (f32x4){0.f, 0.f, 0.f, 0.f};
        gemm_kloop<true, 4>(acc, M + (size_t)m0 * D, D, W + (size_t)n0 * D, D, D, lds);
#pragma unroll
        for (int mt = 0; mt < 4; ++mt)
#pragma unroll
            for (int nt = 0; nt < 4; ++nt) {
                const int row = m0 + wm * 64 + mt * 16 + fr, col = n0 + wn * 64 + nt * 16 + fq * 4;
                const f32x4 xv = *(const f32x4*)(G.x + (size_t)row * D + col);
                *(f32x4*)(G.out + (size_t)row * D + col) = xv + acc[mt][nt];
            }
    }
}

__device__ __forceinline__ void phase_peerq(const Params& p, int g, char* lds, int u) {
    const int tid_ = otid(), lane = tid_ & 63, wid = tid_ >> 6, wm = wid >> 2, wn = wid & 3, fr = lane & 15, fq = lane >> 4;
    const bf16_t* A = (const bf16_t*)(p.ws + WS_HB); const bf16_t* W = (const bf16_t*)(p.ws + WS_WQT); bf16_t* P = (bf16_t*)(p.ws + WS_PROJ);
    for (int pn = 0; pn < 8; ++pn) {
        const int m0 = u * 128, n0 = pn * 256;
        f32x4 acc[4][4];
#pragma unroll
        for (int i = 0; i < 4; ++i)
#pragma unroll
            for (int j = 0; j < 4; ++j) acc[i][j] = (f32x4){0.f, 0.f, 0.f, 0.f};
        gemm_kloop<true, 4>(acc, A + (size_t)m0 * D, D, W + (size_t)n0 * D, D, D, lds);
#pragma unroll
        for (int mt = 0; mt < 4; ++mt)
#pragma unroll
            for (int nt = 0; nt < 4; ++nt) {
                const int row = m0 + wm * 64 + mt * 16 + fr, col = n0 + wn * 64 + nt * 16 + fq * 4;
                *(u32x2*)(P + (size_t)row * NP + col) = (u32x2){pk2(acc[mt][nt].x, acc[mt][nt].y), pk2(acc[mt][nt].z, acc[mt][nt].w)};
            }
    }
}

__device__ __forceinline__ unsigned f2ord(float f) { const unsigned u = __float_as_uint(f); return (u & 0x80000000u) ? ~u : (u | 0x80000000u); }
__device__ __forceinline__ float ord2f(unsigned k) { const unsigned u = (k & 0x80000000u) ? (k & 0x7fffffffu) : ~k; return __uint_as_float(u); }
__device__ __forceinline__ unsigned gmax16(unsigned v) {
    unsigned t;
    t = sxoru<1>(v); v = v > t ? v : t; t = sxoru<2>(v); v = v > t ? v : t; t = sxoru<4>(v); v = v > t ? v : t; t = sxoru<8>(v); v = v > t ? v : t;
    return v;
}
__device__ __forceinline__ float gsum16(float v) { v += sxor<1>(v); v += sxor<2>(v); v += sxor<4>(v); v += sxor<8>(v); return v; }
__device__ __forceinline__ float gelu_exact(float a) { return 0.5f * a * (1.0f + erff(a * 0.70710678118654752f)); }

__device__ __forceinline__ void phase_peer(const Params& p, int g, char* lds, int tile0, int ntile) {
    const Grp G = get_group(p, g);
    const int tid = otid(), lane = tid & 63, wid = tid >> 6, fr = lane & 15, fq = lane >> 4;
    const bf16_t* P = (const bf16_t*)(p.ws + WS_PROJ); const bf16_t* HB = (const bf16_t*)(p.ws + WS_HB);
    const bf16_t* K12 = (const bf16_t*)(p.ws + WS_K12);
    float* SC = (float*)lds;
    int* EIDX = (int*)(lds + 65536);
    float* GATE = (float*)(lds + 65536 + 4096);
    char* KL = lds + 73728;
    for (int i = tid; i < 2 * 128 * 16; i += NTHR) {
        const int r = i >> 4, ch = i & 15;
        *(u32x4*)(KL + r * 272 + ch * 16) = *(const u32x4*)(K12 + (size_t)r * 128 + ch * 8);
    }
    __syncthreads();
    for (int tile = tile0; tile < tile0 + ntile; ++tile) {
        const int tok0 = tile * 8;
        {
            const bf16_t* qtok = P + (size_t)(tok0 + wid) * NP + (fr & 7) * 256;
#pragma unroll
            for (int half = 0; half < 2; ++half) {
                f32x4 acc[8];
#pragma unroll
                for (int i = 0; i < 8; ++i) acc[i] = (f32x4){0.f, 0.f, 0.f, 0.f};
                bf16x8 af[4], kfa[8], kfb[8];
#pragma unroll
                for (int ks = 0; ks < 4; ++ks) af[ks] = *(const bf16x8*)(qtok + half * 128 + ks * 32 + fq * 8);
#define KFLOAD(BUF, KS) do { _Pragma("unroll") for (int nt = 0; nt < 8; ++nt) BUF[nt] = *(const bf16x8*)(KL + (half * 128 + nt * 16 + fr) * 272 + (KS) * 64 + fq * 16); } while (0)
#define KFMMA(BUF, KS) do { _Pragma("unroll") for (int nt = 0; nt < 8; ++nt) acc[nt] = mfma16(af[KS], BUF[nt], acc[nt]); } while (0)
                KFLOAD(kfa, 0);
                __builtin_amdgcn_sched_barrier(0);
                KFLOAD(kfb, 1); KFMMA(kfa, 0);
                __builtin_amdgcn_sched_barrier(0);
                KFLOAD(kfa, 2); KFMMA(kfb, 1);
                __builtin_amdgcn_sched_barrier(0);
                KFLOAD(kfb, 3); KFMMA(kfa, 2);
                __builtin_amdgcn_sched_barrier(0);
                KFMMA(kfb, 3);
#undef KFLOAD
#undef KFMMA
                if (fq < 2) {
#pragma unroll
                    for (int nt = 0; nt < 8; ++nt) {
                        float* dst = SC + (wid * 8 + fq * 4) * 256 + half * 128 + nt * 16 + fr;
                        dst[0] = acc[nt].x; dst[256] = acc[nt].y; dst[512] = acc[nt].z; dst[768] = acc[nt].w;
                    }
                }
            }
        }
        __builtin_amdgcn_wave_barrier();
        {
            const int sl = fr, gb = fq * 16;
            const int row0_ = wid * 8 + fq, row1_ = wid * 8 + 4 + fq;
            float v1[2] = {0.f, 0.f}, v2[2] = {0.f, 0.f}; int i1[2] = {0, 0}, i2[2] = {0, 0};
            {
                unsigned kc[4][8];
#pragma unroll
                for (int c4 = 0; c4 < 4; ++c4)
#pragma unroll
                    for (int i = 0; i < 8; ++i) { const int idx = sl + 16 * i;
                        kc[c4][i] = (f2ord(SC[((c4 & 1) ? row1_ : row0_) * 256 + (c4 >> 1) * 128 + idx]) & ~127u) | (unsigned)(127 - idx); }
                float sv[4] = {0.f, 0.f, 0.f, 0.f}; int si[4] = {0, 0, 0, 0};
                for (int r = 0; r < 16; ++r) {
                    unsigned m[4], t[4];
#pragma unroll
                    for (int c4 = 0; c4 < 4; ++c4) {
                        const unsigned x0 = kc[c4][0] > kc[c4][1] ? kc[c4][0] : kc[c4][1], x1 = kc[c4][2] > kc[c4][3] ? kc[c4][2] : kc[c4][3];
                        const unsigned x2 = kc[c4][4] > kc[c4][5] ? kc[c4][4] : kc[c4][5], x3 = kc[c4][6] > kc[c4][7] ? kc[c4][6] : kc[c4][7];
                        const unsigned y0 = x0 > x1 ? x0 : x1, y1 = x2 > x3 ? x2 : x3; m[c4] = y0 > y1 ? y0 : y1;
                    }
#pragma unroll
                    for (int c4 = 0; c4 < 4; ++c4) t[c4] = sxoru<1>(m[c4]);
#pragma unroll
                    for (int c4 = 0; c4 < 4; ++c4) m[c4] = m[c4] > t[c4] ? m[c4] : t[c4];
#pragma unroll
                    for (int c4 = 0; c4 < 4; ++c4) t[c4] = sxoru<2>(m[c4]);
#pragma unroll
                    for (int c4 = 0; c4 < 4; ++c4) m[c4] = m[c4] > t[c4] ? m[c4] : t[c4];
#pragma unroll
                    for (int c4 = 0; c4 < 4; ++c4) t[c4] = sxoru<4>(m[c4]);
#pragma unroll
                    for (int c4 = 0; c4 < 4; ++c4) m[c4] = m[c4] > t[c4] ? m[c4] : t[c4];
#pragma unroll
                    for (int c4 = 0; c4 < 4; ++c4) t[c4] = sxoru<8>(m[c4]);
#pragma unroll
                    for (int c4 = 0; c4 < 4; ++c4) m[c4] = m[c4] > t[c4] ? m[c4] : t[c4];
#pragma unroll
                    for (int c4 = 0; c4 < 4; ++c4) {
                        if (sl == r) { sv[c4] = ord2f(m[c4] & ~127u); si[c4] = 127 - (int)(m[c4] & 127u); }
#pragma unroll
                        for (int i = 0; i < 8; ++i) kc[c4][i] = kc[c4][i] == m[c4] ? 0u : kc[c4][i];
                    }
                }
                v1[0] = sv[0]; i1[0] = si[0]; v1[1] = sv[1]; i1[1] = si[1]; v2[0] = sv[2]; i2[0] = si[2]; v2[1] = sv[3]; i2[1] = si[3];
            }
            int pa = 0, pb = 0; float tsa = 0.f, tsb = 0.f; int pida = 0, pidb = 0;
            for (int r = 0; r < 16; ++r) {
                const float va = __int_as_float(__builtin_amdgcn_ds_bpermute((gb + (pa & 15)) << 2, __float_as_int(v2[0])));
                const float vb = __int_as_float(__builtin_amdgcn_ds_bpermute((gb + (pb & 15)) << 2, __float_as_int(v2[1])));
                const unsigned keya = pa < 16 ? ((f2ord(v1[0] + va) & ~255u) | (unsigned)(255 - (sl * 16 + pa))) : 0u;
                const unsigned keyb = pb < 16 ? ((f2ord(v1[1] + vb) & ~255u) | (unsigned)(255 - (sl * 16 + pb))) : 0u;
                unsigned ma = keya, mb = keyb, ta, tb;
                ta = sxoru<1>(ma); tb = sxoru<1>(mb); ma = ma > ta ? ma : ta; mb = mb > tb ? mb : tb;
                ta = sxoru<2>(ma); tb = sxoru<2>(mb); ma = ma > ta ? ma : ta; mb = mb > tb ? mb : tb;
                ta = sxoru<4>(ma); tb = sxoru<4>(mb); ma = ma > ta ? ma : ta; mb = mb > tb ? mb : tb;
                ta = sxoru<8>(ma); tb = sxoru<8>(mb); ma = ma > ta ? ma : ta; mb = mb > tb ? mb : tb;
                if (sl == r) { tsa = ord2f(ma & ~255u); pida = 255 - (int)(ma & 255u); tsb = ord2f(mb & ~255u); pidb = 255 - (int)(mb & 255u); }
                if (keya == ma) pa++;
                if (keyb == mb) pb++;
            }
#pragma unroll
            for (int ps = 0; ps < 2; ++ps) {
                const int pid = ps ? pidb : pida; const float ts = ps ? tsb : tsa; const int row = ps ? row1_ : row0_;
                const int e1 = __builtin_amdgcn_ds_bpermute((gb + (pid >> 4)) << 2, i1[ps]), e2 = __builtin_amdgcn_ds_bpermute((gb + (pid & 15)) << 2, i2[ps]);
                float mx = ts;
                mx = fmaxf(mx, sxor<1>(mx)); mx = fmaxf(mx, sxor<2>(mx)); mx = fmaxf(mx, sxor<4>(mx)); mx = fmaxf(mx, sxor<8>(mx));
                const float ex = __expf(ts - mx), sm = gsum16(ex);
                EIDX[row * 16 + sl] = e1 * 128 + e2; GATE[row * 16 + sl] = ex / sm;
            }
        }
        __builtin_amdgcn_wave_barrier();
        {
            const int tok = tok0 + wid;
            const bf16_t* hrow = HB + (size_t)tok * D;
            const int grp = lane >> 4, sl = lane & 15;
            {
                f32x2 hv[32];
#pragma unroll
                for (int c = 0; c < 8; ++c) {
                    const u32x4 hq = *(const u32x4*)(hrow + sl * 64 + c * 8);
                    hv[c * 4 + 0] = (f32x2){bflo(hq.x), bfhi(hq.x)} * (1.0f / PEER_SU); hv[c * 4 + 1] = (f32x2){bflo(hq.y), bfhi(hq.y)} * (1.0f / PEER_SU);
                    hv[c * 4 + 2] = (f32x2){bflo(hq.z), bfhi(hq.z)} * (1.0f / PEER_SU); hv[c * 4 + 3] = (f32x2){bflo(hq.w), bfhi(hq.w)} * (1.0f / PEER_SU);
                }
                const unsigned char* PU8 = p.ws + WS_PU + sl * 64;
#define ULOADG(BUF, IT) do { _Pragma("unroll") for (int i_ = 0; i_ < 2; ++i_) { const int k_ = ((IT) + i_) * 4 + grp; const unsigned char* ur_ = PU8 + (size_t)EIDX[wid * 128 + k_] * D; \
        BUF[i_ * 4 + 0] = *(const u32x4*)ur_; BUF[i_ * 4 + 1] = *(const u32x4*)(ur_ + 16); BUF[i_ * 4 + 2] = *(const u32x4*)(ur_ + 32); BUF[i_ * 4 + 3] = *(const u32x4*)(ur_ + 48); } } while (0)
#define PDOT(uq, base) \
        a2 += __builtin_amdgcn_cvt_pk_f32_fp8((int)uq.x, false) * hv[base + 0]; b2 += __builtin_amdgcn_cvt_pk_f32_fp8((int)uq.x, true) * hv[base + 1]; \
        a2 += __builtin_amdgcn_cvt_pk_f32_fp8((int)uq.y, false) * hv[base + 2]; b2 += __builtin_amdgcn_cvt_pk_f32_fp8((int)uq.y, true) * hv[base + 3]; \
        a2 += __builtin_amdgcn_cvt_pk_f32_fp8((int)uq.z, false) * hv[base + 4]; b2 += __builtin_amdgcn_cvt_pk_f32_fp8((int)uq.z, true) * hv[base + 5]; \
        a2 += __builtin_amdgcn_cvt_pk_f32_fp8((int)uq.w, false) * hv[base + 6]; b2 += __builtin_amdgcn_cvt_pk_f32_fp8((int)uq.w, true) * hv[base + 7];
#define UCOMP(BUF, IT) do { _Pragma("unroll") for (int i_ = 0; i_ < 2; ++i_) { const int k_ = ((IT) + i_) * 4 + grp; \
        f32x2 a2 = (f32x2){0.f, 0.f}, b2 = (f32x2){0.f, 0.f}; \
        PDOT(BUF[i_ * 4 + 0], 0) PDOT(BUF[i_ * 4 + 1], 8) PDOT(BUF[i_ * 4 + 2], 16) PDOT(BUF[i_ * 4 + 3], 24) \
        a2 += b2; const float a_ = gsum16(a2.x + a2.y); GATE[wid * 128 + k_] = GATE[wid * 128 + k_] * gelu_exact(a_); } } while (0)
                u32x4 ubA[8], ubB[8];
                ULOADG(ubA, 0);
                for (int it0 = 0; it0 < 32; it0 += 4) {
                    ULOADG(ubB, it0 + 2);
                    __builtin_amdgcn_sched_barrier(0);
                    UCOMP(ubA, it0);
                    __builtin_amdgcn_sched_barrier(0);
                    if (it0 + 4 < 32) ULOADG(ubA, it0 + 4);
                    __builtin_amdgcn_sched_barrier(0);
                    UCOMP(ubB, it0 + 2);
                    __builtin_amdgcn_sched_barrier(0);
                }
#undef ULOADG
#undef PDOT
#undef UCOMP
            }
            __builtin_amdgcn_wave_barrier();
            f32x2 acc[8];
#pragma unroll
            for (int i = 0; i < 8; ++i) acc[i] = (f32x2){0.f, 0.f};
            const unsigned char* PV8 = p.ws + WS_PV + lane * 16;
#define VLOADG(BUF, K0) do { _Pragma("unroll") for (int i_ = 0; i_ < 8; ++i_) BUF[i_] = *(const u32x4*)(PV8 + (size_t)EIDX[wid * 128 + (K0) + i_] * D); } while (0)
#define VCOMP(BUF, K0) do { _Pragma("unroll") for (int i_ = 0; i_ < 8; ++i_) { const float w_ = GATE[wid * 128 + (K0) + i_]; const f32x2 w2 = (f32x2){w_, w_}; const u32x4 v = BUF[i_]; \
        acc[0] += w2 * __builtin_amdgcn_cvt_pk_f32_fp8((int)v.x, false); acc[1] += w2 * __builtin_amdgcn_cvt_pk_f32_fp8((int)v.x, true); \
        acc[2] += w2 * __builtin_amdgcn_cvt_pk_f32_fp8((int)v.y, false); acc[3] += w2 * __builtin_amdgcn_cvt_pk_f32_fp8((int)v.y, true); \
        acc[4] += w2 * __builtin_amdgcn_cvt_pk_f32_fp8((int)v.z, false); acc[5] += w2 * __builtin_amdgcn_cvt_pk_f32_fp8((int)v.z, true); \
        acc[6] += w2 * __builtin_amdgcn_cvt_pk_f32_fp8((int)v.w, false); acc[7] += w2 * __builtin_amdgcn_cvt_pk_f32_fp8((int)v.w, true); } } while (0)
            {
                u32x4 vbA[8], vbB[8];
                VLOADG(vbA, 0);
                for (int k0 = 0; k0 < 128; k0 += 16) {
                    VLOADG(vbB, k0 + 8);
                    __builtin_amdgcn_sched_barrier(0);
                    VCOMP(vbA, k0);
                    __builtin_amdgcn_sched_barrier(0);
                    if (k0 + 16 < 128) VLOADG(vbA, k0 + 16);
                    __builtin_amdgcn_sched_barrier(0);
                    VCOMP(vbB, k0 + 8);
                    __builtin_amdgcn_sched_barrier(0);
                }
            }
#undef VLOADG
#undef VCOMP
            float* orow = G.out + (size_t)tok * D + lane * 16;
#pragma unroll
            for (int i = 0; i < 4; ++i) {
                f32x4 t = *(f32x4*)(orow + i * 4);
                t.x += acc[2 * i].x * (1.0f / PEER_SV); t.y += acc[2 * i].y * (1.0f / PEER_SV); t.z += acc[2 * i + 1].x * (1.0f / PEER_SV); t.w += acc[2 * i + 1].y * (1.0f / PEER_SV);
                *(f32x4*)(orow + i * 4) = t;
            }
        }
        __builtin_amdgcn_wave_barrier();
    }
}


constexpr int NPH = 3 + NGROUP * 3;
__device__ __forceinline__ void run_phase(const Params& p, int ph, char* lds, int* s_item) {
    const int g = (ph - 3) / 3, s = (ph - 3) % 3;
    const Grp G = get_group(p, g);
    if (s == 0) {
        for (int u = blockIdx.x; u < 256; u += gridDim.x) {
            const int m0 = (u >> 1) * 256;
            phase_rmsnorm(G.x, p.in[I_GMIX], (bf16_t*)(p.ws + WS_HB), m0, 256);
            __syncthreads();
            phase_inproj(p, g, lds, u);
            __syncthreads();
        }
    } else if (s == 1) {
        phase_mixer(p, g, lds, s_item);
    } else {
        for (int u = blockIdx.x; u < 256; u += gridDim.x) {
            const int m0 = u * 128;
            phase_glafin(p, g, m0, 128);
            __syncthreads();
            phase_merge(p, g, lds, u);
            __syncthreads();
            phase_outproj(p, g, lds, u);
            __syncthreads();
            phase_rmsnorm(G.out, p.in[I_GFFN], (bf16_t*)(p.ws + WS_HB), m0, 128);
            __syncthreads();
            phase_peerq(p, g, lds, u);
            __syncthreads();
            phase_peer(p, g, lds, m0 / 8, 16);
            __syncthreads();
        }
    }
}

__global__ void __launch_bounds__(NTHR) mega_kernel(Params p) {
    extern __shared__ __attribute__((aligned(16))) char lds[];
    __shared__ int s_item;
    cg::grid_group grid = cg::this_grid();
    phase_p0a(p, lds); grid.sync();
    phase_p0b(p, lds); grid.sync();
    phase_p0c(p); grid.sync();
    for (int ph = 3; ph < NPH; ++ph) {
        run_phase(p, ph, lds, &s_item);
        if (ph + 1 < NPH) grid.sync();
    }
}

extern "C" void kernel_launch(void* const* d_in, const int* in_sizes, int n_in, void* d_out, int out_size, void* d_ws, size_t ws_size, hipStream_t stream) {
    static int grid_blocks = 0;
    if (grid_blocks == 0) {
        if (n_in != 32 || ws_size < WS_END) { fprintf(stderr, "kernel_launch: unexpected n_in %d or ws_size %zu (< %zu)\n", n_in, ws_size, (size_t)WS_END); grid_blocks = -1; return; }
        int dev = 0, cus = 0, per_cu = 0;
        hipGetDevice(&dev);
        hipDeviceGetAttribute(&cus, hipDeviceAttributeMultiprocessorCount, dev);
        hipFuncSetAttribute((const void*)mega_kernel, hipFuncAttributeMaxDynamicSharedMemorySize, LDS_BYTES);
        hipOccupancyMaxActiveBlocksPerMultiprocessor(&per_cu, (const void*)mega_kernel, NTHR, LDS_BYTES);
        if (per_cu < 1) per_cu = 1;
        grid_blocks = cus * per_cu;
        (void)hipGetLastError();
    }
    if (grid_blocks < 0) return;
    Params p{};
    for (int i = 0; i < 32; ++i) p.in[i] = (const float*)d_in[i];
    p.out = (float*)d_out; p.ws = (unsigned char*)d_ws; p.ph_lo = 0; p.ph_hi = NPH;
    void* args[] = {&p};
    hipError_t e = hipLaunchCooperativeKernel((const void*)mega_kernel, dim3(grid_blocks), dim3(NTHR), args, LDS_BYTES, stream);
    if (e != hipSuccess) fprintf(stderr, "cooperative launch failed: %s (grid %d)\n", hipGetErrorString(e), grid_blocks);
}
```

```cpp
#include <hip/hip_runtime.h>
#include <hip/hip_cooperative_groups.h>
#include <cstdio>
#include <cstdint>
namespace cg = cooperative_groups;

typedef unsigned short bf16_t;
typedef short bf16x8 __attribute__((ext_vector_type(8)));
typedef float f32x4 __attribute__((ext_vector_type(4)));
typedef unsigned u32x4 __attribute__((ext_vector_type(4)));
typedef unsigned u32x2 __attribute__((ext_vector_type(2)));

constexpr int D = 1024;
constexpr int NP = 10496;
constexpr int IN_COLS = 10272;
constexpr int C_GQ = 0, C_GK = 512, C_GV = 1024, C_GG = 2048, C_DQ = 3072, C_DK = 4096, C_DV = 5120, C_MQ = 6144, C_BG = 7168, C_LR = 10240;
constexpr int G_TOK = 32768;
constexpr int NGROUP = 3;
constexpr int NTHR = 512;
constexpr float RMS_EPS = 1e-6f;
constexpr float LOG2E = 1.4426950408889634f;
constexpr int LDS_BYTES = 147456;
constexpr float PEER_SU = 32.0f, PEER_SV = 8.0f;

enum { I_XP = 0, I_XS, I_MP, I_MS, I_GMIX, I_WIN, I_WDF, I_BDF, I_WDB, I_BDB, I_GOUT, I_GWO, I_DGQ, I_DGK, I_LQ1, I_LK1, I_LQ2, I_LK2,
       I_DGSUB, I_DWO, I_MGN, I_MWKV, I_MGQ, I_MGK, I_MWO, I_WOUT, I_GFFN, I_PWQ, I_PK1, I_PK2, I_PU, I_PV };

constexpr size_t al256(size_t x) { return (x + 255) & ~(size_t)255; }
constexpr size_t WS_CTRL = 0;
constexpr size_t WS_PROJ = 4096;
constexpr size_t WS_HB   = WS_PROJ + (size_t)G_TOK * NP * 2;
constexpr size_t WS_VT   = WS_HB + (size_t)G_TOK * D * 2;
constexpr size_t WS_WINT = WS_VT + (size_t)G_TOK * D * 2;
constexpr size_t WS_WOT  = WS_WINT + (size_t)NP * D * 2;
constexpr size_t WS_WKVT = WS_WOT + (size_t)4 * D * D * 2;
constexpr size_t WS_WQT  = WS_WKVT + (size_t)2048 * D * 2;
constexpr size_t WS_PU   = WS_WQT + (size_t)2048 * D * 2;
constexpr size_t WS_PV   = WS_PU + (size_t)16384 * D * 2;
constexpr size_t WS_K12  = WS_PV + (size_t)16384 * D * 2;
constexpr size_t WS_ROPE = WS_K12 + (size_t)2 * 128 * 128 * 2;
constexpr size_t WS_HM   = WS_ROPE + (size_t)16384 * 64 * 4;
constexpr size_t WS_KVR  = WS_HM + (size_t)2560 * D * 2;
constexpr size_t WS_MEMK = WS_KVR + (size_t)2560 * 2048 * 4;
constexpr size_t WS_MEMV = WS_MEMK + (size_t)10 * 4 * 256 * 256 * 2;
constexpr size_t WS_END  = WS_MEMV + (size_t)10 * 4 * 256 * 256 * 2;

struct Params {
    const float* in[32];
    float* out;
    unsigned char* ws;
    int ph_lo, ph_hi;
};

typedef float f32x2 __attribute__((ext_vector_type(2)));
typedef __bf16 bf16x2v __attribute__((ext_vector_type(2)));
__device__ __forceinline__ unsigned pk2(float lo, float hi) { const f32x2 v = {lo, hi}; const bf16x2v b = __builtin_convertvector(v, bf16x2v); return __builtin_bit_cast(unsigned, b); }
__device__ __forceinline__ float bflo(unsigned u) { return __uint_as_float(u << 16); }
__device__ __forceinline__ float bfhi(unsigned u) { return __uint_as_float(u & 0xffff0000u); }
__device__ __forceinline__ float bf2f(bf16_t b) { return __uint_as_float(((unsigned)b) << 16); }
__device__ __forceinline__ bf16_t f2bf(float f) { return (bf16_t)(pk2(f, 0.f) & 0xffffu); }
__device__ __forceinline__ f32x4 mfma16(bf16x8 a, bf16x8 b, f32x4 c) { return __builtin_amdgcn_mfma_f32_16x16x32_bf16(a, b, c, 0, 0, 0); }
__device__ __forceinline__ float fexp2(float x) { return __builtin_amdgcn_exp2f(x); }
template <class T> __device__ __forceinline__ T* launder(T* q) { asm volatile("" : "+s"(q)); return q; }
__device__ __forceinline__ int otid() { int t = threadIdx.x; asm volatile("" : "+v"(t)); return t; }
template <int M> __device__ __forceinline__ float sxor(float v) {
    if (M < 32) return __int_as_float(__builtin_amdgcn_ds_swizzle(__float_as_int(v), (M << 10) | 0x1F));
    const int l = otid() & 63; return __int_as_float(__builtin_amdgcn_ds_bpermute((l ^ 32) << 2, __float_as_int(v)));
}
template <int M> __device__ __forceinline__ unsigned sxoru(unsigned v) { return (unsigned)__builtin_amdgcn_ds_swizzle((int)v, (M << 10) | 0x1F); }
__device__ __forceinline__ float wave_sum(float v) {
    v += sxor<1>(v); v += sxor<2>(v); v += sxor<4>(v); v += sxor<8>(v); v += sxor<16>(v); v += sxor<32>(v);
    return v;
}

struct Grp { const float* x; const float* mem; float* out; int B, T, mb0; };
__device__ __forceinline__ Grp get_group(const Params& p, int g) {
    Grp r;
    if (g == 0) { r.x = p.in[I_XP]; r.out = p.out; r.B = 2; r.T = 16384; r.mb0 = 0; }
    else { r.x = p.in[I_XS] + (size_t)(g - 1) * G_TOK * D; r.out = p.out + (size_t)g * G_TOK * D; r.B = 4; r.T = 8192; r.mb0 = 2 + (g - 1) * 4; }
    r.mem = nullptr;
    return r;
}

constexpr int G_ROW = 144;
constexpr int G_A_BYTES = 128 * G_ROW;
constexpr int G_B_BYTES = 256 * G_ROW;
constexpr int G_STAGE = G_A_BYTES + G_B_BYTES;

template <bool SWAP, int MT>
__device__ __forceinline__ void gemm_kloop(f32x4 (&acc)[MT][4], const bf16_t* __restrict__ A, int lda, const bf16_t* __restrict__ Bt, int ldb, int K, char* lds) {
    constexpr int A_ROWS = MT * 32, A_BYTES = A_ROWS * G_ROW, STAGE = A_BYTES + G_B_BYTES;
    constexpr int NA = A_BYTES / 1024, NI = STAGE / 1024, NPER = (NI + 7) / 8;
    const int tid = otid(), lane = tid & 63, wid = __builtin_amdgcn_readfirstlane(tid >> 6), wm = wid >> 2, wn = wid & 3, fr = lane & 15, fq = lane >> 4;
    unsigned goff[NPER];
#pragma unroll
    for (int i = 0; i < NPER; ++i) {
        const int j = wid + 8 * i;
        const int ci = (j < NA ? j : j - NA) * 64 + lane, row = ci / 9, ch = ci % 9, chc = ch < 8 ? ch : 7;
        goff[i] = (unsigned)(row * (j < NA ? lda : ldb) + chc * 8);
    }
#define GSTAGE(buf, k0) do { _Pragma("unroll") for (int i = 0; i < NPER; ++i) { const int j = wid + 8 * i; if (j < NI) { \
        const bf16_t* src_ = (j < NA ? A : Bt) + goff[i] + (k0); \
        __builtin_amdgcn_global_load_lds((const unsigned*)src_, (unsigned*)(lds + (buf) * STAGE + j * 1024), 16, 0, 0); } } } while (0)
    const int nk = K / 64;
    GSTAGE(0, 0);
    __syncthreads();
    for (int kt = 0; kt < nk; ++kt) {
        if (kt + 1 < nk) GSTAGE((kt + 1) & 1, (kt + 1) * 64);
        const char* base = lds + (kt & 1) * STAGE;
        const char* abase = base + (wm * (MT * 16) + fr) * G_ROW + fq * 16;
        const char* bbase = base + A_BYTES + (wn * 64 + fr) * G_ROW + fq * 16;
        bf16x8 b0[4], b1[4], ar[4];
#pragma unroll
        for (int nt = 0; nt < 4; ++nt) b0[nt] = *(const bf16x8*)(bbase + nt * 16 * G_ROW);
        ar[0] = *(const bf16x8*)(abase); ar[1] = *(const bf16x8*)(abase + 16 * G_ROW); ar[2] = *(const bf16x8*)(abase + 32 * G_ROW);
#pragma unroll
        for (int st = 0; st < 2 * MT; ++st) {
            const int ks = st / MT, mt = st % MT;
            __builtin_amdgcn_sched_barrier(0);
            if (st + 3 < 2 * MT) { const int ks2 = (st + 3) / MT, mt2 = (st + 3) % MT; ar[(st + 3) % 4] = *(const bf16x8*)(abase + mt2 * 16 * G_ROW + ks2 * 64); }
            if (ks == 0 && mt >= MT - 3 && mt < MT - 1) {
#pragma unroll
                for (int q = 0; q < 2; ++q) { const int nt = (mt - (MT - 3)) * 2 + q; b1[nt] = *(const bf16x8*)(bbase + nt * 16 * G_ROW + 64); }
            }
#pragma unroll
            for (int nt = 0; nt < 4; ++nt) {
                const bf16x8 bv = ks == 0 ? b0[nt] : b1[nt];
                acc[mt][nt] = SWAP ? mfma16(bv, ar[st % 4], acc[mt][nt]) : mfma16(ar[st % 4], bv, acc[mt][nt]);
            }
        }
        __builtin_amdgcn_sched_barrier(0);
        __syncthreads();
    }
#undef GSTAGE
}

__device__ __forceinline__ void tile_order(int t, int nM, int nN, int& pm, int& pn) {
    const int per = 8 * nN, grp = t / per, r = t % per;
    pm = grp * 8 + (r & 7); pn = r >> 3;
}

__device__ __forceinline__ void phase_p0a(const Params& p, char* lds) {
    const int tid = otid(), lane = tid & 63, wid = tid >> 6;
    unsigned char* ws = p.ws;
    if (blockIdx.x == 0 && tid < 256) atomicExch((unsigned*)(ws + WS_CTRL) + tid, 0u);
    float* scr = (float*)(lds + wid * 8448);
    constexpr int IT_WIN = 16 * (NP / 32), IT_SQ = 16 * 32, IT_W2 = 16 * 64;
    constexpr int NIT = IT_WIN + 4 * IT_SQ + 2 * IT_W2;
    for (int it0 = blockIdx.x * 8; it0 < NIT; it0 += gridDim.x * 8) {
        int it = it0 + wid;
        const float* W = nullptr; bf16_t* WT = nullptr; int N = 0, nb = 0, kb = 0, srccol = -1;
        if (it < NIT) {
            int r = it;
            if (r < IT_WIN) { W = p.in[I_WIN]; N = IN_COLS; WT = (bf16_t*)(ws + WS_WINT); kb = r / (NP / 32); nb = r % (NP / 32);
                const int n0 = nb * 32; srccol = n0 < 3072 ? n0 : (n0 < 10240 ? n0 + 32 : (n0 == 10240 ? 3072 : -1)); }
            else { r -= IT_WIN;
                if (r < 4 * IT_SQ) { const int w = r / IT_SQ; r %= IT_SQ; const int idx[4] = {I_GWO, I_DWO, I_MWO, I_WOUT};
                    W = p.in[w == 0 ? I_GWO : (w == 1 ? I_DWO : (w == 2 ? I_MWO : I_WOUT))]; (void)idx; N = 1024; WT = (bf16_t*)(ws + WS_WOT) + (size_t)w * D * D; kb = r / 32; nb = r % 32; srccol = nb * 32; }
                else { r -= 4 * IT_SQ; const int w = r / IT_W2; r %= IT_W2; W = p.in[w == 0 ? I_MWKV : I_PWQ]; N = 2048; WT = (bf16_t*)(ws + (w == 0 ? WS_WKVT : WS_WQT)); kb = r / 64; nb = r % 64; srccol = nb * 32; }
            }
            const int k0 = kb * 64;
#pragma unroll 8
            for (int i = 0; i < 32; ++i) { const int kk = 2 * i + (lane >> 5); scr[kk * 33 + (lane & 31)] = srccol >= 0 ? W[(size_t)(k0 + kk) * N + srccol + (lane & 31)] : 0.f; }
        }
        __syncthreads();
        if (it < NIT) {
            const int k0 = kb * 64, c = lane & 7;
#pragma unroll
            for (int j = 0; j < 4; ++j) { const int n = (lane >> 3) + 8 * j; const float* s = scr + (8 * c) * 33 + n;
                u32x4 o; o.x = pk2(s[0], s[33]); o.y = pk2(s[66], s[99]); o.z = pk2(s[132], s[165]); o.w = pk2(s[198], s[231]);
                *(u32x4*)(WT + (size_t)(nb * 32 + n) * D + k0 + 8 * c) = o; }
        }
        __syncthreads();
    }
    const size_t gtid = (size_t)blockIdx.x * NTHR + tid, gsz = (size_t)gridDim.x * NTHR;
    {
        const size_t n8 = (size_t)16384 * D / 8;
        for (size_t i = gtid; i < 2 * n8; i += gsz) {
            const int w = i >= n8; const size_t j = w ? i - n8 : i;
            const float* src = p.in[w ? I_PV : I_PU] + j * 8; unsigned char* dst = ws + (w ? WS_PV : WS_PU) + j * 8;
            const float sc = w ? PEER_SV : PEER_SU;
            const f32x4 a = *(const f32x4*)src * sc, b = *(const f32x4*)(src + 4) * sc;
            int lo = __builtin_amdgcn_cvt_pk_fp8_f32(a.x, a.y, 0, false); lo = __builtin_amdgcn_cvt_pk_fp8_f32(a.z, a.w, lo, true);
            int hi = __builtin_amdgcn_cvt_pk_fp8_f32(b.x, b.y, 0, false); hi = __builtin_amdgcn_cvt_pk_fp8_f32(b.z, b.w, hi, true);
            *(u32x2*)dst = (u32x2){(unsigned)lo, (unsigned)hi};
        }
        for (size_t i = gtid; i < 2 * 16384; i += gsz) {
            const int w = i >= 16384; const size_t j = w ? i - 16384 : i;
            ((bf16_t*)(ws + WS_K12))[i] = f2bf(p.in[w ? I_PK2 : I_PK1][j]);
        }
    }
    for (size_t i = gtid; i < (size_t)16384 * 32; i += gsz) {
        const int t = (int)(i >> 5), k = (int)(i & 31);
        const float inv = powf(10000.0f, -(float)(2 * k) / 64.0f);
        const float ang = (float)t * inv;
        double sn, cs; sincos((double)ang, &sn, &cs);
        float* R = (float*)(ws + WS_ROPE) + (size_t)t * 64;
        R[k] = (float)cs; R[32 + k] = (float)sn;
    }
    for (int row = blockIdx.x * 8 + wid; row < 2560; row += gridDim.x * 8) {
        const float* src = row < 512 ? p.in[I_MP] + (size_t)row * D : p.in[I_MS] + (size_t)(row - 512) * D;
        const f32x4* xr = (const f32x4*)src + lane; const f32x4* gr = (const f32x4*)p.in[I_MGN] + lane;
        f32x4 v[4]; float s = 0.f;
#pragma unroll
        for (int j = 0; j < 4; ++j) { v[j] = xr[64 * j]; s += v[j].x * v[j].x + v[j].y * v[j].y + v[j].z * v[j].z + v[j].w * v[j].w; }
        const float r = rsqrtf(wave_sum(s) * (1.f / D) + RMS_EPS);
        u32x2* o = (u32x2*)((bf16_t*)(ws + WS_HM) + (size_t)row * D) + lane;
#pragma unroll
        for (int j = 0; j < 4; ++j) { const f32x4 g = gr[64 * j]; u32x2 w; w.x = pk2(v[j].x * r * g.x, v[j].y * r * g.y); w.y = pk2(v[j].z * r * g.z, v[j].w * r * g.w); o[64 * j] = w; }
    }
}

__device__ __forceinline__ void phase_p0b(const Params& p, char* lds) {
    const int tid_ = otid(), lane = tid_ & 63, wid = tid_ >> 6, wm = wid >> 2, wn = wid & 3, fr = lane & 15, fq = lane >> 4;
    const bf16_t* A = (const bf16_t*)(p.ws + WS_HM); const bf16_t* Bt = (const bf16_t*)(p.ws + WS_WKVT);
    float* C = (float*)(p.ws + WS_KVR);
    const int nM = 20, nN = 8;
    for (int t = blockIdx.x; t < nM * nN; t += gridDim.x) {
        const int pm = t % nM, pn = t / nM, m0 = pm * 128, n0 = pn * 256;
        f32x4 acc[4][4];
#pragma unroll
        for (int i = 0; i < 4; ++i)
#pragma unroll
            for (int j = 0; j < 4; ++j) acc[i][j] = (f32x4){0.f, 0.f, 0.f, 0.f};
        gemm_kloop<true, 4>(acc, A + (size_t)m0 * D, D, Bt + (size_t)n0 * D, D, D, lds);
#pragma unroll
        for (int mt = 0; mt < 4; ++mt)
#pragma unroll
            for (int nt = 0; nt < 4; ++nt) {
                const int row = m0 + wm * 64 + mt * 16 + fr, col = n0 + wn * 64 + nt * 16 + fq * 4;
                *(f32x4*)(C + (size_t)row * 2048 + col) = acc[mt][nt];
            }
    }
}

__device__ __forceinline__ void phase_p0c(const Params& p) {
    const int tid_ = otid(), lane = tid_ & 63, wid = tid_ >> 6;
    const float* KV = (const float*)(p.ws + WS_KVR);
    bf16_t* MK = (bf16_t*)(p.ws + WS_MEMK); bf16_t* MV = (bf16_t*)(p.ws + WS_MEMV);
    for (int it = blockIdx.x * 8 + wid; it < 2560 * 4; it += gridDim.x * 8) {
        const int row = it >> 2, h = it & 3, b = row >> 8, m = row & 255;
        const f32x4 kv = *(const f32x4*)(KV + (size_t)row * 2048 + h * 256 + lane * 4);
        const float ss = wave_sum(kv.x * kv.x + kv.y * kv.y + kv.z * kv.z + kv.w * kv.w);
        const float r = rsqrtf(ss * (1.f / 256.f) + RMS_EPS);
        const f32x4 g = *(const f32x4*)(p.in[I_MGK] + lane * 4);
        u32x2 w; w.x = pk2(kv.x * r * g.x, kv.y * r * g.y); w.y = pk2(kv.z * r * g.z, kv.w * r * g.w);
        *(u32x2*)(MK + ((size_t)(b * 4 + h) * 256 + m) * 256 + lane * 4) = w;
        const f32x4 vv = *(const f32x4*)(KV + (size_t)row * 2048 + 1024 + h * 256 + lane * 4);
        const int pos = (m & ~31) + ((m >> 2) & 3) * 8 + ((m >> 4) & 1) * 4 + (m & 3);
        bf16_t* dst = MV + ((size_t)(b * 4 + h) * 256 + lane * 4) * 256 + pos;
        dst[0] = f2bf(vv.x); dst[256] = f2bf(vv.y); dst[512] = f2bf(vv.z); dst[768] = f2bf(vv.w);
    }
}

__device__ __forceinline__ void phase_rmsnorm(const float* X, const float* gain, bf16_t* O, int row0, int nrows) {
    const int tid_ = otid(), lane = tid_ & 63, wid = tid_ >> 6;
    const f32x4* gr = (const f32x4*)launder(gain) + lane;
    f32x4 g[4];
#pragma unroll
    for (int j = 0; j < 4; ++j) g[j] = gr[64 * j];
    f32x4 vn[4];
    { const f32x4* xr = (const f32x4*)(X + (size_t)(row0 + wid) * D) + lane;
#pragma unroll
      for (int j = 0; j < 4; ++j) vn[j] = xr[64 * j]; }
    for (int row = row0 + wid; row < row0 + nrows; row += 8) {
        f32x4 v[4]; float s = 0.f;
#pragma unroll
        for (int j = 0; j < 4; ++j) v[j] = vn[j];
        if (row + 8 < row0 + nrows) { const f32x4* xr = (const f32x4*)(X + (size_t)(row + 8) * D) + lane;
#pragma unroll
            for (int j = 0; j < 4; ++j) vn[j] = xr[64 * j]; }
        __builtin_amdgcn_sched_barrier(0);
#pragma unroll
        for (int j = 0; j < 4; ++j) s += v[j].x * v[j].x + v[j].y * v[j].y + v[j].z * v[j].z + v[j].w * v[j].w;
        const float r = rsqrtf(wave_sum(s) * (1.f / D) + RMS_EPS);
        u32x2* o = (u32x2*)(O + (size_t)row * D) + lane;
#pragma unroll
        for (int j = 0; j < 4; ++j) { u32x2 w; w.x = pk2(v[j].x * r * g[j].x, v[j].y * r * g[j].y); w.y = pk2(v[j].z * r * g[j].z, v[j].w * r * g[j].w); o[64 * j] = w; }
    }
}

__device__ __forceinline__ void phase_inproj(const Params& p, int g, char* lds, int u) {
    const Grp G = get_group(p, g);
    const int tid_ = otid(), lane = tid_ & 63, wid = tid_ >> 6, wm = wid >> 2, wn = wid & 3, fr = lane & 15, fq = lane >> 4;
    const bf16_t* A = (const bf16_t*)(p.ws + WS_HB); const bf16_t* Bt = (const bf16_t*)(p.ws + WS_WINT);
    bf16_t* P = (bf16_t*)(p.ws + WS_PROJ); bf16_t* VT = (bf16_t*)(p.ws + WS_VT);
    const int pm = u >> 1, half = u & 1, m0 = pm * 256;
    for (int pi = 0; pi < (half ? 17 : 12); ++pi) {
        const int pn = half ? 24 + pi : pi; const int n0 = pn * 256;
        f32x4 acc[8][4];
#pragma unroll
        for (int i = 0; i < 8; ++i)
#pragma unroll
            for (int j = 0; j < 4; ++j) acc[i][j] = (f32x4){0.f, 0.f, 0.f, 0.f};
        gemm_kloop<true, 8>(acc, A + (size_t)m0 * D, D, Bt + (size_t)n0 * D, D, D, lds);
        const float sc = n0 < 512 ? 0.08838834764831845f : 1.0f;
#pragma unroll
        for (int mt = 0; mt < 8; ++mt)
#pragma unroll
            for (int nt = 0; nt < 4; ++nt) {
                const int row = m0 + wm * 128 + mt * 16 + fr, col = n0 + wn * 64 + nt * 16 + fq * 4;
                u32x2 w; w.x = pk2(acc[mt][nt].x * sc, acc[mt][nt].y * sc); w.y = pk2(acc[mt][nt].z * sc, acc[mt][nt].w * sc);
                *(u32x2*)(P + (size_t)row * NP + col) = w;
            }
    }
    if (half == 0) for (int pn = 12; pn < 20; ++pn) {
        const int n0 = pn * 256;
        f32x4 acc[8][4];
#pragma unroll
        for (int i = 0; i < 8; ++i)
#pragma unroll
            for (int j = 0; j < 4; ++j) acc[i][j] = (f32x4){0.f, 0.f, 0.f, 0.f};
        gemm_kloop<true, 8>(acc, A + (size_t)m0 * D, D, Bt + (size_t)n0 * D, D, D, lds);
        const int te_ = otid(), fr = te_ & 15, fq = (te_ >> 4) & 3, wm = te_ >> 8, wn = (te_ >> 6) & 3;
        const bool isk = n0 >= C_DK;
        const float* gn = launder(p.in[isk ? I_DGK : I_DGQ]) + fq * 4;
        const float qs = isk ? 1.0f : 0.125f * LOG2E;
        const float* ROPE = (const float*)(p.ws + WS_ROPE);
        const int tq0 = m0 % G.T + wm * 128 + fr;
#pragma unroll
        for (int mt = 0; mt < 8; ++mt) {
            const int row = m0 + wm * 128 + mt * 16 + fr, t = tq0 + mt * 16;
            float ss = 0.f;
#pragma unroll
            for (int nt = 0; nt < 4; ++nt) ss += acc[mt][nt].x * acc[mt][nt].x + acc[mt][nt].y * acc[mt][nt].y + acc[mt][nt].z * acc[mt][nt].z + acc[mt][nt].w * acc[mt][nt].w;
            ss += sxor<16>(ss); ss += sxor<32>(ss);
            const float r = rsqrtf(ss * (1.f / 64.f) + RMS_EPS) * qs;
            const float* rp = ROPE + (size_t)t * 64 + fq * 4;
            bf16_t* dst = P + (size_t)row * NP + n0 + wn * 64 + fq * 4;
#pragma unroll
            for (int hh = 0; hh < 2; ++hh) {
                const f32x4 cs = *(const f32x4*)(rp + hh * 16), sn = *(const f32x4*)(rp + 32 + hh * 16);
                const f32x4 ya = acc[mt][hh] * *(const f32x4*)(gn + hh * 16) * r, yb = acc[mt][hh + 2] * *(const f32x4*)(gn + 32 + hh * 16) * r;
                const f32x4 oa = ya * cs - yb * sn, ob = yb * cs + ya * sn;
                *(u32x2*)(dst + hh * 16) = (u32x2){pk2(oa.x, oa.y), pk2(oa.z, oa.w)};
                *(u32x2*)(dst + 32 + hh * 16) = (u32x2){pk2(ob.x, ob.y), pk2(ob.z, ob.w)};
            }
        }
    }
    for (int pn = half ? 21 : 20; pn < (half ? 24 : 21); ++pn) {
        const int n0 = pn * 256;
        f32x4 acc[8][4];
#pragma unroll
        for (int i = 0; i < 8; ++i)
#pragma unroll
            for (int j = 0; j < 4; ++j) acc[i][j] = (f32x4){0.f, 0.f, 0.f, 0.f};
        gemm_kloop<false, 8>(acc, A + (size_t)m0 * D, D, Bt + (size_t)n0 * D, D, D, lds);
        const int b = m0 / G.T, t0 = m0 % G.T + wm * 128;
#pragma unroll
        for (int mt = 0; mt < 8; ++mt)
#pragma unroll
            for (int nt = 0; nt < 4; ++nt) {
                const int n = n0 - C_DV + wn * 64 + nt * 16 + fr, h = n >> 7, dv = n & 127;
                const int pos = t0 + (mt >> 1) * 32 + fq * 8 + (mt & 1) * 4;
                u32x2 w; w.x = pk2(acc[mt][nt].x, acc[mt][nt].y); w.y = pk2(acc[mt][nt].z, acc[mt][nt].w);
                *(u32x2*)(VT + ((size_t)((b * 8 + h) * 128 + dv)) * G.T + pos) = w;
            }
    }
}

__device__ __forceinline__ void phase_qkrope(const Params& p, int g, int tok0, int ntok) {
    const Grp G = get_group(p, g);
    const int tid_ = otid(), lane = tid_ & 63, wid = tid_ >> 6, grp = lane >> 2, sub = lane & 3;
    bf16_t* P = (bf16_t*)(p.ws + WS_PROJ); const float* ROPE = (const float*)(p.ws + WS_ROPE);
    for (int it = tok0 * 2 + wid; it < (tok0 + ntok) * 2; it += 8) {
        const int tok = it >> 1, isk = it & 1, t = tok % G.T;
        bf16_t* base = P + (size_t)tok * NP + (isk ? C_DK : C_DQ) + grp * 64 + sub * 8;
        const u32x4 a = *(const u32x4*)base, b = *(const u32x4*)(base + 32);
        float x1[8], x2[8];
        x1[0] = bflo(a.x); x1[1] = bfhi(a.x); x1[2] = bflo(a.y); x1[3] = bfhi(a.y); x1[4] = bflo(a.z); x1[5] = bfhi(a.z); x1[6] = bflo(a.w); x1[7] = bfhi(a.w);
        x2[0] = bflo(b.x); x2[1] = bfhi(b.x); x2[2] = bflo(b.y); x2[3] = bfhi(b.y); x2[4] = bflo(b.z); x2[5] = bfhi(b.z); x2[6] = bflo(b.w); x2[7] = bfhi(b.w);
        float ss = 0.f;
#pragma unroll
        for (int e = 0; e < 8; ++e) ss += x1[e] * x1[e] + x2[e] * x2[e];
        ss += sxor<1>(ss); ss += sxor<2>(ss);
        const float r = rsqrtf(ss * (1.f / 64.f) + RMS_EPS) * (isk ? 1.0f : 0.125f * LOG2E);
        const float* gn = p.in[isk ? I_DGK : I_DGQ] + sub * 8;
        const float* rp = ROPE + (size_t)t * 64 + sub * 8;
        float o1[8], o2[8];
#pragma unroll
        for (int e = 0; e < 8; ++e) {
            const float y1 = x1[e] * r * gn[e], y2 = x2[e] * r * gn[32 + e], c = rp[e], s = rp[32 + e];
            o1[e] = y1 * c - y2 * s; o2[e] = y2 * c + y1 * s;
        }
        u32x4 w1, w2;
        w1.x = pk2(o1[0], o1[1]); w1.y = pk2(o1[2], o1[3]); w1.z = pk2(o1[4], o1[5]); w1.w = pk2(o1[6], o1[7]);
        w2.x = pk2(o2[0], o2[1]); w2.y = pk2(o2[2], o2[3]); w2.z = pk2(o2[4], o2[5]); w2.w = pk2(o2[6], o2[7]);
        *(u32x4*)base = w1; *(u32x4*)(base + 32) = w2;
    }
}

__device__ __forceinline__ void diff_attn_item(const Params& p, const Grp& G, int item, char* lds, float lam, float shift) {
    const int tid = otid(), lane = tid & 63, wid = tid >> 6, fr = lane & 15, fq = lane >> 4;
    const int c = wid & 1, sub = wid >> 1;
    const int T = G.T, nqb = T / 128;
    const int qb = item % nqb, bh = item / nqb, h = bh & 7, b = bh >> 3;
    bf16_t* P = (bf16_t*)(p.ws + WS_PROJ) + (size_t)b * T * NP;
    const bf16_t* Kg = P + C_DK + h * 128;
    const bf16_t* VTg = (const bf16_t*)(p.ws + WS_VT) + (size_t)bh * 128 * T;
    const int q0 = qb * 128 + sub * 32;
    bf16x8 qf[2][2];
#pragma unroll
    for (int nt = 0; nt < 2; ++nt)
#pragma unroll
        for (int ks = 0; ks < 2; ++ks) qf[nt][ks] = *(const bf16x8*)(P + (size_t)(q0 + nt * 16 + fr) * NP + C_DQ + h * 128 + c * 64 + ks * 32 + fq * 8);
    f32x4 o[8][2];
#pragma unroll
    for (int i = 0; i < 8; ++i) { o[i][0] = (f32x4){0.f, 0.f, 0.f, 0.f}; o[i][1] = (f32x4){0.f, 0.f, 0.f, 0.f}; }
    float l[2] = {0.f, 0.f};
    constexpr int STG = 36864, VOFF = 18432;
    u32x4 rk[2], rv[2];
    const int krow = tid >> 4, kch = tid & 15;
    const int vrow = tid >> 3, vch = tid & 7;
#define AGLOAD(kt) do { const int key0_ = (kt) * 64; \
        _Pragma("unroll") for (int i = 0; i < 2; ++i) rk[i] = *(const u32x4*)(Kg + (size_t)(key0_ + krow + i * 32) * NP + kch * 8); \
        _Pragma("unroll") for (int i = 0; i < 2; ++i) rv[i] = *(const u32x4*)(VTg + (size_t)(vrow + i * 64) * T + key0_ + vch * 8); } while (0)
#define ASWRITE(buf) do { char* b_ = lds + (buf) * STG; \
        _Pragma("unroll") for (int i = 0; i < 2; ++i) *(u32x4*)(b_ + ((kch >> 3) * 64 + krow + i * 32) * 144 + (kch & 7) * 16) = rk[i]; \
        _Pragma("unroll") for (int i = 0; i < 2; ++i) *(u32x4*)(b_ + VOFF + (vrow + i * 64) * 144 + vch * 16) = rv[i]; } while (0)
    const int nkt = T / 64;
#define EXPQ(SRC, NT, DSTP) do { const f32x4 a_ = SRC[0][NT], b_ = SRC[1][NT]; \
        const float p0 = fexp2(a_.x), p1 = fexp2(a_.y), p2 = fexp2(a_.z), p3 = fexp2(a_.w); \
        const float p4 = fexp2(b_.x), p5 = fexp2(b_.y), p6 = fexp2(b_.z), p7 = fexp2(b_.w); \
        l[NT] += ((p0 + p1) + (p2 + p3)) + ((p4 + p5) + (p6 + p7)); \
        u32x4 w_; w_.x = pk2(p0, p1); w_.y = pk2(p2, p3); w_.z = pk2(p4, p5); w_.w = pk2(p6, p7); \
        DSTP[NT] = __builtin_bit_cast(bf16x8, w_); } while (0)
#define SMMA1(DST, I, MT, KBASE) do { \
        const bf16x8 k0_ = *(const bf16x8*)((KBASE) + (c * 64 + (MT) * 16 + fr) * 144 + fq * 16); \
        const bf16x8 k1_ = *(const bf16x8*)((KBASE) + (c * 64 + (MT) * 16 + fr) * 144 + 64 + fq * 16); \
        DST[I][0] = mfma16(k0_, qf[0][0], (f32x4){0.f, 0.f, 0.f, 0.f}); DST[I][1] = mfma16(k0_, qf[1][0], (f32x4){0.f, 0.f, 0.f, 0.f}); \
        DST[I][0] = mfma16(k1_, qf[0][1], DST[I][0]); DST[I][1] = mfma16(k1_, qf[1][1], DST[I][1]); } while (0)
#define PVMMA(DVT, KK, PF, VBASE) do { \
        const bf16x8 vf_ = *(const bf16x8*)((VBASE) + VOFF + ((DVT) * 16 + fr) * 144 + (KK) * 64 + fq * 16); \
        o[DVT][0] = mfma16(vf_, PF[0], o[DVT][0]); o[DVT][1] = mfma16(vf_, PF[1], o[DVT][1]); } while (0)
#define PV8(KK, PF, VBASE) do { PVMMA(0, KK, PF, VBASE); PVMMA(1, KK, PF, VBASE); PVMMA(2, KK, PF, VBASE); PVMMA(3, KK, PF, VBASE); \
        PVMMA(4, KK, PF, VBASE); PVMMA(5, KK, PF, VBASE); PVMMA(6, KK, PF, VBASE); PVMMA(7, KK, PF, VBASE); } while (0)
    f32x4 slo[2][2], shi[2][2];
    bf16x8 pflo[2], pfhi[2];
    pfhi[0] = (bf16x8){0, 0, 0, 0, 0, 0, 0, 0}; pfhi[1] = pfhi[0];
#define KLOAD(KR, MTA, MTB, KBASE) do { \
        KR[0] = *(const bf16x8*)((KBASE) + (c * 64 + (MTA) * 16 + fr) * 144 + fq * 16); KR[1] = *(const bf16x8*)((KBASE) + (c * 64 + (MTA) * 16 + fr) * 144 + 64 + fq * 16); \
        KR[2] = *(const bf16x8*)((KBASE) + (c * 64 + (MTB) * 16 + fr) * 144 + fq * 16); KR[3] = *(const bf16x8*)((KBASE) + (c * 64 + (MTB) * 16 + fr) * 144 + 64 + fq * 16); } while (0)
#define SMMAK(DST, KR) do { \
        DST[0][0] = mfma16(KR[0], qf[0][0], (f32x4){0.f, 0.f, 0.f, 0.f}); DST[0][1] = mfma16(KR[0], qf[1][0], (f32x4){0.f, 0.f, 0.f, 0.f}); \
        DST[1][0] = mfma16(KR[2], qf[0][0], (f32x4){0.f, 0.f, 0.f, 0.f}); DST[1][1] = mfma16(KR[2], qf[1][0], (f32x4){0.f, 0.f, 0.f, 0.f}); \
        DST[0][0] = mfma16(KR[1], qf[0][1], DST[0][0]); DST[0][1] = mfma16(KR[1], qf[1][1], DST[0][1]); \
        DST[1][0] = mfma16(KR[3], qf[0][1], DST[1][0]); DST[1][1] = mfma16(KR[3], qf[1][1], DST[1][1]); } while (0)
#define VLOAD4(VR, D0, KK, VBASE) do { _Pragma("unroll") for (int i_ = 0; i_ < 4; ++i_) VR[i_] = *(const bf16x8*)((VBASE) + VOFF + (((D0) + i_) * 16 + fr) * 144 + (KK) * 64 + fq * 16); } while (0)
#define PV4(VR, D0, PF) do { _Pragma("unroll") for (int i_ = 0; i_ < 4; ++i_) { o[(D0) + i_][0] = mfma16(VR[i_], PF[0], o[(D0) + i_][0]); o[(D0) + i_][1] = mfma16(VR[i_], PF[1], o[(D0) + i_][1]); } } while (0)
#define FENCE() __builtin_amdgcn_sched_barrier(0)
    AGLOAD(0); ASWRITE(0); AGLOAD(1); ASWRITE(1);
    for (int i = tid; i < 18432 / 16; i += NTHR) *(u32x4*)(lds + 3 * STG + VOFF + i * 16) = (u32x4){0u, 0u, 0u, 0u};
    __syncthreads();
    bf16x8 kr[4], va[4], vb[4];
    KLOAD(kr, 0, 1, lds); SMMAK(slo, kr);
    for (int kt = 0; kt < nkt; ++kt) {
        { const int ktl = kt + 2 < nkt ? kt + 2 : nkt - 1; AGLOAD(ktl); }
        const char* cur = lds + (kt & 3) * STG; const char* nxt = lds + ((kt + 1) & 3) * STG; const char* prv = lds + ((kt + 3) & 3) * STG;
        KLOAD(kr, 2, 3, cur); VLOAD4(va, 0, 1, prv);
        FENCE();
        SMMAK(shi, kr); VLOAD4(vb, 4, 1, prv); EXPQ(slo, 0, pflo);
        FENCE();
        PV4(va, 0, pfhi); KLOAD(kr, 0, 1, nxt); EXPQ(slo, 1, pflo);
        FENCE();
        PV4(vb, 4, pfhi); VLOAD4(va, 0, 0, cur);
        FENCE();
        SMMAK(slo, kr); VLOAD4(vb, 4, 0, cur); EXPQ(shi, 0, pfhi);
        FENCE();
        PV4(va, 0, pflo); EXPQ(shi, 1, pfhi);
        FENCE();
        PV4(vb, 4, pflo);
        FENCE();
        ASWRITE((kt + 2) & 3);
        __syncthreads();
    }
    { const char* prv = lds + ((nkt - 1) & 3) * STG; VLOAD4(va, 0, 1, prv); VLOAD4(vb, 4, 1, prv); PV4(va, 0, pfhi); PV4(vb, 4, pfhi); }
    __syncthreads();
#undef KLOAD
#undef SMMAK
#undef VLOAD4
#undef PV4
#undef FENCE
#undef EXPQ
#undef SMMA1
#undef PVMMA
#undef PV8
#undef AGLOAD
#undef ASWRITE
    float inv[2];
#pragma unroll
    for (int nt = 0; nt < 2; ++nt) { float v = l[nt]; v += sxor<16>(v); v += sxor<32>(v); inv[nt] = 1.0f / v; }
    float* xch = (float*)lds + sub * 4096;
    if (c == 1) {
#pragma unroll
        for (int dvt = 0; dvt < 8; ++dvt)
#pragma unroll
            for (int nt = 0; nt < 2; ++nt) {
                xch[(dvt * 16 + fq * 4 + 0) * 32 + nt * 16 + fr] = o[dvt][nt].x * inv[nt];
                xch[(dvt * 16 + fq * 4 + 1) * 32 + nt * 16 + fr] = o[dvt][nt].y * inv[nt];
                xch[(dvt * 16 + fq * 4 + 2) * 32 + nt * 16 + fr] = o[dvt][nt].z * inv[nt];
                xch[(dvt * 16 + fq * 4 + 3) * 32 + nt * 16 + fr] = o[dvt][nt].w * inv[nt];
            }
    }
    __syncthreads();
    if (c == 0) {
        float ss[2] = {0.f, 0.f};
#pragma unroll
        for (int dvt = 0; dvt < 8; ++dvt)
#pragma unroll
            for (int nt = 0; nt < 2; ++nt) {
                f32x4 v = o[dvt][nt] * inv[nt];
                v.x -= lam * xch[(dvt * 16 + fq * 4 + 0) * 32 + nt * 16 + fr];
                v.y -= lam * xch[(dvt * 16 + fq * 4 + 1) * 32 + nt * 16 + fr];
                v.z -= lam * xch[(dvt * 16 + fq * 4 + 2) * 32 + nt * 16 + fr];
                v.w -= lam * xch[(dvt * 16 + fq * 4 + 3) * 32 + nt * 16 + fr];
                o[dvt][nt] = v; ss[nt] += v.x * v.x + v.y * v.y + v.z * v.z + v.w * v.w;
            }
#pragma unroll
        for (int nt = 0; nt < 2; ++nt) {
            float v = ss[nt]; v += sxor<16>(v); v += sxor<32>(v);
            const float r = rsqrtf(v * (1.f / 128.f) + RMS_EPS) * 0.8f;
#pragma unroll
            for (int dvt = 0; dvt < 8; ++dvt) {
                const f32x4 gs = *(const f32x4*)(p.in[I_DGSUB] + dvt * 16 + fq * 4);
                const f32x4 v4 = o[dvt][nt];
                u32x2 w; w.x = pk2(v4.x * r * gs.x, v4.y * r * gs.y); w.y = pk2(v4.z * r * gs.z, v4.w * r * gs.w);
                *(u32x2*)(P + (size_t)(q0 + nt * 16 + fr) * NP + C_DQ + h * 128 + dvt * 16 + fq * 4) = w;
            }
        }
    }
    __syncthreads();
}

__device__ __forceinline__ void mem_attn_item(const Params& p, const Grp& G, int item, char* lds, float shift) {
    const int tid = otid(), lane = tid & 63, wid = tid >> 6, fr = lane & 15, fq = lane >> 4;
    const int T = G.T, nqb = T / 128;
    const int qb = item % nqb, bh = item / nqb, h = bh & 3, b = bh >> 2;
    bf16_t* P = (bf16_t*)(p.ws + WS_PROJ) + (size_t)b * T * NP;
    const bf16_t* MK = (const bf16_t*)(p.ws + WS_MEMK) + (size_t)((G.mb0 + b) * 4 + h) * 256 * 256;
    const bf16_t* MV = (const bf16_t*)(p.ws + WS_MEMV) + (size_t)((G.mb0 + b) * 4 + h) * 256 * 256;
    const int row = qb * 128 + wid * 16 + fr;
    bf16_t* qp = P + (size_t)row * NP + C_MQ + h * 256;
    bf16x8 qf[8];
    {
        float ss = 0.f; u32x4 raw[8];
#pragma unroll
        for (int ks = 0; ks < 8; ++ks) { raw[ks] = *(const u32x4*)(qp + ks * 32 + fq * 8);
            const float a0 = bflo(raw[ks].x), a1 = bfhi(raw[ks].x), a2 = bflo(raw[ks].y), a3 = bfhi(raw[ks].y), a4 = bflo(raw[ks].z), a5 = bfhi(raw[ks].z), a6 = bflo(raw[ks].w), a7 = bfhi(raw[ks].w);
            ss += a0 * a0 + a1 * a1 + a2 * a2 + a3 * a3 + a4 * a4 + a5 * a5 + a6 * a6 + a7 * a7; }
        ss += sxor<16>(ss); ss += sxor<32>(ss);
        const float r = rsqrtf(ss * (1.f / 256.f) + RMS_EPS) * (0.0625f * LOG2E);
#pragma unroll
        for (int ks = 0; ks < 8; ++ks) {
            const f32x4 g0 = *(const f32x4*)(p.in[I_MGQ] + ks * 32 + fq * 8), g1 = *(const f32x4*)(p.in[I_MGQ] + ks * 32 + fq * 8 + 4);
            u32x4 w;
            w.x = pk2(bflo(raw[ks].x) * r * g0.x, bfhi(raw[ks].x) * r * g0.y); w.y = pk2(bflo(raw[ks].y) * r * g0.z, bfhi(raw[ks].y) * r * g0.w);
            w.z = pk2(bflo(raw[ks].z) * r * g1.x, bfhi(raw[ks].z) * r * g1.y); w.w = pk2(bflo(raw[ks].w) * r * g1.z, bfhi(raw[ks].w) * r * g1.w);
            qf[ks] = __builtin_bit_cast(bf16x8, w);
        }
    }
    f32x4 o[16];
#pragma unroll
    for (int i = 0; i < 16; ++i) o[i] = (f32x4){0.f, 0.f, 0.f, 0.f};
    float l = 0.f;
    constexpr int KROW = 528, VOFF = 64 * 528;
    u32x4 mk[4], mv[4];
#define MLOAD(KT) do { _Pragma("unroll") for (int i = 0; i < 4; ++i) { const int idx = tid + i * 512; \
        mk[i] = *(const u32x4*)(MK + (size_t)((KT) * 64 + (idx >> 5)) * 256 + (idx & 31) * 8); mv[i] = *(const u32x4*)(MV + (size_t)(idx >> 3) * 256 + (KT) * 64 + (idx & 7) * 8); } } while (0)
    MLOAD(0);
    for (int kt = 0; kt < 4; ++kt) {
#pragma unroll
        for (int i = 0; i < 4; ++i) {
            const int idx = tid + i * 512;
            *(u32x4*)(lds + (idx >> 5) * KROW + (idx & 31) * 16) = mk[i];
            *(u32x4*)(lds + VOFF + (idx >> 3) * 144 + (idx & 7) * 16) = mv[i];
        }
        __syncthreads();
        if (kt + 1 < 4) MLOAD(kt + 1);
        __builtin_amdgcn_sched_barrier(0);
        f32x4 s[4];
#pragma unroll
        for (int mt = 0; mt < 4; ++mt) s[mt] = (f32x4){0.f, 0.f, 0.f, 0.f};
#pragma unroll
        for (int ks = 0; ks < 8; ks += 2) {
            bf16x8 kf[8];
#pragma unroll
            for (int u = 0; u < 8; ++u) kf[u] = *(const bf16x8*)(lds + ((u & 3) * 16 + fr) * KROW + (ks + (u >> 2)) * 64 + fq * 16);
            __builtin_amdgcn_sched_barrier(0);
#pragma unroll
            for (int u = 0; u < 8; ++u) s[u & 3] = mfma16(kf[u], qf[ks + (u >> 2)], s[u & 3]);
        }
        bf16x8 pf[2];
#pragma unroll
        for (int kk = 0; kk < 2; ++kk) {
            const f32x4 a = s[2 * kk], bb = s[2 * kk + 1];
            const float p0 = fexp2(a.x), p1 = fexp2(a.y), p2 = fexp2(a.z), p3 = fexp2(a.w);
            const float p4 = fexp2(bb.x), p5 = fexp2(bb.y), p6 = fexp2(bb.z), p7 = fexp2(bb.w);
            l += ((p0 + p1) + (p2 + p3)) + ((p4 + p5) + (p6 + p7));
            u32x4 w; w.x = pk2(p0, p1); w.y = pk2(p2, p3); w.z = pk2(p4, p5); w.w = pk2(p6, p7);
            pf[kk] = __builtin_bit_cast(bf16x8, w);
        }
#pragma unroll
        for (int kk = 0; kk < 2; ++kk)
#pragma unroll
            for (int d0 = 0; d0 < 16; d0 += 8) {
                bf16x8 vf[8];
#pragma unroll
                for (int u = 0; u < 8; ++u) vf[u] = *(const bf16x8*)(lds + VOFF + ((d0 + u) * 16 + fr) * 144 + kk * 64 + fq * 16);
                __builtin_amdgcn_sched_barrier(0);
#pragma unroll
                for (int u = 0; u < 8; ++u) o[d0 + u] = mfma16(vf[u], pf[kk], o[d0 + u]);
            }
        __syncthreads();
    }
#undef MLOAD
    l += sxor<16>(l); l += sxor<32>(l);
    const float inv = 1.0f / l;
#pragma unroll
    for (int dvt = 0; dvt < 16; ++dvt) {
        u32x2 w; w.x = pk2(o[dvt].x * inv, o[dvt].y * inv); w.y = pk2(o[dvt].z * inv, o[dvt].w * inv);
        *(u32x2*)(qp + dvt * 16 + fq * 4) = w;
    }
}

constexpr int L_QE = 0, L_KE = 17408, L_KST = 34816, L_VTL = 53248, L_ATT = 71680, L_SB = 80896, L_LRF = 115712, L_TOT = 119808, L_GDEC = 121856;
__device__ __forceinline__ void gla_item(const Params& p, const Grp& G, int item, char* lds) {
    const int tid = otid(), lane = tid & 63, wid = tid >> 6, fr = lane & 15, fq = lane >> 4;
    const int slice = item & 1, dir = (item >> 1) & 1, h = (item >> 2) & 3, b = item >> 4;
    const int T = G.T, N = T / 64;
    const bf16_t* P = (const bf16_t*)(p.ws + WS_PROJ) + (size_t)b * T * NP;
    bf16_t* OUT = dir ? (bf16_t*)(p.ws + WS_PROJ) + (size_t)b * T * NP + C_DV + h * 256 + slice * 128
                      : (bf16_t*)(p.ws + WS_HB) + (size_t)b * T * D + h * 256 + slice * 128;
    const int ldo = dir ? NP : D;
    const int amt = wid & 3, antg = wid >> 2;
    bf16x8 wdB[4]; float bd4[4];
    {
        const float* wd = p.in[dir ? I_WDB : I_WDF]; const float* bdp = p.in[dir ? I_BDB : I_BDF];
#pragma unroll
        for (int q = 0; q < 4; ++q) {
            const int col = h * 128 + (antg * 4 + q) * 16 + fr;
            u32x4 w = (u32x4){0u, 0u, 0u, 0u};
            if (fq < 2) { const float* wp = wd + (size_t)(fq * 8) * 512 + col;
                w.x = pk2(wp[0], wp[512]); w.y = pk2(wp[1024], wp[1536]); w.z = pk2(wp[2048], wp[2560]); w.w = pk2(wp[3072], wp[3584]); }
            wdB[q] = __builtin_bit_cast(bf16x8, w);
            bd4[q] = bdp[col];
        }
    }
    { unsigned z = 0u; asm volatile("" : "+v"(z)); for (int i = tid; i < 34816 / 16; i += NTHR) *(u32x4*)(lds + L_SB + i * 16) = (u32x4){z, z, z, z}; }
    f32x4 S[8];
#pragma unroll
    for (int i = 0; i < 8; ++i) S[i] = (f32x4){0.f, 0.f, 0.f, 0.f};
    u32x4 rq[2], rk[2], rv[2], rl;
    const int lrow = tid >> 4, lch = tid & 15;
#define GGLOAD(n) do { const int cb_ = (dir ? (N - 1 - (n)) : (n)) * 64; \
        _Pragma("unroll") for (int i = 0; i < 2; ++i) { const int li_ = lrow + i * 32, tk_ = cb_ + (dir ? 63 - li_ : li_); const bf16_t* rp_ = P + (size_t)tk_ * NP; \
            rq[i] = *(const u32x4*)(rp_ + C_GQ + h * 128 + lch * 8); rk[i] = *(const u32x4*)(rp_ + C_GK + h * 128 + lch * 8); rv[i] = *(const u32x4*)(rp_ + C_GV + h * 256 + slice * 128 + lch * 8); } \
        if (tid < 128) { const int li_ = tid >> 1, tk_ = cb_ + (dir ? 63 - li_ : li_); rl = *(const u32x4*)(P + (size_t)tk_ * NP + C_LR + dir * 16 + (tid & 1) * 8); } } while (0)
    GGLOAD(0);
    for (int n = 0; n < N; ++n) {
#pragma unroll
        for (int i = 0; i < 2; ++i) {
            const int li = lrow + i * 32;
            *(u32x4*)(lds + L_QE + li * 272 + lch * 16) = rq[i];
            *(u32x4*)(lds + L_KE + li * 272 + lch * 16) = rk[i];
            bf16_t* vt = (bf16_t*)(lds + L_VTL) + (lch * 8) * 72 + li;
            vt[0 * 72] = (bf16_t)(rv[i].x & 0xffff); vt[1 * 72] = (bf16_t)(rv[i].x >> 16); vt[2 * 72] = (bf16_t)(rv[i].y & 0xffff); vt[3 * 72] = (bf16_t)(rv[i].y >> 16);
            vt[4 * 72] = (bf16_t)(rv[i].z & 0xffff); vt[5 * 72] = (bf16_t)(rv[i].z >> 16); vt[6 * 72] = (bf16_t)(rv[i].w & 0xffff); vt[7 * 72] = (bf16_t)(rv[i].w >> 16);
        }
        if (tid < 128) *(u32x4*)(lds + L_LRF + (tid >> 1) * 32 + (tid & 1) * 16) = rl;
        if (n + 1 < N) GGLOAD(n + 1);
        __syncthreads();
        {
            u32x4 araw = (u32x4){0u, 0u, 0u, 0u};
            if (fq < 2) araw = *(const u32x4*)(lds + L_LRF + (amt * 16 + fr) * 32 + fq * 16);
            const bf16x8 afr = __builtin_bit_cast(bf16x8, araw);
            float pb[4][4]; float E[4], tt[4];
#pragma unroll
            for (int q = 0; q < 4; ++q) {
                const f32x4 x4 = mfma16(afr, wdB[q], (f32x4){bd4[q], bd4[q], bd4[q], bd4[q]});
                float run = 0.f;
#pragma unroll
                for (int j = 0; j < 4; ++j) {
                    const float x = x4[j];
                    const float ls = fminf(x, 0.f) - __logf(1.0f + __expf(-fabsf(x)));
                    run += ls * 0.0625f; pb[q][j] = run;
                }
                const float u = sxor<16>(run), v = run + u, w2 = sxor<32>(v);
                E[q] = ((fq & 1) ? u : 0.f) + ((fq & 2) ? w2 : 0.f);
                tt[q] = v + w2;
                if (fq == 0) ((float*)(lds + L_TOT))[amt * 128 + (antg * 4 + q) * 16 + fr] = tt[q];
            }
            __syncthreads();
#pragma unroll
            for (int q = 0; q < 4; ++q) {
                const int col = (antg * 4 + q) * 16 + fr;
                float off = 0.f, blast = 0.f;
#pragma unroll
                for (int r = 0; r < 4; ++r) { const float tv = ((const float*)(lds + L_TOT))[r * 128 + col]; blast += tv; if (r < amt) off += tv; }
                const float gcol = __expf(blast);
                bf16_t* qe = (bf16_t*)(lds + L_QE) + (amt * 16 + fq * 4) * 136 + col; bf16_t* ke = (bf16_t*)(lds + L_KE) + (amt * 16 + fq * 4) * 136 + col;
                float ksv[4];
#pragma unroll
                for (int j = 0; j < 4; ++j) {
                    const float bb = off + E[q] + pb[q][j];
                    const float qv = bf2f(qe[j * 136]), kv = bf2f(ke[j * 136]);
                    const float kd = kv * __expf(-bb);
                    qe[j * 136] = f2bf(qv * __expf(bb)); ke[j * 136] = f2bf(kd);
                    ksv[j] = kd * gcol;
                }
                *(u32x2*)(lds + L_KST + col * 144 + (amt * 16 + fq * 4) * 2) = (u32x2){pk2(ksv[0], ksv[1]), pk2(ksv[2], ksv[3])};
                if (amt == 0 && fq == 0) ((float*)(lds + L_GDEC))[col] = gcol;
            }
        }
        __syncthreads();
        {
            const int ct = wid & 3;
            f32x4 a[2] = {(f32x4){0.f, 0.f, 0.f, 0.f}, (f32x4){0.f, 0.f, 0.f, 0.f}};
            bf16x8 qv[4], kv[2][4];
#pragma unroll
            for (int ks = 0; ks < 4; ++ks) {
                qv[ks] = *(const bf16x8*)(lds + L_QE + (ct * 16 + fr) * 272 + ks * 64 + fq * 16);
#pragma unroll
                for (int j = 0; j < 2; ++j) kv[j][ks] = *(const bf16x8*)(lds + L_KE + (((wid >> 2) * 2 + j) * 16 + fr) * 272 + ks * 64 + fq * 16);
            }
            __builtin_amdgcn_sched_barrier(0);
#pragma unroll
            for (int ks = 0; ks < 4; ++ks)
#pragma unroll
                for (int j = 0; j < 2; ++j) a[j] = mfma16(kv[j][ks], qv[ks], a[j]);
#pragma unroll
            for (int j = 0; j < 2; ++j) {
                const int st = (wid >> 2) * 2 + j, cc = ct * 16 + fr, s0 = st * 16 + fq * 4;
                const float v0 = (s0 + 0 <= cc) ? a[j].x : 0.f, v1 = (s0 + 1 <= cc) ? a[j].y : 0.f, v2 = (s0 + 2 <= cc) ? a[j].z : 0.f, v3 = (s0 + 3 <= cc) ? a[j].w : 0.f;
                *(u32x2*)(lds + L_ATT + cc * 144 + s0 * 2) = (u32x2){pk2(v0, v1), pk2(v2, v3)};
            }
        }
        __syncthreads();
        {
            f32x4 oc[4] = {(f32x4){0.f, 0.f, 0.f, 0.f}, (f32x4){0.f, 0.f, 0.f, 0.f}, (f32x4){0.f, 0.f, 0.f, 0.f}, (f32x4){0.f, 0.f, 0.f, 0.f}};
            bf16x8 fa[2], fb[2][4], ga[2], gb[2][4];
#define LD_VA(FA, FB) do { _Pragma("unroll") for (int ks = 0; ks < 2; ++ks) { FA[ks] = *(const bf16x8*)(lds + L_VTL + (wid * 16 + fr) * 144 + ks * 64 + fq * 16); \
                _Pragma("unroll") for (int ct = 0; ct < 4; ++ct) FB[ks][ct] = *(const bf16x8*)(lds + L_ATT + (ct * 16 + fr) * 144 + ks * 64 + fq * 16); } } while (0)
#define LD_SQ(FA, FB, K0) do { _Pragma("unroll") for (int ks = 0; ks < 2; ++ks) { FA[ks] = *(const bf16x8*)(lds + L_SB + (wid * 16 + fr) * 272 + ((K0) + ks) * 64 + fq * 16); \
                _Pragma("unroll") for (int ct = 0; ct < 4; ++ct) FB[ks][ct] = *(const bf16x8*)(lds + L_QE + (ct * 16 + fr) * 272 + ((K0) + ks) * 64 + fq * 16); } } while (0)
#define MM10(FA, FB) do { _Pragma("unroll") for (int ks = 0; ks < 2; ++ks) _Pragma("unroll") for (int ct = 0; ct < 4; ++ct) oc[ct] = mfma16(FA[ks], FB[ks][ct], oc[ct]); } while (0)
            LD_VA(fa, fb); LD_SQ(ga, gb, 0);
            __builtin_amdgcn_sched_barrier(0);
            MM10(fa, fb); LD_SQ(fa, fb, 2);
            __builtin_amdgcn_sched_barrier(0);
            MM10(ga, gb);
            __builtin_amdgcn_sched_barrier(0);
            MM10(fa, fb);
#undef LD_VA
#undef LD_SQ
#undef MM10
            const int cb = (dir ? (N - 1 - n) : n) * 64;
#pragma unroll
            for (int ct = 0; ct < 4; ++ct) {
                const int cl = ct * 16 + fr, tk = cb + (dir ? 63 - cl : cl);
                *(u32x2*)(OUT + (size_t)tk * ldo + wid * 16 + fq * 4) = (u32x2){pk2(oc[ct].x, oc[ct].y), pk2(oc[ct].z, oc[ct].w)};
            }
        }
        __syncthreads();
        {
            const f32x4 gd = *(const f32x4*)((const float*)(lds + L_GDEC) + wid * 16 + fq * 4);
#pragma unroll
            for (int et = 0; et < 8; ++et) S[et] = S[et] * gd;
            bf16x8 da[2], db[2][8];
#pragma unroll
            for (int ks = 0; ks < 2; ++ks) {
                da[ks] = *(const bf16x8*)(lds + L_KST + (wid * 16 + fr) * 144 + ks * 64 + fq * 16);
#pragma unroll
                for (int et = 0; et < 8; ++et) db[ks][et] = *(const bf16x8*)(lds + L_VTL + (et * 16 + fr) * 144 + ks * 64 + fq * 16);
            }
            __builtin_amdgcn_sched_barrier(0);
#pragma unroll
            for (int ks = 0; ks < 2; ++ks)
#pragma unroll
                for (int et = 0; et < 8; ++et) S[et] = mfma16(da[ks], db[ks][et], S[et]);
#pragma unroll
            for (int et = 0; et < 8; ++et)
                *(u32x2*)(lds + L_SB + (et * 16 + fr) * 272 + (wid * 16 + fq * 4) * 2) = (u32x2){pk2(S[et].x, S[et].y), pk2(S[et].z, S[et].w)};
        }
        __syncthreads();
    }
#undef GGLOAD
}

__device__ __forceinline__ void phase_mixer(const Params& p, int g, char* lds, int* s_item) {
    const Grp G = get_group(p, g);
    const int nGLA = G.B * 16, nATT = G.B * 8 * (G.T / 128), nMEM = G.B * 4 * (G.T / 128);
    unsigned* ctr = (unsigned*)(p.ws + WS_CTRL) + g * 4;
    for (;;) {
        if (threadIdx.x == 0) *s_item = (int)atomicAdd(ctr + 0, 1u);
        __syncthreads();
        const int it = *s_item;
        __syncthreads();
        if (it >= nGLA) break;
        gla_item(p, G, it, lds);
    }
    {
        float d1 = 0.f, d2 = 0.f;
        for (int i = 0; i < 64; ++i) { d1 += p.in[I_LQ1][i] * p.in[I_LK1][i]; d2 += p.in[I_LQ2][i] * p.in[I_LK2][i]; }
        const float lam = expf(d1) - expf(d2) + 0.2f;
        for (;;) {
            if (threadIdx.x == 0) *s_item = (int)atomicAdd(ctr + 1, 1u);
            __syncthreads();
            const int it = *s_item;
            __syncthreads();
            if (it >= nATT) break;
            diff_attn_item(p, G, it, lds, lam, 0.f);
        }
    }
    for (;;) {
        if (threadIdx.x == 0) *s_item = (int)atomicAdd(ctr + 2, 1u);
        __syncthreads();
        const int it = *s_item;
        __syncthreads();
        if (it >= nMEM) break;
        mem_attn_item(p, G, it, lds, 0.f);
    }
}

__device__ __forceinline__ void phase_glafin(const Params& p, int g, int tok0, int ntok) {
    const int tid_ = otid(), lane = tid_ & 63, wid = tid_ >> 6;
    bf16_t* P = (bf16_t*)(p.ws + WS_PROJ); const bf16_t* F = (const bf16_t*)(p.ws + WS_HB);
    unsigned qq, kk; u32x2 f, bk, v, gt;
#define GFLOAD(IT) do { const int tok_ = (IT) >> 2, h_ = (IT) & 3; const bf16_t* row_ = P + (size_t)tok_ * NP; \
        qq = *(const unsigned*)(row_ + C_GQ + h_ * 128 + lane * 2); kk = *(const unsigned*)(row_ + C_GK + h_ * 128 + lane * 2); \
        f = *(const u32x2*)(F + (size_t)tok_ * D + h_ * 256 + lane * 4); bk = *(const u32x2*)(row_ + C_DV + h_ * 256 + lane * 4); \
        v = *(const u32x2*)(row_ + C_GV + h_ * 256 + lane * 4); gt = *(const u32x2*)(row_ + C_GG + h_ * 256 + lane * 4); } while (0)
    const f32x4 go = *(const f32x4*)(launder(p.in[I_GOUT]) + lane * 4);
    GFLOAD(tok0 * 4 + wid);
    for (int it = tok0 * 4 + wid; it < (tok0 + ntok) * 4; it += 8) {
        const int tok = it >> 2, h = it & 3;
        bf16_t* row = P + (size_t)tok * NP;
        const unsigned cq = qq, ck = kk; const u32x2 cf = f, cbk = bk, cv = v, cgt = gt;
        if (it + 8 < (tok0 + ntok) * 4) GFLOAD(it + 8);
        __builtin_amdgcn_sched_barrier(0);
        const float qk = wave_sum(bflo(cq) * bflo(ck) + bfhi(cq) * bfhi(ck));
        float o0 = bflo(cf.x) + bflo(cbk.x) - qk * bflo(cv.x), o1 = bfhi(cf.x) + bfhi(cbk.x) - qk * bfhi(cv.x);
        float o2 = bflo(cf.y) + bflo(cbk.y) - qk * bflo(cv.y), o3 = bfhi(cf.y) + bfhi(cbk.y) - qk * bfhi(cv.y);
        const float r = rsqrtf(wave_sum(o0 * o0 + o1 * o1 + o2 * o2 + o3 * o3) * (1.f / 256.f) + RMS_EPS);
        const float g0 = bflo(cgt.x), g1 = bfhi(cgt.x), g2 = bflo(cgt.y), g3 = bfhi(cgt.y);
        o0 *= r * go.x * g0 * __builtin_amdgcn_rcpf(1.f + __expf(-g0)); o1 *= r * go.y * g1 * __builtin_amdgcn_rcpf(1.f + __expf(-g1));
        o2 *= r * go.z * g2 * __builtin_amdgcn_rcpf(1.f + __expf(-g2)); o3 *= r * go.w * g3 * __builtin_amdgcn_rcpf(1.f + __expf(-g3));
        *(u32x2*)(row + C_GG + h * 256 + lane * 4) = (u32x2){pk2(o0, o1), pk2(o2, o3)};
    }
#undef GFLOAD
}

__device__ __forceinline__ void phase_merge(const Params& p, int g, char* lds, int u) {
    const int tid_ = otid(), lane = tid_ & 63, wid = tid_ >> 6, wm = wid >> 2, wn = wid & 3, fr = lane & 15, fq = lane >> 4;
    const bf16_t* P = (const bf16_t*)(p.ws + WS_PROJ); bf16_t* M = (bf16_t*)(p.ws + WS_VT);
    for (int pn = 0; pn < 4; ++pn) {
        const int m0 = u * 128, n0 = pn * 256;
        f32x4 macc[4][4];
#pragma unroll
        for (int i = 0; i < 4; ++i)
#pragma unroll
            for (int j = 0; j < 4; ++j) macc[i][j] = (f32x4){0.f, 0.f, 0.f, 0.f};
        for (int br = 0; br < 3; ++br) {
            f32x4 acc[4][4];
#pragma unroll
            for (int i = 0; i < 4; ++i)
#pragma unroll
                for (int j = 0; j < 4; ++j) acc[i][j] = (f32x4){0.f, 0.f, 0.f, 0.f};
            const int acol = br == 0 ? C_GG : (br == 1 ? C_DQ : C_MQ);
            gemm_kloop<true, 4>(acc, P + (size_t)m0 * NP + acol, NP, (const bf16_t*)(p.ws + WS_WOT) + (size_t)br * D * D + (size_t)n0 * D, D, D, lds);
#pragma unroll
            for (int mt = 0; mt < 4; ++mt)
#pragma unroll
                for (int nt = 0; nt < 4; ++nt) {
                    const int row = m0 + wm * 64 + mt * 16 + fr, col = n0 + wn * 64 + nt * 16 + fq * 4;
                    const u32x2 gt = *(const u32x2*)(P + (size_t)row * NP + C_BG + br * 1024 + col);
                    f32x4 sg; sg.x = __builtin_amdgcn_rcpf(1.f + __expf(-bflo(gt.x))); sg.y = __builtin_amdgcn_rcpf(1.f + __expf(-bfhi(gt.x))); sg.z = __builtin_amdgcn_rcpf(1.f + __expf(-bflo(gt.y))); sg.w = __builtin_amdgcn_rcpf(1.f + __expf(-bfhi(gt.y)));
                    macc[mt][nt] += sg * acc[mt][nt];
                }
        }
#pragma unroll
        for (int mt = 0; mt < 4; ++mt)
#pragma unroll
            for (int nt = 0; nt < 4; ++nt) {
                const int row = m0 + wm * 64 + mt * 16 + fr, col = n0 + wn * 64 + nt * 16 + fq * 4;
                *(u32x2*)(M + (size_t)row * D + col) = (u32x2){pk2(macc[mt][nt].x, macc[mt][nt].y), pk2(macc[mt][nt].z, macc[mt][nt].w)};
            }
    }
}

__device__ __forceinline__ void phase_outproj(const Params& p, int g, char* lds, int u) {
    const Grp G = get_group(p, g);
    const int tid_ = otid(), lane = tid_ & 63, wid = tid_ >> 6, wm = wid >> 2, wn = wid & 3, fr = lane & 15, fq = lane >> 4;
    const bf16_t* M = (const bf16_t*)(p.ws + WS_VT); const bf16_t* W = (const bf16_t*)(p.ws + WS_WOT) + (size_t)3 * D * D;
    for (int pn = 0; pn < 4; ++pn) {
        const int m0 = u * 128, n0 = pn * 256;
        f32x4 acc[4][4];
#pragma unroll
        for (int i = 0; i < 4; ++i)
#pragma unroll
            for (int j = 0; j < 4; ++j) acc[i][j] = (f32x4){0.f, 0.f, 0.f, 0.f};
        gemm_kloop<true, 4>(acc, M + (size_t)m0 * D, D, W + (size_t)n0 * D, D, D, lds);
#pragma unroll
        for (int mt = 0; mt < 4; ++mt)
#pragma unroll
            for (int nt = 0; nt < 4; ++nt) {
                const int row = m0 + wm * 64 + mt * 16 + fr, col = n0 + wn * 64 + nt * 16 + fq * 4;
                const f32x4 xv = *(const f32x4*)(G.x + (size_t)row * D + col);
                *(f32x4*)(G.out + (size_t)row * D + col) = xv + acc[mt][nt];
            }
    }
}

__device__ __forceinline__ void phase_peerq(const Params& p, int g, char* lds, int u) {
    const int tid_ = otid(), lane = tid_ & 63, wid = tid_ >> 6, wm = wid >> 2, wn = wid & 3, fr = lane & 15, fq = lane >> 4;
    const bf16_t* A = (const bf16_t*)(p.ws + WS_HB); const bf16_t* W = (const bf16_t*)(p.ws + WS_WQT); bf16_t* P = (bf16_t*)(p.ws + WS_PROJ);
    for (int pn = 0; pn < 8; ++pn) {
        const int m0 = u * 128, n0 = pn * 256;
        f32x4 acc[4][4];
#pragma unroll
        for (int i = 0; i < 4; ++i)
#pragma unroll
            for (int j = 0; j < 4; ++j) acc[i][j] = (f32x4){0.f, 0.f, 0.f, 0.f};
        gemm_kloop<true, 4>(acc, A + (size_t)m0 * D, D, W + (size_t)n0 * D, D, D, lds);
#pragma unroll
        for (int mt = 0; mt < 4; ++mt)
#pragma unroll
            for (int nt = 0; nt < 4; ++nt) {
                const int row = m0 + wm * 64 + mt * 16 + fr, col = n0 + wn * 64 + nt * 16 + fq * 4;
                *(u32x2*)(P + (size_t)row * NP + col) = (u32x2){pk2(acc[mt][nt].x, acc[mt][nt].y), pk2(acc[mt][nt].z, acc[mt][nt].w)};
            }
    }
}

__device__ __forceinline__ unsigned f2ord(float f) { const unsigned u = __float_as_uint(f); return (u & 0x80000000u) ? ~u : (u | 0x80000000u); }
__device__ __forceinline__ float ord2f(unsigned k) { const unsigned u = (k & 0x80000000u) ? (k & 0x7fffffffu) : ~k; return __uint_as_float(u); }
__device__ __forceinline__ unsigned gmax16(unsigned v) {
    unsigned t;
    t = sxoru<1>(v); v = v > t ? v : t; t = sxoru<2>(v); v = v > t ? v : t; t = sxoru<4>(v); v = v > t ? v : t; t = sxoru<8>(v); v = v > t ? v : t;
    return v;
}
__device__ __forceinline__ float gsum16(float v) { v += sxor<1>(v); v += sxor<2>(v); v += sxor<4>(v); v += sxor<8>(v); return v; }
__device__ __forceinline__ float gelu_exact(float a) { return 0.5f * a * (1.0f + erff(a * 0.70710678118654752f)); }

__device__ __forceinline__ void phase_peer(const Params& p, int g, char* lds, int tile0, int ntile) {
    const Grp G = get_group(p, g);
    const int tid = otid(), lane = tid & 63, wid = tid >> 6, fr = lane & 15, fq = lane >> 4;
    const bf16_t* P = (const bf16_t*)(p.ws + WS_PROJ); const bf16_t* HB = (const bf16_t*)(p.ws + WS_HB);
    const bf16_t* K12 = (const bf16_t*)(p.ws + WS_K12);
    float* SC = (float*)lds;
    int* EIDX = (int*)(lds + 65536);
    float* GATE = (float*)(lds + 65536 + 4096);
    char* KL = lds + 73728;
    for (int i = tid; i < 2 * 128 * 16; i += NTHR) {
        const int r = i >> 4, ch = i & 15;
        *(u32x4*)(KL + r * 272 + ch * 16) = *(const u32x4*)(K12 + (size_t)r * 128 + ch * 8);
    }
    __syncthreads();
    for (int tile = tile0; tile < tile0 + ntile; ++tile) {
        const int tok0 = tile * 8;
        {
            const bf16_t* qtok = P + (size_t)(tok0 + wid) * NP + (fr & 7) * 256;
#pragma unroll
            for (int half = 0; half < 2; ++half) {
                f32x4 acc[8];
#pragma unroll
                for (int i = 0; i < 8; ++i) acc[i] = (f32x4){0.f, 0.f, 0.f, 0.f};
                bf16x8 af[4], kfa[8], kfb[8];
#pragma unroll
                for (int ks = 0; ks < 4; ++ks) af[ks] = *(const bf16x8*)(qtok + half * 128 + ks * 32 + fq * 8);
#define KFLOAD(BUF, KS) do { _Pragma("unroll") for (int nt = 0; nt < 8; ++nt) BUF[nt] = *(const bf16x8*)(KL + (half * 128 + nt * 16 + fr) * 272 + (KS) * 64 + fq * 16); } while (0)
#define KFMMA(BUF, KS) do { _Pragma("unroll") for (int nt = 0; nt < 8; ++nt) acc[nt] = mfma16(af[KS], BUF[nt], acc[nt]); } while (0)
                KFLOAD(kfa, 0);
                __builtin_amdgcn_sched_barrier(0);
                KFLOAD(kfb, 1); KFMMA(kfa, 0);
                __builtin_amdgcn_sched_barrier(0);
                KFLOAD(kfa, 2); KFMMA(kfb, 1);
                __builtin_amdgcn_sched_barrier(0);
                KFLOAD(kfb, 3); KFMMA(kfa, 2);
                __builtin_amdgcn_sched_barrier(0);
                KFMMA(kfb, 3);
#undef KFLOAD
#undef KFMMA
                if (fq < 2) {
#pragma unroll
                    for (int nt = 0; nt < 8; ++nt) {
                        float* dst = SC + (wid * 8 + fq * 4) * 256 + half * 128 + nt * 16 + fr;
                        dst[0] = acc[nt].x; dst[256] = acc[nt].y; dst[512] = acc[nt].z; dst[768] = acc[nt].w;
                    }
                }
            }
        }
        __builtin_amdgcn_wave_barrier();
        {
            const int sl = fr, gb = fq * 16;
            const int row0_ = wid * 8 + fq, row1_ = wid * 8 + 4 + fq;
            float v1[2] = {0.f, 0.f}, v2[2] = {0.f, 0.f}; int i1[2] = {0, 0}, i2[2] = {0, 0};
            {
                unsigned kc[4][8];
#pragma unroll
                for (int c4 = 0; c4 < 4; ++c4)
#pragma unroll
                    for (int i = 0; i < 8; ++i) { const int idx = sl + 16 * i;
                        kc[c4][i] = (f2ord(SC[((c4 & 1) ? row1_ : row0_) * 256 + (c4 >> 1) * 128 + idx]) & ~127u) | (unsigned)(127 - idx); }
                float sv[4] = {0.f, 0.f, 0.f, 0.f}; int si[4] = {0, 0, 0, 0};
                for (int r = 0; r < 16; ++r) {
                    unsigned m[4], t[4];
#pragma unroll
                    for (int c4 = 0; c4 < 4; ++c4) {
                        const unsigned x0 = kc[c4][0] > kc[c4][1] ? kc[c4][0] : kc[c4][1], x1 = kc[c4][2] > kc[c4][3] ? kc[c4][2] : kc[c4][3];
                        const unsigned x2 = kc[c4][4] > kc[c4][5] ? kc[c4][4] : kc[c4][5], x3 = kc[c4][6] > kc[c4][7] ? kc[c4][6] : kc[c4][7];
                        const unsigned y0 = x0 > x1 ? x0 : x1, y1 = x2 > x3 ? x2 : x3; m[c4] = y0 > y1 ? y0 : y1;
                    }
#pragma unroll
                    for (int c4 = 0; c4 < 4; ++c4) t[c4] = sxoru<1>(m[c4]);
#pragma unroll
                    for (int c4 = 0; c4 < 4; ++c4) m[c4] = m[c4] > t[c4] ? m[c4] : t[c4];
#pragma unroll
                    for (int c4 = 0; c4 < 4; ++c4) t[c4] = sxoru<2>(m[c4]);
#pragma unroll
                    for (int c4 = 0; c4 < 4; ++c4) m[c4] = m[c4] > t[c4] ? m[c4] : t[c4];
#pragma unroll
                    for (int c4 = 0; c4 < 4; ++c4) t[c4] = sxoru<4>(m[c4]);
#pragma unroll
                    for (int c4 = 0; c4 < 4; ++c4) m[c4] = m[c4] > t[c4] ? m[c4] : t[c4];
#pragma unroll
                    for (int c4 = 0; c4 < 4; ++c4) t[c4] = sxoru<8>(m[c4]);
#pragma unroll
                    for (int c4 = 0; c4 < 4; ++c4) m[c4] = m[c4] > t[c4] ? m[c4] : t[c4];
#pragma unroll
                    for (int c4 = 0; c4 < 4; ++c4) {
                        if (sl == r) { sv[c4] = ord2f(m[c4] & ~127u); si[c4] = 127 - (int)(m[c4] & 127u); }
#pragma unroll
                        for (int i = 0; i < 8; ++i) kc[c4][i] = kc[c4][i] == m[c4] ? 0u : kc[c4][i];
                    }
                }
                v1[0] = sv[0]; i1[0] = si[0]; v1[1] = sv[1]; i1[1] = si[1]; v2[0] = sv[2]; i2[0] = si[2]; v2[1] = sv[3]; i2[1] = si[3];
            }
            int pa = 0, pb = 0; float tsa = 0.f, tsb = 0.f; int pida = 0, pidb = 0;
            for (int r = 0; r < 16; ++r) {
                const float va = __int_as_float(__builtin_amdgcn_ds_bpermute((gb + (pa & 15)) << 2, __float_as_int(v2[0])));
                const float vb = __int_as_float(__builtin_amdgcn_ds_bpermute((gb + (pb & 15)) << 2, __float_as_int(v2[1])));
                const unsigned keya = pa < 16 ? ((f2ord(v1[0] + va) & ~255u) | (unsigned)(255 - (sl * 16 + pa))) : 0u;
                const unsigned keyb = pb < 16 ? ((f2ord(v1[1] + vb) & ~255u) | (unsigned)(255 - (sl * 16 + pb))) : 0u;
                unsigned ma = keya, mb = keyb, ta, tb;
                ta = sxoru<1>(ma); tb = sxoru<1>(mb); ma = ma > ta ? ma : ta; mb = mb > tb ? mb : tb;
                ta = sxoru<2>(ma); tb = sxoru<2>(mb); ma = ma > ta ? ma : ta; mb = mb > tb ? mb : tb;
                ta = sxoru<4>(ma); tb = sxoru<4>(mb); ma = ma > ta ? ma : ta; mb = mb > tb ? mb : tb;
                ta = sxoru<8>(ma); tb = sxoru<8>(mb); ma = ma > ta ? ma : ta; mb = mb > tb ? mb : tb;
                if (sl == r) { tsa = ord2f(ma & ~255u); pida = 255 - (int)(ma & 255u); tsb = ord2f(mb & ~255u); pidb = 255 - (int)(mb & 255u); }
                if (keya == ma) pa++;
                if (keyb == mb) pb++;
            }
#pragma unroll
            for (int ps = 0; ps < 2; ++ps) {
                const int pid = ps ? pidb : pida; const float ts = ps ? tsb : tsa; const int row = ps ? row1_ : row0_;
                const int e1 = __builtin_amdgcn_ds_bpermute((gb + (pid >> 4)) << 2, i1[ps]), e2 = __builtin_amdgcn_ds_bpermute((gb + (pid & 15)) << 2, i2[ps]);
                float mx = ts;
                mx = fmaxf(mx, sxor<1>(mx)); mx = fmaxf(mx, sxor<2>(mx)); mx = fmaxf(mx, sxor<4>(mx)); mx = fmaxf(mx, sxor<8>(mx));
                const float ex = __expf(ts - mx), sm = gsum16(ex);
                EIDX[row * 16 + sl] = e1 * 128 + e2; GATE[row * 16 + sl] = ex / sm;
            }
        }
        __builtin_amdgcn_wave_barrier();
        {
            const int tok = tok0 + wid;
            const bf16_t* hrow = HB + (size_t)tok * D;
            const int grp = lane >> 4, sl = lane & 15;
            {
                f32x2 hv[32];
#pragma unroll
                for (int c = 0; c < 8; ++c) {
                    const u32x4 hq = *(const u32x4*)(hrow + sl * 64 + c * 8);
                    hv[c * 4 + 0] = (f32x2){bflo(hq.x), bfhi(hq.x)} * (1.0f / PEER_SU); hv[c * 4 + 1] = (f32x2){bflo(hq.y), bfhi(hq.y)} * (1.0f / PEER_SU);
                    hv[c * 4 + 2] = (f32x2){bflo(hq.z), bfhi(hq.z)} * (1.0f / PEER_SU); hv[c * 4 + 3] = (f32x2){bflo(hq.w), bfhi(hq.w)} * (1.0f / PEER_SU);
                }
                const unsigned char* PU8 = p.ws + WS_PU + sl * 64;
#define ULOADG(BUF, IT) do { _Pragma("unroll") for (int i_ = 0; i_ < 2; ++i_) { const int k_ = ((IT) + i_) * 4 + grp; const unsigned char* ur_ = PU8 + (size_t)EIDX[wid * 128 + k_] * D; \
        BUF[i_ * 4 + 0] = *(const u32x4*)ur_; BUF[i_ * 4 + 1] = *(const u32x4*)(ur_ + 16); BUF[i_ * 4 + 2] = *(const u32x4*)(ur_ + 32); BUF[i_ * 4 + 3] = *(const u32x4*)(ur_ + 48); } } while (0)
#define PDOT(uq, base) \
        a2 += __builtin_amdgcn_cvt_pk_f32_fp8((int)uq.x, false) * hv[base + 0]; b2 += __builtin_amdgcn_cvt_pk_f32_fp8((int)uq.x, true) * hv[base + 1]; \
        a2 += __builtin_amdgcn_cvt_pk_f32_fp8((int)uq.y, false) * hv[base + 2]; b2 += __builtin_amdgcn_cvt_pk_f32_fp8((int)uq.y, true) * hv[base + 3]; \
        a2 += __builtin_amdgcn_cvt_pk_f32_fp8((int)uq.z, false) * hv[base + 4]; b2 += __builtin_amdgcn_cvt_pk_f32_fp8((int)uq.z, true) * hv[base + 5]; \
        a2 += __builtin_amdgcn_cvt_pk_f32_fp8((int)uq.w, false) * hv[base + 6]; b2 += __builtin_amdgcn_cvt_pk_f32_fp8((int)uq.w, true) * hv[base + 7];
#define UCOMP(BUF, IT) do { _Pragma("unroll") for (int i_ = 0; i_ < 2; ++i_) { const int k_ = ((IT) + i_) * 4 + grp; \
        f32x2 a2 = (f32x2){0.f, 0.f}, b2 = (f32x2){0.f, 0.f}; \
        PDOT(BUF[i_ * 4 + 0], 0) PDOT(BUF[i_ * 4 + 1], 8) PDOT(BUF[i_ * 4 + 2], 16) PDOT(BUF[i_ * 4 + 3], 24) \
        a2 += b2; const float a_ = gsum16(a2.x + a2.y); GATE[wid * 128 + k_] = GATE[wid * 128 + k_] * gelu_exact(a_); } } while (0)
                u32x4 ubA[8], ubB[8];
                ULOADG(ubA, 0);
                for (int it0 = 0; it0 < 32; it0 += 4) {
                    ULOADG(ubB, it0 + 2);
                    __builtin_amdgcn_sched_barrier(0);
                    UCOMP(ubA, it0);
                    __builtin_amdgcn_sched_barrier(0);
                    if (it0 + 4 < 32) ULOADG(ubA, it0 + 4);
                    __builtin_amdgcn_sched_barrier(0);
                    UCOMP(ubB, it0 + 2);
                    __builtin_amdgcn_sched_barrier(0);
                }
#undef ULOADG
#undef PDOT
#undef UCOMP
            }
            __builtin_amdgcn_wave_barrier();
            f32x2 acc[8];
#pragma unroll
            for (int i = 0; i < 8; ++i) acc[i] = (f32x2){0.f, 0.f};
            const unsigned char* PV8 = p.ws + WS_PV + lane * 16;
#define VLOADG(BUF, K0) do { _Pragma("unroll") for (int i_ = 0; i_ < 8; ++i_) BUF[i_] = *(const u32x4*)(PV8 + (size_t)EIDX[wid * 128 + (K0) + i_] * D); } while (0)
#define VCOMP(BUF, K0) do { _Pragma("unroll") for (int i_ = 0; i_ < 8; ++i_) { const float w_ = GATE[wid * 128 + (K0) + i_]; const f32x2 w2 = (f32x2){w_, w_}; const u32x4 v = BUF[i_]; \
        acc[0] += w2 * __builtin_amdgcn_cvt_pk_f32_fp8((int)v.x, false); acc[1] += w2 * __builtin_amdgcn_cvt_pk_f32_fp8((int)v.x, true); \
        acc[2] += w2 * __builtin_amdgcn_cvt_pk_f32_fp8((int)v.y, false); acc[3] += w2 * __builtin_amdgcn_cvt_pk_f32_fp8((int)v.y, true); \
        acc[4] += w2 * __builtin_amdgcn_cvt_pk_f32_fp8((int)v.z, false); acc[5] += w2 * __builtin_amdgcn_cvt_pk_f32_fp8((int)v.z, true); \
        acc[6] += w2 * __builtin_amdgcn_cvt_pk_f32_fp8((int)v.w, false); acc[7] += w2 * __builtin_amdgcn_cvt_pk_f32_fp8((int)v.w, true); } } while (0)
            {
                u32x4 vbA[8], vbB[8];
                VLOADG(vbA, 0);
                for (int k0 = 0; k0 < 128; k0 += 16) {
                    VLOADG(vbB, k0 + 8);
                    __builtin_amdgcn_sched_barrier(0);
                    VCOMP(vbA, k0);
                    __builtin_amdgcn_sched_barrier(0);
                    if (k0 + 16 < 128) VLOADG(vbA, k0 + 16);
                    __builtin_amdgcn_sched_barrier(0);
                    VCOMP(vbB, k0 + 8);
                    __builtin_amdgcn_sched_barrier(0);
                }
            }
#undef VLOADG
#undef VCOMP
            float* orow = G.out + (size_t)tok * D + lane * 16;
#pragma unroll
            for (int i = 0; i < 4; ++i) {
                f32x4 t = *(f32x4*)(orow + i * 4);
                t.x += acc[2 * i].x * (1.0f / PEER_SV); t.y += acc[2 * i].y * (1.0f / PEER_SV); t.z += acc[2 * i + 1].x * (1.0f / PEER_SV); t.w += acc[2 * i + 1].y * (1.0f / PEER_SV);
                *(f32x4*)(orow + i * 4) = t;
            }
        }
        __builtin_amdgcn_wave_barrier();
    }
}


constexpr int NPH = 3 + NGROUP * 3;
__device__ __forceinline__ void run_phase(const Params& p, int ph, char* lds, int* s_item) {
    const int g = (ph - 3) / 3, s = (ph - 3) % 3;
    const Grp G = get_group(p, g);
    if (s == 0) {
        for (int u = blockIdx.x; u < 256; u += gridDim.x) {
            const int m0 = (u >> 1) * 256;
            phase_rmsnorm(G.x, p.in[I_GMIX], (bf16_t*)(p.ws + WS_HB), m0, 256);
            __syncthreads();
            phase_inproj(p, g, lds, u);
            __syncthreads();
        }
    } else if (s == 1) {
        phase_mixer(p, g, lds, s_item);
    } else {
        for (int u = blockIdx.x; u < 256; u += gridDim.x) {
            const int m0 = u * 128;
            phase_glafin(p, g, m0, 128);
            __syncthreads();
            phase_merge(p, g, lds, u);
            __syncthreads();
            phase_outproj(p, g, lds, u);
            __syncthreads();
            phase_rmsnorm(G.out, p.in[I_GFFN], (bf16_t*)(p.ws + WS_HB), m0, 128);
            __syncthreads();
            phase_peerq(p, g, lds, u);
            __syncthreads();
            phase_peer(p, g, lds, m0 / 8, 16);
            __syncthreads();
        }
    }
}

__global__ void __launch_bounds__(NTHR) mega_kernel(Params p) {
    extern __shared__ __attribute__((aligned(16))) char lds[];
    __shared__ int s_item;
    cg::grid_group grid = cg::this_grid();
    phase_p0a(p, lds); grid.sync();
    phase_p0b(p, lds); grid.sync();
    phase_p0c(p); grid.sync();
    for (int ph = 3; ph < NPH; ++ph) {
        run_phase(p, ph, lds, &s_item);
        if (ph + 1 < NPH) grid.sync();
    }
}

extern "C" void kernel_launch(void* const* d_in, const int* in_sizes, int n_in, void* d_out, int out_size, void* d_ws, size_t ws_size, hipStream_t stream) {
    static int grid_blocks = 0;
    if (grid_blocks == 0) {
        if (n_in != 32 || ws_size < WS_END) { fprintf(stderr, "kernel_launch: unexpected n_in %d or ws_size %zu (< %zu)\n", n_in, ws_size, (size_t)WS_END); grid_blocks = -1; return; }
        int dev = 0, cus = 0, per_cu = 0;
        hipGetDevice(&dev);
        hipDeviceGetAttribute(&cus, hipDeviceAttributeMultiprocessorCount, dev);
        hipFuncSetAttribute((const void*)mega_kernel, hipFuncAttributeMaxDynamicSharedMemorySize, LDS_BYTES);
        hipOccupancyMaxActiveBlocksPerMultiprocessor(&per_cu, (const void*)mega_kernel, NTHR, LDS_BYTES);
        if (per_cu < 1) per_cu = 1;
        grid_blocks = cus * per_cu;
        (void)hipGetLastError();
    }
    if (grid_blocks < 0) return;
    Params p{};
    for (int i = 0; i < 32; ++i) p.in[i] = (const float*)d_in[i];
    p.out = (float*)d_out; p.ws = (unsigned char*)d_ws; p.ph_lo = 0; p.ph_hi = NPH;
    void* args[] = {&p};
    hipError_t e = hipLaunchCooperativeKernel((const void*)mega_kernel, dim3(grid_blocks), dim3(NTHR), args, LDS_BYTES, stream);
    if (e != hipSuccess) fprintf(stderr, "cooperative launch failed: %s (grid %d)\n", hipGetErrorString(e), grid_blocks);
}
```

```cpp
#include <hip/hip_runtime.h>
#include <hip/hip_cooperative_groups.h>
#include <cstdio>
#include <cstdint>
namespace cg = cooperative_groups;

typedef unsigned short bf16_t;
typedef short bf16x8 __attribute__((ext_vector_type(8)));
typedef float f32x4 __attribute__((ext_vector_type(4)));
typedef unsigned u32x4 __attribute__((ext_vector_type(4)));
typedef unsigned u32x2 __attribute__((ext_vector_type(2)));

constexpr int D = 1024;
constexpr int NP = 10496;
constexpr int IN_COLS = 10272;
constexpr int C_GQ = 0, C_GK = 512, C_GV = 1024, C_GG = 2048, C_DQ = 3072, C_DK = 4096, C_DV = 5120, C_MQ = 6144, C_BG = 7168, C_LR = 10240;
constexpr int G_TOK = 32768;
constexpr int NGROUP = 3;
constexpr int NTHR = 512;
constexpr float RMS_EPS = 1e-6f;
constexpr float LOG2E = 1.4426950408889634f;
constexpr int LDS_BYTES = 147456;
constexpr float PEER_SU = 32.0f, PEER_SV = 8.0f;

enum { I_XP = 0, I_XS, I_MP, I_MS, I_GMIX, I_WIN, I_WDF, I_BDF, I_WDB, I_BDB, I_GOUT, I_GWO, I_DGQ, I_DGK, I_LQ1, I_LK1, I_LQ2, I_LK2,
       I_DGSUB, I_DWO, I_MGN, I_MWKV, I_MGQ, I_MGK, I_MWO, I_WOUT, I_GFFN, I_PWQ, I_PK1, I_PK2, I_PU, I_PV };

constexpr size_t al256(size_t x) { return (x + 255) & ~(size_t)255; }
constexpr size_t WS_CTRL = 0;
constexpr size_t WS_PROJ = 4096;
constexpr size_t WS_HB   = WS_PROJ + (size_t)G_TOK * NP * 2;
constexpr size_t WS_VT   = WS_HB + (size_t)G_TOK * D * 2;
constexpr size_t WS_WINT = WS_VT + (size_t)G_TOK * D * 2;
constexpr size_t WS_WOT  = WS_WINT + (size_t)NP * D * 2;
constexpr size_t WS_WKVT = WS_WOT + (size_t)4 * D * D * 2;
constexpr size_t WS_WQT  = WS_WKVT + (size_t)2048 * D * 2;
constexpr size_t WS_PU   = WS_WQT + (size_t)2048 * D * 2;
constexpr size_t WS_PV   = WS_PU + (size_t)16384 * D * 2;
constexpr size_t WS_K12  = WS_PV + (size_t)16384 * D * 2;
constexpr size_t WS_ROPE = WS_K12 + (size_t)2 * 128 * 128 * 2;
constexpr size_t WS_HM   = WS_ROPE + (size_t)16384 * 64 * 4;
constexpr size_t WS_KVR  = WS_HM + (size_t)2560 * D * 2;
constexpr size_t WS_MEMK = WS_KVR + (size_t)2560 * 2048 * 4;
constexpr size_t WS_MEMV = WS_MEMK + (size_t)10 * 4 * 256 * 256 * 2;
constexpr size_t WS_END  = WS_MEMV + (size_t)10 * 4 * 256 * 256 * 2;

struct Params {
    const float* in[32];
    float* out;
    unsigned char* ws;
    int ph_lo, ph_hi;
};

typedef float f32x2 __attribute__((ext_vector_type(2)));
typedef __bf16 bf16x2v __attribute__((ext_vector_type(2)));
__device__ __forceinline__ unsigned pk2(float lo, float hi) { const f32x2 v = {lo, hi}; const bf16x2v b = __builtin_convertvector(v, bf16x2v); return __builtin_bit_cast(unsigned, b); }
__device__ __forceinline__ float bflo(unsigned u) { return __uint_as_float(u << 16); }
__device__ __forceinline__ float bfhi(unsigned u) { return __uint_as_float(u & 0xffff0000u); }
__device__ __forceinline__ float bf2f(bf16_t b) { return __uint_as_float(((unsigned)b) << 16); }
__device__ __forceinline__ bf16_t f2bf(float f) { return (bf16_t)(pk2(f, 0.f) & 0xffffu); }
__device__ __forceinline__ f32x4 mfma16(bf16x8 a, bf16x8 b, f32x4 c) { return __builtin_amdgcn_mfma_f32_16x16x32_bf16(a, b, c, 0, 0, 0); }
__device__ __forceinline__ float fexp2(float x) { return __builtin_amdgcn_exp2f(x); }
template <class T> __device__ __forceinline__ T* launder(T* q) { asm volatile("" : "+s"(q)); return q; }
__device__ __forceinline__ int otid() { int t = threadIdx.x; asm volatile("" : "+v"(t)); return t; }
template <int M> __device__ __forceinline__ float sxor(float v) {
    if (M < 32) return __int_as_float(__builtin_amdgcn_ds_swizzle(__float_as_int(v), (M << 10) | 0x1F));
    const int l = otid() & 63; return __int_as_float(__builtin_amdgcn_ds_bpermute((l ^ 32) << 2, __float_as_int(v)));
}
template <int M> __device__ __forceinline__ unsigned sxoru(unsigned v) { return (unsigned)__builtin_amdgcn_ds_swizzle((int)v, (M << 10) | 0x1F); }
__device__ __forceinline__ float wave_sum(float v) {
    v += sxor<1>(v); v += sxor<2>(v); v += sxor<4>(v); v += sxor<8>(v); v += sxor<16>(v); v += sxor<32>(v);
    return v;
}

struct Grp { const float* x; const float* mem; float* out; int B, T, mb0; };
__device__ __forceinline__ Grp get_group(const Params& p, int g) {
    Grp r;
    if (g == 0) { r.x = p.in[I_XP]; r.out = p.out; r.B = 2; r.T = 16384; r.mb0 = 0; }
    else { r.x = p.in[I_XS] + (size_t)(g - 1) * G_TOK * D; r.out = p.out + (size_t)g * G_TOK * D; r.B = 4; r.T = 8192; r.mb0 = 2 + (g - 1) * 4; }
    r.mem = nullptr;
    return r;
}

constexpr int G_ROW = 144;
constexpr int G_A_BYTES = 128 * G_ROW;
constexpr int G_B_BYTES = 256 * G_ROW;
constexpr int G_STAGE = G_A_BYTES + G_B_BYTES;

template <bool SWAP, int MT>
__device__ __forceinline__ void gemm_kloop(f32x4 (&acc)[MT][4], const bf16_t* __restrict__ A, int lda, const bf16_t* __restrict__ Bt, int ldb, int K, char* lds) {
    constexpr int A_ROWS = MT * 32, A_BYTES = A_ROWS * G_ROW, STAGE = A_BYTES + G_B_BYTES;
    constexpr int NA = A_BYTES / 1024, NI = STAGE / 1024, NPER = (NI + 7) / 8;
    const int tid = otid(), lane = tid & 63, wid = __builtin_amdgcn_readfirstlane(tid >> 6), wm = wid >> 2, wn = wid & 3, fr = lane & 15, fq = lane >> 4;
    unsigned goff[NPER];
#pragma unroll
    for (int i = 0; i < NPER; ++i) {
        const int j = wid + 8 * i;
        const int ci = (j < NA ? j : j - NA) * 64 + lane, row = ci / 9, ch = ci % 9, chc = ch < 8 ? ch : 7;
        goff[i] = (unsigned)(row * (j < NA ? lda : ldb) + chc * 8);
    }
#define GSTAGE(buf, k0) do { _Pragma("unroll") for (int i = 0; i < NPER; ++i) { const int j = wid + 8 * i; if (j < NI) { \
        const bf16_t* src_ = (j < NA ? A : Bt) + goff[i] + (k0); \
        __builtin_amdgcn_global_load_lds((const unsigned*)src_, (unsigned*)(lds + (buf) * STAGE + j * 1024), 16, 0, 0); } } } while (0)
    const int nk = K / 64;
    GSTAGE(0, 0);
    __syncthreads();
    for (int kt = 0; kt < nk; ++kt) {
        if (kt + 1 < nk) GSTAGE((kt + 1) & 1, (kt + 1) * 64);
        const char* base = lds + (kt & 1) * STAGE;
        const char* abase = base + (wm * (MT * 16) + fr) * G_ROW + fq * 16;
        const char* bbase = base + A_BYTES + (wn * 64 + fr) * G_ROW + fq * 16;
        bf16x8 b0[4], b1[4], ar[4];
#pragma unroll
        for (int nt = 0; nt < 4; ++nt) b0[nt] = *(const bf16x8*)(bbase + nt * 16 * G_ROW);
        ar[0] = *(const bf16x8*)(abase); ar[1] = *(const bf16x8*)(abase + 16 * G_ROW); ar[2] = *(const bf16x8*)(abase + 32 * G_ROW);
#pragma unroll
        for (int st = 0; st < 2 * MT; ++st) {
            const int ks = st / MT, mt = st % MT;
            __builtin_amdgcn_sched_barrier(0);
            if (st + 3 < 2 * MT) { const int ks2 = (st + 3) / MT, mt2 = (st + 3) % MT; ar[(st + 3) % 4] = *(const bf16x8*)(abase + mt2 * 16 * G_ROW + ks2 * 64); }
            if (ks == 0 && mt >= MT - 3 && mt < MT - 1) {
#pragma unroll
                for (int q = 0; q < 2; ++q) { const int nt = (mt - (MT - 3)) * 2 + q; b1[nt] = *(const bf16x8*)(bbase + nt * 16 * G_ROW + 64); }
            }
#pragma unroll
            for (int nt = 0; nt < 4; ++nt) {
                const bf16x8 bv = ks == 0 ? b0[nt] : b1[nt];
                acc[mt][nt] = SWAP ? mfma16(bv, ar[st % 4], acc[mt][nt]) : mfma16(ar[st % 4], bv, acc[mt][nt]);
            }
        }
        __builtin_amdgcn_sched_barrier(0);
        __syncthreads();
    }
#undef GSTAGE
}

__device__ __forceinline__ void tile_order(int t, int nM, int nN, int& pm, int& pn) {
    const int per = 8 * nN, grp = t / per, r = t % per;
    pm = grp * 8 + (r & 7); pn = r >> 3;
}

__device__ __forceinline__ void phase_p0a(const Params& p, char* lds) {
    const int tid = otid(), lane = tid & 63, wid = tid >> 6;
    unsigned char* ws = p.ws;
    if (blockIdx.x == 0 && tid < 256) atomicExch((unsigned*)(ws + WS_CTRL) + tid, 0u);
    float* scr = (float*)(lds + wid * 8448);
    constexpr int IT_WIN = 16 * (NP / 32), IT_SQ = 16 * 32, IT_W2 = 16 * 64;
    constexpr int NIT = IT_WIN + 4 * IT_SQ + 2 * IT_W2;
    for (int it0 = blockIdx.x * 8; it0 < NIT; it0 += gridDim.x * 8) {
        int it = it0 + wid;
        const float* W = nullptr; bf16_t* WT = nullptr; int N = 0, nb = 0, kb = 0, srccol = -1;
        if (it < NIT) {
            int r = it;
            if (r < IT_WIN) { W = p.in[I_WIN]; N = IN_COLS; WT = (bf16_t*)(ws + WS_WINT); kb = r / (NP / 32); nb = r % (NP / 32);
                const int n0 = nb * 32; srccol = n0 < 3072 ? n0 : (n0 < 10240 ? n0 + 32 : (n0 == 10240 ? 3072 : -1)); }
            else { r -= IT_WIN;
                if (r < 4 * IT_SQ) { const int w = r / IT_SQ; r %= IT_SQ; const int idx[4] = {I_GWO, I_DWO, I_MWO, I_WOUT};
                    W = p.in[w == 0 ? I_GWO : (w == 1 ? I_DWO : (w == 2 ? I_MWO : I_WOUT))]; (void)idx; N = 1024; WT = (bf16_t*)(ws + WS_WOT) + (size_t)w * D * D; kb = r / 32; nb = r % 32; srccol = nb * 32; }
                else { r -= 4 * IT_SQ; const int w = r / IT_W2; r %= IT_W2; W = p.in[w == 0 ? I_MWKV : I_PWQ]; N = 2048; WT = (bf16_t*)(ws + (w == 0 ? WS_WKVT : WS_WQT)); kb = r / 64; nb = r % 64; srccol = nb * 32; }
            }
            const int k0 = kb * 64;
#pragma unroll 8
            for (int i = 0; i < 32; ++i) { const int kk = 2 * i + (lane >> 5); scr[kk * 33 + (lane & 31)] = srccol >= 0 ? W[(size_t)(k0 + kk) * N + srccol + (lane & 31)] : 0.f; }
        }
        __syncthreads();
        if (it < NIT) {
            const int k0 = kb * 64, c = lane & 7;
#pragma unroll
            for (int j = 0; j < 4; ++j) { const int n = (lane >> 3) + 8 * j; const float* s = scr + (8 * c) * 33 + n;
                u32x4 o; o.x = pk2(s[0], s[33]); o.y = pk2(s[66], s[99]); o.z = pk2(s[132], s[165]); o.w = pk2(s[198], s[231]);
                *(u32x4*)(WT + (size_t)(nb * 32 + n) * D + k0 + 8 * c) = o; }
        }
        __syncthreads();
    }
    const size_t gtid = (size_t)blockIdx.x * NTHR + tid, gsz = (size_t)gridDim.x * NTHR;
    {
        const size_t n8 = (size_t)16384 * D / 8;
        for (size_t i = gtid; i < 2 * n8; i += gsz) {
            const int w = i >= n8; const size_t j = w ? i - n8 : i;
            const float* src = p.in[w ? I_PV : I_PU] + j * 8; unsigned char* dst = ws + (w ? WS_PV : WS_PU) + j * 8;
            const float sc = w ? PEER_SV : PEER_SU;
            const f32x4 a = *(const f32x4*)src * sc, b = *(const f32x4*)(src + 4) * sc;
            int lo = __builtin_amdgcn_cvt_pk_fp8_f32(a.x, a.y, 0, false); lo = __builtin_amdgcn_cvt_pk_fp8_f32(a.z, a.w, lo, true);
            int hi = __builtin_amdgcn_cvt_pk_fp8_f32(b.x, b.y, 0, false); hi = __builtin_amdgcn_cvt_pk_fp8_f32(b.z, b.w, hi, true);
            *(u32x2*)dst = (u32x2){(unsigned)lo, (unsigned)hi};
        }
        for (size_t i = gtid; i < 2 * 16384; i += gsz) {
            const int w = i >= 16384; const size_t j = w ? i - 16384 : i;
            ((bf16_t*)(ws + WS_K12))[i] = f2bf(p.in[w ? I_PK2 : I_PK1][j]);
        }
    }
    for (size_t i = gtid; i < (size_t)16384 * 32; i += gsz) {
        const int t = (int)(i >> 5), k = (int)(i & 31);
        const float inv = powf(10000.0f, -(float)(2 * k) / 64.0f);
        const float ang = (float)t * inv;
        double sn, cs; sincos((double)ang, &sn, &cs);
        float* R = (float*)(ws + WS_ROPE) + (size_t)t * 64;
        R[k] = (float)cs; R[32 + k] = (float)sn;
    }
    for (int row = blockIdx.x * 8 + wid; row < 2560; row += gridDim.x * 8) {
        const float* src = row < 512 ? p.in[I_MP] + (size_t)row * D : p.in[I_MS] + (size_t)(row - 512) * D;
        const f32x4* xr = (const f32x4*)src + lane; const f32x4* gr = (const f32x4*)p.in[I_MGN] + lane;
        f32x4 v[4]; float s = 0.f;
#pragma unroll
        for (int j = 0; j < 4; ++j) { v[j] = xr[64 * j]; s += v[j].x * v[j].x + v[j].y * v[j].y + v[j].z * v[j].z + v[j].w * v[j].w; }
        const float r = rsqrtf(wave_sum(s) * (1.f / D) + RMS_EPS);
        u32x2* o = (u32x2*)((bf16_t*)(ws + WS_HM) + (size_t)row * D) + lane;
#pragma unroll
        for (int j = 0; j < 4; ++j) { const f32x4 g = gr[64 * j]; u32x2 w; w.x = pk2(v[j].x * r * g.x, v[j].y * r * g.y); w.y = pk2(v[j].z * r * g.z, v[j].w * r * g.w); o[64 * j] = w; }
    }
}

__device__ __forceinline__ void phase_p0b(const Params& p, char* lds) {
    const int tid_ = otid(), lane = tid_ & 63, wid = tid_ >> 6, wm = wid >> 2, wn = wid & 3, fr = lane & 15, fq = lane >> 4;
    const bf16_t* A = (const bf16_t*)(p.ws + WS_HM); const bf16_t* Bt = (const bf16_t*)(p.ws + WS_WKVT);
    float* C = (float*)(p.ws + WS_KVR);
    const int nM = 20, nN = 8;
    for (int t = blockIdx.x; t < nM * nN; t += gridDim.x) {
        const int pm = t % nM, pn = t / nM, m0 = pm * 128, n0 = pn * 256;
        f32x4 acc[4][4];
#pragma unroll
        for (int i = 0; i < 4; ++i)
#pragma unroll
            for (int j = 0; j < 4; ++j) acc[i][j] = (f32x4){0.f, 0.f, 0.f, 0.f};
        gemm_kloop<true, 4>(acc, A + (size_t)m0 * D, D, Bt + (size_t)n0 * D, D, D, lds);
#pragma unroll
        for (int mt = 0; mt < 4; ++mt)
#pragma unroll
            for (int nt = 0; nt < 4; ++nt) {
                const int row = m0 + wm * 64 + mt * 16 + fr, col = n0 + wn * 64 + nt * 16 + fq * 4;
                *(f32x4*)(C + (size_t)row * 2048 + col) = acc[mt][nt];
            }
    }
}

__device__ __forceinline__ void phase_p0c(const Params& p) {
    const int tid_ = otid(), lane = tid_ & 63, wid = tid_ >> 6;
    const float* KV = (const float*)(p.ws + WS_KVR);
    bf16_t* MK = (bf16_t*)(p.ws + WS_MEMK); bf16_t* MV = (bf16_t*)(p.ws + WS_MEMV);
    for (int it = blockIdx.x * 8 + wid; it < 2560 * 4; it += gridDim.x * 8) {
        const int row = it >> 2, h = it & 3, b = row >> 8, m = row & 255;
        const f32x4 kv = *(const f32x4*)(KV + (size_t)row * 2048 + h * 256 + lane * 4);
        const float ss = wave_sum(kv.x * kv.x + kv.y * kv.y + kv.z * kv.z + kv.w * kv.w);
        const float r = rsqrtf(ss * (1.f / 256.f) + RMS_EPS);
        const f32x4 g = *(const f32x4*)(p.in[I_MGK] + lane * 4);
        u32x2 w; w.x = pk2(kv.x * r * g.x, kv.y * r * g.y); w.y = pk2(kv.z * r * g.z, kv.w * r * g.w);
        *(u32x2*)(MK + ((size_t)(b * 4 + h) * 256 + m) * 256 + lane * 4) = w;
        const f32x4 vv = *(const f32x4*)(KV + (size_t)row * 2048 + 1024 + h * 256 + lane * 4);
        const int pos = (m & ~31) + ((m >> 2) & 3) * 8 + ((m >> 4) & 1) * 4 + (m & 3);
        bf16_t* dst = MV + ((size_t)(b * 4 + h) * 256 + lane * 4) * 256 + pos;
        dst[0] = f2bf(vv.x); dst[256] = f2bf(vv.y); dst[512] = f2bf(vv.z); dst[768] = f2bf(vv.w);
    }
}

__device__ __forceinline__ void phase_rmsnorm(const float* X, const float* gain, bf16_t* O, int row0, int nrows) {
    const int tid_ = otid(), lane = tid_ & 63, wid = tid_ >> 6;
    const f32x4* gr = (const f32x4*)launder(gain) + lane;
    f32x4 g[4];
#pragma unroll
    for (int j = 0; j < 4; ++j) g[j] = gr[64 * j];
    f32x4 vn[4];
    { const f32x4* xr = (const f32x4*)(X + (size_t)(row0 + wid) * D) + lane;
#pragma unroll
      for (int j = 0; j < 4; ++j) vn[j] = xr[64 * j]; }
    for (int row = row0 + wid; row < row0 + nrows; row += 8) {
        f32x4 v[4]; float s = 0.f;
#pragma unroll
        for (int j = 0; j < 4; ++j) v[j] = vn[j];
        if (row + 8 < row0 + nrows) { const f32x4* xr = (const f32x4*)(X + (size_t)(row + 8) * D) + lane;
#pragma unroll
            for (int j = 0; j < 4; ++j) vn[j] = xr[64 * j]; }
        __builtin_amdgcn_sched_barrier(0);
#pragma unroll
        for (int j = 0; j < 4; ++j) s += v[j].x * v[j].x + v[j].y * v[j].y + v[j].z * v[j].z + v[j].w * v[j].w;
        const float r = rsqrtf(wave_sum(s) * (1.f / D) + RMS_EPS);
        u32x2* o = (u32x2*)(O + (size_t)row * D) + lane;
#pragma unroll
        for (int j = 0; j < 4; ++j) { u32x2 w; w.x = pk2(v[j].x * r * g[j].x, v[j].y * r * g[j].y); w.y = pk2(v[j].z * r * g[j].z, v[j].w * r * g[j].w); o[64 * j] = w; }
    }
}

__device__ __forceinline__ void phase_inproj(const Params& p, int g, char* lds, int u) {
    const Grp G = get_group(p, g);
    const int tid_ = otid(), lane = tid_ & 63, wid = tid_ >> 6, wm = wid >> 2, wn = wid & 3, fr = lane & 15, fq = lane >> 4;
    const bf16_t* A = (const bf16_t*)(p.ws + WS_HB); const bf16_t* Bt = (const bf16_t*)(p.ws + WS_WINT);
    bf16_t* P = (bf16_t*)(p.ws + WS_PROJ); bf16_t* VT = (bf16_t*)(p.ws + WS_VT);
    const int pm = u >> 1, half = u & 1, m0 = pm * 256;
    for (int pi = 0; pi < (half ? 17 : 12); ++pi) {
        const int pn = half ? 24 + pi : pi; const int n0 = pn * 256;
        f32x4 acc[8][4];
#pragma unroll
        for (int i = 0; i < 8; ++i)
#pragma unroll
            for (int j = 0; j < 4; ++j) acc[i][j] = (f32x4){0.f, 0.f, 0.f, 0.f};
        gemm_kloop<true, 8>(acc, A + (size_t)m0 * D, D, Bt + (size_t)n0 * D, D, D, lds);
        const float sc = n0 < 512 ? 0.08838834764831845f : 1.0f;
#pragma unroll
        for (int mt = 0; mt < 8; ++mt)
#pragma unroll
            for (int nt = 0; nt < 4; ++nt) {
                const int row = m0 + wm * 128 + mt * 16 + fr, col = n0 + wn * 64 + nt * 16 + fq * 4;
                u32x2 w; w.x = pk2(acc[mt][nt].x * sc, acc[mt][nt].y * sc); w.y = pk2(acc[mt][nt].z * sc, acc[mt][nt].w * sc);
                *(u32x2*)(P + (size_t)row * NP + col) = w;
            }
    }
    if (half == 0) for (int pn = 12; pn < 20; ++pn) {
        const int n0 = pn * 256;
        f32x4 acc[8][4];
#pragma unroll
        for (int i = 0; i < 8; ++i)
#pragma unroll
            for (int j = 0; j < 4; ++j) acc[i][j] = (f32x4){0.f, 0.f, 0.f, 0.f};
        gemm_kloop<true, 8>(acc, A + (size_t)m0 * D, D, Bt + (size_t)n0 * D, D, D, lds);
        const int te_ = otid(), fr = te_ & 15, fq = (te_ >> 4) & 3, wm = te_ >> 8, wn = (te_ >> 6) & 3;
        const bool isk = n0 >= C_DK;
        const float* gn = launder(p.in[isk ? I_DGK : I_DGQ]) + fq * 4;
        const float qs = isk ? 1.0f : 0.125f * LOG2E;
        const float* ROPE = (const float*)(p.ws + WS_ROPE);
        const int tq0 = m0 % G.T + wm * 128 + fr;
#pragma unroll
        for (int mt = 0; mt < 8; ++mt) {
            const int row = m0 + wm * 128 + mt * 16 + fr, t = tq0 + mt * 16;
            float ss = 0.f;
#pragma unroll
            for (int nt = 0; nt < 4; ++nt) ss += acc[mt][nt].x * acc[mt][nt].x + acc[mt][nt].y * acc[mt][nt].y + acc[mt][nt].z * acc[mt][nt].z + acc[mt][nt].w * acc[mt][nt].w;
            ss += sxor<16>(ss); ss += sxor<32>(ss);
            const float r = rsqrtf(ss * (1.f / 64.f) + RMS_EPS) * qs;
            const float* rp = ROPE + (size_t)t * 64 + fq * 4;
            bf16_t* dst = P + (size_t)row * NP + n0 + wn * 64 + fq * 4;
#pragma unroll
            for (int hh = 0; hh < 2; ++hh) {
                const f32x4 cs = *(const f32x4*)(rp + hh * 16), sn = *(const f32x4*)(rp + 32 + hh * 16);
                const f32x4 ya = acc[mt][hh] * *(const f32x4*)(gn + hh * 16) * r, yb = acc[mt][hh + 2] * *(const f32x4*)(gn + 32 + hh * 16) * r;
                const f32x4 oa = ya * cs - yb * sn, ob = yb * cs + ya * sn;
                *(u32x2*)(dst + hh * 16) = (u32x2){pk2(oa.x, oa.y), pk2(oa.z, oa.w)};
                *(u32x2*)(dst + 32 + hh * 16) = (u32x2){pk2(ob.x, ob.y), pk2(ob.z, ob.w)};
            }
        }
    }
    for (int pn = half ? 21 : 20; pn < (half ? 24 : 21); ++pn) {
        const int n0 = pn * 256;
        f32x4 acc[8][4];
#pragma unroll
        for (int i = 0; i < 8; ++i)
#pragma unroll
            for (int j = 0; j < 4; ++j) acc[i][j] = (f32x4){0.f, 0.f, 0.f, 0.f};
        gemm_kloop<false, 8>(acc, A + (size_t)m0 * D, D, Bt + (size_t)n0 * D, D, D, lds);
        const int b = m0 / G.T, t0 = m0 % G.T + wm * 128;
#pragma unroll
        for (int mt = 0; mt < 8; ++mt)
#pragma unroll
            for (int nt = 0; nt < 4; ++nt) {
                const int n = n0 - C_DV + wn * 64 + nt * 16 + fr, h = n >> 7, dv = n & 127;
                const int pos = t0 + (mt >> 1) * 32 + fq * 8 + (mt & 1) * 4;
                u32x2 w; w.x = pk2(acc[mt][nt].x, acc[mt][nt].y); w.y = pk2(acc[mt][nt].z, acc[mt][nt].w);
                *(u32x2*)(VT + ((size_t)((b * 8 + h) * 128 + dv)) * G.T + pos) = w;
            }
    }
}

__device__ __forceinline__ void phase_qkrope(const Params& p, int g, int tok0, int ntok) {
    const Grp G = get_group(p, g);
    const int tid_ = otid(), lane = tid_ & 63, wid = tid_ >> 6, grp = lane >> 2, sub = lane & 3;
    bf16_t* P = (bf16_t*)(p.ws + WS_PROJ); const float* ROPE = (const float*)(p.ws + WS_ROPE);
    for (int it = tok0 * 2 + wid; it < (tok0 + ntok) * 2; it += 8) {
        const int tok = it >> 1, isk = it & 1, t = tok % G.T;
        bf16_t* base = P + (size_t)tok * NP + (isk ? C_DK : C_DQ) + grp * 64 + sub * 8;
        const u32x4 a = *(const u32x4*)base, b = *(const u32x4*)(base + 32);
        float x1[8], x2[8];
        x1[0] = bflo(a.x); x1[1] = bfhi(a.x); x1[2] = bflo(a.y); x1[3] = bfhi(a.y); x1[4] = bflo(a.z); x1[5] = bfhi(a.z); x1[6] = bflo(a.w); x1[7] = bfhi(a.w);
        x2[0] = bflo(b.x); x2[1] = bfhi(b.x); x2[2] = bflo(b.y); x2[3] = bfhi(b.y); x2[4] = bflo(b.z); x2[5] = bfhi(b.z); x2[6] = bflo(b.w); x2[7] = bfhi(b.w);
        float ss = 0.f;
#pragma unroll
        for (int e = 0; e < 8; ++e) ss += x1[e] * x1[e] + x2[e] * x2[e];
        ss += sxor<1>(ss); ss += sxor<2>(ss);
        const float r = rsqrtf(ss * (1.f / 64.f) + RMS_EPS) * (isk ? 1.0f : 0.125f * LOG2E);
        const float* gn = p.in[isk ? I_DGK : I_DGQ] + sub * 8;
        const float* rp = ROPE + (size_t)t * 64 + sub * 8;
        float o1[8], o2[8];
#pragma unroll
        for (int e = 0; e < 8; ++e) {
            const float y1 = x1[e] * r * gn[e], y2 = x2[e] * r * gn[32 + e], c = rp[e], s = rp[32 + e];
            o1[e] = y1 * c - y2 * s; o2[e] = y2 * c + y1 * s;
        }
        u32x4 w1, w2;
        w1.x = pk2(o1[0], o1[1]); w1.y = pk2(o1[2], o1[3]); w1.z = pk2(o1[4], o1[5]); w1.w = pk2(o1[6], o1[7]);
        w2.x = pk2(o2[0], o2[1]); w2.y = pk2(o2[2], o2[3]); w2.z = pk2(o2[4], o2[5]); w2.w = pk2(o2[6], o2[7]);
        *(u32x4*)base = w1; *(u32x4*)(base + 32) = w2;
    }
}

__device__ __forceinline__ void diff_attn_item(const Params& p, const Grp& G, int item, char* lds, float lam, float shift) {
    const int tid = otid(), lane = tid & 63, wid = tid >> 6, fr = lane & 15, fq = lane >> 4;
    const int c = wid & 1, sub = wid >> 1;
    const int T = G.T, nqb = T / 128;
    const int qb = item % nqb, bh = item / nqb, h = bh & 7, b = bh >> 3;
    bf16_t* P = (bf16_t*)(p.ws + WS_PROJ) + (size_t)b * T * NP;
    const bf16_t* Kg = P + C_DK + h * 128;
    const bf16_t* VTg = (const bf16_t*)(p.ws + WS_VT) + (size_t)bh * 128 * T;
    const int q0 = qb * 128 + sub * 32;
    bf16x8 qf[2][2];
#pragma unroll
    for (int nt = 0; nt < 2; ++nt)
#pragma unroll
        for (int ks = 0; ks < 2; ++ks) qf[nt][ks] = *(const bf16x8*)(P + (size_t)(q0 + nt * 16 + fr) * NP + C_DQ + h * 128 + c * 64 + ks * 32 + fq * 8);
    f32x4 o[8][2];
#pragma unroll
    for (int i = 0; i < 8; ++i) { o[i][0] = (f32x4){0.f, 0.f, 0.f, 0.f}; o[i][1] = (f32x4){0.f, 0.f, 0.f, 0.f}; }
    float l[2] = {0.f, 0.f};
    constexpr int STG = 36864, VOFF = 18432;
    u32x4 rk[2], rv[2];
    const int krow = tid >> 4, kch = tid & 15;
    const int vrow = tid >> 3, vch = tid & 7;
#define AGLOAD(kt) do { const int key0_ = (kt) * 64; \
        _Pragma("unroll") for (int i = 0; i < 2; ++i) rk[i] = *(const u32x4*)(Kg + (size_t)(key0_ + krow + i * 32) * NP + kch * 8); \
        _Pragma("unroll") for (int i = 0; i < 2; ++i) rv[i] = *(const u32x4*)(VTg + (size_t)(vrow + i * 64) * T + key0_ + vch * 8); } while (0)
#define ASWRITE(buf) do { char* b_ = lds + (buf) * STG; \
        _Pragma("unroll") for (int i = 0; i < 2; ++i) *(u32x4*)(b_ + ((kch >> 3) * 64 + krow + i * 32) * 144 + (kch & 7) * 16) = rk[i]; \
        _Pragma("unroll") for (int i = 0; i < 2; ++i) *(u32x4*)(b_ + VOFF + (vrow + i * 64) * 144 + vch * 16) = rv[i]; } while (0)
    const int nkt = T / 64;
#define EXPQ(SRC, NT, DSTP) do { const f32x4 a_ = SRC[0][NT], b_ = SRC[1][NT]; \
        const float p0 = fexp2(a_.x), p1 = fexp2(a_.y), p2 = fexp2(a_.z), p3 = fexp2(a_.w); \
        const float p4 = fexp2(b_.x), p5 = fexp2(b_.y), p6 = fexp2(b_.z), p7 = fexp2(b_.w); \
        l[NT] += ((p0 + p1) + (p2 + p3)) + ((p4 + p5) + (p6 + p7)); \
        u32x4 w_; w_.x = pk2(p0, p1); w_.y = pk2(p2, p3); w_.z = pk2(p4, p5); w_.w = pk2(p6, p7); \
        DSTP[NT] = __builtin_bit_cast(bf16x8, w_); } while (0)
#define SMMA1(DST, I, MT, KBASE) do { \
        const bf16x8 k0_ = *(const bf16x8*)((KBASE) + (c * 64 + (MT) * 16 + fr) * 144 + fq * 16); \
        const bf16x8 k1_ = *(const bf16x8*)((KBASE) + (c * 64 + (MT) * 16 + fr) * 144 + 64 + fq * 16); \
        DST[I][0] = mfma16(k0_, qf[0][0], (f32x4){0.f, 0.f, 0.f, 0.f}); DST[I][1] = mfma16(k0_, qf[1][0], (f32x4){0.f, 0.f, 0.f, 0.f}); \
        DST[I][0] = mfma16(k1_, qf[0][1], DST[I][0]); DST[I][1] = mfma16(k1_, qf[1][1], DST[I][1]); } while (0)
#define PVMMA(DVT, KK, PF, VBASE) do { \
        const bf16x8 vf_ = *(const bf16x8*)((VBASE) + VOFF + ((DVT) * 16 + fr) * 144 + (KK) * 64 + fq * 16); \
        o[DVT][0] = mfma16(vf_, PF[0], o[DVT][0]); o[DVT][1] = mfma16(vf_, PF[1], o[DVT][1]); } while (0)
#define PV8(KK, PF, VBASE) do { PVMMA(0, KK, PF, VBASE); PVMMA(1, KK, PF, VBASE); PVMMA(2, KK, PF, VBASE); PVMMA(3, KK, PF, VBASE); \
        PVMMA(4, KK, PF, VBASE); PVMMA(5, KK, PF, VBASE); PVMMA(6, KK, PF, VBASE); PVMMA(7, KK, PF, VBASE); } while (0)
    f32x4 slo[2][2], shi[2][2];
    bf16x8 pflo[2], pfhi[2];
    pfhi[0] = (bf16x8){0, 0, 0, 0, 0, 0, 0, 0}; pfhi[1] = pfhi[0];
#define KLOAD(KR, MTA, MTB, KBASE) do { \
        KR[0] = *(const bf16x8*)((KBASE) + (c * 64 + (MTA) * 16 + fr) * 144 + fq * 16); KR[1] = *(const bf16x8*)((KBASE) + (c * 64 + (MTA) * 16 + fr) * 144 + 64 + fq * 16); \
        KR[2] = *(const bf16x8*)((KBASE) + (c * 64 + (MTB) * 16 + fr) * 144 + fq * 16); KR[3] = *(const bf16x8*)((KBASE) + (c * 64 + (MTB) * 16 + fr) * 144 + 64 + fq * 16); } while (0)
#define SMMAK(DST, KR) do { \
        DST[0][0] = mfma16(KR[0], qf[0][0], (f32x4){0.f, 0.f, 0.f, 0.f}); DST[0][1] = mfma16(KR[0], qf[1][0], (f32x4){0.f, 0.f, 0.f, 0.f}); \
        DST[1][0] = mfma16(KR[2], qf[0][0], (f32x4){0.f, 0.f, 0.f, 0.f}); DST[1][1] = mfma16(KR[2], qf[1][0], (f32x4){0.f, 0.f, 0.f, 0.f}); \
        DST[0][0] = mfma16(KR[1], qf[0][1], DST[0][0]); DST[0][1] = mfma16(KR[1], qf[1][1], DST[0][1]); \
        DST[1][0] = mfma16(KR[3], qf[0][1], DST[1][0]); DST[1][1] = mfma16(KR[3], qf[1][1], DST[1][1]); } while (0)
#define VLOAD4(VR, D0, KK, VBASE) do { _Pragma("unroll") for (int i_ = 0; i_ < 4; ++i_) VR[i_] = *(const bf16x8*)((VBASE) + VOFF + (((D0) + i_) * 16 + fr) * 144 + (KK) * 64 + fq * 16); } while (0)
#define PV4(VR, D0, PF) do { _Pragma("unroll") for (int i_ = 0; i_ < 4; ++i_) { o[(D0) + i_][0] = mfma16(VR[i_], PF[0], o[(D0) + i_][0]); o[(D0) + i_][1] = mfma16(VR[i_], PF[1], o[(D0) + i_][1]); } } while (0)
#define FENCE() __builtin_amdgcn_sched_barrier(0)
    AGLOAD(0); ASWRITE(0); AGLOAD(1); ASWRITE(1);
    for (int i = tid; i < 18432 / 16; i += NTHR) *(u32x4*)(lds + 3 * STG + VOFF + i * 16) = (u32x4){0u, 0u, 0u, 0u};
    __syncthreads();
    bf16x8 kr[4], va[4], vb[4];
    KLOAD(kr, 0, 1, lds); SMMAK(slo, kr);
    for (int kt = 0; kt < nkt; ++kt) {
        { const int ktl = kt + 2 < nkt ? kt + 2 : nkt - 1; AGLOAD(ktl); }
        const char* cur = lds + (kt & 3) * STG; const char* nxt = lds + ((kt + 1) & 3) * STG; const char* prv = lds + ((kt + 3) & 3) * STG;
        KLOAD(kr, 2, 3, cur); VLOAD4(va, 0, 1, prv);
        FENCE();
        SMMAK(shi, kr); VLOAD4(vb, 4, 1, prv); EXPQ(slo, 0, pflo);
        FENCE();
        PV4(va, 0, pfhi); KLOAD(kr, 0, 1, nxt); EXPQ(slo, 1, pflo);
        FENCE();
        PV4(vb, 4, pfhi); VLOAD4(va, 0, 0, cur);
        FENCE();
        SMMAK(slo, kr); VLOAD4(vb, 4, 0, cur); EXPQ(shi, 0, pfhi);
        FENCE();
        PV4(va, 0, pflo); EXPQ(shi, 1, pfhi);
        FENCE();
        PV4(vb, 4, pflo);
        FENCE();
        ASWRITE((kt + 2) & 3);
        __syncthreads();
    }
    { const char* prv = lds + ((nkt - 1) & 3) * STG; VLOAD4(va, 0, 1, prv); VLOAD4(vb, 4, 1, prv); PV4(va, 0, pfhi); PV4(vb, 4, pfhi); }
    __syncthreads();
#undef KLOAD
#undef SMMAK
#undef VLOAD4
#undef PV4
#undef FENCE
#undef EXPQ
#undef SMMA1
#undef PVMMA
#undef PV8
#undef AGLOAD
#undef ASWRITE
    float inv[2];
#pragma unroll
    for (int nt = 0; nt < 2; ++nt) { float v = l[nt]; v += sxor<16>(v); v += sxor<32>(v); inv[nt] = 1.0f / v; }
    float* xch = (float*)lds + sub * 4096;
    if (c == 1) {
#pragma unroll
        for (int dvt = 0; dvt < 8; ++dvt)
#pragma unroll
            for (int nt = 0; nt < 2; ++nt) {
                xch[(dvt * 16 + fq * 4 + 0) * 32 + nt * 16 + fr] = o[dvt][nt].x * inv[nt];
                xch[(dvt * 16 + fq * 4 + 1) * 32 + nt * 16 + fr] = o[dvt][nt].y * inv[nt];
                xch[(dvt * 16 + fq * 4 + 2) * 32 + nt * 16 + fr] = o[dvt][nt].z * inv[nt];
                xch[(dvt * 16 + fq * 4 + 3) * 32 + nt * 16 + fr] = o[dvt][nt].w * inv[nt];
            }
    }
    __syncthreads();
    if (c == 0) {
        float ss[2] = {0.f, 0.f};
#pragma unroll
        for (int dvt = 0; dvt < 8; ++dvt)
#pragma unroll
            for (int nt = 0; nt < 2; ++nt) {
                f32x4 v = o[dvt][nt] * inv[nt];
                v.x -= lam * xch[(dvt * 16 + fq * 4 + 0) * 32 + nt * 16 + fr];
                v.y -= lam * xch[(dvt * 16 + fq * 4 + 1) * 32 + nt * 16 + fr];
                v.z -= lam * xch[(dvt * 16 + fq * 4 + 2) * 32 + nt * 16 + fr];
                v.w -= lam * xch[(dvt * 16 + fq * 4 + 3) * 32 + nt * 16 + fr];
                o[dvt][nt] = v; ss[nt] += v.x * v.x + v.y * v.y + v.z * v.z + v.w * v.w;
            }
#pragma unroll
        for (int nt = 0; nt < 2; ++nt) {
            float v = ss[nt]; v += sxor<16>(v); v += sxor<32>(v);
            const float r = rsqrtf(v * (1.f / 128.f) + RMS_EPS) * 0.8f;
#pragma unroll
            for (int dvt = 0; dvt < 8; ++dvt) {
                const f32x4 gs = *(const f32x4*)(p.in[I_DGSUB] + dvt * 16 + fq * 4);
                const f32x4 v4 = o[dvt][nt];
                u32x2 w; w.x = pk2(v4.x * r * gs.x, v4.y * r * gs.y); w.y = pk2(v4.z * r * gs.z, v4.w * r * gs.w);
                *(u32x2*)(P + (size_t)(q0 + nt * 16 + fr) * NP + C_DQ + h * 128 + dvt * 16 + fq * 4) = w;
            }
        }
    }
    __syncthreads();
}

__device__ __forceinline__ void mem_attn_item(const Params& p, const Grp& G, int item, char* lds, float shift) {
    const int tid = otid(), lane = tid & 63, wid = tid >> 6, fr = lane & 15, fq = lane >> 4;
    const int T = G.T, nqb = T / 128;
    const int qb = item % nqb, bh = item / nqb, h = bh & 3, b = bh >> 2;
    bf16_t* P = (bf16_t*)(p.ws + WS_PROJ) + (size_t)b * T * NP;
    const bf16_t* MK = (const bf16_t*)(p.ws + WS_MEMK) + (size_t)((G.mb0 + b) * 4 + h) * 256 * 256;
    const bf16_t* MV = (const bf16_t*)(p.ws + WS_MEMV) + (size_t)((G.mb0 + b) * 4 + h) * 256 * 256;
    const int row = qb * 128 + wid * 16 + fr;
    bf16_t* qp = P + (size_t)row * NP + C_MQ + h * 256;
    bf16x8 qf[8];
    {
        float ss = 0.f; u32x4 raw[8];
#pragma unroll
        for (int ks = 0; ks < 8; ++ks) { raw[ks] = *(const u32x4*)(qp + ks * 32 + fq * 8);
            const float a0 = bflo(raw[ks].x), a1 = bfhi(raw[ks].x), a2 = bflo(raw[ks].y), a3 = bfhi(raw[ks].y), a4 = bflo(raw[ks].z), a5 = bfhi(raw[ks].z), a6 = bflo(raw[ks].w), a7 = bfhi(raw[ks].w);
            ss += a0 * a0 + a1 * a1 + a2 * a2 + a3 * a3 + a4 * a4 + a5 * a5 + a6 * a6 + a7 * a7; }
        ss += sxor<16>(ss); ss += sxor<32>(ss);
        const float r = rsqrtf(ss * (1.f / 256.f) + RMS_EPS) * (0.0625f * LOG2E);
#pragma unroll
        for (int ks = 0; ks < 8; ++ks) {
            const f32x4 g0 = *(const f32x4*)(p.in[I_MGQ] + ks * 32 + fq * 8), g1 = *(const f32x4*)(p.in[I_MGQ] + ks * 32 + fq * 8 + 4);
            u32x4 w;
            w.x = pk2(bflo(raw[ks].x) * r * g0.x, bfhi(raw[ks].x) * r * g0.y); w.y = pk2(bflo(raw[ks].y) * r * g0.z, bfhi(raw[ks].y) * r * g0.w);
            w.z = pk2(bflo(raw[ks].z) * r * g1.x, bfhi(raw[ks].z) * r * g1.y); w.w = pk2(bflo(raw[ks].w) * r * g1.z, bfhi(raw[ks].w) * r * g1.w);
            qf[ks] = __builtin_bit_cast(bf16x8, w);
        }
    }
    f32x4 o[16];
#pragma unroll
    for (int i = 0; i < 16; ++i) o[i] = (f32x4){0.f, 0.f, 0.f, 0.f};
    float l = 0.f;
    constexpr int KROW = 528, VOFF = 64 * 528;
    u32x4 mk[4], mv[4];
#define MLOAD(KT) do { _Pragma("unroll") for (int i = 0; i < 4; ++i) { const int idx = tid + i * 512; \
        mk[i] = *(const u32x4*)(MK + (size_t)((KT) * 64 + (idx >> 5)) * 256 + (idx & 31) * 8); mv[i] = *(const u32x4*)(MV + (size_t)(idx >> 3) * 256 + (KT) * 64 + (idx & 7) * 8); } } while (0)
    MLOAD(0);
    for (int kt = 0; kt < 4; ++kt) {
#pragma unroll
        for (int i = 0; i < 4; ++i) {
            const int idx = tid + i * 512;
            *(u32x4*)(lds + (idx >> 5) * KROW + (idx & 31) * 16) = mk[i];
            *(u32x4*)(lds + VOFF + (idx >> 3) * 144 + (idx & 7) * 16) = mv[i];
        }
        __syncthreads();
        if (kt + 1 < 4) MLOAD(kt + 1);
        __builtin_amdgcn_sched_barrier(0);
        f32x4 s[4];
#pragma unroll
        for (int mt = 0; mt < 4; ++mt) s[mt] = (f32x4){0.f, 0.f, 0.f, 0.f};
#pragma unroll
        for (int ks = 0; ks < 8; ks += 2) {
            bf16x8 kf[8];
#pragma unroll
            for (int u = 0; u < 8; ++u) kf[u] = *(const bf16x8*)(lds + ((u & 3) * 16 + fr) * KROW + (ks + (u >> 2)) * 64 + fq * 16);
            __builtin_amdgcn_sched_barrier(0);
#pragma unroll
            for (int u = 0; u < 8; ++u) s[u & 3] = mfma16(kf[u], qf[ks + (u >> 2)], s[u & 3]);
        }
        bf16x8 pf[2];
#pragma unroll
        for (int kk = 0; kk < 2; ++kk) {
            const f32x4 a = s[2 * kk], bb = s[2 * kk + 1];
            const float p0 = fexp2(a.x), p1 = fexp2(a.y), p2 = fexp2(a.z), p3 = fexp2(a.w);
            const float p4 = fexp2(bb.x), p5 = fexp2(bb.y), p6 = fexp2(bb.z), p7 = fexp2(bb.w);
            l += ((p0 + p1) + (p2 + p3)) + ((p4 + p5) + (p6 + p7));
            u32x4 w; w.x = pk2(p0, p1); w.y = pk2(p2, p3); w.z = pk2(p4, p5); w.w = pk2(p6, p7);
            pf[kk] = __builtin_bit_cast(bf16x8, w);
        }
#pragma unroll
        for (int kk = 0; kk < 2; ++kk)
#pragma unroll
            for (int d0 = 0; d0 < 16; d0 += 8) {
                bf16x8 vf[8];
#pragma unroll
                for (int u = 0; u < 8; ++u) vf[u] = *(const bf16x8*)(lds + VOFF + ((d0 + u) * 16 + fr) * 144 + kk * 64 + fq * 16);
                __builtin_amdgcn_sched_barrier(0);
#pragma unroll
                for (int u = 0; u < 8; ++u) o[d0 + u] = mfma16(vf[u], pf[kk], o[d0 + u]);
            }
        __syncthreads();
    }
#undef MLOAD
    l += sxor<16>(l); l += sxor<32>(l);
    const float inv = 1.0f / l;
#pragma unroll
    for (int dvt = 0; dvt < 16; ++dvt) {
        u32x2 w; w.x = pk2(o[dvt].x * inv, o[dvt].y * inv); w.y = pk2(o[dvt].z * inv, o[dvt].w * inv);
        *(u32x2*)(qp + dvt * 16 + fq * 4) = w;
    }
}

constexpr int L_QE = 0, L_KE = 17408, L_KST = 34816, L_VTL = 53248, L_ATT = 71680, L_SB = 80896, L_LRF = 115712, L_TOT = 119808, L_GDEC = 121856;
__device__ __forceinline__ void gla_item(const Params& p, const Grp& G, int item, char* lds) {
    const int tid = otid(), lane = tid & 63, wid = tid >> 6, fr = lane & 15, fq = lane >> 4;
    const int slice = item & 1, dir = (item >> 1) & 1, h = (item >> 2) & 3, b = item >> 4;
    const int T = G.T, N = T / 64;
    const bf16_t* P = (const bf16_t*)(p.ws + WS_PROJ) + (size_t)b * T * NP;
    bf16_t* OUT = dir ? (bf16_t*)(p.ws + WS_PROJ) + (size_t)b * T * NP + C_DV + h * 256 + slice * 128
                      : (bf16_t*)(p.ws + WS_HB) + (size_t)b * T * D + h * 256 + slice * 128;
    const int ldo = dir ? NP : D;
    const int amt = wid & 3, antg = wid >> 2;
    bf16x8 wdB[4]; float bd4[4];
    {
        const float* wd = p.in[dir ? I_WDB : I_WDF]; const float* bdp = p.in[dir ? I_BDB : I_BDF];
#pragma unroll
        for (int q = 0; q < 4; ++q) {
            const int col = h * 128 + (antg * 4 + q) * 16 + fr;
            u32x4 w = (u32x4){0u, 0u, 0u, 0u};
            if (fq < 2) { const float* wp = wd + (size_t)(fq * 8) * 512 + col;
                w.x = pk2(wp[0], wp[512]); w.y = pk2(wp[1024], wp[1536]); w.z = pk2(wp[2048], wp[2560]); w.w = pk2(wp[3072], wp[3584]); }
            wdB[q] = __builtin_bit_cast(bf16x8, w);
            bd4[q] = bdp[col];
        }
    }
    { unsigned z = 0u; asm volatile("" : "+v"(z)); for (int i = tid; i < 34816 / 16; i += NTHR) *(u32x4*)(lds + L_SB + i * 16) = (u32x4){z, z, z, z}; }
    f32x4 S[8];
#pragma unroll
    for (int i = 0; i < 8; ++i) S[i] = (f32x4){0.f, 0.f, 0.f, 0.f};
    u32x4 rq[2], rk[2], rv[2], rl;
    const int lrow = tid >> 4, lch = tid & 15;
#define GGLOAD(n) do { const int cb_ = (dir ? (N - 1 - (n)) : (n)) * 64; \
        _Pragma("unroll") for (int i = 0; i < 2; ++i) { const int li_ = lrow + i * 32, tk_ = cb_ + (dir ? 63 - li_ : li_); const bf16_t* rp_ = P + (size_t)tk_ * NP; \
            rq[i] = *(const u32x4*)(rp_ + C_GQ + h * 128 + lch * 8); rk[i] = *(const u32x4*)(rp_ + C_GK + h * 128 + lch * 8); rv[i] = *(const u32x4*)(rp_ + C_GV + h * 256 + slice * 128 + lch * 8); } \
        if (tid < 128) { const int li_ = tid >> 1, tk_ = cb_ + (dir ? 63 - li_ : li_); rl = *(const u32x4*)(P + (size_t)tk_ * NP + C_LR + dir * 16 + (tid & 1) * 8); } } while (0)
    GGLOAD(0);
    for (int n = 0; n < N; ++n) {
#pragma unroll
        for (int i = 0; i < 2; ++i) {
            const int li = lrow + i * 32;
            *(u32x4*)(lds + L_QE + li * 272 + lch * 16) = rq[i];
            *(u32x4*)(lds + L_KE + li * 272 + lch * 16) = rk[i];
            bf16_t* vt = (bf16_t*)(lds + L_VTL) + (lch * 8) * 72 + li;
            vt[0 * 72] = (bf16_t)(rv[i].x & 0xffff); vt[1 * 72] = (bf16_t)(rv[i].x >> 16); vt[2 * 72] = (bf16_t)(rv[i].y & 0xffff); vt[3 * 72] = (bf16_t)(rv[i].y >> 16);
            vt[4 * 72] = (bf16_t)(rv[i].z & 0xffff); vt[5 * 72] = (bf16_t)(rv[i].z >> 16); vt[6 * 72] = (bf16_t)(rv[i].w & 0xffff); vt[7 * 72] = (bf16_t)(rv[i].w >> 16);
        }
        if (tid < 128) *(u32x4*)(lds + L_LRF + (tid >> 1) * 32 + (tid & 1) * 16) = rl;
        if (n + 1 < N) GGLOAD(n + 1);
        __syncthreads();
        {
            u32x4 araw = (u32x4){0u, 0u, 0u, 0u};
            if (fq < 2) araw = *(const u32x4*)(lds + L_LRF + (amt * 16 + fr) * 32 + fq * 16);
            const bf16x8 afr = __builtin_bit_cast(bf16x8, araw);
            float pb[4][4]; float E[4], tt[4];
#pragma unroll
            for (int q = 0; q < 4; ++q) {
                const f32x4 x4 = mfma16(afr, wdB[q], (f32x4){bd4[q], bd4[q], bd4[q], bd4[q]});
                float run = 0.f;
#pragma unroll
                for (int j = 0; j < 4; ++j) {
                    const float x = x4[j];
                    const float ls = fminf(x, 0.f) - __logf(1.0f + __expf(-fabsf(x)));
                    run += ls * 0.0625f; pb[q][j] = run;
                }
                const float u = sxor<16>(run), v = run + u, w2 = sxor<32>(v);
                E[q] = ((fq & 1) ? u : 0.f) + ((fq & 2) ? w2 : 0.f);
                tt[q] = v + w2;
                if (fq == 0) ((float*)(lds + L_TOT))[amt * 128 + (antg * 4 + q) * 16 + fr] = tt[q];
            }
            __syncthreads();
#pragma unroll
            for (int q = 0; q < 4; ++q) {
                const int col = (antg * 4 + q) * 16 + fr;
                float off = 0.f, blast = 0.f;
#pragma unroll
                for (int r = 0; r < 4; ++r) { const float tv = ((const float*)(lds + L_TOT))[r * 128 + col]; blast += tv; if (r < amt) off += tv; }
                const float gcol = __expf(blast);
                bf16_t* qe = (bf16_t*)(lds + L_QE) + (amt * 16 + fq * 4) * 136 + col; bf16_t* ke = (bf16_t*)(lds + L_KE) + (amt * 16 + fq * 4) * 136 + col;
                float ksv[4];
#pragma unroll
                for (int j = 0; j < 4; ++j) {
                    const float bb = off + E[q] + pb[q][j];
                    const float qv = bf2f(qe[j * 136]), kv = bf2f(ke[j * 136]);
                    const float kd = kv * __expf(-bb);
                    qe[j * 136] = f2bf(qv * __expf(bb)); ke[j * 136] = f2bf(kd);
                    ksv[j] = kd * gcol;
                }
                *(u32x2*)(lds + L_KST + col * 144 + (amt * 16 + fq * 4) * 2) = (u32x2){pk2(ksv[0], ksv[1]), pk2(ksv[2], ksv[3])};
                if (amt == 0 && fq == 0) ((float*)(lds + L_GDEC))[col] = gcol;
            }
        }
        __syncthreads();
        {
            const int ct = wid & 3;
            f32x4 a[2] = {(f32x4){0.f, 0.f, 0.f, 0.f}, (f32x4){0.f, 0.f, 0.f, 0.f}};
            bf16x8 qv[4], kv[2][4];
#pragma unroll
            for (int ks = 0; ks < 4; ++ks) {
                qv[ks] = *(const bf16x8*)(lds + L_QE + (ct * 16 + fr) * 272 + ks * 64 + fq * 16);
#pragma unroll
                for (int j = 0; j < 2; ++j) kv[j][ks] = *(const bf16x8*)(lds + L_KE + (((wid >> 2) * 2 + j) * 16 + fr) * 272 + ks * 64 + fq * 16);
            }
            __builtin_amdgcn_sched_barrier(0);
#pragma unroll
            for (int ks = 0; ks < 4; ++ks)
#pragma unroll
                for (int j = 0; j < 2; ++j) a[j] = mfma16(kv[j][ks], qv[ks], a[j]);
#pragma unroll
            for (int j = 0; j < 2; ++j) {
                const int st = (wid >> 2) * 2 + j, cc = ct * 16 + fr, s0 = st * 16 + fq * 4;
                const float v0 = (s0 + 0 <= cc) ? a[j].x : 0.f, v1 = (s0 + 1 <= cc) ? a[j].y : 0.f, v2 = (s0 + 2 <= cc) ? a[j].z : 0.f, v3 = (s0 + 3 <= cc) ? a[j].w : 0.f;
                *(u32x2*)(lds + L_ATT + cc * 144 + s0 * 2) = (u32x2){pk2(v0, v1), pk2(v2, v3)};
            }
        }
        __syncthreads();
        {
            f32x4 oc[4] = {(f32x4){0.f, 0.f, 0.f, 0.f}, (f32x4){0.f, 0.f, 0.f, 0.f}, (f32x4){0.f, 0.f, 0.f, 0.f}, (f32x4){0.f, 0.f, 0.f, 0.f}};
            bf16x8 fa[2], fb[2][4], ga[2], gb[2][4];
#define LD_VA(FA, FB) do { _Pragma("unroll") for (int ks = 0; ks < 2; ++ks) { FA[ks] = *(const bf16x8*)(lds + L_VTL + (wid * 16 + fr) * 144 + ks * 64 + fq * 16); \
                _Pragma("unroll") for (int ct = 0; ct < 4; ++ct) FB[ks][ct] = *(const bf16x8*)(lds + L_ATT + (ct * 16 + fr) * 144 + ks * 64 + fq * 16); } } while (0)
#define LD_SQ(FA, FB, K0) do { _Pragma("unroll") for (int ks = 0; ks < 2; ++ks) { FA[ks] = *(const bf16x8*)(lds + L_SB + (wid * 16 + fr) * 272 + ((K0) + ks) * 64 + fq * 16); \
                _Pragma("unroll") for (int ct = 0; ct < 4; ++ct) FB[ks][ct] = *(const bf16x8*)(lds + L_QE + (ct * 16 + fr) * 272 + ((K0) + ks) * 64 + fq * 16); } } while (0)
#define MM10(FA, FB) do { _Pragma("unroll") for (int ks = 0; ks < 2; ++ks) _Pragma("unroll") for (int ct = 0; ct < 4; ++ct) oc[ct] = mfma16(FA[ks], FB[ks][ct], oc[ct]); } while (0)
            LD_VA(fa, fb); LD_SQ(ga, gb, 0);
            __builtin_amdgcn_sched_barrier(0);
            MM10(fa, fb); LD_SQ(fa, fb, 2);
            __builtin_amdgcn_sched_barrier(0);
            MM10(ga, gb);
            __builtin_amdgcn_sched_barrier(0);
            MM10(fa, fb);
#undef LD_VA
#undef LD_SQ
#undef MM10
            const int cb = (dir ? (N - 1 - n) : n) * 64;
#pragma unroll
            for (int ct = 0; ct < 4; ++ct) {
                const int cl = ct * 16 + fr, tk = cb + (dir ? 63 - cl : cl);
                *(u32x2*)(OUT + (size_t)tk * ldo + wid * 16 + fq * 4) = (u32x2){pk2(oc[ct].x, oc[ct].y), pk2(oc[ct].z, oc[ct].w)};
            }
        }
        __syncthreads();
        {
            const f32x4 gd = *(const f32x4*)((const float*)(lds + L_GDEC) + wid * 16 + fq * 4);
#pragma unroll
            for (int et = 0; et < 8; ++et) S[et] = S[et] * gd;
            bf16x8 da[2], db[2][8];
#pragma unroll
            for (int ks = 0; ks < 2; ++ks) {
                da[ks] = *(const bf16x8*)(lds + L_KST + (wid * 16 + fr) * 144 + ks * 64 + fq * 16);
#pragma unroll
                for (int et = 0; et < 8; ++et) db[ks][et] = *(const bf16x8*)(lds + L_VTL + (et * 16 + fr) * 144 + ks * 64 + fq * 16);
            }
            __builtin_amdgcn_sched_barrier(0);
#pragma unroll
            for (int ks = 0; ks < 2; ++ks)
#pragma unroll
                for (int et = 0; et < 8; ++et) S[et] = mfma16(da[ks], db[ks][et], S[et]);
#pragma unroll
            for (int et = 0; et < 8; ++et)
                *(u32x2*)(lds + L_SB + (et * 16 + fr) * 272 + (wid * 16 + fq * 4) * 2) = (u32x2){pk2(S[et].x, S[et].y), pk2(S[et].z, S[et].w)};
        }
        __syncthreads();
    }
#undef GGLOAD
}

__device__ __forceinline__ void phase_mixer(const Params& p, int g, char* lds, int* s_item) {
    const Grp G = get_group(p, g);
    const int nGLA = G.B * 16, nATT = G.B * 8 * (G.T / 128), nMEM = G.B * 4 * (G.T / 128);
    unsigned* ctr = (unsigned*)(p.ws + WS_CTRL) + g * 4;
    for (;;) {
        if (threadIdx.x == 0) *s_item = (int)atomicAdd(ctr + 0, 1u);
        __syncthreads();
        const int it = *s_item;
        __syncthreads();
        if (it >= nGLA) break;
        gla_item(p, G, it, lds);
    }
    {
        float d1 = 0.f, d2 = 0.f;
        for (int i = 0; i < 64; ++i) { d1 += p.in[I_LQ1][i] * p.in[I_LK1][i]; d2 += p.in[I_LQ2][i] * p.in[I_LK2][i]; }
        const float lam = expf(d1) - expf(d2) + 0.2f;
        for (;;) {
            if (threadIdx.x == 0) *s_item = (int)atomicAdd(ctr + 1, 1u);
            __syncthreads();
            const int it = *s_item;
            __syncthreads();
            if (it >= nATT) break;
            diff_attn_item(p, G, it, lds, lam, 0.f);
        }
    }
    for (;;) {
        if (threadIdx.x == 0) *s_item = (int)atomicAdd(ctr + 2, 1u);
        __syncthreads();
        const int it = *s_item;
        __syncthreads();
        if (it >= nMEM) break;
        mem_attn_item(p, G, it, lds, 0.f);
    }
}

__device__ __forceinline__ void phase_glafin(const Params& p, int g, int tok0, int ntok) {
    const int tid_ = otid(), lane = tid_ & 63, wid = tid_ >> 6;
    bf16_t* P = (bf16_t*)(p.ws + WS_PROJ); const bf16_t* F = (const bf16_t*)(p.ws + WS_HB);
    unsigned qq, kk; u32x2 f, bk, v, gt;
#define GFLOAD(IT) do { const int tok_ = (IT) >> 2, h_ = (IT) & 3; const bf16_t* row_ = P + (size_t)tok_ * NP; \
        qq = *(const unsigned*)(row_ + C_GQ + h_ * 128 + lane * 2); kk = *(const unsigned*)(row_ + C_GK + h_ * 128 + lane * 2); \
        f = *(const u32x2*)(F + (size_t)tok_ * D + h_ * 256 + lane * 4); bk = *(const u32x2*)(row_ + C_DV + h_ * 256 + lane * 4); \
        v = *(const u32x2*)(row_ + C_GV + h_ * 256 + lane * 4); gt = *(const u32x2*)(row_ + C_GG + h_ * 256 + lane * 4); } while (0)
    const f32x4 go = *(const f32x4*)(launder(p.in[I_GOUT]) + lane * 4);
    GFLOAD(tok0 * 4 + wid);
    for (int it = tok0 * 4 + wid; it < (tok0 + ntok) * 4; it += 8) {
        const int tok = it >> 2, h = it & 3;
        bf16_t* row = P + (size_t)tok * NP;
        const unsigned cq = qq, ck = kk; const u32x2 cf = f, cbk = bk, cv = v, cgt = gt;
        if (it + 8 < (tok0 + ntok) * 4) GFLOAD(it + 8);
        __builtin_amdgcn_sched_barrier(0);
        const float qk = wave_sum(bflo(cq) * bflo(ck) + bfhi(cq) * bfhi(ck));
        float o0 = bflo(cf.x) + bflo(cbk.x) - qk * bflo(cv.x), o1 = bfhi(cf.x) + bfhi(cbk.x) - qk * bfhi(cv.x);
        float o2 = bflo(cf.y) + bflo(cbk.y) - qk * bflo(cv.y), o3 = bfhi(cf.y) + bfhi(cbk.y) - qk * bfhi(cv.y);
        const float r = rsqrtf(wave_sum(o0 * o0 + o1 * o1 + o2 * o2 + o3 * o3) * (1.f / 256.f) + RMS_EPS);
        const float g0 = bflo(cgt.x), g1 = bfhi(cgt.x), g2 = bflo(cgt.y), g3 = bfhi(cgt.y);
        o0 *= r * go.x * g0 * __builtin_amdgcn_rcpf(1.f + __expf(-g0)); o1 *= r * go.y * g1 * __builtin_amdgcn_rcpf(1.f + __expf(-g1));
        o2 *= r * go.z * g2 * __builtin_amdgcn_rcpf(1.f + __expf(-g2)); o3 *= r * go.w * g3 * __builtin_amdgcn_rcpf(1.f + __expf(-g3));
        *(u32x2*)(row + C_GG + h * 256 + lane * 4) = (u32x2){pk2(o0, o1), pk2(o2, o3)};
    }
#undef GFLOAD
}

__device__ __forceinline__ void phase_merge(const Params& p, int g, char* lds, int u) {
    const int tid_ = otid(), lane = tid_ & 63, wid = tid_ >> 6, wm = wid >> 2, wn = wid & 3, fr = lane & 15, fq = lane >> 4;
    const bf16_t* P = (const bf16_t*)(p.ws + WS_PROJ); bf16_t* M = (bf16_t*)(p.ws + WS_VT);
    for (int pn = 0; pn < 4; ++pn) {
        const int m0 = u * 128, n0 = pn * 256;
        f32x4 macc[4][4];
#pragma unroll
        for (int i = 0; i < 4; ++i)
#pragma unroll
            for (int j = 0; j < 4; ++j) macc[i][j] = (f32x4){0.f, 0.f, 0.f, 0.f};
        for (int br = 0; br < 3; ++br) {
            f32x4 acc[4][4];
#pragma unroll
            for (int i = 0; i < 4; ++i)
#pragma unroll
                for (int j = 0; j < 4; ++j) acc[i][j] = (f32x4){0.f, 0.f, 0.f, 0.f};
            const int acol = br == 0 ? C_GG : (br == 1 ? C_DQ : C_MQ);
            gemm_kloop<true, 4>(acc, P + (size_t)m0 * NP + acol, NP, (const bf16_t*)(p.ws + WS_WOT) + (size_t)br * D * D + (size_t)n0 * D, D, D, lds);
#pragma unroll
            for (int mt = 0; mt < 4; ++mt)
#pragma unroll
                for (int nt = 0; nt < 4; ++nt) {
                    const int row = m0 + wm * 64 + mt * 16 + fr, col = n0 + wn * 64 + nt * 16 + fq * 4;
                    const u32x2 gt = *(const u32x2*)(P + (size_t)row * NP + C_BG + br * 1024 + col);
                    f32x4 sg; sg.x = __builtin_amdgcn_rcpf(1.f + __expf(-bflo(gt.x))); sg.y = __builtin_amdgcn_rcpf(1.f + __expf(-bfhi(gt.x))); sg.z = __builtin_amdgcn_rcpf(1.f + __expf(-bflo(gt.y))); sg.w = __builtin_amdgcn_rcpf(1.f + __expf(-bfhi(gt.y)));
                    macc[mt][nt] += sg * acc[mt][nt];
                }
        }
#pragma unroll
        for (int mt = 0; mt < 4; ++mt)
#pragma unroll
            for (int nt = 0; nt < 4; ++nt) {
                const int row = m0 + wm * 64 + mt * 16 + fr, col = n0 + wn * 64 + nt * 16 + fq * 4;
                *(u32x2*)(M + (size_t)row * D + col) = (u32x2){pk2(macc[mt][nt].x, macc[mt][nt].y), pk2(macc[mt][nt].z, macc[mt][nt].w)};
            }
    }
}

__device__ __forceinline__ void phase_outproj(const Params& p, int g, char* lds, int u) {
    const Grp G = get_group(p, g);
    const int tid_ = otid(), lane = tid_ & 63, wid = tid_ >> 6, wm = wid >> 2, wn = wid & 3, fr = lane & 15, fq = lane >> 4;
    const bf16_t* M = (const bf16_t*)(p.ws + WS_VT); const bf16_t* W = (const bf16_t*)(p.ws + WS_WOT) + (size_t)3 * D * D;
    for (int pn = 0; pn < 4; ++pn) {
        const int m0 = u * 128, n0 = pn * 256;
        f32x4 acc[4][4];
#pragma unroll
        for (int i = 0; i < 4; ++i)
#pragma unroll
            for (int j = 0; j < 4; ++j) acc[i][j] = (f32x4){0.f, 0.f, 0.f, 0.f};
        gemm_kloop<true, 4>(acc, M + (size_t)m0 * D, D, W + (size_t)n0 * D, D, D, lds);
#pragma unroll
        for (int mt = 0; mt < 4; ++mt)
#pragma unroll
            for (int nt = 0; nt < 4; ++nt) {
                const int row = m0 + wm * 64 + mt * 16 + fr, col = n0 + wn * 64 + nt * 16 + fq * 4;
                const f32x4 xv = *(const f32x4*)(G.x + (size_t)row * D + col);
                *(f32x4*)(G.out + (size_t)row * D + col) = xv + acc[mt][nt];
            }
    }
}

__device__ __forceinline__ void phase_peerq(const Params& p, int g, char* lds, int u) {
    const int tid_ = otid(), lane = tid_ & 63, wid = tid_ >> 6, wm = wid >> 2, wn = wid & 3, fr = lane & 15, fq = lane >> 4;
    const bf16_t* A = (const bf16_t*)(p.ws + WS_HB); const bf16_t* W = (const bf16_t*)(p.ws + WS_WQT); bf16_t* P = (bf16_t*)(p.ws + WS_PROJ);
    for (int pn = 0; pn < 8; ++pn) {
        const int m0 = u * 128, n0 = pn * 256;
        f32x4 acc[4][4];
#pragma unroll
        for (int i = 0; i < 4; ++i)
#pragma unroll
            for (int j = 0; j < 4; ++j) acc[i][j] = (f32x4){0.f, 0.f, 0.f, 0.f};
        gemm_kloop<true, 4>(acc, A + (size_t)m0 * D, D, W + (size_t)n0 * D, D, D, lds);
#pragma unroll
        for (int mt = 0; mt < 4; ++mt)
#pragma unroll
            for (int nt = 0; nt < 4; ++nt) {
                const int row = m0 + wm * 64 + mt * 16 + fr, col = n0 + wn * 64 + nt * 16 + fq * 4;
                *(u32x2*)(P + (size_t)row * NP + col) = (u32x2){pk2(acc[mt][nt].x, acc[mt][nt].y), pk2(acc[mt][nt].z, acc[mt][nt].w)};
            }
    }
}

__device__ __forceinline__ unsigned f2ord(float f) { const unsigned u = __float_as_uint(f); return (u & 0x80000000u) ? ~u : (u | 0x80000000u); }
__device__ __forceinline__ float ord2f(unsigned k) { const unsigned u = (k & 0x80000000u) ? (k & 0x7fffffffu) : ~k; return __uint_as_float(u); }
__device__ __forceinline__ unsigned gmax16(unsigned v) {
    unsigned t;
    t = sxoru<1>(v); v = v > t ? v : t; t = sxoru<2>(v); v = v > t ? v : t; t = sxoru<4>(v); v = v > t ? v : t; t = sxoru<8>(v); v = v > t ? v : t;
    return v;
}
__device__ __forceinline__ float gsum16(float v) { v += sxor<1>(v); v += sxor<2>(v); v += sxor<4>(v); v += sxor<8>(v); return v; }
__device__ __forceinline__ float gelu_exact(float v) {
    const float av = fabsf(v), t = __builtin_amdgcn_rcpf(av * 0.2316418882f + 1.0f);
    float q = t * 0.5307027145f + (-0.7265760135f); q = q * t + 0.7107068705f; q = q * t + (-0.142248368f); q = q * t + 0.127414796f; q = q * t;
    const float e = __builtin_amdgcn_exp2f(v * v * (-0.72134752044f));
    const float m = v * (q * e);
    return v < 0.f ? m : v - m;
}

__device__ __forceinline__ void phase_peer(const Params& p, int g, char* lds, int tile0, int ntile) {
    const Grp G = get_group(p, g);
    const int tid = otid(), lane = tid & 63, wid = tid >> 6, fr = lane & 15, fq = lane >> 4;
    const bf16_t* P = (const bf16_t*)(p.ws + WS_PROJ); const bf16_t* HB = (const bf16_t*)(p.ws + WS_HB);
    const bf16_t* K12 = (const bf16_t*)(p.ws + WS_K12);
    float* SC = (float*)lds;
    int* EIDX = (int*)(lds + 65536);
    float* GATE = (float*)(lds + 65536 + 4096);
    char* KL = lds + 73728;
    for (int i = tid; i < 2 * 128 * 16; i += NTHR) {
        const int r = i >> 4, ch = i & 15;
        *(u32x4*)(KL + r * 272 + ch * 16) = *(const u32x4*)(K12 + (size_t)r * 128 + ch * 8);
    }
    __syncthreads();
    for (int tile = tile0; tile < tile0 + ntile; ++tile) {
        const int tok0 = tile * 8;
        {
            const bf16_t* qtok = P + (size_t)(tok0 + wid) * NP + (fr & 7) * 256;
#pragma unroll
            for (int half = 0; half < 2; ++half) {
                f32x4 acc[8];
#pragma unroll
                for (int i = 0; i < 8; ++i) acc[i] = (f32x4){0.f, 0.f, 0.f, 0.f};
                bf16x8 af[4], kfa[8], kfb[8];
#pragma unroll
                for (int ks = 0; ks < 4; ++ks) af[ks] = *(const bf16x8*)(qtok + half * 128 + ks * 32 + fq * 8);
#define KFLOAD(BUF, KS) do { _Pragma("unroll") for (int nt = 0; nt < 8; ++nt) BUF[nt] = *(const bf16x8*)(KL + (half * 128 + nt * 16 + fr) * 272 + (KS) * 64 + fq * 16); } while (0)
#define KFMMA(BUF, KS) do { _Pragma("unroll") for (int nt = 0; nt < 8; ++nt) acc[nt] = mfma16(af[KS], BUF[nt], acc[nt]); } while (0)
                KFLOAD(kfa, 0);
                __builtin_amdgcn_sched_barrier(0);
                KFLOAD(kfb, 1); KFMMA(kfa, 0);
                __builtin_amdgcn_sched_barrier(0);
                KFLOAD(kfa, 2); KFMMA(kfb, 1);
                __builtin_amdgcn_sched_barrier(0);
                KFLOAD(kfb, 3); KFMMA(kfa, 2);
                __builtin_amdgcn_sched_barrier(0);
                KFMMA(kfb, 3);
#undef KFLOAD
#undef KFMMA
                if (fq < 2) {
#pragma unroll
                    for (int nt = 0; nt < 8; ++nt) {
                        float* dst = SC + (wid * 8 + fq * 4) * 256 + half * 128 + nt * 16 + fr;
                        dst[0] = acc[nt].x; dst[256] = acc[nt].y; dst[512] = acc[nt].z; dst[768] = acc[nt].w;
                    }
                }
            }
        }
        __builtin_amdgcn_wave_barrier();
        {
            const int sl = fr, gb = fq * 16;
            const int row0_ = wid * 8 + fq, row1_ = wid * 8 + 4 + fq;
            float v1[2] = {0.f, 0.f}, v2[2] = {0.f, 0.f}; int i1[2] = {0, 0}, i2[2] = {0, 0};
            {
                unsigned kc[4][8];
#pragma unroll
                for (int c4 = 0; c4 < 4; ++c4)
#pragma unroll
                    for (int i = 0; i < 8; ++i) { const int idx = sl + 16 * i;
                        kc[c4][i] = (f2ord(SC[((c4 & 1) ? row1_ : row0_) * 256 + (c4 >> 1) * 128 + idx]) & ~127u) | (unsigned)(127 - idx); }
                float sv[4] = {0.f, 0.f, 0.f, 0.f}; int si[4] = {0, 0, 0, 0};
                for (int r = 0; r < 16; ++r) {
                    unsigned m[4], t[4];
#pragma unroll
                    for (int c4 = 0; c4 < 4; ++c4) {
                        const unsigned x0 = kc[c4][0] > kc[c4][1] ? kc[c4][0] : kc[c4][1], x1 = kc[c4][2] > kc[c4][3] ? kc[c4][2] : kc[c4][3];
                        const unsigned x2 = kc[c4][4] > kc[c4][5] ? kc[c4][4] : kc[c4][5], x3 = kc[c4][6] > kc[c4][7] ? kc[c4][6] : kc[c4][7];
                        const unsigned y0 = x0 > x1 ? x0 : x1, y1 = x2 > x3 ? x2 : x3; m[c4] = y0 > y1 ? y0 : y1;
                    }
#pragma unroll
                    for (int c4 = 0; c4 < 4; ++c4) t[c4] = sxoru<1>(m[c4]);
#pragma unroll
                    for (int c4 = 0; c4 < 4; ++c4) m[c4] = m[c4] > t[c4] ? m[c4] : t[c4];
#pragma unroll
                    for (int c4 = 0; c4 < 4; ++c4) t[c4] = sxoru<2>(m[c4]);
#pragma unroll
                    for (int c4 = 0; c4 < 4; ++c4) m[c4] = m[c4] > t[c4] ? m[c4] : t[c4];
#pragma unroll
                    for (int c4 = 0; c4 < 4; ++c4) t[c4] = sxoru<4>(m[c4]);
#pragma unroll
                    for (int c4 = 0; c4 < 4; ++c4) m[c4] = m[c4] > t[c4] ? m[c4] : t[c4];
#pragma unroll
                    for (int c4 = 0; c4 < 4; ++c4) t[c4] = sxoru<8>(m[c4]);
#pragma unroll
                    for (int c4 = 0; c4 < 4; ++c4) m[c4] = m[c4] > t[c4] ? m[c4] : t[c4];
#pragma unroll
                    for (int c4 = 0; c4 < 4; ++c4) {
                        if (sl == r) { sv[c4] = ord2f(m[c4] & ~127u); si[c4] = 127 - (int)(m[c4] & 127u); }
#pragma unroll
                        for (int i = 0; i < 8; ++i) kc[c4][i] = kc[c4][i] == m[c4] ? 0u : kc[c4][i];
                    }
                }
                v1[0] = sv[0]; i1[0] = si[0]; v1[1] = sv[1]; i1[1] = si[1]; v2[0] = sv[2]; i2[0] = si[2]; v2[1] = sv[3]; i2[1] = si[3];
            }
            int pa = 0, pb = 0; float tsa = 0.f, tsb = 0.f; int pida = 0, pidb = 0;
            for (int r = 0; r < 16; ++r) {
                const float va = __int_as_float(__builtin_amdgcn_ds_bpermute((gb + (pa & 15)) << 2, __float_as_int(v2[0])));
                const float vb = __int_as_float(__builtin_amdgcn_ds_bpermute((gb + (pb & 15)) << 2, __float_as_int(v2[1])));
                const unsigned keya = pa < 16 ? ((f2ord(v1[0] + va) & ~255u) | (unsigned)(255 - (sl * 16 + pa))) : 0u;
                const unsigned keyb = pb < 16 ? ((f2ord(v1[1] + vb) & ~255u) | (unsigned)(255 - (sl * 16 + pb))) : 0u;
                unsigned ma = keya, mb = keyb, ta, tb;
                ta = sxoru<1>(ma); tb = sxoru<1>(mb); ma = ma > ta ? ma : ta; mb = mb > tb ? mb : tb;
                ta = sxoru<2>(ma); tb = sxoru<2>(mb); ma = ma > ta ? ma : ta; mb = mb > tb ? mb : tb;
                ta = sxoru<4>(ma); tb = sxoru<4>(mb); ma = ma > ta ? ma : ta; mb = mb > tb ? mb : tb;
                ta = sxoru<8>(ma); tb = sxoru<8>(mb); ma = ma > ta ? ma : ta; mb = mb > tb ? mb : tb;
                if (sl == r) { tsa = ord2f(ma & ~255u); pida = 255 - (int)(ma & 255u); tsb = ord2f(mb & ~255u); pidb = 255 - (int)(mb & 255u); }
                if (keya == ma) pa++;
                if (keyb == mb) pb++;
            }
#pragma unroll
            for (int ps = 0; ps < 2; ++ps) {
                const int pid = ps ? pidb : pida; const float ts = ps ? tsb : tsa; const int row = ps ? row1_ : row0_;
                const int e1 = __builtin_amdgcn_ds_bpermute((gb + (pid >> 4)) << 2, i1[ps]), e2 = __builtin_amdgcn_ds_bpermute((gb + (pid & 15)) << 2, i2[ps]);
                float mx = ts;
                mx = fmaxf(mx, sxor<1>(mx)); mx = fmaxf(mx, sxor<2>(mx)); mx = fmaxf(mx, sxor<4>(mx)); mx = fmaxf(mx, sxor<8>(mx));
                const float ex = __expf(ts - mx), sm = gsum16(ex);
                EIDX[row * 16 + sl] = e1 * 128 + e2; GATE[row * 16 + sl] = ex / sm;
            }
        }
        __builtin_amdgcn_wave_barrier();
        {
            const int tok = tok0 + wid;
            const bf16_t* hrow = HB + (size_t)tok * D;
            const int grp = lane >> 4, sl = lane & 15;
            {
                f32x2 hv[32];
#pragma unroll
                for (int c = 0; c < 8; ++c) {
                    const u32x4 hq = *(const u32x4*)(hrow + sl * 64 + c * 8);
                    hv[c * 4 + 0] = (f32x2){bflo(hq.x), bfhi(hq.x)} * (1.0f / PEER_SU); hv[c * 4 + 1] = (f32x2){bflo(hq.y), bfhi(hq.y)} * (1.0f / PEER_SU);
                    hv[c * 4 + 2] = (f32x2){bflo(hq.z), bfhi(hq.z)} * (1.0f / PEER_SU); hv[c * 4 + 3] = (f32x2){bflo(hq.w), bfhi(hq.w)} * (1.0f / PEER_SU);
                }
                const unsigned char* PU8 = p.ws + WS_PU + sl * 64;
#define ULOADG(BUF, IT) do { _Pragma("unroll") for (int i_ = 0; i_ < 2; ++i_) { const int k_ = ((IT) + i_) * 4 + grp; const unsigned char* ur_ = PU8 + (size_t)EIDX[wid * 128 + k_] * D; \
        BUF[i_ * 4 + 0] = *(const u32x4*)ur_; BUF[i_ * 4 + 1] = *(const u32x4*)(ur_ + 16); BUF[i_ * 4 + 2] = *(const u32x4*)(ur_ + 32); BUF[i_ * 4 + 3] = *(const u32x4*)(ur_ + 48); } } while (0)
#define PDOT(uq, base) \
        a2 += __builtin_amdgcn_cvt_pk_f32_fp8((int)uq.x, false) * hv[base + 0]; b2 += __builtin_amdgcn_cvt_pk_f32_fp8((int)uq.x, true) * hv[base + 1]; \
        a2 += __builtin_amdgcn_cvt_pk_f32_fp8((int)uq.y, false) * hv[base + 2]; b2 += __builtin_amdgcn_cvt_pk_f32_fp8((int)uq.y, true) * hv[base + 3]; \
        a2 += __builtin_amdgcn_cvt_pk_f32_fp8((int)uq.z, false) * hv[base + 4]; b2 += __builtin_amdgcn_cvt_pk_f32_fp8((int)uq.z, true) * hv[base + 5]; \
        a2 += __builtin_amdgcn_cvt_pk_f32_fp8((int)uq.w, false) * hv[base + 6]; b2 += __builtin_amdgcn_cvt_pk_f32_fp8((int)uq.w, true) * hv[base + 7];
#define UCOMP(BUF, IT) do { _Pragma("unroll") for (int i_ = 0; i_ < 2; ++i_) { const int k_ = ((IT) + i_) * 4 + grp; \
        f32x2 a2 = (f32x2){0.f, 0.f}, b2 = (f32x2){0.f, 0.f}; \
        PDOT(BUF[i_ * 4 + 0], 0) PDOT(BUF[i_ * 4 + 1], 8) PDOT(BUF[i_ * 4 + 2], 16) PDOT(BUF[i_ * 4 + 3], 24) \
        a2 += b2; const float a_ = gsum16(a2.x + a2.y); GATE[wid * 128 + k_] = GATE[wid * 128 + k_] * gelu_exact(a_); } } while (0)
                u32x4 ubA[8], ubB[8];
                ULOADG(ubA, 0);
                for (int it0 = 0; it0 < 32; it0 += 4) {
                    ULOADG(ubB, it0 + 2);
                    __builtin_amdgcn_sched_barrier(0);
                    UCOMP(ubA, it0);
                    __builtin_amdgcn_sched_barrier(0);
                    if (it0 + 4 < 32) ULOADG(ubA, it0 + 4);
                    __builtin_amdgcn_sched_barrier(0);
                    UCOMP(ubB, it0 + 2);
                    __builtin_amdgcn_sched_barrier(0);
                }
#undef ULOADG
#undef PDOT
#undef UCOMP
            }
            __builtin_amdgcn_wave_barrier();
            f32x2 acc[8];
#pragma unroll
            for (int i = 0; i < 8; ++i) acc[i] = (f32x2){0.f, 0.f};
            const unsigned char* PV8 = p.ws + WS_PV + lane * 16;
#define VLOADG(BUF, K0) do { _Pragma("unroll") for (int i_ = 0; i_ < 8; ++i_) BUF[i_] = *(const u32x4*)(PV8 + (size_t)EIDX[wid * 128 + (K0) + i_] * D); } while (0)
#define VCOMP(BUF, K0) do { _Pragma("unroll") for (int i_ = 0; i_ < 8; ++i_) { const float w_ = GATE[wid * 128 + (K0) + i_]; const f32x2 w2 = (f32x2){w_, w_}; const u32x4 v = BUF[i_]; \
        acc[0] += w2 * __builtin_amdgcn_cvt_pk_f32_fp8((int)v.x, false); acc[1] += w2 * __builtin_amdgcn_cvt_pk_f32_fp8((int)v.x, true); \
        acc[2] += w2 * __builtin_amdgcn_cvt_pk_f32_fp8((int)v.y, false); acc[3] += w2 * __builtin_amdgcn_cvt_pk_f32_fp8((int)v.y, true); \
        acc[4] += w2 * __builtin_amdgcn_cvt_pk_f32_fp8((int)v.z, false); acc[5] += w2 * __builtin_amdgcn_cvt_pk_f32_fp8((int)v.z, true); \
        acc[6] += w2 * __builtin_amdgcn_cvt_pk_f32_fp8((int)v.w, false); acc[7] += w2 * __builtin_amdgcn_cvt_pk_f32_fp8((int)v.w, true); } } while (0)
            {
                u32x4 vbA[8], vbB[8];
                VLOADG(vbA, 0);
                for (int k0 = 0; k0 < 128; k0 += 16) {
                    VLOADG(vbB, k0 + 8);
                    __builtin_amdgcn_sched_barrier(0);
                    VCOMP(vbA, k0);
                    __builtin_amdgcn_sched_barrier(0);
                    if (k0 + 16 < 128) VLOADG(vbA, k0 + 16);
                    __builtin_amdgcn_sched_barrier(0);
                    VCOMP(vbB, k0 + 8);
                    __builtin_amdgcn_sched_barrier(0);
                }
            }
#undef VLOADG
#undef VCOMP
            float* orow = G.out + (size_t)tok * D + lane * 16;
#pragma unroll
            for (int i = 0; i < 4; ++i) {
                f32x4 t = *(f32x4*)(orow + i * 4);
                t.x += acc[2 * i].x * (1.0f / PEER_SV); t.y += acc[2 * i].y * (1.0f / PEER_SV); t.z += acc[2 * i + 1].x * (1.0f / PEER_SV); t.w += acc[2 * i + 1].y * (1.0f / PEER_SV);
                *(f32x4*)(orow + i * 4) = t;
            }
        }
        __builtin_amdgcn_wave_barrier();
    }
}


constexpr int NPH = 3 + NGROUP * 3;
__device__ __forceinline__ void run_phase(const Params& p, int ph, char* lds, int* s_item) {
    const int g = (ph - 3) / 3, s = (ph - 3) % 3;
    const Grp G = get_group(p, g);
    if (s == 0) {
        for (int u = blockIdx.x; u < 256; u += gridDim.x) {
            const int m0 = (u >> 1) * 256;
            phase_rmsnorm(G.x, p.in[I_GMIX], (bf16_t*)(p.ws + WS_HB), m0, 256);
            __syncthreads();
            phase_inproj(p, g, lds, u);
            __syncthreads();
        }
    } else if (s == 1) {
        phase_mixer(p, g, lds, s_item);
    } else {
        for (int u = blockIdx.x; u < 256; u += gridDim.x) {
            const int m0 = u * 128;
            phase_glafin(p, g, m0, 128);
            __syncthreads();
            phase_merge(p, g, lds, u);
            __syncthreads();
            phase_outproj(p, g, lds, u);
            __syncthreads();
            phase_rmsnorm(G.out, p.in[I_GFFN], (bf16_t*)(p.ws + WS_HB), m0, 128);
            __syncthreads();
            phase_peerq(p, g, lds, u);
            __syncthreads();
            phase_peer(p, g, lds, m0 / 8, 16);
            __syncthreads();
        }
    }
}

__global__ void __launch_bounds__(NTHR) mega_kernel(Params p) {
    extern __shared__ __attribute__((aligned(16))) char lds[];
    __shared__ int s_item;
    cg::grid_group grid = cg::this_grid();
    phase_p0a(p, lds); grid.sync();
    phase_p0b(p, lds); grid.sync();
    phase_p0c(p); grid.sync();
    for (int ph = 3; ph < NPH; ++ph) {
        run_phase(p, ph, lds, &s_item);
        if (ph + 1 < NPH) grid.sync();
    }
}

extern "C" void kernel_launch(void* const* d_in, const int* in_sizes, int n_in, void* d_out, int out_size, void* d_ws, size_t ws_size, hipStream_t stream) {
    static int grid_blocks = 0;
    if (grid_blocks == 0) {
        if (n_in != 32 || ws_size < WS_END) { fprintf(stderr, "kernel_launch: unexpected n_in %d or ws_size %zu (< %zu)\n", n_in, ws_size, (size_t)WS_END); grid_blocks = -1; return; }
        int dev = 0, cus = 0, per_cu = 0;
        hipGetDevice(&dev);
        hipDeviceGetAttribute(&cus, hipDeviceAttributeMultiprocessorCount, dev);
        hipFuncSetAttribute((const void*)mega_kernel, hipFuncAttributeMaxDynamicSharedMemorySize, LDS_BYTES);
        hipOccupancyMaxActiveBlocksPerMultiprocessor(&per_cu, (const void*)mega_kernel, NTHR, LDS_BYTES);
        if (per_cu < 1) per_cu = 1;
        grid_blocks = cus * per_cu;
        (void)hipGetLastError();
    }
    if (grid_blocks < 0) return;
    Params p{};
    for (int i = 0; i < 32; ++i) p.in[i] = (const float*)d_in[i];
    p.out = (float*)d_out; p.ws = (unsigned char*)d_ws; p.ph_lo = 0; p.ph_hi = NPH;
    void* args[] = {&p};
    hipError_t e = hipLaunchCooperativeKernel((const void*)mega_kernel, dim3(grid_blocks), dim3(NTHR), args, LDS_BYTES, stream);
    if (e != hipSuccess) fprintf(stderr, "cooperative launch failed: %s (grid %d)\n", hipGetErrorString(e), grid_blocks);
}
```

```cpp
#include <hip/hip_runtime.h>
#include <hip/hip_cooperative_groups.h>
#include <cstdio>
#include <cstdint>
namespace cg = cooperative_groups;

typedef unsigned short bf16_t;
typedef short bf16x8 __attribute__((ext_vector_type(8)));
typedef float f32x4 __attribute__((ext_vector_type(4)));
typedef unsigned u32x4 __attribute__((ext_vector_type(4)));
typedef unsigned u32x2 __attribute__((ext_vector_type(2)));

constexpr int D = 1024;
constexpr int NP = 10496;
constexpr int IN_COLS = 10272;
constexpr int C_GQ = 0, C_GK = 512, C_GV = 1024, C_GG = 2048, C_DQ = 3072, C_DK = 4096, C_DV = 5120, C_MQ = 6144, C_BG = 7168, C_LR = 10240;
constexpr int G_TOK = 32768;
constexpr int NGROUP = 3;
constexpr int NTHR = 512;
constexpr float RMS_EPS = 1e-6f;
constexpr float LOG2E = 1.4426950408889634f;
constexpr int LDS_BYTES = 147456;
constexpr float PEER_SU = 32.0f, PEER_SV = 8.0f;

enum { I_XP = 0, I_XS, I_MP, I_MS, I_GMIX, I_WIN, I_WDF, I_BDF, I_WDB, I_BDB, I_GOUT, I_GWO, I_DGQ, I_DGK, I_LQ1, I_LK1, I_LQ2, I_LK2,
       I_DGSUB, I_DWO, I_MGN, I_MWKV, I_MGQ, I_MGK, I_MWO, I_WOUT, I_GFFN, I_PWQ, I_PK1, I_PK2, I_PU, I_PV };

constexpr size_t al256(size_t x) { return (x + 255) & ~(size_t)255; }
constexpr size_t WS_CTRL = 0;
constexpr size_t WS_PROJ = 4096;
constexpr size_t WS_HB   = WS_PROJ + (size_t)G_TOK * NP * 2;
constexpr size_t WS_VT   = WS_HB + (size_t)G_TOK * D * 2;
constexpr size_t WS_WINT = WS_VT + (size_t)G_TOK * D * 2;
constexpr size_t WS_WOT  = WS_WINT + (size_t)NP * D * 2;
constexpr size_t WS_WKVT = WS_WOT + (size_t)4 * D * D * 2;
constexpr size_t WS_WQT  = WS_WKVT + (size_t)2048 * D * 2;
constexpr size_t WS_PU   = WS_WQT + (size_t)2048 * D * 2;
constexpr size_t WS_PV   = WS_PU + (size_t)16384 * D * 2;
constexpr size_t WS_K12  = WS_PV + (size_t)16384 * D * 2;
constexpr size_t WS_ROPE = WS_K12 + (size_t)2 * 128 * 128 * 2;
constexpr size_t WS_HM   = WS_ROPE + (size_t)16384 * 64 * 4;
constexpr size_t WS_KVR  = WS_HM + (size_t)2560 * D * 2;
constexpr size_t WS_MEMK = WS_KVR + (size_t)2560 * 2048 * 4;
constexpr size_t WS_MEMV = WS_MEMK + (size_t)10 * 4 * 256 * 256 * 2;
constexpr size_t WS_END  = WS_MEMV + (size_t)10 * 4 * 256 * 256 * 2;

struct Params {
    const float* in[32];
    float* out;
    unsigned char* ws;
    int ph_lo, ph_hi;
};

typedef float f32x2 __attribute__((ext_vector_type(2)));
typedef __bf16 bf16x2v __attribute__((ext_vector_type(2)));
__device__ __forceinline__ unsigned pk2(float lo, float hi) { const f32x2 v = {lo, hi}; const bf16x2v b = __builtin_convertvector(v, bf16x2v); return __builtin_bit_cast(unsigned, b); }
__device__ __forceinline__ float bflo(unsigned u) { return __uint_as_float(u << 16); }
__device__ __forceinline__ float bfhi(unsigned u) { return __uint_as_float(u & 0xffff0000u); }
__device__ __forceinline__ float bf2f(bf16_t b) { return __uint_as_float(((unsigned)b) << 16); }
__device__ __forceinline__ bf16_t f2bf(float f) { return (bf16_t)(pk2(f, 0.f) & 0xffffu); }
__device__ __forceinline__ f32x4 mfma16(bf16x8 a, bf16x8 b, f32x4 c) { return __builtin_amdgcn_mfma_f32_16x16x32_bf16(a, b, c, 0, 0, 0); }
__device__ __forceinline__ float fexp2(float x) { return __builtin_amdgcn_exp2f(x); }
template <class T> __device__ __forceinline__ T* launder(T* q) { asm volatile("" : "+s"(q)); return q; }
__device__ __forceinline__ int otid() { int t = threadIdx.x; asm volatile("" : "+v"(t)); return t; }
template <int M> __device__ __forceinline__ float sxor(float v) {
    if (M < 32) return __int_as_float(__builtin_amdgcn_ds_swizzle(__float_as_int(v), (M << 10) | 0x1F));
    const int l = otid() & 63; return __int_as_float(__builtin_amdgcn_ds_bpermute((l ^ 32) << 2, __float_as_int(v)));
}
template <int M> __device__ __forceinline__ unsigned sxoru(unsigned v) { return (unsigned)__builtin_amdgcn_ds_swizzle((int)v, (M << 10) | 0x1F); }
__device__ __forceinline__ float wave_sum(float v) {
    v += sxor<1>(v); v += sxor<2>(v); v += sxor<4>(v); v += sxor<8>(v); v += sxor<16>(v); v += sxor<32>(v);
    return v;
}

struct Grp { const float* x; const float* mem; float* out; int B, T, mb0; };
__device__ __forceinline__ Grp get_group(const Params& p, int g) {
    Grp r;
    if (g == 0) { r.x = p.in[I_XP]; r.out = p.out; r.B = 2; r.T = 16384; r.mb0 = 0; }
    else { r.x = p.in[I_XS] + (size_t)(g - 1) * G_TOK * D; r.out = p.out + (size_t)g * G_TOK * D; r.B = 4; r.T = 8192; r.mb0 = 2 + (g - 1) * 4; }
    r.mem = nullptr;
    return r;
}

constexpr int G_ROW = 144;
constexpr int G_A_BYTES = 128 * G_ROW;
constexpr int G_B_BYTES = 256 * G_ROW;
constexpr int G_STAGE = G_A_BYTES + G_B_BYTES;

template <bool SWAP, int MT>
__device__ __forceinline__ void gemm_kloop(f32x4 (&acc)[MT][4], const bf16_t* __restrict__ A, int lda, const bf16_t* __restrict__ Bt, int ldb, int K, char* lds) {
    constexpr int A_ROWS = MT * 32, A_BYTES = A_ROWS * G_ROW, STAGE = A_BYTES + G_B_BYTES;
    constexpr int NA = A_BYTES / 1024, NI = STAGE / 1024, NPER = (NI + 7) / 8;
    const int tid = otid(), lane = tid & 63, wid = __builtin_amdgcn_readfirstlane(tid >> 6), wm = wid >> 2, wn = wid & 3, fr = lane & 15, fq = lane >> 4;
    unsigned goff[NPER];
#pragma unroll
    for (int i = 0; i < NPER; ++i) {
        const int j = wid + 8 * i;
        const int ci = (j < NA ? j : j - NA) * 64 + lane, row = ci / 9, ch = ci % 9, chc = ch < 8 ? ch : 7;
        goff[i] = (unsigned)(row * (j < NA ? lda : ldb) + chc * 8);
    }
#define GSTAGE(buf, k0) do { _Pragma("unroll") for (int i = 0; i < NPER; ++i) { const int j = wid + 8 * i; if (j < NI) { \
        const bf16_t* src_ = (j < NA ? A : Bt) + goff[i] + (k0); \
        __builtin_amdgcn_global_load_lds((const unsigned*)src_, (unsigned*)(lds + (buf) * STAGE + j * 1024), 16, 0, 0); } } } while (0)
    const int nk = K / 64;
    GSTAGE(0, 0);
    __syncthreads();
    for (int kt = 0; kt < nk; ++kt) {
        if (kt + 1 < nk) GSTAGE((kt + 1) & 1, (kt + 1) * 64);
        const char* base = lds + (kt & 1) * STAGE;
        const char* abase = base + (wm * (MT * 16) + fr) * G_ROW + fq * 16;
        const char* bbase = base + A_BYTES + (wn * 64 + fr) * G_ROW + fq * 16;
        bf16x8 b0[4], b1[4], ar[4];
#pragma unroll
        for (int nt = 0; nt < 4; ++nt) b0[nt] = *(const bf16x8*)(bbase + nt * 16 * G_ROW);
        ar[0] = *(const bf16x8*)(abase); ar[1] = *(const bf16x8*)(abase + 16 * G_ROW); ar[2] = *(const bf16x8*)(abase + 32 * G_ROW);
#pragma unroll
        for (int st = 0; st < 2 * MT; ++st) {
            const int ks = st / MT, mt = st % MT;
            __builtin_amdgcn_sched_barrier(0);
            if (st + 3 < 2 * MT) { const int ks2 = (st + 3) / MT, mt2 = (st + 3) % MT; ar[(st + 3) % 4] = *(const bf16x8*)(abase + mt2 * 16 * G_ROW + ks2 * 64); }
            if (ks == 0 && mt >= MT - 3 && mt < MT - 1) {
#pragma unroll
                for (int q = 0; q < 2; ++q) { const int nt = (mt - (MT - 3)) * 2 + q; b1[nt] = *(const bf16x8*)(bbase + nt * 16 * G_ROW + 64); }
            }
#pragma unroll
            for (int nt = 0; nt < 4; ++nt) {
                const bf16x8 bv = ks == 0 ? b0[nt] : b1[nt];
                acc[mt][nt] = SWAP ? mfma16(bv, ar[st % 4], acc[mt][nt]) : mfma16(ar[st % 4], bv, acc[mt][nt]);
            }
        }
        __builtin_amdgcn_sched_barrier(0);
        __syncthreads();
    }
#undef GSTAGE
}

__device__ __forceinline__ void tile_order(int t, int nM, int nN, int& pm, int& pn) {
    const int per = 8 * nN, grp = t / per, r = t % per;
    pm = grp * 8 + (r & 7); pn = r >> 3;
}

__device__ __forceinline__ void phase_p0a(const Params& p, char* lds) {
    const int tid = otid(), lane = tid & 63, wid = tid >> 6;
    unsigned char* ws = p.ws;
    if (blockIdx.x == 0 && tid < 256) atomicExch((unsigned*)(ws + WS_CTRL) + tid, 0u);
    float* scr = (float*)(lds + wid * 8448);
    constexpr int IT_WIN = 16 * (NP / 32), IT_SQ = 16 * 32, IT_W2 = 16 * 64;
    constexpr int NIT = IT_WIN + 4 * IT_SQ + 2 * IT_W2;
    for (int it0 = blockIdx.x * 8; it0 < NIT; it0 += gridDim.x * 8) {
        int it = it0 + wid;
        const float* W = nullptr; bf16_t* WT = nullptr; int N = 0, nb = 0, kb = 0, srccol = -1;
        if (it < NIT) {
            int r = it;
            if (r < IT_WIN) { W = p.in[I_WIN]; N = IN_COLS; WT = (bf16_t*)(ws + WS_WINT); kb = r / (NP / 32); nb = r % (NP / 32);
                const int n0 = nb * 32; srccol = n0 < 3072 ? n0 : (n0 < 10240 ? n0 + 32 : (n0 == 10240 ? 3072 : -1)); }
            else { r -= IT_WIN;
                if (r < 4 * IT_SQ) { const int w = r / IT_SQ; r %= IT_SQ; const int idx[4] = {I_GWO, I_DWO, I_MWO, I_WOUT};
                    W = p.in[w == 0 ? I_GWO : (w == 1 ? I_DWO : (w == 2 ? I_MWO : I_WOUT))]; (void)idx; N = 1024; WT = (bf16_t*)(ws + WS_WOT) + (size_t)w * D * D; kb = r / 32; nb = r % 32; srccol = nb * 32; }
                else { r -= 4 * IT_SQ; const int w = r / IT_W2; r %= IT_W2; W = p.in[w == 0 ? I_MWKV : I_PWQ]; N = 2048; WT = (bf16_t*)(ws + (w == 0 ? WS_WKVT : WS_WQT)); kb = r / 64; nb = r % 64; srccol = nb * 32; }
            }
            const int k0 = kb * 64;
#pragma unroll 8
            for (int i = 0; i < 32; ++i) { const int kk = 2 * i + (lane >> 5); scr[kk * 33 + (lane & 31)] = srccol >= 0 ? W[(size_t)(k0 + kk) * N + srccol + (lane & 31)] : 0.f; }
        }
        __syncthreads();
        if (it < NIT) {
            const int k0 = kb * 64, c = lane & 7;
#pragma unroll
            for (int j = 0; j < 4; ++j) { const int n = (lane >> 3) + 8 * j; const float* s = scr + (8 * c) * 33 + n;
                u32x4 o; o.x = pk2(s[0], s[33]); o.y = pk2(s[66], s[99]); o.z = pk2(s[132], s[165]); o.w = pk2(s[198], s[231]);
                *(u32x4*)(WT + (size_t)(nb * 32 + n) * D + k0 + 8 * c) = o; }
        }
        __syncthreads();
    }
    const size_t gtid = (size_t)blockIdx.x * NTHR + tid, gsz = (size_t)gridDim.x * NTHR;
    {
        const size_t n8 = (size_t)16384 * D / 8;
        for (size_t i = gtid; i < 2 * n8; i += gsz) {
            const int w = i >= n8; const size_t j = w ? i - n8 : i;
            const float* src = p.in[w ? I_PV : I_PU] + j * 8; unsigned char* dst = ws + (w ? WS_PV : WS_PU) + j * 8;
            const float sc = w ? PEER_SV : PEER_SU;
            const f32x4 a = *(const f32x4*)src * sc, b = *(const f32x4*)(src + 4) * sc;
            int lo = __builtin_amdgcn_cvt_pk_fp8_f32(a.x, a.y, 0, false); lo = __builtin_amdgcn_cvt_pk_fp8_f32(a.z, a.w, lo, true);
            int hi = __builtin_amdgcn_cvt_pk_fp8_f32(b.x, b.y, 0, false); hi = __builtin_amdgcn_cvt_pk_fp8_f32(b.z, b.w, hi, true);
            *(u32x2*)dst = (u32x2){(unsigned)lo, (unsigned)hi};
        }
        for (size_t i = gtid; i < 2 * 16384; i += gsz) {
            const int w = i >= 16384; const size_t j = w ? i - 16384 : i;
            ((bf16_t*)(ws + WS_K12))[i] = f2bf(p.in[w ? I_PK2 : I_PK1][j]);
        }
    }
    for (size_t i = gtid; i < (size_t)16384 * 32; i += gsz) {
        const int t = (int)(i >> 5), k = (int)(i & 31);
        const float inv = powf(10000.0f, -(float)(2 * k) / 64.0f);
        const float ang = (float)t * inv;
        double sn, cs; sincos((double)ang, &sn, &cs);
        float* R = (float*)(ws + WS_ROPE) + (size_t)t * 64;
        R[k] = (float)cs; R[32 + k] = (float)sn;
    }
    for (int row = blockIdx.x * 8 + wid; row < 2560; row += gridDim.x * 8) {
        const float* src = row < 512 ? p.in[I_MP] + (size_t)row * D : p.in[I_MS] + (size_t)(row - 512) * D;
        const f32x4* xr = (const f32x4*)src + lane; const f32x4* gr = (const f32x4*)p.in[I_MGN] + lane;
        f32x4 v[4]; float s = 0.f;
#pragma unroll
        for (int j = 0; j < 4; ++j) { v[j] = xr[64 * j]; s += v[j].x * v[j].x + v[j].y * v[j].y + v[j].z * v[j].z + v[j].w * v[j].w; }
        const float r = rsqrtf(wave_sum(s) * (1.f / D) + RMS_EPS);
        u32x2* o = (u32x2*)((bf16_t*)(ws + WS_HM) + (size_t)row * D) + lane;
#pragma unroll
        for (int j = 0; j < 4; ++j) { const f32x4 g = gr[64 * j]; u32x2 w; w.x = pk2(v[j].x * r * g.x, v[j].y * r * g.y); w.y = pk2(v[j].z * r * g.z, v[j].w * r * g.w); o[64 * j] = w; }
    }
}

__device__ __forceinline__ void phase_p0b(const Params& p, char* lds) {
    const int tid_ = otid(), lane = tid_ & 63, wid = tid_ >> 6, wm = wid >> 2, wn = wid & 3, fr = lane & 15, fq = lane >> 4;
    const bf16_t* A = (const bf16_t*)(p.ws + WS_HM); const bf16_t* Bt = (const bf16_t*)(p.ws + WS_WKVT);
    float* C = (float*)(p.ws + WS_KVR);
    const int nM = 20, nN = 8;
    for (int t = blockIdx.x; t < nM * nN; t += gridDim.x) {
        const int pm = t % nM, pn = t / nM, m0 = pm * 128, n0 = pn * 256;
        f32x4 acc[4][4];
#pragma unroll
        for (int i = 0; i < 4; ++i)
#pragma unroll
            for (int j = 0; j < 4; ++j) acc[i][j] = (f32x4){0.f, 0.f, 0.f, 0.f};
        gemm_kloop<true, 4>(acc, A + (size_t)m0 * D, D, Bt + (size_t)n0 * D, D, D, lds);
#pragma unroll
        for (int mt = 0; mt < 4; ++mt)
#pragma unroll
            for (int nt = 0; nt < 4; ++nt) {
                const int row = m0 + wm * 64 + mt * 16 + fr, col = n0 + wn * 64 + nt * 16 + fq * 4;
                *(f32x4*)(C + (size_t)row * 2048 + col) = acc[mt][nt];
            }
        __syncthreads();
        {
            bf16_t* MK = (bf16_t*)(p.ws + WS_MEMK); bf16_t* MV = (bf16_t*)(p.ws + WS_MEMV);
            for (int r = wid; r < 128; r += 8) {
                const int row = m0 + r, b = row >> 8, m = row & 255;
                const f32x4 kv = *(const f32x4*)(C + (size_t)row * 2048 + n0 + lane * 4);
                if (pn < 4) {
                    const int h = pn;
                    const float ss = wave_sum(kv.x * kv.x + kv.y * kv.y + kv.z * kv.z + kv.w * kv.w);
                    const float rr = rsqrtf(ss * (1.f / 256.f) + RMS_EPS);
                    const f32x4 g = *(const f32x4*)(p.in[I_MGK] + lane * 4);
                    u32x2 w; w.x = pk2(kv.x * rr * g.x, kv.y * rr * g.y); w.y = pk2(kv.z * rr * g.z, kv.w * rr * g.w);
                    *(u32x2*)(MK + ((size_t)(b * 4 + h) * 256 + m) * 256 + lane * 4) = w;
                } else {
                    const int h = pn - 4;
                    const int pos = (m & ~31) + ((m >> 2) & 3) * 8 + ((m >> 4) & 1) * 4 + (m & 3);
                    bf16_t* dst = MV + ((size_t)(b * 4 + h) * 256 + lane * 4) * 256 + pos;
                    dst[0] = f2bf(kv.x); dst[256] = f2bf(kv.y); dst[512] = f2bf(kv.z); dst[768] = f2bf(kv.w);
                }
            }
        }
        __syncthreads();
    }
}

__device__ __forceinline__ void phase_p0c(const Params& p) {
    const int tid_ = otid(), lane = tid_ & 63, wid = tid_ >> 6;
    const float* KV = (const float*)(p.ws + WS_KVR);
    bf16_t* MK = (bf16_t*)(p.ws + WS_MEMK); bf16_t* MV = (bf16_t*)(p.ws + WS_MEMV);
    for (int it = blockIdx.x * 8 + wid; it < 2560 * 4; it += gridDim.x * 8) {
        const int row = it >> 2, h = it & 3, b = row >> 8, m = row & 255;
        const f32x4 kv = *(const f32x4*)(KV + (size_t)row * 2048 + h * 256 + lane * 4);
        const float ss = wave_sum(kv.x * kv.x + kv.y * kv.y + kv.z * kv.z + kv.w * kv.w);
        const float r = rsqrtf(ss * (1.f / 256.f) + RMS_EPS);
        const f32x4 g = *(const f32x4*)(p.in[I_MGK] + lane * 4);
        u32x2 w; w.x = pk2(kv.x * r * g.x, kv.y * r * g.y); w.y = pk2(kv.z * r * g.z, kv.w * r * g.w);
        *(u32x2*)(MK + ((size_t)(b * 4 + h) * 256 + m) * 256 + lane * 4) = w;
        const f32x4 vv = *(const f32x4*)(KV + (size_t)row * 2048 + 1024 + h * 256 + lane * 4);
        const int pos = (m & ~31) + ((m >> 2) & 3) * 8 + ((m >> 4) & 1) * 4 + (m & 3);
        bf16_t* dst = MV + ((size_t)(b * 4 + h) * 256 + lane * 4) * 256 + pos;
        dst[0] = f2bf(vv.x); dst[256] = f2bf(vv.y); dst[512] = f2bf(vv.z); dst[768] = f2bf(vv.w);
    }
}

__device__ __forceinline__ void phase_rmsnorm(const float* X, const float* gain, bf16_t* O, int row0, int nrows) {
    const int tid_ = otid(), lane = tid_ & 63, wid = tid_ >> 6;
    const f32x4* gr = (const f32x4*)launder(gain) + lane;
    f32x4 g[4];
#pragma unroll
    for (int j = 0; j < 4; ++j) g[j] = gr[64 * j];
    f32x4 vn[4];
    { const f32x4* xr = (const f32x4*)(X + (size_t)(row0 + wid) * D) + lane;
#pragma unroll
      for (int j = 0; j < 4; ++j) vn[j] = xr[64 * j]; }
    for (int row = row0 + wid; row < row0 + nrows; row += 8) {
        f32x4 v[4]; float s = 0.f;
#pragma unroll
        for (int j = 0; j < 4; ++j) v[j] = vn[j];
        if (row + 8 < row0 + nrows) { const f32x4* xr = (const f32x4*)(X + (size_t)(row + 8) * D) + lane;
#pragma unroll
            for (int j = 0; j < 4; ++j) vn[j] = xr[64 * j]; }
        __builtin_amdgcn_sched_barrier(0);
#pragma unroll
        for (int j = 0; j < 4; ++j) s += v[j].x * v[j].x + v[j].y * v[j].y + v[j].z * v[j].z + v[j].w * v[j].w;
        const float r = rsqrtf(wave_sum(s) * (1.f / D) + RMS_EPS);
        u32x2* o = (u32x2*)(O + (size_t)row * D) + lane;
#pragma unroll
        for (int j = 0; j < 4; ++j) { u32x2 w; w.x = pk2(v[j].x * r * g[j].x, v[j].y * r * g[j].y); w.y = pk2(v[j].z * r * g[j].z, v[j].w * r * g[j].w); o[64 * j] = w; }
    }
}

__device__ __forceinline__ void phase_inproj(const Params& p, int g, char* lds, int u) {
    const Grp G = get_group(p, g);
    const int tid_ = otid(), lane = tid_ & 63, wid = tid_ >> 6, wm = wid >> 2, wn = wid & 3, fr = lane & 15, fq = lane >> 4;
    const bf16_t* A = (const bf16_t*)(p.ws + WS_HB); const bf16_t* Bt = (const bf16_t*)(p.ws + WS_WINT);
    bf16_t* P = (bf16_t*)(p.ws + WS_PROJ); bf16_t* VT = (bf16_t*)(p.ws + WS_VT);
    const int pm = u >> 1, half = u & 1, m0 = pm * 256;
    for (int pi = 0; pi < (half ? 17 : 12); ++pi) {
        const int pn = half ? 24 + pi : pi; const int n0 = pn * 256;
        f32x4 acc[8][4];
#pragma unroll
        for (int i = 0; i < 8; ++i)
#pragma unroll
            for (int j = 0; j < 4; ++j) acc[i][j] = (f32x4){0.f, 0.f, 0.f, 0.f};
        gemm_kloop<true, 8>(acc, A + (size_t)m0 * D, D, Bt + (size_t)n0 * D, D, D, lds);
        const float sc = n0 < 512 ? 0.08838834764831845f : 1.0f;
#pragma unroll
        for (int mt = 0; mt < 8; ++mt)
#pragma unroll
            for (int nt = 0; nt < 4; ++nt) {
                const int row = m0 + wm * 128 + mt * 16 + fr, col = n0 + wn * 64 + nt * 16 + fq * 4;
                u32x2 w; w.x = pk2(acc[mt][nt].x * sc, acc[mt][nt].y * sc); w.y = pk2(acc[mt][nt].z * sc, acc[mt][nt].w * sc);
                *(u32x2*)(P + (size_t)row * NP + col) = w;
            }
    }
    if (half == 0) for (int pn = 12; pn < 20; ++pn) {
        const int n0 = pn * 256;
        f32x4 acc[8][4];
#pragma unroll
        for (int i = 0; i < 8; ++i)
#pragma unroll
            for (int j = 0; j < 4; ++j) acc[i][j] = (f32x4){0.f, 0.f, 0.f, 0.f};
        gemm_kloop<true, 8>(acc, A + (size_t)m0 * D, D, Bt + (size_t)n0 * D, D, D, lds);
        const int te_ = otid(), fr = te_ & 15, fq = (te_ >> 4) & 3, wm = te_ >> 8, wn = (te_ >> 6) & 3;
        const bool isk = n0 >= C_DK;
        const float* gn = launder(p.in[isk ? I_DGK : I_DGQ]) + fq * 4;
        const float qs = isk ? 1.0f : 0.125f * LOG2E;
        const float* ROPE = (const float*)(p.ws + WS_ROPE);
        const int tq0 = m0 % G.T + wm * 128 + fr;
#pragma unroll
        for (int mt = 0; mt < 8; ++mt) {
            const int row = m0 + wm * 128 + mt * 16 + fr, t = tq0 + mt * 16;
            float ss = 0.f;
#pragma unroll
            for (int nt = 0; nt < 4; ++nt) ss += acc[mt][nt].x * acc[mt][nt].x + acc[mt][nt].y * acc[mt][nt].y + acc[mt][nt].z * acc[mt][nt].z + acc[mt][nt].w * acc[mt][nt].w;
            ss += sxor<16>(ss); ss += sxor<32>(ss);
            const float r = rsqrtf(ss * (1.f / 64.f) + RMS_EPS) * qs;
            const float* rp = ROPE + (size_t)t * 64 + fq * 4;
            bf16_t* dst = P + (size_t)row * NP + n0 + wn * 64 + fq * 4;
#pragma unroll
            for (int hh = 0; hh < 2; ++hh) {
                const f32x4 cs = *(const f32x4*)(rp + hh * 16), sn = *(const f32x4*)(rp + 32 + hh * 16);
                const f32x4 ya = acc[mt][hh] * *(const f32x4*)(gn + hh * 16) * r, yb = acc[mt][hh + 2] * *(const f32x4*)(gn + 32 + hh * 16) * r;
                const f32x4 oa = ya * cs - yb * sn, ob = yb * cs + ya * sn;
                *(u32x2*)(dst + hh * 16) = (u32x2){pk2(oa.x, oa.y), pk2(oa.z, oa.w)};
                *(u32x2*)(dst + 32 + hh * 16) = (u32x2){pk2(ob.x, ob.y), pk2(ob.z, ob.w)};
            }
        }
    }
    for (int pn = half ? 21 : 20; pn < (half ? 24 : 21); ++pn) {
        const int n0 = pn * 256;
        f32x4 acc[8][4];
#pragma unroll
        for (int i = 0; i < 8; ++i)
#pragma unroll
            for (int j = 0; j < 4; ++j) acc[i][j] = (f32x4){0.f, 0.f, 0.f, 0.f};
        gemm_kloop<false, 8>(acc, A + (size_t)m0 * D, D, Bt + (size_t)n0 * D, D, D, lds);
        const int b = m0 / G.T, t0 = m0 % G.T + wm * 128;
#pragma unroll
        for (int mt = 0; mt < 8; ++mt)
#pragma unroll
            for (int nt = 0; nt < 4; ++nt) {
                const int n = n0 - C_DV + wn * 64 + nt * 16 + fr, h = n >> 7, dv = n & 127;
                const int pos = t0 + (mt >> 1) * 32 + fq * 8 + (mt & 1) * 4;
                u32x2 w; w.x = pk2(acc[mt][nt].x, acc[mt][nt].y); w.y = pk2(acc[mt][nt].z, acc[mt][nt].w);
                *(u32x2*)(VT + ((size_t)((b * 8 + h) * 128 + dv)) * G.T + pos) = w;
            }
    }
}

__device__ __forceinline__ void phase_qkrope(const Params& p, int g, int tok0, int ntok) {
    const Grp G = get_group(p, g);
    const int tid_ = otid(), lane = tid_ & 63, wid = tid_ >> 6, grp = lane >> 2, sub = lane & 3;
    bf16_t* P = (bf16_t*)(p.ws + WS_PROJ); const float* ROPE = (const float*)(p.ws + WS_ROPE);
    for (int it = tok0 * 2 + wid; it < (tok0 + ntok) * 2; it += 8) {
        const int tok = it >> 1, isk = it & 1, t = tok % G.T;
        bf16_t* base = P + (size_t)tok * NP + (isk ? C_DK : C_DQ) + grp * 64 + sub * 8;
        const u32x4 a = *(const u32x4*)base, b = *(const u32x4*)(base + 32);
        float x1[8], x2[8];
        x1[0] = bflo(a.x); x1[1] = bfhi(a.x); x1[2] = bflo(a.y); x1[3] = bfhi(a.y); x1[4] = bflo(a.z); x1[5] = bfhi(a.z); x1[6] = bflo(a.w); x1[7] = bfhi(a.w);
        x2[0] = bflo(b.x); x2[1] = bfhi(b.x); x2[2] = bflo(b.y); x2[3] = bfhi(b.y); x2[4] = bflo(b.z); x2[5] = bfhi(b.z); x2[6] = bflo(b.w); x2[7] = bfhi(b.w);
        float ss = 0.f;
#pragma unroll
        for (int e = 0; e < 8; ++e) ss += x1[e] * x1[e] + x2[e] * x2[e];
        ss += sxor<1>(ss); ss += sxor<2>(ss);
        const float r = rsqrtf(ss * (1.f / 64.f) + RMS_EPS) * (isk ? 1.0f : 0.125f * LOG2E);
        const float* gn = p.in[isk ? I_DGK : I_DGQ] + sub * 8;
        const float* rp = ROPE + (size_t)t * 64 + sub * 8;
        float o1[8], o2[8];
#pragma unroll
        for (int e = 0; e < 8; ++e) {
            const float y1 = x1[e] * r * gn[e], y2 = x2[e] * r * gn[32 + e], c = rp[e], s = rp[32 + e];
            o1[e] = y1 * c - y2 * s; o2[e] = y2 * c + y1 * s;
        }
        u32x4 w1, w2;
        w1.x = pk2(o1[0], o1[1]); w1.y = pk2(o1[2], o1[3]); w1.z = pk2(o1[4], o1[5]); w1.w = pk2(o1[6], o1[7]);
        w2.x = pk2(o2[0], o2[1]); w2.y = pk2(o2[2], o2[3]); w2.z = pk2(o2[4], o2[5]); w2.w = pk2(o2[6], o2[7]);
        *(u32x4*)base = w1; *(u32x4*)(base + 32) = w2;
    }
}

__device__ __forceinline__ void diff_attn_item(const Params& p, const Grp& G, int item, char* lds, float lam, float shift) {
    const int tid = otid(), lane = tid & 63, wid = tid >> 6, fr = lane & 15, fq = lane >> 4;
    const int c = wid & 1, sub = wid >> 1;
    const int T = G.T, nqb = T / 128;
    const int qb = item % nqb, bh = item / nqb, h = bh & 7, b = bh >> 3;
    bf16_t* P = (bf16_t*)(p.ws + WS_PROJ) + (size_t)b * T * NP;
    const bf16_t* Kg = P + C_DK + h * 128;
    const bf16_t* VTg = (const bf16_t*)(p.ws + WS_VT) + (size_t)bh * 128 * T;
    const int q0 = qb * 128 + sub * 32;
    bf16x8 qf[2][2];
#pragma unroll
    for (int nt = 0; nt < 2; ++nt)
#pragma unroll
        for (int ks = 0; ks < 2; ++ks) qf[nt][ks] = *(const bf16x8*)(P + (size_t)(q0 + nt * 16 + fr) * NP + C_DQ + h * 128 + c * 64 + ks * 32 + fq * 8);
    f32x4 o[8][2];
#pragma unroll
    for (int i = 0; i < 8; ++i) { o[i][0] = (f32x4){0.f, 0.f, 0.f, 0.f}; o[i][1] = (f32x4){0.f, 0.f, 0.f, 0.f}; }
    float l[2] = {0.f, 0.f};
    constexpr int STG = 36864, VOFF = 18432;
    u32x4 rk[2], rv[2];
    const int krow = tid >> 4, kch = tid & 15;
    const int vrow = tid >> 3, vch = tid & 7;
#define AGLOAD(kt) do { const int key0_ = (kt) * 64; \
        _Pragma("unroll") for (int i = 0; i < 2; ++i) rk[i] = *(const u32x4*)(Kg + (size_t)(key0_ + krow + i * 32) * NP + kch * 8); \
        _Pragma("unroll") for (int i = 0; i < 2; ++i) rv[i] = *(const u32x4*)(VTg + (size_t)(vrow + i * 64) * T + key0_ + vch * 8); } while (0)
#define ASWRITE(buf) do { char* b_ = lds + (buf) * STG; \
        _Pragma("unroll") for (int i = 0; i < 2; ++i) *(u32x4*)(b_ + ((kch >> 3) * 64 + krow + i * 32) * 144 + (kch & 7) * 16) = rk[i]; \
        _Pragma("unroll") for (int i = 0; i < 2; ++i) *(u32x4*)(b_ + VOFF + (vrow + i * 64) * 144 + vch * 16) = rv[i]; } while (0)
    const int nkt = T / 64;
#define EXPQ(SRC, NT, DSTP) do { const f32x4 a_ = SRC[0][NT], b_ = SRC[1][NT]; \
        const float p0 = fexp2(a_.x), p1 = fexp2(a_.y), p2 = fexp2(a_.z), p3 = fexp2(a_.w); \
        const float p4 = fexp2(b_.x), p5 = fexp2(b_.y), p6 = fexp2(b_.z), p7 = fexp2(b_.w); \
        l[NT] += ((p0 + p1) + (p2 + p3)) + ((p4 + p5) + (p6 + p7)); \
        u32x4 w_; w_.x = pk2(p0, p1); w_.y = pk2(p2, p3); w_.z = pk2(p4, p5); w_.w = pk2(p6, p7); \
        DSTP[NT] = __builtin_bit_cast(bf16x8, w_); } while (0)
#define SMMA1(DST, I, MT, KBASE) do { \
        const bf16x8 k0_ = *(const bf16x8*)((KBASE) + (c * 64 + (MT) * 16 + fr) * 144 + fq * 16); \
        const bf16x8 k1_ = *(const bf16x8*)((KBASE) + (c * 64 + (MT) * 16 + fr) * 144 + 64 + fq * 16); \
        DST[I][0] = mfma16(k0_, qf[0][0], (f32x4){0.f, 0.f, 0.f, 0.f}); DST[I][1] = mfma16(k0_, qf[1][0], (f32x4){0.f, 0.f, 0.f, 0.f}); \
        DST[I][0] = mfma16(k1_, qf[0][1], DST[I][0]); DST[I][1] = mfma16(k1_, qf[1][1], DST[I][1]); } while (0)
#define PVMMA(DVT, KK, PF, VBASE) do { \
        const bf16x8 vf_ = *(const bf16x8*)((VBASE) + VOFF + ((DVT) * 16 + fr) * 144 + (KK) * 64 + fq * 16); \
        o[DVT][0] = mfma16(vf_, PF[0], o[DVT][0]); o[DVT][1] = mfma16(vf_, PF[1], o[DVT][1]); } while (0)
#define PV8(KK, PF, VBASE) do { PVMMA(0, KK, PF, VBASE); PVMMA(1, KK, PF, VBASE); PVMMA(2, KK, PF, VBASE); PVMMA(3, KK, PF, VBASE); \
        PVMMA(4, KK, PF, VBASE); PVMMA(5, KK, PF, VBASE); PVMMA(6, KK, PF, VBASE); PVMMA(7, KK, PF, VBASE); } while (0)
    f32x4 slo[2][2], shi[2][2];
    bf16x8 pflo[2], pfhi[2];
    pfhi[0] = (bf16x8){0, 0, 0, 0, 0, 0, 0, 0}; pfhi[1] = pfhi[0];
#define KLOAD(KR, MTA, MTB, KBASE) do { \
        KR[0] = *(const bf16x8*)((KBASE) + (c * 64 + (MTA) * 16 + fr) * 144 + fq * 16); KR[1] = *(const bf16x8*)((KBASE) + (c * 64 + (MTA) * 16 + fr) * 144 + 64 + fq * 16); \
        KR[2] = *(const bf16x8*)((KBASE) + (c * 64 + (MTB) * 16 + fr) * 144 + fq * 16); KR[3] = *(const bf16x8*)((KBASE) + (c * 64 + (MTB) * 16 + fr) * 144 + 64 + fq * 16); } while (0)
#define SMMAK(DST, KR) do { \
        DST[0][0] = mfma16(KR[0], qf[0][0], (f32x4){0.f, 0.f, 0.f, 0.f}); DST[0][1] = mfma16(KR[0], qf[1][0], (f32x4){0.f, 0.f, 0.f, 0.f}); \
        DST[1][0] = mfma16(KR[2], qf[0][0], (f32x4){0.f, 0.f, 0.f, 0.f}); DST[1][1] = mfma16(KR[2], qf[1][0], (f32x4){0.f, 0.f, 0.f, 0.f}); \
        DST[0][0] = mfma16(KR[1], qf[0][1], DST[0][0]); DST[0][1] = mfma16(KR[1], qf[1][1], DST[0][1]); \
        DST[1][0] = mfma16(KR[3], qf[0][1], DST[1][0]); DST[1][1] = mfma16(KR[3], qf[1][1], DST[1][1]); } while (0)
#define VLOAD4(VR, D0, KK, VBASE) do { _Pragma("unroll") for (int i_ = 0; i_ < 4; ++i_) VR[i_] = *(const bf16x8*)((VBASE) + VOFF + (((D0) + i_) * 16 + fr) * 144 + (KK) * 64 + fq * 16); } while (0)
#define PV4(VR, D0, PF) do { _Pragma("unroll") for (int i_ = 0; i_ < 4; ++i_) { o[(D0) + i_][0] = mfma16(VR[i_], PF[0], o[(D0) + i_][0]); o[(D0) + i_][1] = mfma16(VR[i_], PF[1], o[(D0) + i_][1]); } } while (0)
#define FENCE() __builtin_amdgcn_sched_barrier(0)
    AGLOAD(0); ASWRITE(0); AGLOAD(1); ASWRITE(1);
    for (int i = tid; i < 18432 / 16; i += NTHR) *(u32x4*)(lds + 3 * STG + VOFF + i * 16) = (u32x4){0u, 0u, 0u, 0u};
    __syncthreads();
    bf16x8 kr[4], va[4], vb[4];
    KLOAD(kr, 0, 1, lds); SMMAK(slo, kr);
    for (int kt = 0; kt < nkt; ++kt) {
        { const int ktl = kt + 2 < nkt ? kt + 2 : nkt - 1; AGLOAD(ktl); }
        const char* cur = lds + (kt & 3) * STG; const char* nxt = lds + ((kt + 1) & 3) * STG; const char* prv = lds + ((kt + 3) & 3) * STG;
        KLOAD(kr, 2, 3, cur); VLOAD4(va, 0, 1, prv);
        FENCE();
        SMMAK(shi, kr); VLOAD4(vb, 4, 1, prv); EXPQ(slo, 0, pflo);
        FENCE();
        PV4(va, 0, pfhi); KLOAD(kr, 0, 1, nxt); EXPQ(slo, 1, pflo);
        FENCE();
        PV4(vb, 4, pfhi); VLOAD4(va, 0, 0, cur);
        FENCE();
        SMMAK(slo, kr); VLOAD4(vb, 4, 0, cur); EXPQ(shi, 0, pfhi);
        FENCE();
        PV4(va, 0, pflo); EXPQ(shi, 1, pfhi);
        FENCE();
        PV4(vb, 4, pflo);
        FENCE();
        ASWRITE((kt + 2) & 3);
        __syncthreads();
    }
    { const char* prv = lds + ((nkt - 1) & 3) * STG; VLOAD4(va, 0, 1, prv); VLOAD4(vb, 4, 1, prv); PV4(va, 0, pfhi); PV4(vb, 4, pfhi); }
    __syncthreads();
#undef KLOAD
#undef SMMAK
#undef VLOAD4
#undef PV4
#undef FENCE
#undef EXPQ
#undef SMMA1
#undef PVMMA
#undef PV8
#undef AGLOAD
#undef ASWRITE
    float inv[2];
#pragma unroll
    for (int nt = 0; nt < 2; ++nt) { float v = l[nt]; v += sxor<16>(v); v += sxor<32>(v); inv[nt] = 1.0f / v; }
    float* xch = (float*)lds + sub * 4096;
    if (c == 1) {
#pragma unroll
        for (int dvt = 0; dvt < 8; ++dvt)
#pragma unroll
            for (int nt = 0; nt < 2; ++nt) {
                xch[(dvt * 16 + fq * 4 + 0) * 32 + nt * 16 + fr] = o[dvt][nt].x * inv[nt];
                xch[(dvt * 16 + fq * 4 + 1) * 32 + nt * 16 + fr] = o[dvt][nt].y * inv[nt];
                xch[(dvt * 16 + fq * 4 + 2) * 32 + nt * 16 + fr] = o[dvt][nt].z * inv[nt];
                xch[(dvt * 16 + fq * 4 + 3) * 32 + nt * 16 + fr] = o[dvt][nt].w * inv[nt];
            }
    }
    __syncthreads();
    if (c == 0) {
        float ss[2] = {0.f, 0.f};
#pragma unroll
        for (int dvt = 0; dvt < 8; ++dvt)
#pragma unroll
            for (int nt = 0; nt < 2; ++nt) {
                f32x4 v = o[dvt][nt] * inv[nt];
                v.x -= lam * xch[(dvt * 16 + fq * 4 + 0) * 32 + nt * 16 + fr];
                v.y -= lam * xch[(dvt * 16 + fq * 4 + 1) * 32 + nt * 16 + fr];
                v.z -= lam * xch[(dvt * 16 + fq * 4 + 2) * 32 + nt * 16 + fr];
                v.w -= lam * xch[(dvt * 16 + fq * 4 + 3) * 32 + nt * 16 + fr];
                o[dvt][nt] = v; ss[nt] += v.x * v.x + v.y * v.y + v.z * v.z + v.w * v.w;
            }
#pragma unroll
        for (int nt = 0; nt < 2; ++nt) {
            float v = ss[nt]; v += sxor<16>(v); v += sxor<32>(v);
            const float r = rsqrtf(v * (1.f / 128.f) + RMS_EPS) * 0.8f;
#pragma unroll
            for (int dvt = 0; dvt < 8; ++dvt) {
                const f32x4 gs = *(const f32x4*)(p.in[I_DGSUB] + dvt * 16 + fq * 4);
                const f32x4 v4 = o[dvt][nt];
                u32x2 w; w.x = pk2(v4.x * r * gs.x, v4.y * r * gs.y); w.y = pk2(v4.z * r * gs.z, v4.w * r * gs.w);
                *(u32x2*)(P + (size_t)(q0 + nt * 16 + fr) * NP + C_DQ + h * 128 + dvt * 16 + fq * 4) = w;
            }
        }
    }
    __syncthreads();
}

__device__ __forceinline__ void mem_attn_item(const Params& p, const Grp& G, int item, char* lds, float shift) {
    const int tid = otid(), lane = tid & 63, wid = tid >> 6, fr = lane & 15, fq = lane >> 4;
    const int T = G.T, nqb = T / 128;
    const int qb = item % nqb, bh = item / nqb, h = bh & 3, b = bh >> 2;
    bf16_t* P = (bf16_t*)(p.ws + WS_PROJ) + (size_t)b * T * NP;
    const bf16_t* MK = (const bf16_t*)(p.ws + WS_MEMK) + (size_t)((G.mb0 + b) * 4 + h) * 256 * 256;
    const bf16_t* MV = (const bf16_t*)(p.ws + WS_MEMV) + (size_t)((G.mb0 + b) * 4 + h) * 256 * 256;
    const int row = qb * 128 + wid * 16 + fr;
    bf16_t* qp = P + (size_t)row * NP + C_MQ + h * 256;
    bf16x8 qf[8];
    {
        float ss = 0.f; u32x4 raw[8];
#pragma unroll
        for (int ks = 0; ks < 8; ++ks) { raw[ks] = *(const u32x4*)(qp + ks * 32 + fq * 8);
            const float a0 = bflo(raw[ks].x), a1 = bfhi(raw[ks].x), a2 = bflo(raw[ks].y), a3 = bfhi(raw[ks].y), a4 = bflo(raw[ks].z), a5 = bfhi(raw[ks].z), a6 = bflo(raw[ks].w), a7 = bfhi(raw[ks].w);
            ss += a0 * a0 + a1 * a1 + a2 * a2 + a3 * a3 + a4 * a4 + a5 * a5 + a6 * a6 + a7 * a7; }
        ss += sxor<16>(ss); ss += sxor<32>(ss);
        const float r = rsqrtf(ss * (1.f / 256.f) + RMS_EPS) * (0.0625f * LOG2E);
#pragma unroll
        for (int ks = 0; ks < 8; ++ks) {
            const f32x4 g0 = *(const f32x4*)(p.in[I_MGQ] + ks * 32 + fq * 8), g1 = *(const f32x4*)(p.in[I_MGQ] + ks * 32 + fq * 8 + 4);
            u32x4 w;
            w.x = pk2(bflo(raw[ks].x) * r * g0.x, bfhi(raw[ks].x) * r * g0.y); w.y = pk2(bflo(raw[ks].y) * r * g0.z, bfhi(raw[ks].y) * r * g0.w);
            w.z = pk2(bflo(raw[ks].z) * r * g1.x, bfhi(raw[ks].z) * r * g1.y); w.w = pk2(bflo(raw[ks].w) * r * g1.z, bfhi(raw[ks].w) * r * g1.w);
            qf[ks] = __builtin_bit_cast(bf16x8, w);
        }
    }
    f32x4 o[16];
#pragma unroll
    for (int i = 0; i < 16; ++i) o[i] = (f32x4){0.f, 0.f, 0.f, 0.f};
    float l = 0.f;
    constexpr int KROW = 528, VOFF = 64 * 528;
    u32x4 mk[4], mv[4];
#define MLOAD(KT) do { _Pragma("unroll") for (int i = 0; i < 4; ++i) { const int idx = tid + i * 512; \
        mk[i] = *(const u32x4*)(MK + (size_t)((KT) * 64 + (idx >> 5)) * 256 + (idx & 31) * 8); mv[i] = *(const u32x4*)(MV + (size_t)(idx >> 3) * 256 + (KT) * 64 + (idx & 7) * 8); } } while (0)
    MLOAD(0);
    for (int kt = 0; kt < 4; ++kt) {
#pragma unroll
        for (int i = 0; i < 4; ++i) {
            const int idx = tid + i * 512;
            *(u32x4*)(lds + (idx >> 5) * KROW + (idx & 31) * 16) = mk[i];
            *(u32x4*)(lds + VOFF + (idx >> 3) * 144 + (idx & 7) * 16) = mv[i];
        }
        __syncthreads();
        if (kt + 1 < 4) MLOAD(kt + 1);
        __builtin_amdgcn_sched_barrier(0);
        f32x4 s[4];
#pragma unroll
        for (int mt = 0; mt < 4; ++mt) s[mt] = (f32x4){0.f, 0.f, 0.f, 0.f};
#pragma unroll
        for (int ks = 0; ks < 8; ks += 2) {
            bf16x8 kf[8];
#pragma unroll
            for (int u = 0; u < 8; ++u) kf[u] = *(const bf16x8*)(lds + ((u & 3) * 16 + fr) * KROW + (ks + (u >> 2)) * 64 + fq * 16);
            __builtin_amdgcn_sched_barrier(0);
#pragma unroll
            for (int u = 0; u < 8; ++u) s[u & 3] = mfma16(kf[u], qf[ks + (u >> 2)], s[u & 3]);
        }
        bf16x8 pf[2];
#pragma unroll
        for (int kk = 0; kk < 2; ++kk) {
            const f32x4 a = s[2 * kk], bb = s[2 * kk + 1];
            const float p0 = fexp2(a.x), p1 = fexp2(a.y), p2 = fexp2(a.z), p3 = fexp2(a.w);
            const float p4 = fexp2(bb.x), p5 = fexp2(bb.y), p6 = fexp2(bb.z), p7 = fexp2(bb.w);
            l += ((p0 + p1) + (p2 + p3)) + ((p4 + p5) + (p6 + p7));
            u32x4 w; w.x = pk2(p0, p1); w.y = pk2(p2, p3); w.z = pk2(p4, p5); w.w = pk2(p6, p7);
            pf[kk] = __builtin_bit_cast(bf16x8, w);
        }
#pragma unroll
        for (int kk = 0; kk < 2; ++kk)
#pragma unroll
            for (int d0 = 0; d0 < 16; d0 += 8) {
                bf16x8 vf[8];
#pragma unroll
                for (int u = 0; u < 8; ++u) vf[u] = *(const bf16x8*)(lds + VOFF + ((d0 + u) * 16 + fr) * 144 + kk * 64 + fq * 16);
                __builtin_amdgcn_sched_barrier(0);
#pragma unroll
                for (int u = 0; u < 8; ++u) o[d0 + u] = mfma16(vf[u], pf[kk], o[d0 + u]);
            }
        __syncthreads();
    }
#undef MLOAD
    l += sxor<16>(l); l += sxor<32>(l);
    const float inv = 1.0f / l;
#pragma unroll
    for (int dvt = 0; dvt < 16; ++dvt) {
        u32x2 w; w.x = pk2(o[dvt].x * inv, o[dvt].y * inv); w.y = pk2(o[dvt].z * inv, o[dvt].w * inv);
        *(u32x2*)(qp + dvt * 16 + fq * 4) = w;
    }
}

constexpr int L_QE = 0, L_KE = 17408, L_KST = 34816, L_VTL = 53248, L_ATT = 71680, L_SB = 80896, L_LRF = 115712, L_TOT = 119808, L_GDEC = 121856;
__device__ __forceinline__ void gla_item(const Params& p, const Grp& G, int item, char* lds) {
    const int tid = otid(), lane = tid & 63, wid = tid >> 6, fr = lane & 15, fq = lane >> 4;
    const int slice = item & 1, dir = (item >> 1) & 1, h = (item >> 2) & 3, b = item >> 4;
    const int T = G.T, N = T / 64;
    const bf16_t* P = (const bf16_t*)(p.ws + WS_PROJ) + (size_t)b * T * NP;
    bf16_t* OUT = dir ? (bf16_t*)(p.ws + WS_PROJ) + (size_t)b * T * NP + C_DV + h * 256 + slice * 128
                      : (bf16_t*)(p.ws + WS_HB) + (size_t)b * T * D + h * 256 + slice * 128;
    const int ldo = dir ? NP : D;
    const int amt = wid & 3, antg = wid >> 2;
    bf16x8 wdB[4]; float bd4[4];
    {
        const float* wd = p.in[dir ? I_WDB : I_WDF]; const float* bdp = p.in[dir ? I_BDB : I_BDF];
#pragma unroll
        for (int q = 0; q < 4; ++q) {
            const int col = h * 128 + (antg * 4 + q) * 16 + fr;
            u32x4 w = (u32x4){0u, 0u, 0u, 0u};
            if (fq < 2) { const float* wp = wd + (size_t)(fq * 8) * 512 + col;
                w.x = pk2(wp[0], wp[512]); w.y = pk2(wp[1024], wp[1536]); w.z = pk2(wp[2048], wp[2560]); w.w = pk2(wp[3072], wp[3584]); }
            wdB[q] = __builtin_bit_cast(bf16x8, w);
            bd4[q] = bdp[col];
        }
    }
    { unsigned z = 0u; asm volatile("" : "+v"(z)); for (int i = tid; i < 34816 / 16; i += NTHR) *(u32x4*)(lds + L_SB + i * 16) = (u32x4){z, z, z, z}; }
    f32x4 S[8];
#pragma unroll
    for (int i = 0; i < 8; ++i) S[i] = (f32x4){0.f, 0.f, 0.f, 0.f};
    u32x4 rq[2], rk[2], rv[2], rl;
    const int lrow = tid >> 4, lch = tid & 15;
#define GGLOAD(n) do { const int cb_ = (dir ? (N - 1 - (n)) : (n)) * 64; \
        _Pragma("unroll") for (int i = 0; i < 2; ++i) { const int li_ = lrow + i * 32, tk_ = cb_ + (dir ? 63 - li_ : li_); const bf16_t* rp_ = P + (size_t)tk_ * NP; \
            rq[i] = *(const u32x4*)(rp_ + C_GQ + h * 128 + lch * 8); rk[i] = *(const u32x4*)(rp_ + C_GK + h * 128 + lch * 8); rv[i] = *(const u32x4*)(rp_ + C_GV + h * 256 + slice * 128 + lch * 8); } \
        if (tid < 128) { const int li_ = tid >> 1, tk_ = cb_ + (dir ? 63 - li_ : li_); rl = *(const u32x4*)(P + (size_t)tk_ * NP + C_LR + dir * 16 + (tid & 1) * 8); } } while (0)
    GGLOAD(0);
    for (int n = 0; n < N; ++n) {
#pragma unroll
        for (int i = 0; i < 2; ++i) {
            const int li = lrow + i * 32;
            *(u32x4*)(lds + L_QE + li * 272 + lch * 16) = rq[i];
            *(u32x4*)(lds + L_KE + li * 272 + lch * 16) = rk[i];
            bf16_t* vt = (bf16_t*)(lds + L_VTL) + (lch * 8) * 72 + li;
            vt[0 * 72] = (bf16_t)(rv[i].x & 0xffff); vt[1 * 72] = (bf16_t)(rv[i].x >> 16); vt[2 * 72] = (bf16_t)(rv[i].y & 0xffff); vt[3 * 72] = (bf16_t)(rv[i].y >> 16);
            vt[4 * 72] = (bf16_t)(rv[i].z & 0xffff); vt[5 * 72] = (bf16_t)(rv[i].z >> 16); vt[6 * 72] = (bf16_t)(rv[i].w & 0xffff); vt[7 * 72] = (bf16_t)(rv[i].w >> 16);
        }
        if (tid < 128) *(u32x4*)(lds + L_LRF + (tid >> 1) * 32 + (tid & 1) * 16) = rl;
        if (n + 1 < N) GGLOAD(n + 1);
        __syncthreads();
        {
            u32x4 araw = (u32x4){0u, 0u, 0u, 0u};
            if (fq < 2) araw = *(const u32x4*)(lds + L_LRF + (amt * 16 + fr) * 32 + fq * 16);
            const bf16x8 afr = __builtin_bit_cast(bf16x8, araw);
            float pb[4][4]; float E[4], tt[4];
#pragma unroll
            for (int q = 0; q < 4; ++q) {
                const f32x4 x4 = mfma16(afr, wdB[q], (f32x4){bd4[q], bd4[q], bd4[q], bd4[q]});
                float run = 0.f;
#pragma unroll
                for (int j = 0; j < 4; ++j) {
                    const float x = x4[j];
                    const float ls = fminf(x, 0.f) - __logf(1.0f + __expf(-fabsf(x)));
                    run += ls * 0.0625f; pb[q][j] = run;
                }
                const float u = sxor<16>(run), v = run + u, w2 = sxor<32>(v);
                E[q] = ((fq & 1) ? u : 0.f) + ((fq & 2) ? w2 : 0.f);
                tt[q] = v + w2;
                if (fq == 0) ((float*)(lds + L_TOT))[amt * 128 + (antg * 4 + q) * 16 + fr] = tt[q];
            }
            __syncthreads();
#pragma unroll
            for (int q = 0; q < 4; ++q) {
                const int col = (antg * 4 + q) * 16 + fr;
                float off = 0.f, blast = 0.f;
#pragma unroll
                for (int r = 0; r < 4; ++r) { const float tv = ((const float*)(lds + L_TOT))[r * 128 + col]; blast += tv; if (r < amt) off += tv; }
                const float gcol = __expf(blast);
                bf16_t* qe = (bf16_t*)(lds + L_QE) + (amt * 16 + fq * 4) * 136 + col; bf16_t* ke = (bf16_t*)(lds + L_KE) + (amt * 16 + fq * 4) * 136 + col;
                float ksv[4];
#pragma unroll
                for (int j = 0; j < 4; ++j) {
                    const float bb = off + E[q] + pb[q][j];
                    const float qv = bf2f(qe[j * 136]), kv = bf2f(ke[j * 136]);
                    const float kd = kv * __expf(-bb);
                    qe[j * 136] = f2bf(qv * __expf(bb)); ke[j * 136] = f2bf(kd);
                    ksv[j] = kd * gcol;
                }
                *(u32x2*)(lds + L_KST + col * 144 + (amt * 16 + fq * 4) * 2) = (u32x2){pk2(ksv[0], ksv[1]), pk2(ksv[2], ksv[3])};
                if (amt == 0 && fq == 0) ((float*)(lds + L_GDEC))[col] = gcol;
            }
        }
        __syncthreads();
        {
            const int ct = wid & 3;
            f32x4 a[2] = {(f32x4){0.f, 0.f, 0.f, 0.f}, (f32x4){0.f, 0.f, 0.f, 0.f}};
            bf16x8 qv[4], kv[2][4];
#pragma unroll
            for (int ks = 0; ks < 4; ++ks) {
                qv[ks] = *(const bf16x8*)(lds + L_QE + (ct * 16 + fr) * 272 + ks * 64 + fq * 16);
#pragma unroll
                for (int j = 0; j < 2; ++j) kv[j][ks] = *(const bf16x8*)(lds + L_KE + (((wid >> 2) * 2 + j) * 16 + fr) * 272 + ks * 64 + fq * 16);
            }
            __builtin_amdgcn_sched_barrier(0);
#pragma unroll
            for (int ks = 0; ks < 4; ++ks)
#pragma unroll
                for (int j = 0; j < 2; ++j) a[j] = mfma16(kv[j][ks], qv[ks], a[j]);
#pragma unroll
            for (int j = 0; j < 2; ++j) {
                const int st = (wid >> 2) * 2 + j, cc = ct * 16 + fr, s0 = st * 16 + fq * 4;
                const float v0 = (s0 + 0 <= cc) ? a[j].x : 0.f, v1 = (s0 + 1 <= cc) ? a[j].y : 0.f, v2 = (s0 + 2 <= cc) ? a[j].z : 0.f, v3 = (s0 + 3 <= cc) ? a[j].w : 0.f;
                *(u32x2*)(lds + L_ATT + cc * 144 + s0 * 2) = (u32x2){pk2(v0, v1), pk2(v2, v3)};
            }
        }
        __syncthreads();
        {
            f32x4 oc[4] = {(f32x4){0.f, 0.f, 0.f, 0.f}, (f32x4){0.f, 0.f, 0.f, 0.f}, (f32x4){0.f, 0.f, 0.f, 0.f}, (f32x4){0.f, 0.f, 0.f, 0.f}};
            bf16x8 fa[2], fb[2][4], ga[2], gb[2][4];
#define LD_VA(FA, FB) do { _Pragma("unroll") for (int ks = 0; ks < 2; ++ks) { FA[ks] = *(const bf16x8*)(lds + L_VTL + (wid * 16 + fr) * 144 + ks * 64 + fq * 16); \
                _Pragma("unroll") for (int ct = 0; ct < 4; ++ct) FB[ks][ct] = *(const bf16x8*)(lds + L_ATT + (ct * 16 + fr) * 144 + ks * 64 + fq * 16); } } while (0)
#define LD_SQ(FA, FB, K0) do { _Pragma("unroll") for (int ks = 0; ks < 2; ++ks) { FA[ks] = *(const bf16x8*)(lds + L_SB + (wid * 16 + fr) * 272 + ((K0) + ks) * 64 + fq * 16); \
                _Pragma("unroll") for (int ct = 0; ct < 4; ++ct) FB[ks][ct] = *(const bf16x8*)(lds + L_QE + (ct * 16 + fr) * 272 + ((K0) + ks) * 64 + fq * 16); } } while (0)
#define MM10(FA, FB) do { _Pragma("unroll") for (int ks = 0; ks < 2; ++ks) _Pragma("unroll") for (int ct = 0; ct < 4; ++ct) oc[ct] = mfma16(FA[ks], FB[ks][ct], oc[ct]); } while (0)
            LD_VA(fa, fb); LD_SQ(ga, gb, 0);
            __builtin_amdgcn_sched_barrier(0);
            MM10(fa, fb); LD_SQ(fa, fb, 2);
            __builtin_amdgcn_sched_barrier(0);
            MM10(ga, gb);
            __builtin_amdgcn_sched_barrier(0);
            MM10(fa, fb);
#undef LD_VA
#undef LD_SQ
#undef MM10
            const int cb = (dir ? (N - 1 - n) : n) * 64;
#pragma unroll
            for (int ct = 0; ct < 4; ++ct) {
                const int cl = ct * 16 + fr, tk = cb + (dir ? 63 - cl : cl);
                *(u32x2*)(OUT + (size_t)tk * ldo + wid * 16 + fq * 4) = (u32x2){pk2(oc[ct].x, oc[ct].y), pk2(oc[ct].z, oc[ct].w)};
            }
        }
        __syncthreads();
        {
            const f32x4 gd = *(const f32x4*)((const float*)(lds + L_GDEC) + wid * 16 + fq * 4);
#pragma unroll
            for (int et = 0; et < 8; ++et) S[et] = S[et] * gd;
            bf16x8 da[2], db[2][8];
#pragma unroll
            for (int ks = 0; ks < 2; ++ks) {
                da[ks] = *(const bf16x8*)(lds + L_KST + (wid * 16 + fr) * 144 + ks * 64 + fq * 16);
#pragma unroll
                for (int et = 0; et < 8; ++et) db[ks][et] = *(const bf16x8*)(lds + L_VTL + (et * 16 + fr) * 144 + ks * 64 + fq * 16);
            }
            __builtin_amdgcn_sched_barrier(0);
#pragma unroll
            for (int ks = 0; ks < 2; ++ks)
#pragma unroll
                for (int et = 0; et < 8; ++et) S[et] = mfma16(da[ks], db[ks][et], S[et]);
#pragma unroll
            for (int et = 0; et < 8; ++et)
                *(u32x2*)(lds + L_SB + (et * 16 + fr) * 272 + (wid * 16 + fq * 4) * 2) = (u32x2){pk2(S[et].x, S[et].y), pk2(S[et].z, S[et].w)};
        }
        __syncthreads();
    }
#undef GGLOAD
}

__device__ __forceinline__ void phase_mixer(const Params& p, int g, char* lds, int* s_item) {
    const Grp G = get_group(p, g);
    const int nGLA = G.B * 16, nATT = G.B * 8 * (G.T / 128), nMEM = G.B * 4 * (G.T / 128);
    unsigned* ctr = (unsigned*)(p.ws + WS_CTRL) + g * 4;
    for (;;) {
        if (threadIdx.x == 0) *s_item = (int)atomicAdd(ctr + 0, 1u);
        __syncthreads();
        const int it = *s_item;
        __syncthreads();
        if (it >= nGLA) break;
        gla_item(p, G, it, lds);
    }
    {
        float d1 = 0.f, d2 = 0.f;
        for (int i = 0; i < 64; ++i) { d1 += p.in[I_LQ1][i] * p.in[I_LK1][i]; d2 += p.in[I_LQ2][i] * p.in[I_LK2][i]; }
        const float lam = expf(d1) - expf(d2) + 0.2f;
        for (;;) {
            if (threadIdx.x == 0) *s_item = (int)atomicAdd(ctr + 1, 1u);
            __syncthreads();
            const int it = *s_item;
            __syncthreads();
            if (it >= nATT) break;
            diff_attn_item(p, G, it, lds, lam, 0.f);
        }
    }
    for (;;) {
        if (threadIdx.x == 0) *s_item = (int)atomicAdd(ctr + 2, 1u);
        __syncthreads();
        const int it = *s_item;
        __syncthreads();
        if (it >= nMEM) break;
        mem_attn_item(p, G, it, lds, 0.f);
    }
}

__device__ __forceinline__ void phase_glafin(const Params& p, int g, int tok0, int ntok) {
    const int tid_ = otid(), lane = tid_ & 63, wid = tid_ >> 6;
    bf16_t* P = (bf16_t*)(p.ws + WS_PROJ); const bf16_t* F = (const bf16_t*)(p.ws + WS_HB);
    unsigned qq, kk; u32x2 f, bk, v, gt;
#define GFLOAD(IT) do { const int tok_ = (IT) >> 2, h_ = (IT) & 3; const bf16_t* row_ = P + (size_t)tok_ * NP; \
        qq = *(const unsigned*)(row_ + C_GQ + h_ * 128 + lane * 2); kk = *(const unsigned*)(row_ + C_GK + h_ * 128 + lane * 2); \
        f = *(const u32x2*)(F + (size_t)tok_ * D + h_ * 256 + lane * 4); bk = *(const u32x2*)(row_ + C_DV + h_ * 256 + lane * 4); \
        v = *(const u32x2*)(row_ + C_GV + h_ * 256 + lane * 4); gt = *(const u32x2*)(row_ + C_GG + h_ * 256 + lane * 4); } while (0)
    const f32x4 go = *(const f32x4*)(launder(p.in[I_GOUT]) + lane * 4);
    GFLOAD(tok0 * 4 + wid);
    for (int it = tok0 * 4 + wid; it < (tok0 + ntok) * 4; it += 8) {
        const int tok = it >> 2, h = it & 3;
        bf16_t* row = P + (size_t)tok * NP;
        const unsigned cq = qq, ck = kk; const u32x2 cf = f, cbk = bk, cv = v, cgt = gt;
        if (it + 8 < (tok0 + ntok) * 4) GFLOAD(it + 8);
        __builtin_amdgcn_sched_barrier(0);
        const float qk = wave_sum(bflo(cq) * bflo(ck) + bfhi(cq) * bfhi(ck));
        float o0 = bflo(cf.x) + bflo(cbk.x) - qk * bflo(cv.x), o1 = bfhi(cf.x) + bfhi(cbk.x) - qk * bfhi(cv.x);
        float o2 = bflo(cf.y) + bflo(cbk.y) - qk * bflo(cv.y), o3 = bfhi(cf.y) + bfhi(cbk.y) - qk * bfhi(cv.y);
        const float r = rsqrtf(wave_sum(o0 * o0 + o1 * o1 + o2 * o2 + o3 * o3) * (1.f / 256.f) + RMS_EPS);
        const float g0 = bflo(cgt.x), g1 = bfhi(cgt.x), g2 = bflo(cgt.y), g3 = bfhi(cgt.y);
        o0 *= r * go.x * g0 * __builtin_amdgcn_rcpf(1.f + __expf(-g0)); o1 *= r * go.y * g1 * __builtin_amdgcn_rcpf(1.f + __expf(-g1));
        o2 *= r * go.z * g2 * __builtin_amdgcn_rcpf(1.f + __expf(-g2)); o3 *= r * go.w * g3 * __builtin_amdgcn_rcpf(1.f + __expf(-g3));
        *(u32x2*)(row + C_GG + h * 256 + lane * 4) = (u32x2){pk2(o0, o1), pk2(o2, o3)};
    }
#undef GFLOAD
}

__device__ __forceinline__ void phase_merge(const Params& p, int g, char* lds, int u) {
    const int tid_ = otid(), lane = tid_ & 63, wid = tid_ >> 6, wm = wid >> 2, wn = wid & 3, fr = lane & 15, fq = lane >> 4;
    const bf16_t* P = (const bf16_t*)(p.ws + WS_PROJ); bf16_t* M = (bf16_t*)(p.ws + WS_VT);
    for (int pn = 0; pn < 4; ++pn) {
        const int m0 = u * 128, n0 = pn * 256;
        f32x4 macc[4][4];
#pragma unroll
        for (int i = 0; i < 4; ++i)
#pragma unroll
            for (int j = 0; j < 4; ++j) macc[i][j] = (f32x4){0.f, 0.f, 0.f, 0.f};
        for (int br = 0; br < 3; ++br) {
            f32x4 acc[4][4];
#pragma unroll
            for (int i = 0; i < 4; ++i)
#pragma unroll
                for (int j = 0; j < 4; ++j) acc[i][j] = (f32x4){0.f, 0.f, 0.f, 0.f};
            const int acol = br == 0 ? C_GG : (br == 1 ? C_DQ : C_MQ);
            gemm_kloop<true, 4>(acc, P + (size_t)m0 * NP + acol, NP, (const bf16_t*)(p.ws + WS_WOT) + (size_t)br * D * D + (size_t)n0 * D, D, D, lds);
#pragma unroll
            for (int mt = 0; mt < 4; ++mt)
#pragma unroll
                for (int nt = 0; nt < 4; ++nt) {
                    const int row = m0 + wm * 64 + mt * 16 + fr, col = n0 + wn * 64 + nt * 16 + fq * 4;
                    const u32x2 gt = *(const u32x2*)(P + (size_t)row * NP + C_BG + br * 1024 + col);
                    f32x4 sg; sg.x = __builtin_amdgcn_rcpf(1.f + __expf(-bflo(gt.x))); sg.y = __builtin_amdgcn_rcpf(1.f + __expf(-bfhi(gt.x))); sg.z = __builtin_amdgcn_rcpf(1.f + __expf(-bflo(gt.y))); sg.w = __builtin_amdgcn_rcpf(1.f + __expf(-bfhi(gt.y)));
                    macc[mt][nt] += sg * acc[mt][nt];
                }
        }
#pragma unroll
        for (int mt = 0; mt < 4; ++mt)
#pragma unroll
            for (int nt = 0; nt < 4; ++nt) {
                const int row = m0 + wm * 64 + mt * 16 + fr, col = n0 + wn * 64 + nt * 16 + fq * 4;
                *(u32x2*)(M + (size_t)row * D + col) = (u32x2){pk2(macc[mt][nt].x, macc[mt][nt].y), pk2(macc[mt][nt].z, macc[mt][nt].w)};
            }
    }
}

__device__ __forceinline__ void phase_outproj(const Params& p, int g, char* lds, int u) {
    const Grp G = get_group(p, g);
    const int tid_ = otid(), lane = tid_ & 63, wid = tid_ >> 6, wm = wid >> 2, wn = wid & 3, fr = lane & 15, fq = lane >> 4;
    const bf16_t* M = (const bf16_t*)(p.ws + WS_VT); const bf16_t* W = (const bf16_t*)(p.ws + WS_WOT) + (size_t)3 * D * D;
    for (int pn = 0; pn < 4; ++pn) {
        const int m0 = u * 128, n0 = pn * 256;
        f32x4 acc[4][4];
#pragma unroll
        for (int i = 0; i < 4; ++i)
#pragma unroll
            for (int j = 0; j < 4; ++j) acc[i][j] = (f32x4){0.f, 0.f, 0.f, 0.f};
        gemm_kloop<true, 4>(acc, M + (size_t)m0 * D, D, W + (size_t)n0 * D, D, D, lds);
#pragma unroll
        for (int mt = 0; mt < 4; ++mt)
#pragma unroll
            for (int nt = 0; nt < 4; ++nt) {
                const int row = m0 + wm * 64 + mt * 16 + fr, col = n0 + wn * 64 + nt * 16 + fq * 4;
                const f32x4 xv = *(const f32x4*)(G.x + (size_t)row * D + col);
                *(f32x4*)(G.out + (size_t)row * D + col) = xv + acc[mt][nt];
            }
    }
}

__device__ __forceinline__ void phase_peerq(const Params& p, int g, char* lds, int u) {
    const int tid_ = otid(), lane = tid_ & 63, wid = tid_ >> 6, wm = wid >> 2, wn = wid & 3, fr = lane & 15, fq = lane >> 4;
    const bf16_t* A = (const bf16_t*)(p.ws + WS_HB); const bf16_t* W = (const bf16_t*)(p.ws + WS_WQT); bf16_t* P = (bf16_t*)(p.ws + WS_PROJ);
    for (int pn = 0; pn < 8; ++pn) {
        const int m0 = u * 128, n0 = pn * 256;
        f32x4 acc[4][4];
#pragma unroll
        for (int i = 0; i < 4; ++i)
#pragma unroll
            for (int j = 0; j < 4; ++j) acc[i][j] = (f32x4){0.f, 0.f, 0.f, 0.f};
        gemm_kloop<true, 4>(acc, A + (size_t)m0 * D, D, W + (size_t)n0 * D, D, D, lds);
#pragma unroll
        for (int mt = 0; mt < 4; ++mt)
#pragma unroll
            for (int nt = 0; nt < 4; ++nt) {
                const int row = m0 + wm * 64 + mt * 16 + fr, col = n0 + wn * 64 + nt * 16 + fq * 4;
                *(u32x2*)(P + (size_t)row * NP + col) = (u32x2){pk2(acc[mt][nt].x, acc[mt][nt].y), pk2(acc[mt][nt].z, acc[mt][nt].w)};
            }
    }
}

__device__ __forceinline__ unsigned f2ord(float f) { const unsigned u = __float_as_uint(f); return (u & 0x80000000u) ? ~u : (u | 0x80000000u); }
__device__ __forceinline__ float ord2f(unsigned k) { const unsigned u = (k & 0x80000000u) ? (k & 0x7fffffffu) : ~k; return __uint_as_float(u); }
__device__ __forceinline__ unsigned gmax16(unsigned v) {
    unsigned t;
    t = sxoru<1>(v); v = v > t ? v : t; t = sxoru<2>(v); v = v > t ? v : t; t = sxoru<4>(v); v = v > t ? v : t; t = sxoru<8>(v); v = v > t ? v : t;
    return v;
}
__device__ __forceinline__ float gsum16(float v) { v += sxor<1>(v); v += sxor<2>(v); v += sxor<4>(v); v += sxor<8>(v); return v; }
__device__ __forceinline__ float gelu_exact(float v) {
    const float av = fabsf(v), t = __builtin_amdgcn_rcpf(av * 0.2316418882f + 1.0f);
    float q = t * 0.5307027145f + (-0.7265760135f); q = q * t + 0.7107068705f; q = q * t + (-0.142248368f); q = q * t + 0.127414796f; q = q * t;
    const float e = __builtin_amdgcn_exp2f(v * v * (-0.72134752044f));
    const float m = v * (q * e);
    return v < 0.f ? m : v - m;
}

__device__ __forceinline__ void phase_peer(const Params& p, int g, char* lds, int tile0, int ntile) {
    const Grp G = get_group(p, g);
    const int tid = otid(), lane = tid & 63, wid = tid >> 6, fr = lane & 15, fq = lane >> 4;
    const bf16_t* P = (const bf16_t*)(p.ws + WS_PROJ); const bf16_t* HB = (const bf16_t*)(p.ws + WS_HB);
    const bf16_t* K12 = (const bf16_t*)(p.ws + WS_K12);
    float* SC = (float*)lds;
    int* EIDX = (int*)(lds + 65536);
    float* GATE = (float*)(lds + 65536 + 4096);
    char* KL = lds + 73728;
    for (int i = tid; i < 2 * 128 * 16; i += NTHR) {
        const int r = i >> 4, ch = i & 15;
        *(u32x4*)(KL + r * 272 + ch * 16) = *(const u32x4*)(K12 + (size_t)r * 128 + ch * 8);
    }
    __syncthreads();
    for (int tile = tile0; tile < tile0 + ntile; ++tile) {
        const int tok0 = tile * 8;
        {
            const bf16_t* qtok = P + (size_t)(tok0 + wid) * NP + (fr & 7) * 256;
#pragma unroll
            for (int half = 0; half < 2; ++half) {
                f32x4 acc[8];
#pragma unroll
                for (int i = 0; i < 8; ++i) acc[i] = (f32x4){0.f, 0.f, 0.f, 0.f};
                bf16x8 af[4], kfa[8], kfb[8];
#pragma unroll
                for (int ks = 0; ks < 4; ++ks) af[ks] = *(const bf16x8*)(qtok + half * 128 + ks * 32 + fq * 8);
#define KFLOAD(BUF, KS) do { _Pragma("unroll") for (int nt = 0; nt < 8; ++nt) BUF[nt] = *(const bf16x8*)(KL + (half * 128 + nt * 16 + fr) * 272 + (KS) * 64 + fq * 16); } while (0)
#define KFMMA(BUF, KS) do { _Pragma("unroll") for (int nt = 0; nt < 8; ++nt) acc[nt] = mfma16(af[KS], BUF[nt], acc[nt]); } while (0)
                KFLOAD(kfa, 0);
                __builtin_amdgcn_sched_barrier(0);
                KFLOAD(kfb, 1); KFMMA(kfa, 0);
                __builtin_amdgcn_sched_barrier(0);
                KFLOAD(kfa, 2); KFMMA(kfb, 1);
                __builtin_amdgcn_sched_barrier(0);
                KFLOAD(kfb, 3); KFMMA(kfa, 2);
                __builtin_amdgcn_sched_barrier(0);
                KFMMA(kfb, 3);
#undef KFLOAD
#undef KFMMA
                if (fq < 2) {
#pragma unroll
                    for (int nt = 0; nt < 8; ++nt) {
                        float* dst = SC + (wid * 8 + fq * 4) * 256 + half * 128 + nt * 16 + fr;
                        dst[0] = acc[nt].x; dst[256] = acc[nt].y; dst[512] = acc[nt].z; dst[768] = acc[nt].w;
                    }
                }
            }
        }
        __builtin_amdgcn_wave_barrier();
        {
            const int sl = fr, gb = fq * 16;
            const int row0_ = wid * 8 + fq, row1_ = wid * 8 + 4 + fq;
            float v1[2] = {0.f, 0.f}, v2[2] = {0.f, 0.f}; int i1[2] = {0, 0}, i2[2] = {0, 0};
            {
                unsigned kc[4][8];
#pragma unroll
                for (int c4 = 0; c4 < 4; ++c4)
#pragma unroll
                    for (int i = 0; i < 8; ++i) { const int idx = sl + 16 * i;
                        kc[c4][i] = (f2ord(SC[((c4 & 1) ? row1_ : row0_) * 256 + (c4 >> 1) * 128 + idx]) & ~127u) | (unsigned)(127 - idx); }
                float sv[4] = {0.f, 0.f, 0.f, 0.f}; int si[4] = {0, 0, 0, 0};
                for (int r = 0; r < 16; ++r) {
                    unsigned m[4], t[4];
#pragma unroll
                    for (int c4 = 0; c4 < 4; ++c4) {
                        const unsigned x0 = kc[c4][0] > kc[c4][1] ? kc[c4][0] : kc[c4][1], x1 = kc[c4][2] > kc[c4][3] ? kc[c4][2] : kc[c4][3];
                        const unsigned x2 = kc[c4][4] > kc[c4][5] ? kc[c4][4] : kc[c4][5], x3 = kc[c4][6] > kc[c4][7] ? kc[c4][6] : kc[c4][7];
                        const unsigned y0 = x0 > x1 ? x0 : x1, y1 = x2 > x3 ? x2 : x3; m[c4] = y0 > y1 ? y0 : y1;
                    }
#pragma unroll
                    for (int c4 = 0; c4 < 4; ++c4) t[c4] = sxoru<1>(m[c4]);
#pragma unroll
                    for (int c4 = 0; c4 < 4; ++c4) m[c4] = m[c4] > t[c4] ? m[c4] : t[c4];
#pragma unroll
                    for (int c4 = 0; c4 < 4; ++c4) t[c4] = sxoru<2>(m[c4]);
#pragma unroll
                    for (int c4 = 0; c4 < 4; ++c4) m[c4] = m[c4] > t[c4] ? m[c4] : t[c4];
#pragma unroll
                    for (int c4 = 0; c4 < 4; ++c4) t[c4] = sxoru<4>(m[c4]);
#pragma unroll
                    for (int c4 = 0; c4 < 4; ++c4) m[c4] = m[c4] > t[c4] ? m[c4] : t[c4];
#pragma unroll
                    for (int c4 = 0; c4 < 4; ++c4) t[c4] = sxoru<8>(m[c4]);
#pragma unroll
                    for (int c4 = 0; c4 < 4; ++c4) m[c4] = m[c4] > t[c4] ? m[c4] : t[c4];
#pragma unroll
                    for (int c4 = 0; c4 < 4; ++c4) {
                        if (sl == r) { sv[c4] = ord2f(m[c4] & ~127u); si[c4] = 127 - (int)(m[c4] & 127u); }
#pragma unroll
                        for (int i = 0; i < 8; ++i) kc[c4][i] = kc[c4][i] == m[c4] ? 0u : kc[c4][i];
                    }
                }
                v1[0] = sv[0]; i1[0] = si[0]; v1[1] = sv[1]; i1[1] = si[1]; v2[0] = sv[2]; i2[0] = si[2]; v2[1] = sv[3]; i2[1] = si[3];
            }
            int pa = 0, pb = 0; float tsa = 0.f, tsb = 0.f; int pida = 0, pidb = 0;
            for (int r = 0; r < 16; ++r) {
                const float va = __int_as_float(__builtin_amdgcn_ds_bpermute((gb + (pa & 15)) << 2, __float_as_int(v2[0])));
                const float vb = __int_as_float(__builtin_amdgcn_ds_bpermute((gb + (pb & 15)) << 2, __float_as_int(v2[1])));
                const unsigned keya = pa < 16 ? ((f2ord(v1[0] + va) & ~255u) | (unsigned)(255 - (sl * 16 + pa))) : 0u;
                const unsigned keyb = pb < 16 ? ((f2ord(v1[1] + vb) & ~255u) | (unsigned)(255 - (sl * 16 + pb))) : 0u;
                unsigned ma = keya, mb = keyb, ta, tb;
                ta = sxoru<1>(ma); tb = sxoru<1>(mb); ma = ma > ta ? ma : ta; mb = mb > tb ? mb : tb;
                ta = sxoru<2>(ma); tb = sxoru<2>(mb); ma = ma > ta ? ma : ta; mb = mb > tb ? mb : tb;
                ta = sxoru<4>(ma); tb = sxoru<4>(mb); ma = ma > ta ? ma : ta; mb = mb > tb ? mb : tb;
                ta = sxoru<8>(ma); tb = sxoru<8>(mb); ma = ma > ta ? ma : ta; mb = mb > tb ? mb : tb;
                if (sl == r) { tsa = ord2f(ma & ~255u); pida = 255 - (int)(ma & 255u); tsb = ord2f(mb & ~255u); pidb = 255 - (int)(mb & 255u); }
                if (keya == ma) pa++;
                if (keyb == mb) pb++;
            }
#pragma unroll
            for (int ps = 0; ps < 2; ++ps) {
                const int pid = ps ? pidb : pida; const float ts = ps ? tsb : tsa; const int row = ps ? row1_ : row0_;
                const int e1 = __builtin_amdgcn_ds_bpermute((gb + (pid >> 4)) << 2, i1[ps]), e2 = __builtin_amdgcn_ds_bpermute((gb + (pid & 15)) << 2, i2[ps]);
                float mx = ts;
                mx = fmaxf(mx, sxor<1>(mx)); mx = fmaxf(mx, sxor<2>(mx)); mx = fmaxf(mx, sxor<4>(mx)); mx = fmaxf(mx, sxor<8>(mx));
                const float ex = __expf(ts - mx), sm = gsum16(ex);
                EIDX[row * 16 + sl] = e1 * 128 + e2; GATE[row * 16 + sl] = ex / sm;
            }
        }
        __builtin_amdgcn_wave_barrier();
        {
            const int tok = tok0 + wid;
            const bf16_t* hrow = HB + (size_t)tok * D;
            const int grp = lane >> 4, sl = lane & 15;
            {
                f32x2 hv[32];
#pragma unroll
                for (int c = 0; c < 8; ++c) {
                    const u32x4 hq = *(const u32x4*)(hrow + sl * 64 + c * 8);
                    hv[c * 4 + 0] = (f32x2){bflo(hq.x), bfhi(hq.x)} * (1.0f / PEER_SU); hv[c * 4 + 1] = (f32x2){bflo(hq.y), bfhi(hq.y)} * (1.0f / PEER_SU);
                    hv[c * 4 + 2] = (f32x2){bflo(hq.z), bfhi(hq.z)} * (1.0f / PEER_SU); hv[c * 4 + 3] = (f32x2){bflo(hq.w), bfhi(hq.w)} * (1.0f / PEER_SU);
                }
                const unsigned char* PU8 = p.ws + WS_PU + sl * 64;
#define ULOADG(BUF, IT) do { _Pragma("unroll") for (int i_ = 0; i_ < 2; ++i_) { const int k_ = ((IT) + i_) * 4 + grp; const unsigned char* ur_ = PU8 + (size_t)EIDX[wid * 128 + k_] * D; \
        BUF[i_ * 4 + 0] = *(const u32x4*)ur_; BUF[i_ * 4 + 1] = *(const u32x4*)(ur_ + 16); BUF[i_ * 4 + 2] = *(const u32x4*)(ur_ + 32); BUF[i_ * 4 + 3] = *(const u32x4*)(ur_ + 48); } } while (0)
#define PDOT(uq, base) \
        a2 += __builtin_amdgcn_cvt_pk_f32_fp8((int)uq.x, false) * hv[base + 0]; b2 += __builtin_amdgcn_cvt_pk_f32_fp8((int)uq.x, true) * hv[base + 1]; \
        a2 += __builtin_amdgcn_cvt_pk_f32_fp8((int)uq.y, false) * hv[base + 2]; b2 += __builtin_amdgcn_cvt_pk_f32_fp8((int)uq.y, true) * hv[base + 3]; \
        a2 += __builtin_amdgcn_cvt_pk_f32_fp8((int)uq.z, false) * hv[base + 4]; b2 += __builtin_amdgcn_cvt_pk_f32_fp8((int)uq.z, true) * hv[base + 5]; \
        a2 += __builtin_amdgcn_cvt_pk_f32_fp8((int)uq.w, false) * hv[base + 6]; b2 += __builtin_amdgcn_cvt_pk_f32_fp8((int)uq.w, true) * hv[base + 7];
#define UCOMP(BUF, IT) do { _Pragma("unroll") for (int i_ = 0; i_ < 2; ++i_) { const int k_ = ((IT) + i_) * 4 + grp; \
        f32x2 a2 = (f32x2){0.f, 0.f}, b2 = (f32x2){0.f, 0.f}; \
        PDOT(BUF[i_ * 4 + 0], 0) PDOT(BUF[i_ * 4 + 1], 8) PDOT(BUF[i_ * 4 + 2], 16) PDOT(BUF[i_ * 4 + 3], 24) \
        a2 += b2; const float a_ = gsum16(a2.x + a2.y); GATE[wid * 128 + k_] = GATE[wid * 128 + k_] * gelu_exact(a_); } } while (0)
                u32x4 ubA[8], ubB[8];
                ULOADG(ubA, 0);
                for (int it0 = 0; it0 < 32; it0 += 4) {
                    ULOADG(ubB, it0 + 2);
                    __builtin_amdgcn_sched_barrier(0);
                    UCOMP(ubA, it0);
                    __builtin_amdgcn_sched_barrier(0);
                    if (it0 + 4 < 32) ULOADG(ubA, it0 + 4);
                    __builtin_amdgcn_sched_barrier(0);
                    UCOMP(ubB, it0 + 2);
                    __builtin_amdgcn_sched_barrier(0);
                }
#undef ULOADG
#undef PDOT
#undef UCOMP
            }
            __builtin_amdgcn_wave_barrier();
            f32x2 acc[8];
#pragma unroll
            for (int i = 0; i < 8; ++i) acc[i] = (f32x2){0.f, 0.f};
            const unsigned char* PV8 = p.ws + WS_PV + lane * 16;
#define VLOADG(BUF, K0) do { _Pragma("unroll") for (int i_ = 0; i_ < 8; ++i_) BUF[i_] = *(const u32x4*)(PV8 + (size_t)EIDX[wid * 128 + (K0) + i_] * D); } while (0)
#define VCOMP(BUF, K0) do { _Pragma("unroll") for (int i_ = 0; i_ < 8; ++i_) { const float w_ = GATE[wid * 128 + (K0) + i_]; const f32x2 w2 = (f32x2){w_, w_}; const u32x4 v = BUF[i_]; \
        acc[0] += w2 * __builtin_amdgcn_cvt_pk_f32_fp8((int)v.x, false); acc[1] += w2 * __builtin_amdgcn_cvt_pk_f32_fp8((int)v.x, true); \
        acc[2] += w2 * __builtin_amdgcn_cvt_pk_f32_fp8((int)v.y, false); acc[3] += w2 * __builtin_amdgcn_cvt_pk_f32_fp8((int)v.y, true); \
        acc[4] += w2 * __builtin_amdgcn_cvt_pk_f32_fp8((int)v.z, false); acc[5] += w2 * __builtin_amdgcn_cvt_pk_f32_fp8((int)v.z, true); \
        acc[6] += w2 * __builtin_amdgcn_cvt_pk_f32_fp8((int)v.w, false); acc[7] += w2 * __builtin_amdgcn_cvt_pk_f32_fp8((int)v.w, true); } } while (0)
            {
                u32x4 vbA[8], vbB[8];
                VLOADG(vbA, 0);
                for (int k0 = 0; k0 < 128; k0 += 16) {
                    VLOADG(vbB, k0 + 8);
                    __builtin_amdgcn_sched_barrier(0);
                    VCOMP(vbA, k0);
                    __builtin_amdgcn_sched_barrier(0);
                    if (k0 + 16 < 128) VLOADG(vbA, k0 + 16);
                    __builtin_amdgcn_sched_barrier(0);
                    VCOMP(vbB, k0 + 8);
                    __builtin_amdgcn_sched_barrier(0);
                }
            }
#undef VLOADG
#undef VCOMP
            float* orow = G.out + (size_t)tok * D + lane * 16;
#pragma unroll
            for (int i = 0; i < 4; ++i) {
                f32x4 t = *(f32x4*)(orow + i * 4);
                t.x += acc[2 * i].x * (1.0f / PEER_SV); t.y += acc[2 * i].y * (1.0f / PEER_SV); t.z += acc[2 * i + 1].x * (1.0f / PEER_SV); t.w += acc[2 * i + 1].y * (1.0f / PEER_SV);
                *(f32x4*)(orow + i * 4) = t;
            }
        }
        __builtin_amdgcn_wave_barrier();
    }
}


constexpr int NPH = 3 + NGROUP * 3;
__device__ __forceinline__ void run_phase(const Params& p, int ph, char* lds, int* s_item) {
    const int g = (ph - 3) / 3, s = (ph - 3) % 3;
    const Grp G = get_group(p, g);
    if (s == 0) {
        for (int u = blockIdx.x; u < 256; u += gridDim.x) {
            const int m0 = (u >> 1) * 256;
            phase_rmsnorm(G.x, p.in[I_GMIX], (bf16_t*)(p.ws + WS_HB), m0, 256);
            __syncthreads();
            phase_inproj(p, g, lds, u);
            __syncthreads();
        }
    } else if (s == 1) {
        phase_mixer(p, g, lds, s_item);
    } else {
        for (int u = blockIdx.x; u < 256; u += gridDim.x) {
            const int m0 = u * 128;
            phase_glafin(p, g, m0, 128);
            __syncthreads();
            phase_merge(p, g, lds, u);
            __syncthreads();
            phase_outproj(p, g, lds, u);
            __syncthreads();
            phase_rmsnorm(G.out, p.in[I_GFFN], (bf16_t*)(p.ws + WS_HB), m0, 128);
            __syncthreads();
            phase_peerq(p, g, lds, u);
            __syncthreads();
            phase_peer(p, g, lds, m0 / 8, 16);
            __syncthreads();
        }
    }
}

__global__ void __launch_bounds__(NTHR) mega_kernel(Params p) {
    extern __shared__ __attribute__((aligned(16))) char lds[];
    __shared__ int s_item;
    cg::grid_group grid = cg::this_grid();
    phase_p0a(p, lds); grid.sync();
    phase_p0b(p, lds); grid.sync();
    for (int ph = 3; ph < NPH; ++ph) {
        run_phase(p, ph, lds, &s_item);
        if (ph + 1 < NPH) grid.sync();
    }
}

extern "C" void kernel_launch(void* const* d_in, const int* in_sizes, int n_in, void* d_out, int out_size, void* d_ws, size_t ws_size, hipStream_t stream) {
    static int grid_blocks = 0;
    if (grid_blocks == 0) {
        if (n_in != 32 || ws_size < WS_END) { fprintf(stderr, "kernel_launch: unexpected n_in %d or ws_size %zu (< %zu)\n", n_in, ws_size, (size_t)WS_END); grid_blocks = -1; return; }
        int dev = 0, cus = 0, per_cu = 0;
        hipGetDevice(&dev);
        hipDeviceGetAttribute(&cus, hipDeviceAttributeMultiprocessorCount, dev);
        hipFuncSetAttribute((const void*)mega_kernel, hipFuncAttributeMaxDynamicSharedMemorySize, LDS_BYTES);
        hipOccupancyMaxActiveBlocksPerMultiprocessor(&per_cu, (const void*)mega_kernel, NTHR, LDS_BYTES);
        if (per_cu < 1) per_cu = 1;
        grid_blocks = cus * per_cu;
        (void)hipGetLastError();
    }
    if (grid_blocks < 0) return;
    Params p{};
    for (int i = 0; i < 32; ++i) p.in[i] = (const float*)d_in[i];
    p.out = (float*)d_out; p.ws = (unsigned char*)d_ws; p.ph_lo = 0; p.ph_hi = NPH;
    void* args[] = {&p};
    hipError_t e = hipLaunchCooperativeKernel((const void*)mega_kernel, dim3(grid_blocks), dim3(NTHR), args, LDS_BYTES, stream);
    if (e != hipSuccess) fprintf(stderr, "cooperative launch failed: %s (grid %d)\n", hipGetErrorString(e), grid_blocks);
}
```

```cpp
#include <hip/hip_runtime.h>
#include <hip/hip_cooperative_groups.h>
#include <cstdio>
#include <cstdint>
namespace cg = cooperative_groups;

typedef unsigned short bf16_t;
typedef short bf16x8 __attribute__((ext_vector_type(8)));
typedef float f32x4 __attribute__((ext_vector_type(4)));
typedef unsigned u32x4 __attribute__((ext_vector_type(4)));
typedef unsigned u32x2 __attribute__((ext_vector_type(2)));

constexpr int D = 1024;
constexpr int NP = 10496;
constexpr int IN_COLS = 10272;
constexpr int C_GQ = 0, C_GK = 512, C_GV = 1024, C_GG = 2048, C_DQ = 3072, C_DK = 4096, C_DV = 5120, C_MQ = 6144, C_BG = 7168, C_LR = 10240;
constexpr int G_TOK = 32768;
constexpr int NGROUP = 3;
constexpr int NTHR = 512;
constexpr float RMS_EPS = 1e-6f;
constexpr float LOG2E = 1.4426950408889634f;
constexpr int LDS_BYTES = 147456;
constexpr float PEER_SU = 32.0f, PEER_SV = 8.0f;

enum { I_XP = 0, I_XS, I_MP, I_MS, I_GMIX, I_WIN, I_WDF, I_BDF, I_WDB, I_BDB, I_GOUT, I_GWO, I_DGQ, I_DGK, I_LQ1, I_LK1, I_LQ2, I_LK2,
       I_DGSUB, I_DWO, I_MGN, I_MWKV, I_MGQ, I_MGK, I_MWO, I_WOUT, I_GFFN, I_PWQ, I_PK1, I_PK2, I_PU, I_PV };

constexpr size_t al256(size_t x) { return (x + 255) & ~(size_t)255; }
constexpr size_t WS_CTRL = 0;
constexpr size_t WS_PROJ = 4096;
constexpr size_t WS_HB   = WS_PROJ + (size_t)G_TOK * NP * 2;
constexpr size_t WS_VT   = WS_HB + (size_t)G_TOK * D * 2;
constexpr size_t WS_WINT = WS_VT + (size_t)G_TOK * D * 2;
constexpr size_t WS_WOT  = WS_WINT + (size_t)NP * D * 2;
constexpr size_t WS_WKVT = WS_WOT + (size_t)4 * D * D * 2;
constexpr size_t WS_WQT  = WS_WKVT + (size_t)2048 * D * 2;
constexpr size_t WS_PU   = WS_WQT + (size_t)2048 * D * 2;
constexpr size_t WS_PV   = WS_PU + (size_t)16384 * D * 2;
constexpr size_t WS_K12  = WS_PV + (size_t)16384 * D * 2;
constexpr size_t WS_ROPE = WS_K12 + (size_t)2 * 128 * 128 * 2;
constexpr size_t WS_HM   = WS_ROPE + (size_t)16384 * 64 * 4;
constexpr size_t WS_KVR  = WS_HM + (size_t)2560 * D * 2;
constexpr size_t WS_MEMK = WS_KVR + (size_t)2560 * 2048 * 4;
constexpr size_t WS_MEMV = WS_MEMK + (size_t)10 * 4 * 256 * 256 * 2;
constexpr size_t WS_END  = WS_MEMV + (size_t)10 * 4 * 256 * 256 * 2;

struct Params {
    const float* in[32];
    float* out;
    unsigned char* ws;
    int ph_lo, ph_hi;
};

typedef float f32x2 __attribute__((ext_vector_type(2)));
typedef __bf16 bf16x2v __attribute__((ext_vector_type(2)));
__device__ __forceinline__ unsigned pk2(float lo, float hi) { const f32x2 v = {lo, hi}; const bf16x2v b = __builtin_convertvector(v, bf16x2v); return __builtin_bit_cast(unsigned, b); }
__device__ __forceinline__ float bflo(unsigned u) { return __uint_as_float(u << 16); }
__device__ __forceinline__ float bfhi(unsigned u) { return __uint_as_float(u & 0xffff0000u); }
__device__ __forceinline__ float bf2f(bf16_t b) { return __uint_as_float(((unsigned)b) << 16); }
__device__ __forceinline__ bf16_t f2bf(float f) { return (bf16_t)(pk2(f, 0.f) & 0xffffu); }
__device__ __forceinline__ f32x4 mfma16(bf16x8 a, bf16x8 b, f32x4 c) { return __builtin_amdgcn_mfma_f32_16x16x32_bf16(a, b, c, 0, 0, 0); }
__device__ __forceinline__ float fexp2(float x) { return __builtin_amdgcn_exp2f(x); }
template <class T> __device__ __forceinline__ T* launder(T* q) { asm volatile("" : "+s"(q)); return q; }
__device__ __forceinline__ int otid() { int t = threadIdx.x; asm volatile("" : "+v"(t)); return t; }
template <int M> __device__ __forceinline__ float sxor(float v) {
    if (M < 32) return __int_as_float(__builtin_amdgcn_ds_swizzle(__float_as_int(v), (M << 10) | 0x1F));
    const int l = otid() & 63; return __int_as_float(__builtin_amdgcn_ds_bpermute((l ^ 32) << 2, __float_as_int(v)));
}
template <int M> __device__ __forceinline__ unsigned sxoru(unsigned v) { return (unsigned)__builtin_amdgcn_ds_swizzle((int)v, (M << 10) | 0x1F); }
__device__ __forceinline__ float wave_sum(float v) {
    v += sxor<1>(v); v += sxor<2>(v); v += sxor<4>(v); v += sxor<8>(v); v += sxor<16>(v); v += sxor<32>(v);
    return v;
}

struct Grp { const float* x; const float* mem; float* out; int B, T, mb0; };
__device__ __forceinline__ Grp get_group(const Params& p, int g) {
    Grp r;
    if (g == 0) { r.x = p.in[I_XP]; r.out = p.out; r.B = 2; r.T = 16384; r.mb0 = 0; }
    else { r.x = p.in[I_XS] + (size_t)(g - 1) * G_TOK * D; r.out = p.out + (size_t)g * G_TOK * D; r.B = 4; r.T = 8192; r.mb0 = 2 + (g - 1) * 4; }
    r.mem = nullptr;
    return r;
}

constexpr int G_ROW = 144;
constexpr int G_A_BYTES = 128 * G_ROW;
constexpr int G_B_BYTES = 256 * G_ROW;
constexpr int G_STAGE = G_A_BYTES + G_B_BYTES;

template <bool SWAP, int MT>
__device__ __forceinline__ void gemm_kloop(f32x4 (&acc)[MT][4], const bf16_t* __restrict__ A, int lda, const bf16_t* __restrict__ Bt, int ldb, int K, char* lds) {
    constexpr int A_ROWS = MT * 32, A_BYTES = A_ROWS * G_ROW, STAGE = A_BYTES + G_B_BYTES;
    constexpr int NA = A_BYTES / 1024, NI = STAGE / 1024, NPER = (NI + 7) / 8;
    const int tid = otid(), lane = tid & 63, wid = __builtin_amdgcn_readfirstlane(tid >> 6), wm = wid >> 2, wn = wid & 3, fr = lane & 15, fq = lane >> 4;
    unsigned goff[NPER];
#pragma unroll
    for (int i = 0; i < NPER; ++i) {
        const int j = wid + 8 * i;
        const int ci = (j < NA ? j : j - NA) * 64 + lane, row = ci / 9, ch = ci % 9, chc = ch < 8 ? ch : 7;
        goff[i] = (unsigned)(row * (j < NA ? lda : ldb) + chc * 8);
    }
#define GSTAGE(buf, k0) do { _Pragma("unroll") for (int i = 0; i < NPER; ++i) { const int j = wid + 8 * i; if (j < NI) { \
        const bf16_t* src_ = (j < NA ? A : Bt) + goff[i] + (k0); \
        __builtin_amdgcn_global_load_lds((const unsigned*)src_, (unsigned*)(lds + (buf) * STAGE + j * 1024), 16, 0, 0); } } } while (0)
    const int nk = K / 64;
    GSTAGE(0, 0);
    __syncthreads();
    for (int kt = 0; kt < nk; ++kt) {
        if (kt + 1 < nk) GSTAGE((kt + 1) & 1, (kt + 1) * 64);
        const char* base = lds + (kt & 1) * STAGE;
        const char* abase = base + (wm * (MT * 16) + fr) * G_ROW + fq * 16;
        const char* bbase = base + A_BYTES + (wn * 64 + fr) * G_ROW + fq * 16;
        bf16x8 b0[4], b1[4], ar[4];
#pragma unroll
        for (int nt = 0; nt < 4; ++nt) b0[nt] = *(const bf16x8*)(bbase + nt * 16 * G_ROW);
        ar[0] = *(const bf16x8*)(abase); ar[1] = *(const bf16x8*)(abase + 16 * G_ROW); ar[2] = *(const bf16x8*)(abase + 32 * G_ROW);
#pragma unroll
        for (int st = 0; st < 2 * MT; ++st) {
            const int ks = st / MT, mt = st % MT;
            __builtin_amdgcn_sched_barrier(0);
            if (st + 3 < 2 * MT) { const int ks2 = (st + 3) / MT, mt2 = (st + 3) % MT; ar[(st + 3) % 4] = *(const bf16x8*)(abase + mt2 * 16 * G_ROW + ks2 * 64); }
            if (ks == 0 && mt >= MT - 3 && mt < MT - 1) {
#pragma unroll
                for (int q = 0; q < 2; ++q) { const int nt = (mt - (MT - 3)) * 2 + q; b1[nt] = *(const bf16x8*)(bbase + nt * 16 * G_ROW + 64); }
            }
#pragma unroll
            for (int nt = 0; nt < 4; ++nt) {
                const bf16x8 bv = ks == 0 ? b0[nt] : b1[nt];
                acc[mt][nt] = SWAP ? mfma16(bv, ar[st % 4], acc[mt][nt]) : mfma16(ar[st % 4], bv, acc[mt][nt]);
            }
        }
        __builtin_amdgcn_sched_barrier(0);
        __syncthreads();
    }
#undef GSTAGE
}

__device__ __forceinline__ void tile_order(int t, int nM, int nN, int& pm, int& pn) {
    const int per = 8 * nN, grp = t / per, r = t % per;
    pm = grp * 8 + (r & 7); pn = r >> 3;
}

__device__ __forceinline__ void phase_p0a(const Params& p, char* lds) {
    const int tid = otid(), lane = tid & 63, wid = tid >> 6;
    unsigned char* ws = p.ws;
    if (blockIdx.x == 0 && tid < 256) atomicExch((unsigned*)(ws + WS_CTRL) + tid, 0u);
    float* scr = (float*)(lds + wid * 8448);
    constexpr int IT_WIN = 16 * (NP / 32), IT_SQ = 16 * 32, IT_W2 = 16 * 64;
    constexpr int NIT = IT_WIN + 4 * IT_SQ + 2 * IT_W2;
    for (int it0 = blockIdx.x * 8; it0 < NIT; it0 += gridDim.x * 8) {
        int it = it0 + wid;
        const float* W = nullptr; bf16_t* WT = nullptr; int N = 0, nb = 0, kb = 0, srccol = -1;
        if (it < NIT) {
            int r = it;
            if (r < IT_WIN) { W = p.in[I_WIN]; N = IN_COLS; WT = (bf16_t*)(ws + WS_WINT); kb = r / (NP / 32); nb = r % (NP / 32);
                const int n0 = nb * 32; srccol = n0 < 3072 ? n0 : (n0 < 10240 ? n0 + 32 : (n0 == 10240 ? 3072 : -1)); }
            else { r -= IT_WIN;
                if (r < 4 * IT_SQ) { const int w = r / IT_SQ; r %= IT_SQ; const int idx[4] = {I_GWO, I_DWO, I_MWO, I_WOUT};
                    W = p.in[w == 0 ? I_GWO : (w == 1 ? I_DWO : (w == 2 ? I_MWO : I_WOUT))]; (void)idx; N = 1024; WT = (bf16_t*)(ws + WS_WOT) + (size_t)w * D * D; kb = r / 32; nb = r % 32; srccol = nb * 32; }
                else { r -= 4 * IT_SQ; const int w = r / IT_W2; r %= IT_W2; W = p.in[w == 0 ? I_MWKV : I_PWQ]; N = 2048; WT = (bf16_t*)(ws + (w == 0 ? WS_WKVT : WS_WQT)); kb = r / 64; nb = r % 64; srccol = nb * 32; }
            }
            const int k0 = kb * 64;
#pragma unroll 8
            for (int i = 0; i < 32; ++i) { const int kk = 2 * i + (lane >> 5); scr[kk * 33 + (lane & 31)] = srccol >= 0 ? W[(size_t)(k0 + kk) * N + srccol + (lane & 31)] : 0.f; }
        }
        __syncthreads();
        if (it < NIT) {
            const int k0 = kb * 64, c = lane & 7;
#pragma unroll
            for (int j = 0; j < 4; ++j) { const int n = (lane >> 3) + 8 * j; const float* s = scr + (8 * c) * 33 + n;
                u32x4 o; o.x = pk2(s[0], s[33]); o.y = pk2(s[66], s[99]); o.z = pk2(s[132], s[165]); o.w = pk2(s[198], s[231]);
                *(u32x4*)(WT + (size_t)(nb * 32 + n) * D + k0 + 8 * c) = o; }
        }
        __syncthreads();
    }
    const size_t gtid = (size_t)blockIdx.x * NTHR + tid, gsz = (size_t)gridDim.x * NTHR;
    {
        const size_t n8 = (size_t)16384 * D / 8;
        for (size_t i = gtid; i < 2 * n8; i += gsz) {
            const int w = i >= n8; const size_t j = w ? i - n8 : i;
            const float* src = p.in[w ? I_PV : I_PU] + j * 8; unsigned char* dst = ws + (w ? WS_PV : WS_PU) + j * 8;
            const float sc = w ? PEER_SV : PEER_SU;
            const f32x4 a = *(const f32x4*)src * sc, b = *(const f32x4*)(src + 4) * sc;
            int lo = __builtin_amdgcn_cvt_pk_fp8_f32(a.x, a.y, 0, false); lo = __builtin_amdgcn_cvt_pk_fp8_f32(a.z, a.w, lo, true);
            int hi = __builtin_amdgcn_cvt_pk_fp8_f32(b.x, b.y, 0, false); hi = __builtin_amdgcn_cvt_pk_fp8_f32(b.z, b.w, hi, true);
            *(u32x2*)dst = (u32x2){(unsigned)lo, (unsigned)hi};
        }
        for (size_t i = gtid; i < 2 * 16384; i += gsz) {
            const int w = i >= 16384; const size_t j = w ? i - 16384 : i;
            ((bf16_t*)(ws + WS_K12))[i] = f2bf(p.in[w ? I_PK2 : I_PK1][j]);
        }
    }
    for (size_t i = gtid; i < (size_t)16384 * 32; i += gsz) {
        const int t = (int)(i >> 5), k = (int)(i & 31);
        const float inv = powf(10000.0f, -(float)(2 * k) / 64.0f);
        const float ang = (float)t * inv;
        double sn, cs; sincos((double)ang, &sn, &cs);
        float* R = (float*)(ws + WS_ROPE) + (size_t)t * 64;
        R[k] = (float)cs; R[32 + k] = (float)sn;
    }
    for (int row = blockIdx.x * 8 + wid; row < 2560; row += gridDim.x * 8) {
        const float* src = row < 512 ? p.in[I_MP] + (size_t)row * D : p.in[I_MS] + (size_t)(row - 512) * D;
        const f32x4* xr = (const f32x4*)src + lane; const f32x4* gr = (const f32x4*)p.in[I_MGN] + lane;
        f32x4 v[4]; float s = 0.f;
#pragma unroll
        for (int j = 0; j < 4; ++j) { v[j] = xr[64 * j]; s += v[j].x * v[j].x + v[j].y * v[j].y + v[j].z * v[j].z + v[j].w * v[j].w; }
        const float r = rsqrtf(wave_sum(s) * (1.f / D) + RMS_EPS);
        u32x2* o = (u32x2*)((bf16_t*)(ws + WS_HM) + (size_t)row * D) + lane;
#pragma unroll
        for (int j = 0; j < 4; ++j) { const f32x4 g = gr[64 * j]; u32x2 w; w.x = pk2(v[j].x * r * g.x, v[j].y * r * g.y); w.y = pk2(v[j].z * r * g.z, v[j].w * r * g.w); o[64 * j] = w; }
    }
}

__device__ __forceinline__ void phase_p0b(const Params& p, char* lds) {
    const int tid_ = otid(), lane = tid_ & 63, wid = tid_ >> 6, wm = wid >> 2, wn = wid & 3, fr = lane & 15, fq = lane >> 4;
    const bf16_t* A = (const bf16_t*)(p.ws + WS_HM); const bf16_t* Bt = (const bf16_t*)(p.ws + WS_WKVT);
    float* C = (float*)(p.ws + WS_KVR);
    const int nM = 20, nN = 8;
    for (int t = blockIdx.x; t < nM * nN; t += gridDim.x) {
        const int pm = t % nM, pn = t / nM, m0 = pm * 128, n0 = pn * 256;
        f32x4 acc[4][4];
#pragma unroll
        for (int i = 0; i < 4; ++i)
#pragma unroll
            for (int j = 0; j < 4; ++j) acc[i][j] = (f32x4){0.f, 0.f, 0.f, 0.f};
        gemm_kloop<true, 4>(acc, A + (size_t)m0 * D, D, Bt + (size_t)n0 * D, D, D, lds);
#pragma unroll
        for (int mt = 0; mt < 4; ++mt)
#pragma unroll
            for (int nt = 0; nt < 4; ++nt) {
                const int row = m0 + wm * 64 + mt * 16 + fr, col = n0 + wn * 64 + nt * 16 + fq * 4;
                *(f32x4*)(C + (size_t)row * 2048 + col) = acc[mt][nt];
            }
        __syncthreads();
        {
            bf16_t* MK = (bf16_t*)(p.ws + WS_MEMK); bf16_t* MV = (bf16_t*)(p.ws + WS_MEMV);
            for (int r = wid; r < 128; r += 8) {
                const int row = m0 + r, b = row >> 8, m = row & 255;
                const f32x4 kv = *(const f32x4*)(C + (size_t)row * 2048 + n0 + lane * 4);
                if (pn < 4) {
                    const int h = pn;
                    const float ss = wave_sum(kv.x * kv.x + kv.y * kv.y + kv.z * kv.z + kv.w * kv.w);
                    const float rr = rsqrtf(ss * (1.f / 256.f) + RMS_EPS);
                    const f32x4 g = *(const f32x4*)(p.in[I_MGK] + lane * 4);
                    u32x2 w; w.x = pk2(kv.x * rr * g.x, kv.y * rr * g.y); w.y = pk2(kv.z * rr * g.z, kv.w * rr * g.w);
                    *(u32x2*)(MK + ((size_t)(b * 4 + h) * 256 + m) * 256 + lane * 4) = w;
                } else {
                    const int h = pn - 4;
                    const int pos = (m & ~31) + ((m >> 2) & 3) * 8 + ((m >> 4) & 1) * 4 + (m & 3);
                    bf16_t* dst = MV + ((size_t)(b * 4 + h) * 256 + lane * 4) * 256 + pos;
                    dst[0] = f2bf(kv.x); dst[256] = f2bf(kv.y); dst[512] = f2bf(kv.z); dst[768] = f2bf(kv.w);
                }
            }
        }
        __syncthreads();
    }
}

__device__ __forceinline__ void phase_p0c(const Params& p) {
    const int tid_ = otid(), lane = tid_ & 63, wid = tid_ >> 6;
    const float* KV = (const float*)(p.ws + WS_KVR);
    bf16_t* MK = (bf16_t*)(p.ws + WS_MEMK); bf16_t* MV = (bf16_t*)(p.ws + WS_MEMV);
    for (int it = blockIdx.x * 8 + wid; it < 2560 * 4; it += gridDim.x * 8) {
        const int row = it >> 2, h = it & 3, b = row >> 8, m = row & 255;
        const f32x4 kv = *(const f32x4*)(KV + (size_t)row * 2048 + h * 256 + lane * 4);
        const float ss = wave_sum(kv.x * kv.x + kv.y * kv.y + kv.z * kv.z + kv.w * kv.w);
        const float r = rsqrtf(ss * (1.f / 256.f) + RMS_EPS);
        const f32x4 g = *(const f32x4*)(p.in[I_MGK] + lane * 4);
        u32x2 w; w.x = pk2(kv.x * r * g.x, kv.y * r * g.y); w.y = pk2(kv.z * r * g.z, kv.w * r * g.w);
        *(u32x2*)(MK + ((size_t)(b * 4 + h) * 256 + m) * 256 + lane * 4) = w;
        const f32x4 vv = *(const f32x4*)(KV + (size_t)row * 2048 + 1024 + h * 256 + lane * 4);
        const int pos = (m & ~31) + ((m >> 2) & 3) * 8 + ((m >> 4) & 1) * 4 + (m & 3);
        bf16_t* dst = MV + ((size_t)(b * 4 + h) * 256 + lane * 4) * 256 + pos;
        dst[0] = f2bf(vv.x); dst[256] = f2bf(vv.y); dst[512] = f2bf(vv.z); dst[768] = f2bf(vv.w);
    }
}

__device__ __forceinline__ void phase_rmsnorm(const float* X, const float* gain, bf16_t* O, int row0, int nrows) {
    const int tid_ = otid(), lane = tid_ & 63, wid = tid_ >> 6;
    const f32x4* gr = (const f32x4*)launder(gain) + lane;
    f32x4 g[4];
#pragma unroll
    for (int j = 0; j < 4; ++j) g[j] = gr[64 * j];
    f32x4 vn[4];
    { const f32x4* xr = (const f32x4*)(X + (size_t)(row0 + wid) * D) + lane;
#pragma unroll
      for (int j = 0; j < 4; ++j) vn[j] = xr[64 * j]; }
    for (int row = row0 + wid; row < row0 + nrows; row += 8) {
        f32x4 v[4]; float s = 0.f;
#pragma unroll
        for (int j = 0; j < 4; ++j) v[j] = vn[j];
        if (row + 8 < row0 + nrows) { const f32x4* xr = (const f32x4*)(X + (size_t)(row + 8) * D) + lane;
#pragma unroll
            for (int j = 0; j < 4; ++j) vn[j] = xr[64 * j]; }
        __builtin_amdgcn_sched_barrier(0);
#pragma unroll
        for (int j = 0; j < 4; ++j) s += v[j].x * v[j].x + v[j].y * v[j].y + v[j].z * v[j].z + v[j].w * v[j].w;
        const float r = rsqrtf(wave_sum(s) * (1.f / D) + RMS_EPS);
        u32x2* o = (u32x2*)(O + (size_t)row * D) + lane;
#pragma unroll
        for (int j = 0; j < 4; ++j) { u32x2 w; w.x = pk2(v[j].x * r * g[j].x, v[j].y * r * g[j].y); w.y = pk2(v[j].z * r * g[j].z, v[j].w * r * g[j].w); o[64 * j] = w; }
    }
}

__device__ __forceinline__ void phase_inproj(const Params& p, int g, char* lds, int u) {
    const Grp G = get_group(p, g);
    const int tid_ = otid(), lane = tid_ & 63, wid = tid_ >> 6, wm = wid >> 2, wn = wid & 3, fr = lane & 15, fq = lane >> 4;
    const bf16_t* A = (const bf16_t*)(p.ws + WS_HB); const bf16_t* Bt = (const bf16_t*)(p.ws + WS_WINT);
    bf16_t* P = (bf16_t*)(p.ws + WS_PROJ); bf16_t* VT = (bf16_t*)(p.ws + WS_VT);
    const int pm = u >> 1, half = u & 1, m0 = pm * 256;
    for (int pi = 0; pi < (half ? 17 : 12); ++pi) {
        const int pn = half ? 24 + pi : pi; const int n0 = pn * 256;
        f32x4 acc[8][4];
#pragma unroll
        for (int i = 0; i < 8; ++i)
#pragma unroll
            for (int j = 0; j < 4; ++j) acc[i][j] = (f32x4){0.f, 0.f, 0.f, 0.f};
        gemm_kloop<true, 8>(acc, A + (size_t)m0 * D, D, Bt + (size_t)n0 * D, D, D, lds);
        const float sc = n0 < 512 ? 0.08838834764831845f : 1.0f;
#pragma unroll
        for (int mt = 0; mt < 8; ++mt)
#pragma unroll
            for (int nt = 0; nt < 4; ++nt) {
                const int row = m0 + wm * 128 + mt * 16 + fr, col = n0 + wn * 64 + nt * 16 + fq * 4;
                u32x2 w; w.x = pk2(acc[mt][nt].x * sc, acc[mt][nt].y * sc); w.y = pk2(acc[mt][nt].z * sc, acc[mt][nt].w * sc);
                *(u32x2*)(P + (size_t)row * NP + col) = w;
            }
    }
    if (half == 0) for (int pn = 12; pn < 20; ++pn) {
        const int n0 = pn * 256;
        f32x4 acc[8][4];
#pragma unroll
        for (int i = 0; i < 8; ++i)
#pragma unroll
            for (int j = 0; j < 4; ++j) acc[i][j] = (f32x4){0.f, 0.f, 0.f, 0.f};
        gemm_kloop<true, 8>(acc, A + (size_t)m0 * D, D, Bt + (size_t)n0 * D, D, D, lds);
        const int te_ = otid(), fr = te_ & 15, fq = (te_ >> 4) & 3, wm = te_ >> 8, wn = (te_ >> 6) & 3;
        const bool isk = n0 >= C_DK;
        const float* gn = launder(p.in[isk ? I_DGK : I_DGQ]) + fq * 4;
        const float qs = isk ? 1.0f : 0.125f * LOG2E;
        const float* ROPE = (const float*)(p.ws + WS_ROPE);
        const int tq0 = m0 % G.T + wm * 128 + fr;
#pragma unroll
        for (int mt = 0; mt < 8; ++mt) {
            const int row = m0 + wm * 128 + mt * 16 + fr, t = tq0 + mt * 16;
            float ss = 0.f;
#pragma unroll
            for (int nt = 0; nt < 4; ++nt) ss += acc[mt][nt].x * acc[mt][nt].x + acc[mt][nt].y * acc[mt][nt].y + acc[mt][nt].z * acc[mt][nt].z + acc[mt][nt].w * acc[mt][nt].w;
            ss += sxor<16>(ss); ss += sxor<32>(ss);
            const float r = rsqrtf(ss * (1.f / 64.f) + RMS_EPS) * qs;
            const float* rp = ROPE + (size_t)t * 64 + fq * 4;
            bf16_t* dst = P + (size_t)row * NP + n0 + wn * 64 + fq * 4;
#pragma unroll
            for (int hh = 0; hh < 2; ++hh) {
                const f32x4 cs = *(const f32x4*)(rp + hh * 16), sn = *(const f32x4*)(rp + 32 + hh * 16);
                const f32x4 ya = acc[mt][hh] * *(const f32x4*)(gn + hh * 16) * r, yb = acc[mt][hh + 2] * *(const f32x4*)(gn + 32 + hh * 16) * r;
                const f32x4 oa = ya * cs - yb * sn, ob = yb * cs + ya * sn;
                *(u32x2*)(dst + hh * 16) = (u32x2){pk2(oa.x, oa.y), pk2(oa.z, oa.w)};
                *(u32x2*)(dst + 32 + hh * 16) = (u32x2){pk2(ob.x, ob.y), pk2(ob.z, ob.w)};
            }
        }
    }
    for (int pn = half ? 21 : 20; pn < (half ? 24 : 21); ++pn) {
        const int n0 = pn * 256;
        f32x4 acc[8][4];
#pragma unroll
        for (int i = 0; i < 8; ++i)
#pragma unroll
            for (int j = 0; j < 4; ++j) acc[i][j] = (f32x4){0.f, 0.f, 0.f, 0.f};
        gemm_kloop<false, 8>(acc, A + (size_t)m0 * D, D, Bt + (size_t)n0 * D, D, D, lds);
        const int b = m0 / G.T, t0 = m0 % G.T + wm * 128;
#pragma unroll
        for (int mt = 0; mt < 8; ++mt)
#pragma unroll
            for (int nt = 0; nt < 4; ++nt) {
                const int n = n0 - C_DV + wn * 64 + nt * 16 + fr, h = n >> 7, dv = n & 127;
                const int pos = t0 + (mt >> 1) * 32 + fq * 8 + (mt & 1) * 4;
                u32x2 w; w.x = pk2(acc[mt][nt].x, acc[mt][nt].y); w.y = pk2(acc[mt][nt].z, acc[mt][nt].w);
                *(u32x2*)(VT + ((size_t)((b * 8 + h) * 128 + dv)) * G.T + pos) = w;
            }
    }
}

__device__ __forceinline__ void phase_qkrope(const Params& p, int g, int tok0, int ntok) {
    const Grp G = get_group(p, g);
    const int tid_ = otid(), lane = tid_ & 63, wid = tid_ >> 6, grp = lane >> 2, sub = lane & 3;
    bf16_t* P = (bf16_t*)(p.ws + WS_PROJ); const float* ROPE = (const float*)(p.ws + WS_ROPE);
    for (int it = tok0 * 2 + wid; it < (tok0 + ntok) * 2; it += 8) {
        const int tok = it >> 1, isk = it & 1, t = tok % G.T;
        bf16_t* base = P + (size_t)tok * NP + (isk ? C_DK : C_DQ) + grp * 64 + sub * 8;
        const u32x4 a = *(const u32x4*)base, b = *(const u32x4*)(base + 32);
        float x1[8], x2[8];
        x1[0] = bflo(a.x); x1[1] = bfhi(a.x); x1[2] = bflo(a.y); x1[3] = bfhi(a.y); x1[4] = bflo(a.z); x1[5] = bfhi(a.z); x1[6] = bflo(a.w); x1[7] = bfhi(a.w);
        x2[0] = bflo(b.x); x2[1] = bfhi(b.x); x2[2] = bflo(b.y); x2[3] = bfhi(b.y); x2[4] = bflo(b.z); x2[5] = bfhi(b.z); x2[6] = bflo(b.w); x2[7] = bfhi(b.w);
        float ss = 0.f;
#pragma unroll
        for (int e = 0; e < 8; ++e) ss += x1[e] * x1[e] + x2[e] * x2[e];
        ss += sxor<1>(ss); ss += sxor<2>(ss);
        const float r = rsqrtf(ss * (1.f / 64.f) + RMS_EPS) * (isk ? 1.0f : 0.125f * LOG2E);
        const float* gn = p.in[isk ? I_DGK : I_DGQ] + sub * 8;
        const float* rp = ROPE + (size_t)t * 64 + sub * 8;
        float o1[8], o2[8];
#pragma unroll
        for (int e = 0; e < 8; ++e) {
            const float y1 = x1[e] * r * gn[e], y2 = x2[e] * r * gn[32 + e], c = rp[e], s = rp[32 + e];
            o1[e] = y1 * c - y2 * s; o2[e] = y2 * c + y1 * s;
        }
        u32x4 w1, w2;
        w1.x = pk2(o1[0], o1[1]); w1.y = pk2(o1[2], o1[3]); w1.z = pk2(o1[4], o1[5]); w1.w = pk2(o1[6], o1[7]);
        w2.x = pk2(o2[0], o2[1]); w2.y = pk2(o2[2], o2[3]); w2.z = pk2(o2[4], o2[5]); w2.w = pk2(o2[6], o2[7]);
        *(u32x4*)base = w1; *(u32x4*)(base + 32) = w2;
    }
}

__device__ __forceinline__ void diff_attn_item(const Params& p, const Grp& G, int item, char* lds, float lam, float shift) {
    const int tid = otid(), lane = tid & 63, wid = tid >> 6, fr = lane & 15, fq = lane >> 4;
    const int c = wid & 1, sub = wid >> 1;
    const int T = G.T, nqb = T / 128;
    const int qb = item % nqb, bh = item / nqb, h = bh & 7, b = bh >> 3;
    bf16_t* P = (bf16_t*)(p.ws + WS_PROJ) + (size_t)b * T * NP;
    const bf16_t* Kg = P + C_DK + h * 128;
    const bf16_t* VTg = (const bf16_t*)(p.ws + WS_VT) + (size_t)bh * 128 * T;
    const int q0 = qb * 128 + sub * 32;
    bf16x8 qf[2][2];
#pragma unroll
    for (int nt = 0; nt < 2; ++nt)
#pragma unroll
        for (int ks = 0; ks < 2; ++ks) qf[nt][ks] = *(const bf16x8*)(P + (size_t)(q0 + nt * 16 + fr) * NP + C_DQ + h * 128 + c * 64 + ks * 32 + fq * 8);
    f32x4 o[8][2];
#pragma unroll
    for (int i = 0; i < 8; ++i) { o[i][0] = (f32x4){0.f, 0.f, 0.f, 0.f}; o[i][1] = (f32x4){0.f, 0.f, 0.f, 0.f}; }
    float l[2] = {0.f, 0.f};
    constexpr int STG = 36864, VOFF = 18432;
    u32x4 rk[2], rv[2];
    const int krow = tid >> 4, kch = tid & 15;
    const int vrow = tid >> 3, vch = tid & 7;
#define AGLOAD(kt) do { const int key0_ = (kt) * 64; \
        _Pragma("unroll") for (int i = 0; i < 2; ++i) rk[i] = *(const u32x4*)(Kg + (size_t)(key0_ + krow + i * 32) * NP + kch * 8); \
        _Pragma("unroll") for (int i = 0; i < 2; ++i) rv[i] = *(const u32x4*)(VTg + (size_t)(vrow + i * 64) * T + key0_ + vch * 8); } while (0)
#define ASWRITE(buf) do { char* b_ = lds + (buf) * STG; \
        _Pragma("unroll") for (int i = 0; i < 2; ++i) *(u32x4*)(b_ + ((kch >> 3) * 64 + krow + i * 32) * 144 + (kch & 7) * 16) = rk[i]; \
        _Pragma("unroll") for (int i = 0; i < 2; ++i) *(u32x4*)(b_ + VOFF + (vrow + i * 64) * 144 + vch * 16) = rv[i]; } while (0)
    const int nkt = T / 64;
#define EXPQ(SRC, NT, DSTP) do { const f32x4 a_ = SRC[0][NT], b_ = SRC[1][NT]; \
        const float p0 = fexp2(a_.x), p1 = fexp2(a_.y), p2 = fexp2(a_.z), p3 = fexp2(a_.w); \
        const float p4 = fexp2(b_.x), p5 = fexp2(b_.y), p6 = fexp2(b_.z), p7 = fexp2(b_.w); \
        l[NT] += ((p0 + p1) + (p2 + p3)) + ((p4 + p5) + (p6 + p7)); \
        u32x4 w_; w_.x = pk2(p0, p1); w_.y = pk2(p2, p3); w_.z = pk2(p4, p5); w_.w = pk2(p6, p7); \
        DSTP[NT] = __builtin_bit_cast(bf16x8, w_); } while (0)
#define SMMA1(DST, I, MT, KBASE) do { \
        const bf16x8 k0_ = *(const bf16x8*)((KBASE) + (c * 64 + (MT) * 16 + fr) * 144 + fq * 16); \
        const bf16x8 k1_ = *(const bf16x8*)((KBASE) + (c * 64 + (MT) * 16 + fr) * 144 + 64 + fq * 16); \
        DST[I][0] = mfma16(k0_, qf[0][0], (f32x4){0.f, 0.f, 0.f, 0.f}); DST[I][1] = mfma16(k0_, qf[1][0], (f32x4){0.f, 0.f, 0.f, 0.f}); \
        DST[I][0] = mfma16(k1_, qf[0][1], DST[I][0]); DST[I][1] = mfma16(k1_, qf[1][1], DST[I][1]); } while (0)
#define PVMMA(DVT, KK, PF, VBASE) do { \
        const bf16x8 vf_ = *(const bf16x8*)((VBASE) + VOFF + ((DVT) * 16 + fr) * 144 + (KK) * 64 + fq * 16); \
        o[DVT][0] = mfma16(vf_, PF[0], o[DVT][0]); o[DVT][1] = mfma16(vf_, PF[1], o[DVT][1]); } while (0)
#define PV8(KK, PF, VBASE) do { PVMMA(0, KK, PF, VBASE); PVMMA(1, KK, PF, VBASE); PVMMA(2, KK, PF, VBASE); PVMMA(3, KK, PF, VBASE); \
        PVMMA(4, KK, PF, VBASE); PVMMA(5, KK, PF, VBASE); PVMMA(6, KK, PF, VBASE); PVMMA(7, KK, PF, VBASE); } while (0)
    f32x4 slo[2][2], shi[2][2];
    bf16x8 pflo[2], pfhi[2];
    pfhi[0] = (bf16x8){0, 0, 0, 0, 0, 0, 0, 0}; pfhi[1] = pfhi[0];
#define KLOAD(KR, MTA, MTB, KBASE) do { \
        KR[0] = *(const bf16x8*)((KBASE) + (c * 64 + (MTA) * 16 + fr) * 144 + fq * 16); KR[1] = *(const bf16x8*)((KBASE) + (c * 64 + (MTA) * 16 + fr) * 144 + 64 + fq * 16); \
        KR[2] = *(const bf16x8*)((KBASE) + (c * 64 + (MTB) * 16 + fr) * 144 + fq * 16); KR[3] = *(const bf16x8*)((KBASE) + (c * 64 + (MTB) * 16 + fr) * 144 + 64 + fq * 16); } while (0)
#define SMMAK(DST, KR) do { \
        DST[0][0] = mfma16(KR[0], qf[0][0], (f32x4){0.f, 0.f, 0.f, 0.f}); DST[0][1] = mfma16(KR[0], qf[1][0], (f32x4){0.f, 0.f, 0.f, 0.f}); \
        DST[1][0] = mfma16(KR[2], qf[0][0], (f32x4){0.f, 0.f, 0.f, 0.f}); DST[1][1] = mfma16(KR[2], qf[1][0], (f32x4){0.f, 0.f, 0.f, 0.f}); \
        DST[0][0] = mfma16(KR[1], qf[0][1], DST[0][0]); DST[0][1] = mfma16(KR[1], qf[1][1], DST[0][1]); \
        DST[1][0] = mfma16(KR[3], qf[0][1], DST[1][0]); DST[1][1] = mfma16(KR[3], qf[1][1], DST[1][1]); } while (0)
#define VLOAD4(VR, D0, KK, VBASE) do { _Pragma("unroll") for (int i_ = 0; i_ < 4; ++i_) VR[i_] = *(const bf16x8*)((VBASE) + VOFF + (((D0) + i_) * 16 + fr) * 144 + (KK) * 64 + fq * 16); } while (0)
#define PV4(VR, D0, PF) do { _Pragma("unroll") for (int i_ = 0; i_ < 4; ++i_) { o[(D0) + i_][0] = mfma16(VR[i_], PF[0], o[(D0) + i_][0]); o[(D0) + i_][1] = mfma16(VR[i_], PF[1], o[(D0) + i_][1]); } } while (0)
#define FENCE() __builtin_amdgcn_sched_barrier(0)
    AGLOAD(0); ASWRITE(0); AGLOAD(1); ASWRITE(1);
    for (int i = tid; i < 18432 / 16; i += NTHR) *(u32x4*)(lds + 3 * STG + VOFF + i * 16) = (u32x4){0u, 0u, 0u, 0u};
    __syncthreads();
    bf16x8 kr[4], va[4], vb[4];
    KLOAD(kr, 0, 1, lds); SMMAK(slo, kr);
    for (int kt = 0; kt < nkt; ++kt) {
        { const int ktl = kt + 2 < nkt ? kt + 2 : nkt - 1; AGLOAD(ktl); }
        const char* cur = lds + (kt & 3) * STG; const char* nxt = lds + ((kt + 1) & 3) * STG; const char* prv = lds + ((kt + 3) & 3) * STG;
        KLOAD(kr, 2, 3, cur); VLOAD4(va, 0, 1, prv);
        FENCE();
        SMMAK(shi, kr); VLOAD4(vb, 4, 1, prv); EXPQ(slo, 0, pflo);
        FENCE();
        PV4(va, 0, pfhi); KLOAD(kr, 0, 1, nxt); EXPQ(slo, 1, pflo);
        FENCE();
        PV4(vb, 4, pfhi); VLOAD4(va, 0, 0, cur);
        FENCE();
        SMMAK(slo, kr); VLOAD4(vb, 4, 0, cur); EXPQ(shi, 0, pfhi);
        FENCE();
        PV4(va, 0, pflo); EXPQ(shi, 1, pfhi);
        FENCE();
        PV4(vb, 4, pflo);
        FENCE();
        ASWRITE((kt + 2) & 3);
        __syncthreads();
    }
    { const char* prv = lds + ((nkt - 1) & 3) * STG; VLOAD4(va, 0, 1, prv); VLOAD4(vb, 4, 1, prv); PV4(va, 0, pfhi); PV4(vb, 4, pfhi); }
    __syncthreads();
#undef KLOAD
#undef SMMAK
#undef VLOAD4
#undef PV4
#undef FENCE
#undef EXPQ
#undef SMMA1
#undef PVMMA
#undef PV8
#undef AGLOAD
#undef ASWRITE
    float inv[2];
#pragma unroll
    for (int nt = 0; nt < 2; ++nt) { float v = l[nt]; v += sxor<16>(v); v += sxor<32>(v); inv[nt] = 1.0f / v; }
    float* xch = (float*)lds + sub * 4096;
    if (c == 1) {
#pragma unroll
        for (int dvt = 0; dvt < 8; ++dvt)
#pragma unroll
            for (int nt = 0; nt < 2; ++nt) {
                xch[(dvt * 16 + fq * 4 + 0) * 32 + nt * 16 + fr] = o[dvt][nt].x * inv[nt];
                xch[(dvt * 16 + fq * 4 + 1) * 32 + nt * 16 + fr] = o[dvt][nt].y * inv[nt];
                xch[(dvt * 16 + fq * 4 + 2) * 32 + nt * 16 + fr] = o[dvt][nt].z * inv[nt];
                xch[(dvt * 16 + fq * 4 + 3) * 32 + nt * 16 + fr] = o[dvt][nt].w * inv[nt];
            }
    }
    __syncthreads();
    if (c == 0) {
        float ss[2] = {0.f, 0.f};
#pragma unroll
        for (int dvt = 0; dvt < 8; ++dvt)
#pragma unroll
            for (int nt = 0; nt < 2; ++nt) {
                f32x4 v = o[dvt][nt] * inv[nt];
                v.x -= lam * xch[(dvt * 16 + fq * 4 + 0) * 32 + nt * 16 + fr];
                v.y -= lam * xch[(dvt * 16 + fq * 4 + 1) * 32 + nt * 16 + fr];
                v.z -= lam * xch[(dvt * 16 + fq * 4 + 2) * 32 + nt * 16 + fr];
                v.w -= lam * xch[(dvt * 16 + fq * 4 + 3) * 32 + nt * 16 + fr];
                o[dvt][nt] = v; ss[nt] += v.x * v.x + v.y * v.y + v.z * v.z + v.w * v.w;
            }
#pragma unroll
        for (int nt = 0; nt < 2; ++nt) {
            float v = ss[nt]; v += sxor<16>(v); v += sxor<32>(v);
            const float r = rsqrtf(v * (1.f / 128.f) + RMS_EPS) * 0.8f;
#pragma unroll
            for (int dvt = 0; dvt < 8; ++dvt) {
                const f32x4 gs = *(const f32x4*)(p.in[I_DGSUB] + dvt * 16 + fq * 4);
                const f32x4 v4 = o[dvt][nt];
                u32x2 w; w.x = pk2(v4.x * r * gs.x, v4.y * r * gs.y); w.y = pk2(v4.z * r * gs.z, v4.w * r * gs.w);
                *(u32x2*)(P + (size_t)(q0 + nt * 16 + fr) * NP + C_DQ + h * 128 + dvt * 16 + fq * 4) = w;
            }
        }
    }
    __syncthreads();
}

__device__ __forceinline__ void mem_attn_item(const Params& p, const Grp& G, int item, char* lds, float shift) {
    const int tid = otid(), lane = tid & 63, wid = tid >> 6, fr = lane & 15, fq = lane >> 4;
    const int T = G.T, nqb = T / 128;
    const int qb = item % nqb, bh = item / nqb, h = bh & 3, b = bh >> 2;
    bf16_t* P = (bf16_t*)(p.ws + WS_PROJ) + (size_t)b * T * NP;
    const bf16_t* MK = (const bf16_t*)(p.ws + WS_MEMK) + (size_t)((G.mb0 + b) * 4 + h) * 256 * 256;
    const bf16_t* MV = (const bf16_t*)(p.ws + WS_MEMV) + (size_t)((G.mb0 + b) * 4 + h) * 256 * 256;
    const int row = qb * 128 + wid * 16 + fr;
    bf16_t* qp = P + (size_t)row * NP + C_MQ + h * 256;
    bf16x8 qf[8];
    {
        float ss = 0.f; u32x4 raw[8];
#pragma unroll
        for (int ks = 0; ks < 8; ++ks) { raw[ks] = *(const u32x4*)(qp + ks * 32 + fq * 8);
            const float a0 = bflo(raw[ks].x), a1 = bfhi(raw[ks].x), a2 = bflo(raw[ks].y), a3 = bfhi(raw[ks].y), a4 = bflo(raw[ks].z), a5 = bfhi(raw[ks].z), a6 = bflo(raw[ks].w), a7 = bfhi(raw[ks].w);
            ss += a0 * a0 + a1 * a1 + a2 * a2 + a3 * a3 + a4 * a4 + a5 * a5 + a6 * a6 + a7 * a7; }
        ss += sxor<16>(ss); ss += sxor<32>(ss);
        const float r = rsqrtf(ss * (1.f / 256.f) + RMS_EPS) * (0.0625f * LOG2E);
#pragma unroll
        for (int ks = 0; ks < 8; ++ks) {
            const f32x4 g0 = *(const f32x4*)(p.in[I_MGQ] + ks * 32 + fq * 8), g1 = *(const f32x4*)(p.in[I_MGQ] + ks * 32 + fq * 8 + 4);
            u32x4 w;
            w.x = pk2(bflo(raw[ks].x) * r * g0.x, bfhi(raw[ks].x) * r * g0.y); w.y = pk2(bflo(raw[ks].y) * r * g0.z, bfhi(raw[ks].y) * r * g0.w);
            w.z = pk2(bflo(raw[ks].z) * r * g1.x, bfhi(raw[ks].z) * r * g1.y); w.w = pk2(bflo(raw[ks].w) * r * g1.z, bfhi(raw[ks].w) * r * g1.w);
            qf[ks] = __builtin_bit_cast(bf16x8, w);
        }
    }
    f32x4 o[16];
#pragma unroll
    for (int i = 0; i < 16; ++i) o[i] = (f32x4){0.f, 0.f, 0.f, 0.f};
    float l = 0.f;
    constexpr int KROW = 528, VOFF = 64 * 528;
    u32x4 mk[4], mv[4];
#define MLOAD(KT) do { _Pragma("unroll") for (int i = 0; i < 4; ++i) { const int idx = tid + i * 512; \
        mk[i] = *(const u32x4*)(MK + (size_t)((KT) * 64 + (idx >> 5)) * 256 + (idx & 31) * 8); mv[i] = *(const u32x4*)(MV + (size_t)(idx >> 3) * 256 + (KT) * 64 + (idx & 7) * 8); } } while (0)
    MLOAD(0);
    for (int kt = 0; kt < 4; ++kt) {
#pragma unroll
        for (int i = 0; i < 4; ++i) {
            const int idx = tid + i * 512;
            *(u32x4*)(lds + (idx >> 5) * KROW + (idx & 31) * 16) = mk[i];
            *(u32x4*)(lds + VOFF + (idx >> 3) * 144 + (idx & 7) * 16) = mv[i];
        }
        __syncthreads();
        if (kt + 1 < 4) MLOAD(kt + 1);
        __builtin_amdgcn_sched_barrier(0);
        f32x4 s[4];
#pragma unroll
        for (int mt = 0; mt < 4; ++mt) s[mt] = (f32x4){0.f, 0.f, 0.f, 0.f};
#pragma unroll
        for (int ks = 0; ks < 8; ks += 2) {
            bf16x8 kf[8];
#pragma unroll
            for (int u = 0; u < 8; ++u) kf[u] = *(const bf16x8*)(lds + ((u & 3) * 16 + fr) * KROW + (ks + (u >> 2)) * 64 + fq * 16);
            __builtin_amdgcn_sched_barrier(0);
#pragma unroll
            for (int u = 0; u < 8; ++u) s[u & 3] = mfma16(kf[u], qf[ks + (u >> 2)], s[u & 3]);
        }
        bf16x8 pf[2];
#pragma unroll
        for (int kk = 0; kk < 2; ++kk) {
            const f32x4 a = s[2 * kk], bb = s[2 * kk + 1];
            const float p0 = fexp2(a.x), p1 = fexp2(a.y), p2 = fexp2(a.z), p3 = fexp2(a.w);
            const float p4 = fexp2(bb.x), p5 = fexp2(bb.y), p6 = fexp2(bb.z), p7 = fexp2(bb.w);
            l += ((p0 + p1) + (p2 + p3)) + ((p4 + p5) + (p6 + p7));
            u32x4 w; w.x = pk2(p0, p1); w.y = pk2(p2, p3); w.z = pk2(p4, p5); w.w = pk2(p6, p7);
            pf[kk] = __builtin_bit_cast(bf16x8, w);
        }
#pragma unroll
        for (int kk = 0; kk < 2; ++kk)
#pragma unroll
            for (int d0 = 0; d0 < 16; d0 += 8) {
                bf16x8 vf[8];
#pragma unroll
                for (int u = 0; u < 8; ++u) vf[u] = *(const bf16x8*)(lds + VOFF + ((d0 + u) * 16 + fr) * 144 + kk * 64 + fq * 16);
                __builtin_amdgcn_sched_barrier(0);
#pragma unroll
                for (int u = 0; u < 8; ++u) o[d0 + u] = mfma16(vf[u], pf[kk], o[d0 + u]);
            }
        __syncthreads();
    }
#undef MLOAD
    l += sxor<16>(l); l += sxor<32>(l);
    const float inv = 1.0f / l;
#pragma unroll
    for (int dvt = 0; dvt < 16; ++dvt) {
        u32x2 w; w.x = pk2(o[dvt].x * inv, o[dvt].y * inv); w.y = pk2(o[dvt].z * inv, o[dvt].w * inv);
        *(u32x2*)(qp + dvt * 16 + fq * 4) = w;
    }
}

constexpr int L_QE = 0, L_KE = 17408, L_KST = 34816, L_VTL = 53248, L_ATT = 71680, L_SB = 80896, L_LRF = 115712, L_TOT = 119808, L_GDEC = 121856;
__device__ __forceinline__ void gla_item(const Params& p, const Grp& G, int item, char* lds) {
    const int tid = otid(), lane = tid & 63, wid = tid >> 6, fr = lane & 15, fq = lane >> 4;
    const int slice = item & 1, dir = (item >> 1) & 1, h = (item >> 2) & 3, b = item >> 4;
    const int T = G.T, N = T / 64;
    const bf16_t* P = (const bf16_t*)(p.ws + WS_PROJ) + (size_t)b * T * NP;
    bf16_t* OUT = dir ? (bf16_t*)(p.ws + WS_PROJ) + (size_t)b * T * NP + C_DV + h * 256 + slice * 128
                      : (bf16_t*)(p.ws + WS_HB) + (size_t)b * T * D + h * 256 + slice * 128;
    const int ldo = dir ? NP : D;
    const int amt = wid & 3, antg = wid >> 2;
    bf16x8 wdB[4]; float bd4[4];
    {
        const float* wd = p.in[dir ? I_WDB : I_WDF]; const float* bdp = p.in[dir ? I_BDB : I_BDF];
#pragma unroll
        for (int q = 0; q < 4; ++q) {
            const int col = h * 128 + (antg * 4 + q) * 16 + fr;
            u32x4 w = (u32x4){0u, 0u, 0u, 0u};
            if (fq < 2) { const float* wp = wd + (size_t)(fq * 8) * 512 + col;
                w.x = pk2(wp[0], wp[512]); w.y = pk2(wp[1024], wp[1536]); w.z = pk2(wp[2048], wp[2560]); w.w = pk2(wp[3072], wp[3584]); }
            wdB[q] = __builtin_bit_cast(bf16x8, w);
            bd4[q] = bdp[col];
        }
    }
    { unsigned z = 0u; asm volatile("" : "+v"(z)); for (int i = tid; i < 34816 / 16; i += NTHR) *(u32x4*)(lds + L_SB + i * 16) = (u32x4){z, z, z, z}; }
    f32x4 S[8];
#pragma unroll
    for (int i = 0; i < 8; ++i) S[i] = (f32x4){0.f, 0.f, 0.f, 0.f};
    u32x4 rq[2], rk[2], rv[2], rl;
    const int lrow = tid >> 4, lch = tid & 15;
#define GGLOAD(n) do { const int cb_ = (dir ? (N - 1 - (n)) : (n)) * 64; \
        _Pragma("unroll") for (int i = 0; i < 2; ++i) { const int li_ = lrow + i * 32, tk_ = cb_ + (dir ? 63 - li_ : li_); const bf16_t* rp_ = P + (size_t)tk_ * NP; \
            rq[i] = *(const u32x4*)(rp_ + C_GQ + h * 128 + lch * 8); rk[i] = *(const u32x4*)(rp_ + C_GK + h * 128 + lch * 8); rv[i] = *(const u32x4*)(rp_ + C_GV + h * 256 + slice * 128 + lch * 8); } \
        if (tid < 128) { const int li_ = tid >> 1, tk_ = cb_ + (dir ? 63 - li_ : li_); rl = *(const u32x4*)(P + (size_t)tk_ * NP + C_LR + dir * 16 + (tid & 1) * 8); } } while (0)
    GGLOAD(0);
    for (int n = 0; n < N; ++n) {
#pragma unroll
        for (int i = 0; i < 2; ++i) {
            const int li = lrow + i * 32;
            *(u32x4*)(lds + L_QE + li * 272 + lch * 16) = rq[i];
            *(u32x4*)(lds + L_KE + li * 272 + lch * 16) = rk[i];
            bf16_t* vt = (bf16_t*)(lds + L_VTL) + (lch * 8) * 72 + li;
            vt[0 * 72] = (bf16_t)(rv[i].x & 0xffff); vt[1 * 72] = (bf16_t)(rv[i].x >> 16); vt[2 * 72] = (bf16_t)(rv[i].y & 0xffff); vt[3 * 72] = (bf16_t)(rv[i].y >> 16);
            vt[4 * 72] = (bf16_t)(rv[i].z & 0xffff); vt[5 * 72] = (bf16_t)(rv[i].z >> 16); vt[6 * 72] = (bf16_t)(rv[i].w & 0xffff); vt[7 * 72] = (bf16_t)(rv[i].w >> 16);
        }
        if (tid < 128) *(u32x4*)(lds + L_LRF + (tid >> 1) * 32 + (tid & 1) * 16) = rl;
        if (n + 1 < N) GGLOAD(n + 1);
        __syncthreads();
        {
            u32x4 araw = (u32x4){0u, 0u, 0u, 0u};
            if (fq < 2) araw = *(const u32x4*)(lds + L_LRF + (amt * 16 + fr) * 32 + fq * 16);
            const bf16x8 afr = __builtin_bit_cast(bf16x8, araw);
            float pb[4][4]; float E[4], tt[4];
#pragma unroll
            for (int q = 0; q < 4; ++q) {
                const f32x4 x4 = mfma16(afr, wdB[q], (f32x4){bd4[q], bd4[q], bd4[q], bd4[q]});
                float run = 0.f;
#pragma unroll
                for (int j = 0; j < 4; ++j) {
                    const float x = x4[j];
                    const float ls = fminf(x, 0.f) - __logf(1.0f + __expf(-fabsf(x)));
                    run += ls * 0.0625f; pb[q][j] = run;
                }
                const float u = sxor<16>(run), v = run + u, w2 = sxor<32>(v);
                E[q] = ((fq & 1) ? u : 0.f) + ((fq & 2) ? w2 : 0.f);
                tt[q] = v + w2;
                if (fq == 0) ((float*)(lds + L_TOT))[amt * 128 + (antg * 4 + q) * 16 + fr] = tt[q];
            }
            __syncthreads();
#pragma unroll
            for (int q = 0; q < 4; ++q) {
                const int col = (antg * 4 + q) * 16 + fr;
                float off = 0.f, blast = 0.f;
#pragma unroll
                for (int r = 0; r < 4; ++r) { const float tv = ((const float*)(lds + L_TOT))[r * 128 + col]; blast += tv; if (r < amt) off += tv; }
                const float gcol = __expf(blast);
                bf16_t* qe = (bf16_t*)(lds + L_QE) + (amt * 16 + fq * 4) * 136 + col; bf16_t* ke = (bf16_t*)(lds + L_KE) + (amt * 16 + fq * 4) * 136 + col;
                float ksv[4];
#pragma unroll
                for (int j = 0; j < 4; ++j) {
                    const float bb = off + E[q] + pb[q][j];
                    const float qv = bf2f(qe[j * 136]), kv = bf2f(ke[j * 136]);
                    const float kd = kv * __expf(-bb);
                    qe[j * 136] = f2bf(qv * __expf(bb)); ke[j * 136] = f2bf(kd);
                    ksv[j] = kd * gcol;
                }
                *(u32x2*)(lds + L_KST + col * 144 + (amt * 16 + fq * 4) * 2) = (u32x2){pk2(ksv[0], ksv[1]), pk2(ksv[2], ksv[3])};
                if (amt == 0 && fq == 0) ((float*)(lds + L_GDEC))[col] = gcol;
            }
        }
        __syncthreads();
        {
            const int ct = wid & 3;
            f32x4 a[2] = {(f32x4){0.f, 0.f, 0.f, 0.f}, (f32x4){0.f, 0.f, 0.f, 0.f}};
            bf16x8 qv[4], kv[2][4];
#pragma unroll
            for (int ks = 0; ks < 4; ++ks) {
                qv[ks] = *(const bf16x8*)(lds + L_QE + (ct * 16 + fr) * 272 + ks * 64 + fq * 16);
#pragma unroll
                for (int j = 0; j < 2; ++j) kv[j][ks] = *(const bf16x8*)(lds + L_KE + (((wid >> 2) * 2 + j) * 16 + fr) * 272 + ks * 64 + fq * 16);
            }
            __builtin_amdgcn_sched_barrier(0);
#pragma unroll
            for (int ks = 0; ks < 4; ++ks)
#pragma unroll
                for (int j = 0; j < 2; ++j) a[j] = mfma16(kv[j][ks], qv[ks], a[j]);
#pragma unroll
            for (int j = 0; j < 2; ++j) {
                const int st = (wid >> 2) * 2 + j, cc = ct * 16 + fr, s0 = st * 16 + fq * 4;
                const float v0 = (s0 + 0 <= cc) ? a[j].x : 0.f, v1 = (s0 + 1 <= cc) ? a[j].y : 0.f, v2 = (s0 + 2 <= cc) ? a[j].z : 0.f, v3 = (s0 + 3 <= cc) ? a[j].w : 0.f;
                *(u32x2*)(lds + L_ATT + cc * 144 + s0 * 2) = (u32x2){pk2(v0, v1), pk2(v2, v3)};
            }
        }
        __syncthreads();
        {
            f32x4 oc[4] = {(f32x4){0.f, 0.f, 0.f, 0.f}, (f32x4){0.f, 0.f, 0.f, 0.f}, (f32x4){0.f, 0.f, 0.f, 0.f}, (f32x4){0.f, 0.f, 0.f, 0.f}};
            bf16x8 fa[2], fb[2][4], ga[2], gb[2][4];
#define LD_VA(FA, FB) do { _Pragma("unroll") for (int ks = 0; ks < 2; ++ks) { FA[ks] = *(const bf16x8*)(lds + L_VTL + (wid * 16 + fr) * 144 + ks * 64 + fq * 16); \
                _Pragma("unroll") for (int ct = 0; ct < 4; ++ct) FB[ks][ct] = *(const bf16x8*)(lds + L_ATT + (ct * 16 + fr) * 144 + ks * 64 + fq * 16); } } while (0)
#define LD_SQ(FA, FB, K0) do { _Pragma("unroll") for (int ks = 0; ks < 2; ++ks) { FA[ks] = *(const bf16x8*)(lds + L_SB + (wid * 16 + fr) * 272 + ((K0) + ks) * 64 + fq * 16); \
                _Pragma("unroll") for (int ct = 0; ct < 4; ++ct) FB[ks][ct] = *(const bf16x8*)(lds + L_QE + (ct * 16 + fr) * 272 + ((K0) + ks) * 64 + fq * 16); } } while (0)
#define MM10(FA, FB) do { _Pragma("unroll") for (int ks = 0; ks < 2; ++ks) _Pragma("unroll") for (int ct = 0; ct < 4; ++ct) oc[ct] = mfma16(FA[ks], FB[ks][ct], oc[ct]); } while (0)
            LD_VA(fa, fb); LD_SQ(ga, gb, 0);
            __builtin_amdgcn_sched_barrier(0);
            MM10(fa, fb); LD_SQ(fa, fb, 2);
            __builtin_amdgcn_sched_barrier(0);
            MM10(ga, gb);
            __builtin_amdgcn_sched_barrier(0);
            MM10(fa, fb);
#undef LD_VA
#undef LD_SQ
#undef MM10
            const int cb = (dir ? (N - 1 - n) : n) * 64;
#pragma unroll
            for (int ct = 0; ct < 4; ++ct) {
                const int cl = ct * 16 + fr, tk = cb + (dir ? 63 - cl : cl);
                *(u32x2*)(OUT + (size_t)tk * ldo + wid * 16 + fq * 4) = (u32x2){pk2(oc[ct].x, oc[ct].y), pk2(oc[ct].z, oc[ct].w)};
            }
        }
        __syncthreads();
        {
            const f32x4 gd = *(const f32x4*)((const float*)(lds + L_GDEC) + wid * 16 + fq * 4);
#pragma unroll
            for (int et = 0; et < 8; ++et) S[et] = S[et] * gd;
            bf16x8 da[2], db[2][8];
#pragma unroll
            for (int ks = 0; ks < 2; ++ks) {
                da[ks] = *(const bf16x8*)(lds + L_KST + (wid * 16 + fr) * 144 + ks * 64 + fq * 16);
#pragma unroll
                for (int et = 0; et < 8; ++et) db[ks][et] = *(const bf16x8*)(lds + L_VTL + (et * 16 + fr) * 144 + ks * 64 + fq * 16);
            }
            __builtin_amdgcn_sched_barrier(0);
#pragma unroll
            for (int ks = 0; ks < 2; ++ks)
#pragma unroll
                for (int et = 0; et < 8; ++et) S[et] = mfma16(da[ks], db[ks][et], S[et]);
#pragma unroll
            for (int et = 0; et < 8; ++et)
                *(u32x2*)(lds + L_SB + (et * 16 + fr) * 272 + (wid * 16 + fq * 4) * 2) = (u32x2){pk2(S[et].x, S[et].y), pk2(S[et].z, S[et].w)};
        }
        __syncthreads();
    }
#undef GGLOAD
}

__device__ __forceinline__ void phase_mixer(const Params& p, int g, char* lds, int* s_item) {
    const Grp G = get_group(p, g);
    const int nGLA = G.B * 16, nATT = G.B * 8 * (G.T / 128), nMEM = G.B * 4 * (G.T / 128);
    unsigned* ctr = (unsigned*)(p.ws + WS_CTRL) + g * 4;
    for (;;) {
        if (threadIdx.x == 0) *s_item = (int)atomicAdd(ctr + 0, 1u);
        __syncthreads();
        const int it = *s_item;
        __syncthreads();
        if (it >= nGLA) break;
        gla_item(p, G, it, lds);
    }
    {
        float d1 = 0.f, d2 = 0.f;
        for (int i = 0; i < 64; ++i) { d1 += p.in[I_LQ1][i] * p.in[I_LK1][i]; d2 += p.in[I_LQ2][i] * p.in[I_LK2][i]; }
        const float lam = expf(d1) - expf(d2) + 0.2f;
        for (;;) {
            if (threadIdx.x == 0) *s_item = (int)atomicAdd(ctr + 1, 1u);
            __syncthreads();
            const int it = *s_item;
            __syncthreads();
            if (it >= nATT) break;
            diff_attn_item(p, G, it, lds, lam, 0.f);
        }
    }
    for (;;) {
        if (threadIdx.x == 0) *s_item = (int)atomicAdd(ctr + 2, 1u);
        __syncthreads();
        const int it = *s_item;
        __syncthreads();
        if (it >= nMEM) break;
        mem_attn_item(p, G, it, lds, 0.f);
    }
}

__device__ __forceinline__ void phase_glafin(const Params& p, int g, int tok0, int ntok) {
    const int tid_ = otid(), lane = tid_ & 63, wid = tid_ >> 6;
    bf16_t* P = (bf16_t*)(p.ws + WS_PROJ); const bf16_t* F = (const bf16_t*)(p.ws + WS_HB);
    unsigned qq, kk; u32x2 f, bk, v, gt;
#define GFLOAD(IT) do { const int tok_ = (IT) >> 2, h_ = (IT) & 3; const bf16_t* row_ = P + (size_t)tok_ * NP; \
        qq = *(const unsigned*)(row_ + C_GQ + h_ * 128 + lane * 2); kk = *(const unsigned*)(row_ + C_GK + h_ * 128 + lane * 2); \
        f = *(const u32x2*)(F + (size_t)tok_ * D + h_ * 256 + lane * 4); bk = *(const u32x2*)(row_ + C_DV + h_ * 256 + lane * 4); \
        v = *(const u32x2*)(row_ + C_GV + h_ * 256 + lane * 4); gt = *(const u32x2*)(row_ + C_GG + h_ * 256 + lane * 4); } while (0)
    const f32x4 go = *(const f32x4*)(launder(p.in[I_GOUT]) + lane * 4);
    GFLOAD(tok0 * 4 + wid);
    for (int it = tok0 * 4 + wid; it < (tok0 + ntok) * 4; it += 8) {
        const int tok = it >> 2, h = it & 3;
        bf16_t* row = P + (size_t)tok * NP;
        const unsigned cq = qq, ck = kk; const u32x2 cf = f, cbk = bk, cv = v, cgt = gt;
        if (it + 8 < (tok0 + ntok) * 4) GFLOAD(it + 8);
        __builtin_amdgcn_sched_barrier(0);
        const float qk = wave_sum(bflo(cq) * bflo(ck) + bfhi(cq) * bfhi(ck));
        float o0 = bflo(cf.x) + bflo(cbk.x) - qk * bflo(cv.x), o1 = bfhi(cf.x) + bfhi(cbk.x) - qk * bfhi(cv.x);
        float o2 = bflo(cf.y) + bflo(cbk.y) - qk * bflo(cv.y), o3 = bfhi(cf.y) + bfhi(cbk.y) - qk * bfhi(cv.y);
        const float r = rsqrtf(wave_sum(o0 * o0 + o1 * o1 + o2 * o2 + o3 * o3) * (1.f / 256.f) + RMS_EPS);
        const float g0 = bflo(cgt.x), g1 = bfhi(cgt.x), g2 = bflo(cgt.y), g3 = bfhi(cgt.y);
        o0 *= r * go.x * g0 * __builtin_amdgcn_rcpf(1.f + __expf(-g0)); o1 *= r * go.y * g1 * __builtin_amdgcn_rcpf(1.f + __expf(-g1));
        o2 *= r * go.z * g2 * __builtin_amdgcn_rcpf(1.f + __expf(-g2)); o3 *= r * go.w * g3 * __builtin_amdgcn_rcpf(1.f + __expf(-g3));
        *(u32x2*)(row + C_GG + h * 256 + lane * 4) = (u32x2){pk2(o0, o1), pk2(o2, o3)};
    }
#undef GFLOAD
}

__device__ __forceinline__ void phase_merge(const Params& p, int g, char* lds, int u) {
    const int tid_ = otid(), lane = tid_ & 63, wid = tid_ >> 6, wm = wid >> 2, wn = wid & 3, fr = lane & 15, fq = lane >> 4;
    const bf16_t* P = (const bf16_t*)(p.ws + WS_PROJ); bf16_t* M = (bf16_t*)(p.ws + WS_VT);
    for (int pn = 0; pn < 4; ++pn) {
        const int m0 = u * 128, n0 = pn * 256;
        f32x4 macc[4][4];
#pragma unroll
        for (int i = 0; i < 4; ++i)
#pragma unroll
            for (int j = 0; j < 4; ++j) macc[i][j] = (f32x4){0.f, 0.f, 0.f, 0.f};
        for (int br = 0; br < 3; ++br) {
            f32x4 acc[4][4];
#pragma unroll
            for (int i = 0; i < 4; ++i)
#pragma unroll
                for (int j = 0; j < 4; ++j) acc[i][j] = (f32x4){0.f, 0.f, 0.f, 0.f};
            const int acol = br == 0 ? C_GG : (br == 1 ? C_DQ : C_MQ);
            gemm_kloop<true, 4>(acc, P + (size_t)m0 * NP + acol, NP, (const bf16_t*)(p.ws + WS_WOT) + (size_t)br * D * D + (size_t)n0 * D, D, D, lds);
#pragma unroll
            for (int mt = 0; mt < 4; ++mt)
#pragma unroll
                for (int nt = 0; nt < 4; ++nt) {
                    const int row = m0 + wm * 64 + mt * 16 + fr, col = n0 + wn * 64 + nt * 16 + fq * 4;
                    const u32x2 gt = *(const u32x2*)(P + (size_t)row * NP + C_BG + br * 1024 + col);
                    f32x4 sg; sg.x = __builtin_amdgcn_rcpf(1.f + __expf(-bflo(gt.x))); sg.y = __builtin_amdgcn_rcpf(1.f + __expf(-bfhi(gt.x))); sg.z = __builtin_amdgcn_rcpf(1.f + __expf(-bflo(gt.y))); sg.w = __builtin_amdgcn_rcpf(1.f + __expf(-bfhi(gt.y)));
                    macc[mt][nt] += sg * acc[mt][nt];
                }
        }
#pragma unroll
        for (int mt = 0; mt < 4; ++mt)
#pragma unroll
            for (int nt = 0; nt < 4; ++nt) {
                const int row = m0 + wm * 64 + mt * 16 + fr, col = n0 + wn * 64 + nt * 16 + fq * 4;
                *(u32x2*)(M + (size_t)row * D + col) = (u32x2){pk2(macc[mt][nt].x, macc[mt][nt].y), pk2(macc[mt][nt].z, macc[mt][nt].w)};
            }
    }
}

__device__ __forceinline__ void phase_outproj(const Params& p, int g, char* lds, int u) {
    const Grp G = get_group(p, g);
    const int tid_ = otid(), lane = tid_ & 63, wid = tid_ >> 6, wm = wid >> 2, wn = wid & 3, fr = lane & 15, fq = lane >> 4;
    const bf16_t* M = (const bf16_t*)(p.ws + WS_VT); const bf16_t* W = (const bf16_t*)(p.ws + WS_WOT) + (size_t)3 * D * D;
    for (int pn = 0; pn < 4; ++pn) {
        const int m0 = u * 128, n0 = pn * 256;
        f32x4 acc[4][4];
#pragma unroll
        for (int i = 0; i < 4; ++i)
#pragma unroll
            for (int j = 0; j < 4; ++j) acc[i][j] = (f32x4){0.f, 0.f, 0.f, 0.f};
        gemm_kloop<true, 4>(acc, M + (size_t)m0 * D, D, W + (size_t)n0 * D, D, D, lds);
#pragma unroll
        for (int mt = 0; mt < 4; ++mt)
#pragma unroll
            for (int nt = 0; nt < 4; ++nt) {
                const int row = m0 + wm * 64 + mt * 16 + fr, col = n0 + wn * 64 + nt * 16 + fq * 4;
                const f32x4 xv = *(const f32x4*)(G.x + (size_t)row * D + col);
                *(f32x4*)(G.out + (size_t)row * D + col) = xv + acc[mt][nt];
            }
    }
}

__device__ __forceinline__ void phase_peerq(const Params& p, int g, char* lds, int u) {
    const int tid_ = otid(), lane = tid_ & 63, wid = tid_ >> 6, wm = wid >> 2, wn = wid & 3, fr = lane & 15, fq = lane >> 4;
    const bf16_t* A = (const bf16_t*)(p.ws + WS_HB); const bf16_t* W = (const bf16_t*)(p.ws + WS_WQT); bf16_t* P = (bf16_t*)(p.ws + WS_PROJ);
    for (int pn = 0; pn < 8; ++pn) {
        const int m0 = u * 128, n0 = pn * 256;
        f32x4 acc[4][4];
#pragma unroll
        for (int i = 0; i < 4; ++i)
#pragma unroll
            for (int j = 0; j < 4; ++j) acc[i][j] = (f32x4){0.f, 0.f, 0.f, 0.f};
        gemm_kloop<true, 4>(acc, A + (size_t)m0 * D, D, W + (size_t)n0 * D, D, D, lds);
#pragma unroll
        for (int mt = 0; mt < 4; ++mt)
#pragma unroll
            for (int nt = 0; nt < 4; ++nt) {
                const int row = m0 + wm * 64 + mt * 16 + fr, col = n0 + wn * 64 + nt * 16 + fq * 4;
                *(u32x2*)(P + (size_t)row * NP + col) = (u32x2){pk2(acc[mt][nt].x, acc[mt][nt].y), pk2(acc[mt][nt].z, acc[mt][nt].w)};
            }
    }
}

__device__ __forceinline__ unsigned f2ord(float f) { const unsigned u = __float_as_uint(f); return (u & 0x80000000u) ? ~u : (u | 0x80000000u); }
__device__ __forceinline__ float ord2f(unsigned k) { const unsigned u = (k & 0x80000000u) ? (k & 0x7fffffffu) : ~k; return __uint_as_float(u); }
__device__ __forceinline__ unsigned gmax16(unsigned v) {
    unsigned t;
    t = sxoru<1>(v); v = v > t ? v : t; t = sxoru<2>(v); v = v > t ? v : t; t = sxoru<4>(v); v = v > t ? v : t; t = sxoru<8>(v); v = v > t ? v : t;
    return v;
}
__device__ __forceinline__ float gsum16(float v) { v += sxor<1>(v); v += sxor<2>(v); v += sxor<4>(v); v += sxor<8>(v); return v; }
__device__ __forceinline__ float gelu_exact(float v) {
    const float av = fabsf(v), t = __builtin_amdgcn_rcpf(av * 0.2316418882f + 1.0f);
    float q = t * 0.5307027145f + (-0.7265760135f); q = q * t + 0.7107068705f; q = q * t + (-0.142248368f); q = q * t + 0.127414796f; q = q * t;
    const float e = __builtin_amdgcn_exp2f(v * v * (-0.72134752044f));
    const float m = v * (q * e);
    return v < 0.f ? m : v - m;
}

__device__ __forceinline__ void phase_peer(const Params& p, int g, char* lds, int tile0, int ntile) {
    const Grp G = get_group(p, g);
    const int tid = otid(), lane = tid & 63, wid = tid >> 6, fr = lane & 15, fq = lane >> 4;
    const bf16_t* P = (const bf16_t*)(p.ws + WS_PROJ); const bf16_t* HB = (const bf16_t*)(p.ws + WS_HB);
    const bf16_t* K12 = (const bf16_t*)(p.ws + WS_K12);
    float* SC = (float*)lds;
    int* EIDX = (int*)(lds + 65536);
    float* GATE = (float*)(lds + 65536 + 4096);
    char* KL = lds + 73728;
    for (int i = tid; i < 2 * 128 * 16; i += NTHR) {
        const int r = i >> 4, ch = i & 15;
        *(u32x4*)(KL + r * 272 + ch * 16) = *(const u32x4*)(K12 + (size_t)r * 128 + ch * 8);
    }
    __syncthreads();
    for (int tile = tile0; tile < tile0 + ntile; ++tile) {
        const int tok0 = tile * 8;
        {
            const bf16_t* qtok = P + (size_t)(tok0 + wid) * NP + (fr & 7) * 256;
#pragma unroll
            for (int half = 0; half < 2; ++half) {
                f32x4 acc[8];
#pragma unroll
                for (int i = 0; i < 8; ++i) acc[i] = (f32x4){0.f, 0.f, 0.f, 0.f};
                bf16x8 af[4], kfa[8], kfb[8];
#pragma unroll
                for (int ks = 0; ks < 4; ++ks) af[ks] = *(const bf16x8*)(qtok + half * 128 + ks * 32 + fq * 8);
#define KFLOAD(BUF, KS) do { _Pragma("unroll") for (int nt = 0; nt < 8; ++nt) BUF[nt] = *(const bf16x8*)(KL + (half * 128 + nt * 16 + fr) * 272 + (KS) * 64 + fq * 16); } while (0)
#define KFMMA(BUF, KS) do { _Pragma("unroll") for (int nt = 0; nt < 8; ++nt) acc[nt] = mfma16(af[KS], BUF[nt], acc[nt]); } while (0)
                KFLOAD(kfa, 0);
                __builtin_amdgcn_sched_barrier(0);
                KFLOAD(kfb, 1); KFMMA(kfa, 0);
                __builtin_amdgcn_sched_barrier(0);
                KFLOAD(kfa, 2); KFMMA(kfb, 1);
                __builtin_amdgcn_sched_barrier(0);
                KFLOAD(kfb, 3); KFMMA(kfa, 2);
                __builtin_amdgcn_sched_barrier(0);
                KFMMA(kfb, 3);
#undef KFLOAD
#undef KFMMA
                if (fq < 2) {
#pragma unroll
                    for (int nt = 0; nt < 8; ++nt) {
                        float* dst = SC + (wid * 8 + fq * 4) * 256 + half * 128 + nt * 16 + fr;
                        dst[0] = acc[nt].x; dst[256] = acc[nt].y; dst[512] = acc[nt].z; dst[768] = acc[nt].w;
                    }
                }
            }
        }
        __builtin_amdgcn_wave_barrier();
        {
            const int sl = fr, gb = fq * 16;
            const int row0_ = wid * 8 + fq, row1_ = wid * 8 + 4 + fq;
            float v1[2] = {0.f, 0.f}, v2[2] = {0.f, 0.f}; int i1[2] = {0, 0}, i2[2] = {0, 0};
            {
                unsigned kc[4][8];
#pragma unroll
                for (int c4 = 0; c4 < 4; ++c4)
#pragma unroll
                    for (int i = 0; i < 8; ++i) { const int idx = sl + 16 * i;
                        kc[c4][i] = (f2ord(SC[((c4 & 1) ? row1_ : row0_) * 256 + (c4 >> 1) * 128 + idx]) & ~127u) | (unsigned)(127 - idx); }
                float sv[4] = {0.f, 0.f, 0.f, 0.f}; int si[4] = {0, 0, 0, 0};
                for (int r = 0; r < 16; ++r) {
                    unsigned m[4], t[4];
#pragma unroll
                    for (int c4 = 0; c4 < 4; ++c4) {
                        const unsigned x0 = kc[c4][0] > kc[c4][1] ? kc[c4][0] : kc[c4][1], x1 = kc[c4][2] > kc[c4][3] ? kc[c4][2] : kc[c4][3];
                        const unsigned x2 = kc[c4][4] > kc[c4][5] ? kc[c4][4] : kc[c4][5], x3 = kc[c4][6] > kc[c4][7] ? kc[c4][6] : kc[c4][7];
                        const unsigned y0 = x0 > x1 ? x0 : x1, y1 = x2 > x3 ? x2 : x3; m[c4] = y0 > y1 ? y0 : y1;
                    }
#pragma unroll
                    for (int c4 = 0; c4 < 4; ++c4) t[c4] = sxoru<1>(m[c4]);
#pragma unroll
                    for (int c4 = 0; c4 < 4; ++c4) m[c4] = m[c4] > t[c4] ? m[c4] : t[c4];
#pragma unroll
                    for (int c4 = 0; c4 < 4; ++c4) t[c4] = sxoru<2>(m[c4]);
#pragma unroll
                    for (int c4 = 0; c4 < 4; ++c4) m[c4] = m[c4] > t[c4] ? m[c4] : t[c4];
#pragma unroll
                    for (int c4 = 0; c4 < 4; ++c4) t[c4] = sxoru<4>(m[c4]);
#pragma unroll
                    for (int c4 = 0; c4 < 4; ++c4) m[c4] = m[c4] > t[c4] ? m[c4] : t[c4];
#pragma unroll
                    for (int c4 = 0; c4 < 4; ++c4) t[c4] = sxoru<8>(m[c4]);
#pragma unroll
                    for (int c4 = 0; c4 < 4; ++c4) m[c4] = m[c4] > t[c4] ? m[c4] : t[c4];
#pragma unroll
                    for (int c4 = 0; c4 < 4; ++c4) {
                        if (sl == r) { sv[c4] = ord2f(m[c4] & ~127u); si[c4] = 127 - (int)(m[c4] & 127u); }
#pragma unroll
                        for (int i = 0; i < 8; ++i) kc[c4][i] = kc[c4][i] == m[c4] ? 0u : kc[c4][i];
                    }
                }
                v1[0] = sv[0]; i1[0] = si[0]; v1[1] = sv[1]; i1[1] = si[1]; v2[0] = sv[2]; i2[0] = si[2]; v2[1] = sv[3]; i2[1] = si[3];
            }
            int pa = 0, pb = 0; float tsa = 0.f, tsb = 0.f; int pida = 0, pidb = 0;
            for (int r = 0; r < 16; ++r) {
                const float va = __int_as_float(__builtin_amdgcn_ds_bpermute((gb + (pa & 15)) << 2, __float_as_int(v2[0])));
                const float vb = __int_as_float(__builtin_amdgcn_ds_bpermute((gb + (pb & 15)) << 2, __float_as_int(v2[1])));
                const unsigned keya = pa < 16 ? ((f2ord(v1[0] + va) & ~255u) | (unsigned)(255 - (sl * 16 + pa))) : 0u;
                const unsigned keyb = pb < 16 ? ((f2ord(v1[1] + vb) & ~255u) | (unsigned)(255 - (sl * 16 + pb))) : 0u;
                unsigned ma = keya, mb = keyb, ta, tb;
                ta = sxoru<1>(ma); tb = sxoru<1>(mb); ma = ma > ta ? ma : ta; mb = mb > tb ? mb : tb;
                ta = sxoru<2>(ma); tb = sxoru<2>(mb); ma = ma > ta ? ma : ta; mb = mb > tb ? mb : tb;
                ta = sxoru<4>(ma); tb = sxoru<4>(mb); ma = ma > ta ? ma : ta; mb = mb > tb ? mb : tb;
                ta = sxoru<8>(ma); tb = sxoru<8>(mb); ma = ma > ta ? ma : ta; mb = mb > tb ? mb : tb;
                if (sl == r) { tsa = ord2f(ma & ~255u); pida = 255 - (int)(ma & 255u); tsb = ord2f(mb & ~255u); pidb = 255 - (int)(mb & 255u); }
                if (keya == ma) pa++;
                if (keyb == mb) pb++;
            }
#pragma unroll
            for (int ps = 0; ps < 2; ++ps) {
                const int pid = ps ? pidb : pida; const float ts = ps ? tsb : tsa; const int row = ps ? row1_ : row0_;
                const int e1 = __builtin_amdgcn_ds_bpermute((gb + (pid >> 4)) << 2, i1[ps]), e2 = __builtin_amdgcn_ds_bpermute((gb + (pid & 15)) << 2, i2[ps]);
                float mx = ts;
                mx = fmaxf(mx, sxor<1>(mx)); mx = fmaxf(mx, sxor<2>(mx)); mx = fmaxf(mx, sxor<4>(mx)); mx = fmaxf(mx, sxor<8>(mx));
                const float ex = __expf(ts - mx), sm = gsum16(ex);
                EIDX[row * 16 + sl] = e1 * 128 + e2; GATE[row * 16 + sl] = ex / sm;
            }
        }
        __builtin_amdgcn_wave_barrier();
        {
            const int tok = tok0 + wid;
            const bf16_t* hrow = HB + (size_t)tok * D;
            const int grp = lane >> 4, sl = lane & 15;
            {
                f32x2 hv[32];
#pragma unroll
                for (int c = 0; c < 8; ++c) {
                    const u32x4 hq = *(const u32x4*)(hrow + sl * 64 + c * 8);
                    hv[c * 4 + 0] = (f32x2){bflo(hq.x), bfhi(hq.x)} * (1.0f / PEER_SU); hv[c * 4 + 1] = (f32x2){bflo(hq.y), bfhi(hq.y)} * (1.0f / PEER_SU);
                    hv[c * 4 + 2] = (f32x2){bflo(hq.z), bfhi(hq.z)} * (1.0f / PEER_SU); hv[c * 4 + 3] = (f32x2){bflo(hq.w), bfhi(hq.w)} * (1.0f / PEER_SU);
                }
                const unsigned char* PU8 = p.ws + WS_PU + sl * 64;
#define ULOADG(BUF, IT) do { _Pragma("unroll") for (int i_ = 0; i_ < 2; ++i_) { const int k_ = ((IT) + i_) * 4 + grp; const unsigned char* ur_ = PU8 + (size_t)EIDX[wid * 128 + k_] * D; \
        BUF[i_ * 4 + 0] = *(const u32x4*)ur_; BUF[i_ * 4 + 1] = *(const u32x4*)(ur_ + 16); BUF[i_ * 4 + 2] = *(const u32x4*)(ur_ + 32); BUF[i_ * 4 + 3] = *(const u32x4*)(ur_ + 48); } } while (0)
#define PDOT(uq, base) \
        a2 += __builtin_amdgcn_cvt_pk_f32_fp8((int)uq.x, false) * hv[base + 0]; b2 += __builtin_amdgcn_cvt_pk_f32_fp8((int)uq.x, true) * hv[base + 1]; \
        a2 += __builtin_amdgcn_cvt_pk_f32_fp8((int)uq.y, false) * hv[base + 2]; b2 += __builtin_amdgcn_cvt_pk_f32_fp8((int)uq.y, true) * hv[base + 3]; \
        a2 += __builtin_amdgcn_cvt_pk_f32_fp8((int)uq.z, false) * hv[base + 4]; b2 += __builtin_amdgcn_cvt_pk_f32_fp8((int)uq.z, true) * hv[base + 5]; \
        a2 += __builtin_amdgcn_cvt_pk_f32_fp8((int)uq.w, false) * hv[base + 6]; b2 += __builtin_amdgcn_cvt_pk_f32_fp8((int)uq.w, true) * hv[base + 7];
#define UCOMP(BUF, IT) do { _Pragma("unroll") for (int i_ = 0; i_ < 2; ++i_) { const int k_ = ((IT) + i_) * 4 + grp; \
        f32x2 a2 = (f32x2){0.f, 0.f}, b2 = (f32x2){0.f, 0.f}; \
        PDOT(BUF[i_ * 4 + 0], 0) PDOT(BUF[i_ * 4 + 1], 8) PDOT(BUF[i_ * 4 + 2], 16) PDOT(BUF[i_ * 4 + 3], 24) \
        a2 += b2; const float a_ = gsum16(a2.x + a2.y); GATE[wid * 128 + k_] = GATE[wid * 128 + k_] * gelu_exact(a_); } } while (0)
                u32x4 ubA[8], ubB[8];
                ULOADG(ubA, 0);
                for (int it0 = 0; it0 < 32; it0 += 4) {
                    ULOADG(ubB, it0 + 2);
                    __builtin_amdgcn_sched_barrier(0);
                    UCOMP(ubA, it0);
                    __builtin_amdgcn_sched_barrier(0);
                    if (it0 + 4 < 32) ULOADG(ubA, it0 + 4);
                    __builtin_amdgcn_sched_barrier(0);
                    UCOMP(ubB, it0 + 2);
                    __builtin_amdgcn_sched_barrier(0);
                }
#undef ULOADG
#undef PDOT
#undef UCOMP
            }
            __builtin_amdgcn_wave_barrier();
            f32x2 acc[8];
#pragma unroll
            for (int i = 0; i < 8; ++i) acc[i] = (f32x2){0.f, 0.f};
            const unsigned char* PV8 = p.ws + WS_PV + lane * 16;
#define VLOADG(BUF, K0) do { _Pragma("unroll") for (int i_ = 0; i_ < 8; ++i_) BUF[i_] = *(const u32x4*)(PV8 + (size_t)EIDX[wid * 128 + (K0) + i_] * D); } while (0)
#define VCOMP(BUF, K0) do { _Pragma("unroll") for (int i_ = 0; i_ < 8; ++i_) { const float w_ = GATE[wid * 128 + (K0) + i_]; const f32x2 w2 = (f32x2){w_, w_}; const u32x4 v = BUF[i_]; \
        acc[0] += w2 * __builtin_amdgcn_cvt_pk_f32_fp8((int)v.x, false); acc[1] += w2 * __builtin_amdgcn_cvt_pk_f32_fp8((int)v.x, true); \
        acc[2] += w2 * __builtin_amdgcn_cvt_pk_f32_fp8((int)v.y, false); acc[3] += w2 * __builtin_amdgcn_cvt_pk_f32_fp8((int)v.y, true); \
        acc[4] += w2 * __builtin_amdgcn_cvt_pk_f32_fp8((int)v.z, false); acc[5] += w2 * __builtin_amdgcn_cvt_pk_f32_fp8((int)v.z, true); \
        acc[6] += w2 * __builtin_amdgcn_cvt_pk_f32_fp8((int)v.w, false); acc[7] += w2 * __builtin_amdgcn_cvt_pk_f32_fp8((int)v.w, true); } } while (0)
            {
                u32x4 vbA[8], vbB[8];
                VLOADG(vbA, 0);
                for (int k0 = 0; k0 < 128; k0 += 16) {
                    VLOADG(vbB, k0 + 8);
                    __builtin_amdgcn_sched_barrier(0);
                    VCOMP(vbA, k0);
                    __builtin_amdgcn_sched_barrier(0);
                    if (k0 + 16 < 128) VLOADG(vbA, k0 + 16);
                    __builtin_amdgcn_sched_barrier(0);
                    VCOMP(vbB, k0 + 8);
                    __builtin_amdgcn_sched_barrier(0);
                }
            }
#undef VLOADG
#undef VCOMP
            float* orow = G.out + (size_t)tok * D + lane * 16;
#pragma unroll
            for (int i = 0; i < 4; ++i) {
                f32x4 t = *(f32x4*)(orow + i * 4);
                t.x += acc[2 * i].x * (1.0f / PEER_SV); t.y += acc[2 * i].y * (1.0f / PEER_SV); t.z += acc[2 * i + 1].x * (1.0f / PEER_SV); t.w += acc[2 * i + 1].y * (1.0f / PEER_SV);
                *(f32x4*)(orow + i * 4) = t;
            }
        }
        __builtin_amdgcn_wave_barrier();
    }
}


constexpr int NPH = 3 + NGROUP * 3;
__device__ __forceinline__ void run_phase(const Params& p, int ph, char* lds, int* s_item) {
    const int g = (ph - 3) / 3, s = (ph - 3) % 3;
    const Grp G = get_group(p, g);
    if (s == 0) {
        for (int u = blockIdx.x; u < 256; u += gridDim.x) {
            const int m0 = (u >> 1) * 256;
            phase_rmsnorm(G.x, p.in[I_GMIX], (bf16_t*)(p.ws + WS_HB), m0, 256);
            __syncthreads();
            phase_inproj(p, g, lds, u);
            __syncthreads();
        }
        if (g == 0) {
            phase_p0b(p, lds);
        }
    } else if (s == 1) {
        phase_mixer(p, g, lds, s_item);
    } else {
        for (int u = blockIdx.x; u < 256; u += gridDim.x) {
            const int m0 = u * 128;
            phase_glafin(p, g, m0, 128);
            __syncthreads();
            phase_merge(p, g, lds, u);
            __syncthreads();
            phase_outproj(p, g, lds, u);
            __syncthreads();
            phase_rmsnorm(G.out, p.in[I_GFFN], (bf16_t*)(p.ws + WS_HB), m0, 128);
            __syncthreads();
            phase_peerq(p, g, lds, u);
            __syncthreads();
            phase_peer(p, g, lds, m0 / 8, 16);
            __syncthreads();
        }
    }
}

__global__ void __launch_bounds__(NTHR) mega_kernel(Params p) {
    extern __shared__ __attribute__((aligned(16))) char lds[];
    __shared__ int s_item;
    cg::grid_group grid = cg::this_grid();
    phase_p0a(p, lds); grid.sync();
    for (int ph = 3; ph < NPH; ++ph) {
        run_phase(p, ph, lds, &s_item);
        if (ph + 1 < NPH) grid.sync();
    }
}

extern "C" void kernel_launch(void* const* d_in, const int* in_sizes, int n_in, void* d_out, int out_size, void* d_ws, size_t ws_size, hipStream_t stream) {
    static int grid_blocks = 0;
    if (grid_blocks == 0) {
        if (n_in != 32 || ws_size < WS_END) { fprintf(stderr, "kernel_launch: unexpected n_in %d or ws_size %zu (< %zu)\n", n_in, ws_size, (size_t)WS_END); grid_blocks = -1; return; }
        int dev = 0, cus = 0, per_cu = 0;
        hipGetDevice(&dev);
        hipDeviceGetAttribute(&cus, hipDeviceAttributeMultiprocessorCount, dev);
        hipFuncSetAttribute((const void*)mega_kernel, hipFuncAttributeMaxDynamicSharedMemorySize, LDS_BYTES);
        hipOccupancyMaxActiveBlocksPerMultiprocessor(&per_cu, (const void*)mega_kernel, NTHR, LDS_BYTES);
        if (per_cu < 1) per_cu = 1;
        grid_blocks = cus * per_cu;
        (void)hipGetLastError();
    }
    if (grid_blocks < 0) return;
    Params p{};
    for (int i = 0; i < 32; ++i) p.in[i] = (const float*)d_in[i];
    p.out = (float*)d_out; p.ws = (unsigned char*)d_ws; p.ph_lo = 0; p.ph_hi = NPH;
    void* args[] = {&p};
    hipError_t e = hipLaunchCooperativeKernel((const void*)mega_kernel, dim3(grid_blocks), dim3(NTHR), args, LDS_BYTES, stream);
    if (e != hipSuccess) fprintf(stderr, "cooperative launch failed: %s (grid %d)\n", hipGetErrorString(e), grid_blocks);
}
```

```cpp
#include <hip/hip_runtime.h>
#include <hip/hip_cooperative_groups.h>
#include <cstdio>
#include <cstdint>
namespace cg = cooperative_groups;

typedef unsigned short bf16_t;
typedef short bf16x8 __attribute__((ext_vector_type(8)));
typedef float f32x4 __attribute__((ext_vector_type(4)));
typedef unsigned u32x4 __attribute__((ext_vector_type(4)));
typedef unsigned u32x2 __attribute__((ext_vector_type(2)));

constexpr int D = 1024;
constexpr int NP = 10496;
constexpr int IN_COLS = 10272;
constexpr int C_GQ = 0, C_GK = 512, C_GV = 1024, C_GG = 2048, C_DQ = 3072, C_DK = 4096, C_DV = 5120, C_MQ = 6144, C_BG = 7168, C_LR = 10240;
constexpr int G_TOK = 32768;
constexpr int NGROUP = 3;
constexpr int NTHR = 512;
constexpr float RMS_EPS = 1e-6f;
constexpr float LOG2E = 1.4426950408889634f;
constexpr int LDS_BYTES = 147456;
constexpr float PEER_SU = 32.0f, PEER_SV = 8.0f;

enum { I_XP = 0, I_XS, I_MP, I_MS, I_GMIX, I_WIN, I_WDF, I_BDF, I_WDB, I_BDB, I_GOUT, I_GWO, I_DGQ, I_DGK, I_LQ1, I_LK1, I_LQ2, I_LK2,
       I_DGSUB, I_DWO, I_MGN, I_MWKV, I_MGQ, I_MGK, I_MWO, I_WOUT, I_GFFN, I_PWQ, I_PK1, I_PK2, I_PU, I_PV };

constexpr size_t al256(size_t x) { return (x + 255) & ~(size_t)255; }
constexpr size_t WS_CTRL = 0;
constexpr size_t WS_PROJ = 4096;
constexpr size_t WS_HB   = WS_PROJ + (size_t)G_TOK * NP * 2;
constexpr size_t WS_VT   = WS_HB + (size_t)G_TOK * D * 2;
constexpr size_t WS_WINT = WS_VT + (size_t)G_TOK * D * 2;
constexpr size_t WS_WOT  = WS_WINT + (size_t)NP * D * 2;
constexpr size_t WS_WKVT = WS_WOT + (size_t)4 * D * D * 2;
constexpr size_t WS_WQT  = WS_WKVT + (size_t)2048 * D * 2;
constexpr size_t WS_PU   = WS_WQT + (size_t)2048 * D * 2;
constexpr size_t WS_PV   = WS_PU + (size_t)16384 * D * 2;
constexpr size_t WS_K12  = WS_PV + (size_t)16384 * D * 2;
constexpr size_t WS_ROPE = WS_K12 + (size_t)2 * 128 * 128 * 2;
constexpr size_t WS_HM   = WS_ROPE + (size_t)16384 * 64 * 4;
constexpr size_t WS_KVR  = WS_HM + (size_t)2560 * D * 2;
constexpr size_t WS_MEMK = WS_KVR + (size_t)2560 * 2048 * 4;
constexpr size_t WS_MEMV = WS_MEMK + (size_t)10 * 4 * 256 * 256 * 2;
constexpr size_t WS_END  = WS_MEMV + (size_t)10 * 4 * 256 * 256 * 2;

struct Params {
    const float* in[32];
    float* out;
    unsigned char* ws;
    int ph_lo, ph_hi;
};

typedef float f32x2 __attribute__((ext_vector_type(2)));
typedef __bf16 bf16x2v __attribute__((ext_vector_type(2)));
__device__ __forceinline__ unsigned pk2(float lo, float hi) { const f32x2 v = {lo, hi}; const bf16x2v b = __builtin_convertvector(v, bf16x2v); return __builtin_bit_cast(unsigned, b); }
__device__ __forceinline__ float bflo(unsigned u) { return __uint_as_float(u << 16); }
__device__ __forceinline__ float bfhi(unsigned u) { return __uint_as_float(u & 0xffff0000u); }
__device__ __forceinline__ float bf2f(bf16_t b) { return __uint_as_float(((unsigned)b) << 16); }
__device__ __forceinline__ bf16_t f2bf(float f) { return (bf16_t)(pk2(f, 0.f) & 0xffffu); }
__device__ __forceinline__ f32x4 mfma16(bf16x8 a, bf16x8 b, f32x4 c) { return __builtin_amdgcn_mfma_f32_16x16x32_bf16(a, b, c, 0, 0, 0); }
__device__ __forceinline__ float fexp2(float x) { return __builtin_amdgcn_exp2f(x); }
template <class T> __device__ __forceinline__ T* launder(T* q) { asm volatile("" : "+s"(q)); return q; }
__device__ __forceinline__ int otid() { int t = threadIdx.x; asm volatile("" : "+v"(t)); return t; }
template <int M> __device__ __forceinline__ float sxor(float v) {
    if (M < 32) return __int_as_float(__builtin_amdgcn_ds_swizzle(__float_as_int(v), (M << 10) | 0x1F));
    const int l = otid() & 63; return __int_as_float(__builtin_amdgcn_ds_bpermute((l ^ 32) << 2, __float_as_int(v)));
}
template <int M> __device__ __forceinline__ unsigned sxoru(unsigned v) { return (unsigned)__builtin_amdgcn_ds_swizzle((int)v, (M << 10) | 0x1F); }
__device__ __forceinline__ float wave_sum(float v) {
    v += sxor<1>(v); v += sxor<2>(v); v += sxor<4>(v); v += sxor<8>(v); v += sxor<16>(v); v += sxor<32>(v);
    return v;
}

struct Grp { const float* x; const float* mem; float* out; int B, T, mb0; };
__device__ __forceinline__ Grp get_group(const Params& p, int g) {
    Grp r;
    if (g == 0) { r.x = p.in[I_XP]; r.out = p.out; r.B = 2; r.T = 16384; r.mb0 = 0; }
    else { r.x = p.in[I_XS] + (size_t)(g - 1) * G_TOK * D; r.out = p.out + (size_t)g * G_TOK * D; r.B = 4; r.T = 8192; r.mb0 = 2 + (g - 1) * 4; }
    r.mem = nullptr;
    return r;
}

constexpr int G_ROW = 144;
constexpr int G_A_BYTES = 128 * G_ROW;
constexpr int G_B_BYTES = 256 * G_ROW;
constexpr int G_STAGE = G_A_BYTES + G_B_BYTES;

template <bool SWAP, int MT>
__device__ __forceinline__ void gemm_kloop(f32x4 (&acc)[MT][4], const bf16_t* __restrict__ A, int lda, const bf16_t* __restrict__ Bt, int ldb, int K, char* lds) {
    constexpr int A_ROWS = MT * 32, A_BYTES = A_ROWS * G_ROW, STAGE = A_BYTES + G_B_BYTES;
    constexpr int NA = A_BYTES / 1024, NI = STAGE / 1024, NPER = (NI + 7) / 8;
    const int tid = otid(), lane = tid & 63, wid = __builtin_amdgcn_readfirstlane(tid >> 6), wm = wid >> 2, wn = wid & 3, fr = lane & 15, fq = lane >> 4;
    unsigned goff[NPER];
#pragma unroll
    for (int i = 0; i < NPER; ++i) {
        const int j = wid + 8 * i;
        const int ci = (j < NA ? j : j - NA) * 64 + lane, row = ci / 9, ch = ci % 9, chc = ch < 8 ? ch : 7;
        goff[i] = (unsigned)(row * (j < NA ? lda : ldb) + chc * 8);
    }
#define GSTAGE(buf, k0) do { _Pragma("unroll") for (int i = 0; i < NPER; ++i) { const int j = wid + 8 * i; if (j < NI) { \
        const bf16_t* src_ = (j < NA ? A : Bt) + goff[i] + (k0); \
        __builtin_amdgcn_global_load_lds((const unsigned*)src_, (unsigned*)(lds + (buf) * STAGE + j * 1024), 16, 0, 0); } } } while (0)
    const int nk = K / 64;
    GSTAGE(0, 0);
    __syncthreads();
    for (int kt = 0; kt < nk; ++kt) {
        if (kt + 1 < nk) GSTAGE((kt + 1) & 1, (kt + 1) * 64);
        const char* base = lds + (kt & 1) * STAGE;
        const char* abase = base + (wm * (MT * 16) + fr) * G_ROW + fq * 16;
        const char* bbase = base + A_BYTES + (wn * 64 + fr) * G_ROW + fq * 16;
        bf16x8 b0[4], b1[4], ar[4];
#pragma unroll
        for (int nt = 0; nt < 4; ++nt) b0[nt] = *(const bf16x8*)(bbase + nt * 16 * G_ROW);
        ar[0] = *(const bf16x8*)(abase); ar[1] = *(const bf16x8*)(abase + 16 * G_ROW); ar[2] = *(const bf16x8*)(abase + 32 * G_ROW);
#pragma unroll
        for (int st = 0; st < 2 * MT; ++st) {
            const int ks = st / MT, mt = st % MT;
            __builtin_amdgcn_sched_barrier(0);
            if (st + 3 < 2 * MT) { const int ks2 = (st + 3) / MT, mt2 = (st + 3) % MT; ar[(st + 3) % 4] = *(const bf16x8*)(abase + mt2 * 16 * G_ROW + ks2 * 64); }
            if (ks == 0 && mt >= MT - 3 && mt < MT - 1) {
#pragma unroll
                for (int q = 0; q < 2; ++q) { const int nt = (mt - (MT - 3)) * 2 + q; b1[nt] = *(const bf16x8*)(bbase + nt * 16 * G_ROW + 64); }
            }
#pragma unroll
            for (int nt = 0; nt < 4; ++nt) {
                const bf16x8 bv = ks == 0 ? b0[nt] : b1[nt];
                acc[mt][nt] = SWAP ? mfma16(bv, ar[st % 4], acc[mt][nt]) : mfma16(ar[st % 4], bv, acc[mt][nt]);
            }
        }
        __builtin_amdgcn_sched_barrier(0);
        __syncthreads();
    }
#undef GSTAGE
}

__device__ __forceinline__ void tile_order(int t, int nM, int nN, int& pm, int& pn) {
    const int per = 8 * nN, grp = t / per, r = t % per;
    pm = grp * 8 + (r & 7); pn = r >> 3;
}

__device__ __forceinline__ void phase_p0a(const Params& p, char* lds) {
    const int tid = otid(), lane = tid & 63, wid = tid >> 6;
    unsigned char* ws = p.ws;
    if (blockIdx.x == 0 && tid < 256) atomicExch((unsigned*)(ws + WS_CTRL) + tid, 0u);
    float* scr = (float*)(lds + wid * 8448);
    constexpr int IT_WIN = 16 * (NP / 32), IT_SQ = 16 * 32, IT_W2 = 16 * 64;
    constexpr int NIT = IT_WIN + 4 * IT_SQ + 2 * IT_W2;
    for (int it0 = blockIdx.x * 8; it0 < NIT; it0 += gridDim.x * 8) {
        int it = it0 + wid;
        const float* W = nullptr; bf16_t* WT = nullptr; int N = 0, nb = 0, kb = 0, srccol = -1;
        if (it < NIT) {
            int r = it;
            if (r < IT_WIN) { W = p.in[I_WIN]; N = IN_COLS; WT = (bf16_t*)(ws + WS_WINT); kb = r / (NP / 32); nb = r % (NP / 32);
                const int n0 = nb * 32; srccol = n0 < 3072 ? n0 : (n0 < 10240 ? n0 + 32 : (n0 == 10240 ? 3072 : -1)); }
            else { r -= IT_WIN;
                if (r < 4 * IT_SQ) { const int w = r / IT_SQ; r %= IT_SQ; const int idx[4] = {I_GWO, I_DWO, I_MWO, I_WOUT};
                    W = p.in[w == 0 ? I_GWO : (w == 1 ? I_DWO : (w == 2 ? I_MWO : I_WOUT))]; (void)idx; N = 1024; WT = (bf16_t*)(ws + WS_WOT) + (size_t)w * D * D; kb = r / 32; nb = r % 32; srccol = nb * 32; }
                else { r -= 4 * IT_SQ; const int w = r / IT_W2; r %= IT_W2; W = p.in[w == 0 ? I_MWKV : I_PWQ]; N = 2048; WT = (bf16_t*)(ws + (w == 0 ? WS_WKVT : WS_WQT)); kb = r / 64; nb = r % 64; srccol = nb * 32; }
            }
            const int k0 = kb * 64;
#pragma unroll 8
            for (int i = 0; i < 32; ++i) { const int kk = 2 * i + (lane >> 5); scr[kk * 33 + (lane & 31)] = srccol >= 0 ? W[(size_t)(k0 + kk) * N + srccol + (lane & 31)] : 0.f; }
        }
        __syncthreads();
        if (it < NIT) {
            const int k0 = kb * 64, c = lane & 7;
#pragma unroll
            for (int j = 0; j < 4; ++j) { const int n = (lane >> 3) + 8 * j; const float* s = scr + (8 * c) * 33 + n;
                u32x4 o; o.x = pk2(s[0], s[33]); o.y = pk2(s[66], s[99]); o.z = pk2(s[132], s[165]); o.w = pk2(s[198], s[231]);
                *(u32x4*)(WT + (size_t)(nb * 32 + n) * D + k0 + 8 * c) = o; }
        }
        __syncthreads();
    }
    const size_t gtid = (size_t)blockIdx.x * NTHR + tid, gsz = (size_t)gridDim.x * NTHR;
    {
        const size_t n8 = (size_t)16384 * D / 8;
        for (size_t i = gtid; i < 2 * n8; i += gsz) {
            const int w = i >= n8; const size_t j = w ? i - n8 : i;
            const float* src = p.in[w ? I_PV : I_PU] + j * 8; unsigned char* dst = ws + (w ? WS_PV : WS_PU) + j * 8;
            const float sc = w ? PEER_SV : PEER_SU;
            const f32x4 a = *(const f32x4*)src * sc, b = *(const f32x4*)(src + 4) * sc;
            int lo = __builtin_amdgcn_cvt_pk_fp8_f32(a.x, a.y, 0, false); lo = __builtin_amdgcn_cvt_pk_fp8_f32(a.z, a.w, lo, true);
            int hi = __builtin_amdgcn_cvt_pk_fp8_f32(b.x, b.y, 0, false); hi = __builtin_amdgcn_cvt_pk_fp8_f32(b.z, b.w, hi, true);
            *(u32x2*)dst = (u32x2){(unsigned)lo, (unsigned)hi};
        }
        for (size_t i = gtid; i < 2 * 16384; i += gsz) {
            const int w = i >= 16384; const size_t j = w ? i - 16384 : i;
            ((bf16_t*)(ws + WS_K12))[i] = f2bf(p.in[w ? I_PK2 : I_PK1][j]);
        }
    }
    for (size_t i = gtid; i < (size_t)16384 * 32; i += gsz) {
        const int t = (int)(i >> 5), k = (int)(i & 31);
        const float inv = powf(10000.0f, -(float)(2 * k) / 64.0f);
        const float ang = (float)t * inv;
        double sn, cs; sincos((double)ang, &sn, &cs);
        float* R = (float*)(ws + WS_ROPE) + (size_t)t * 64;
        R[k] = (float)cs; R[32 + k] = (float)sn;
    }
    for (int row = blockIdx.x * 8 + wid; row < 2560; row += gridDim.x * 8) {
        const float* src = row < 512 ? p.in[I_MP] + (size_t)row * D : p.in[I_MS] + (size_t)(row - 512) * D;
        const f32x4* xr = (const f32x4*)src + lane; const f32x4* gr = (const f32x4*)p.in[I_MGN] + lane;
        f32x4 v[4]; float s = 0.f;
#pragma unroll
        for (int j = 0; j < 4; ++j) { v[j] = xr[64 * j]; s += v[j].x * v[j].x + v[j].y * v[j].y + v[j].z * v[j].z + v[j].w * v[j].w; }
        const float r = rsqrtf(wave_sum(s) * (1.f / D) + RMS_EPS);
        u32x2* o = (u32x2*)((bf16_t*)(ws + WS_HM) + (size_t)row * D) + lane;
#pragma unroll
        for (int j = 0; j < 4; ++j) { const f32x4 g = gr[64 * j]; u32x2 w; w.x = pk2(v[j].x * r * g.x, v[j].y * r * g.y); w.y = pk2(v[j].z * r * g.z, v[j].w * r * g.w); o[64 * j] = w; }
    }
}

__device__ __forceinline__ void phase_p0b(const Params& p, char* lds) {
    const int tid_ = otid(), lane = tid_ & 63, wid = tid_ >> 6, wm = wid >> 2, wn = wid & 3, fr = lane & 15, fq = lane >> 4;
    const bf16_t* A = (const bf16_t*)(p.ws + WS_HM); const bf16_t* Bt = (const bf16_t*)(p.ws + WS_WKVT);
    float* C = (float*)(p.ws + WS_KVR);
    const int nM = 20, nN = 8;
    for (int t = blockIdx.x; t < nM * nN; t += gridDim.x) {
        const int pm = t % nM, pn = t / nM, m0 = pm * 128, n0 = pn * 256;
        f32x4 acc[4][4];
#pragma unroll
        for (int i = 0; i < 4; ++i)
#pragma unroll
            for (int j = 0; j < 4; ++j) acc[i][j] = (f32x4){0.f, 0.f, 0.f, 0.f};
        gemm_kloop<true, 4>(acc, A + (size_t)m0 * D, D, Bt + (size_t)n0 * D, D, D, lds);
#pragma unroll
        for (int mt = 0; mt < 4; ++mt)
#pragma unroll
            for (int nt = 0; nt < 4; ++nt) {
                const int row = m0 + wm * 64 + mt * 16 + fr, col = n0 + wn * 64 + nt * 16 + fq * 4;
                *(f32x4*)(C + (size_t)row * 2048 + col) = acc[mt][nt];
            }
        __syncthreads();
        {
            bf16_t* MK = (bf16_t*)(p.ws + WS_MEMK); bf16_t* MV = (bf16_t*)(p.ws + WS_MEMV);
            for (int r = wid; r < 128; r += 8) {
                const int row = m0 + r, b = row >> 8, m = row & 255;
                const f32x4 kv = *(const f32x4*)(C + (size_t)row * 2048 + n0 + lane * 4);
                if (pn < 4) {
                    const int h = pn;
                    const float ss = wave_sum(kv.x * kv.x + kv.y * kv.y + kv.z * kv.z + kv.w * kv.w);
                    const float rr = rsqrtf(ss * (1.f / 256.f) + RMS_EPS);
                    const f32x4 g = *(const f32x4*)(p.in[I_MGK] + lane * 4);
                    u32x2 w; w.x = pk2(kv.x * rr * g.x, kv.y * rr * g.y); w.y = pk2(kv.z * rr * g.z, kv.w * rr * g.w);
                    *(u32x2*)(MK + ((size_t)(b * 4 + h) * 256 + m) * 256 + lane * 4) = w;
                } else {
                    const int h = pn - 4;
                    const int pos = (m & ~31) + ((m >> 2) & 3) * 8 + ((m >> 4) & 1) * 4 + (m & 3);
                    bf16_t* dst = MV + ((size_t)(b * 4 + h) * 256 + lane * 4) * 256 + pos;
                    dst[0] = f2bf(kv.x); dst[256] = f2bf(kv.y); dst[512] = f2bf(kv.z); dst[768] = f2bf(kv.w);
                }
            }
        }
        __syncthreads();
    }
}

__device__ __forceinline__ void phase_p0c(const Params& p) {
    const int tid_ = otid(), lane = tid_ & 63, wid = tid_ >> 6;
    const float* KV = (const float*)(p.ws + WS_KVR);
    bf16_t* MK = (bf16_t*)(p.ws + WS_MEMK); bf16_t* MV = (bf16_t*)(p.ws + WS_MEMV);
    for (int it = blockIdx.x * 8 + wid; it < 2560 * 4; it += gridDim.x * 8) {
        const int row = it >> 2, h = it & 3, b = row >> 8, m = row & 255;
        const f32x4 kv = *(const f32x4*)(KV + (size_t)row * 2048 + h * 256 + lane * 4);
        const float ss = wave_sum(kv.x * kv.x + kv.y * kv.y + kv.z * kv.z + kv.w * kv.w);
        const float r = rsqrtf(ss * (1.f / 256.f) + RMS_EPS);
        const f32x4 g = *(const f32x4*)(p.in[I_MGK] + lane * 4);
        u32x2 w; w.x = pk2(kv.x * r * g.x, kv.y * r * g.y); w.y = pk2(kv.z * r * g.z, kv.w * r * g.w);
        *(u32x2*)(MK + ((size_t)(b * 4 + h) * 256 + m) * 256 + lane * 4) = w;
        const f32x4 vv = *(const f32x4*)(KV + (size_t)row * 2048 + 1024 + h * 256 + lane * 4);
        const int pos = (m & ~31) + ((m >> 2) & 3) * 8 + ((m >> 4) & 1) * 4 + (m & 3);
        bf16_t* dst = MV + ((size_t)(b * 4 + h) * 256 + lane * 4) * 256 + pos;
        dst[0] = f2bf(vv.x); dst[256] = f2bf(vv.y); dst[512] = f2bf(vv.z); dst[768] = f2bf(vv.w);
    }
}

__device__ __forceinline__ void phase_rmsnorm(const float* X, const float* gain, bf16_t* O, int row0, int nrows) {
    const int tid_ = otid(), lane = tid_ & 63, wid = tid_ >> 6;
    const f32x4* gr = (const f32x4*)launder(gain) + lane;
    f32x4 g[4];
#pragma unroll
    for (int j = 0; j < 4; ++j) g[j] = gr[64 * j];
    f32x4 vn[4];
    { const f32x4* xr = (const f32x4*)(X + (size_t)(row0 + wid) * D) + lane;
#pragma unroll
      for (int j = 0; j < 4; ++j) vn[j] = xr[64 * j]; }
    for (int row = row0 + wid; row < row0 + nrows; row += 8) {
        f32x4 v[4]; float s = 0.f;
#pragma unroll
        for (int j = 0; j < 4; ++j) v[j] = vn[j];
        if (row + 8 < row0 + nrows) { const f32x4* xr = (const f32x4*)(X + (size_t)(row + 8) * D) + lane;
#pragma unroll
            for (int j = 0; j < 4; ++j) vn[j] = xr[64 * j]; }
        __builtin_amdgcn_sched_barrier(0);
#pragma unroll
        for (int j = 0; j < 4; ++j) s += v[j].x * v[j].x + v[j].y * v[j].y + v[j].z * v[j].z + v[j].w * v[j].w;
        const float r = rsqrtf(wave_sum(s) * (1.f / D) + RMS_EPS);
        u32x2* o = (u32x2*)(O + (size_t)row * D) + lane;
#pragma unroll
        for (int j = 0; j < 4; ++j) { u32x2 w; w.x = pk2(v[j].x * r * g[j].x, v[j].y * r * g[j].y); w.y = pk2(v[j].z * r * g[j].z, v[j].w * r * g[j].w); o[64 * j] = w; }
    }
}

__device__ __forceinline__ void phase_inproj(const Params& p, int g, char* lds, int u) {
    const Grp G = get_group(p, g);
    const int tid_ = otid(), lane = tid_ & 63, wid = tid_ >> 6, wm = wid >> 2, wn = wid & 3, fr = lane & 15, fq = lane >> 4;
    const bf16_t* A = (const bf16_t*)(p.ws + WS_HB); const bf16_t* Bt = (const bf16_t*)(p.ws + WS_WINT);
    bf16_t* P = (bf16_t*)(p.ws + WS_PROJ); bf16_t* VT = (bf16_t*)(p.ws + WS_VT);
    const int pm = u >> 1, half = u & 1, m0 = pm * 256;
    for (int pi = 0; pi < (half ? 17 : 12); ++pi) {
        const int pn = half ? 24 + pi : pi; const int n0 = pn * 256;
        f32x4 acc[8][4];
#pragma unroll
        for (int i = 0; i < 8; ++i)
#pragma unroll
            for (int j = 0; j < 4; ++j) acc[i][j] = (f32x4){0.f, 0.f, 0.f, 0.f};
        gemm_kloop<true, 8>(acc, A + (size_t)m0 * D, D, Bt + (size_t)n0 * D, D, D, lds);
        const float sc = n0 < 512 ? 0.08838834764831845f : 1.0f;
#pragma unroll
        for (int mt = 0; mt < 8; ++mt)
#pragma unroll
            for (int nt = 0; nt < 4; ++nt) {
                const int row = m0 + wm * 128 + mt * 16 + fr, col = n0 + wn * 64 + nt * 16 + fq * 4;
                u32x2 w; w.x = pk2(acc[mt][nt].x * sc, acc[mt][nt].y * sc); w.y = pk2(acc[mt][nt].z * sc, acc[mt][nt].w * sc);
                *(u32x2*)(P + (size_t)row * NP + col) = w;
            }
    }
    if (half == 0) for (int pn = 12; pn < 20; ++pn) {
        const int n0 = pn * 256;
        f32x4 acc[8][4];
#pragma unroll
        for (int i = 0; i < 8; ++i)
#pragma unroll
            for (int j = 0; j < 4; ++j) acc[i][j] = (f32x4){0.f, 0.f, 0.f, 0.f};
        gemm_kloop<true, 8>(acc, A + (size_t)m0 * D, D, Bt + (size_t)n0 * D, D, D, lds);
        const int te_ = otid(), fr = te_ & 15, fq = (te_ >> 4) & 3, wm = te_ >> 8, wn = (te_ >> 6) & 3;
        const bool isk = n0 >= C_DK;
        const float* gn = launder(p.in[isk ? I_DGK : I_DGQ]) + fq * 4;
        const float qs = isk ? 1.0f : 0.125f * LOG2E;
        const float* ROPE = (const float*)(p.ws + WS_ROPE);
        const int tq0 = m0 % G.T + wm * 128 + fr;
#pragma unroll
        for (int mt = 0; mt < 8; ++mt) {
            const int row = m0 + wm * 128 + mt * 16 + fr, t = tq0 + mt * 16;
            float ss = 0.f;
#pragma unroll
            for (int nt = 0; nt < 4; ++nt) ss += acc[mt][nt].x * acc[mt][nt].x + acc[mt][nt].y * acc[mt][nt].y + acc[mt][nt].z * acc[mt][nt].z + acc[mt][nt].w * acc[mt][nt].w;
            ss += sxor<16>(ss); ss += sxor<32>(ss);
            const float r = rsqrtf(ss * (1.f / 64.f) + RMS_EPS) * qs;
            const float* rp = ROPE + (size_t)t * 64 + fq * 4;
            bf16_t* dst = P + (size_t)row * NP + n0 + wn * 64 + fq * 4;
#pragma unroll
            for (int hh = 0; hh < 2; ++hh) {
                const f32x4 cs = *(const f32x4*)(rp + hh * 16), sn = *(const f32x4*)(rp + 32 + hh * 16);
                const f32x4 ya = acc[mt][hh] * *(const f32x4*)(gn + hh * 16) * r, yb = acc[mt][hh + 2] * *(const f32x4*)(gn + 32 + hh * 16) * r;
                const f32x4 oa = ya * cs - yb * sn, ob = yb * cs + ya * sn;
                *(u32x2*)(dst + hh * 16) = (u32x2){pk2(oa.x, oa.y), pk2(oa.z, oa.w)};
                *(u32x2*)(dst + 32 + hh * 16) = (u32x2){pk2(ob.x, ob.y), pk2(ob.z, ob.w)};
            }
        }
    }
    for (int pn = half ? 21 : 20; pn < (half ? 24 : 21); ++pn) {
        const int n0 = pn * 256;
        f32x4 acc[8][4];
#pragma unroll
        for (int i = 0; i < 8; ++i)
#pragma unroll
            for (int j = 0; j < 4; ++j) acc[i][j] = (f32x4){0.f, 0.f, 0.f, 0.f};
        gemm_kloop<false, 8>(acc, A + (size_t)m0 * D, D, Bt + (size_t)n0 * D, D, D, lds);
        const int b = m0 / G.T, t0 = m0 % G.T + wm * 128;
#pragma unroll
        for (int mt = 0; mt < 8; ++mt)
#pragma unroll
            for (int nt = 0; nt < 4; ++nt) {
                const int n = n0 - C_DV + wn * 64 + nt * 16 + fr, h = n >> 7, dv = n & 127;
                const int pos = t0 + (mt >> 1) * 32 + fq * 8 + (mt & 1) * 4;
                u32x2 w; w.x = pk2(acc[mt][nt].x, acc[mt][nt].y); w.y = pk2(acc[mt][nt].z, acc[mt][nt].w);
                *(u32x2*)(VT + ((size_t)((b * 8 + h) * 128 + dv)) * G.T + pos) = w;
            }
    }
}

__device__ __forceinline__ void phase_qkrope(const Params& p, int g, int tok0, int ntok) {
    const Grp G = get_group(p, g);
    const int tid_ = otid(), lane = tid_ & 63, wid = tid_ >> 6, grp = lane >> 2, sub = lane & 3;
    bf16_t* P = (bf16_t*)(p.ws + WS_PROJ); const float* ROPE = (const float*)(p.ws + WS_ROPE);
    for (int it = tok0 * 2 + wid; it < (tok0 + ntok) * 2; it += 8) {
        const int tok = it >> 1, isk = it & 1, t = tok % G.T;
        bf16_t* base = P + (size_t)tok * NP + (isk ? C_DK : C_DQ) + grp * 64 + sub * 8;
        const u32x4 a = *(const u32x4*)base, b = *(const u32x4*)(base + 32);
        float x1[8], x2[8];
        x1[0] = bflo(a.x); x1[1] = bfhi(a.x); x1[2] = bflo(a.y); x1[3] = bfhi(a.y); x1[4] = bflo(a.z); x1[5] = bfhi(a.z); x1[6] = bflo(a.w); x1[7] = bfhi(a.w);
        x2[0] = bflo(b.x); x2[1] = bfhi(b.x); x2[2] = bflo(b.y); x2[3] = bfhi(b.y); x2[4] = bflo(b.z); x2[5] = bfhi(b.z); x2[6] = bflo(b.w); x2[7] = bfhi(b.w);
        float ss = 0.f;
#pragma unroll
        for (int e = 0; e < 8; ++e) ss += x1[e] * x1[e] + x2[e] * x2[e];
        ss += sxor<1>(ss); ss += sxor<2>(ss);
        const float r = rsqrtf(ss * (1.f / 64.f) + RMS_EPS) * (isk ? 1.0f : 0.125f * LOG2E);
        const float* gn = p.in[isk ? I_DGK : I_DGQ] + sub * 8;
        const float* rp = ROPE + (size_t)t * 64 + sub * 8;
        float o1[8], o2[8];
#pragma unroll
        for (int e = 0; e < 8; ++e) {
            const float y1 = x1[e] * r * gn[e], y2 = x2[e] * r * gn[32 + e], c = rp[e], s = rp[32 + e];
            o1[e] = y1 * c - y2 * s; o2[e] = y2 * c + y1 * s;
        }
        u32x4 w1, w2;
        w1.x = pk2(o1[0], o1[1]); w1.y = pk2(o1[2], o1[3]); w1.z = pk2(o1[4], o1[5]); w1.w = pk2(o1[6], o1[7]);
        w2.x = pk2(o2[0], o2[1]); w2.y = pk2(o2[2], o2[3]); w2.z = pk2(o2[4], o2[5]); w2.w = pk2(o2[6], o2[7]);
        *(u32x4*)base = w1; *(u32x4*)(base + 32) = w2;
    }
}

__device__ __forceinline__ void diff_attn_item(const Params& p, const Grp& G, int item, char* lds, float lam, float shift) {
    const int tid = otid(), lane = tid & 63, wid = tid >> 6, fr = lane & 15, fq = lane >> 4;
    const int c = wid & 1, sub = wid >> 1;
    const int T = G.T, nqb = T / 128;
    const int qb = item % nqb, bh = item / nqb, h = bh & 7, b = bh >> 3;
    bf16_t* P = (bf16_t*)(p.ws + WS_PROJ) + (size_t)b * T * NP;
    const bf16_t* Kg = P + C_DK + h * 128;
    const bf16_t* VTg = (const bf16_t*)(p.ws + WS_VT) + (size_t)bh * 128 * T;
    const int q0 = qb * 128 + sub * 32;
    bf16x8 qf[2][2];
#pragma unroll
    for (int nt = 0; nt < 2; ++nt)
#pragma unroll
        for (int ks = 0; ks < 2; ++ks) qf[nt][ks] = *(const bf16x8*)(P + (size_t)(q0 + nt * 16 + fr) * NP + C_DQ + h * 128 + c * 64 + ks * 32 + fq * 8);
    f32x4 o[8][2];
#pragma unroll
    for (int i = 0; i < 8; ++i) { o[i][0] = (f32x4){0.f, 0.f, 0.f, 0.f}; o[i][1] = (f32x4){0.f, 0.f, 0.f, 0.f}; }
    float l[2] = {0.f, 0.f};
    constexpr int STG = 36864, VOFF = 18432;
    u32x4 rk[2], rv[2];
    const int krow = tid >> 4, kch = tid & 15;
    const int vrow = tid >> 3, vch = tid & 7;
#define AGLOAD(kt) do { const int key0_ = (kt) * 64; \
        _Pragma("unroll") for (int i = 0; i < 2; ++i) rk[i] = *(const u32x4*)(Kg + (size_t)(key0_ + krow + i * 32) * NP + kch * 8); \
        _Pragma("unroll") for (int i = 0; i < 2; ++i) rv[i] = *(const u32x4*)(VTg + (size_t)(vrow + i * 64) * T + key0_ + vch * 8); } while (0)
#define ASWRITE(buf) do { char* b_ = lds + (buf) * STG; \
        _Pragma("unroll") for (int i = 0; i < 2; ++i) *(u32x4*)(b_ + ((kch >> 3) * 64 + krow + i * 32) * 144 + (kch & 7) * 16) = rk[i]; \
        _Pragma("unroll") for (int i = 0; i < 2; ++i) *(u32x4*)(b_ + VOFF + (vrow + i * 64) * 144 + vch * 16) = rv[i]; } while (0)
    const int nkt = T / 64;
#define EXPQ(SRC, NT, DSTP) do { const f32x4 a_ = SRC[0][NT], b_ = SRC[1][NT]; \
        const float p0 = fexp2(a_.x), p1 = fexp2(a_.y), p2 = fexp2(a_.z), p3 = fexp2(a_.w); \
        const float p4 = fexp2(b_.x), p5 = fexp2(b_.y), p6 = fexp2(b_.z), p7 = fexp2(b_.w); \
        l[NT] += ((p0 + p1) + (p2 + p3)) + ((p4 + p5) + (p6 + p7)); \
        u32x4 w_; w_.x = pk2(p0, p1); w_.y = pk2(p2, p3); w_.z = pk2(p4, p5); w_.w = pk2(p6, p7); \
        DSTP[NT] = __builtin_bit_cast(bf16x8, w_); } while (0)
#define SMMA1(DST, I, MT, KBASE) do { \
        const bf16x8 k0_ = *(const bf16x8*)((KBASE) + (c * 64 + (MT) * 16 + fr) * 144 + fq * 16); \
        const bf16x8 k1_ = *(const bf16x8*)((KBASE) + (c * 64 + (MT) * 16 + fr) * 144 + 64 + fq * 16); \
        DST[I][0] = mfma16(k0_, qf[0][0], (f32x4){0.f, 0.f, 0.f, 0.f}); DST[I][1] = mfma16(k0_, qf[1][0], (f32x4){0.f, 0.f, 0.f, 0.f}); \
        DST[I][0] = mfma16(k1_, qf[0][1], DST[I][0]); DST[I][1] = mfma16(k1_, qf[1][1], DST[I][1]); } while (0)
#define PVMMA(DVT, KK, PF, VBASE) do { \
        const bf16x8 vf_ = *(const bf16x8*)((VBASE) + VOFF + ((DVT) * 16 + fr) * 144 + (KK) * 64 + fq * 16); \
        o[DVT][0] = mfma16(vf_, PF[0], o[DVT][0]); o[DVT][1] = mfma16(vf_, PF[1], o[DVT][1]); } while (0)
#define PV8(KK, PF, VBASE) do { PVMMA(0, KK, PF, VBASE); PVMMA(1, KK, PF, VBASE); PVMMA(2, KK, PF, VBASE); PVMMA(3, KK, PF, VBASE); \
        PVMMA(4, KK, PF, VBASE); PVMMA(5, KK, PF, VBASE); PVMMA(6, KK, PF, VBASE); PVMMA(7, KK, PF, VBASE); } while (0)
    f32x4 slo[2][2], shi[2][2];
    bf16x8 pflo[2], pfhi[2];
    pfhi[0] = (bf16x8){0, 0, 0, 0, 0, 0, 0, 0}; pfhi[1] = pfhi[0];
#define KLOAD(KR, MTA, MTB, KBASE) do { \
        KR[0] = *(const bf16x8*)((KBASE) + (c * 64 + (MTA) * 16 + fr) * 144 + fq * 16); KR[1] = *(const bf16x8*)((KBASE) + (c * 64 + (MTA) * 16 + fr) * 144 + 64 + fq * 16); \
        KR[2] = *(const bf16x8*)((KBASE) + (c * 64 + (MTB) * 16 + fr) * 144 + fq * 16); KR[3] = *(const bf16x8*)((KBASE) + (c * 64 + (MTB) * 16 + fr) * 144 + 64 + fq * 16); } while (0)
#define SMMAK(DST, KR) do { \
        DST[0][0] = mfma16(KR[0], qf[0][0], (f32x4){0.f, 0.f, 0.f, 0.f}); DST[0][1] = mfma16(KR[0], qf[1][0], (f32x4){0.f, 0.f, 0.f, 0.f}); \
        DST[1][0] = mfma16(KR[2], qf[0][0], (f32x4){0.f, 0.f, 0.f, 0.f}); DST[1][1] = mfma16(KR[2], qf[1][0], (f32x4){0.f, 0.f, 0.f, 0.f}); \
        DST[0][0] = mfma16(KR[1], qf[0][1], DST[0][0]); DST[0][1] = mfma16(KR[1], qf[1][1], DST[0][1]); \
        DST[1][0] = mfma16(KR[3], qf[0][1], DST[1][0]); DST[1][1] = mfma16(KR[3], qf[1][1], DST[1][1]); } while (0)
#define VLOAD4(VR, D0, KK, VBASE) do { _Pragma("unroll") for (int i_ = 0; i_ < 4; ++i_) VR[i_] = *(const bf16x8*)((VBASE) + VOFF + (((D0) + i_) * 16 + fr) * 144 + (KK) * 64 + fq * 16); } while (0)
#define PV4(VR, D0, PF) do { _Pragma("unroll") for (int i_ = 0; i_ < 4; ++i_) { o[(D0) + i_][0] = mfma16(VR[i_], PF[0], o[(D0) + i_][0]); o[(D0) + i_][1] = mfma16(VR[i_], PF[1], o[(D0) + i_][1]); } } while (0)
#define FENCE() __builtin_amdgcn_sched_barrier(0)
    AGLOAD(0); ASWRITE(0); AGLOAD(1); ASWRITE(1);
    for (int i = tid; i < 18432 / 16; i += NTHR) *(u32x4*)(lds + 3 * STG + VOFF + i * 16) = (u32x4){0u, 0u, 0u, 0u};
    __syncthreads();
    bf16x8 kr[4], va[4], vb[4];
    KLOAD(kr, 0, 1, lds); SMMAK(slo, kr);
    for (int kt = 0; kt < nkt; ++kt) {
        { const int ktl = kt + 2 < nkt ? kt + 2 : nkt - 1; AGLOAD(ktl); }
        const char* cur = lds + (kt & 3) * STG; const char* nxt = lds + ((kt + 1) & 3) * STG; const char* prv = lds + ((kt + 3) & 3) * STG;
        KLOAD(kr, 2, 3, cur); VLOAD4(va, 0, 1, prv);
        FENCE();
        SMMAK(shi, kr); VLOAD4(vb, 4, 1, prv); EXPQ(slo, 0, pflo);
        FENCE();
        PV4(va, 0, pfhi); KLOAD(kr, 0, 1, nxt); EXPQ(slo, 1, pflo);
        FENCE();
        PV4(vb, 4, pfhi); VLOAD4(va, 0, 0, cur);
        FENCE();
        SMMAK(slo, kr); VLOAD4(vb, 4, 0, cur); EXPQ(shi, 0, pfhi);
        FENCE();
        PV4(va, 0, pflo); EXPQ(shi, 1, pfhi);
        FENCE();
        PV4(vb, 4, pflo);
        FENCE();
        ASWRITE((kt + 2) & 3);
        __syncthreads();
    }
    { const char* prv = lds + ((nkt - 1) & 3) * STG; VLOAD4(va, 0, 1, prv); VLOAD4(vb, 4, 1, prv); PV4(va, 0, pfhi); PV4(vb, 4, pfhi); }
    __syncthreads();
#undef KLOAD
#undef SMMAK
#undef VLOAD4
#undef PV4
#undef FENCE
#undef EXPQ
#undef SMMA1
#undef PVMMA
#undef PV8
#undef AGLOAD
#undef ASWRITE
    float inv[2];
#pragma unroll
    for (int nt = 0; nt < 2; ++nt) { float v = l[nt]; v += sxor<16>(v); v += sxor<32>(v); inv[nt] = 1.0f / v; }
    float* xch = (float*)lds + sub * 4096;
    if (c == 1) {
#pragma unroll
        for (int dvt = 0; dvt < 8; ++dvt)
#pragma unroll
            for (int nt = 0; nt < 2; ++nt) {
                xch[(dvt * 16 + fq * 4 + 0) * 32 + nt * 16 + fr] = o[dvt][nt].x * inv[nt];
                xch[(dvt * 16 + fq * 4 + 1) * 32 + nt * 16 + fr] = o[dvt][nt].y * inv[nt];
                xch[(dvt * 16 + fq * 4 + 2) * 32 + nt * 16 + fr] = o[dvt][nt].z * inv[nt];
                xch[(dvt * 16 + fq * 4 + 3) * 32 + nt * 16 + fr] = o[dvt][nt].w * inv[nt];
            }
    }
    __syncthreads();
    if (c == 0) {
        float ss[2] = {0.f, 0.f};
#pragma unroll
        for (int dvt = 0; dvt < 8; ++dvt)
#pragma unroll
            for (int nt = 0; nt < 2; ++nt) {
                f32x4 v = o[dvt][nt] * inv[nt];
                v.x -= lam * xch[(dvt * 16 + fq * 4 + 0) * 32 + nt * 16 + fr];
                v.y -= lam * xch[(dvt * 16 + fq * 4 + 1) * 32 + nt * 16 + fr];
                v.z -= lam * xch[(dvt * 16 + fq * 4 + 2) * 32 + nt * 16 + fr];
                v.w -= lam * xch[(dvt * 16 + fq * 4 + 3) * 32 + nt * 16 + fr];
                o[dvt][nt] = v; ss[nt] += v.x * v.x + v.y * v.y + v.z * v.z + v.w * v.w;
            }
#pragma unroll
        for (int nt = 0; nt < 2; ++nt) {
            float v = ss[nt]; v += sxor<16>(v); v += sxor<32>(v);
            const float r = rsqrtf(v * (1.f / 128.f) + RMS_EPS) * 0.8f;
#pragma unroll
            for (int dvt = 0; dvt < 8; ++dvt) {
                const f32x4 gs = *(const f32x4*)(p.in[I_DGSUB] + dvt * 16 + fq * 4);
                const f32x4 v4 = o[dvt][nt];
                u32x2 w; w.x = pk2(v4.x * r * gs.x, v4.y * r * gs.y); w.y = pk2(v4.z * r * gs.z, v4.w * r * gs.w);
                *(u32x2*)(P + (size_t)(q0 + nt * 16 + fr) * NP + C_DQ + h * 128 + dvt * 16 + fq * 4) = w;
            }
        }
    }
    __syncthreads();
}

__device__ __forceinline__ void mem_attn_item(const Params& p, const Grp& G, int item, char* lds, float shift) {
    const int tid = otid(), lane = tid & 63, wid = tid >> 6, fr = lane & 15, fq = lane >> 4;
    const int T = G.T, nqb = T / 128;
    const int qb = item % nqb, bh = item / nqb, h = bh & 3, b = bh >> 2;
    bf16_t* P = (bf16_t*)(p.ws + WS_PROJ) + (size_t)b * T * NP;
    const bf16_t* MK = (const bf16_t*)(p.ws + WS_MEMK) + (size_t)((G.mb0 + b) * 4 + h) * 256 * 256;
    const bf16_t* MV = (const bf16_t*)(p.ws + WS_MEMV) + (size_t)((G.mb0 + b) * 4 + h) * 256 * 256;
    const int row = qb * 128 + wid * 16 + fr;
    bf16_t* qp = P + (size_t)row * NP + C_MQ + h * 256;
    bf16x8 qf[8];
    {
        float ss = 0.f; u32x4 raw[8];
#pragma unroll
        for (int ks = 0; ks < 8; ++ks) { raw[ks] = *(const u32x4*)(qp + ks * 32 + fq * 8);
            const float a0 = bflo(raw[ks].x), a1 = bfhi(raw[ks].x), a2 = bflo(raw[ks].y), a3 = bfhi(raw[ks].y), a4 = bflo(raw[ks].z), a5 = bfhi(raw[ks].z), a6 = bflo(raw[ks].w), a7 = bfhi(raw[ks].w);
            ss += a0 * a0 + a1 * a1 + a2 * a2 + a3 * a3 + a4 * a4 + a5 * a5 + a6 * a6 + a7 * a7; }
        ss += sxor<16>(ss); ss += sxor<32>(ss);
        const float r = rsqrtf(ss * (1.f / 256.f) + RMS_EPS) * (0.0625f * LOG2E);
#pragma unroll
        for (int ks = 0; ks < 8; ++ks) {
            const f32x4 g0 = *(const f32x4*)(p.in[I_MGQ] + ks * 32 + fq * 8), g1 = *(const f32x4*)(p.in[I_MGQ] + ks * 32 + fq * 8 + 4);
            u32x4 w;
            w.x = pk2(bflo(raw[ks].x) * r * g0.x, bfhi(raw[ks].x) * r * g0.y); w.y = pk2(bflo(raw[ks].y) * r * g0.z, bfhi(raw[ks].y) * r * g0.w);
            w.z = pk2(bflo(raw[ks].z) * r * g1.x, bfhi(raw[ks].z) * r * g1.y); w.w = pk2(bflo(raw[ks].w) * r * g1.z, bfhi(raw[ks].w) * r * g1.w);
            qf[ks] = __builtin_bit_cast(bf16x8, w);
        }
    }
    f32x4 o[16];
#pragma unroll
    for (int i = 0; i < 16; ++i) o[i] = (f32x4){0.f, 0.f, 0.f, 0.f};
    float l = 0.f;
    constexpr int KROW = 528, VOFF = 64 * 528;
    u32x4 mk[4], mv[4];
#define MLOAD(KT) do { _Pragma("unroll") for (int i = 0; i < 4; ++i) { const int idx = tid + i * 512; \
        mk[i] = *(const u32x4*)(MK + (size_t)((KT) * 64 + (idx >> 5)) * 256 + (idx & 31) * 8); mv[i] = *(const u32x4*)(MV + (size_t)(idx >> 3) * 256 + (KT) * 64 + (idx & 7) * 8); } } while (0)
    MLOAD(0);
    for (int kt = 0; kt < 4; ++kt) {
#pragma unroll
        for (int i = 0; i < 4; ++i) {
            const int idx = tid + i * 512;
            *(u32x4*)(lds + (idx >> 5) * KROW + (idx & 31) * 16) = mk[i];
            *(u32x4*)(lds + VOFF + (idx >> 3) * 144 + (idx & 7) * 16) = mv[i];
        }
        __syncthreads();
        if (kt + 1 < 4) MLOAD(kt + 1);
        __builtin_amdgcn_sched_barrier(0);
        f32x4 s[4];
#pragma unroll
        for (int mt = 0; mt < 4; ++mt) s[mt] = (f32x4){0.f, 0.f, 0.f, 0.f};
#pragma unroll
        for (int ks = 0; ks < 8; ks += 2) {
            bf16x8 kf[8];
#pragma unroll
            for (int u = 0; u < 8; ++u) kf[u] = *(const bf16x8*)(lds + ((u & 3) * 16 + fr) * KROW + (ks + (u >> 2)) * 64 + fq * 16);
            __builtin_amdgcn_sched_barrier(0);
#pragma unroll
            for (int u = 0; u < 8; ++u) s[u & 3] = mfma16(kf[u], qf[ks + (u >> 2)], s[u & 3]);
        }
        bf16x8 pf[2];
#pragma unroll
        for (int kk = 0; kk < 2; ++kk) {
            const f32x4 a = s[2 * kk], bb = s[2 * kk + 1];
            const float p0 = fexp2(a.x), p1 = fexp2(a.y), p2 = fexp2(a.z), p3 = fexp2(a.w);
            const float p4 = fexp2(bb.x), p5 = fexp2(bb.y), p6 = fexp2(bb.z), p7 = fexp2(bb.w);
            l += ((p0 + p1) + (p2 + p3)) + ((p4 + p5) + (p6 + p7));
            u32x4 w; w.x = pk2(p0, p1); w.y = pk2(p2, p3); w.z = pk2(p4, p5); w.w = pk2(p6, p7);
            pf[kk] = __builtin_bit_cast(bf16x8, w);
        }
#pragma unroll
        for (int kk = 0; kk < 2; ++kk)
#pragma unroll
            for (int d0 = 0; d0 < 16; d0 += 8) {
                bf16x8 vf[8];
#pragma unroll
                for (int u = 0; u < 8; ++u) vf[u] = *(const bf16x8*)(lds + VOFF + ((d0 + u) * 16 + fr) * 144 + kk * 64 + fq * 16);
                __builtin_amdgcn_sched_barrier(0);
#pragma unroll
                for (int u = 0; u < 8; ++u) o[d0 + u] = mfma16(vf[u], pf[kk], o[d0 + u]);
            }
        __syncthreads();
    }
#undef MLOAD
    l += sxor<16>(l); l += sxor<32>(l);
    const float inv = 1.0f / l;
#pragma unroll
    for (int dvt = 0; dvt < 16; ++dvt) {
        u32x2 w; w.x = pk2(o[dvt].x * inv, o[dvt].y * inv); w.y = pk2(o[dvt].z * inv, o[dvt].w * inv);
        *(u32x2*)(qp + dvt * 16 + fq * 4) = w;
    }
}

constexpr int L_QE = 0, L_KE = 17408, L_KST = 34816, L_VTL = 53248, L_ATT = 71680, L_SB = 80896, L_LRF = 115712, L_TOT = 119808, L_GDEC = 121856;
__device__ __forceinline__ void gla_item(const Params& p, const Grp& G, int item, char* lds) {
    const int tid = otid(), lane = tid & 63, wid = tid >> 6, fr = lane & 15, fq = lane >> 4;
    const int slice = item & 1, dir = (item >> 1) & 1, h = (item >> 2) & 3, b = item >> 4;
    const int T = G.T, N = T / 64;
    const bf16_t* P = (const bf16_t*)(p.ws + WS_PROJ) + (size_t)b * T * NP;
    bf16_t* OUT = dir ? (bf16_t*)(p.ws + WS_PROJ) + (size_t)b * T * NP + C_DV + h * 256 + slice * 128
                      : (bf16_t*)(p.ws + WS_HB) + (size_t)b * T * D + h * 256 + slice * 128;
    const int ldo = dir ? NP : D;
    const int amt = wid & 3, antg = wid >> 2;
    bf16x8 wdB[4]; float bd4[4];
    {
        const float* wd = p.in[dir ? I_WDB : I_WDF]; const float* bdp = p.in[dir ? I_BDB : I_BDF];
#pragma unroll
        for (int q = 0; q < 4; ++q) {
            const int col = h * 128 + (antg * 4 + q) * 16 + fr;
            u32x4 w = (u32x4){0u, 0u, 0u, 0u};
            if (fq < 2) { const float* wp = wd + (size_t)(fq * 8) * 512 + col;
                w.x = pk2(wp[0], wp[512]); w.y = pk2(wp[1024], wp[1536]); w.z = pk2(wp[2048], wp[2560]); w.w = pk2(wp[3072], wp[3584]); }
            wdB[q] = __builtin_bit_cast(bf16x8, w);
            bd4[q] = bdp[col];
        }
    }
    { unsigned z = 0u; asm volatile("" : "+v"(z)); for (int i = tid; i < 34816 / 16; i += NTHR) *(u32x4*)(lds + L_SB + i * 16) = (u32x4){z, z, z, z}; }
    f32x4 S[8];
#pragma unroll
    for (int i = 0; i < 8; ++i) S[i] = (f32x4){0.f, 0.f, 0.f, 0.f};
    u32x4 rq[2], rk[2], rv[2], rl;
    const int lrow = tid >> 4, lch = tid & 15;
#define GGLOAD(n) do { const int cb_ = (dir ? (N - 1 - (n)) : (n)) * 64; \
        _Pragma("unroll") for (int i = 0; i < 2; ++i) { const int li_ = lrow + i * 32, tk_ = cb_ + (dir ? 63 - li_ : li_); const bf16_t* rp_ = P + (size_t)tk_ * NP; \
            rq[i] = *(const u32x4*)(rp_ + C_GQ + h * 128 + lch * 8); rk[i] = *(const u32x4*)(rp_ + C_GK + h * 128 + lch * 8); rv[i] = *(const u32x4*)(rp_ + C_GV + h * 256 + slice * 128 + lch * 8); } \
        if (tid < 128) { const int li_ = tid >> 1, tk_ = cb_ + (dir ? 63 - li_ : li_); rl = *(const u32x4*)(P + (size_t)tk_ * NP + C_LR + dir * 16 + (tid & 1) * 8); } } while (0)
    GGLOAD(0);
    for (int n = 0; n < N; ++n) {
#pragma unroll
        for (int i = 0; i < 2; ++i) {
            const int li = lrow + i * 32;
            *(u32x4*)(lds + L_QE + li * 272 + lch * 16) = rq[i];
            *(u32x4*)(lds + L_KE + li * 272 + lch * 16) = rk[i];
            bf16_t* vt = (bf16_t*)(lds + L_VTL) + (lch * 8) * 72 + li;
            vt[0 * 72] = (bf16_t)(rv[i].x & 0xffff); vt[1 * 72] = (bf16_t)(rv[i].x >> 16); vt[2 * 72] = (bf16_t)(rv[i].y & 0xffff); vt[3 * 72] = (bf16_t)(rv[i].y >> 16);
            vt[4 * 72] = (bf16_t)(rv[i].z & 0xffff); vt[5 * 72] = (bf16_t)(rv[i].z >> 16); vt[6 * 72] = (bf16_t)(rv[i].w & 0xffff); vt[7 * 72] = (bf16_t)(rv[i].w >> 16);
        }
        if (tid < 128) *(u32x4*)(lds + L_LRF + (tid >> 1) * 32 + (tid & 1) * 16) = rl;
        if (n + 1 < N) GGLOAD(n + 1);
        __syncthreads();
        {
            u32x4 araw = (u32x4){0u, 0u, 0u, 0u};
            if (fq < 2) araw = *(const u32x4*)(lds + L_LRF + (amt * 16 + fr) * 32 + fq * 16);
            const bf16x8 afr = __builtin_bit_cast(bf16x8, araw);
            float pb[4][4]; float E[4], tt[4];
#pragma unroll
            for (int q = 0; q < 4; ++q) {
                const f32x4 x4 = mfma16(afr, wdB[q], (f32x4){bd4[q], bd4[q], bd4[q], bd4[q]});
                float run = 0.f;
#pragma unroll
                for (int j = 0; j < 4; ++j) {
                    const float x = x4[j];
                    const float ls = fminf(x, 0.f) - __logf(1.0f + __expf(-fabsf(x)));
                    run += ls * 0.0625f; pb[q][j] = run;
                }
                const float u = sxor<16>(run), v = run + u, w2 = sxor<32>(v);
                E[q] = ((fq & 1) ? u : 0.f) + ((fq & 2) ? w2 : 0.f);
                tt[q] = v + w2;
                if (fq == 0) ((float*)(lds + L_TOT))[amt * 128 + (antg * 4 + q) * 16 + fr] = tt[q];
            }
            __syncthreads();
#pragma unroll
            for (int q = 0; q < 4; ++q) {
                const int col = (antg * 4 + q) * 16 + fr;
                float off = 0.f, blast = 0.f;
#pragma unroll
                for (int r = 0; r < 4; ++r) { const float tv = ((const float*)(lds + L_TOT))[r * 128 + col]; blast += tv; if (r < amt) off += tv; }
                const float gcol = __expf(blast);
                bf16_t* qe = (bf16_t*)(lds + L_QE) + (amt * 16 + fq * 4) * 136 + col; bf16_t* ke = (bf16_t*)(lds + L_KE) + (amt * 16 + fq * 4) * 136 + col;
                float ksv[4];
#pragma unroll
                for (int j = 0; j < 4; ++j) {
                    const float bb = off + E[q] + pb[q][j];
                    const float qv = bf2f(qe[j * 136]), kv = bf2f(ke[j * 136]);
                    const float kd = kv * __expf(-bb);
                    qe[j * 136] = f2bf(qv * __expf(bb)); ke[j * 136] = f2bf(kd);
                    ksv[j] = kd * gcol;
                }
                *(u32x2*)(lds + L_KST + col * 144 + (amt * 16 + fq * 4) * 2) = (u32x2){pk2(ksv[0], ksv[1]), pk2(ksv[2], ksv[3])};
                if (amt == 0 && fq == 0) ((float*)(lds + L_GDEC))[col] = gcol;
            }
        }
        __syncthreads();
        {
            const int ct = wid & 3;
            f32x4 a[2] = {(f32x4){0.f, 0.f, 0.f, 0.f}, (f32x4){0.f, 0.f, 0.f, 0.f}};
            bf16x8 qv[4], kv[2][4];
#pragma unroll
            for (int ks = 0; ks < 4; ++ks) {
                qv[ks] = *(const bf16x8*)(lds + L_QE + (ct * 16 + fr) * 272 + ks * 64 + fq * 16);
#pragma unroll
                for (int j = 0; j < 2; ++j) kv[j][ks] = *(const bf16x8*)(lds + L_KE + (((wid >> 2) * 2 + j) * 16 + fr) * 272 + ks * 64 + fq * 16);
            }
            __builtin_amdgcn_sched_barrier(0);
#pragma unroll
            for (int ks = 0; ks < 4; ++ks)
#pragma unroll
                for (int j = 0; j < 2; ++j) a[j] = mfma16(kv[j][ks], qv[ks], a[j]);
#pragma unroll
            for (int j = 0; j < 2; ++j) {
                const int st = (wid >> 2) * 2 + j, cc = ct * 16 + fr, s0 = st * 16 + fq * 4;
                const float v0 = (s0 + 0 <= cc) ? a[j].x : 0.f, v1 = (s0 + 1 <= cc) ? a[j].y : 0.f, v2 = (s0 + 2 <= cc) ? a[j].z : 0.f, v3 = (s0 + 3 <= cc) ? a[j].w : 0.f;
                *(u32x2*)(lds + L_ATT + cc * 144 + s0 * 2) = (u32x2){pk2(v0, v1), pk2(v2, v3)};
            }
        }
        __syncthreads();
        {
            f32x4 oc[4] = {(f32x4){0.f, 0.f, 0.f, 0.f}, (f32x4){0.f, 0.f, 0.f, 0.f}, (f32x4){0.f, 0.f, 0.f, 0.f}, (f32x4){0.f, 0.f, 0.f, 0.f}};
            bf16x8 fa[2], fb[2][4], ga[2], gb[2][4];
#define LD_VA(FA, FB) do { _Pragma("unroll") for (int ks = 0; ks < 2; ++ks) { FA[ks] = *(const bf16x8*)(lds + L_VTL + (wid * 16 + fr) * 144 + ks * 64 + fq * 16); \
                _Pragma("unroll") for (int ct = 0; ct < 4; ++ct) FB[ks][ct] = *(const bf16x8*)(lds + L_ATT + (ct * 16 + fr) * 144 + ks * 64 + fq * 16); } } while (0)
#define LD_SQ(FA, FB, K0) do { _Pragma("unroll") for (int ks = 0; ks < 2; ++ks) { FA[ks] = *(const bf16x8*)(lds + L_SB + (wid * 16 + fr) * 272 + ((K0) + ks) * 64 + fq * 16); \
                _Pragma("unroll") for (int ct = 0; ct < 4; ++ct) FB[ks][ct] = *(const bf16x8*)(lds + L_QE + (ct * 16 + fr) * 272 + ((K0) + ks) * 64 + fq * 16); } } while (0)
#define MM10(FA, FB) do { _Pragma("unroll") for (int ks = 0; ks < 2; ++ks) _Pragma("unroll") for (int ct = 0; ct < 4; ++ct) oc[ct] = mfma16(FA[ks], FB[ks][ct], oc[ct]); } while (0)
            LD_VA(fa, fb); LD_SQ(ga, gb, 0);
            __builtin_amdgcn_sched_barrier(0);
            MM10(fa, fb); LD_SQ(fa, fb, 2);
            __builtin_amdgcn_sched_barrier(0);
            MM10(ga, gb);
            __builtin_amdgcn_sched_barrier(0);
            MM10(fa, fb);
#undef LD_VA
#undef LD_SQ
#undef MM10
            const int cb = (dir ? (N - 1 - n) : n) * 64;
#pragma unroll
            for (int ct = 0; ct < 4; ++ct) {
                const int cl = ct * 16 + fr, tk = cb + (dir ? 63 - cl : cl);
                *(u32x2*)(OUT + (size_t)tk * ldo + wid * 16 + fq * 4) = (u32x2){pk2(oc[ct].x, oc[ct].y), pk2(oc[ct].z, oc[ct].w)};
            }
        }
        __syncthreads();
        {
            const f32x4 gd = *(const f32x4*)((const float*)(lds + L_GDEC) + wid * 16 + fq * 4);
#pragma unroll
            for (int et = 0; et < 8; ++et) S[et] = S[et] * gd;
            bf16x8 da[2], db[2][8];
#pragma unroll
            for (int ks = 0; ks < 2; ++ks) {
                da[ks] = *(const bf16x8*)(lds + L_KST + (wid * 16 + fr) * 144 + ks * 64 + fq * 16);
#pragma unroll
                for (int et = 0; et < 8; ++et) db[ks][et] = *(const bf16x8*)(lds + L_VTL + (et * 16 + fr) * 144 + ks * 64 + fq * 16);
            }
            __builtin_amdgcn_sched_barrier(0);
#pragma unroll
            for (int ks = 0; ks < 2; ++ks)
#pragma unroll
                for (int et = 0; et < 8; ++et) S[et] = mfma16(da[ks], db[ks][et], S[et]);
#pragma unroll
            for (int et = 0; et < 8; ++et)
                *(u32x2*)(lds + L_SB + (et * 16 + fr) * 272 + (wid * 16 + fq * 4) * 2) = (u32x2){pk2(S[et].x, S[et].y), pk2(S[et].z, S[et].w)};
        }
        __syncthreads();
    }
#undef GGLOAD
}

__device__ __forceinline__ void phase_mixer(const Params& p, int g, char* lds, int* s_item) {
    const Grp G = get_group(p, g);
    const int nGLA = G.B * 16, nATT = G.B * 8 * (G.T / 128), nMEM = G.B * 4 * (G.T / 128);
    unsigned* ctr = (unsigned*)(p.ws + WS_CTRL) + g * 4;
    for (;;) {
        if (threadIdx.x == 0) *s_item = (int)atomicAdd(ctr + 0, 1u);
        __syncthreads();
        const int it = *s_item;
        __syncthreads();
        if (it >= nGLA) break;
        gla_item(p, G, it, lds);
    }
    {
        float d1 = 0.f, d2 = 0.f;
        for (int i = 0; i < 64; ++i) { d1 += p.in[I_LQ1][i] * p.in[I_LK1][i]; d2 += p.in[I_LQ2][i] * p.in[I_LK2][i]; }
        const float lam = expf(d1) - expf(d2) + 0.2f;
        for (;;) {
            if (threadIdx.x == 0) *s_item = (int)atomicAdd(ctr + 1, 1u);
            __syncthreads();
            const int it = *s_item;
            __syncthreads();
            if (it >= nATT) break;
            diff_attn_item(p, G, it, lds, lam, 0.f);
        }
    }
    for (;;) {
        if (threadIdx.x == 0) *s_item = (int)atomicAdd(ctr + 2, 1u);
        __syncthreads();
        const int it = *s_item;
        __syncthreads();
        if (it >= nMEM) break;
        mem_attn_item(p, G, it, lds, 0.f);
    }
}

__device__ __forceinline__ void phase_glafin(const Params& p, int g, int tok0, int ntok) {
    const int tid_ = otid(), lane = tid_ & 63, wid = tid_ >> 6;
    bf16_t* P = (bf16_t*)(p.ws + WS_PROJ); const bf16_t* F = (const bf16_t*)(p.ws + WS_HB);
    unsigned qq, kk; u32x2 f, bk, v, gt;
#define GFLOAD(IT) do { const int tok_ = (IT) >> 2, h_ = (IT) & 3; const bf16_t* row_ = P + (size_t)tok_ * NP; \
        qq = *(const unsigned*)(row_ + C_GQ + h_ * 128 + lane * 2); kk = *(const unsigned*)(row_ + C_GK + h_ * 128 + lane * 2); \
        f = *(const u32x2*)(F + (size_t)tok_ * D + h_ * 256 + lane * 4); bk = *(const u32x2*)(row_ + C_DV + h_ * 256 + lane * 4); \
        v = *(const u32x2*)(row_ + C_GV + h_ * 256 + lane * 4); gt = *(const u32x2*)(row_ + C_GG + h_ * 256 + lane * 4); } while (0)
    const f32x4 go = *(const f32x4*)(launder(p.in[I_GOUT]) + lane * 4);
    GFLOAD(tok0 * 4 + wid);
    for (int it = tok0 * 4 + wid; it < (tok0 + ntok) * 4; it += 8) {
        const int tok = it >> 2, h = it & 3;
        bf16_t* row = P + (size_t)tok * NP;
        const unsigned cq = qq, ck = kk; const u32x2 cf = f, cbk = bk, cv = v, cgt = gt;
        if (it + 8 < (tok0 + ntok) * 4) GFLOAD(it + 8);
        __builtin_amdgcn_sched_barrier(0);
        const float qk = wave_sum(bflo(cq) * bflo(ck) + bfhi(cq) * bfhi(ck));
        float o0 = bflo(cf.x) + bflo(cbk.x) - qk * bflo(cv.x), o1 = bfhi(cf.x) + bfhi(cbk.x) - qk * bfhi(cv.x);
        float o2 = bflo(cf.y) + bflo(cbk.y) - qk * bflo(cv.y), o3 = bfhi(cf.y) + bfhi(cbk.y) - qk * bfhi(cv.y);
        const float r = rsqrtf(wave_sum(o0 * o0 + o1 * o1 + o2 * o2 + o3 * o3) * (1.f / 256.f) + RMS_EPS);
        const float g0 = bflo(cgt.x), g1 = bfhi(cgt.x), g2 = bflo(cgt.y), g3 = bfhi(cgt.y);
        o0 *= r * go.x * g0 * __builtin_amdgcn_rcpf(1.f + __expf(-g0)); o1 *= r * go.y * g1 * __builtin_amdgcn_rcpf(1.f + __expf(-g1));
        o2 *= r * go.z * g2 * __builtin_amdgcn_rcpf(1.f + __expf(-g2)); o3 *= r * go.w * g3 * __builtin_amdgcn_rcpf(1.f + __expf(-g3));
        *(u32x2*)(row + C_GG + h * 256 + lane * 4) = (u32x2){pk2(o0, o1), pk2(o2, o3)};
    }
#undef GFLOAD
}

__device__ __forceinline__ void phase_merge(const Params& p, int g, char* lds, int u) {
    const int tid_ = otid(), lane = tid_ & 63, wid = tid_ >> 6, wm = wid >> 2, wn = wid & 3, fr = lane & 15, fq = lane >> 4;
    const bf16_t* P = (const bf16_t*)(p.ws + WS_PROJ); bf16_t* M = (bf16_t*)(p.ws + WS_VT);
    for (int pn = 0; pn < 4; ++pn) {
        const int m0 = u * 128, n0 = pn * 256;
        f32x4 macc[4][4];
#pragma unroll
        for (int i = 0; i < 4; ++i)
#pragma unroll
            for (int j = 0; j < 4; ++j) macc[i][j] = (f32x4){0.f, 0.f, 0.f, 0.f};
        for (int br = 0; br < 3; ++br) {
            f32x4 acc[4][4];
#pragma unroll
            for (int i = 0; i < 4; ++i)
#pragma unroll
                for (int j = 0; j < 4; ++j) acc[i][j] = (f32x4){0.f, 0.f, 0.f, 0.f};
            const int acol = br == 0 ? C_GG : (br == 1 ? C_DQ : C_MQ);
            gemm_kloop<true, 4>(acc, P + (size_t)m0 * NP + acol, NP, (const bf16_t*)(p.ws + WS_WOT) + (size_t)br * D * D + (size_t)n0 * D, D, D, lds);
#pragma unroll
            for (int mt = 0; mt < 4; ++mt)
#pragma unroll
                for (int nt = 0; nt < 4; ++nt) {
                    const int row = m0 + wm * 64 + mt * 16 + fr, col = n0 + wn * 64 + nt * 16 + fq * 4;
                    const u32x2 gt = *(const u32x2*)(P + (size_t)row * NP + C_BG + br * 1024 + col);
                    f32x4 sg; sg.x = __builtin_amdgcn_rcpf(1.f + __expf(-bflo(gt.x))); sg.y = __builtin_amdgcn_rcpf(1.f + __expf(-bfhi(gt.x))); sg.z = __builtin_amdgcn_rcpf(1.f + __expf(-bflo(gt.y))); sg.w = __builtin_amdgcn_rcpf(1.f + __expf(-bfhi(gt.y)));
                    macc[mt][nt] += sg * acc[mt][nt];
                }
        }
#pragma unroll
        for (int mt = 0; mt < 4; ++mt)
#pragma unroll
            for (int nt = 0; nt < 4; ++nt) {
                const int row = m0 + wm * 64 + mt * 16 + fr, col = n0 + wn * 64 + nt * 16 + fq * 4;
                *(u32x2*)(M + (size_t)row * D + col) = (u32x2){pk2(macc[mt][nt].x, macc[mt][nt].y), pk2(macc[mt][nt].z, macc[mt][nt].w)};
            }
    }
}

__device__ __forceinline__ void phase_outproj(const Params& p, int g, char* lds, int u) {
    const Grp G = get_group(p, g);
    const int tid_ = otid(), lane = tid_ & 63, wid = tid_ >> 6, wm = wid >> 2, wn = wid & 3, fr = lane & 15, fq = lane >> 4;
    const bf16_t* M = (const bf16_t*)(p.ws + WS_VT); const bf16_t* W = (const bf16_t*)(p.ws + WS_WOT) + (size_t)3 * D * D;
    for (int pn = 0; pn < 4; ++pn) {
        const int m0 = u * 128, n0 = pn * 256;
        f32x4 acc[4][4];
#pragma unroll
        for (int i = 0; i < 4; ++i)
#pragma unroll
            for (int j = 0; j < 4; ++j) acc[i][j] = (f32x4){0.f, 0.f, 0.f, 0.f};
        gemm_kloop<true, 4>(acc, M + (size_t)m0 * D, D, W + (size_t)n0 * D, D, D, lds);
#pragma unroll
        for (int mt = 0; mt < 4; ++mt)
#pragma unroll
            for (int nt = 0; nt < 4; ++nt) {
                const int row = m0 + wm * 64 + mt * 16 + fr, col = n0 + wn * 64 + nt * 16 + fq * 4;
                const f32x4 xv = *(const f32x4*)(G.x + (size_t)row * D + col);
                *(f32x4*)(G.out + (size_t)row * D + col) = xv + acc[mt][nt];
            }
    }
}

__device__ __forceinline__ void phase_peerq(const Params& p, int g, char* lds, int u) {
    const int tid_ = otid(), lane = tid_ & 63, wid = tid_ >> 6, wm = wid >> 2, wn = wid & 3, fr = lane & 15, fq = lane >> 4;
    const bf16_t* A = (const bf16_t*)(p.ws + WS_HB); const bf16_t* W = (const bf16_t*)(p.ws + WS_WQT); bf16_t* P = (bf16_t*)(p.ws + WS_PROJ);
    for (int pn = 0; pn < 8; ++pn) {
        const int m0 = u * 128, n0 = pn * 256;
        f32x4 acc[4][4];
#pragma unroll
        for (int i = 0; i < 4; ++i)
#pragma unroll
            for (int j = 0; j < 4; ++j) acc[i][j] = (f32x4){0.f, 0.f, 0.f, 0.f};
        gemm_kloop<true, 4>(acc, A + (size_t)m0 * D, D, W + (size_t)n0 * D, D, D, lds);
#pragma unroll
        for (int mt = 0; mt < 4; ++mt)
#pragma unroll
            for (int nt = 0; nt < 4; ++nt) {
                const int row = m0 + wm * 64 + mt * 16 + fr, col = n0 + wn * 64 + nt * 16 + fq * 4;
                *(u32x2*)(P + (size_t)row * NP + col) = (u32x2){pk2(acc[mt][nt].x, acc[mt][nt].y), pk2(acc[mt][nt].z, acc[mt][nt].w)};
            }
    }
}

__device__ __forceinline__ unsigned f2ord(float f) { const unsigned u = __float_as_uint(f); return (u & 0x80000000u) ? ~u : (u | 0x80000000u); }
__device__ __forceinline__ float ord2f(unsigned k) { const unsigned u = (k & 0x80000000u) ? (k & 0x7fffffffu) : ~k; return __uint_as_float(u); }
__device__ __forceinline__ unsigned gmax16(unsigned v) {
    unsigned t;
    t = sxoru<1>(v); v = v > t ? v : t; t = sxoru<2>(v); v = v > t ? v : t; t = sxoru<4>(v); v = v > t ? v : t; t = sxoru<8>(v); v = v > t ? v : t;
    return v;
}
__device__ __forceinline__ float gsum16(float v) { v += sxor<1>(v); v += sxor<2>(v); v += sxor<4>(v); v += sxor<8>(v); return v; }
__device__ __forceinline__ float gelu_exact(float v) {
    const float av = fabsf(v), t = __builtin_amdgcn_rcpf(av * 0.2316418882f + 1.0f);
    float q = t * 0.5307027145f + (-0.7265760135f); q = q * t + 0.7107068705f; q = q * t + (-0.142248368f); q = q * t + 0.127414796f; q = q * t;
    const float e = __builtin_amdgcn_exp2f(v * v * (-0.72134752044f));
    const float m = v * (q * e);
    return v < 0.f ? m : v - m;
}

__device__ __forceinline__ void phase_peer(const Params& p, int g, char* lds, int tile0, int ntile) {
    const Grp G = get_group(p, g);
    const int tid = otid(), lane = tid & 63, wid = tid >> 6, fr = lane & 15, fq = lane >> 4;
    const bf16_t* P = (const bf16_t*)(p.ws + WS_PROJ); const bf16_t* HB = (const bf16_t*)(p.ws + WS_HB);
    const bf16_t* K12 = (const bf16_t*)(p.ws + WS_K12);
    float* SC = (float*)lds;
    int* EIDX = (int*)(lds + 65536);
    float* GATE = (float*)(lds + 65536 + 4096);
    char* KL = lds + 73728;
    for (int i = tid; i < 2 * 128 * 16; i += NTHR) {
        const int r = i >> 4, ch = i & 15;
        *(u32x4*)(KL + r * 272 + ch * 16) = *(const u32x4*)(K12 + (size_t)r * 128 + ch * 8);
    }
    __syncthreads();
    for (int tile = tile0; tile < tile0 + ntile; ++tile) {
        const int tok0 = tile * 8;
        {
            const bf16_t* qtok = P + (size_t)(tok0 + wid) * NP + (fr & 7) * 256;
#pragma unroll
            for (int half = 0; half < 2; ++half) {
                f32x4 acc[8];
#pragma unroll
                for (int i = 0; i < 8; ++i) acc[i] = (f32x4){0.f, 0.f, 0.f, 0.f};
                bf16x8 af[4], kfa[8], kfb[8];
#pragma unroll
                for (int ks = 0; ks < 4; ++ks) af[ks] = *(const bf16x8*)(qtok + half * 128 + ks * 32 + fq * 8);
#define KFLOAD(BUF, KS) do { _Pragma("unroll") for (int nt = 0; nt < 8; ++nt) BUF[nt] = *(const bf16x8*)(KL + (half * 128 + nt * 16 + fr) * 272 + (KS) * 64 + fq * 16); } while (0)
#define KFMMA(BUF, KS) do { _Pragma("unroll") for (int nt = 0; nt < 8; ++nt) acc[nt] = mfma16(af[KS], BUF[nt], acc[nt]); } while (0)
                KFLOAD(kfa, 0);
                __builtin_amdgcn_sched_barrier(0);
                KFLOAD(kfb, 1); KFMMA(kfa, 0);
                __builtin_amdgcn_sched_barrier(0);
                KFLOAD(kfa, 2); KFMMA(kfb, 1);
                __builtin_amdgcn_sched_barrier(0);
                KFLOAD(kfb, 3); KFMMA(kfa, 2);
                __builtin_amdgcn_sched_barrier(0);
                KFMMA(kfb, 3);
#undef KFLOAD
#undef KFMMA
                if (fq < 2) {
#pragma unroll
                    for (int nt = 0; nt < 8; ++nt) {
                        float* dst = SC + (wid * 8 + fq * 4) * 256 + half * 128 + nt * 16 + fr;
                        dst[0] = acc[nt].x; dst[256] = acc[nt].y; dst[512] = acc[nt].z; dst[768] = acc[nt].w;
                    }
                }
            }
        }
        __builtin_amdgcn_wave_barrier();
        {
            const int sl = fr, gb = fq * 16;
            const int row0_ = wid * 8 + fq, row1_ = wid * 8 + 4 + fq;
            float v1[2] = {0.f, 0.f}, v2[2] = {0.f, 0.f}; int i1[2] = {0, 0}, i2[2] = {0, 0};
            {
                unsigned kc[4][8];
#pragma unroll
                for (int c4 = 0; c4 < 4; ++c4)
#pragma unroll
                    for (int i = 0; i < 8; ++i) { const int idx = sl + 16 * i;
                        kc[c4][i] = (f2ord(SC[((c4 & 1) ? row1_ : row0_) * 256 + (c4 >> 1) * 128 + idx]) & ~127u) | (unsigned)(127 - idx); }
                float sv[4] = {0.f, 0.f, 0.f, 0.f}; int si[4] = {0, 0, 0, 0};
                for (int r = 0; r < 16; ++r) {
                    unsigned m[4], t[4];
#pragma unroll
                    for (int c4 = 0; c4 < 4; ++c4) {
                        const unsigned x0 = kc[c4][0] > kc[c4][1] ? kc[c4][0] : kc[c4][1], x1 = kc[c4][2] > kc[c4][3] ? kc[c4][2] : kc[c4][3];
                        const unsigned x2 = kc[c4][4] > kc[c4][5] ? kc[c4][4] : kc[c4][5], x3 = kc[c4][6] > kc[c4][7] ? kc[c4][6] : kc[c4][7];
                        const unsigned y0 = x0 > x1 ? x0 : x1, y1 = x2 > x3 ? x2 : x3; m[c4] = y0 > y1 ? y0 : y1;
                    }
#pragma unroll
                    for (int c4 = 0; c4 < 4; ++c4) t[c4] = sxoru<1>(m[c4]);
#pragma unroll
                    for (int c4 = 0; c4 < 4; ++c4) m[c4] = m[c4] > t[c4] ? m[c4] : t[c4];
#pragma unroll
                    for (int c4 = 0; c4 < 4; ++c4) t[c4] = sxoru<2>(m[c4]);
#pragma unroll
                    for (int c4 = 0; c4 < 4; ++c4) m[c4] = m[c4] > t[c4] ? m[c4] : t[c4];
#pragma unroll
                    for (int c4 = 0; c4 < 4; ++c4) t[c4] = sxoru<4>(m[c4]);
#pragma unroll
                    for (int c4 = 0; c4 < 4; ++c4) m[c4] = m[c4] > t[c4] ? m[c4] : t[c4];
#pragma unroll
                    for (int c4 = 0; c4 < 4; ++c4) t[c4] = sxoru<8>(m[c4]);
#pragma unroll
                    for (int c4 = 0; c4 < 4; ++c4) m[c4] = m[c4] > t[c4] ? m[c4] : t[c4];
#pragma unroll
                    for (int c4 = 0; c4 < 4; ++c4) {
                        if (sl == r) { sv[c4] = ord2f(m[c4] & ~127u); si[c4] = 127 - (int)(m[c4] & 127u); }
#pragma unroll
                        for (int i = 0; i < 8; ++i) kc[c4][i] = kc[c4][i] == m[c4] ? 0u : kc[c4][i];
                    }
                }
                v1[0] = sv[0]; i1[0] = si[0]; v1[1] = sv[1]; i1[1] = si[1]; v2[0] = sv[2]; i2[0] = si[2]; v2[1] = sv[3]; i2[1] = si[3];
            }
            int pa = 0, pb = 0; float tsa = 0.f, tsb = 0.f; int pida = 0, pidb = 0;
            for (int r = 0; r < 16; ++r) {
                const float va = __int_as_float(__builtin_amdgcn_ds_bpermute((gb + (pa & 15)) << 2, __float_as_int(v2[0])));
                const float vb = __int_as_float(__builtin_amdgcn_ds_bpermute((gb + (pb & 15)) << 2, __float_as_int(v2[1])));
                const unsigned keya = pa < 16 ? ((f2ord(v1[0] + va) & ~255u) | (unsigned)(255 - (sl * 16 + pa))) : 0u;
                const unsigned keyb = pb < 16 ? ((f2ord(v1[1] + vb) & ~255u) | (unsigned)(255 - (sl * 16 + pb))) : 0u;
                unsigned ma = keya, mb = keyb, ta, tb;
                ta = sxoru<1>(ma); tb = sxoru<1>(mb); ma = ma > ta ? ma : ta; mb = mb > tb ? mb : tb;
                ta = sxoru<2>(ma); tb = sxoru<2>(mb); ma = ma > ta ? ma : ta; mb = mb > tb ? mb : tb;
                ta = sxoru<4>(ma); tb = sxoru<4>(mb); ma = ma > ta ? ma : ta; mb = mb > tb ? mb : tb;
                ta = sxoru<8>(ma); tb = sxoru<8>(mb); ma = ma > ta ? ma : ta; mb = mb > tb ? mb : tb;
                if (sl == r) { tsa = ord2f(ma & ~255u); pida = 255 - (int)(ma & 255u); tsb = ord2f(mb & ~255u); pidb = 255 - (int)(mb & 255u); }
                if (keya == ma) pa++;
                if (keyb == mb) pb++;
            }
#pragma unroll
            for (int ps = 0; ps < 2; ++ps) {
                const int pid = ps ? pidb : pida; const float ts = ps ? tsb : tsa; const int row = ps ? row1_ : row0_;
                const int e1 = __builtin_amdgcn_ds_bpermute((gb + (pid >> 4)) << 2, i1[ps]), e2 = __builtin_amdgcn_ds_bpermute((gb + (pid & 15)) << 2, i2[ps]);
                float mx = ts;
                mx = fmaxf(mx, sxor<1>(mx)); mx = fmaxf(mx, sxor<2>(mx)); mx = fmaxf(mx, sxor<4>(mx)); mx = fmaxf(mx, sxor<8>(mx));
                const float ex = __expf(ts - mx), sm = gsum16(ex);
                EIDX[row * 16 + sl] = e1 * 128 + e2; GATE[row * 16 + sl] = ex / sm;
            }
        }
        __builtin_amdgcn_wave_barrier();
        {
            const int tok = tok0 + wid;
            const bf16_t* hrow = HB + (size_t)tok * D;
            const int grp = lane >> 4, sl = lane & 15;
            {
                f32x2 hv[32];
#pragma unroll
                for (int c = 0; c < 8; ++c) {
                    const u32x4 hq = *(const u32x4*)(hrow + sl * 64 + c * 8);
                    hv[c * 4 + 0] = (f32x2){bflo(hq.x), bfhi(hq.x)} * (1.0f / PEER_SU); hv[c * 4 + 1] = (f32x2){bflo(hq.y), bfhi(hq.y)} * (1.0f / PEER_SU);
                    hv[c * 4 + 2] = (f32x2){bflo(hq.z), bfhi(hq.z)} * (1.0f / PEER_SU); hv[c * 4 + 3] = (f32x2){bflo(hq.w), bfhi(hq.w)} * (1.0f / PEER_SU);
                }
                const unsigned char* PU8 = p.ws + WS_PU + sl * 64;
#define ULOADG(BUF, IT) do { _Pragma("unroll") for (int i_ = 0; i_ < 2; ++i_) { const int k_ = ((IT) + i_) * 4 + grp; const unsigned char* ur_ = PU8 + (size_t)EIDX[wid * 128 + k_] * D; \
        BUF[i_ * 4 + 0] = *(const u32x4*)ur_; BUF[i_ * 4 + 1] = *(const u32x4*)(ur_ + 16); BUF[i_ * 4 + 2] = *(const u32x4*)(ur_ + 32); BUF[i_ * 4 + 3] = *(const u32x4*)(ur_ + 48); } } while (0)
#define PDOT(uq, base) \
        a2 += __builtin_amdgcn_cvt_pk_f32_fp8((int)uq.x, false) * hv[base + 0]; b2 += __builtin_amdgcn_cvt_pk_f32_fp8((int)uq.x, true) * hv[base + 1]; \
        a2 += __builtin_amdgcn_cvt_pk_f32_fp8((int)uq.y, false) * hv[base + 2]; b2 += __builtin_amdgcn_cvt_pk_f32_fp8((int)uq.y, true) * hv[base + 3]; \
        a2 += __builtin_amdgcn_cvt_pk_f32_fp8((int)uq.z, false) * hv[base + 4]; b2 += __builtin_amdgcn_cvt_pk_f32_fp8((int)uq.z, true) * hv[base + 5]; \
        a2 += __builtin_amdgcn_cvt_pk_f32_fp8((int)uq.w, false) * hv[base + 6]; b2 += __builtin_amdgcn_cvt_pk_f32_fp8((int)uq.w, true) * hv[base + 7];
#define UCOMP(BUF, IT) do { _Pragma("unroll") for (int i_ = 0; i_ < 2; ++i_) { const int k_ = ((IT) + i_) * 4 + grp; \
        f32x2 a2 = (f32x2){0.f, 0.f}, b2 = (f32x2){0.f, 0.f}; \
        PDOT(BUF[i_ * 4 + 0], 0) PDOT(BUF[i_ * 4 + 1], 8) PDOT(BUF[i_ * 4 + 2], 16) PDOT(BUF[i_ * 4 + 3], 24) \
        a2 += b2; const float a_ = gsum16(a2.x + a2.y); GATE[wid * 128 + k_] = GATE[wid * 128 + k_] * gelu_exact(a_); } } while (0)
                u32x4 ubA[8], ubB[8];
                ULOADG(ubA, 0);
                for (int it0 = 0; it0 < 32; it0 += 4) {
                    ULOADG(ubB, it0 + 2);
                    __builtin_amdgcn_sched_barrier(0);
                    UCOMP(ubA, it0);
                    __builtin_amdgcn_sched_barrier(0);
                    if (it0 + 4 < 32) ULOADG(ubA, it0 + 4);
                    __builtin_amdgcn_sched_barrier(0);
                    UCOMP(ubB, it0 + 2);
                    __builtin_amdgcn_sched_barrier(0);
                }
#undef ULOADG
#undef PDOT
#undef UCOMP
            }
            __builtin_amdgcn_wave_barrier();
            f32x2 acc[8];
#pragma unroll
            for (int i = 0; i < 8; ++i) acc[i] = (f32x2){0.f, 0.f};
            const unsigned char* PV8 = p.ws + WS_PV + lane * 16;
#define VLOADG(BUF, K0) do { _Pragma("unroll") for (int i_ = 0; i_ < 8; ++i_) BUF[i_] = *(const u32x4*)(PV8 + (size_t)EIDX[wid * 128 + (K0) + i_] * D); } while (0)
#define VCOMP(BUF, K0) do { _Pragma("unroll") for (int i_ = 0; i_ < 8; ++i_) { const float w_ = GATE[wid * 128 + (K0) + i_]; const f32x2 w2 = (f32x2){w_, w_}; const u32x4 v = BUF[i_]; \
        acc[0] += w2 * __builtin_amdgcn_cvt_pk_f32_fp8((int)v.x, false); acc[1] += w2 * __builtin_amdgcn_cvt_pk_f32_fp8((int)v.x, true); \
        acc[2] += w2 * __builtin_amdgcn_cvt_pk_f32_fp8((int)v.y, false); acc[3] += w2 * __builtin_amdgcn_cvt_pk_f32_fp8((int)v.y, true); \
        acc[4] += w2 * __builtin_amdgcn_cvt_pk_f32_fp8((int)v.z, false); acc[5] += w2 * __builtin_amdgcn_cvt_pk_f32_fp8((int)v.z, true); \
        acc[6] += w2 * __builtin_amdgcn_cvt_pk_f32_fp8((int)v.w, false); acc[7] += w2 * __builtin_amdgcn_cvt_pk_f32_fp8((int)v.w, true); } } while (0)
            {
                u32x4 vbA[8], vbB[8];
                VLOADG(vbA, 0);
                for (int k0 = 0; k0 < 128; k0 += 16) {
                    VLOADG(vbB, k0 + 8);
                    __builtin_amdgcn_sched_barrier(0);
                    VCOMP(vbA, k0);
                    __builtin_amdgcn_sched_barrier(0);
                    if (k0 + 16 < 128) VLOADG(vbA, k0 + 16);
                    __builtin_amdgcn_sched_barrier(0);
                    VCOMP(vbB, k0 + 8);
                    __builtin_amdgcn_sched_barrier(0);
                }
            }
#undef VLOADG
#undef VCOMP
            float* orow = G.out + (size_t)tok * D + lane * 16;
#pragma unroll
            for (int i = 0; i < 4; ++i) {
                f32x4 t = *(f32x4*)(orow + i * 4);
                t.x += acc[2 * i].x * (1.0f / PEER_SV); t.y += acc[2 * i].y * (1.0f / PEER_SV); t.z += acc[2 * i + 1].x * (1.0f / PEER_SV); t.w += acc[2 * i + 1].y * (1.0f / PEER_SV);
                *(f32x4*)(orow + i * 4) = t;
            }
        }
        __builtin_amdgcn_wave_barrier();
    }
}


constexpr int NPH = 3 + NGROUP * 3;
__device__ __forceinline__ void run_phase(const Params& p, int ph, char* lds, int* s_item) {
    const int g = (ph - 3) / 3, s = (ph - 3) % 3;
    const Grp G = get_group(p, g);
    if (s == 0) {
        for (int ub = blockIdx.x; ub < 256; ub += gridDim.x) {
            const int u = (ub & 0xF0) | ((ub & 7) << 1) | ((ub >> 3) & 1);
            const int m0 = (u >> 1) * 256;
            phase_rmsnorm(G.x, p.in[I_GMIX], (bf16_t*)(p.ws + WS_HB), m0, 256);
            __syncthreads();
            phase_inproj(p, g, lds, u);
            __syncthreads();
        }
        if (g == 0) {
            phase_p0b(p, lds);
        }
    } else if (s == 1) {
        phase_mixer(p, g, lds, s_item);
    } else {
        for (int u = blockIdx.x; u < 256; u += gridDim.x) {
            const int m0 = u * 128;
            phase_glafin(p, g, m0, 128);
            __syncthreads();
            phase_merge(p, g, lds, u);
            __syncthreads();
            phase_outproj(p, g, lds, u);
            __syncthreads();
            phase_rmsnorm(G.out, p.in[I_GFFN], (bf16_t*)(p.ws + WS_HB), m0, 128);
            __syncthreads();
            phase_peerq(p, g, lds, u);
            __syncthreads();
            phase_peer(p, g, lds, m0 / 8, 16);
            __syncthreads();
        }
    }
}

__global__ void __launch_bounds__(NTHR) mega_kernel(Params p) {
    extern __shared__ __attribute__((aligned(16))) char lds[];
    __shared__ int s_item;
    cg::grid_group grid = cg::this_grid();
    phase_p0a(p, lds); grid.sync();
    for (int ph = 3; ph < NPH; ++ph) {
        run_phase(p, ph, lds, &s_item);
        if (ph + 1 < NPH) grid.sync();
    }
}

extern "C" void kernel_launch(void* const* d_in, const int* in_sizes, int n_in, void* d_out, int out_size, void* d_ws, size_t ws_size, hipStream_t stream) {
    static int grid_blocks = 0;
    if (grid_blocks == 0) {
        if (n_in != 32 || ws_size < WS_END) { fprintf(stderr, "kernel_launch: unexpected n_in %d or ws_size %zu (< %zu)\n", n_in, ws_size, (size_t)WS_END); grid_blocks = -1; return; }
        int dev = 0, cus = 0, per_cu = 0;
        hipGetDevice(&dev);
        hipDeviceGetAttribute(&cus, hipDeviceAttributeMultiprocessorCount, dev);
        hipFuncSetAttribute((const void*)mega_kernel, hipFuncAttributeMaxDynamicSharedMemorySize, LDS_BYTES);
        hipOccupancyMaxActiveBlocksPerMultiprocessor(&per_cu, (const void*)mega_kernel, NTHR, LDS_BYTES);
        if (per_cu < 1) per_cu = 1;
        grid_blocks = cus * per_cu;
        (void)hipGetLastError();
    }
    if (grid_blocks < 0) return;
    Params p{};
    for (int i = 0; i < 32; ++i) p.in[i] = (const float*)d_in[i];
    p.out = (float*)d_out; p.ws = (unsigned char*)d_ws; p.ph_lo = 0; p.ph_hi = NPH;
    void* args[] = {&p};
    hipError_t e = hipLaunchCooperativeKernel((const void*)mega_kernel, dim3(grid_blocks), dim3(NTHR), args, LDS_BYTES, stream);
    if (e != hipSuccess) fprintf(stderr, "cooperative launch failed: %s (grid %d)\n", hipGetErrorString(e), grid_blocks);
}
```
